# Optimizing an MI355X kernel written in HIP

```python
import math
import jax, jax.numpy as jnp
from jax import lax
import numpy as np

D_MODEL = 1024
BATCH = 16
SEQ = 256
DEPTH = 1
DEC_BATCH = 2
DEC_SEQ = 2048
PAST_LEN = 256

GRID_W = 64
MLA_HEADS = 8
MLA_NOPE = 64
MLA_ROPE = 32
MLA_QK = MLA_NOPE + MLA_ROPE
MLA_V = 64
Q_LORA = 384
KV_LORA = 256
GLA_HEADS = 4
GLA_DK = 64
GLA_DV = 128
GATE_RANK = 16
GATE_NORM = 16.0
CHUNK = 64
D_MIX = MLA_HEADS * MLA_V + GLA_HEADS * GLA_DV
D_FF = 2816
QBLOCK = 128
ROPE_BASE = 10000.0
EPS = 1e-6
IN_SIZES = (Q_LORA, KV_LORA, MLA_ROPE, GLA_HEADS * GLA_DK, GLA_HEADS * GLA_DK,
            GLA_HEADS * GLA_DV, GATE_RANK, GATE_RANK, GLA_HEADS * GLA_DV)
IN_COLS = Q_LORA + KV_LORA + MLA_ROPE + 2 * GLA_HEADS * GLA_DK + 2 * GLA_HEADS * GLA_DV + 2 * GATE_RANK

kernel_name = "hybrid_mla_gla_diffusion_step"


def _rmsnorm(x, w):
    xf = x.astype(jnp.float32)
    xf = xf * lax.rsqrt(jnp.mean(xf * xf, axis=-1, keepdims=True) + EPS)
    return (xf * w.astype(jnp.float32)).astype(x.dtype)


def _split_in(z):
    idx = []
    acc = 0
    for s in IN_SIZES[:-1]:
        acc += s
        idx.append(acc)
    return jnp.split(z, idx, axis=-1)


def _axial_rope_tables(n_tokens):
    rows = n_tokens // GRID_W
    t = jnp.arange(rows * GRID_W)
    row = (t // GRID_W).astype(jnp.float32)
    col = (t % GRID_W).astype(jnp.float32)
    half = MLA_ROPE // 2
    inv = ROPE_BASE ** (-jnp.arange(0, half, 2, dtype=jnp.float32) / half)
    ang_r = row[:, None] * inv
    ang_c = col[:, None] * inv
    ang = jnp.concatenate([ang_r, ang_r, ang_c, ang_c], axis=-1)
    return jnp.cos(ang), jnp.sin(ang)


def _rotate_half(x):
    x1, x2 = jnp.split(x, 2, axis=-1)
    return jnp.concatenate([-x2, x1], axis=-1)


def _apply_axial_rope(x, cos, sin):
    xf = x.astype(jnp.float32)
    half = MLA_ROPE // 2
    rot = jnp.concatenate([_rotate_half(xf[..., :half]), _rotate_half(xf[..., half:])], axis=-1)
    return (xf * cos + rot * sin).astype(x.dtype)


def _mla_decompress(ckv, k_rope, w_ukv):
    b, s, _ = ckv.shape
    kv = (ckv @ w_ukv).reshape(b, s, MLA_HEADS, MLA_NOPE + MLA_V)
    k_nope, v = kv[..., :MLA_NOPE], kv[..., MLA_NOPE:]
    k_r = jnp.broadcast_to(k_rope[:, :, None, :], (b, s, MLA_HEADS, MLA_ROPE))
    return jnp.concatenate([k_nope, k_r], axis=-1), v


def _blocked_attention(q, k, v):
    b, t, h, d = q.shape
    nb = t // QBLOCK
    qb = q.reshape(b, nb, QBLOCK, h, d).transpose(1, 0, 2, 3, 4)
    scale = MLA_QK ** -0.5

    def one_block(qi):
        s = jnp.einsum('bqhd,bkhd->bhqk', qi, k).astype(jnp.float32) * scale
        p = jax.nn.softmax(s, axis=-1).astype(v.dtype)
        return jnp.einsum('bhqk,bkhd->bqhd', p, v)

    out = lax.map(one_block, qb)
    return out.transpose(1, 0, 2, 3, 4).reshape(b, t, h, v.shape[-1])


def _gla_chunk(q, k, v, g, s0):
    b, h, t, dk = q.shape
    dv = v.shape[-1]
    n = t // CHUNK
    f32 = jnp.float32
    q = q.astype(f32).reshape(b, h, n, CHUNK, dk) * (dk ** -0.5)
    k = k.astype(f32).reshape(b, h, n, CHUNK, dk)
    v = v.astype(f32).reshape(b, h, n, CHUNK, dv)
    cum = jnp.cumsum(g.astype(f32).reshape(b, h, n, CHUNK, dk), axis=3)
    cum_last = cum[:, :, :, -1:, :]
    qe = q * jnp.exp(cum)
    ke = k * jnp.exp(-cum)
    kd = k * jnp.exp(cum_last - cum)
    mask = jnp.tril(jnp.ones((CHUNK, CHUNK), dtype=bool))
    att = jnp.where(mask, jnp.einsum('bhncd,bhnsd->bhncs', qe, ke), 0.0)
    o_intra = jnp.einsum('bhncs,bhnse->bhnce', att, v)
    decay = jnp.exp(cum_last[:, :, :, 0, :])

    def step(state, inp):
        qe_n, kd_n, v_n, dec_n = inp
        o_n = jnp.einsum('bhcd,bhde->bhce', qe_n, state)
        state = dec_n[..., None] * state + jnp.einsum('bhcd,bhce->bhde', kd_n, v_n)
        return state, o_n

    xs = (jnp.moveaxis(qe, 2, 0), jnp.moveaxis(kd, 2, 0), jnp.moveaxis(v, 2, 0), jnp.moveaxis(decay, 2, 0))
    s_final, o_inter = lax.scan(step, s0.astype(f32), xs)
    o = o_intra + jnp.moveaxis(o_inter, 0, 2)
    return o.reshape(b, h, t, dv), s_final


def _gla_gate(low, w2, b2):
    return jax.nn.log_sigmoid((low @ w2 + b2).astype(jnp.float32)) / GATE_NORM


def _layer(x, cond, lp, rope, ctx):
    (w_ada, b_ada, norm_attn, w_in, q_norm, w_uq, kv_norm, w_ukv, w_gate_f, b_gate_f,
     w_gate_b, b_gate_b, gla_norm, w_out, norm_ffn, w_ffn_in, w_ffn_out) = lp
    b, t, _ = x.shape
    mod = jax.nn.silu(cond) @ w_ada + b_ada
    sh1, sc1, gt1, sh2, sc2, gt2 = jnp.split(mod, 6, axis=-1)
    h = _rmsnorm(x, norm_attn) * (1 + sc1) + sh1
    q_lat, kv_lat, k_rope, gq, gk, gv, gf_low, gb_low, g_out = _split_in(h @ w_in)

    q = (_rmsnorm(q_lat, q_norm) @ w_uq).reshape(b, t, MLA_HEADS, MLA_QK)
    ckv = _rmsnorm(kv_lat, kv_norm)
    if rope is not None:
        cos, sin = rope
        q = jnp.concatenate([q[..., :MLA_NOPE],
                             _apply_axial_rope(q[..., MLA_NOPE:], cos[:, None, :], sin[:, None, :])], axis=-1)
        k_rope_pos = _apply_axial_rope(k_rope, cos, sin)
    else:
        k_rope_pos = k_rope
    k, v = _mla_decompress(ckv, k_rope_pos, w_ukv)
    if ctx is not None:
        ckv_ctx, krope_ctx, s_f0, s_b0 = ctx
        k_c, v_c = _mla_decompress(ckv_ctx.astype(x.dtype), krope_ctx.astype(x.dtype), w_ukv)
        k = jnp.concatenate([k_c, k], axis=1)
        v = jnp.concatenate([v_c, v], axis=1)
    else:
        s_f0 = jnp.zeros((b, GLA_HEADS, GLA_DK, GLA_DV), jnp.float32)
        s_b0 = jnp.zeros((b, GLA_HEADS, GLA_DK, GLA_DV), jnp.float32)
    attn = _blocked_attention(q, k, v).reshape(b, t, MLA_HEADS * MLA_V)

    def heads(a, d):
        return a.reshape(b, t, GLA_HEADS, d).transpose(0, 2, 1, 3)
    qg, kg, vg = heads(gq, GLA_DK), heads(gk, GLA_DK), heads(gv, GLA_DV)
    g_f = heads(_gla_gate(gf_low, w_gate_f, b_gate_f), GLA_DK)
    g_b = heads(_gla_gate(gb_low, w_gate_b, b_gate_b), GLA_DK)
    o_f, s_f = _gla_chunk(qg, kg, vg, g_f, s_f0)
    o_b, s_b = _gla_chunk(jnp.flip(qg, 2), jnp.flip(kg, 2), jnp.flip(vg, 2), jnp.flip(g_b, 2), s_b0)
    o = (o_f + jnp.flip(o_b, 2)).transpose(0, 2, 1, 3).astype(x.dtype)
    o = _rmsnorm(o, gla_norm).reshape(b, t, GLA_HEADS * GLA_DV) * jax.nn.silu(g_out)

    mix = jnp.concatenate([attn, o], axis=-1) @ w_out
    x = x + gt1 * mix
    h2 = _rmsnorm(x, norm_ffn) * (1 + sc2) + sh2
    a, g = jnp.split(h2 @ w_ffn_in, 2, axis=-1)
    x = x + gt2 * ((jax.nn.silu(a) * g) @ w_ffn_out)
    return x, (ckv, k_rope, s_f, s_b)


def setup_inputs(seed: int = 0) -> dict:
    key = jax.random.key(seed)
    ks = jax.random.split(key, 32)
    f32 = jnp.float32

    def nrm(k, shape, scale):
        return jax.random.normal(k, shape, f32) * scale

    def gain(k, shape):
        return 1.0 + 0.1 * jax.random.normal(k, shape, f32)

    L = DEPTH
    return {
        "x_prompt": nrm(ks[0], (BATCH, SEQ, D_MODEL), 1.0),
        "x_sample": nrm(ks[1], (DEC_BATCH, DEC_SEQ, D_MODEL), 1.0),
        "cache_kv_latent": nrm(ks[2], (DEC_BATCH, L, PAST_LEN, KV_LORA), 1.0),
        "cache_k_rope": nrm(ks[3], (DEC_BATCH, L, PAST_LEN, MLA_ROPE), 1.0),
        "state_gla_fwd": nrm(ks[4], (DEC_BATCH, L, GLA_HEADS, GLA_DK, GLA_DV), 0.3),
        "state_gla_bwd": nrm(ks[5], (DEC_BATCH, L, GLA_HEADS, GLA_DK, GLA_DV), 0.3),
        "c": nrm(ks[6], (DEC_BATCH, D_MODEL), 1.0),
        "c_ctx": nrm(ks[7], (D_MODEL,), 1.0),
        "w_ada": nrm(ks[8], (L, D_MODEL, 6 * D_MODEL), D_MODEL ** -0.5),
        "b_ada": nrm(ks[9], (L, 6 * D_MODEL), 0.02),
        "norm_attn": gain(ks[10], (L, D_MODEL)),
        "w_in": nrm(ks[11], (L, D_MODEL, IN_COLS), D_MODEL ** -0.5),
        "mla_q_norm": gain(ks[12], (L, Q_LORA)),
        "w_uq": nrm(ks[13], (L, Q_LORA, MLA_HEADS * MLA_QK), Q_LORA ** -0.5),
        "mla_kv_norm": gain(ks[14], (L, KV_LORA)),
        "w_ukv": nrm(ks[15], (L, KV_LORA, MLA_HEADS * (MLA_NOPE + MLA_V)), KV_LORA ** -0.5),
        "w_gate_f": nrm(ks[16], (L, GATE_RANK, GLA_HEADS * GLA_DK), GATE_RANK ** -0.5),
        "b_gate_f": nrm(ks[17], (L, GLA_HEADS * GLA_DK), 0.1),
        "w_gate_b": nrm(ks[18], (L, GATE_RANK, GLA_HEADS * GLA_DK), GATE_RANK ** -0.5),
        "b_gate_b": nrm(ks[19], (L, GLA_HEADS * GLA_DK), 0.1),
        "gla_norm": gain(ks[20], (L, GLA_DV)),
        "w_out": nrm(ks[21], (L, D_MIX, D_MODEL), D_MIX ** -0.5),
        "norm_ffn": gain(ks[22], (L, D_MODEL)),
        "w_ffn_in": nrm(ks[23], (L, D_MODEL, 2 * D_FF), D_MODEL ** -0.5),
        "w_ffn_out": nrm(ks[24], (L, D_FF, D_MODEL), D_FF ** -0.5),
        "final_norm": gain(ks[25], (D_MODEL,)),
    }


def reference(x_prompt, x_sample, cache_kv_latent, cache_k_rope, state_gla_fwd, state_gla_bwd,
              c, c_ctx, w_ada, b_ada, norm_attn, w_in, mla_q_norm, w_uq, mla_kv_norm, w_ukv,
              w_gate_f, b_gate_f, w_gate_b, b_gate_b, gla_norm, w_out, norm_ffn, w_ffn_in,
              w_ffn_out, final_norm):
    rope = _axial_rope_tables(x_sample.shape[1])
    cond_ctx = c_ctx[None, None, :]
    cond_lat = c[:, None, :]
    xp, xs = x_prompt, x_sample
    kv_list, kr_list, sf_list, sb_list = [], [], [], []
    for l in range(DEPTH):
        lp = (w_ada[l], b_ada[l], norm_attn[l], w_in[l], mla_q_norm[l], w_uq[l], mla_kv_norm[l],
              w_ukv[l], w_gate_f[l], b_gate_f[l], w_gate_b[l], b_gate_b[l], gla_norm[l], w_out[l],
              norm_ffn[l], w_ffn_in[l], w_ffn_out[l])
        xp, (ckv, kr, sf, sb) = _layer(xp, cond_ctx, lp, None, None)
        kv_list.append(ckv)
        kr_list.append(kr)
        sf_list.append(sf.astype(x_prompt.dtype))
        sb_list.append(sb.astype(x_prompt.dtype))
        ctx = (cache_kv_latent[:, l], cache_k_rope[:, l], state_gla_fwd[:, l], state_gla_bwd[:, l])
        xs, _ = _layer(xs, cond_lat, lp, rope, ctx)
    y_prompt = _rmsnorm(xp, final_norm)
    y_sample = _rmsnorm(xs, final_norm)
    new_kv_latent = jnp.stack(kv_list, axis=1)
    new_k_rope = jnp.stack(kr_list, axis=1)
    new_state_fwd = jnp.stack(sf_list, axis=1)
    new_state_bwd = jnp.stack(sb_list, axis=1)
    return (y_prompt, y_sample, new_kv_latent, new_k_rope, new_state_fwd, new_state_bwd)
```

```cpp
#include <hip/hip_runtime.h>
#include <hip/hip_cooperative_groups.h>
#include <cstdio>
#include <cstdint>
namespace cg = cooperative_groups;

#define PROBE_FILL 0
#define PROBE_EXC 0
#define PROBE_BLO 0
#define PROBE_BHI 256
#define PROBE_RSTRIDE 1
#define PROBE_REP 1
#define PROBE_XLO 0
#define PROBE_XHI 8
#define PROBE_HANG 0
#define PROBE_DUMP 0
#define PROBE_STATS 0
#define PROBE_K6 512
#define PROBE_ONLY_LAUNCH -1
#define PROBE_NOSTORE 0
#define PROBE_FILL_MIB 256
#define PROBE_FILL_VAL 1.2345f
#ifndef PROBE_MUL
#define PROBE_MUL 1.f
#endif
#ifndef PROBE_MODOFF
#define PROBE_MODOFF 0u
#endif
#ifndef MK_COOP
#define MK_COOP 0
#endif
#ifndef MK_PER_PHASE_LAUNCH
#define MK_PER_PHASE_LAUNCH 0
#endif

#define LAS __attribute__((address_space(3)))
typedef unsigned short bf16_t;
typedef short bf16x8 __attribute__((ext_vector_type(8)));
typedef float f32x4 __attribute__((ext_vector_type(4)));
typedef float f32x2 __attribute__((ext_vector_type(2)));
typedef unsigned u32x4 __attribute__((ext_vector_type(4)));
typedef unsigned u32x2 __attribute__((ext_vector_type(2)));

constexpr int D = 1024, MTOK = 8192, MP = 4096;
constexpr int ZP = 2304;
constexpr int C_QLAT = 0, C_KVLAT = 384, C_KROPE = 640, C_GQ = 672, C_GK = 928, C_GV = 1184, C_GFL = 1696, C_GOUT = 1728;
constexpr int DFF = 2816;
constexpr float EPS = 1e-6f;
constexpr float QSCALE = 0.10206207261596577f * 1.4426950408889634f;
constexpr int SKS = 2304;

constexpr size_t MiB = 1u << 20;
constexpr size_t WS_WIN = 1 * MiB;
constexpr size_t WS_WUQ = 6 * MiB;
constexpr size_t WS_WKF = 7 * MiB, WS_WVF = 7 * MiB + 256 * 1024;
constexpr size_t WS_WKU = 7 * MiB + 512 * 1024, WS_WVU = 7 * MiB + 768 * 1024;
constexpr size_t WS_WOUT = 8 * MiB;
constexpr size_t WS_WFFI = 10 * MiB;
constexpr size_t WS_WFFO = 21 * MiB;
constexpr size_t WS_BAR = 27 * MiB - 4096;
constexpr size_t WS_MOD = 27 * MiB;
constexpr size_t WS_RSSQ = 29 * MiB;
constexpr size_t WS_RSSKV = WS_RSSQ;
constexpr size_t WS_CACHEB = 27 * MiB + 256 * 1024;
constexpr size_t WS_DEC = 28 * MiB;
constexpr size_t WS_H = 32 * MiB;
constexpr size_t WS_Z = 48 * MiB;
constexpr size_t WS_Q = 84 * MiB;
constexpr size_t WS_HFF = 48 * MiB;
constexpr size_t WS_KP = 96 * MiB;
constexpr size_t WS_KS = 102 * MiB;
constexpr size_t WS_VTP = 109 * MiB;
constexpr size_t WS_VTS = 113 * MiB;
constexpr size_t WS_CT = 118 * MiB;
constexpr size_t WS_MIX = 150 * MiB;
constexpr size_t WS_X1 = 166 * MiB;
constexpr size_t WS_P0 = 96 * MiB;
constexpr size_t WS_P1A = 48 * MiB, WS_P1B = 128 * MiB;
constexpr size_t O_Y = 0, O_KV = 8388608, O_KR = O_KV + 1048576, O_SF = O_KR + 131072, O_SB = O_SF + 524288;

constexpr int LDS_BYTES = 147456;

__device__ __forceinline__ unsigned f2bf_sw(float f) { unsigned u = __builtin_bit_cast(unsigned, f); return (u + 0x7fffu + ((u >> 16) & 1u)) >> 16; }
__device__ __forceinline__ unsigned cvt_pk_bf16(float lo, float hi) { return f2bf_sw(lo) | (f2bf_sw(hi) << 16); }
__device__ __forceinline__ bf16_t f2bf(float f) { return (bf16_t)(cvt_pk_bf16(f, 0.f) & 0xffffu); }
__device__ __forceinline__ float bf2f(bf16_t b) { return __uint_as_float((unsigned)b << 16); }
__device__ __forceinline__ float bflo(unsigned w) { return __uint_as_float(w << 16); }
__device__ __forceinline__ float bfhi(unsigned w) { return __uint_as_float(w & 0xffff0000u); }
__device__ __forceinline__ float wave_sum(float v) {
#pragma unroll
    for (int o = 1; o < 64; o <<= 1) v += __shfl_xor(v, o);
    return v;
}
__device__ __forceinline__ float fast_rcp(float x) { return __builtin_amdgcn_rcpf(x); }
__device__ __forceinline__ float silu_f(float a) { return a * fast_rcp(1.f + __expf(-a)); }
__device__ __forceinline__ float logsigmoid_f(float x) { return fminf(x, 0.f) - __logf(1.f + __expf(-fabsf(x))); }
__device__ __forceinline__ int opaque_lane() { int l; asm volatile("v_mbcnt_lo_u32_b32 %0, -1, 0\n\tv_mbcnt_hi_u32_b32 %0, -1, %0" : "=v"(l)); return l; }
__device__ __forceinline__ int otid(int wv) { int t = (int)threadIdx.x; asm volatile("" : "+v"(t)); return t; }
#define LDS_WAIT() asm volatile("s_waitcnt lgkmcnt(0)" ::: "memory")
#define VM_WAIT() asm volatile("s_waitcnt vmcnt(0)" ::: "memory")

namespace pg8 {
constexpr int BM = 256, BK = 64, HALF = 128, HTB = HALF * BK * 2, STAGE_BYTES = 8 * HTB, NXCD = 8, WGM = 8;
__host__ __device__ __forceinline__ int lds_byte(int r, int c) { const int st = (r >> 4) * 2 + (c >> 5), rr = r & 15, cc = c & 31, ob = rr * 64 + cc * 2; return st * 1024 + (ob ^ (((ob >> 9) & 1) << 5)); }
__host__ __device__ __forceinline__ void stage_rc(int b, int& R, int& C) { const int st = b / 1024, sb = b % 1024, swz = sb ^ (((sb >> 9) & 1) << 5); R = (st >> 1) * 16 + swz / 64; C = (st & 1) * 32 + (swz % 64) / 2; }
__host__ __device__ __forceinline__ int perm32(int rho) { const int n = rho >> 4, i = rho & 15; return 8 * (i >> 2) + 4 * n + (i & 3); }

struct Unit { int pm, pn, ks; };
struct Gemm { const bf16_t* A; const bf16_t* Bt; int lda, ldb, K, wv; };

struct Order {
    int nM, nN, nNs, nwg, G, c;
    __device__ void init(int M, int N, int nsplit, int G_, int c_) { nM = M / BM; nN = N / BM; nNs = nN * nsplit; nwg = nM * nNs; G = G_; c = c_; }
    __device__ bool next(int i, Unit& u) const {
        const long L = (long)i * G + c; if (L >= nwg) return false;
        int wgid = (int)L; { const int q = nwg / NXCD, r = nwg % NXCD, xcd = wgid % NXCD, off = wgid / NXCD; wgid = (xcd < r ? xcd * (q + 1) : r * (q + 1) + (xcd - r) * q) + off; }
        const int nig = WGM * nNs, gid = wgid / nig, fm = gid * WGM, gsz = (nM - fm) < WGM ? (nM - fm) : WGM;
        u.pm = fm + ((wgid % nig) % gsz); const int pn2 = (wgid % nig) / gsz; u.pn = pn2 % nN; u.ks = pn2 / nN; return true;
    }
};

template <class Epi, class Sched, bool ALIGN_EPI = true, bool SP2 = true>
__device__ __forceinline__ void gemm_phase(LAS unsigned char* lds, const Gemm g, const Sched& S, const Epi& E) {
    const int tid = otid(g.wv), wid = g.wv, lane = tid & 63, wr = wid >> 2, wc = wid & 3, fr = lane & 15, fq = lane >> 4;
    const int K = g.K, nt = K / BK;
    unsigned voffA[2], voffB[2];
#pragma unroll
    for (int i = 0; i < 2; ++i) { int R, C; stage_rc(tid * 16 + i * 8192, R, C); const int Rb = Epi::PERM ? ((R & ~31) + perm32(R & 31)) : R;
        voffA[i] = (unsigned)(R * g.lda + C) * 2u; voffB[i] = (unsigned)(Rb * g.ldb + C) * 2u; }
    const size_t kstep = (size_t)(BK * 2);
    const size_t hstepA = (size_t)HALF * g.lda * 2, hstepB = (size_t)HALF * g.ldb * 2;
    const size_t tstepA = 2 * hstepA, tstepB = 2 * hstepB;
    const size_t ksplit = (size_t)K * 2;
    const unsigned ldsw = (unsigned)wid * 1024u;
    const int aoff = lds_byte(wr * 64 + fr, fq * 8), boff = lds_byte(wc * 32 + fr, fq * 8);
#define PG8_SA(b, h) (((b) * 2 + (h)) * HTB)
#define PG8_SB(b, h) ((4 + (b) * 2 + (h)) * HTB)
#define PG8_STAGE(bufoff, gbase, voff) do { _Pragma("unroll") for (int _i = 0; _i < 2; ++_i) \
        __builtin_amdgcn_global_load_lds((const unsigned*)((const char*)(gbase) + (voff)[_i]), (LAS unsigned*)(lds + (bufoff) + ldsw + _i * 8192), 16, 0, 0); } while (0)
#define PG8_LDA(dst, b, h) do { _Pragma("unroll") for (int m = 0; m < 4; ++m) _Pragma("unroll") for (int k = 0; k < 2; ++k) dst[m][k] = *(const LAS bf16x8*)(lds + PG8_SA(b, h) + aoff + m * 2048 + k * 1024); } while (0)
#define PG8_LDB(dst, b, h) do { _Pragma("unroll") for (int n = 0; n < 2; ++n) _Pragma("unroll") for (int k = 0; k < 2; ++k) dst[n][k] = *(const LAS bf16x8*)(lds + PG8_SB(b, h) + boff + n * 2048 + k * 1024); } while (0)
#define PG8_MMA(ai, bj, At, Bt) do { __builtin_amdgcn_s_setprio(1); _Pragma("unroll") for (int m = 0; m < 4; ++m) _Pragma("unroll") for (int n = 0; n < 2; ++n) _Pragma("unroll") for (int k = 0; k < 2; ++k) \
        acc[ai][bj][m][n] = __builtin_amdgcn_mfma_f32_16x16x32_bf16(Bt[n][k], At[m][k], acc[ai][bj][m][n], 0, 0, 0); __builtin_amdgcn_s_setprio(0); } while (0)
#define PG8_WAIT_V(n) asm volatile("s_waitcnt vmcnt(" #n ")" ::: "memory")
#define PG8_WAIT_L(n) asm volatile("s_waitcnt lgkmcnt(" #n ")" ::: "memory")
#define PG8_BAR __builtin_amdgcn_s_barrier()
#define PG8_SCHED __builtin_amdgcn_sched_barrier(0)
    Unit cur, nxt; int ui = 0;
    if (!S.next(0, cur)) return;
    f32x4 acc[2][2][4][2];
#pragma unroll
    for (int a = 0; a < 2; ++a)
#pragma unroll
        for (int b = 0; b < 2; ++b)
#pragma unroll
            for (int m = 0; m < 4; ++m)
#pragma unroll
                for (int n = 0; n < 2; ++n) acc[a][b][m][n] = (f32x4){0.f, 0.f, 0.f, 0.f};
    bf16x8 At[4][2], B0[2][2], B1[2][2];
    const char* cA = (const char*)g.A + (size_t)cur.pm * tstepA + (size_t)cur.ks * ksplit; const char* cB = (const char*)g.Bt + (size_t)cur.pn * tstepB + (size_t)cur.ks * ksplit;
    if constexpr (SP2) {
        PG8_STAGE(PG8_SB(0, 0), cB, voffB); PG8_STAGE(PG8_SB(0, 1), cB + hstepB, voffB); PG8_STAGE(PG8_SA(0, 0), cA, voffA); PG8_STAGE(PG8_SA(0, 1), cA + hstepA, voffA);
        if (wr == 1) PG8_BAR;
        PG8_WAIT_V(2); PG8_BAR;
        PG8_STAGE(PG8_SB(1, 0), cB + kstep, voffB); PG8_STAGE(PG8_SA(1, 0), cA + kstep, voffA); PG8_STAGE(PG8_SB(1, 1), cB + hstepB + kstep, voffB);
        PG8_WAIT_V(6); PG8_BAR;
    } else {
        PG8_STAGE(PG8_SB(0, 0), cB, voffB); PG8_STAGE(PG8_SA(0, 0), cA, voffA); PG8_STAGE(PG8_SB(0, 1), cB + hstepB, voffB); PG8_STAGE(PG8_SA(0, 1), cA + hstepA, voffA);
        if (wr == 1) PG8_BAR;
        PG8_WAIT_V(4); PG8_BAR;
        PG8_STAGE(PG8_SB(1, 0), cB + kstep, voffB); PG8_STAGE(PG8_SA(1, 0), cA + kstep, voffA); PG8_STAGE(PG8_SB(1, 1), cB + hstepB + kstep, voffB);
        PG8_WAIT_V(6); PG8_BAR;
    }
    for (;;) {
        const bool has_next = S.next(ui + 1, nxt);
        const char* nA = has_next ? (const char*)g.A + (size_t)nxt.pm * tstepA + (size_t)nxt.ks * ksplit : cA; const char* nB = has_next ? (const char*)g.Bt + (size_t)nxt.pn * tstepB + (size_t)nxt.ks * ksplit : cB;
#pragma nounroll
        for (int t = 0; t < nt; t += 2) {
            const bool last = (t == nt - 2);
            const char* a1 = cA + (size_t)(t + 1) * kstep;
            const char* a2 = last ? nA : cA + (size_t)(t + 2) * kstep; const char* b2 = last ? nB : cB + (size_t)(t + 2) * kstep;
            const char* a3 = a2 + kstep; const char* b3 = b2 + kstep;
            if constexpr (SP2) {
            PG8_LDB(B0, 0, 0); PG8_LDB(B1, 0, 1); PG8_SCHED; PG8_LDA(At, 0, 0); PG8_STAGE(PG8_SA(1, 1), a1 + hstepA, voffA);
            PG8_WAIT_V(8); PG8_WAIT_L(0); PG8_BAR; PG8_MMA(0, 0, At, B0); PG8_MMA(0, 1, At, B1); PG8_BAR; PG8_SCHED;
            PG8_LDA(At, 0, 1); PG8_STAGE(PG8_SB(0, 0), b2, voffB); PG8_STAGE(PG8_SB(0, 1), b2 + hstepB, voffB); PG8_STAGE(PG8_SA(0, 0), a2, voffA);
            PG8_WAIT_V(8); PG8_WAIT_L(0); PG8_BAR; PG8_MMA(1, 0, At, B0); PG8_MMA(1, 1, At, B1); PG8_BAR; PG8_SCHED;
            PG8_LDB(B0, 1, 0); PG8_LDB(B1, 1, 1); PG8_SCHED; PG8_LDA(At, 1, 0); PG8_STAGE(PG8_SA(0, 1), a2 + hstepA, voffA);
            PG8_WAIT_V(8); PG8_WAIT_L(0); PG8_BAR; PG8_MMA(0, 0, At, B0); PG8_MMA(0, 1, At, B1); PG8_BAR; PG8_SCHED;
            PG8_LDA(At, 1, 1); PG8_STAGE(PG8_SB(1, 0), b3, voffB); PG8_STAGE(PG8_SB(1, 1), b3 + hstepB, voffB); PG8_STAGE(PG8_SA(1, 0), a3, voffA);
            PG8_WAIT_V(8); PG8_WAIT_L(0); PG8_BAR; PG8_MMA(1, 0, At, B0); PG8_MMA(1, 1, At, B1); PG8_BAR; PG8_SCHED;
            } else {
            PG8_LDB(B0, 0, 0); PG8_SCHED; PG8_LDA(At, 0, 0); PG8_STAGE(PG8_SA(1, 1), a1 + hstepA, voffA);
            PG8_WAIT_L(8); PG8_BAR; PG8_WAIT_L(0); PG8_MMA(0, 0, At, B0); PG8_BAR; PG8_SCHED;
            PG8_LDB(B1, 0, 1); PG8_STAGE(PG8_SB(0, 0), b2, voffB);
            PG8_BAR; PG8_WAIT_L(0); PG8_MMA(0, 1, At, B1); PG8_BAR;
            PG8_LDA(At, 0, 1); PG8_STAGE(PG8_SA(0, 0), a2, voffA);
            PG8_BAR; PG8_WAIT_L(0); PG8_MMA(1, 0, At, B0); PG8_BAR; PG8_SCHED;
            PG8_STAGE(PG8_SB(0, 1), b2 + hstepB, voffB);
            PG8_WAIT_V(6); PG8_BAR; PG8_MMA(1, 1, At, B1); PG8_BAR;
            PG8_LDB(B0, 1, 0); PG8_SCHED; PG8_LDA(At, 1, 0); PG8_STAGE(PG8_SA(0, 1), a2 + hstepA, voffA);
            PG8_WAIT_L(8); PG8_BAR; PG8_WAIT_L(0); PG8_MMA(0, 0, At, B0); PG8_BAR; PG8_SCHED;
            PG8_LDB(B1, 1, 1); PG8_STAGE(PG8_SB(1, 0), b3, voffB);
            PG8_BAR; PG8_WAIT_L(0); PG8_MMA(0, 1, At, B1); PG8_BAR;
            PG8_LDA(At, 1, 1); PG8_STAGE(PG8_SA(1, 0), a3, voffA);
            PG8_BAR; PG8_WAIT_L(0); PG8_MMA(1, 0, At, B0); PG8_BAR; PG8_SCHED;
            PG8_STAGE(PG8_SB(1, 1), b3 + hstepB, voffB);
            PG8_WAIT_V(6); PG8_BAR; PG8_MMA(1, 1, At, B1); PG8_BAR;
            }
        }
        if constexpr (ALIGN_EPI) { if (wr == 0) PG8_BAR; }
        E(acc, cur, wr, wc, fr, fq);
        if (!has_next) break;
#pragma unroll
        for (int a = 0; a < 2; ++a)
#pragma unroll
            for (int b = 0; b < 2; ++b)
#pragma unroll
                for (int m = 0; m < 4; ++m)
#pragma unroll
                    for (int n = 0; n < 2; ++n) acc[a][b][m][n] = (f32x4){0.f, 0.f, 0.f, 0.f};
        cur = nxt; cA = nA; cB = nB; ++ui;
        if constexpr (ALIGN_EPI) { if (wr == 1) PG8_BAR; }
    }
    PG8_WAIT_V(0);
    if constexpr (!ALIGN_EPI) { if (wr == 0) PG8_BAR; }
    PG8_BAR;
#undef PG8_SA
#undef PG8_SB
#undef PG8_STAGE
#undef PG8_LDA
#undef PG8_LDB
#undef PG8_MMA
#undef PG8_WAIT_V
#undef PG8_WAIT_L
#undef PG8_BAR
#undef PG8_SCHED
}

__device__ __forceinline__ float rss_q(const float* rss, int row) { float s = 0.f;
#pragma unroll
    for (int p = 0; p < 12; ++p) s += rss[(size_t)p * MTOK + row]; return s; }
__device__ __forceinline__ float rss_kv(const float* rss, int row) { float s = 0.f;
#pragma unroll
    for (int p = 12; p < 20; ++p) s += rss[(size_t)p * MTOK + row]; return s; }
#define EPI_ROWS_BEGIN _Pragma("unroll") for (int ai = 0; ai < 2; ++ai) _Pragma("unroll") for (int m = 0; m < 4; ++m) { const int row = u.pm * BM + wr * 64 + fr + ai * HALF + m * 16;
#define EPI_ROWS_END asm volatile("" ::: "memory"); }

struct EpiZ {
    static constexpr bool PERM = true;
    bf16_t* Z; float* rssq; float* rsskv;
    __device__ __forceinline__ void operator()(const f32x4 (&acc)[2][2][4][2], const Unit& u, int wr, int wc, int fr_, int fq_) const {
        int lane_e = (int)threadIdx.x & 63; asm volatile("" : "+v"(lane_e)); const int fr = lane_e & 15, fq = lane_e >> 4;
        const int col0 = u.pn * BM + wc * 32 + 8 * fq;
        EPI_ROWS_BEGIN
            bf16_t* rowp = Z + (size_t)row * ZP + col0;
#pragma unroll
            for (int bj = 0; bj < 2; ++bj) { const f32x4 v0 = acc[ai][bj][m][0], v1 = acc[ai][bj][m][1];
                u32x4 w; w.x = cvt_pk_bf16(v0[0], v0[1]); w.y = cvt_pk_bf16(v0[2], v0[3]); w.z = cvt_pk_bf16(v1[0], v1[1]); w.w = cvt_pk_bf16(v1[2], v1[3]);
                *(u32x4*)(rowp + bj * HALF) = w;
                const int hc = 2 * u.pn + bj;
                if (hc < 5) { float s = (v0[0] * v0[0] + v0[1] * v0[1]) + (v0[2] * v0[2] + v0[3] * v0[3]) + (v1[0] * v1[0] + v1[1] * v1[1]) + (v1[2] * v1[2] + v1[3] * v1[3]);
                    s += __shfl_xor(s, 16); s += __shfl_xor(s, 32);
                    if (fq == 0) rssq[(size_t)(hc * 4 + wc) * MTOK + row] = s; } }
        EPI_ROWS_END
    }
};

struct EpiQ {
    static constexpr bool PERM = true;
    bf16_t* Q; const float* rssq;
    __device__ __forceinline__ void operator()(const f32x4 (&acc)[2][2][4][2], const Unit& u, int wr, int wc, int fr_, int fq_) const {
        int lane_e = (int)threadIdx.x & 63; asm volatile("" : "+v"(lane_e)); const int fr = lane_e & 15, fq = lane_e >> 4;
        const int col0 = u.pn * BM + wc * 32 + 8 * fq;
        const float inv[8] = {1.f, 0.316227766f, 0.1f, 0.0316227766f, 0.01f, 0.00316227766f, 0.001f, 0.000316227766f};
        EPI_ROWS_BEGIN
            const float rs = rsqrtf(rss_q(rssq, row) * (1.f / 384.f) + EPS) * QSCALE;
            const int t = (row - MP) & 2047;
#pragma unroll
            for (int bj = 0; bj < 2; ++bj) { const int c = col0 + bj * HALF; const int j0 = c % 96;
                const bool rp = (row >= MP && j0 >= 64);
                const float pos = (float)((j0 < 80) ? (t >> 6) : (t & 63)) * 0.15915494309189535f;
                const float sg = (j0 & 8) ? 1.f : -1.f;
#pragma unroll
                for (int n = 0; n < 2; ++n) {
                    f32x4 v = acc[ai][bj][m][n] * rs;
#pragma unroll
                    for (int i = 0; i < 4; ++i) { const float p = __shfl_xor(v[i], 16);
                        const float rev = pos * inv[4 * n + i]; const float rf = rev - floorf(rev);
                        const float cs = __builtin_amdgcn_cosf(rf), sn = __builtin_amdgcn_sinf(rf); v[i] = rp ? v[i] * cs + sg * p * sn : v[i]; }
                    u32x2 w; w.x = cvt_pk_bf16(v[0], v[1]); w.y = cvt_pk_bf16(v[2], v[3]);
                    *(u32x2*)(Q + (size_t)row * 768 + c + 4 * n) = w; } }
        EPI_ROWS_END
    }
};

struct EpiK {
    static constexpr bool PERM = true;
    bf16_t* Kp; bf16_t* Ks; const float* rsskv; int ctx;
    __device__ __forceinline__ void operator()(const f32x4 (&acc)[2][2][4][2], const Unit& u, int wr, int wc, int fr_, int fq_) const {
        int lane_e = (int)threadIdx.x & 63; asm volatile("" : "+v"(lane_e)); const int fr = lane_e & 15, fq = lane_e >> 4;
        EPI_ROWS_BEGIN
            float rs = 1.f; unsigned off; bool smp;
            if (ctx) { off = ((unsigned)(row >> 8) * 8u * SKS + (row & 255)) * 96u; smp = true; }
            else { rs = rsqrtf(rss_kv(rsskv, row) * (1.f / 256.f) + EPS);
                if (row < MP) { off = ((unsigned)(row >> 8) * 8u * 256u + (row & 255)) * 96u; smp = false; } else { off = ((unsigned)((row - MP) >> 11) * 8u * SKS + 256u + ((row - MP) & 2047)) * 96u; smp = true; } }
            bf16_t* base = smp ? Ks : Kp; const unsigned hs = (smp ? SKS : 256) * 96u;
#pragma unroll
            for (int bj = 0; bj < 2; ++bj) { const unsigned h = 4 * u.pn + 2 * bj + (wc >> 1); const unsigned j = (wc & 1) * 32 + 8 * fq;
                const f32x4 v0 = acc[ai][bj][m][0] * rs, v1 = acc[ai][bj][m][1] * rs;
                u32x4 w; w.x = cvt_pk_bf16(v0[0], v0[1]); w.y = cvt_pk_bf16(v0[2], v0[3]); w.z = cvt_pk_bf16(v1[0], v1[1]); w.w = cvt_pk_bf16(v1[2], v1[3]);
                *(u32x4*)(base + (off + h * hs + j)) = w; }
        EPI_ROWS_END
    }
};

struct EpiVt {
    static constexpr bool PERM = true;
    bf16_t* Vtp; bf16_t* Vts; const float* rsskv; int ctx;
    __device__ __forceinline__ void operator()(const f32x4 (&acc)[2][2][4][2], const Unit& u, int wr, int wc, int fr_, int fq_) const {
        int lane_e = (int)threadIdx.x & 63; asm volatile("" : "+v"(lane_e)); const int fr = lane_e & 15, fq = lane_e >> 4;
#pragma unroll
        for (int bj = 0; bj < 2; ++bj) {
            const int tok = u.pn * BM + bj * HALF + wc * 32 + 8 * fq;
            f32x4 r0 = {1.f, 1.f, 1.f, 1.f}, r1 = {1.f, 1.f, 1.f, 1.f}; unsigned off; bool smp; unsigned S;
            if (ctx) { off = (unsigned)(tok >> 8) * 8u * 64u * SKS + (tok & 255); smp = true; S = SKS; }
            else { f32x4 q0 = {0.f, 0.f, 0.f, 0.f}, q1 = {0.f, 0.f, 0.f, 0.f};
#pragma unroll
                for (int p = 12; p < 20; ++p) { q0 += *(const f32x4*)(rsskv + (size_t)p * MTOK + tok); q1 += *(const f32x4*)(rsskv + (size_t)p * MTOK + tok + 4); }
#pragma unroll
                for (int i = 0; i < 4; ++i) { r0[i] = rsqrtf(q0[i] * (1.f / 256.f) + EPS); r1[i] = rsqrtf(q1[i] * (1.f / 256.f) + EPS); }
                if (tok < MP) { off = (unsigned)(tok >> 8) * 8u * 64u * 256u + (tok & 255); smp = false; S = 256; } else { off = (unsigned)((tok - MP) >> 11) * 8u * 64u * SKS + 256u + ((tok - MP) & 2047); smp = true; S = SKS; } }
            bf16_t* base = smp ? Vts : Vtp;
#pragma unroll
            for (int ai = 0; ai < 2; ++ai)
#pragma unroll
                for (int m = 0; m < 4; ++m) { const unsigned hd = u.pm * BM + wr * 64 + fr + ai * HALF + m * 16;
                    const f32x4 v0 = acc[ai][bj][m][0] * r0, v1 = acc[ai][bj][m][1] * r1;
                    u32x4 w; w.x = cvt_pk_bf16(v0[0], v0[1]); w.y = cvt_pk_bf16(v0[2], v0[3]); w.z = cvt_pk_bf16(v1[0], v1[1]); w.w = cvt_pk_bf16(v1[2], v1[3]);
                    *(u32x4*)(base + (off + hd * S)) = w; }
            asm volatile("" ::: "memory");
        }
    }
};

struct EpiPart {
    static constexpr bool PERM = true;
    float* P0; float* P1;
    __device__ __forceinline__ void operator()(const f32x4 (&acc)[2][2][4][2], const Unit& u, int wr, int wc, int fr_, int fq_) const {
        int lane_e = (int)threadIdx.x & 63; asm volatile("" : "+v"(lane_e)); const int fr = lane_e & 15, fq = lane_e >> 4;
        const int col0 = u.pn * BM + wc * 32 + 8 * fq; float* P = u.ks ? P1 : P0;
        EPI_ROWS_BEGIN
            float* rowp = P + (size_t)row * D + col0;
#pragma unroll
            for (int bj = 0; bj < 2; ++bj) { *(f32x4*)(rowp + bj * HALF) = acc[ai][bj][m][0]; *(f32x4*)(rowp + bj * HALF + 4) = acc[ai][bj][m][1]; }
        EPI_ROWS_END
    }
};

struct EpiFFI {
    static constexpr bool PERM = true;
    bf16_t* H;
    __device__ __forceinline__ void operator()(const f32x4 (&acc)[2][2][4][2], const Unit& u, int wr, int wc, int fr_, int fq_) const {
        int lane_e = (int)threadIdx.x & 63; asm volatile("" : "+v"(lane_e)); const int fr = lane_e & 15, fq = lane_e >> 4;
        const int col0 = u.pn * HALF + wc * 32 + 8 * fq;
        EPI_ROWS_BEGIN
            float o[8];
#pragma unroll
            for (int i = 0; i < 4; ++i) { o[i] = silu_f(acc[ai][0][m][0][i]) * acc[ai][1][m][0][i]; o[4 + i] = silu_f(acc[ai][0][m][1][i]) * acc[ai][1][m][1][i]; }
            u32x4 w; w.x = cvt_pk_bf16(o[0], o[1]); w.y = cvt_pk_bf16(o[2], o[3]); w.z = cvt_pk_bf16(o[4], o[5]); w.w = cvt_pk_bf16(o[6], o[7]);
            *(u32x4*)(H + (size_t)row * DFF + col0) = w;
        EPI_ROWS_END
    }
};
}

struct Args { const float* in[26]; float* out; unsigned char* ws; int ph_lo, ph_hi; };
enum { I_XP = 0, I_XS, I_CKV, I_CKR, I_SF, I_SB, I_C, I_CCTX, I_WADA, I_BADA, I_NATT, I_WIN, I_QN, I_WUQ, I_KVN, I_WUKV, I_WGF, I_BGF, I_WGB, I_BGB, I_GLAN, I_WOUT, I_NFFN, I_WFFI, I_WFFO, I_FN };

__device__ __forceinline__ const float* xrow_ptr(const Args& a, int r) { return r < MP ? a.in[I_XP] + (size_t)r * D : a.in[I_XS] + (size_t)(r - MP) * D; }
__device__ __forceinline__ int cond_of_row(int r) { return r < MP ? 0 : 1 + ((r - MP) >> 11); }

__device__ __forceinline__ void p0_tr(const float* W, int K, int N, bf16_t* WT, bf16_t* WT2, const float* kscale, int kb, int nb, int drow, LAS float* scr, int lane) {
    const int k0 = 64 * kb, n0 = 32 * nb;
#pragma unroll 8
    for (int i = 0; i < 32; ++i) { const int kk = 2 * i + (lane >> 5); scr[kk * 33 + (lane & 31)] = W[(size_t)(k0 + kk) * N + n0 + (lane & 31)]; }
    LDS_WAIT();
    const int c = lane & 7;
    float sc[8];
#pragma unroll
    for (int i = 0; i < 8; ++i) sc[i] = kscale ? kscale[k0 + 8 * c + i] : 1.f;
#pragma unroll
    for (int j = 0; j < 4; ++j) { const int n = (lane >> 3) + 8 * j; const LAS float* s = scr + (8 * c) * 33 + n;
        float v[8];
#pragma unroll
        for (int i = 0; i < 8; ++i) v[i] = s[i * 33];
        if (WT2) { u32x4 o; o.x = cvt_pk_bf16(v[0], v[1]); o.y = cvt_pk_bf16(v[2], v[3]); o.z = cvt_pk_bf16(v[4], v[5]); o.w = cvt_pk_bf16(v[6], v[7]);
            *(u32x4*)(WT2 + (size_t)(drow + n0 + n) * K + k0 + 8 * c) = o; }
        u32x4 o; o.x = cvt_pk_bf16(v[0] * sc[0], v[1] * sc[1]); o.y = cvt_pk_bf16(v[2] * sc[2], v[3] * sc[3]); o.z = cvt_pk_bf16(v[4] * sc[4], v[5] * sc[5]); o.w = cvt_pk_bf16(v[6] * sc[6], v[7] * sc[7]);
        *(u32x4*)(WT + (size_t)(drow + n0 + n) * K + k0 + 8 * c) = o; }
    LDS_WAIT();
}

__device__ __forceinline__ void phase0(const Args& a, int wv, LAS unsigned char* lds, int vcu, int G) {
    const int tid = otid(wv), lane = tid & 63, wave = __builtin_amdgcn_readfirstlane(tid >> 6);
    unsigned char* ws = a.ws;
#ifndef P0MASK
#define P0MASK 7
#endif
    if (P0MASK & 2) {
        LAS float* scr = (LAS float*)(lds + wave * 16384);
        const int gw = vcu * 8 + wave, NGW = G * 8;
        constexpr int T_IN = 16 * 70, T_UQ = 6 * 24, T_UKV = 4 * 32, T_OUT = 16 * 32, T_FFI = 16 * 176, T_FFO = 44 * 32, T_ZERO = 64, T_ADA = 192;
        constexpr int NIT = T_ADA + T_IN + T_UQ + T_UKV + T_OUT + T_FFI + T_FFO + T_ZERO;
        for (int it = gw; it < NIT; it += NGW) {
            int r = it;
            if (r < T_ADA) {
                const int n0 = 32 * r; const float* W = a.in[I_WADA];
                const int n = lane & 31, hf = lane >> 5; float s0 = 0.f, s1 = 0.f, s2 = 0.f;
                for (int kb = 0; kb < 16; ++kb) { const int k0 = 64 * kb;
#pragma unroll 8
                    for (int i = 0; i < 32; ++i) { const int kk = 2 * i + (lane >> 5); scr[kk * 33 + (lane & 31)] = W[(size_t)(k0 + kk) * 6144 + n0 + (lane & 31)]; }
                    LDS_WAIT();
                    for (int j = 0; j < 32; ++j) { const int kk = hf * 32 + j; const float w = scr[kk * 33 + n];
                        s0 += w * silu_f(a.in[I_CCTX][k0 + kk]); s1 += w * silu_f(a.in[I_C][k0 + kk]); s2 += w * silu_f(a.in[I_C][1024 + k0 + kk]); }
                    LDS_WAIT(); }
                s0 += __shfl_xor(s0, 32); s1 += __shfl_xor(s1, 32); s2 += __shfl_xor(s2, 32);
                const float bv = a.in[I_BADA][n0 + n];
                float* MOD = (float*)(ws + WS_MOD);
                if (hf == 0) { MOD[n0 + n] = s0 + bv; MOD[6144 + n0 + n] = s1 + bv; MOD[12288 + n0 + n] = s2 + bv; }
                continue; } r -= T_ADA;
            if (r < T_FFI) { const int kb = r / 176, nb = r % 176; const int n0 = nb * 32; const int drow = n0 < DFF ? (n0 / 128) * 256 + (n0 % 128) : ((n0 - DFF) / 128) * 256 + 128 + ((n0 - DFF) % 128);
                p0_tr(a.in[I_WFFI], 1024, 5632, (bf16_t*)(ws + WS_WFFI), nullptr, nullptr, kb, nb, drow - n0, scr, lane); continue; } r -= T_FFI;
            if (r < T_FFO) { p0_tr(a.in[I_WFFO], DFF, 1024, (bf16_t*)(ws + WS_WFFO), nullptr, nullptr, r / 32, r % 32, 0, scr, lane); continue; } r -= T_FFO;
            if (r < T_IN) { p0_tr(a.in[I_WIN], 1024, 2240, (bf16_t*)(ws + WS_WIN), nullptr, nullptr, r / 70, r % 70, 0, scr, lane); continue; } r -= T_IN;
            if (r < T_OUT) { p0_tr(a.in[I_WOUT], 1024, 1024, (bf16_t*)(ws + WS_WOUT), nullptr, nullptr, r / 32, r % 32, 0, scr, lane); continue; } r -= T_OUT;
            if (r < T_UQ) { p0_tr(a.in[I_WUQ], 384, 768, (bf16_t*)(ws + WS_WUQ), nullptr, a.in[I_QN], r / 24, r % 24, 0, scr, lane); continue; } r -= T_UQ;
            if (r < T_UKV) { const int nb = r % 32, n0 = nb * 32, hh = n0 >> 7, j0 = n0 & 127; const bool isv = j0 >= 64; const int drow = hh * 64 + (j0 & 63);
                p0_tr(a.in[I_WUKV], 256, 1024, (bf16_t*)(ws + (isv ? WS_WVF : WS_WKF)), (bf16_t*)(ws + (isv ? WS_WVU : WS_WKU)), a.in[I_KVN], r / 32, nb, drow - n0, scr, lane); continue; } r -= T_UKV;
            { u32x4 z = {0u, 0u, 0u, 0u}; u32x4* p = (u32x4*)((bf16_t*)(ws + WS_WIN) + (size_t)(2240 + r) * 1024); p[lane] = z; p[64 + lane] = z; }
        }
    }
    if (P0MASK & 4) {
        const int gt = vcu * 512 + tid, NT = G * 512;
        for (int i = gt; i < 32768; i += NT) { const f32x4 v = ((const f32x4*)a.in[I_CKV])[i]; u32x2 w; w.x = cvt_pk_bf16(v[0], v[1]); w.y = cvt_pk_bf16(v[2], v[3]); ((u32x2*)(ws + WS_CACHEB))[i] = w; }
    }
}

__device__ __forceinline__ void phase1(const Args& a, int wv, int vcu, int G) {
    if (PROBE_FILL == 3) { float* m = (float*)(a.ws + WS_MOD); for (int i = otid(wv); i < 3 * 6144; i += 512) { unsigned h = (unsigned)i * 2654435761u; h ^= h >> 15; h *= 2246822519u; h ^= h >> 13; m[i] = ((float)(h & 0xffff) * (1.f / 65536.f) - 0.5f) * 2.f; } __syncthreads(); }
    const int tid_ = otid(wv); const int lane = tid_ & 63, wave = tid_ >> 6; const int gw = vcu * 8 + wave, NGW = G * 8;
    const float* mod = (const float*)(a.ws + WS_MOD + PROBE_MODOFF); bf16_t* H = (bf16_t*)(a.ws + WS_H);
    for (int r = gw; r < MTOK; r += NGW * PROBE_RSTRIDE) {
        const f32x4* xr = (const f32x4*)xrow_ptr(a, r) + lane; const float* md = mod + cond_of_row(r) * 6144;
        f32x4 v[4]; float s = 0.f;
#pragma unroll
        for (int j = 0; j < 4; ++j) { v[j] = xr[64 * j]; s += (v[j][0] * v[j][0] + v[j][1] * v[j][1]) + (v[j][2] * v[j][2] + v[j][3] * v[j][3]); }
        const float rstd = rsqrtf(wave_sum(s) * (1.f / D) + EPS);
        u32x2* o = (u32x2*)(H + (size_t)r * D) + lane;
#pragma unroll
        for (int j = 0; j < 4; ++j) { const int c = 4 * lane + 256 * j; const f32x4 w = *(const f32x4*)(a.in[I_NATT] + c), sh = *(const f32x4*)(md + c), scv = *(const f32x4*)(md + 1024 + c);
            const f32x4 y = v[j] * rstd * w * (scv * PROBE_MUL + 1.f) + sh * PROBE_MUL; u32x2 p; p.x = cvt_pk_bf16(y[0], y[1]); p.y = cvt_pk_bf16(y[2], y[3]); if (PROBE_NOSTORE) { if ((p.x ^ p.y) == 0x12345u) o[64 * j] = p; } else o[64 * j] = p; }
    }
}
__device__ __forceinline__ void phase6(const Args& a, int wv, int vcu, int G) {
    const int tid_ = otid(wv); const int lane = tid_ & 63, wave = tid_ >> 6; const int gw = vcu * 8 + wave, NGW = G * 8;
    const float* mod = (const float*)(a.ws + WS_MOD); bf16_t* H = (bf16_t*)(a.ws + WS_H); float* X1 = (float*)(a.ws + WS_X1);
    const float* P0 = (const float*)(a.ws + WS_P0); const float* P1 = (const float*)(a.ws + WS_P1A);
    for (int r = gw; r < MTOK; r += NGW) {
        const f32x4* xr = (const f32x4*)xrow_ptr(a, r) + lane; const float* md = mod + cond_of_row(r) * 6144;
        const f32x4* p0 = (const f32x4*)(P0 + (size_t)r * D) + lane; const f32x4* p1 = (const f32x4*)(P1 + (size_t)r * D) + lane;
        f32x4 v[4]; float s = 0.f;
#pragma unroll
        for (int j = 0; j < 4; ++j) { const int c = 4 * lane + 256 * j; const f32x4 gt = *(const f32x4*)(md + 2048 + c);
            v[j] = xr[64 * j] + gt * (p0[64 * j] + p1[64 * j]); s += (v[j][0] * v[j][0] + v[j][1] * v[j][1]) + (v[j][2] * v[j][2] + v[j][3] * v[j][3]); }
        const float rstd = rsqrtf(wave_sum(s) * (1.f / D) + EPS);
        f32x4* x1 = (f32x4*)(X1 + (size_t)r * D) + lane; u32x2* o = (u32x2*)(H + (size_t)r * D) + lane;
#pragma unroll
        for (int j = 0; j < 4; ++j) { const int c = 4 * lane + 256 * j; x1[64 * j] = v[j];
            const f32x4 w = *(const f32x4*)(a.in[I_NFFN] + c), sh = *(const f32x4*)(md + 3072 + c), scv = *(const f32x4*)(md + 4096 + c);
            const f32x4 y = v[j] * rstd * w * (scv + 1.f) + sh; u32x2 p; p.x = cvt_pk_bf16(y[0], y[1]); p.y = cvt_pk_bf16(y[2], y[3]); o[64 * j] = p; }
    }
}
__device__ __forceinline__ void phase9(const Args& a, int wv, int vcu, int G) {
    const int tid_ = otid(wv); const int lane = tid_ & 63, wave = tid_ >> 6; const int gw = vcu * 8 + wave, NGW = G * 8;
    const float* mod = (const float*)(a.ws + WS_MOD); const float* X1 = (const float*)(a.ws + WS_X1);
    const float* P0 = (const float*)(a.ws + WS_P0); const float* P1 = (const float*)(a.ws + WS_P1B);
    for (int r = gw; r < MTOK; r += NGW) {
        const f32x4* xr = (const f32x4*)(X1 + (size_t)r * D) + lane; const float* md = mod + cond_of_row(r) * 6144;
        const f32x4* p0 = (const f32x4*)(P0 + (size_t)r * D) + lane; const f32x4* p1 = (const f32x4*)(P1 + (size_t)r * D) + lane;
        f32x4 v[4]; float s = 0.f;
#pragma unroll
        for (int j = 0; j < 4; ++j) { const int c = 4 * lane + 256 * j; const f32x4 gt = *(const f32x4*)(md + 5120 + c);
            v[j] = xr[64 * j] + gt * (p0[64 * j] + p1[64 * j]); s += (v[j][0] * v[j][0] + v[j][1] * v[j][1]) + (v[j][2] * v[j][2] + v[j][3] * v[j][3]); }
        const float rstd = rsqrtf(wave_sum(s) * (1.f / D) + EPS);
        f32x4* y = (f32x4*)(a.out + O_Y + (size_t)r * D) + lane;
#pragma unroll
        for (int j = 0; j < 4; ++j) { const int c = 4 * lane + 256 * j; const f32x4 w = *(const f32x4*)(a.in[I_FN] + c); y[64 * j] = v[j] * rstd * w; }
    }
}

__device__ __forceinline__ void p3_row_extras(const Args& a, int wv, int gw, int NGW) {
    const int lane = otid(wv) & 63;
    const bf16_t* Z = (const bf16_t*)(a.ws + WS_Z); const float* rsskv = (const float*)(a.ws + WS_RSSKV);
    bf16_t* Kp = (bf16_t*)(a.ws + WS_KP); bf16_t* Ks = (bf16_t*)(a.ws + WS_KS);
    const float inv[8] = {1.f, 0.316227766f, 0.1f, 0.0316227766f, 0.01f, 0.00316227766f, 0.001f, 0.000316227766f};
    for (int r = gw; r < MTOK + 512; r += NGW) {
        if (r < MTOK) {
            const bf16_t* zr = Z + (size_t)r * ZP;
            if (r < MP) {
                const float rs = rsqrtf(pg8::rss_kv(rsskv, r) * (1.f / 256.f) + EPS);
                const u32x2 w = *(const u32x2*)(zr + C_KVLAT + 4 * lane); const f32x4 g = *(const f32x4*)(a.in[I_KVN] + 4 * lane);
                f32x4 o; o[0] = bflo(w.x) * rs * g[0]; o[1] = bfhi(w.x) * rs * g[1]; o[2] = bflo(w.y) * rs * g[2]; o[3] = bfhi(w.y) * rs * g[3];
                *(f32x4*)(a.out + O_KV + (size_t)r * 256 + 4 * lane) = o;
            }
            const int i = lane & 31;
            float v = bf2f(zr[C_KROPE + i]);
            if (r < MP && lane < 32) a.out[O_KR + (size_t)r * 32 + i] = v;
            const float pv = __shfl_xor(v, 8);
            int b, s; bf16_t* kb;
            if (r >= MP) { const int t = (r - MP) & 2047; const float pos = (float)((i < 16) ? (t >> 6) : (t & 63));
                const float rev = pos * inv[i & 7] * 0.15915494309189535f; const float rf = rev - floorf(rev);
                const float cs = __builtin_amdgcn_cosf(rf), sn = __builtin_amdgcn_sinf(rf); v = v * cs + ((i & 8) ? pv : -pv) * sn;
                b = (r - MP) >> 11; s = 256 + t; kb = Ks + ((size_t)(b * 8) * SKS + s) * 96 + 64 + i;
                const bf16_t o = f2bf(v);
                if (lane < 32) { for (int h = 0; h < 8; ++h) kb[(size_t)h * SKS * 96] = o; }
            } else { b = r >> 8; s = r & 255; kb = Kp + ((size_t)(b * 8) * 256 + s) * 96 + 64 + i; const bf16_t o = f2bf(v);
                if (lane < 32) { for (int h = 0; h < 8; ++h) kb[(size_t)h * 256 * 96] = o; } }
        } else {
            const int rr = r - MTOK, b = rr >> 8, s = rr & 255, i = lane & 31;
            const bf16_t o = f2bf(a.in[I_CKR][(size_t)rr * 32 + i]); bf16_t* kb = Ks + ((size_t)(b * 8) * SKS + s) * 96 + 64 + i;
            if (lane < 32) { for (int h = 0; h < 8; ++h) kb[(size_t)h * SKS * 96] = o; }
        }
    }
}

constexpr int GL_LOW = 0, GL_WG = 8192, GL_BG = 16384, GL_SEG = 16896, GL_RED = 20992, GL_VT = 22528, GL_QF = 40960, GL_KF = GL_QF + 9216, GL_QB = GL_KF + 9216, GL_KB = GL_QB + 9216;
constexpr int GROW = 144;

__device__ __forceinline__ void gla_gates(const Args& a, int wv, LAS unsigned char* lds, int r0, int h, float (&cumF)[8], float (&cumB)[8], float& totF, float& totB) {
    const int tid = otid(wv), d = tid & 63, tg = tid >> 6;
    const bf16_t* Z = (const bf16_t*)(a.ws + WS_Z);
    LAS float* low = (LAS float*)(lds + GL_LOW); LAS float* wg = (LAS float*)(lds + GL_WG); LAS float* bg = (LAS float*)(lds + GL_BG); LAS float* seg = (LAS float*)(lds + GL_SEG);
    { const int t = tid >> 3, r4 = (tid & 7) * 4; const u32x2 w = *(const u32x2*)(Z + (size_t)(r0 + t) * ZP + C_GFL + r4);
      low[t * 32 + r4] = bflo(w.x); low[t * 32 + r4 + 1] = bfhi(w.x); low[t * 32 + r4 + 2] = bflo(w.y); low[t * 32 + r4 + 3] = bfhi(w.y); }
    { const int dir = tid >> 8, r = (tid >> 4) & 15, d4 = (tid & 15) * 4; const f32x4 w = *(const f32x4*)(a.in[dir ? I_WGB : I_WGF] + r * 256 + h * 64 + d4);
      *(LAS f32x4*)(wg + (dir * 16 + r) * 64 + d4) = w; }
    if (tid < 128) { const int dir = tid >> 6; bg[tid] = a.in[dir ? I_BGB : I_BGF][h * 64 + (tid & 63)]; }
    __syncthreads();
    float wf[16], wb[16];
#pragma unroll
    for (int r = 0; r < 16; ++r) { wf[r] = wg[r * 64 + d]; wb[r] = wg[(16 + r) * 64 + d]; }
    const float bf_ = bg[d], bb_ = bg[64 + d];
    float gf[8], gb[8];
#pragma unroll
    for (int i = 0; i < 8; ++i) { const int t = tg * 8 + i; float xf = bf_, xb = bb_;
#pragma unroll
        for (int r = 0; r < 16; ++r) { xf += low[t * 32 + r] * wf[r]; xb += low[t * 32 + 16 + r] * wb[r]; }
        gf[i] = logsigmoid_f(xf) * (1.f / 16.f); gb[i] = logsigmoid_f(xb) * (1.f / 16.f); }
#pragma unroll
    for (int i = 1; i < 8; ++i) gf[i] += gf[i - 1];
#pragma unroll
    for (int i = 6; i >= 0; --i) gb[i] += gb[i + 1];
    seg[tg * 64 + d] = gf[7]; seg[512 + tg * 64 + d] = gb[0];
    __syncthreads();
    float offF = 0.f, offB = 0.f; totF = 0.f; totB = 0.f;
#pragma unroll
    for (int g = 0; g < 8; ++g) { const float sf = seg[g * 64 + d], sb = seg[512 + g * 64 + d]; totF += sf; totB += sb; if (g < tg) offF += sf; if (g > tg) offB += sb; }
#pragma unroll
    for (int i = 0; i < 8; ++i) { cumF[i] = gf[i] + offF; cumB[i] = gb[i] + offB; }
}
__device__ __forceinline__ void gla_load_vT(const Args& a, int wv, LAS unsigned char* lds, int r0, int h) {
    const int tid = otid(wv), e = tid & 127, tq = tid >> 7;
    const bf16_t* Z = (const bf16_t*)(a.ws + WS_Z) + (size_t)r0 * ZP + C_GV + h * 128 + e;
    unsigned w[8];
#pragma unroll
    for (int i = 0; i < 8; ++i) { const unsigned lo = Z[(size_t)(tq * 16 + 2 * i) * ZP], hi = Z[(size_t)(tq * 16 + 2 * i + 1) * ZP]; w[i] = lo | (hi << 16); }
    LAS u32x4* p = (LAS u32x4*)(lds + GL_VT + e * GROW + tq * 32);
    p[0] = (u32x4){w[0], w[1], w[2], w[3]}; p[1] = (u32x4){w[4], w[5], w[6], w[7]};
}

__device__ __forceinline__ void gla_stepA(const Args& a, int wv, LAS unsigned char* lds, int u) {
    const int tid = otid(wv), lane = tid & 63, wave = __builtin_amdgcn_readfirstlane(tid >> 6), d = tid & 63, tg = tid >> 6, fr = lane & 15, fq = lane >> 4;
    const int cgi = u >> 2, h = u & 3, r0 = cgi * 64;
    const bf16_t* Z = (const bf16_t*)(a.ws + WS_Z);
    float cumF[8], cumB[8], totF, totB;
    gla_gates(a, wv, lds, r0, h, cumF, cumB, totF, totB);
    unsigned kf[4], kb[4];
#pragma unroll
    for (int i = 0; i < 4; ++i) { const float k0 = bf2f(Z[(size_t)(r0 + tg * 8 + 2 * i) * ZP + C_GK + h * 64 + d]), k1 = bf2f(Z[(size_t)(r0 + tg * 8 + 2 * i + 1) * ZP + C_GK + h * 64 + d]);
        kf[i] = cvt_pk_bf16(k0 * __expf(totF - cumF[2 * i]), k1 * __expf(totF - cumF[2 * i + 1]));
        kb[i] = cvt_pk_bf16(k0 * __expf(totB - cumB[2 * i]), k1 * __expf(totB - cumB[2 * i + 1])); }
    *(LAS u32x4*)(lds + GL_QF + d * GROW + tg * 16) = (u32x4){kf[0], kf[1], kf[2], kf[3]};
    *(LAS u32x4*)(lds + GL_KF + d * GROW + tg * 16) = (u32x4){kb[0], kb[1], kb[2], kb[3]};
    gla_load_vT(a, wv, lds, r0, h);
    if (tg == 0) { float* dec = (float*)(a.ws + WS_DEC) + (size_t)u * 128; dec[d] = __expf(totF); dec[64 + d] = __expf(totB); }
    __syncthreads();
    const int dir = wave >> 2, eb0 = 2 * (wave & 3);
    const LAS unsigned char* kd = lds + (dir ? GL_KF : GL_QF);
    float* CT = (float*)(a.ws + WS_CT) + ((size_t)u * 2 + dir) * 8192;
#pragma unroll
    for (int eb = 0; eb < 2; ++eb) {
        bf16x8 vf[2];
#pragma unroll
        for (int ks = 0; ks < 2; ++ks) vf[ks] = *(const LAS bf16x8*)(lds + GL_VT + (16 * (eb0 + eb) + fr) * GROW + (32 * ks + 8 * fq) * 2);
#pragma unroll
        for (int db = 0; db < 4; ++db) { f32x4 c = {0.f, 0.f, 0.f, 0.f};
#pragma unroll
            for (int ks = 0; ks < 2; ++ks) { const bf16x8 kfr = *(const LAS bf16x8*)(kd + (16 * db + fr) * GROW + (32 * ks + 8 * fq) * 2); c = __builtin_amdgcn_mfma_f32_16x16x32_bf16(vf[ks], kfr, c, 0, 0, 0); }
#pragma unroll
            for (int j = 0; j < 4; ++j) CT[(16 * (eb0 + eb) + 4 * fq + j) * 64 + 16 * db + fr] = c[j]; }
    }
    __syncthreads();
}

__device__ __forceinline__ void gla_scan(const Args& a, int wv, int vcu, int G) {
    const int gt = vcu * 512 + otid(wv), NT = G * 512;
    float* CTb = (float*)(a.ws + WS_CT); const float* DEC = (const float*)(a.ws + WS_DEC);
    for (int it = gt; it < 32768 + 262144; it += NT) {
        int seq, N, cg0, x;
        if (it < 32768) { seq = 16 + (it >> 14); x = it & 16383; N = 32; cg0 = 64 + 32 * (seq - 16); } else { const int j = it - 32768; seq = j >> 14; x = j & 16383; N = 4; cg0 = 4 * seq; }
        const int h = x >> 12, dir = (x >> 11) & 1, e = (x >> 4) & 127, d4 = (x & 15) * 4;
        f32x4 st = {0.f, 0.f, 0.f, 0.f};
        if (seq >= 16) { const float* s0 = a.in[dir ? I_SB : I_SF] + ((size_t)((seq - 16) * 4 + h) * 64) * 128 + e;
#pragma unroll
            for (int i = 0; i < 4; ++i) st[i] = s0[(size_t)(d4 + i) * 128]; }
        for (int n0 = 0; n0 < N; n0 += 4) {
            f32x4 c[4], dc[4];
#pragma unroll
            for (int i = 0; i < 4; ++i) { const int n = dir ? (N - 1 - n0 - i) : (n0 + i); const int u = (cg0 + n) * 4 + h;
                c[i] = *(const f32x4*)(CTb + ((size_t)u * 2 + dir) * 8192 + e * 64 + d4); dc[i] = *(const f32x4*)(DEC + (size_t)u * 128 + dir * 64 + d4); }
#pragma unroll
            for (int i = 0; i < 4; ++i) { const int n = dir ? (N - 1 - n0 - i) : (n0 + i); const int u = (cg0 + n) * 4 + h;
                *(f32x4*)(CTb + ((size_t)u * 2 + dir) * 8192 + e * 64 + d4) = st; st = dc[i] * st + c[i]; }
        }
        if (seq < 16) { float* o = a.out + (dir ? O_SB : O_SF) + ((size_t)(seq * 4 + h) * 64) * 128 + e;
#pragma unroll
            for (int i = 0; i < 4; ++i) o[(size_t)(d4 + i) * 128] = st[i]; }
    }
}

__device__ __forceinline__ void gla_stepC(const Args& a, int wv, LAS unsigned char* lds, int u) {
    const int tid = otid(wv), lane = tid & 63, wave = __builtin_amdgcn_readfirstlane(tid >> 6), d = tid & 63, tg = tid >> 6, fr = lane & 15, fq = lane >> 4;
    const int cgi = u >> 2, h = u & 3, r0 = cgi * 64;
    const bf16_t* Z = (const bf16_t*)(a.ws + WS_Z);
    float cumF[8], cumB[8], totF, totB;
    gla_gates(a, wv, lds, r0, h, cumF, cumB, totF, totB);
#pragma unroll
    for (int i = 0; i < 8; ++i) { const int t = tg * 8 + i; const float q = bf2f(Z[(size_t)(r0 + t) * ZP + C_GQ + h * 64 + d]) * 0.125f, k = bf2f(Z[(size_t)(r0 + t) * ZP + C_GK + h * 64 + d]);
        *(LAS bf16_t*)(lds + GL_QF + t * GROW + d * 2) = f2bf(q * __expf(cumF[i]));
        *(LAS bf16_t*)(lds + GL_KF + t * GROW + d * 2) = f2bf(k * __expf(-cumF[i]));
        *(LAS bf16_t*)(lds + GL_QB + t * GROW + d * 2) = f2bf(q * __expf(cumB[i]));
        *(LAS bf16_t*)(lds + GL_KB + t * GROW + d * 2) = f2bf(k * __expf(-cumB[i])); }
    gla_load_vT(a, wv, lds, r0, h);
    __syncthreads();
    const int ch = wave & 1, eq = wave >> 1;
    f32x4 oT[2][2];
#pragma unroll
    for (int i = 0; i < 2; ++i)
#pragma unroll
        for (int j = 0; j < 2; ++j) oT[i][j] = (f32x4){0.f, 0.f, 0.f, 0.f};
#pragma unroll
    for (int dir = 0; dir < 2; ++dir) {
        const LAS unsigned char* qe = lds + (dir ? GL_QB : GL_QF); const LAS unsigned char* ke = lds + (dir ? GL_KB : GL_KF);
        const float* ST = (const float*)(a.ws + WS_CT) + ((size_t)u * 2 + dir) * 8192;
        bf16x8 sf[2][2];
#pragma unroll
        for (int eb = 0; eb < 2; ++eb)
#pragma unroll
            for (int ks = 0; ks < 2; ++ks) { const float* p = ST + (16 * (2 * eq + eb) + fr) * 64 + 32 * ks + 8 * fq; const f32x4 x0 = *(const f32x4*)p, x1 = *(const f32x4*)(p + 4);
                u32x4 w; w.x = cvt_pk_bf16(x0[0], x0[1]); w.y = cvt_pk_bf16(x0[2], x0[3]); w.z = cvt_pk_bf16(x1[0], x1[1]); w.w = cvt_pk_bf16(x1[2], x1[3]); sf[eb][ks] = __builtin_bit_cast(bf16x8, w); }
#pragma unroll
        for (int cb = 0; cb < 2; ++cb) {
            const int cbg = 2 * ch + cb;
            bf16x8 qf[2];
#pragma unroll
            for (int ks = 0; ks < 2; ++ks) qf[ks] = *(const LAS bf16x8*)(qe + (16 * cbg + fr) * GROW + (32 * ks + 8 * fq) * 2);
            f32x4 att[4];
#pragma unroll
            for (int sb = 0; sb < 4; ++sb) {
                f32x4 acc = {0.f, 0.f, 0.f, 0.f};
                const bool need = dir == 0 ? (sb <= cbg) : (sb >= cbg);
                if (need) {
#pragma unroll
                    for (int ks = 0; ks < 2; ++ks) { const bf16x8 kfr = *(const LAS bf16x8*)(ke + (16 * sb + fr) * GROW + (32 * ks + 8 * fq) * 2); acc = __builtin_amdgcn_mfma_f32_16x16x32_bf16(kfr, qf[ks], acc, 0, 0, 0); }
                    if (sb == cbg) {
#pragma unroll
                        for (int j = 0; j < 4; ++j) { const int sl = 4 * fq + j; const bool keep = dir == 0 ? (sl <= fr) : (sl >= fr); acc[j] = keep ? acc[j] : 0.f; } }
                }
                att[sb] = acc;
            }
#pragma unroll
            for (int kp = 0; kp < 2; ++kp) {
                u32x4 w; w.x = cvt_pk_bf16(att[2 * kp][0], att[2 * kp][1]); w.y = cvt_pk_bf16(att[2 * kp][2], att[2 * kp][3]); w.z = cvt_pk_bf16(att[2 * kp + 1][0], att[2 * kp + 1][1]); w.w = cvt_pk_bf16(att[2 * kp + 1][2], att[2 * kp + 1][3]);
                const bf16x8 pb = __builtin_bit_cast(bf16x8, w);
#pragma unroll
                for (int eb = 0; eb < 2; ++eb) { const LAS unsigned char* vp = lds + GL_VT + (16 * (2 * eq + eb) + fr) * GROW + (32 * kp + 4 * fq) * 2;
                    const u32x2 v0 = *(const LAS u32x2*)vp, v1 = *(const LAS u32x2*)(vp + 32); const u32x4 vv = {v0.x, v0.y, v1.x, v1.y};
                    oT[eb][cb] = __builtin_amdgcn_mfma_f32_16x16x32_bf16(__builtin_bit_cast(bf16x8, vv), pb, oT[eb][cb], 0, 0, 0); }
            }
#pragma unroll
            for (int ks = 0; ks < 2; ++ks)
#pragma unroll
                for (int eb = 0; eb < 2; ++eb) oT[eb][cb] = __builtin_amdgcn_mfma_f32_16x16x32_bf16(sf[eb][ks], qf[ks], oT[eb][cb], 0, 0, 0);
        }
    }
    LAS float* red = (LAS float*)(lds + GL_RED);
#pragma unroll
    for (int cb = 0; cb < 2; ++cb) { float s = 0.f;
#pragma unroll
        for (int eb = 0; eb < 2; ++eb)
#pragma unroll
            for (int j = 0; j < 4; ++j) s += oT[eb][cb][j] * oT[eb][cb][j];
        s += __shfl_xor(s, 16); s += __shfl_xor(s, 32);
        if (fq == 0) red[eq * 64 + 16 * (2 * ch + cb) + fr] = s; }
    __syncthreads();
    bf16_t* MIX = (bf16_t*)(a.ws + WS_MIX);
#pragma unroll
    for (int cb = 0; cb < 2; ++cb) { const int c = 16 * (2 * ch + cb) + fr; const float tot = red[c] + red[64 + c] + red[128 + c] + red[192 + c]; const float rstd = rsqrtf(tot * (1.f / 128.f) + EPS);
#pragma unroll
        for (int eb = 0; eb < 2; ++eb) { const int e = 16 * (2 * eq + eb) + 4 * fq; const f32x4 gn = *(const f32x4*)(a.in[I_GLAN] + e);
            const u32x2 gw = *(const u32x2*)(Z + (size_t)(r0 + c) * ZP + C_GOUT + h * 128 + e);
            const float g0 = bflo(gw.x), g1 = bfhi(gw.x), g2 = bflo(gw.y), g3 = bfhi(gw.y);
            const f32x4 o = oT[eb][cb] * rstd * gn; u32x2 w; w.x = cvt_pk_bf16(o[0] * silu_f(g0), o[1] * silu_f(g1)); w.y = cvt_pk_bf16(o[2] * silu_f(g2), o[3] * silu_f(g3));
            *(u32x2*)(MIX + (size_t)(r0 + c) * D + 512 + h * 128 + e) = w; } }
    __syncthreads();
}

constexpr int AT_KROW = 208, AT_VROW = 144, AT_KB = 64 * AT_KROW  , AT_STAGE = AT_KB + 64 * AT_VROW  ;
__device__ __forceinline__ void attn_unit(const Args& a, int wv, LAS unsigned char* lds, int idx) {
    const int tid = otid(wv), lane = tid & 63, wave = __builtin_amdgcn_readfirstlane(tid >> 6), fr = lane & 15, fq = lane >> 4;
    int row0, S, nt; const bf16_t* Kb; const bf16_t* Vb; int h;
    if (idx < 256) { const int b = idx >> 7, qb = idx & 15; h = (idx >> 4) & 7; row0 = MP + b * 2048 + qb * 128; S = SKS; nt = 36;
        Kb = (const bf16_t*)(a.ws + WS_KS) + (size_t)(b * 8 + h) * SKS * 96; Vb = (const bf16_t*)(a.ws + WS_VTS) + (size_t)(b * 8 + h) * 64 * SKS; }
    else { const int j = idx - 256; const int b = j >> 4, qb = j & 1; h = (j >> 1) & 7; row0 = b * 256 + qb * 128; S = 256; nt = 4;
        Kb = (const bf16_t*)(a.ws + WS_KP) + (size_t)(b * 8 + h) * 256 * 96; Vb = (const bf16_t*)(a.ws + WS_VTP) + (size_t)(b * 8 + h) * 64 * 256; }
    const char* src[3]; unsigned step[3]; unsigned dst[3]; bool valid[3];
#pragma unroll
    for (int j = 0; j < 3; ++j) { const int ins = wave + 8 * j; valid[j] = ins < 22;
        if (ins < 13) { const int ck = ins * 64 + lane, r = ck / 13, cc = ck % 13; src[j] = (const char*)Kb + (size_t)r * 192 + (cc < 12 ? cc : 11) * 16; step[j] = 64 * 192; dst[j] = ins * 1024; }
        else { const int cv = (ins - 13) * 64 + lane, r = cv / 9, cc = cv % 9; src[j] = (const char*)Vb + (size_t)r * S * 2 + (cc < 8 ? cc : 7) * 16; step[j] = 128; dst[j] = AT_KB + (ins - 13) * 1024; } }
#define AT_ISSUE(t, buf) do { _Pragma("unroll") for (int j = 0; j < 3; ++j) if (valid[j]) \
        __builtin_amdgcn_global_load_lds((const unsigned*)(src[j] + (size_t)(t) * step[j]), (LAS unsigned*)(lds + (buf) * AT_STAGE + dst[j]), 16, 0, 0); } while (0)
    AT_ISSUE(0, 0);
    const bf16_t* Q = (const bf16_t*)(a.ws + WS_Q) + (size_t)(row0 + wave * 16 + fr) * 768 + h * 96 + 8 * fq;
    bf16x8 qf[3];
#pragma unroll
    for (int ks = 0; ks < 3; ++ks) qf[ks] = *(const bf16x8*)(Q + 32 * ks);
    float mrun = -1e30f, lsum = 0.f;
    f32x4 o[4];
#pragma unroll
    for (int i = 0; i < 4; ++i) o[i] = (f32x4){0.f, 0.f, 0.f, 0.f};
    for (int t = 0; t < nt; ++t) {
        VM_WAIT(); __syncthreads();
        if (t + 1 < nt) AT_ISSUE(t + 1, (t + 1) & 1);
        const LAS unsigned char* kt = lds + (t & 1) * AT_STAGE; const LAS unsigned char* vt = kt + AT_KB;
        f32x4 s[4];
#pragma unroll
        for (int kb = 0; kb < 4; ++kb) { s[kb] = (f32x4){0.f, 0.f, 0.f, 0.f};
#pragma unroll
            for (int ks = 0; ks < 3; ++ks) { const bf16x8 kf = *(const LAS bf16x8*)(kt + (16 * kb + fr) * AT_KROW + (32 * ks + 8 * fq) * 2); s[kb] = __builtin_amdgcn_mfma_f32_16x16x32_bf16(kf, qf[ks], s[kb], 0, 0, 0); } }
        float mx = fmaxf(fmaxf(fmaxf(s[0][0], s[0][1]), fmaxf(s[0][2], s[0][3])), fmaxf(fmaxf(s[1][0], s[1][1]), fmaxf(s[1][2], s[1][3])));
        mx = fmaxf(mx, fmaxf(fmaxf(fmaxf(s[2][0], s[2][1]), fmaxf(s[2][2], s[2][3])), fmaxf(fmaxf(s[3][0], s[3][1]), fmaxf(s[3][2], s[3][3]))));
        mx = fmaxf(mx, __shfl_xor(mx, 16)); mx = fmaxf(mx, __shfl_xor(mx, 32));
        const float mnew = fmaxf(mrun, mx); const float alpha = __builtin_amdgcn_exp2f(mrun - mnew); mrun = mnew;
        float ps = 0.f;
#pragma unroll
        for (int kb = 0; kb < 4; ++kb)
#pragma unroll
            for (int j = 0; j < 4; ++j) { s[kb][j] = __builtin_amdgcn_exp2f(s[kb][j] - mnew); ps += s[kb][j]; }
        lsum = lsum * alpha + ps;
#pragma unroll
        for (int i = 0; i < 4; ++i) o[i] = o[i] * alpha;
#pragma unroll
        for (int kp = 0; kp < 2; ++kp) {
            u32x4 w; w.x = cvt_pk_bf16(s[2 * kp][0], s[2 * kp][1]); w.y = cvt_pk_bf16(s[2 * kp][2], s[2 * kp][3]); w.z = cvt_pk_bf16(s[2 * kp + 1][0], s[2 * kp + 1][1]); w.w = cvt_pk_bf16(s[2 * kp + 1][2], s[2 * kp + 1][3]);
            const bf16x8 pb = __builtin_bit_cast(bf16x8, w);
#pragma unroll
            for (int mb = 0; mb < 4; ++mb) { const LAS unsigned char* vp = vt + (16 * mb + fr) * AT_VROW + (32 * kp + 4 * fq) * 2;
                const u32x2 v0 = *(const LAS u32x2*)vp, v1 = *(const LAS u32x2*)(vp + 32); const u32x4 vv = {v0.x, v0.y, v1.x, v1.y};
                o[mb] = __builtin_amdgcn_mfma_f32_16x16x32_bf16(__builtin_bit_cast(bf16x8, vv), pb, o[mb], 0, 0, 0); }
        }
    }
    lsum += __shfl_xor(lsum, 16); lsum += __shfl_xor(lsum, 32);
    const float il = fast_rcp(lsum);
    bf16_t* MIX = (bf16_t*)(a.ws + WS_MIX) + (size_t)(row0 + wave * 16 + fr) * D + h * 64 + 4 * fq;
#pragma unroll
    for (int mb = 0; mb < 4; ++mb) { u32x2 w; w.x = cvt_pk_bf16(o[mb][0] * il, o[mb][1] * il); w.y = cvt_pk_bf16(o[mb][2] * il, o[mb][3] * il); *(u32x2*)(MIX + 16 * mb) = w; }
    __syncthreads();
#undef AT_ISSUE
}

__device__ unsigned g_bar[128];
__device__ __forceinline__ void my_grid_barrier(unsigned* ctr, unsigned nth, unsigned G, int wv, LAS unsigned* sbase) {
    asm volatile("s_waitcnt vmcnt(0) lgkmcnt(0)" ::: "memory");
    __syncthreads();
    if (otid(wv) == 0) {
        __builtin_amdgcn_fence(__ATOMIC_RELEASE, "agent");
        asm volatile("s_waitcnt vmcnt(0)" ::: "memory");
        const unsigned old = __hip_atomic_fetch_add(ctr, 1u, __ATOMIC_RELAXED, __HIP_MEMORY_SCOPE_AGENT);
        if (nth == 1u) sbase[0] = old >= 0xAAAAAAAAu ? 0xAAAAAAAAu : 0u;
        const unsigned target = sbase[0] + G * nth;
        while (__hip_atomic_load(ctr, __ATOMIC_RELAXED, __HIP_MEMORY_SCOPE_AGENT) < target) __builtin_amdgcn_s_sleep(2);
        __builtin_amdgcn_fence(__ATOMIC_ACQUIRE, "agent");
        asm volatile("s_waitcnt vmcnt(0)" ::: "memory");
    }
    __syncthreads();
    __builtin_amdgcn_fence(__ATOMIC_ACQUIRE, "agent");
    asm volatile("s_waitcnt vmcnt(0)" ::: "memory");
}
__device__ __forceinline__ void my_grid_barrier_finish(unsigned* ctr, unsigned G, int wv) {
    if (otid(wv) == 0) {
        const unsigned old = __hip_atomic_fetch_add(ctr + 64, 1u, __ATOMIC_RELAXED, __HIP_MEMORY_SCOPE_AGENT);
        const unsigned base = old >= 0xAAAAAAAAu ? 0xAAAAAAAAu : 0u;
        if (old - base == G - 1u) { __hip_atomic_store(ctr, 0u, __ATOMIC_RELAXED, __HIP_MEMORY_SCOPE_AGENT); __hip_atomic_store(ctr + 64, 0u, __ATOMIC_RELAXED, __HIP_MEMORY_SCOPE_AGENT); }
    }
}
__device__ __forceinline__ void dbg_stat(unsigned char* ws, int wv, LAS unsigned char* lds, const void* buf, int is_bf16, size_t n, int slot) {
    const int tid = otid(wv); float ss = 0.f; float bad = 0.f;
    for (size_t i = tid; i < n; i += 512) { const float v = is_bf16 ? bf2f(((const bf16_t*)buf)[i]) : ((const float*)buf)[i];
        if (!(fabsf(v) < 1e30f)) bad += 1.f; else ss += v * v; }
    ss = wave_sum(ss); bad = wave_sum(bad);
    LAS float* red = (LAS float*)(lds + 1024);
    __syncthreads();
    if ((tid & 63) == 0) { red[(tid >> 6) * 2] = ss; red[(tid >> 6) * 2 + 1] = bad; }
    __syncthreads();
    if (tid == 0) { float a0 = 0.f, b0 = 0.f; for (int w = 0; w < 8; ++w) { a0 += red[2 * w]; b0 += red[2 * w + 1]; }
        float* d = (float*)(ws + (30u << 20)); d[slot * 2] = sqrtf(a0 / (float)n) * 1000.f; d[slot * 2 + 1] = b0; }
    __syncthreads();
}
constexpr int NPHASE = 11;
__global__ void __launch_bounds__(512, 2) mk_fwd(Args a) {
    const int wv = __builtin_amdgcn_readfirstlane((int)threadIdx.x >> 6);
    extern __shared__ __attribute__((aligned(16))) unsigned char lds_raw[];
    LAS unsigned char* lds = (LAS unsigned char*)lds_raw;
    const int G = gridDim.x, bx = blockIdx.x;
    const int vcu = (G % 8 == 0) ? (bx % 8) * (G / 8) + bx / 8 : bx;
    unsigned char* ws = a.ws;
    const int lo = a.ph_lo, hi = a.ph_hi;
#ifndef PHMASK
#define PHMASK 0x7ff
#endif
#define IN(k) (((PHMASK >> (k)) & 1) && lo <= (k) && (k) < hi)
#define SEAM(k) do { if (IN(k) && IN((k) + 1)) { ++nbar; my_grid_barrier(g_bar, nbar, (unsigned)G, wv, (LAS unsigned*)(lds + LDS_BYTES - 64)); } } while (0)
#ifndef PROBE_FILL
#define PROBE_FILL 0
#endif
    if (PROBE_FILL && lo == 0) { f32x4* p = (f32x4*)a.ws; const size_t n = (size_t)(PROBE_FILL_MIB) << 16; const float fv = PROBE_FILL_VAL;
        for (size_t i = (size_t)bx * 512 + threadIdx.x; i < n; i += (size_t)G * 512) { unsigned h = (unsigned)i * 2654435761u; h ^= h >> 15; h *= 2246822519u; h ^= h >> 13; const float r0 = (float)(h & 0xffff) * (1.f / 65536.f) - 0.5f + fv * 0.f; p[i] = (f32x4){r0, r0 * 1.7f, r0 * -0.3f, r0 + 0.1f}; } }
    if (PROBE_FILL == 2 && lo == 0 && bx == 0) { static const int szs[26] = {4194304, 4194304, 131072, 16384, 65536, 65536, 2048, 1024, 6291456, 6144, 1024, 2293760, 384, 294912, 256, 262144, 4096, 256, 4096, 256, 128, 1048576, 1024, 5767168, 2883584, 1024};
        float sm = 0.f; for (int i = 0; i < 26; ++i) { const int n = szs[i]; const int st = n > 1024 ? n - 1024 : 0; for (int j = st + (int)threadIdx.x; j < n; j += 512) sm += a.in[i][j]; for (int j = threadIdx.x; j < (n < 1024 ? n : 1024); j += 512) sm += a.in[i][j]; }
        ((float*)(a.ws))[threadIdx.x] = sm; }
    if (PROBE_FILL == 5 && lo == 0) { volatile float* p = (volatile float*)a.ws; const float big = p[0] * 0.f + 1e38f, tiny = p[1] * 0.f + 1e-38f, zero = p[2] * 0.f, neg = p[3] * 0.f - 1.f;
        float r = 0.f;
#if PROBE_EXC & 1
        r += big * big;
#endif
#if PROBE_EXC & 2
        r += tiny * tiny;
#endif
#if PROBE_EXC & 4
        r += 1.f / zero;
#endif
#if PROBE_EXC & 8
        r += __builtin_sqrtf(neg);
#endif
        p[4 + bx] = r; }
    unsigned nbar = 0;
    if (IN(0)) { phase0(a, wv, lds, vcu, G); } SEAM(0);
    if (IN(1) && bx >= PROBE_BLO && bx < PROBE_BHI && (bx & 7) >= PROBE_XLO && (bx & 7) < PROBE_XHI) { for (int rep = 0; rep < PROBE_REP; ++rep) phase1(a, wv, vcu, G); } SEAM(1);
    if (PROBE_HANG && lo == 1) { volatile unsigned* q = (volatile unsigned*)(a.ws + 8); while (*q != 0x12345678u) __builtin_amdgcn_s_sleep(20); }
    if (IN(2)) {
        pg8::Gemm g{(const bf16_t*)(ws + WS_H), (const bf16_t*)(ws + WS_WIN), D, D, D, wv}; pg8::Order S; S.init(MTOK, ZP, 1, G, bx);
        pg8::EpiZ E{(bf16_t*)(ws + WS_Z), (float*)(ws + WS_RSSQ), (float*)(ws + WS_RSSKV)};
        pg8::gemm_phase<pg8::EpiZ, pg8::Order>(lds, g, S, E);
    } SEAM(2);
    if (PROBE_STATS && bx == 0 && IN(3)) dbg_stat(ws, wv, lds, ws + WS_Z, 1, (size_t)256 * ZP, 0);
    if (IN(3)) {
#ifndef P3MASK
#define P3MASK 0x3f
#endif
#if (P3MASK >> 0) & 1
        { pg8::Gemm g{(const bf16_t*)(ws + WS_Z) + C_QLAT, (const bf16_t*)(ws + WS_WUQ), ZP, 384, 384, wv}; pg8::Order S; S.init(MTOK, 768, 1, G, bx);
          pg8::EpiQ E{(bf16_t*)(ws + WS_Q), (const float*)(ws + WS_RSSQ)}; pg8::gemm_phase<pg8::EpiQ, pg8::Order>(lds, g, S, E); }
#endif
#if (P3MASK >> 1) & 1
        { pg8::Gemm g{(const bf16_t*)(ws + WS_Z) + C_KVLAT, (const bf16_t*)(ws + WS_WKF), ZP, 256, 256, wv}; pg8::Order S; S.init(MTOK, 512, 1, G, (bx + G - 96) % G);
          pg8::EpiK E{(bf16_t*)(ws + WS_KP), (bf16_t*)(ws + WS_KS), (const float*)(ws + WS_RSSKV), 0}; pg8::gemm_phase<pg8::EpiK, pg8::Order>(lds, g, S, E); }
#endif
#if (P3MASK >> 2) & 1
        { pg8::Gemm g{(const bf16_t*)(ws + WS_WVF), (const bf16_t*)(ws + WS_Z) + C_KVLAT, 256, ZP, 256, wv}; pg8::Order S; S.init(512, MTOK, 1, G, (bx + G - 160) % G);
          pg8::EpiVt E{(bf16_t*)(ws + WS_VTP), (bf16_t*)(ws + WS_VTS), (const float*)(ws + WS_RSSKV), 0}; pg8::gemm_phase<pg8::EpiVt, pg8::Order>(lds, g, S, E); }
#endif
#if (P3MASK >> 3) & 1
        { pg8::Gemm g{(const bf16_t*)(ws + WS_CACHEB), (const bf16_t*)(ws + WS_WKU), 256, 256, 256, wv}; pg8::Order S; S.init(512, 512, 1, G, (bx + G - 224) % G);
          pg8::EpiK E{(bf16_t*)(ws + WS_KP), (bf16_t*)(ws + WS_KS), (const float*)(ws + WS_RSSKV), 1}; pg8::gemm_phase<pg8::EpiK, pg8::Order>(lds, g, S, E); }
#endif
#if (P3MASK >> 4) & 1
        { pg8::Gemm g{(const bf16_t*)(ws + WS_WVU), (const bf16_t*)(ws + WS_CACHEB), 256, 256, 256, wv}; pg8::Order S; S.init(512, 512, 1, G, (bx + G - 228) % G);
          pg8::EpiVt E{(bf16_t*)(ws + WS_VTP), (bf16_t*)(ws + WS_VTS), (const float*)(ws + WS_RSSKV), 1}; pg8::gemm_phase<pg8::EpiVt, pg8::Order>(lds, g, S, E); }
#endif
        __syncthreads();
        const int c2 = (bx + G - 232) % G;
#if (P3MASK >> 5) & 1
        for (int u = c2; u < 512; u += G) gla_stepA(a, wv, lds, u);
#endif
        p3_row_extras(a, wv, c2 * 8 + (otid(wv) >> 6), G * 8);
    } SEAM(3);
    if (IN(4)) { gla_scan(a, wv, vcu, G); } SEAM(4);
    if (IN(5)) {
        for (int u = vcu; u < 512; u += G) attn_unit(a, wv, lds, u);
        for (int u = vcu; u < 512; u += G) gla_stepC(a, wv, lds, u);
    } SEAM(5);
    if (PROBE_STATS && bx == 0 && IN(6)) dbg_stat(ws, wv, lds, ws + WS_MIX, 1, (size_t)8192 * D, 1);
    if (IN(6)) {
        pg8::Gemm g{(const bf16_t*)(ws + WS_MIX), (const bf16_t*)(ws + WS_WOUT), D, D, PROBE_K6, wv}; pg8::Order S; S.init(MTOK, D, 1024 / PROBE_K6, G, bx);
        pg8::EpiPart E{(float*)(ws + WS_P0), (float*)(ws + WS_P1A)}; pg8::gemm_phase<pg8::EpiPart, pg8::Order>(lds, g, S, E);
    } SEAM(6);
    if (IN(7)) { phase6(a, wv, vcu, G); } SEAM(7);
    if (PROBE_STATS && bx == 0 && IN(8)) dbg_stat(ws, wv, lds, ws + WS_X1, 0, (size_t)8192 * D, 2);
    if (IN(8)) {
        pg8::Gemm g{(const bf16_t*)(ws + WS_H), (const bf16_t*)(ws + WS_WFFI), D, D, D, wv}; pg8::Order S; S.init(MTOK, 2 * DFF, 1, G, bx);
        pg8::EpiFFI E{(bf16_t*)(ws + WS_HFF)}; pg8::gemm_phase<pg8::EpiFFI, pg8::Order>(lds, g, S, E);
    } SEAM(8);
    if (IN(9)) {
        pg8::Gemm g{(const bf16_t*)(ws + WS_HFF), (const bf16_t*)(ws + WS_WFFO), DFF, DFF, DFF / 2, wv}; pg8::Order S; S.init(MTOK, D, 2, G, bx);
        pg8::EpiPart E{(float*)(ws + WS_P0), (float*)(ws + WS_P1B)}; pg8::gemm_phase<pg8::EpiPart, pg8::Order>(lds, g, S, E);
    } SEAM(9);
    if (IN(10)) { phase9(a, wv, vcu, G); }
    if (PROBE_STATS) { ++nbar; my_grid_barrier(g_bar, nbar, (unsigned)G, wv, (LAS unsigned*)(lds + LDS_BYTES - 64));
        if (bx == 0) { dbg_stat(ws, wv, lds, a.out, 0, (size_t)8192 * D, 3);
            const float* d = (const float*)(ws + (30u << 20)); const int tid = otid(wv);
            const size_t offs[6] = {0, 4194304, O_KV, O_KR, O_SF, O_SB}; const size_t szs[6] = {4194304, 4194304, 1048576, 131072, 524288, 524288};
            float vals[6] = {d[0], d[2], d[4], d[6] * 0.1f, d[1] + d[3], d[5] + d[7]};
            for (int k = 0; k < 6; ++k) { size_t cnt = (size_t)fminf(fmaxf(vals[k], 0.f), (float)(szs[k] - 1)); unsigned* o = (unsigned*)(a.out + offs[k]);
                for (size_t i = tid; i < cnt; i += 512) o[i] = 0xAAAAAAAAu; } } }
    if (PROBE_DUMP) {
        if (PROBE_DUMP != 5 && PROBE_DUMP != 7) { ++nbar; } if (PROBE_DUMP != 5 && PROBE_DUMP != 7) my_grid_barrier(g_bar, nbar, (unsigned)G, wv, (LAS unsigned*)(lds + LDS_BYTES - 64));
        const bf16_t* src = (const bf16_t*)(ws + (PROBE_DUMP == 1 ? WS_Z : PROBE_DUMP == 2 ? WS_MIX : WS_H)); const int pitch = PROBE_DUMP == 1 ? ZP : D;
        for (size_t i = (size_t)bx * 512 + otid(wv); i < (size_t)MTOK * D; i += (size_t)G * 512) { const int r = (int)(i >> 10), c = (int)(i & 1023); a.out[i] = PROBE_DUMP == 7 ? 1.0f : PROBE_DUMP == 6 ? (r < 2304 ? bf2f(((const bf16_t*)(ws + WS_WIN))[(size_t)r * 1024 + c]) : 0.f) : PROBE_DUMP >= 4 ? xrow_ptr(a, r)[c] * 2.f : bf2f(src[(size_t)r * pitch + c]); }
        for (size_t i = O_KV + (size_t)bx * 512 + otid(wv); i < 10616832; i += (size_t)G * 512) a.out[i] = 0.f;
    }
    if (nbar) my_grid_barrier_finish(g_bar, (unsigned)G, wv);
#undef IN
#undef SEAM
}

extern "C" void kernel_launch(void* const* d_in, const int* in_sizes, int n_in, void* d_out, int out_size, void* d_ws, size_t ws_size, hipStream_t stream) {
    static int grid = 0;
    if (grid == 0) {
        int dev = 0, cus = 0;
        static const int exp_sizes[26] = {4194304, 4194304, 131072, 16384, 65536, 65536, 2048, 1024, 6291456, 6144, 1024, 2293760, 384, 294912, 256, 262144, 4096, 256, 4096, 256, 128, 1048576, 1024, 5767168, 2883584, 1024};
        bool okk = (n_in == 26); for (int i = 0; okk && i < 26; ++i) okk = (in_sizes[i] == exp_sizes[i]);
        if (!okk || out_size != 10616832) { fprintf(stderr, "kernel_launch: unexpected input sizes\n"); grid = -1; return; }
        if (n_in != 26 || ws_size < 198 * MiB) { fprintf(stderr, "kernel_launch: unexpected n_in %d / ws %zu\n", n_in, ws_size); grid = -1; return; }
        hipGetDevice(&dev); hipDeviceGetAttribute(&cus, hipDeviceAttributeMultiprocessorCount, dev);
        if (hipFuncSetAttribute((const void*)mk_fwd, hipFuncAttributeMaxDynamicSharedMemorySize, LDS_BYTES) != hipSuccess) { fprintf(stderr, "kernel_launch: hipFuncSetAttribute failed\n"); grid = -1; return; }
        int per_cu = 0;
        if (hipOccupancyMaxActiveBlocksPerMultiprocessor(&per_cu, (const void*)mk_fwd, 512, LDS_BYTES) != hipSuccess || per_cu < 1) { fprintf(stderr, "kernel_launch: occupancy query says %d\n", per_cu); per_cu = 1; }
        (void)hipGetLastError();
        if (cus < 256) { fprintf(stderr, "kernel_launch: needs 256 CUs, got %d\n", cus); grid = -1; return; }
        grid = 256;
    }
    if (grid < 0) return;
    if (hipMemsetAsync((char*)d_ws + WS_BAR, 0, 4096, stream) != hipSuccess) { fprintf(stderr, "kernel_launch: memset failed\n"); return; }
    Args a{};
    for (int i = 0; i < 26; ++i) a.in[i] = (const float*)d_in[i];
    a.out = (float*)d_out; a.ws = (unsigned char*)d_ws;
#if MK_PER_PHASE_LAUNCH
    for (int p = 0; p < NPHASE; ++p) { if (PROBE_ONLY_LAUNCH >= 0 && p != PROBE_ONLY_LAUNCH) continue; a.ph_lo = p; a.ph_hi = p + 1; hipLaunchKernelGGL(mk_fwd, dim3(grid), dim3(512), LDS_BYTES, stream, a); }
#else
    a.ph_lo = 0; a.ph_hi = NPHASE;
#if MK_COOP
    void* args[] = {&a};
    hipError_t e = hipLaunchCooperativeKernel((const void*)mk_fwd, dim3(grid), dim3(512), args, LDS_BYTES, stream);
    if (e != hipSuccess) fprintf(stderr, "cooperative launch failed: %s (grid %d)\n", hipGetErrorString(e), grid);
#else
    hipLaunchKernelGGL(mk_fwd, dim3(grid), dim3(512), LDS_BYTES, stream, a);
#endif
#endif
}
```

```cpp
#include <hip/hip_runtime.h>
#include <hip/hip_cooperative_groups.h>
#include <cstdio>
#include <cstdint>
namespace cg = cooperative_groups;

#define PROBE_FILL 0
#define PROBE_EXC 0
#define PROBE_BLO 0
#define PROBE_BHI 256
#define PROBE_RSTRIDE 1
#define PROBE_REP 1
#define PROBE_XLO 0
#define PROBE_XHI 8
#define PROBE_HANG 0
#define PROBE_DUMP 0
#define PROBE_STATS 0
#define PROBE_K6 512
#define PROBE_ONLY_LAUNCH -1
#define PROBE_NOSTORE 0
#define PROBE_FILL_MIB 256
#define PROBE_FILL_VAL 1.2345f
#ifndef PROBE_MUL
#define PROBE_MUL 1.f
#endif
#ifndef PROBE_MODOFF
#define PROBE_MODOFF 0u
#endif
#ifndef MK_COOP
#define MK_COOP 0
#endif
#ifndef MK_PER_PHASE_LAUNCH
#define MK_PER_PHASE_LAUNCH 0
#endif

#define LAS __attribute__((address_space(3)))
typedef unsigned short bf16_t;
typedef short bf16x8 __attribute__((ext_vector_type(8)));
typedef float f32x4 __attribute__((ext_vector_type(4)));
typedef float f32x2 __attribute__((ext_vector_type(2)));
typedef unsigned u32x4 __attribute__((ext_vector_type(4)));
typedef unsigned u32x2 __attribute__((ext_vector_type(2)));

constexpr int D = 1024, MTOK = 8192, MP = 4096;
constexpr int ZP = 2304;
constexpr int C_QLAT = 0, C_KVLAT = 384, C_KROPE = 640, C_GQ = 672, C_GK = 928, C_GV = 1184, C_GFL = 1696, C_GOUT = 1728;
constexpr int DFF = 2816;
constexpr float EPS = 1e-6f;
constexpr float QSCALE = 0.10206207261596577f * 1.4426950408889634f;
constexpr int SKS = 2304;

constexpr size_t MiB = 1u << 20;
constexpr size_t WS_WIN = 1 * MiB;
constexpr size_t WS_WUQ = 6 * MiB;
constexpr size_t WS_WKF = 7 * MiB, WS_WVF = 7 * MiB + 256 * 1024;
constexpr size_t WS_WKU = 7 * MiB + 512 * 1024, WS_WVU = 7 * MiB + 768 * 1024;
constexpr size_t WS_WOUT = 8 * MiB;
constexpr size_t WS_WFFI = 10 * MiB;
constexpr size_t WS_WFFO = 21 * MiB;
constexpr size_t WS_BAR = 27 * MiB - 4096;
constexpr size_t WS_MOD = 27 * MiB;
constexpr size_t WS_RSSQ = 29 * MiB;
constexpr size_t WS_RSSKV = WS_RSSQ;
constexpr size_t WS_CACHEB = 27 * MiB + 512 * 1024;
constexpr size_t WS_DEC = 28 * MiB;
constexpr size_t WS_H = 32 * MiB;
constexpr size_t WS_Z = 48 * MiB;
constexpr size_t WS_Q = 84 * MiB;
constexpr size_t WS_HFF = 48 * MiB;
constexpr size_t WS_KP = 96 * MiB;
constexpr size_t WS_KS = 102 * MiB;
constexpr size_t WS_VTP = 109 * MiB;
constexpr size_t WS_VTS = 113 * MiB;
constexpr size_t WS_CT = 118 * MiB;
constexpr size_t WS_MIX = 150 * MiB;
constexpr size_t WS_X1 = 166 * MiB;
constexpr size_t WS_P0 = 96 * MiB;
constexpr size_t WS_P1A = 48 * MiB, WS_P1B = 128 * MiB;
constexpr size_t O_Y = 0, O_KV = 8388608, O_KR = O_KV + 1048576, O_SF = O_KR + 131072, O_SB = O_SF + 524288;

constexpr int LDS_BYTES = 147456;

__device__ __forceinline__ unsigned f2bf_sw(float f) { unsigned u = __builtin_bit_cast(unsigned, f); return (u + 0x7fffu + ((u >> 16) & 1u)) >> 16; }
__device__ __forceinline__ unsigned cvt_pk_bf16(float lo, float hi) { return f2bf_sw(lo) | (f2bf_sw(hi) << 16); }
__device__ __forceinline__ bf16_t f2bf(float f) { return (bf16_t)(cvt_pk_bf16(f, 0.f) & 0xffffu); }
__device__ __forceinline__ float bf2f(bf16_t b) { return __uint_as_float((unsigned)b << 16); }
__device__ __forceinline__ float bflo(unsigned w) { return __uint_as_float(w << 16); }
__device__ __forceinline__ float bfhi(unsigned w) { return __uint_as_float(w & 0xffff0000u); }
__device__ __forceinline__ float wave_sum(float v) {
#pragma unroll
    for (int o = 1; o < 64; o <<= 1) v += __shfl_xor(v, o);
    return v;
}
__device__ __forceinline__ float fast_rcp(float x) { return __builtin_amdgcn_rcpf(x); }
__device__ __forceinline__ float silu_f(float a) { return a * fast_rcp(1.f + __expf(-a)); }
__device__ __forceinline__ float logsigmoid_f(float x) { return fminf(x, 0.f) - __logf(1.f + __expf(-fabsf(x))); }
__device__ __forceinline__ int opaque_lane() { int l; asm volatile("v_mbcnt_lo_u32_b32 %0, -1, 0\n\tv_mbcnt_hi_u32_b32 %0, -1, %0" : "=v"(l)); return l; }
__device__ __forceinline__ int otid(int wv) { int t = (int)threadIdx.x; asm volatile("" : "+v"(t)); return t; }
#define LDS_WAIT() asm volatile("s_waitcnt lgkmcnt(0)" ::: "memory")
#define VM_WAIT() asm volatile("s_waitcnt vmcnt(0)" ::: "memory")

namespace pg8 {
constexpr int BM = 256, BK = 64, HALF = 128, HTB = HALF * BK * 2, STAGE_BYTES = 8 * HTB, NXCD = 8, WGM = 8;
__host__ __device__ __forceinline__ int lds_byte(int r, int c) { const int st = (r >> 4) * 2 + (c >> 5), rr = r & 15, cc = c & 31, ob = rr * 64 + cc * 2; return st * 1024 + (ob ^ (((ob >> 9) & 1) << 5)); }
__host__ __device__ __forceinline__ void stage_rc(int b, int& R, int& C) { const int st = b / 1024, sb = b % 1024, swz = sb ^ (((sb >> 9) & 1) << 5); R = (st >> 1) * 16 + swz / 64; C = (st & 1) * 32 + (swz % 64) / 2; }
__host__ __device__ __forceinline__ int perm32(int rho) { const int n = rho >> 4, i = rho & 15; return 8 * (i >> 2) + 4 * n + (i & 3); }

struct Unit { int pm, pn, ks; };
struct Gemm { const bf16_t* A; const bf16_t* Bt; int lda, ldb, K, wv; };

struct Order {
    int nM, nN, nNs, nwg, G, c;
    __device__ void init(int M, int N, int nsplit, int G_, int c_) { nM = M / BM; nN = N / BM; nNs = nN * nsplit; nwg = nM * nNs; G = G_; c = c_; }
    __device__ bool next(int i, Unit& u) const {
        const long L = (long)i * G + c; if (L >= nwg) return false;
        int wgid = (int)L; { const int q = nwg / NXCD, r = nwg % NXCD, xcd = wgid % NXCD, off = wgid / NXCD; wgid = (xcd < r ? xcd * (q + 1) : r * (q + 1) + (xcd - r) * q) + off; }
        const int nig = WGM * nNs, gid = wgid / nig, fm = gid * WGM, gsz = (nM - fm) < WGM ? (nM - fm) : WGM;
        u.pm = fm + ((wgid % nig) % gsz); const int pn2 = (wgid % nig) / gsz; u.pn = pn2 % nN; u.ks = pn2 / nN; return true;
    }
};

template <class Epi, class Sched, bool ALIGN_EPI = true, bool SP2 = true>
__device__ __forceinline__ void gemm_phase(LAS unsigned char* lds, const Gemm g, const Sched& S, const Epi& E) {
    const int tid = otid(g.wv), wid = g.wv, lane = tid & 63, wr = wid >> 2, wc = wid & 3, fr = lane & 15, fq = lane >> 4;
    const int K = g.K, nt = K / BK;
    unsigned voffA[2], voffB[2];
#pragma unroll
    for (int i = 0; i < 2; ++i) { int R, C; stage_rc(tid * 16 + i * 8192, R, C); const int Rb = Epi::PERM ? ((R & ~31) + perm32(R & 31)) : R;
        voffA[i] = (unsigned)(R * g.lda + C) * 2u; voffB[i] = (unsigned)(Rb * g.ldb + C) * 2u; }
    const size_t kstep = (size_t)(BK * 2);
    const size_t hstepA = (size_t)HALF * g.lda * 2, hstepB = (size_t)HALF * g.ldb * 2;
    const size_t tstepA = 2 * hstepA, tstepB = 2 * hstepB;
    const size_t ksplit = (size_t)K * 2;
    const unsigned ldsw = (unsigned)wid * 1024u;
    const int aoff = lds_byte(wr * 64 + fr, fq * 8), boff = lds_byte(wc * 32 + fr, fq * 8);
#define PG8_SA(b, h) (((b) * 2 + (h)) * HTB)
#define PG8_SB(b, h) ((4 + (b) * 2 + (h)) * HTB)
#define PG8_STAGE(bufoff, gbase, voff) do { _Pragma("unroll") for (int _i = 0; _i < 2; ++_i) \
        __builtin_amdgcn_global_load_lds((const unsigned*)((const char*)(gbase) + (voff)[_i]), (LAS unsigned*)(lds + (bufoff) + ldsw + _i * 8192), 16, 0, 0); } while (0)
#define PG8_LDA(dst, b, h) do { _Pragma("unroll") for (int m = 0; m < 4; ++m) _Pragma("unroll") for (int k = 0; k < 2; ++k) dst[m][k] = *(const LAS bf16x8*)(lds + PG8_SA(b, h) + aoff + m * 2048 + k * 1024); } while (0)
#define PG8_LDB(dst, b, h) do { _Pragma("unroll") for (int n = 0; n < 2; ++n) _Pragma("unroll") for (int k = 0; k < 2; ++k) dst[n][k] = *(const LAS bf16x8*)(lds + PG8_SB(b, h) + boff + n * 2048 + k * 1024); } while (0)
#define PG8_MMA(ai, bj, At, Bt) do { __builtin_amdgcn_s_setprio(1); _Pragma("unroll") for (int m = 0; m < 4; ++m) _Pragma("unroll") for (int n = 0; n < 2; ++n) _Pragma("unroll") for (int k = 0; k < 2; ++k) \
        acc[ai][bj][m][n] = __builtin_amdgcn_mfma_f32_16x16x32_bf16(Bt[n][k], At[m][k], acc[ai][bj][m][n], 0, 0, 0); __builtin_amdgcn_s_setprio(0); } while (0)
#define PG8_WAIT_V(n) asm volatile("s_waitcnt vmcnt(" #n ")" ::: "memory")
#define PG8_WAIT_L(n) asm volatile("s_waitcnt lgkmcnt(" #n ")" ::: "memory")
#define PG8_BAR __builtin_amdgcn_s_barrier()
#define PG8_SCHED __builtin_amdgcn_sched_barrier(0)
    Unit cur, nxt; int ui = 0;
    if (!S.next(0, cur)) return;
    f32x4 acc[2][2][4][2];
#pragma unroll
    for (int a = 0; a < 2; ++a)
#pragma unroll
        for (int b = 0; b < 2; ++b)
#pragma unroll
            for (int m = 0; m < 4; ++m)
#pragma unroll
                for (int n = 0; n < 2; ++n) acc[a][b][m][n] = (f32x4){0.f, 0.f, 0.f, 0.f};
    bf16x8 At[4][2], B0[2][2], B1[2][2];
    const char* cA = (const char*)g.A + (size_t)cur.pm * tstepA + (size_t)cur.ks * ksplit; const char* cB = (const char*)g.Bt + (size_t)cur.pn * tstepB + (size_t)cur.ks * ksplit;
    if constexpr (SP2) {
        PG8_STAGE(PG8_SB(0, 0), cB, voffB); PG8_STAGE(PG8_SB(0, 1), cB + hstepB, voffB); PG8_STAGE(PG8_SA(0, 0), cA, voffA); PG8_STAGE(PG8_SA(0, 1), cA + hstepA, voffA);
        if (wr == 1) PG8_BAR;
        PG8_WAIT_V(2); PG8_BAR;
        PG8_STAGE(PG8_SB(1, 0), cB + kstep, voffB); PG8_STAGE(PG8_SA(1, 0), cA + kstep, voffA); PG8_STAGE(PG8_SB(1, 1), cB + hstepB + kstep, voffB);
        PG8_WAIT_V(6); PG8_BAR;
    } else {
        PG8_STAGE(PG8_SB(0, 0), cB, voffB); PG8_STAGE(PG8_SA(0, 0), cA, voffA); PG8_STAGE(PG8_SB(0, 1), cB + hstepB, voffB); PG8_STAGE(PG8_SA(0, 1), cA + hstepA, voffA);
        if (wr == 1) PG8_BAR;
        PG8_WAIT_V(4); PG8_BAR;
        PG8_STAGE(PG8_SB(1, 0), cB + kstep, voffB); PG8_STAGE(PG8_SA(1, 0), cA + kstep, voffA); PG8_STAGE(PG8_SB(1, 1), cB + hstepB + kstep, voffB);
        PG8_WAIT_V(6); PG8_BAR;
    }
    for (;;) {
        const bool has_next = S.next(ui + 1, nxt);
        const char* nA = has_next ? (const char*)g.A + (size_t)nxt.pm * tstepA + (size_t)nxt.ks * ksplit : cA; const char* nB = has_next ? (const char*)g.Bt + (size_t)nxt.pn * tstepB + (size_t)nxt.ks * ksplit : cB;
#pragma nounroll
        for (int t = 0; t < nt; t += 2) {
            const bool last = (t == nt - 2);
            const char* a1 = cA + (size_t)(t + 1) * kstep;
            const char* a2 = last ? nA : cA + (size_t)(t + 2) * kstep; const char* b2 = last ? nB : cB + (size_t)(t + 2) * kstep;
            const char* a3 = a2 + kstep; const char* b3 = b2 + kstep;
            if constexpr (SP2) {
            PG8_LDB(B0, 0, 0); PG8_LDB(B1, 0, 1); PG8_SCHED; PG8_LDA(At, 0, 0); PG8_STAGE(PG8_SA(1, 1), a1 + hstepA, voffA);
            PG8_WAIT_V(8); PG8_WAIT_L(0); PG8_BAR; PG8_MMA(0, 0, At, B0); PG8_MMA(0, 1, At, B1); PG8_BAR; PG8_SCHED;
            PG8_LDA(At, 0, 1); PG8_STAGE(PG8_SB(0, 0), b2, voffB); PG8_STAGE(PG8_SB(0, 1), b2 + hstepB, voffB); PG8_STAGE(PG8_SA(0, 0), a2, voffA);
            PG8_WAIT_V(8); PG8_WAIT_L(0); PG8_BAR; PG8_MMA(1, 0, At, B0); PG8_MMA(1, 1, At, B1); PG8_BAR; PG8_SCHED;
            PG8_LDB(B0, 1, 0); PG8_LDB(B1, 1, 1); PG8_SCHED; PG8_LDA(At, 1, 0); PG8_STAGE(PG8_SA(0, 1), a2 + hstepA, voffA);
            PG8_WAIT_V(8); PG8_WAIT_L(0); PG8_BAR; PG8_MMA(0, 0, At, B0); PG8_MMA(0, 1, At, B1); PG8_BAR; PG8_SCHED;
            PG8_LDA(At, 1, 1); PG8_STAGE(PG8_SB(1, 0), b3, voffB); PG8_STAGE(PG8_SB(1, 1), b3 + hstepB, voffB); PG8_STAGE(PG8_SA(1, 0), a3, voffA);
            PG8_WAIT_V(8); PG8_WAIT_L(0); PG8_BAR; PG8_MMA(1, 0, At, B0); PG8_MMA(1, 1, At, B1); PG8_BAR; PG8_SCHED;
            } else {
            PG8_LDB(B0, 0, 0); PG8_SCHED; PG8_LDA(At, 0, 0); PG8_STAGE(PG8_SA(1, 1), a1 + hstepA, voffA);
            PG8_WAIT_L(8); PG8_BAR; PG8_WAIT_L(0); PG8_MMA(0, 0, At, B0); PG8_BAR; PG8_SCHED;
            PG8_LDB(B1, 0, 1); PG8_STAGE(PG8_SB(0, 0), b2, voffB);
            PG8_BAR; PG8_WAIT_L(0); PG8_MMA(0, 1, At, B1); PG8_BAR;
            PG8_LDA(At, 0, 1); PG8_STAGE(PG8_SA(0, 0), a2, voffA);
            PG8_BAR; PG8_WAIT_L(0); PG8_MMA(1, 0, At, B0); PG8_BAR; PG8_SCHED;
            PG8_STAGE(PG8_SB(0, 1), b2 + hstepB, voffB);
            PG8_WAIT_V(6); PG8_BAR; PG8_MMA(1, 1, At, B1); PG8_BAR;
            PG8_LDB(B0, 1, 0); PG8_SCHED; PG8_LDA(At, 1, 0); PG8_STAGE(PG8_SA(0, 1), a2 + hstepA, voffA);
            PG8_WAIT_L(8); PG8_BAR; PG8_WAIT_L(0); PG8_MMA(0, 0, At, B0); PG8_BAR; PG8_SCHED;
            PG8_LDB(B1, 1, 1); PG8_STAGE(PG8_SB(1, 0), b3, voffB);
            PG8_BAR; PG8_WAIT_L(0); PG8_MMA(0, 1, At, B1); PG8_BAR;
            PG8_LDA(At, 1, 1); PG8_STAGE(PG8_SA(1, 0), a3, voffA);
            PG8_BAR; PG8_WAIT_L(0); PG8_MMA(1, 0, At, B0); PG8_BAR; PG8_SCHED;
            PG8_STAGE(PG8_SB(1, 1), b3 + hstepB, voffB);
            PG8_WAIT_V(6); PG8_BAR; PG8_MMA(1, 1, At, B1); PG8_BAR;
            }
        }
        if constexpr (ALIGN_EPI) { if (wr == 0) PG8_BAR; }
        E(acc, cur, wr, wc, fr, fq);
        if (!has_next) break;
#pragma unroll
        for (int a = 0; a < 2; ++a)
#pragma unroll
            for (int b = 0; b < 2; ++b)
#pragma unroll
                for (int m = 0; m < 4; ++m)
#pragma unroll
                    for (int n = 0; n < 2; ++n) acc[a][b][m][n] = (f32x4){0.f, 0.f, 0.f, 0.f};
        cur = nxt; cA = nA; cB = nB; ++ui;
        if constexpr (ALIGN_EPI) { if (wr == 1) PG8_BAR; }
    }
    PG8_WAIT_V(0);
    if constexpr (!ALIGN_EPI) { if (wr == 0) PG8_BAR; }
    PG8_BAR;
#undef PG8_SA
#undef PG8_SB
#undef PG8_STAGE
#undef PG8_LDA
#undef PG8_LDB
#undef PG8_MMA
#undef PG8_WAIT_V
#undef PG8_WAIT_L
#undef PG8_BAR
#undef PG8_SCHED
}

__device__ __forceinline__ float rss_q(const float* rss, int row) { float s = 0.f;
#pragma unroll
    for (int p = 0; p < 12; ++p) s += rss[(size_t)p * MTOK + row]; return s; }
__device__ __forceinline__ float rss_kv(const float* rss, int row) { float s = 0.f;
#pragma unroll
    for (int p = 12; p < 20; ++p) s += rss[(size_t)p * MTOK + row]; return s; }
#define EPI_ROWS_BEGIN _Pragma("unroll") for (int ai = 0; ai < 2; ++ai) _Pragma("unroll") for (int m = 0; m < 4; ++m) { const int row = u.pm * BM + wr * 64 + fr + ai * HALF + m * 16;
#define EPI_ROWS_END asm volatile("" ::: "memory"); }

struct EpiZ {
    static constexpr bool PERM = true;
    bf16_t* Z; float* rssq; float* rsskv;
    __device__ __forceinline__ void operator()(const f32x4 (&acc)[2][2][4][2], const Unit& u, int wr, int wc, int fr_, int fq_) const {
        int lane_e = (int)threadIdx.x & 63; asm volatile("" : "+v"(lane_e)); const int fr = lane_e & 15, fq = lane_e >> 4;
        const int col0 = u.pn * BM + wc * 32 + 8 * fq;
        EPI_ROWS_BEGIN
            bf16_t* rowp = Z + (size_t)row * ZP + col0;
#pragma unroll
            for (int bj = 0; bj < 2; ++bj) { const f32x4 v0 = acc[ai][bj][m][0], v1 = acc[ai][bj][m][1];
                u32x4 w; w.x = cvt_pk_bf16(v0[0], v0[1]); w.y = cvt_pk_bf16(v0[2], v0[3]); w.z = cvt_pk_bf16(v1[0], v1[1]); w.w = cvt_pk_bf16(v1[2], v1[3]);
                *(u32x4*)(rowp + bj * HALF) = w;
                const int hc = 2 * u.pn + bj;
                if (hc < 5) { float s = (v0[0] * v0[0] + v0[1] * v0[1]) + (v0[2] * v0[2] + v0[3] * v0[3]) + (v1[0] * v1[0] + v1[1] * v1[1]) + (v1[2] * v1[2] + v1[3] * v1[3]);
                    s += __shfl_xor(s, 16); s += __shfl_xor(s, 32);
                    if (fq == 0) rssq[(size_t)(hc * 4 + wc) * MTOK + row] = s; } }
        EPI_ROWS_END
    }
};

struct EpiQ {
    static constexpr bool PERM = true;
    bf16_t* Q; const float* rssq;
    __device__ __forceinline__ void operator()(const f32x4 (&acc)[2][2][4][2], const Unit& u, int wr, int wc, int fr_, int fq_) const {
        int lane_e = (int)threadIdx.x & 63; asm volatile("" : "+v"(lane_e)); const int fr = lane_e & 15, fq = lane_e >> 4;
        const int col0 = u.pn * BM + wc * 32 + 8 * fq;
        const float inv[8] = {1.f, 0.316227766f, 0.1f, 0.0316227766f, 0.01f, 0.00316227766f, 0.001f, 0.000316227766f};
        EPI_ROWS_BEGIN
            const float rs = rsqrtf(rss_q(rssq, row) * (1.f / 384.f) + EPS) * QSCALE;
            const int t = (row - MP) & 2047;
#pragma unroll
            for (int bj = 0; bj < 2; ++bj) { const int c = col0 + bj * HALF; const int j0 = c % 96;
                const bool rp = (row >= MP && j0 >= 64);
                const float pos = (float)((j0 < 80) ? (t >> 6) : (t & 63)) * 0.15915494309189535f;
                const float sg = (j0 & 8) ? 1.f : -1.f;
#pragma unroll
                for (int n = 0; n < 2; ++n) {
                    f32x4 v = acc[ai][bj][m][n] * rs;
#pragma unroll
                    for (int i = 0; i < 4; ++i) { const float p = __shfl_xor(v[i], 16);
                        const float rev = pos * inv[4 * n + i]; const float rf = rev - floorf(rev);
                        const float cs = __builtin_amdgcn_cosf(rf), sn = __builtin_amdgcn_sinf(rf); v[i] = rp ? v[i] * cs + sg * p * sn : v[i]; }
                    u32x2 w; w.x = cvt_pk_bf16(v[0], v[1]); w.y = cvt_pk_bf16(v[2], v[3]);
                    *(u32x2*)(Q + (size_t)row * 768 + c + 4 * n) = w; } }
        EPI_ROWS_END
    }
};

struct EpiK {
    static constexpr bool PERM = true;
    bf16_t* Kp; bf16_t* Ks; const float* rsskv; int ctx;
    __device__ __forceinline__ void operator()(const f32x4 (&acc)[2][2][4][2], const Unit& u, int wr, int wc, int fr_, int fq_) const {
        int lane_e = (int)threadIdx.x & 63; asm volatile("" : "+v"(lane_e)); const int fr = lane_e & 15, fq = lane_e >> 4;
        EPI_ROWS_BEGIN
            float rs = 1.f; unsigned off; bool smp;
            if (ctx) { off = ((unsigned)(row >> 8) * 8u * SKS + (row & 255)) * 96u; smp = true; }
            else { rs = rsqrtf(rss_kv(rsskv, row) * (1.f / 256.f) + EPS);
                if (row < MP) { off = ((unsigned)(row >> 8) * 8u * 256u + (row & 255)) * 96u; smp = false; } else { off = ((unsigned)((row - MP) >> 11) * 8u * SKS + 256u + ((row - MP) & 2047)) * 96u; smp = true; } }
            bf16_t* base = smp ? Ks : Kp; const unsigned hs = (smp ? SKS : 256) * 96u;
#pragma unroll
            for (int bj = 0; bj < 2; ++bj) { const unsigned h = 4 * u.pn + 2 * bj + (wc >> 1); const unsigned j = (wc & 1) * 32 + 8 * fq;
                const f32x4 v0 = acc[ai][bj][m][0] * rs, v1 = acc[ai][bj][m][1] * rs;
                u32x4 w; w.x = cvt_pk_bf16(v0[0], v0[1]); w.y = cvt_pk_bf16(v0[2], v0[3]); w.z = cvt_pk_bf16(v1[0], v1[1]); w.w = cvt_pk_bf16(v1[2], v1[3]);
                *(u32x4*)(base + (off + h * hs + j)) = w; }
        EPI_ROWS_END
    }
};

struct EpiVt {
    static constexpr bool PERM = true;
    bf16_t* Vtp; bf16_t* Vts; const float* rsskv; int ctx;
    __device__ __forceinline__ void operator()(const f32x4 (&acc)[2][2][4][2], const Unit& u, int wr, int wc, int fr_, int fq_) const {
        int lane_e = (int)threadIdx.x & 63; asm volatile("" : "+v"(lane_e)); const int fr = lane_e & 15, fq = lane_e >> 4;
#pragma unroll
        for (int bj = 0; bj < 2; ++bj) {
            const int tok = u.pn * BM + bj * HALF + wc * 32 + 8 * fq;
            f32x4 r0 = {1.f, 1.f, 1.f, 1.f}, r1 = {1.f, 1.f, 1.f, 1.f}; unsigned off; bool smp; unsigned S;
            if (ctx) { off = (unsigned)(tok >> 8) * 8u * 64u * SKS + (tok & 255); smp = true; S = SKS; }
            else { f32x4 q0 = {0.f, 0.f, 0.f, 0.f}, q1 = {0.f, 0.f, 0.f, 0.f};
#pragma unroll
                for (int p = 12; p < 20; ++p) { q0 += *(const f32x4*)(rsskv + (size_t)p * MTOK + tok); q1 += *(const f32x4*)(rsskv + (size_t)p * MTOK + tok + 4); }
#pragma unroll
                for (int i = 0; i < 4; ++i) { r0[i] = rsqrtf(q0[i] * (1.f / 256.f) + EPS); r1[i] = rsqrtf(q1[i] * (1.f / 256.f) + EPS); }
                if (tok < MP) { off = (unsigned)(tok >> 8) * 8u * 64u * 256u + (tok & 255); smp = false; S = 256; } else { off = (unsigned)((tok - MP) >> 11) * 8u * 64u * SKS + 256u + ((tok - MP) & 2047); smp = true; S = SKS; } }
            bf16_t* base = smp ? Vts : Vtp;
#pragma unroll
            for (int ai = 0; ai < 2; ++ai)
#pragma unroll
                for (int m = 0; m < 4; ++m) { const unsigned hd = u.pm * BM + wr * 64 + fr + ai * HALF + m * 16;
                    const f32x4 v0 = acc[ai][bj][m][0] * r0, v1 = acc[ai][bj][m][1] * r1;
                    u32x4 w; w.x = cvt_pk_bf16(v0[0], v0[1]); w.y = cvt_pk_bf16(v0[2], v0[3]); w.z = cvt_pk_bf16(v1[0], v1[1]); w.w = cvt_pk_bf16(v1[2], v1[3]);
                    *(u32x4*)(base + (off + hd * S)) = w; }
            asm volatile("" ::: "memory");
        }
    }
};

struct EpiPart {
    static constexpr bool PERM = true;
    float* P0; float* P1;
    __device__ __forceinline__ void operator()(const f32x4 (&acc)[2][2][4][2], const Unit& u, int wr, int wc, int fr_, int fq_) const {
        int lane_e = (int)threadIdx.x & 63; asm volatile("" : "+v"(lane_e)); const int fr = lane_e & 15, fq = lane_e >> 4;
        const int col0 = u.pn * BM + wc * 32 + 8 * fq; float* P = u.ks ? P1 : P0;
        EPI_ROWS_BEGIN
            float* rowp = P + (size_t)row * D + col0;
#pragma unroll
            for (int bj = 0; bj < 2; ++bj) { *(f32x4*)(rowp + bj * HALF) = acc[ai][bj][m][0]; *(f32x4*)(rowp + bj * HALF + 4) = acc[ai][bj][m][1]; }
        EPI_ROWS_END
    }
};

struct EpiFFI {
    static constexpr bool PERM = true;
    bf16_t* H;
    __device__ __forceinline__ void operator()(const f32x4 (&acc)[2][2][4][2], const Unit& u, int wr, int wc, int fr_, int fq_) const {
        int lane_e = (int)threadIdx.x & 63; asm volatile("" : "+v"(lane_e)); const int fr = lane_e & 15, fq = lane_e >> 4;
        const int col0 = u.pn * HALF + wc * 32 + 8 * fq;
        EPI_ROWS_BEGIN
            float o[8];
#pragma unroll
            for (int i = 0; i < 4; ++i) { o[i] = silu_f(acc[ai][0][m][0][i]) * acc[ai][1][m][0][i]; o[4 + i] = silu_f(acc[ai][0][m][1][i]) * acc[ai][1][m][1][i]; }
            u32x4 w; w.x = cvt_pk_bf16(o[0], o[1]); w.y = cvt_pk_bf16(o[2], o[3]); w.z = cvt_pk_bf16(o[4], o[5]); w.w = cvt_pk_bf16(o[6], o[7]);
            *(u32x4*)(H + (size_t)row * DFF + col0) = w;
        EPI_ROWS_END
    }
};
}

struct Args { const float* in[26]; float* out; unsigned char* ws; int ph_lo, ph_hi; };
enum { I_XP = 0, I_XS, I_CKV, I_CKR, I_SF, I_SB, I_C, I_CCTX, I_WADA, I_BADA, I_NATT, I_WIN, I_QN, I_WUQ, I_KVN, I_WUKV, I_WGF, I_BGF, I_WGB, I_BGB, I_GLAN, I_WOUT, I_NFFN, I_WFFI, I_WFFO, I_FN };

__device__ __forceinline__ const float* xrow_ptr(const Args& a, int r) { return r < MP ? a.in[I_XP] + (size_t)r * D : a.in[I_XS] + (size_t)(r - MP) * D; }
__device__ __forceinline__ int cond_of_row(int r) { return r < MP ? 0 : 1 + ((r - MP) >> 11); }

__device__ __forceinline__ void p0_tr(const float* W, int K, int N, bf16_t* WT, bf16_t* WT2, const float* kscale, int kb, int nb, int drow, LAS float* scr, int lane) {
    const int k0 = 64 * kb, n0 = 32 * nb;
#pragma unroll 8
    for (int i = 0; i < 32; ++i) { const int kk = 2 * i + (lane >> 5); scr[kk * 33 + (lane & 31)] = W[(size_t)(k0 + kk) * N + n0 + (lane & 31)]; }
    LDS_WAIT();
    const int c = lane & 7;
    float sc[8];
#pragma unroll
    for (int i = 0; i < 8; ++i) sc[i] = kscale ? kscale[k0 + 8 * c + i] : 1.f;
#pragma unroll
    for (int j = 0; j < 4; ++j) { const int n = (lane >> 3) + 8 * j; const LAS float* s = scr + (8 * c) * 33 + n;
        float v[8];
#pragma unroll
        for (int i = 0; i < 8; ++i) v[i] = s[i * 33];
        if (WT2) { u32x4 o; o.x = cvt_pk_bf16(v[0], v[1]); o.y = cvt_pk_bf16(v[2], v[3]); o.z = cvt_pk_bf16(v[4], v[5]); o.w = cvt_pk_bf16(v[6], v[7]);
            *(u32x4*)(WT2 + (size_t)(drow + n0 + n) * K + k0 + 8 * c) = o; }
        u32x4 o; o.x = cvt_pk_bf16(v[0] * sc[0], v[1] * sc[1]); o.y = cvt_pk_bf16(v[2] * sc[2], v[3] * sc[3]); o.z = cvt_pk_bf16(v[4] * sc[4], v[5] * sc[5]); o.w = cvt_pk_bf16(v[6] * sc[6], v[7] * sc[7]);
        *(u32x4*)(WT + (size_t)(drow + n0 + n) * K + k0 + 8 * c) = o; }
    LDS_WAIT();
}

__device__ __forceinline__ void phase0(const Args& a, int wv, LAS unsigned char* lds, int vcu, int G) {
    const int tid = otid(wv), lane = tid & 63, wave = __builtin_amdgcn_readfirstlane(tid >> 6);
    unsigned char* ws = a.ws;
#ifndef P0MASK
#define P0MASK 7
#endif
    if (P0MASK & 2) {
        LAS float* scr = (LAS float*)(lds + wave * 16384);
        LAS float* scnd = (LAS float*)(lds + 131072);
        for (int i = tid; i < 3072; i += 512) { const int ci = i >> 10, k = i & 1023; scnd[i] = silu_f(ci == 0 ? a.in[I_CCTX][k] : a.in[I_C][(ci - 1) * D + k]); }
        __syncthreads();
        const int gw = vcu * 8 + wave, NGW = G * 8;
        constexpr int T_IN = 16 * 70, T_UQ = 6 * 24, T_UKV = 4 * 32, T_OUT = 16 * 32, T_FFI = 16 * 176, T_FFO = 44 * 32, T_ZERO = 64, T_ADA = 768;
        constexpr int NIT = T_ADA + T_IN + T_UQ + T_UKV + T_OUT + T_FFI + T_FFO + T_ZERO;
        for (int it = gw; it < NIT; it += NGW) {
            int r = it;
            if (r < T_ADA) {
                const int nbq = r >> 2, kq = r & 3; const int n0 = 32 * nbq; const float* W = a.in[I_WADA];
                const int n = lane & 31, hf = lane >> 5; float s0 = 0.f, s1 = 0.f, s2 = 0.f;
                for (int kb = 4 * kq; kb < 4 * kq + 4; ++kb) { const int k0 = 64 * kb;
#pragma unroll 8
                    for (int i = 0; i < 32; ++i) { const int kk = 2 * i + (lane >> 5); scr[kk * 33 + (lane & 31)] = W[(size_t)(k0 + kk) * 6144 + n0 + (lane & 31)]; }
                    LDS_WAIT();
#pragma unroll 8
                    for (int j = 0; j < 32; ++j) { const int kk = hf * 32 + j; const float w = scr[kk * 33 + n];
                        s0 += w * scnd[k0 + kk]; s1 += w * scnd[1024 + k0 + kk]; s2 += w * scnd[2048 + k0 + kk]; }
                    LDS_WAIT(); }
                s0 += __shfl_xor(s0, 32); s1 += __shfl_xor(s1, 32); s2 += __shfl_xor(s2, 32);
                float* MOD = (float*)(ws + WS_MOD) + (size_t)kq * 18432;
                if (hf == 0) { MOD[n0 + n] = s0; MOD[6144 + n0 + n] = s1; MOD[12288 + n0 + n] = s2; }
                continue; } r -= T_ADA;
            if (r < T_FFI) { const int kb = r / 176, nb = r % 176; const int n0 = nb * 32; const int drow = n0 < DFF ? (n0 / 128) * 256 + (n0 % 128) : ((n0 - DFF) / 128) * 256 + 128 + ((n0 - DFF) % 128);
                p0_tr(a.in[I_WFFI], 1024, 5632, (bf16_t*)(ws + WS_WFFI), nullptr, nullptr, kb, nb, drow - n0, scr, lane); continue; } r -= T_FFI;
            if (r < T_FFO) { p0_tr(a.in[I_WFFO], DFF, 1024, (bf16_t*)(ws + WS_WFFO), nullptr, nullptr, r / 32, r % 32, 0, scr, lane); continue; } r -= T_FFO;
            if (r < T_IN) { p0_tr(a.in[I_WIN], 1024, 2240, (bf16_t*)(ws + WS_WIN), nullptr, nullptr, r / 70, r % 70, 0, scr, lane); continue; } r -= T_IN;
            if (r < T_OUT) { p0_tr(a.in[I_WOUT], 1024, 1024, (bf16_t*)(ws + WS_WOUT), nullptr, nullptr, r / 32, r % 32, 0, scr, lane); continue; } r -= T_OUT;
            if (r < T_UQ) { p0_tr(a.in[I_WUQ], 384, 768, (bf16_t*)(ws + WS_WUQ), nullptr, a.in[I_QN], r / 24, r % 24, 0, scr, lane); continue; } r -= T_UQ;
            if (r < T_UKV) { const int nb = r % 32, n0 = nb * 32, hh = n0 >> 7, j0 = n0 & 127; const bool isv = j0 >= 64; const int drow = hh * 64 + (j0 & 63);
                p0_tr(a.in[I_WUKV], 256, 1024, (bf16_t*)(ws + (isv ? WS_WVF : WS_WKF)), (bf16_t*)(ws + (isv ? WS_WVU : WS_WKU)), a.in[I_KVN], r / 32, nb, drow - n0, scr, lane); continue; } r -= T_UKV;
            { u32x4 z = {0u, 0u, 0u, 0u}; u32x4* p = (u32x4*)((bf16_t*)(ws + WS_WIN) + (size_t)(2240 + r) * 1024); p[lane] = z; p[64 + lane] = z; }
        }
    }
    if (P0MASK & 4) {
        const int gt = vcu * 512 + tid, NT = G * 512;
        for (int i = gt; i < 32768; i += NT) { const f32x4 v = ((const f32x4*)a.in[I_CKV])[i]; u32x2 w; w.x = cvt_pk_bf16(v[0], v[1]); w.y = cvt_pk_bf16(v[2], v[3]); ((u32x2*)(ws + WS_CACHEB))[i] = w; }
    }
}

__device__ __forceinline__ f32x4 mod4(const float* modp, const float* bias, int ci, int off) {
    const float* p = modp + ci * 6144 + off;
    return ((*(const f32x4*)p + *(const f32x4*)(p + 18432)) + (*(const f32x4*)(p + 36864) + *(const f32x4*)(p + 55296))) + *(const f32x4*)(bias + off);
}
__device__ __forceinline__ void phase1(const Args& a, int wv, int vcu, int G) {
    if (PROBE_FILL == 3) { float* m = (float*)(a.ws + WS_MOD); for (int i = otid(wv); i < 3 * 6144; i += 512) { unsigned h = (unsigned)i * 2654435761u; h ^= h >> 15; h *= 2246822519u; h ^= h >> 13; m[i] = ((float)(h & 0xffff) * (1.f / 65536.f) - 0.5f) * 2.f; } __syncthreads(); }
    const int tid_ = otid(wv); const int lane = tid_ & 63, wave = tid_ >> 6; const int gw = vcu * 8 + wave, NGW = G * 8;
    const float* mod = (const float*)(a.ws + WS_MOD + PROBE_MODOFF); bf16_t* H = (bf16_t*)(a.ws + WS_H);
    for (int r = gw; r < MTOK; r += NGW * PROBE_RSTRIDE) {
        const f32x4* xr = (const f32x4*)xrow_ptr(a, r) + lane; const int ci_ = cond_of_row(r);
        f32x4 v[4]; float s = 0.f;
#pragma unroll
        for (int j = 0; j < 4; ++j) { v[j] = xr[64 * j]; s += (v[j][0] * v[j][0] + v[j][1] * v[j][1]) + (v[j][2] * v[j][2] + v[j][3] * v[j][3]); }
        const float rstd = rsqrtf(wave_sum(s) * (1.f / D) + EPS);
        u32x2* o = (u32x2*)(H + (size_t)r * D) + lane;
#pragma unroll
        for (int j = 0; j < 4; ++j) { const int c = 4 * lane + 256 * j; const f32x4 w = *(const f32x4*)(a.in[I_NATT] + c), sh = mod4(mod, a.in[I_BADA], ci_, c), scv = mod4(mod, a.in[I_BADA], ci_, 1024 + c);
            const f32x4 y = v[j] * rstd * w * (scv * PROBE_MUL + 1.f) + sh * PROBE_MUL; u32x2 p; p.x = cvt_pk_bf16(y[0], y[1]); p.y = cvt_pk_bf16(y[2], y[3]); if (PROBE_NOSTORE) { if ((p.x ^ p.y) == 0x12345u) o[64 * j] = p; } else o[64 * j] = p; }
    }
}
__device__ __forceinline__ void phase6(const Args& a, int wv, int vcu, int G) {
    const int tid_ = otid(wv); const int lane = tid_ & 63, wave = tid_ >> 6; const int gw = vcu * 8 + wave, NGW = G * 8;
    const float* mod = (const float*)(a.ws + WS_MOD); bf16_t* H = (bf16_t*)(a.ws + WS_H); float* X1 = (float*)(a.ws + WS_X1);
    const float* P0 = (const float*)(a.ws + WS_P0); const float* P1 = (const float*)(a.ws + WS_P1A);
    for (int r = gw; r < MTOK; r += NGW) {
        const f32x4* xr = (const f32x4*)xrow_ptr(a, r) + lane; const int ci_ = cond_of_row(r);
        const f32x4* p0 = (const f32x4*)(P0 + (size_t)r * D) + lane; const f32x4* p1 = (const f32x4*)(P1 + (size_t)r * D) + lane;
        f32x4 v[4]; float s = 0.f;
#pragma unroll
        for (int j = 0; j < 4; ++j) { const int c = 4 * lane + 256 * j; const f32x4 gt = mod4(mod, a.in[I_BADA], ci_, 2048 + c);
            v[j] = xr[64 * j] + gt * (p0[64 * j] + p1[64 * j]); s += (v[j][0] * v[j][0] + v[j][1] * v[j][1]) + (v[j][2] * v[j][2] + v[j][3] * v[j][3]); }
        const float rstd = rsqrtf(wave_sum(s) * (1.f / D) + EPS);
        f32x4* x1 = (f32x4*)(X1 + (size_t)r * D) + lane; u32x2* o = (u32x2*)(H + (size_t)r * D) + lane;
#pragma unroll
        for (int j = 0; j < 4; ++j) { const int c = 4 * lane + 256 * j; x1[64 * j] = v[j];
            const f32x4 w = *(const f32x4*)(a.in[I_NFFN] + c), sh = mod4(mod, a.in[I_BADA], ci_, 3072 + c), scv = mod4(mod, a.in[I_BADA], ci_, 4096 + c);
            const f32x4 y = v[j] * rstd * w * (scv + 1.f) + sh; u32x2 p; p.x = cvt_pk_bf16(y[0], y[1]); p.y = cvt_pk_bf16(y[2], y[3]); o[64 * j] = p; }
    }
}
__device__ __forceinline__ void phase9(const Args& a, int wv, int vcu, int G) {
    const int tid_ = otid(wv); const int lane = tid_ & 63, wave = tid_ >> 6; const int gw = vcu * 8 + wave, NGW = G * 8;
    const float* mod = (const float*)(a.ws + WS_MOD); const float* X1 = (const float*)(a.ws + WS_X1);
    const float* P0 = (const float*)(a.ws + WS_P0); const float* P1 = (const float*)(a.ws + WS_P1B);
    for (int r = gw; r < MTOK; r += NGW) {
        const f32x4* xr = (const f32x4*)(X1 + (size_t)r * D) + lane; const int ci_ = cond_of_row(r);
        const f32x4* p0 = (const f32x4*)(P0 + (size_t)r * D) + lane; const f32x4* p1 = (const f32x4*)(P1 + (size_t)r * D) + lane;
        f32x4 v[4]; float s = 0.f;
#pragma unroll
        for (int j = 0; j < 4; ++j) { const int c = 4 * lane + 256 * j; const f32x4 gt = mod4(mod, a.in[I_BADA], ci_, 5120 + c);
            v[j] = xr[64 * j] + gt * (p0[64 * j] + p1[64 * j]); s += (v[j][0] * v[j][0] + v[j][1] * v[j][1]) + (v[j][2] * v[j][2] + v[j][3] * v[j][3]); }
        const float rstd = rsqrtf(wave_sum(s) * (1.f / D) + EPS);
        f32x4* y = (f32x4*)(a.out + O_Y + (size_t)r * D) + lane;
#pragma unroll
        for (int j = 0; j < 4; ++j) { const int c = 4 * lane + 256 * j; const f32x4 w = *(const f32x4*)(a.in[I_FN] + c); y[64 * j] = v[j] * rstd * w; }
    }
}

__device__ __forceinline__ void p3_row_extras(const Args& a, int wv, int gw, int NGW) {
    const int lane = otid(wv) & 63;
    const bf16_t* Z = (const bf16_t*)(a.ws + WS_Z); const float* rsskv = (const float*)(a.ws + WS_RSSKV);
    bf16_t* Kp = (bf16_t*)(a.ws + WS_KP); bf16_t* Ks = (bf16_t*)(a.ws + WS_KS);
    const float inv[8] = {1.f, 0.316227766f, 0.1f, 0.0316227766f, 0.01f, 0.00316227766f, 0.001f, 0.000316227766f};
    for (int r = gw; r < MTOK + 512; r += NGW) {
        if (r < MTOK) {
            const bf16_t* zr = Z + (size_t)r * ZP;
            if (r < MP) {
                const float rs = rsqrtf(pg8::rss_kv(rsskv, r) * (1.f / 256.f) + EPS);
                const u32x2 w = *(const u32x2*)(zr + C_KVLAT + 4 * lane); const f32x4 g = *(const f32x4*)(a.in[I_KVN] + 4 * lane);
                f32x4 o; o[0] = bflo(w.x) * rs * g[0]; o[1] = bfhi(w.x) * rs * g[1]; o[2] = bflo(w.y) * rs * g[2]; o[3] = bfhi(w.y) * rs * g[3];
                *(f32x4*)(a.out + O_KV + (size_t)r * 256 + 4 * lane) = o;
            }
            const int i = lane & 31;
            float v = bf2f(zr[C_KROPE + i]);
            if (r < MP && lane < 32) a.out[O_KR + (size_t)r * 32 + i] = v;
            const float pv = __shfl_xor(v, 8);
            int b, s; bf16_t* kb;
            if (r >= MP) { const int t = (r - MP) & 2047; const float pos = (float)((i < 16) ? (t >> 6) : (t & 63));
                const float rev = pos * inv[i & 7] * 0.15915494309189535f; const float rf = rev - floorf(rev);
                const float cs = __builtin_amdgcn_cosf(rf), sn = __builtin_amdgcn_sinf(rf); v = v * cs + ((i & 8) ? pv : -pv) * sn;
                b = (r - MP) >> 11; s = 256 + t; kb = Ks + ((size_t)(b * 8) * SKS + s) * 96 + 64 + i;
                const bf16_t o = f2bf(v);
                if (lane < 32) { for (int h = 0; h < 8; ++h) kb[(size_t)h * SKS * 96] = o; }
            } else { b = r >> 8; s = r & 255; kb = Kp + ((size_t)(b * 8) * 256 + s) * 96 + 64 + i; const bf16_t o = f2bf(v);
                if (lane < 32) { for (int h = 0; h < 8; ++h) kb[(size_t)h * 256 * 96] = o; } }
        } else {
            const int rr = r - MTOK, b = rr >> 8, s = rr & 255, i = lane & 31;
            const bf16_t o = f2bf(a.in[I_CKR][(size_t)rr * 32 + i]); bf16_t* kb = Ks + ((size_t)(b * 8) * SKS + s) * 96 + 64 + i;
            if (lane < 32) { for (int h = 0; h < 8; ++h) kb[(size_t)h * SKS * 96] = o; }
        }
    }
}

constexpr int GL_LOW = 0, GL_WG = 8192, GL_BG = 16384, GL_SEG = 16896, GL_RED = 20992, GL_VT = 22528, GL_QF = 40960, GL_KF = GL_QF + 9216, GL_QB = GL_KF + 9216, GL_KB = GL_QB + 9216;
constexpr int GROW = 144;

__device__ __forceinline__ void gla_gates(const Args& a, int wv, LAS unsigned char* lds, int r0, int h, float (&cumF)[8], float (&cumB)[8], float& totF, float& totB) {
    const int tid = otid(wv), d = tid & 63, tg = tid >> 6;
    const bf16_t* Z = (const bf16_t*)(a.ws + WS_Z);
    LAS float* low = (LAS float*)(lds + GL_LOW); LAS float* wg = (LAS float*)(lds + GL_WG); LAS float* bg = (LAS float*)(lds + GL_BG); LAS float* seg = (LAS float*)(lds + GL_SEG);
    { const int t = tid >> 3, r4 = (tid & 7) * 4; const u32x2 w = *(const u32x2*)(Z + (size_t)(r0 + t) * ZP + C_GFL + r4);
      low[t * 32 + r4] = bflo(w.x); low[t * 32 + r4 + 1] = bfhi(w.x); low[t * 32 + r4 + 2] = bflo(w.y); low[t * 32 + r4 + 3] = bfhi(w.y); }
    { const int dir = tid >> 8, r = (tid >> 4) & 15, d4 = (tid & 15) * 4; const f32x4 w = *(const f32x4*)(a.in[dir ? I_WGB : I_WGF] + r * 256 + h * 64 + d4);
      *(LAS f32x4*)(wg + (dir * 16 + r) * 64 + d4) = w; }
    if (tid < 128) { const int dir = tid >> 6; bg[tid] = a.in[dir ? I_BGB : I_BGF][h * 64 + (tid & 63)]; }
    __syncthreads();
    float wf[16], wb[16];
#pragma unroll
    for (int r = 0; r < 16; ++r) { wf[r] = wg[r * 64 + d]; wb[r] = wg[(16 + r) * 64 + d]; }
    const float bf_ = bg[d], bb_ = bg[64 + d];
    float gf[8], gb[8];
#pragma unroll
    for (int i = 0; i < 8; ++i) { const int t = tg * 8 + i; float xf = bf_, xb = bb_;
#pragma unroll
        for (int r = 0; r < 16; ++r) { xf += low[t * 32 + r] * wf[r]; xb += low[t * 32 + 16 + r] * wb[r]; }
        gf[i] = logsigmoid_f(xf) * (1.f / 16.f); gb[i] = logsigmoid_f(xb) * (1.f / 16.f); }
#pragma unroll
    for (int i = 1; i < 8; ++i) gf[i] += gf[i - 1];
#pragma unroll
    for (int i = 6; i >= 0; --i) gb[i] += gb[i + 1];
    seg[tg * 64 + d] = gf[7]; seg[512 + tg * 64 + d] = gb[0];
    __syncthreads();
    float offF = 0.f, offB = 0.f; totF = 0.f; totB = 0.f;
#pragma unroll
    for (int g = 0; g < 8; ++g) { const float sf = seg[g * 64 + d], sb = seg[512 + g * 64 + d]; totF += sf; totB += sb; if (g < tg) offF += sf; if (g > tg) offB += sb; }
#pragma unroll
    for (int i = 0; i < 8; ++i) { cumF[i] = gf[i] + offF; cumB[i] = gb[i] + offB; }
}
__device__ __forceinline__ void gla_load_vT(const Args& a, int wv, LAS unsigned char* lds, int r0, int h) {
    const int tid = otid(wv), e = tid & 127, tq = tid >> 7;
    const bf16_t* Z = (const bf16_t*)(a.ws + WS_Z) + (size_t)r0 * ZP + C_GV + h * 128 + e;
    unsigned w[8];
#pragma unroll
    for (int i = 0; i < 8; ++i) { const unsigned lo = Z[(size_t)(tq * 16 + 2 * i) * ZP], hi = Z[(size_t)(tq * 16 + 2 * i + 1) * ZP]; w[i] = lo | (hi << 16); }
    LAS u32x4* p = (LAS u32x4*)(lds + GL_VT + e * GROW + tq * 32);
    p[0] = (u32x4){w[0], w[1], w[2], w[3]}; p[1] = (u32x4){w[4], w[5], w[6], w[7]};
}

__device__ __forceinline__ void gla_stepA(const Args& a, int wv, LAS unsigned char* lds, int u) {
    const int tid = otid(wv), lane = tid & 63, wave = __builtin_amdgcn_readfirstlane(tid >> 6), d = tid & 63, tg = tid >> 6, fr = lane & 15, fq = lane >> 4;
    const int cgi = u >> 2, h = u & 3, r0 = cgi * 64;
    const bf16_t* Z = (const bf16_t*)(a.ws + WS_Z);
    float cumF[8], cumB[8], totF, totB;
    gla_gates(a, wv, lds, r0, h, cumF, cumB, totF, totB);
    unsigned kf[4], kb[4];
#pragma unroll
    for (int i = 0; i < 4; ++i) { const float k0 = bf2f(Z[(size_t)(r0 + tg * 8 + 2 * i) * ZP + C_GK + h * 64 + d]), k1 = bf2f(Z[(size_t)(r0 + tg * 8 + 2 * i + 1) * ZP + C_GK + h * 64 + d]);
        kf[i] = cvt_pk_bf16(k0 * __expf(totF - cumF[2 * i]), k1 * __expf(totF - cumF[2 * i + 1]));
        kb[i] = cvt_pk_bf16(k0 * __expf(totB - cumB[2 * i]), k1 * __expf(totB - cumB[2 * i + 1])); }
    *(LAS u32x4*)(lds + GL_QF + d * GROW + tg * 16) = (u32x4){kf[0], kf[1], kf[2], kf[3]};
    *(LAS u32x4*)(lds + GL_KF + d * GROW + tg * 16) = (u32x4){kb[0], kb[1], kb[2], kb[3]};
    gla_load_vT(a, wv, lds, r0, h);
    if (tg == 0) { float* dec = (float*)(a.ws + WS_DEC) + (size_t)u * 128; dec[d] = __expf(totF); dec[64 + d] = __expf(totB); }
    __syncthreads();
    const int dir = wave >> 2, eb0 = 2 * (wave & 3);
    const LAS unsigned char* kd = lds + (dir ? GL_KF : GL_QF);
    float* CT = (float*)(a.ws + WS_CT) + ((size_t)u * 2 + dir) * 8192;
#pragma unroll
    for (int eb = 0; eb < 2; ++eb) {
        bf16x8 vf[2];
#pragma unroll
        for (int ks = 0; ks < 2; ++ks) vf[ks] = *(const LAS bf16x8*)(lds + GL_VT + (16 * (eb0 + eb) + fr) * GROW + (32 * ks + 8 * fq) * 2);
#pragma unroll
        for (int db = 0; db < 4; ++db) { f32x4 c = {0.f, 0.f, 0.f, 0.f};
#pragma unroll
            for (int ks = 0; ks < 2; ++ks) { const bf16x8 kfr = *(const LAS bf16x8*)(kd + (16 * db + fr) * GROW + (32 * ks + 8 * fq) * 2); c = __builtin_amdgcn_mfma_f32_16x16x32_bf16(vf[ks], kfr, c, 0, 0, 0); }
#pragma unroll
            for (int j = 0; j < 4; ++j) CT[(16 * (eb0 + eb) + 4 * fq + j) * 64 + 16 * db + fr] = c[j]; }
    }
    __syncthreads();
}

__device__ __forceinline__ void gla_scan(const Args& a, int wv, int vcu, int G) {
    const int gt = vcu * 512 + otid(wv), NT = G * 512;
    float* CTb = (float*)(a.ws + WS_CT); const float* DEC = (const float*)(a.ws + WS_DEC);
    for (int it = gt; it < 32768 + 262144; it += NT) {
        int seq, N, cg0, x;
        if (it < 32768) { seq = 16 + (it >> 14); x = it & 16383; N = 32; cg0 = 64 + 32 * (seq - 16); } else { const int j = it - 32768; seq = j >> 14; x = j & 16383; N = 4; cg0 = 4 * seq; }
        const int h = x >> 12, dir = (x >> 11) & 1, e = (x >> 4) & 127, d4 = (x & 15) * 4;
        f32x4 st = {0.f, 0.f, 0.f, 0.f};
        if (seq >= 16) { const float* s0 = a.in[dir ? I_SB : I_SF] + ((size_t)((seq - 16) * 4 + h) * 64) * 128 + e;
#pragma unroll
            for (int i = 0; i < 4; ++i) st[i] = s0[(size_t)(d4 + i) * 128]; }
        for (int n0 = 0; n0 < N; n0 += 4) {
            f32x4 c[4], dc[4];
#pragma unroll
            for (int i = 0; i < 4; ++i) { const int n = dir ? (N - 1 - n0 - i) : (n0 + i); const int u = (cg0 + n) * 4 + h;
                c[i] = *(const f32x4*)(CTb + ((size_t)u * 2 + dir) * 8192 + e * 64 + d4); dc[i] = *(const f32x4*)(DEC + (size_t)u * 128 + dir * 64 + d4); }
#pragma unroll
            for (int i = 0; i < 4; ++i) { const int n = dir ? (N - 1 - n0 - i) : (n0 + i); const int u = (cg0 + n) * 4 + h;
                *(f32x4*)(CTb + ((size_t)u * 2 + dir) * 8192 + e * 64 + d4) = st; st = dc[i] * st + c[i]; }
        }
        if (seq < 16) { float* o = a.out + (dir ? O_SB : O_SF) + ((size_t)(seq * 4 + h) * 64) * 128 + e;
#pragma unroll
            for (int i = 0; i < 4; ++i) o[(size_t)(d4 + i) * 128] = st[i]; }
    }
}

__device__ __forceinline__ void gla_stepC(const Args& a, int wv, LAS unsigned char* lds, int u) {
    const int tid = otid(wv), lane = tid & 63, wave = __builtin_amdgcn_readfirstlane(tid >> 6), d = tid & 63, tg = tid >> 6, fr = lane & 15, fq = lane >> 4;
    const int cgi = u >> 2, h = u & 3, r0 = cgi * 64;
    const bf16_t* Z = (const bf16_t*)(a.ws + WS_Z);
    float cumF[8], cumB[8], totF, totB;
    gla_gates(a, wv, lds, r0, h, cumF, cumB, totF, totB);
#pragma unroll
    for (int i = 0; i < 8; ++i) { const int t = tg * 8 + i; const float q = bf2f(Z[(size_t)(r0 + t) * ZP + C_GQ + h * 64 + d]) * 0.125f, k = bf2f(Z[(size_t)(r0 + t) * ZP + C_GK + h * 64 + d]);
        *(LAS bf16_t*)(lds + GL_QF + t * GROW + d * 2) = f2bf(q * __expf(cumF[i]));
        *(LAS bf16_t*)(lds + GL_KF + t * GROW + d * 2) = f2bf(k * __expf(-cumF[i]));
        *(LAS bf16_t*)(lds + GL_QB + t * GROW + d * 2) = f2bf(q * __expf(cumB[i]));
        *(LAS bf16_t*)(lds + GL_KB + t * GROW + d * 2) = f2bf(k * __expf(-cumB[i])); }
    gla_load_vT(a, wv, lds, r0, h);
    __syncthreads();
    const int ch = wave & 1, eq = wave >> 1;
    f32x4 oT[2][2];
#pragma unroll
    for (int i = 0; i < 2; ++i)
#pragma unroll
        for (int j = 0; j < 2; ++j) oT[i][j] = (f32x4){0.f, 0.f, 0.f, 0.f};
#pragma unroll
    for (int dir = 0; dir < 2; ++dir) {
        const LAS unsigned char* qe = lds + (dir ? GL_QB : GL_QF); const LAS unsigned char* ke = lds + (dir ? GL_KB : GL_KF);
        const float* ST = (const float*)(a.ws + WS_CT) + ((size_t)u * 2 + dir) * 8192;
        bf16x8 sf[2][2];
#pragma unroll
        for (int eb = 0; eb < 2; ++eb)
#pragma unroll
            for (int ks = 0; ks < 2; ++ks) { const float* p = ST + (16 * (2 * eq + eb) + fr) * 64 + 32 * ks + 8 * fq; const f32x4 x0 = *(const f32x4*)p, x1 = *(const f32x4*)(p + 4);
                u32x4 w; w.x = cvt_pk_bf16(x0[0], x0[1]); w.y = cvt_pk_bf16(x0[2], x0[3]); w.z = cvt_pk_bf16(x1[0], x1[1]); w.w = cvt_pk_bf16(x1[2], x1[3]); sf[eb][ks] = __builtin_bit_cast(bf16x8, w); }
#pragma unroll
        for (int cb = 0; cb < 2; ++cb) {
            const int cbg = 2 * ch + cb;
            bf16x8 qf[2];
#pragma unroll
            for (int ks = 0; ks < 2; ++ks) qf[ks] = *(const LAS bf16x8*)(qe + (16 * cbg + fr) * GROW + (32 * ks + 8 * fq) * 2);
            f32x4 att[4];
#pragma unroll
            for (int sb = 0; sb < 4; ++sb) {
                f32x4 acc = {0.f, 0.f, 0.f, 0.f};
                const bool need = dir == 0 ? (sb <= cbg) : (sb >= cbg);
                if (need) {
#pragma unroll
                    for (int ks = 0; ks < 2; ++ks) { const bf16x8 kfr = *(const LAS bf16x8*)(ke + (16 * sb + fr) * GROW + (32 * ks + 8 * fq) * 2); acc = __builtin_amdgcn_mfma_f32_16x16x32_bf16(kfr, qf[ks], acc, 0, 0, 0); }
                    if (sb == cbg) {
#pragma unroll
                        for (int j = 0; j < 4; ++j) { const int sl = 4 * fq + j; const bool keep = dir == 0 ? (sl <= fr) : (sl >= fr); acc[j] = keep ? acc[j] : 0.f; } }
                }
                att[sb] = acc;
            }
#pragma unroll
            for (int kp = 0; kp < 2; ++kp) {
                u32x4 w; w.x = cvt_pk_bf16(att[2 * kp][0], att[2 * kp][1]); w.y = cvt_pk_bf16(att[2 * kp][2], att[2 * kp][3]); w.z = cvt_pk_bf16(att[2 * kp + 1][0], att[2 * kp + 1][1]); w.w = cvt_pk_bf16(att[2 * kp + 1][2], att[2 * kp + 1][3]);
                const bf16x8 pb = __builtin_bit_cast(bf16x8, w);
#pragma unroll
                for (int eb = 0; eb < 2; ++eb) { const LAS unsigned char* vp = lds + GL_VT + (16 * (2 * eq + eb) + fr) * GROW + (32 * kp + 4 * fq) * 2;
                    const u32x2 v0 = *(const LAS u32x2*)vp, v1 = *(const LAS u32x2*)(vp + 32); const u32x4 vv = {v0.x, v0.y, v1.x, v1.y};
                    oT[eb][cb] = __builtin_amdgcn_mfma_f32_16x16x32_bf16(__builtin_bit_cast(bf16x8, vv), pb, oT[eb][cb], 0, 0, 0); }
            }
#pragma unroll
            for (int ks = 0; ks < 2; ++ks)
#pragma unroll
                for (int eb = 0; eb < 2; ++eb) oT[eb][cb] = __builtin_amdgcn_mfma_f32_16x16x32_bf16(sf[eb][ks], qf[ks], oT[eb][cb], 0, 0, 0);
        }
    }
    LAS float* red = (LAS float*)(lds + GL_RED);
#pragma unroll
    for (int cb = 0; cb < 2; ++cb) { float s = 0.f;
#pragma unroll
        for (int eb = 0; eb < 2; ++eb)
#pragma unroll
            for (int j = 0; j < 4; ++j) s += oT[eb][cb][j] * oT[eb][cb][j];
        s += __shfl_xor(s, 16); s += __shfl_xor(s, 32);
        if (fq == 0) red[eq * 64 + 16 * (2 * ch + cb) + fr] = s; }
    __syncthreads();
    bf16_t* MIX = (bf16_t*)(a.ws + WS_MIX);
#pragma unroll
    for (int cb = 0; cb < 2; ++cb) { const int c = 16 * (2 * ch + cb) + fr; const float tot = red[c] + red[64 + c] + red[128 + c] + red[192 + c]; const float rstd = rsqrtf(tot * (1.f / 128.f) + EPS);
#pragma unroll
        for (int eb = 0; eb < 2; ++eb) { const int e = 16 * (2 * eq + eb) + 4 * fq; const f32x4 gn = *(const f32x4*)(a.in[I_GLAN] + e);
            const u32x2 gw = *(const u32x2*)(Z + (size_t)(r0 + c) * ZP + C_GOUT + h * 128 + e);
            const float g0 = bflo(gw.x), g1 = bfhi(gw.x), g2 = bflo(gw.y), g3 = bfhi(gw.y);
            const f32x4 o = oT[eb][cb] * rstd * gn; u32x2 w; w.x = cvt_pk_bf16(o[0] * silu_f(g0), o[1] * silu_f(g1)); w.y = cvt_pk_bf16(o[2] * silu_f(g2), o[3] * silu_f(g3));
            *(u32x2*)(MIX + (size_t)(r0 + c) * D + 512 + h * 128 + e) = w; } }
    __syncthreads();
}

constexpr int AT_KROW = 208, AT_VROW = 144, AT_KB = 64 * AT_KROW  , AT_STAGE = AT_KB + 64 * AT_VROW  ;
__device__ __forceinline__ void attn_unit(const Args& a, int wv, LAS unsigned char* lds, int idx) {
    const int tid = otid(wv), lane = tid & 63, wave = __builtin_amdgcn_readfirstlane(tid >> 6), fr = lane & 15, fq = lane >> 4;
    int row0, S, nt; const bf16_t* Kb; const bf16_t* Vb; int h;
    if (idx < 256) { const int b = idx >> 7, qb = idx & 15; h = (idx >> 4) & 7; row0 = MP + b * 2048 + qb * 128; S = SKS; nt = 36;
        Kb = (const bf16_t*)(a.ws + WS_KS) + (size_t)(b * 8 + h) * SKS * 96; Vb = (const bf16_t*)(a.ws + WS_VTS) + (size_t)(b * 8 + h) * 64 * SKS; }
    else { const int j = idx - 256; const int b = j >> 4, qb = j & 1; h = (j >> 1) & 7; row0 = b * 256 + qb * 128; S = 256; nt = 4;
        Kb = (const bf16_t*)(a.ws + WS_KP) + (size_t)(b * 8 + h) * 256 * 96; Vb = (const bf16_t*)(a.ws + WS_VTP) + (size_t)(b * 8 + h) * 64 * 256; }
    const char* src[3]; unsigned step[3]; unsigned dst[3]; bool valid[3];
#pragma unroll
    for (int j = 0; j < 3; ++j) { const int ins = wave + 8 * j; valid[j] = ins < 22;
        if (ins < 13) { const int ck = ins * 64 + lane, r = ck / 13, cc = ck % 13; src[j] = (const char*)Kb + (size_t)r * 192 + (cc < 12 ? cc : 11) * 16; step[j] = 64 * 192; dst[j] = ins * 1024; }
        else { const int cv = (ins - 13) * 64 + lane, r = cv / 9, cc = cv % 9; src[j] = (const char*)Vb + (size_t)r * S * 2 + (cc < 8 ? cc : 7) * 16; step[j] = 128; dst[j] = AT_KB + (ins - 13) * 1024; } }
#define AT_ISSUE(t, buf) do { _Pragma("unroll") for (int j = 0; j < 3; ++j) if (valid[j]) \
        __builtin_amdgcn_global_load_lds((const unsigned*)(src[j] + (size_t)(t) * step[j]), (LAS unsigned*)(lds + (buf) * AT_STAGE + dst[j]), 16, 0, 0); } while (0)
    AT_ISSUE(0, 0);
    const bf16_t* Q = (const bf16_t*)(a.ws + WS_Q) + (size_t)(row0 + wave * 16 + fr) * 768 + h * 96 + 8 * fq;
    bf16x8 qf[3];
#pragma unroll
    for (int ks = 0; ks < 3; ++ks) qf[ks] = *(const bf16x8*)(Q + 32 * ks);
    float mrun = -1e30f, lsum = 0.f;
    f32x4 o[4];
#pragma unroll
    for (int i = 0; i < 4; ++i) o[i] = (f32x4){0.f, 0.f, 0.f, 0.f};
    for (int t = 0; t < nt; ++t) {
        VM_WAIT(); __syncthreads();
        if (t + 1 < nt) AT_ISSUE(t + 1, (t + 1) & 1);
        const LAS unsigned char* kt = lds + (t & 1) * AT_STAGE; const LAS unsigned char* vt = kt + AT_KB;
        f32x4 s[4];
#pragma unroll
        for (int kb = 0; kb < 4; ++kb) { s[kb] = (f32x4){0.f, 0.f, 0.f, 0.f};
#pragma unroll
            for (int ks = 0; ks < 3; ++ks) { const bf16x8 kf = *(const LAS bf16x8*)(kt + (16 * kb + fr) * AT_KROW + (32 * ks + 8 * fq) * 2); s[kb] = __builtin_amdgcn_mfma_f32_16x16x32_bf16(kf, qf[ks], s[kb], 0, 0, 0); } }
        float mx = fmaxf(fmaxf(fmaxf(s[0][0], s[0][1]), fmaxf(s[0][2], s[0][3])), fmaxf(fmaxf(s[1][0], s[1][1]), fmaxf(s[1][2], s[1][3])));
        mx = fmaxf(mx, fmaxf(fmaxf(fmaxf(s[2][0], s[2][1]), fmaxf(s[2][2], s[2][3])), fmaxf(fmaxf(s[3][0], s[3][1]), fmaxf(s[3][2], s[3][3]))));
        mx = fmaxf(mx, __shfl_xor(mx, 16)); mx = fmaxf(mx, __shfl_xor(mx, 32));
        const float mnew = fmaxf(mrun, mx); const float alpha = __builtin_amdgcn_exp2f(mrun - mnew); mrun = mnew;
        float ps = 0.f;
#pragma unroll
        for (int kb = 0; kb < 4; ++kb)
#pragma unroll
            for (int j = 0; j < 4; ++j) { s[kb][j] = __builtin_amdgcn_exp2f(s[kb][j] - mnew); ps += s[kb][j]; }
        lsum = lsum * alpha + ps;
#pragma unroll
        for (int i = 0; i < 4; ++i) o[i] = o[i] * alpha;
#pragma unroll
        for (int kp = 0; kp < 2; ++kp) {
            u32x4 w; w.x = cvt_pk_bf16(s[2 * kp][0], s[2 * kp][1]); w.y = cvt_pk_bf16(s[2 * kp][2], s[2 * kp][3]); w.z = cvt_pk_bf16(s[2 * kp + 1][0], s[2 * kp + 1][1]); w.w = cvt_pk_bf16(s[2 * kp + 1][2], s[2 * kp + 1][3]);
            const bf16x8 pb = __builtin_bit_cast(bf16x8, w);
#pragma unroll
            for (int mb = 0; mb < 4; ++mb) { const LAS unsigned char* vp = vt + (16 * mb + fr) * AT_VROW + (32 * kp + 4 * fq) * 2;
                const u32x2 v0 = *(const LAS u32x2*)vp, v1 = *(const LAS u32x2*)(vp + 32); const u32x4 vv = {v0.x, v0.y, v1.x, v1.y};
                o[mb] = __builtin_amdgcn_mfma_f32_16x16x32_bf16(__builtin_bit_cast(bf16x8, vv), pb, o[mb], 0, 0, 0); }
        }
    }
    lsum += __shfl_xor(lsum, 16); lsum += __shfl_xor(lsum, 32);
    const float il = fast_rcp(lsum);
    bf16_t* MIX = (bf16_t*)(a.ws + WS_MIX) + (size_t)(row0 + wave * 16 + fr) * D + h * 64 + 4 * fq;
#pragma unroll
    for (int mb = 0; mb < 4; ++mb) { u32x2 w; w.x = cvt_pk_bf16(o[mb][0] * il, o[mb][1] * il); w.y = cvt_pk_bf16(o[mb][2] * il, o[mb][3] * il); *(u32x2*)(MIX + 16 * mb) = w; }
    __syncthreads();
#undef AT_ISSUE
}

__device__ unsigned g_bar[128];
__device__ __forceinline__ void my_grid_barrier(unsigned* ctr, unsigned nth, unsigned G, int wv, LAS unsigned* sbase) {
    asm volatile("s_waitcnt vmcnt(0) lgkmcnt(0)" ::: "memory");
    __syncthreads();
    if (otid(wv) == 0) {
        __builtin_amdgcn_fence(__ATOMIC_RELEASE, "agent");
        asm volatile("s_waitcnt vmcnt(0)" ::: "memory");
        const unsigned old = __hip_atomic_fetch_add(ctr, 1u, __ATOMIC_RELAXED, __HIP_MEMORY_SCOPE_AGENT);
        if (nth == 1u) sbase[0] = old >= 0xAAAAAAAAu ? 0xAAAAAAAAu : 0u;
        const unsigned target = sbase[0] + G * nth;
        while (__hip_atomic_load(ctr, __ATOMIC_RELAXED, __HIP_MEMORY_SCOPE_AGENT) < target) __builtin_amdgcn_s_sleep(2);
        __builtin_amdgcn_fence(__ATOMIC_ACQUIRE, "agent");
        asm volatile("s_waitcnt vmcnt(0)" ::: "memory");
    }
    __syncthreads();
    __builtin_amdgcn_fence(__ATOMIC_ACQUIRE, "agent");
    asm volatile("s_waitcnt vmcnt(0)" ::: "memory");
}
__device__ __forceinline__ void my_grid_barrier_finish(unsigned* ctr, unsigned G, int wv) {
    if (otid(wv) == 0) {
        const unsigned old = __hip_atomic_fetch_add(ctr + 64, 1u, __ATOMIC_RELAXED, __HIP_MEMORY_SCOPE_AGENT);
        const unsigned base = old >= 0xAAAAAAAAu ? 0xAAAAAAAAu : 0u;
        if (old - base == G - 1u) { __hip_atomic_store(ctr, 0u, __ATOMIC_RELAXED, __HIP_MEMORY_SCOPE_AGENT); __hip_atomic_store(ctr + 64, 0u, __ATOMIC_RELAXED, __HIP_MEMORY_SCOPE_AGENT); }
    }
}
__device__ __forceinline__ void dbg_stat(unsigned char* ws, int wv, LAS unsigned char* lds, const void* buf, int is_bf16, size_t n, int slot) {
    const int tid = otid(wv); float ss = 0.f; float bad = 0.f;
    for (size_t i = tid; i < n; i += 512) { const float v = is_bf16 ? bf2f(((const bf16_t*)buf)[i]) : ((const float*)buf)[i];
        if (!(fabsf(v) < 1e30f)) bad += 1.f; else ss += v * v; }
    ss = wave_sum(ss); bad = wave_sum(bad);
    LAS float* red = (LAS float*)(lds + 1024);
    __syncthreads();
    if ((tid & 63) == 0) { red[(tid >> 6) * 2] = ss; red[(tid >> 6) * 2 + 1] = bad; }
    __syncthreads();
    if (tid == 0) { float a0 = 0.f, b0 = 0.f; for (int w = 0; w < 8; ++w) { a0 += red[2 * w]; b0 += red[2 * w + 1]; }
        float* d = (float*)(ws + (30u << 20)); d[slot * 2] = sqrtf(a0 / (float)n) * 1000.f; d[slot * 2 + 1] = b0; }
    __syncthreads();
}
constexpr int NPHASE = 11;
__global__ void __launch_bounds__(512, 2) mk_fwd(Args a) {
    const int wv = __builtin_amdgcn_readfirstlane((int)threadIdx.x >> 6);
    extern __shared__ __attribute__((aligned(16))) unsigned char lds_raw[];
    LAS unsigned char* lds = (LAS unsigned char*)lds_raw;
    const int G = gridDim.x, bx = blockIdx.x;
    const int vcu = (G % 8 == 0) ? (bx % 8) * (G / 8) + bx / 8 : bx;
    unsigned char* ws = a.ws;
    const int lo = a.ph_lo, hi = a.ph_hi;
#ifndef PHMASK
#define PHMASK 0x7ff
#endif
#define IN(k) (((PHMASK >> (k)) & 1) && lo <= (k) && (k) < hi)
#define SEAM(k) do { if (IN(k) && IN((k) + 1)) { ++nbar; my_grid_barrier(g_bar, nbar, (unsigned)G, wv, (LAS unsigned*)(lds + LDS_BYTES - 64)); } } while (0)
#ifndef PROBE_FILL
#define PROBE_FILL 0
#endif
    if (PROBE_FILL && lo == 0) { f32x4* p = (f32x4*)a.ws; const size_t n = (size_t)(PROBE_FILL_MIB) << 16; const float fv = PROBE_FILL_VAL;
        for (size_t i = (size_t)bx * 512 + threadIdx.x; i < n; i += (size_t)G * 512) { unsigned h = (unsigned)i * 2654435761u; h ^= h >> 15; h *= 2246822519u; h ^= h >> 13; const float r0 = (float)(h & 0xffff) * (1.f / 65536.f) - 0.5f + fv * 0.f; p[i] = (f32x4){r0, r0 * 1.7f, r0 * -0.3f, r0 + 0.1f}; } }
    if (PROBE_FILL == 2 && lo == 0 && bx == 0) { static const int szs[26] = {4194304, 4194304, 131072, 16384, 65536, 65536, 2048, 1024, 6291456, 6144, 1024, 2293760, 384, 294912, 256, 262144, 4096, 256, 4096, 256, 128, 1048576, 1024, 5767168, 2883584, 1024};
        float sm = 0.f; for (int i = 0; i < 26; ++i) { const int n = szs[i]; const int st = n > 1024 ? n - 1024 : 0; for (int j = st + (int)threadIdx.x; j < n; j += 512) sm += a.in[i][j]; for (int j = threadIdx.x; j < (n < 1024 ? n : 1024); j += 512) sm += a.in[i][j]; }
        ((float*)(a.ws))[threadIdx.x] = sm; }
    if (PROBE_FILL == 5 && lo == 0) { volatile float* p = (volatile float*)a.ws; const float big = p[0] * 0.f + 1e38f, tiny = p[1] * 0.f + 1e-38f, zero = p[2] * 0.f, neg = p[3] * 0.f - 1.f;
        float r = 0.f;
#if PROBE_EXC & 1
        r += big * big;
#endif
#if PROBE_EXC & 2
        r += tiny * tiny;
#endif
#if PROBE_EXC & 4
        r += 1.f / zero;
#endif
#if PROBE_EXC & 8
        r += __builtin_sqrtf(neg);
#endif
        p[4 + bx] = r; }
    unsigned nbar = 0;
    if (IN(0)) { phase0(a, wv, lds, vcu, G); } SEAM(0);
    if (IN(1) && bx >= PROBE_BLO && bx < PROBE_BHI && (bx & 7) >= PROBE_XLO && (bx & 7) < PROBE_XHI) { for (int rep = 0; rep < PROBE_REP; ++rep) phase1(a, wv, vcu, G); } SEAM(1);
    if (PROBE_HANG && lo == 1) { volatile unsigned* q = (volatile unsigned*)(a.ws + 8); while (*q != 0x12345678u) __builtin_amdgcn_s_sleep(20); }
    if (IN(2)) {
        pg8::Gemm g{(const bf16_t*)(ws + WS_H), (const bf16_t*)(ws + WS_WIN), D, D, D, wv}; pg8::Order S; S.init(MTOK, ZP, 1, G, bx);
        pg8::EpiZ E{(bf16_t*)(ws + WS_Z), (float*)(ws + WS_RSSQ), (float*)(ws + WS_RSSKV)};
        pg8::gemm_phase<pg8::EpiZ, pg8::Order>(lds, g, S, E);
    } SEAM(2);
    if (PROBE_STATS && bx == 0 && IN(3)) dbg_stat(ws, wv, lds, ws + WS_Z, 1, (size_t)256 * ZP, 0);
    if (IN(3)) {
#ifndef P3MASK
#define P3MASK 0x3f
#endif
#if (P3MASK >> 0) & 1
        { pg8::Gemm g{(const bf16_t*)(ws + WS_Z) + C_QLAT, (const bf16_t*)(ws + WS_WUQ), ZP, 384, 384, wv}; pg8::Order S; S.init(MTOK, 768, 1, G, bx);
          pg8::EpiQ E{(bf16_t*)(ws + WS_Q), (const float*)(ws + WS_RSSQ)}; pg8::gemm_phase<pg8::EpiQ, pg8::Order>(lds, g, S, E); }
#endif
#if (P3MASK >> 1) & 1
        { pg8::Gemm g{(const bf16_t*)(ws + WS_Z) + C_KVLAT, (const bf16_t*)(ws + WS_WKF), ZP, 256, 256, wv}; pg8::Order S; S.init(MTOK, 512, 1, G, (bx + G - 96) % G);
          pg8::EpiK E{(bf16_t*)(ws + WS_KP), (bf16_t*)(ws + WS_KS), (const float*)(ws + WS_RSSKV), 0}; pg8::gemm_phase<pg8::EpiK, pg8::Order>(lds, g, S, E); }
#endif
#if (P3MASK >> 2) & 1
        { pg8::Gemm g{(const bf16_t*)(ws + WS_WVF), (const bf16_t*)(ws + WS_Z) + C_KVLAT, 256, ZP, 256, wv}; pg8::Order S; S.init(512, MTOK, 1, G, (bx + G - 160) % G);
          pg8::EpiVt E{(bf16_t*)(ws + WS_VTP), (bf16_t*)(ws + WS_VTS), (const float*)(ws + WS_RSSKV), 0}; pg8::gemm_phase<pg8::EpiVt, pg8::Order>(lds, g, S, E); }
#endif
#if (P3MASK >> 3) & 1
        { pg8::Gemm g{(const bf16_t*)(ws + WS_CACHEB), (const bf16_t*)(ws + WS_WKU), 256, 256, 256, wv}; pg8::Order S; S.init(512, 512, 1, G, (bx + G - 224) % G);
          pg8::EpiK E{(bf16_t*)(ws + WS_KP), (bf16_t*)(ws + WS_KS), (const float*)(ws + WS_RSSKV), 1}; pg8::gemm_phase<pg8::EpiK, pg8::Order>(lds, g, S, E); }
#endif
#if (P3MASK >> 4) & 1
        { pg8::Gemm g{(const bf16_t*)(ws + WS_WVU), (const bf16_t*)(ws + WS_CACHEB), 256, 256, 256, wv}; pg8::Order S; S.init(512, 512, 1, G, (bx + G - 228) % G);
          pg8::EpiVt E{(bf16_t*)(ws + WS_VTP), (bf16_t*)(ws + WS_VTS), (const float*)(ws + WS_RSSKV), 1}; pg8::gemm_phase<pg8::EpiVt, pg8::Order>(lds, g, S, E); }
#endif
        __syncthreads();
        const int c2 = (bx + G - 232) % G;
#if (P3MASK >> 5) & 1
        for (int u = c2; u < 512; u += G) gla_stepA(a, wv, lds, u);
#endif
        p3_row_extras(a, wv, c2 * 8 + (otid(wv) >> 6), G * 8);
    } SEAM(3);
    if (IN(4)) { gla_scan(a, wv, vcu, G); } SEAM(4);
    if (IN(5)) {
        for (int u = vcu; u < 512; u += G) attn_unit(a, wv, lds, u);
        for (int u = vcu; u < 512; u += G) gla_stepC(a, wv, lds, u);
    } SEAM(5);
    if (PROBE_STATS && bx == 0 && IN(6)) dbg_stat(ws, wv, lds, ws + WS_MIX, 1, (size_t)8192 * D, 1);
    if (IN(6)) {
        pg8::Gemm g{(const bf16_t*)(ws + WS_MIX), (const bf16_t*)(ws + WS_WOUT), D, D, PROBE_K6, wv}; pg8::Order S; S.init(MTOK, D, 1024 / PROBE_K6, G, bx);
        pg8::EpiPart E{(float*)(ws + WS_P0), (float*)(ws + WS_P1A)}; pg8::gemm_phase<pg8::EpiPart, pg8::Order>(lds, g, S, E);
    } SEAM(6);
    if (IN(7)) { phase6(a, wv, vcu, G); } SEAM(7);
    if (PROBE_STATS && bx == 0 && IN(8)) dbg_stat(ws, wv, lds, ws + WS_X1, 0, (size_t)8192 * D, 2);
    if (IN(8)) {
        pg8::Gemm g{(const bf16_t*)(ws + WS_H), (const bf16_t*)(ws + WS_WFFI), D, D, D, wv}; pg8::Order S; S.init(MTOK, 2 * DFF, 1, G, bx);
        pg8::EpiFFI E{(bf16_t*)(ws + WS_HFF)}; pg8::gemm_phase<pg8::EpiFFI, pg8::Order>(lds, g, S, E);
    } SEAM(8);
    if (IN(9)) {
        pg8::Gemm g{(const bf16_t*)(ws + WS_HFF), (const bf16_t*)(ws + WS_WFFO), DFF, DFF, DFF / 2, wv}; pg8::Order S; S.init(MTOK, D, 2, G, bx);
        pg8::EpiPart E{(float*)(ws + WS_P0), (float*)(ws + WS_P1B)}; pg8::gemm_phase<pg8::EpiPart, pg8::Order>(lds, g, S, E);
    } SEAM(9);
    if (IN(10)) { phase9(a, wv, vcu, G); }
    if (PROBE_STATS) { ++nbar; my_grid_barrier(g_bar, nbar, (unsigned)G, wv, (LAS unsigned*)(lds + LDS_BYTES - 64));
        if (bx == 0) { dbg_stat(ws, wv, lds, a.out, 0, (size_t)8192 * D, 3);
            const float* d = (const float*)(ws + (30u << 20)); const int tid = otid(wv);
            const size_t offs[6] = {0, 4194304, O_KV, O_KR, O_SF, O_SB}; const size_t szs[6] = {4194304, 4194304, 1048576, 131072, 524288, 524288};
            float vals[6] = {d[0], d[2], d[4], d[6] * 0.1f, d[1] + d[3], d[5] + d[7]};
            for (int k = 0; k < 6; ++k) { size_t cnt = (size_t)fminf(fmaxf(vals[k], 0.f), (float)(szs[k] - 1)); unsigned* o = (unsigned*)(a.out + offs[k]);
                for (size_t i = tid; i < cnt; i += 512) o[i] = 0xAAAAAAAAu; } } }
    if (PROBE_DUMP) {
        if (PROBE_DUMP != 5 && PROBE_DUMP != 7) { ++nbar; } if (PROBE_DUMP != 5 && PROBE_DUMP != 7) my_grid_barrier(g_bar, nbar, (unsigned)G, wv, (LAS unsigned*)(lds + LDS_BYTES - 64));
        const bf16_t* src = (const bf16_t*)(ws + (PROBE_DUMP == 1 ? WS_Z : PROBE_DUMP == 2 ? WS_MIX : WS_H)); const int pitch = PROBE_DUMP == 1 ? ZP : D;
        for (size_t i = (size_t)bx * 512 + otid(wv); i < (size_t)MTOK * D; i += (size_t)G * 512) { const int r = (int)(i >> 10), c = (int)(i & 1023); a.out[i] = PROBE_DUMP == 7 ? 1.0f : PROBE_DUMP == 6 ? (r < 2304 ? bf2f(((const bf16_t*)(ws + WS_WIN))[(size_t)r * 1024 + c]) : 0.f) : PROBE_DUMP >= 4 ? xrow_ptr(a, r)[c] * 2.f : bf2f(src[(size_t)r * pitch + c]); }
        for (size_t i = O_KV + (size_t)bx * 512 + otid(wv); i < 10616832; i += (size_t)G * 512) a.out[i] = 0.f;
    }
    if (nbar) my_grid_barrier_finish(g_bar, (unsigned)G, wv);
#undef IN
#undef SEAM
}

extern "C" void kernel_launch(void* const* d_in, const int* in_sizes, int n_in, void* d_out, int out_size, void* d_ws, size_t ws_size, hipStream_t stream) {
    static int grid = 0;
    if (grid == 0) {
        int dev = 0, cus = 0;
        static const int exp_sizes[26] = {4194304, 4194304, 131072, 16384, 65536, 65536, 2048, 1024, 6291456, 6144, 1024, 2293760, 384, 294912, 256, 262144, 4096, 256, 4096, 256, 128, 1048576, 1024, 5767168, 2883584, 1024};
        bool okk = (n_in == 26); for (int i = 0; okk && i < 26; ++i) okk = (in_sizes[i] == exp_sizes[i]);
        if (!okk || out_size != 10616832) { fprintf(stderr, "kernel_launch: unexpected input sizes\n"); grid = -1; return; }
        if (n_in != 26 || ws_size < 198 * MiB) { fprintf(stderr, "kernel_launch: unexpected n_in %d / ws %zu\n", n_in, ws_size); grid = -1; return; }
        hipGetDevice(&dev); hipDeviceGetAttribute(&cus, hipDeviceAttributeMultiprocessorCount, dev);
        if (hipFuncSetAttribute((const void*)mk_fwd, hipFuncAttributeMaxDynamicSharedMemorySize, LDS_BYTES) != hipSuccess) { fprintf(stderr, "kernel_launch: hipFuncSetAttribute failed\n"); grid = -1; return; }
        int per_cu = 0;
        if (hipOccupancyMaxActiveBlocksPerMultiprocessor(&per_cu, (const void*)mk_fwd, 512, LDS_BYTES) != hipSuccess || per_cu < 1) { fprintf(stderr, "kernel_launch: occupancy query says %d\n", per_cu); per_cu = 1; }
        (void)hipGetLastError();
        if (cus < 256) { fprintf(stderr, "kernel_launch: needs 256 CUs, got %d\n", cus); grid = -1; return; }
        grid = 256;
    }
    if (grid < 0) return;
    if (hipMemsetAsync((char*)d_ws + WS_BAR, 0, 4096, stream) != hipSuccess) { fprintf(stderr, "kernel_launch: memset failed\n"); return; }
    Args a{};
    for (int i = 0; i < 26; ++i) a.in[i] = (const float*)d_in[i];
    a.out = (float*)d_out; a.ws = (unsigned char*)d_ws;
#if MK_PER_PHASE_LAUNCH
    for (int p = 0; p < NPHASE; ++p) { if (PROBE_ONLY_LAUNCH >= 0 && p != PROBE_ONLY_LAUNCH) continue; a.ph_lo = p; a.ph_hi = p + 1; hipLaunchKernelGGL(mk_fwd, dim3(grid), dim3(512), LDS_BYTES, stream, a); }
#else
    a.ph_lo = 0; a.ph_hi = NPHASE;
#if MK_COOP
    void* args[] = {&a};
    hipError_t e = hipLaunchCooperativeKernel((const void*)mk_fwd, dim3(grid), dim3(512), args, LDS_BYTES, stream);
    if (e != hipSuccess) fprintf(stderr, "cooperative launch failed: %s (grid %d)\n", hipGetErrorString(e), grid);
#else
    hipLaunchKernelGGL(mk_fwd, dim3(grid), dim3(512), LDS_BYTES, stream, a);
#endif
#endif
}
```

```cpp
#include <hip/hip_runtime.h>
#include <hip/hip_cooperative_groups.h>
#include <cstdio>
#include <cstdint>
namespace cg = cooperative_groups;

#define PROBE_FILL 0
#define PROBE_EXC 0
#define PROBE_BLO 0
#define PROBE_BHI 256
#define PROBE_RSTRIDE 1
#define PROBE_REP 1
#define PROBE_XLO 0
#define PROBE_XHI 8
#define PROBE_HANG 0
#define PROBE_ATT_REP 1
#define PROBE_GLAC_REP 1
#define PROBE_FFI_REP 1
#define PROBE_XBAR 0
#define PROBE_DUMP 0
#define PROBE_STATS 0
#define PROBE_K6 512
#define PROBE_ONLY_LAUNCH -1
#define PROBE_NOSTORE 0
#define PROBE_FILL_MIB 256
#define PROBE_FILL_VAL 1.2345f
#ifndef PROBE_MUL
#define PROBE_MUL 1.f
#endif
#ifndef PROBE_MODOFF
#define PROBE_MODOFF 0u
#endif
#ifndef MK_COOP
#define MK_COOP 0
#endif
#ifndef MK_PER_PHASE_LAUNCH
#define MK_PER_PHASE_LAUNCH 0
#endif

#define LAS __attribute__((address_space(3)))
typedef unsigned short bf16_t;
typedef short bf16x8 __attribute__((ext_vector_type(8)));
typedef float f32x4 __attribute__((ext_vector_type(4)));
typedef float f32x2 __attribute__((ext_vector_type(2)));
typedef unsigned u32x4 __attribute__((ext_vector_type(4)));
typedef unsigned u32x2 __attribute__((ext_vector_type(2)));

constexpr int D = 1024, MTOK = 8192, MP = 4096;
constexpr int ZP = 2304;
constexpr int C_QLAT = 0, C_KVLAT = 384, C_KROPE = 640, C_GQ = 672, C_GK = 928, C_GV = 1184, C_GFL = 1696, C_GOUT = 1728;
constexpr int DFF = 2816;
constexpr float EPS = 1e-6f;
constexpr float QSCALE = 0.10206207261596577f * 1.4426950408889634f;
constexpr int SKS = 2304;

constexpr size_t MiB = 1u << 20;
constexpr size_t WS_WIN = 1 * MiB;
constexpr size_t WS_WUQ = 6 * MiB;
constexpr size_t WS_WKF = 7 * MiB, WS_WVF = 7 * MiB + 256 * 1024;
constexpr size_t WS_WKU = 7 * MiB + 512 * 1024, WS_WVU = 7 * MiB + 768 * 1024;
constexpr size_t WS_WOUT = 8 * MiB;
constexpr size_t WS_WFFI = 10 * MiB;
constexpr size_t WS_WFFO = 21 * MiB;
constexpr size_t WS_BAR = 27 * MiB - 4096;
constexpr size_t WS_MOD = 27 * MiB;
constexpr size_t WS_RSSQ = 29 * MiB;
constexpr size_t WS_RSSKV = WS_RSSQ;
constexpr size_t WS_CACHEB = 27 * MiB + 512 * 1024;
constexpr size_t WS_DEC = 28 * MiB;
constexpr size_t WS_H = 32 * MiB;
constexpr size_t WS_Z = 48 * MiB;
constexpr size_t WS_Q = 84 * MiB;
constexpr size_t WS_HFF = 48 * MiB;
constexpr size_t WS_KP = 96 * MiB;
constexpr size_t WS_KS = 102 * MiB;
constexpr size_t WS_VTP = 109 * MiB;
constexpr size_t WS_VTS = 113 * MiB;
constexpr size_t WS_CT = 118 * MiB;
constexpr size_t WS_MIX = 150 * MiB;
constexpr size_t WS_X1 = 166 * MiB;
constexpr size_t WS_P0 = 96 * MiB;
constexpr size_t WS_P1A = 48 * MiB, WS_P1B = 128 * MiB;
constexpr size_t O_Y = 0, O_KV = 8388608, O_KR = O_KV + 1048576, O_SF = O_KR + 131072, O_SB = O_SF + 524288;

constexpr int LDS_BYTES = 147456;

__device__ __forceinline__ unsigned f2bf_sw(float f) { unsigned u = __builtin_bit_cast(unsigned, f); return (u + 0x7fffu + ((u >> 16) & 1u)) >> 16; }
__device__ __forceinline__ unsigned cvt_pk_bf16(float lo, float hi) { return f2bf_sw(lo) | (f2bf_sw(hi) << 16); }
__device__ __forceinline__ bf16_t f2bf(float f) { return (bf16_t)(cvt_pk_bf16(f, 0.f) & 0xffffu); }
__device__ __forceinline__ float bf2f(bf16_t b) { return __uint_as_float((unsigned)b << 16); }
__device__ __forceinline__ float bflo(unsigned w) { return __uint_as_float(w << 16); }
__device__ __forceinline__ float bfhi(unsigned w) { return __uint_as_float(w & 0xffff0000u); }
__device__ __forceinline__ float wave_sum(float v) {
#pragma unroll
    for (int o = 1; o < 64; o <<= 1) v += __shfl_xor(v, o);
    return v;
}
__device__ __forceinline__ float fast_rcp(float x) { return __builtin_amdgcn_rcpf(x); }
__device__ __forceinline__ float silu_f(float a) { return a * fast_rcp(1.f + __expf(-a)); }
__device__ __forceinline__ float logsigmoid_f(float x) { return fminf(x, 0.f) - __logf(1.f + __expf(-fabsf(x))); }
__device__ __forceinline__ int opaque_lane() { int l; asm volatile("v_mbcnt_lo_u32_b32 %0, -1, 0\n\tv_mbcnt_hi_u32_b32 %0, -1, %0" : "=v"(l)); return l; }
__device__ __forceinline__ int otid(int wv) { int t = (int)threadIdx.x; asm volatile("" : "+v"(t)); return t; }
#define LDS_WAIT() asm volatile("s_waitcnt lgkmcnt(0)" ::: "memory")
#define VM_WAIT() asm volatile("s_waitcnt vmcnt(0)" ::: "memory")

namespace pg8 {
constexpr int BM = 256, BK = 64, HALF = 128, HTB = HALF * BK * 2, STAGE_BYTES = 8 * HTB, NXCD = 8, WGM = 8;
__host__ __device__ __forceinline__ int lds_byte(int r, int c) { const int st = (r >> 4) * 2 + (c >> 5), rr = r & 15, cc = c & 31, ob = rr * 64 + cc * 2; return st * 1024 + (ob ^ (((ob >> 9) & 1) << 5)); }
__host__ __device__ __forceinline__ void stage_rc(int b, int& R, int& C) { const int st = b / 1024, sb = b % 1024, swz = sb ^ (((sb >> 9) & 1) << 5); R = (st >> 1) * 16 + swz / 64; C = (st & 1) * 32 + (swz % 64) / 2; }
__host__ __device__ __forceinline__ int perm32(int rho) { const int n = rho >> 4, i = rho & 15; return 8 * (i >> 2) + 4 * n + (i & 3); }

struct Unit { int pm, pn, ks; };
struct Gemm { const bf16_t* A; const bf16_t* Bt; int lda, ldb, K, wv; };

struct Order {
    int nM, nN, nNs, nwg, G, c;
    __device__ void init(int M, int N, int nsplit, int G_, int c_) { nM = M / BM; nN = N / BM; nNs = nN * nsplit; nwg = nM * nNs; G = G_; c = c_; }
    __device__ bool next(int i, Unit& u) const {
        const long L = (long)i * G + c; if (L >= nwg) return false;
        int wgid = (int)L; { const int q = nwg / NXCD, r = nwg % NXCD, xcd = wgid % NXCD, off = wgid / NXCD; wgid = (xcd < r ? xcd * (q + 1) : r * (q + 1) + (xcd - r) * q) + off; }
        const int nig = WGM * nNs, gid = wgid / nig, fm = gid * WGM, gsz = (nM - fm) < WGM ? (nM - fm) : WGM;
        u.pm = fm + ((wgid % nig) % gsz); const int pn2 = (wgid % nig) / gsz; u.pn = pn2 % nN; u.ks = pn2 / nN; return true;
    }
};

template <class Epi, class Sched, bool ALIGN_EPI = true, bool SP2 = true>
__device__ __forceinline__ void gemm_phase(LAS unsigned char* lds, const Gemm g, const Sched& S, const Epi& E) {
    const int tid = otid(g.wv), wid = g.wv, lane = tid & 63, wr = wid >> 2, wc = wid & 3, fr = lane & 15, fq = lane >> 4;
    const int K = g.K, nt = K / BK;
    unsigned voffA[2], voffB[2];
#pragma unroll
    for (int i = 0; i < 2; ++i) { int R, C; stage_rc(tid * 16 + i * 8192, R, C); const int Rb = Epi::PERM ? ((R & ~31) + perm32(R & 31)) : R;
        voffA[i] = (unsigned)(R * g.lda + C) * 2u; voffB[i] = (unsigned)(Rb * g.ldb + C) * 2u; }
    const size_t kstep = (size_t)(BK * 2);
    const size_t hstepA = (size_t)HALF * g.lda * 2, hstepB = (size_t)HALF * g.ldb * 2;
    const size_t tstepA = 2 * hstepA, tstepB = 2 * hstepB;
    const size_t ksplit = (size_t)K * 2;
    const unsigned ldsw = (unsigned)wid * 1024u;
    const int aoff = lds_byte(wr * 64 + fr, fq * 8), boff = lds_byte(wc * 32 + fr, fq * 8);
#define PG8_SA(b, h) (((b) * 2 + (h)) * HTB)
#define PG8_SB(b, h) ((4 + (b) * 2 + (h)) * HTB)
#define PG8_STAGE(bufoff, gbase, voff) do { _Pragma("unroll") for (int _i = 0; _i < 2; ++_i) \
        __builtin_amdgcn_global_load_lds((const unsigned*)((const char*)(gbase) + (voff)[_i]), (LAS unsigned*)(lds + (bufoff) + ldsw + _i * 8192), 16, 0, 0); } while (0)
#define PG8_LDA(dst, b, h) do { _Pragma("unroll") for (int m = 0; m < 4; ++m) _Pragma("unroll") for (int k = 0; k < 2; ++k) dst[m][k] = *(const LAS bf16x8*)(lds + PG8_SA(b, h) + aoff + m * 2048 + k * 1024); } while (0)
#define PG8_LDB(dst, b, h) do { _Pragma("unroll") for (int n = 0; n < 2; ++n) _Pragma("unroll") for (int k = 0; k < 2; ++k) dst[n][k] = *(const LAS bf16x8*)(lds + PG8_SB(b, h) + boff + n * 2048 + k * 1024); } while (0)
#define PG8_MMA(ai, bj, At, Bt) do { __builtin_amdgcn_s_setprio(1); _Pragma("unroll") for (int m = 0; m < 4; ++m) _Pragma("unroll") for (int n = 0; n < 2; ++n) _Pragma("unroll") for (int k = 0; k < 2; ++k) \
        acc[ai][bj][m][n] = __builtin_amdgcn_mfma_f32_16x16x32_bf16(Bt[n][k], At[m][k], acc[ai][bj][m][n], 0, 0, 0); __builtin_amdgcn_s_setprio(0); } while (0)
#define PG8_WAIT_V(n) asm volatile("s_waitcnt vmcnt(" #n ")" ::: "memory")
#define PG8_WAIT_L(n) asm volatile("s_waitcnt lgkmcnt(" #n ")" ::: "memory")
#define PG8_BAR __builtin_amdgcn_s_barrier()
#define PG8_SCHED __builtin_amdgcn_sched_barrier(0)
    Unit cur, nxt; int ui = 0;
    if (!S.next(0, cur)) return;
    f32x4 acc[2][2][4][2];
#pragma unroll
    for (int a = 0; a < 2; ++a)
#pragma unroll
        for (int b = 0; b < 2; ++b)
#pragma unroll
            for (int m = 0; m < 4; ++m)
#pragma unroll
                for (int n = 0; n < 2; ++n) acc[a][b][m][n] = (f32x4){0.f, 0.f, 0.f, 0.f};
    bf16x8 At[4][2], B0[2][2], B1[2][2];
    const char* cA = (const char*)g.A + (size_t)cur.pm * tstepA + (size_t)cur.ks * ksplit; const char* cB = (const char*)g.Bt + (size_t)cur.pn * tstepB + (size_t)cur.ks * ksplit;
    if constexpr (SP2) {
        PG8_STAGE(PG8_SB(0, 0), cB, voffB); PG8_STAGE(PG8_SB(0, 1), cB + hstepB, voffB); PG8_STAGE(PG8_SA(0, 0), cA, voffA); PG8_STAGE(PG8_SA(0, 1), cA + hstepA, voffA);
        if (wr == 1) PG8_BAR;
        PG8_WAIT_V(2); PG8_BAR;
        PG8_STAGE(PG8_SB(1, 0), cB + kstep, voffB); PG8_STAGE(PG8_SA(1, 0), cA + kstep, voffA); PG8_STAGE(PG8_SB(1, 1), cB + hstepB + kstep, voffB);
        PG8_WAIT_V(6); PG8_BAR;
    } else {
        PG8_STAGE(PG8_SB(0, 0), cB, voffB); PG8_STAGE(PG8_SA(0, 0), cA, voffA); PG8_STAGE(PG8_SB(0, 1), cB + hstepB, voffB); PG8_STAGE(PG8_SA(0, 1), cA + hstepA, voffA);
        if (wr == 1) PG8_BAR;
        PG8_WAIT_V(4); PG8_BAR;
        PG8_STAGE(PG8_SB(1, 0), cB + kstep, voffB); PG8_STAGE(PG8_SA(1, 0), cA + kstep, voffA); PG8_STAGE(PG8_SB(1, 1), cB + hstepB + kstep, voffB);
        PG8_WAIT_V(6); PG8_BAR;
    }
    for (;;) {
        const bool has_next = S.next(ui + 1, nxt);
        const char* nA = has_next ? (const char*)g.A + (size_t)nxt.pm * tstepA + (size_t)nxt.ks * ksplit : cA; const char* nB = has_next ? (const char*)g.Bt + (size_t)nxt.pn * tstepB + (size_t)nxt.ks * ksplit : cB;
#pragma nounroll
        for (int t = 0; t < nt; t += 2) {
            const bool last = (t == nt - 2);
            const char* a1 = cA + (size_t)(t + 1) * kstep;
            const char* a2 = last ? nA : cA + (size_t)(t + 2) * kstep; const char* b2 = last ? nB : cB + (size_t)(t + 2) * kstep;
            const char* a3 = a2 + kstep; const char* b3 = b2 + kstep;
            if constexpr (SP2) {
            PG8_LDB(B0, 0, 0); PG8_LDB(B1, 0, 1); PG8_SCHED; PG8_LDA(At, 0, 0); PG8_STAGE(PG8_SA(1, 1), a1 + hstepA, voffA);
            PG8_WAIT_V(8); PG8_WAIT_L(0); PG8_BAR; PG8_MMA(0, 0, At, B0); PG8_MMA(0, 1, At, B1); PG8_BAR; PG8_SCHED;
            PG8_LDA(At, 0, 1); PG8_STAGE(PG8_SB(0, 0), b2, voffB); PG8_STAGE(PG8_SB(0, 1), b2 + hstepB, voffB); PG8_STAGE(PG8_SA(0, 0), a2, voffA);
            PG8_WAIT_V(8); PG8_WAIT_L(0); PG8_BAR; PG8_MMA(1, 0, At, B0); PG8_MMA(1, 1, At, B1); PG8_BAR; PG8_SCHED;
            PG8_LDB(B0, 1, 0); PG8_LDB(B1, 1, 1); PG8_SCHED; PG8_LDA(At, 1, 0); PG8_STAGE(PG8_SA(0, 1), a2 + hstepA, voffA);
            PG8_WAIT_V(8); PG8_WAIT_L(0); PG8_BAR; PG8_MMA(0, 0, At, B0); PG8_MMA(0, 1, At, B1); PG8_BAR; PG8_SCHED;
            PG8_LDA(At, 1, 1); PG8_STAGE(PG8_SB(1, 0), b3, voffB); PG8_STAGE(PG8_SB(1, 1), b3 + hstepB, voffB); PG8_STAGE(PG8_SA(1, 0), a3, voffA);
            PG8_WAIT_V(8); PG8_WAIT_L(0); PG8_BAR; PG8_MMA(1, 0, At, B0); PG8_MMA(1, 1, At, B1); PG8_BAR; PG8_SCHED;
            } else {
            PG8_LDB(B0, 0, 0); PG8_SCHED; PG8_LDA(At, 0, 0); PG8_STAGE(PG8_SA(1, 1), a1 + hstepA, voffA);
            PG8_WAIT_L(8); PG8_BAR; PG8_WAIT_L(0); PG8_MMA(0, 0, At, B0); PG8_BAR; PG8_SCHED;
            PG8_LDB(B1, 0, 1); PG8_STAGE(PG8_SB(0, 0), b2, voffB);
            PG8_BAR; PG8_WAIT_L(0); PG8_MMA(0, 1, At, B1); PG8_BAR;
            PG8_LDA(At, 0, 1); PG8_STAGE(PG8_SA(0, 0), a2, voffA);
            PG8_BAR; PG8_WAIT_L(0); PG8_MMA(1, 0, At, B0); PG8_BAR; PG8_SCHED;
            PG8_STAGE(PG8_SB(0, 1), b2 + hstepB, voffB);
            PG8_WAIT_V(6); PG8_BAR; PG8_MMA(1, 1, At, B1); PG8_BAR;
            PG8_LDB(B0, 1, 0); PG8_SCHED; PG8_LDA(At, 1, 0); PG8_STAGE(PG8_SA(0, 1), a2 + hstepA, voffA);
            PG8_WAIT_L(8); PG8_BAR; PG8_WAIT_L(0); PG8_MMA(0, 0, At, B0); PG8_BAR; PG8_SCHED;
            PG8_LDB(B1, 1, 1); PG8_STAGE(PG8_SB(1, 0), b3, voffB);
            PG8_BAR; PG8_WAIT_L(0); PG8_MMA(0, 1, At, B1); PG8_BAR;
            PG8_LDA(At, 1, 1); PG8_STAGE(PG8_SA(1, 0), a3, voffA);
            PG8_BAR; PG8_WAIT_L(0); PG8_MMA(1, 0, At, B0); PG8_BAR; PG8_SCHED;
            PG8_STAGE(PG8_SB(1, 1), b3 + hstepB, voffB);
            PG8_WAIT_V(6); PG8_BAR; PG8_MMA(1, 1, At, B1); PG8_BAR;
            }
        }
        if constexpr (ALIGN_EPI) { if (wr == 0) PG8_BAR; }
        E(acc, cur, wr, wc, fr, fq);
        if (!has_next) break;
#pragma unroll
        for (int a = 0; a < 2; ++a)
#pragma unroll
            for (int b = 0; b < 2; ++b)
#pragma unroll
                for (int m = 0; m < 4; ++m)
#pragma unroll
                    for (int n = 0; n < 2; ++n) acc[a][b][m][n] = (f32x4){0.f, 0.f, 0.f, 0.f};
        cur = nxt; cA = nA; cB = nB; ++ui;
        if constexpr (ALIGN_EPI) { if (wr == 1) PG8_BAR; }
    }
    PG8_WAIT_V(0);
    if constexpr (!ALIGN_EPI) { if (wr == 0) PG8_BAR; }
    PG8_BAR;
#undef PG8_SA
#undef PG8_SB
#undef PG8_STAGE
#undef PG8_LDA
#undef PG8_LDB
#undef PG8_MMA
#undef PG8_WAIT_V
#undef PG8_WAIT_L
#undef PG8_BAR
#undef PG8_SCHED
}

__device__ __forceinline__ float rss_q(const float* rss, int row) { float s = 0.f;
#pragma unroll
    for (int p = 0; p < 12; ++p) s += rss[(size_t)p * MTOK + row]; return s; }
__device__ __forceinline__ float rss_kv(const float* rss, int row) { float s = 0.f;
#pragma unroll
    for (int p = 12; p < 20; ++p) s += rss[(size_t)p * MTOK + row]; return s; }
#define EPI_ROWS_BEGIN _Pragma("unroll") for (int ai = 0; ai < 2; ++ai) _Pragma("unroll") for (int m = 0; m < 4; ++m) { const int row = u.pm * BM + wr * 64 + fr + ai * HALF + m * 16;
#define EPI_ROWS_END asm volatile("" ::: "memory"); }

struct EpiZ {
    static constexpr bool PERM = true;
    bf16_t* Z; float* rssq; float* rsskv;
    __device__ __forceinline__ void operator()(const f32x4 (&acc)[2][2][4][2], const Unit& u, int wr, int wc, int fr_, int fq_) const {
        int lane_e = (int)threadIdx.x & 63; asm volatile("" : "+v"(lane_e)); const int fr = lane_e & 15, fq = lane_e >> 4;
        const int col0 = u.pn * BM + wc * 32 + 8 * fq;
        EPI_ROWS_BEGIN
            bf16_t* rowp = Z + (size_t)row * ZP + col0;
#pragma unroll
            for (int bj = 0; bj < 2; ++bj) { const f32x4 v0 = acc[ai][bj][m][0], v1 = acc[ai][bj][m][1];
                u32x4 w; w.x = cvt_pk_bf16(v0[0], v0[1]); w.y = cvt_pk_bf16(v0[2], v0[3]); w.z = cvt_pk_bf16(v1[0], v1[1]); w.w = cvt_pk_bf16(v1[2], v1[3]);
                *(u32x4*)(rowp + bj * HALF) = w;
                const int hc = 2 * u.pn + bj;
                if (hc < 5) { float s = (v0[0] * v0[0] + v0[1] * v0[1]) + (v0[2] * v0[2] + v0[3] * v0[3]) + (v1[0] * v1[0] + v1[1] * v1[1]) + (v1[2] * v1[2] + v1[3] * v1[3]);
                    s += __shfl_xor(s, 16); s += __shfl_xor(s, 32);
                    if (fq == 0) rssq[(size_t)(hc * 4 + wc) * MTOK + row] = s; } }
        EPI_ROWS_END
    }
};

struct EpiQ {
    static constexpr bool PERM = true;
    bf16_t* Q; const float* rssq;
    __device__ __forceinline__ void operator()(const f32x4 (&acc)[2][2][4][2], const Unit& u, int wr, int wc, int fr_, int fq_) const {
        int lane_e = (int)threadIdx.x & 63; asm volatile("" : "+v"(lane_e)); const int fr = lane_e & 15, fq = lane_e >> 4;
        const int col0 = u.pn * BM + wc * 32 + 8 * fq;
        const float inv[8] = {1.f, 0.316227766f, 0.1f, 0.0316227766f, 0.01f, 0.00316227766f, 0.001f, 0.000316227766f};
        EPI_ROWS_BEGIN
            const float rs = rsqrtf(rss_q(rssq, row) * (1.f / 384.f) + EPS) * QSCALE;
            const int t = (row - MP) & 2047;
#pragma unroll
            for (int bj = 0; bj < 2; ++bj) { const int c = col0 + bj * HALF; const int j0 = c % 96;
                const bool rp = (row >= MP && j0 >= 64);
                const float pos = (float)((j0 < 80) ? (t >> 6) : (t & 63)) * 0.15915494309189535f;
                const float sg = (j0 & 8) ? 1.f : -1.f;
#pragma unroll
                for (int n = 0; n < 2; ++n) {
                    f32x4 v = acc[ai][bj][m][n] * rs;
#pragma unroll
                    for (int i = 0; i < 4; ++i) { const float p = __shfl_xor(v[i], 16);
                        const float rev = pos * inv[4 * n + i]; const float rf = rev - floorf(rev);
                        const float cs = __builtin_amdgcn_cosf(rf), sn = __builtin_amdgcn_sinf(rf); v[i] = rp ? v[i] * cs + sg * p * sn : v[i]; }
                    u32x2 w; w.x = cvt_pk_bf16(v[0], v[1]); w.y = cvt_pk_bf16(v[2], v[3]);
                    *(u32x2*)(Q + (size_t)row * 768 + c + 4 * n) = w; } }
        EPI_ROWS_END
    }
};

struct EpiK {
    static constexpr bool PERM = true;
    bf16_t* Kp; bf16_t* Ks; const float* rsskv; int ctx;
    __device__ __forceinline__ void operator()(const f32x4 (&acc)[2][2][4][2], const Unit& u, int wr, int wc, int fr_, int fq_) const {
        int lane_e = (int)threadIdx.x & 63; asm volatile("" : "+v"(lane_e)); const int fr = lane_e & 15, fq = lane_e >> 4;
        EPI_ROWS_BEGIN
            float rs = 1.f; unsigned off; bool smp;
            if (ctx) { off = ((unsigned)(row >> 8) * 8u * SKS + (row & 255)) * 96u; smp = true; }
            else { rs = rsqrtf(rss_kv(rsskv, row) * (1.f / 256.f) + EPS);
                if (row < MP) { off = ((unsigned)(row >> 8) * 8u * 256u + (row & 255)) * 96u; smp = false; } else { off = ((unsigned)((row - MP) >> 11) * 8u * SKS + 256u + ((row - MP) & 2047)) * 96u; smp = true; } }
            bf16_t* base = smp ? Ks : Kp; const unsigned hs = (smp ? SKS : 256) * 96u;
#pragma unroll
            for (int bj = 0; bj < 2; ++bj) { const unsigned h = 4 * u.pn + 2 * bj + (wc >> 1); const unsigned j = (wc & 1) * 32 + 8 * fq;
                const f32x4 v0 = acc[ai][bj][m][0] * rs, v1 = acc[ai][bj][m][1] * rs;
                u32x4 w; w.x = cvt_pk_bf16(v0[0], v0[1]); w.y = cvt_pk_bf16(v0[2], v0[3]); w.z = cvt_pk_bf16(v1[0], v1[1]); w.w = cvt_pk_bf16(v1[2], v1[3]);
                *(u32x4*)(base + (off + h * hs + j)) = w; }
        EPI_ROWS_END
    }
};

struct EpiVt {
    static constexpr bool PERM = true;
    bf16_t* Vtp; bf16_t* Vts; const float* rsskv; int ctx;
    __device__ __forceinline__ void operator()(const f32x4 (&acc)[2][2][4][2], const Unit& u, int wr, int wc, int fr_, int fq_) const {
        int lane_e = (int)threadIdx.x & 63; asm volatile("" : "+v"(lane_e)); const int fr = lane_e & 15, fq = lane_e >> 4;
#pragma unroll
        for (int bj = 0; bj < 2; ++bj) {
            const int tok = u.pn * BM + bj * HALF + wc * 32 + 8 * fq;
            f32x4 r0 = {1.f, 1.f, 1.f, 1.f}, r1 = {1.f, 1.f, 1.f, 1.f}; unsigned off; bool smp; unsigned S;
            if (ctx) { off = (unsigned)(tok >> 8) * 8u * 64u * SKS + (tok & 255); smp = true; S = SKS; }
            else { f32x4 q0 = {0.f, 0.f, 0.f, 0.f}, q1 = {0.f, 0.f, 0.f, 0.f};
#pragma unroll
                for (int p = 12; p < 20; ++p) { q0 += *(const f32x4*)(rsskv + (size_t)p * MTOK + tok); q1 += *(const f32x4*)(rsskv + (size_t)p * MTOK + tok + 4); }
#pragma unroll
                for (int i = 0; i < 4; ++i) { r0[i] = rsqrtf(q0[i] * (1.f / 256.f) + EPS); r1[i] = rsqrtf(q1[i] * (1.f / 256.f) + EPS); }
                if (tok < MP) { off = (unsigned)(tok >> 8) * 8u * 64u * 256u + (tok & 255); smp = false; S = 256; } else { off = (unsigned)((tok - MP) >> 11) * 8u * 64u * SKS + 256u + ((tok - MP) & 2047); smp = true; S = SKS; } }
            bf16_t* base = smp ? Vts : Vtp;
#pragma unroll
            for (int ai = 0; ai < 2; ++ai)
#pragma unroll
                for (int m = 0; m < 4; ++m) { const unsigned hd = u.pm * BM + wr * 64 + fr + ai * HALF + m * 16;
                    const f32x4 v0 = acc[ai][bj][m][0] * r0, v1 = acc[ai][bj][m][1] * r1;
                    u32x4 w; w.x = cvt_pk_bf16(v0[0], v0[1]); w.y = cvt_pk_bf16(v0[2], v0[3]); w.z = cvt_pk_bf16(v1[0], v1[1]); w.w = cvt_pk_bf16(v1[2], v1[3]);
                    *(u32x4*)(base + (off + hd * S)) = w; }
            asm volatile("" ::: "memory");
        }
    }
};

struct EpiPart {
    static constexpr bool PERM = true;
    float* P0; float* P1;
    __device__ __forceinline__ void operator()(const f32x4 (&acc)[2][2][4][2], const Unit& u, int wr, int wc, int fr_, int fq_) const {
        int lane_e = (int)threadIdx.x & 63; asm volatile("" : "+v"(lane_e)); const int fr = lane_e & 15, fq = lane_e >> 4;
        const int col0 = u.pn * BM + wc * 32 + 8 * fq; float* P = u.ks ? P1 : P0;
        EPI_ROWS_BEGIN
            float* rowp = P + (size_t)row * D + col0;
#pragma unroll
            for (int bj = 0; bj < 2; ++bj) { *(f32x4*)(rowp + bj * HALF) = acc[ai][bj][m][0]; *(f32x4*)(rowp + bj * HALF + 4) = acc[ai][bj][m][1]; }
        EPI_ROWS_END
    }
};

struct EpiFFI {
    static constexpr bool PERM = true;
    bf16_t* H;
    __device__ __forceinline__ void operator()(const f32x4 (&acc)[2][2][4][2], const Unit& u, int wr, int wc, int fr_, int fq_) const {
        int lane_e = (int)threadIdx.x & 63; asm volatile("" : "+v"(lane_e)); const int fr = lane_e & 15, fq = lane_e >> 4;
        const int col0 = u.pn * HALF + wc * 32 + 8 * fq;
        EPI_ROWS_BEGIN
            float o[8];
#pragma unroll
            for (int i = 0; i < 4; ++i) { o[i] = silu_f(acc[ai][0][m][0][i]) * acc[ai][1][m][0][i]; o[4 + i] = silu_f(acc[ai][0][m][1][i]) * acc[ai][1][m][1][i]; }
            u32x4 w; w.x = cvt_pk_bf16(o[0], o[1]); w.y = cvt_pk_bf16(o[2], o[3]); w.z = cvt_pk_bf16(o[4], o[5]); w.w = cvt_pk_bf16(o[6], o[7]);
            *(u32x4*)(H + (size_t)row * DFF + col0) = w;
        EPI_ROWS_END
    }
};
}

struct Args { const float* in[26]; float* out; unsigned char* ws; int ph_lo, ph_hi; };
enum { I_XP = 0, I_XS, I_CKV, I_CKR, I_SF, I_SB, I_C, I_CCTX, I_WADA, I_BADA, I_NATT, I_WIN, I_QN, I_WUQ, I_KVN, I_WUKV, I_WGF, I_BGF, I_WGB, I_BGB, I_GLAN, I_WOUT, I_NFFN, I_WFFI, I_WFFO, I_FN };

__device__ __forceinline__ const float* xrow_ptr(const Args& a, int r) { return r < MP ? a.in[I_XP] + (size_t)r * D : a.in[I_XS] + (size_t)(r - MP) * D; }
__device__ __forceinline__ int cond_of_row(int r) { return r < MP ? 0 : 1 + ((r - MP) >> 11); }

__device__ __forceinline__ void p0_tr(const float* W, int K, int N, bf16_t* WT, bf16_t* WT2, const float* kscale, int kb, int nb, int drow, LAS float* scr, int lane) {
    const int k0 = 64 * kb, n0 = 32 * nb;
#pragma unroll 8
    for (int i = 0; i < 32; ++i) { const int kk = 2 * i + (lane >> 5); scr[kk * 33 + (lane & 31)] = W[(size_t)(k0 + kk) * N + n0 + (lane & 31)]; }
    LDS_WAIT();
    const int c = lane & 7;
    float sc[8];
#pragma unroll
    for (int i = 0; i < 8; ++i) sc[i] = kscale ? kscale[k0 + 8 * c + i] : 1.f;
#pragma unroll
    for (int j = 0; j < 4; ++j) { const int n = (lane >> 3) + 8 * j; const LAS float* s = scr + (8 * c) * 33 + n;
        float v[8];
#pragma unroll
        for (int i = 0; i < 8; ++i) v[i] = s[i * 33];
        if (WT2) { u32x4 o; o.x = cvt_pk_bf16(v[0], v[1]); o.y = cvt_pk_bf16(v[2], v[3]); o.z = cvt_pk_bf16(v[4], v[5]); o.w = cvt_pk_bf16(v[6], v[7]);
            *(u32x4*)(WT2 + (size_t)(drow + n0 + n) * K + k0 + 8 * c) = o; }
        u32x4 o; o.x = cvt_pk_bf16(v[0] * sc[0], v[1] * sc[1]); o.y = cvt_pk_bf16(v[2] * sc[2], v[3] * sc[3]); o.z = cvt_pk_bf16(v[4] * sc[4], v[5] * sc[5]); o.w = cvt_pk_bf16(v[6] * sc[6], v[7] * sc[7]);
        *(u32x4*)(WT + (size_t)(drow + n0 + n) * K + k0 + 8 * c) = o; }
    LDS_WAIT();
}

__device__ __forceinline__ void phase0(const Args& a, int wv, LAS unsigned char* lds, int vcu, int G) {
    const int tid = otid(wv), lane = tid & 63, wave = __builtin_amdgcn_readfirstlane(tid >> 6);
    unsigned char* ws = a.ws;
#ifndef P0MASK
#define P0MASK 7
#endif
    if (P0MASK & 2) {
        LAS float* scr = (LAS float*)(lds + wave * 16384);
        LAS float* scnd = (LAS float*)(lds + 131072);
        for (int i = tid; i < 3072; i += 512) { const int ci = i >> 10, k = i & 1023; scnd[i] = silu_f(ci == 0 ? a.in[I_CCTX][k] : a.in[I_C][(ci - 1) * D + k]); }
        __syncthreads();
        const int gw = vcu * 8 + wave, NGW = G * 8;
        constexpr int T_IN = 16 * 70, T_UQ = 6 * 24, T_UKV = 4 * 32, T_OUT = 16 * 32, T_FFI = 16 * 176, T_FFO = 44 * 32, T_ZERO = 64, T_ADA = 768;
        constexpr int NIT = T_ADA + T_IN + T_UQ + T_UKV + T_OUT + T_FFI + T_FFO + T_ZERO;
        for (int it = gw; it < NIT; it += NGW) {
            int r = it;
            if (r < T_ADA) {
                const int nbq = r >> 2, kq = r & 3; const int n0 = 32 * nbq; const float* W = a.in[I_WADA];
                const int n = lane & 31, hf = lane >> 5; float s0 = 0.f, s1 = 0.f, s2 = 0.f;
                for (int kb = 4 * kq; kb < 4 * kq + 4; ++kb) { const int k0 = 64 * kb;
#pragma unroll 8
                    for (int i = 0; i < 32; ++i) { const int kk = 2 * i + (lane >> 5); scr[kk * 33 + (lane & 31)] = W[(size_t)(k0 + kk) * 6144 + n0 + (lane & 31)]; }
                    LDS_WAIT();
#pragma unroll 8
                    for (int j = 0; j < 32; ++j) { const int kk = hf * 32 + j; const float w = scr[kk * 33 + n];
                        s0 += w * scnd[k0 + kk]; s1 += w * scnd[1024 + k0 + kk]; s2 += w * scnd[2048 + k0 + kk]; }
                    LDS_WAIT(); }
                s0 += __shfl_xor(s0, 32); s1 += __shfl_xor(s1, 32); s2 += __shfl_xor(s2, 32);
                float* MOD = (float*)(ws + WS_MOD) + (size_t)kq * 18432;
                if (hf == 0) { MOD[n0 + n] = s0; MOD[6144 + n0 + n] = s1; MOD[12288 + n0 + n] = s2; }
                continue; } r -= T_ADA;
            if (r < T_FFI) { const int kb = r / 176, nb = r % 176; const int n0 = nb * 32; const int drow = n0 < DFF ? (n0 / 128) * 256 + (n0 % 128) : ((n0 - DFF) / 128) * 256 + 128 + ((n0 - DFF) % 128);
                p0_tr(a.in[I_WFFI], 1024, 5632, (bf16_t*)(ws + WS_WFFI), nullptr, nullptr, kb, nb, drow - n0, scr, lane); continue; } r -= T_FFI;
            if (r < T_FFO) { p0_tr(a.in[I_WFFO], DFF, 1024, (bf16_t*)(ws + WS_WFFO), nullptr, nullptr, r / 32, r % 32, 0, scr, lane); continue; } r -= T_FFO;
            if (r < T_IN) { p0_tr(a.in[I_WIN], 1024, 2240, (bf16_t*)(ws + WS_WIN), nullptr, nullptr, r / 70, r % 70, 0, scr, lane); continue; } r -= T_IN;
            if (r < T_OUT) { p0_tr(a.in[I_WOUT], 1024, 1024, (bf16_t*)(ws + WS_WOUT), nullptr, nullptr, r / 32, r % 32, 0, scr, lane); continue; } r -= T_OUT;
            if (r < T_UQ) { p0_tr(a.in[I_WUQ], 384, 768, (bf16_t*)(ws + WS_WUQ), nullptr, a.in[I_QN], r / 24, r % 24, 0, scr, lane); continue; } r -= T_UQ;
            if (r < T_UKV) { const int nb = r % 32, n0 = nb * 32, hh = n0 >> 7, j0 = n0 & 127; const bool isv = j0 >= 64; const int drow = hh * 64 + (j0 & 63);
                p0_tr(a.in[I_WUKV], 256, 1024, (bf16_t*)(ws + (isv ? WS_WVF : WS_WKF)), (bf16_t*)(ws + (isv ? WS_WVU : WS_WKU)), a.in[I_KVN], r / 32, nb, drow - n0, scr, lane); continue; } r -= T_UKV;
            { u32x4 z = {0u, 0u, 0u, 0u}; u32x4* p = (u32x4*)((bf16_t*)(ws + WS_WIN) + (size_t)(2240 + r) * 1024); p[lane] = z; p[64 + lane] = z; }
        }
    }
    if (P0MASK & 4) {
        const int gt = vcu * 512 + tid, NT = G * 512;
        for (int i = gt; i < 32768; i += NT) { const f32x4 v = ((const f32x4*)a.in[I_CKV])[i]; u32x2 w; w.x = cvt_pk_bf16(v[0], v[1]); w.y = cvt_pk_bf16(v[2], v[3]); ((u32x2*)(ws + WS_CACHEB))[i] = w; }
    }
}

__device__ __forceinline__ f32x4 mod4(const float* modp, const float* bias, int ci, int off) {
    const float* p = modp + ci * 6144 + off;
    return ((*(const f32x4*)p + *(const f32x4*)(p + 18432)) + (*(const f32x4*)(p + 36864) + *(const f32x4*)(p + 55296))) + *(const f32x4*)(bias + off);
}
__device__ __forceinline__ void phase1(const Args& a, int wv, int vcu, int G) {
    if (PROBE_FILL == 3) { float* m = (float*)(a.ws + WS_MOD); for (int i = otid(wv); i < 3 * 6144; i += 512) { unsigned h = (unsigned)i * 2654435761u; h ^= h >> 15; h *= 2246822519u; h ^= h >> 13; m[i] = ((float)(h & 0xffff) * (1.f / 65536.f) - 0.5f) * 2.f; } __syncthreads(); }
    const int tid_ = otid(wv); const int lane = tid_ & 63, wave = tid_ >> 6; const int gw = vcu * 8 + wave, NGW = G * 8;
    const float* mod = (const float*)(a.ws + WS_MOD + PROBE_MODOFF); bf16_t* H = (bf16_t*)(a.ws + WS_H);
    for (int r = gw; r < MTOK; r += NGW * PROBE_RSTRIDE) {
        const f32x4* xr = (const f32x4*)xrow_ptr(a, r) + lane; const int ci_ = cond_of_row(r);
        f32x4 v[4]; float s = 0.f;
#pragma unroll
        for (int j = 0; j < 4; ++j) { v[j] = xr[64 * j]; s += (v[j][0] * v[j][0] + v[j][1] * v[j][1]) + (v[j][2] * v[j][2] + v[j][3] * v[j][3]); }
        const float rstd = rsqrtf(wave_sum(s) * (1.f / D) + EPS);
        u32x2* o = (u32x2*)(H + (size_t)r * D) + lane;
#pragma unroll
        for (int j = 0; j < 4; ++j) { const int c = 4 * lane + 256 * j; const f32x4 w = *(const f32x4*)(a.in[I_NATT] + c), sh = mod4(mod, a.in[I_BADA], ci_, c), scv = mod4(mod, a.in[I_BADA], ci_, 1024 + c);
            const f32x4 y = v[j] * rstd * w * (scv * PROBE_MUL + 1.f) + sh * PROBE_MUL; u32x2 p; p.x = cvt_pk_bf16(y[0], y[1]); p.y = cvt_pk_bf16(y[2], y[3]); if (PROBE_NOSTORE) { if ((p.x ^ p.y) == 0x12345u) o[64 * j] = p; } else o[64 * j] = p; }
    }
}
__device__ __forceinline__ void phase6(const Args& a, int wv, int vcu, int G) {
    const int tid_ = otid(wv); const int lane = tid_ & 63, wave = tid_ >> 6; const int gw = vcu * 8 + wave, NGW = G * 8;
    const float* mod = (const float*)(a.ws + WS_MOD); bf16_t* H = (bf16_t*)(a.ws + WS_H); float* X1 = (float*)(a.ws + WS_X1);
    const float* P0 = (const float*)(a.ws + WS_P0); const float* P1 = (const float*)(a.ws + WS_P1A);
    for (int r = gw; r < MTOK; r += NGW) {
        const f32x4* xr = (const f32x4*)xrow_ptr(a, r) + lane; const int ci_ = cond_of_row(r);
        const f32x4* p0 = (const f32x4*)(P0 + (size_t)r * D) + lane; const f32x4* p1 = (const f32x4*)(P1 + (size_t)r * D) + lane;
        f32x4 v[4]; float s = 0.f;
#pragma unroll
        for (int j = 0; j < 4; ++j) { const int c = 4 * lane + 256 * j; const f32x4 gt = mod4(mod, a.in[I_BADA], ci_, 2048 + c);
            v[j] = xr[64 * j] + gt * (p0[64 * j] + p1[64 * j]); s += (v[j][0] * v[j][0] + v[j][1] * v[j][1]) + (v[j][2] * v[j][2] + v[j][3] * v[j][3]); }
        const float rstd = rsqrtf(wave_sum(s) * (1.f / D) + EPS);
        f32x4* x1 = (f32x4*)(X1 + (size_t)r * D) + lane; u32x2* o = (u32x2*)(H + (size_t)r * D) + lane;
#pragma unroll
        for (int j = 0; j < 4; ++j) { const int c = 4 * lane + 256 * j; x1[64 * j] = v[j];
            const f32x4 w = *(const f32x4*)(a.in[I_NFFN] + c), sh = mod4(mod, a.in[I_BADA], ci_, 3072 + c), scv = mod4(mod, a.in[I_BADA], ci_, 4096 + c);
            const f32x4 y = v[j] * rstd * w * (scv + 1.f) + sh; u32x2 p; p.x = cvt_pk_bf16(y[0], y[1]); p.y = cvt_pk_bf16(y[2], y[3]); o[64 * j] = p; }
    }
}
__device__ __forceinline__ void phase9(const Args& a, int wv, int vcu, int G) {
    const int tid_ = otid(wv); const int lane = tid_ & 63, wave = tid_ >> 6; const int gw = vcu * 8 + wave, NGW = G * 8;
    const float* mod = (const float*)(a.ws + WS_MOD); const float* X1 = (const float*)(a.ws + WS_X1);
    const float* P0 = (const float*)(a.ws + WS_P0); const float* P1 = (const float*)(a.ws + WS_P1B);
    for (int r = gw; r < MTOK; r += NGW) {
        const f32x4* xr = (const f32x4*)(X1 + (size_t)r * D) + lane; const int ci_ = cond_of_row(r);
        const f32x4* p0 = (const f32x4*)(P0 + (size_t)r * D) + lane; const f32x4* p1 = (const f32x4*)(P1 + (size_t)r * D) + lane;
        f32x4 v[4]; float s = 0.f;
#pragma unroll
        for (int j = 0; j < 4; ++j) { const int c = 4 * lane + 256 * j; const f32x4 gt = mod4(mod, a.in[I_BADA], ci_, 5120 + c);
            v[j] = xr[64 * j] + gt * (p0[64 * j] + p1[64 * j]); s += (v[j][0] * v[j][0] + v[j][1] * v[j][1]) + (v[j][2] * v[j][2] + v[j][3] * v[j][3]); }
        const float rstd = rsqrtf(wave_sum(s) * (1.f / D) + EPS);
        f32x4* y = (f32x4*)(a.out + O_Y + (size_t)r * D) + lane;
#pragma unroll
        for (int j = 0; j < 4; ++j) { const int c = 4 * lane + 256 * j; const f32x4 w = *(const f32x4*)(a.in[I_FN] + c); y[64 * j] = v[j] * rstd * w; }
    }
}

__device__ __forceinline__ void p3_row_extras(const Args& a, int wv, int gw, int NGW) {
    const int lane = otid(wv) & 63;
    const bf16_t* Z = (const bf16_t*)(a.ws + WS_Z); const float* rsskv = (const float*)(a.ws + WS_RSSKV);
    bf16_t* Kp = (bf16_t*)(a.ws + WS_KP); bf16_t* Ks = (bf16_t*)(a.ws + WS_KS);
    const float inv[8] = {1.f, 0.316227766f, 0.1f, 0.0316227766f, 0.01f, 0.00316227766f, 0.001f, 0.000316227766f};
    for (int r = gw; r < MTOK + 512; r += NGW) {
        if (r < MTOK) {
            const bf16_t* zr = Z + (size_t)r * ZP;
            if (r < MP) {
                const float rs = rsqrtf(pg8::rss_kv(rsskv, r) * (1.f / 256.f) + EPS);
                const u32x2 w = *(const u32x2*)(zr + C_KVLAT + 4 * lane); const f32x4 g = *(const f32x4*)(a.in[I_KVN] + 4 * lane);
                f32x4 o; o[0] = bflo(w.x) * rs * g[0]; o[1] = bfhi(w.x) * rs * g[1]; o[2] = bflo(w.y) * rs * g[2]; o[3] = bfhi(w.y) * rs * g[3];
                *(f32x4*)(a.out + O_KV + (size_t)r * 256 + 4 * lane) = o;
            }
            const int i = lane & 31;
            float v = bf2f(zr[C_KROPE + i]);
            if (r < MP && lane < 32) a.out[O_KR + (size_t)r * 32 + i] = v;
            const float pv = __shfl_xor(v, 8);
            int b, s; bf16_t* kb;
            if (r >= MP) { const int t = (r - MP) & 2047; const float pos = (float)((i < 16) ? (t >> 6) : (t & 63));
                const float rev = pos * inv[i & 7] * 0.15915494309189535f; const float rf = rev - floorf(rev);
                const float cs = __builtin_amdgcn_cosf(rf), sn = __builtin_amdgcn_sinf(rf); v = v * cs + ((i & 8) ? pv : -pv) * sn;
                b = (r - MP) >> 11; s = 256 + t; kb = Ks + ((size_t)(b * 8) * SKS + s) * 96 + 64 + i;
                const bf16_t o = f2bf(v);
                if (lane < 32) { for (int h = 0; h < 8; ++h) kb[(size_t)h * SKS * 96] = o; }
            } else { b = r >> 8; s = r & 255; kb = Kp + ((size_t)(b * 8) * 256 + s) * 96 + 64 + i; const bf16_t o = f2bf(v);
                if (lane < 32) { for (int h = 0; h < 8; ++h) kb[(size_t)h * 256 * 96] = o; } }
        } else {
            const int rr = r - MTOK, b = rr >> 8, s = rr & 255, i = lane & 31;
            const bf16_t o = f2bf(a.in[I_CKR][(size_t)rr * 32 + i]); bf16_t* kb = Ks + ((size_t)(b * 8) * SKS + s) * 96 + 64 + i;
            if (lane < 32) { for (int h = 0; h < 8; ++h) kb[(size_t)h * SKS * 96] = o; }
        }
    }
}

constexpr int GL_LOW = 0, GL_WG = 8192, GL_BG = 16384, GL_SEG = 16896, GL_RED = 20992, GL_VT = 22528, GL_QF = 40960, GL_KF = GL_QF + 9216, GL_QB = GL_KF + 9216, GL_KB = GL_QB + 9216;
constexpr int GROW = 144;

__device__ __forceinline__ void gla_gates(const Args& a, int wv, LAS unsigned char* lds, int r0, int h, float (&cumF)[8], float (&cumB)[8], float& totF, float& totB) {
    const int tid = otid(wv), d = tid & 63, tg = tid >> 6;
    const bf16_t* Z = (const bf16_t*)(a.ws + WS_Z);
    LAS float* low = (LAS float*)(lds + GL_LOW); LAS float* wg = (LAS float*)(lds + GL_WG); LAS float* bg = (LAS float*)(lds + GL_BG); LAS float* seg = (LAS float*)(lds + GL_SEG);
    { const int t = tid >> 3, r4 = (tid & 7) * 4; const u32x2 w = *(const u32x2*)(Z + (size_t)(r0 + t) * ZP + C_GFL + r4);
      low[t * 32 + r4] = bflo(w.x); low[t * 32 + r4 + 1] = bfhi(w.x); low[t * 32 + r4 + 2] = bflo(w.y); low[t * 32 + r4 + 3] = bfhi(w.y); }
    { const int dir = tid >> 8, r = (tid >> 4) & 15, d4 = (tid & 15) * 4; const f32x4 w = *(const f32x4*)(a.in[dir ? I_WGB : I_WGF] + r * 256 + h * 64 + d4);
      *(LAS f32x4*)(wg + (dir * 16 + r) * 64 + d4) = w; }
    if (tid < 128) { const int dir = tid >> 6; bg[tid] = a.in[dir ? I_BGB : I_BGF][h * 64 + (tid & 63)]; }
    __syncthreads();
    float wf[16], wb[16];
#pragma unroll
    for (int r = 0; r < 16; ++r) { wf[r] = wg[r * 64 + d]; wb[r] = wg[(16 + r) * 64 + d]; }
    const float bf_ = bg[d], bb_ = bg[64 + d];
    float gf[8], gb[8];
#pragma unroll
    for (int i = 0; i < 8; ++i) { const int t = tg * 8 + i; float xf = bf_, xb = bb_;
#pragma unroll
        for (int r = 0; r < 16; ++r) { xf += low[t * 32 + r] * wf[r]; xb += low[t * 32 + 16 + r] * wb[r]; }
        gf[i] = logsigmoid_f(xf) * (1.f / 16.f); gb[i] = logsigmoid_f(xb) * (1.f / 16.f); }
#pragma unroll
    for (int i = 1; i < 8; ++i) gf[i] += gf[i - 1];
#pragma unroll
    for (int i = 6; i >= 0; --i) gb[i] += gb[i + 1];
    seg[tg * 64 + d] = gf[7]; seg[512 + tg * 64 + d] = gb[0];
    __syncthreads();
    float offF = 0.f, offB = 0.f; totF = 0.f; totB = 0.f;
#pragma unroll
    for (int g = 0; g < 8; ++g) { const float sf = seg[g * 64 + d], sb = seg[512 + g * 64 + d]; totF += sf; totB += sb; if (g < tg) offF += sf; if (g > tg) offB += sb; }
#pragma unroll
    for (int i = 0; i < 8; ++i) { cumF[i] = gf[i] + offF; cumB[i] = gb[i] + offB; }
}
__device__ __forceinline__ void gla_load_vT(const Args& a, int wv, LAS unsigned char* lds, int r0, int h) {
    const int tid = otid(wv), e = tid & 127, tq = tid >> 7;
    const bf16_t* Z = (const bf16_t*)(a.ws + WS_Z) + (size_t)r0 * ZP + C_GV + h * 128 + e;
    unsigned w[8];
#pragma unroll
    for (int i = 0; i < 8; ++i) { const unsigned lo = Z[(size_t)(tq * 16 + 2 * i) * ZP], hi = Z[(size_t)(tq * 16 + 2 * i + 1) * ZP]; w[i] = lo | (hi << 16); }
    LAS u32x4* p = (LAS u32x4*)(lds + GL_VT + e * GROW + tq * 32);
    p[0] = (u32x4){w[0], w[1], w[2], w[3]}; p[1] = (u32x4){w[4], w[5], w[6], w[7]};
}

__device__ __forceinline__ void gla_stepA(const Args& a, int wv, LAS unsigned char* lds, int u) {
    const int tid = otid(wv), lane = tid & 63, wave = __builtin_amdgcn_readfirstlane(tid >> 6), d = tid & 63, tg = tid >> 6, fr = lane & 15, fq = lane >> 4;
    const int cgi = u >> 2, h = u & 3, r0 = cgi * 64;
    const bf16_t* Z = (const bf16_t*)(a.ws + WS_Z);
    float cumF[8], cumB[8], totF, totB;
    gla_gates(a, wv, lds, r0, h, cumF, cumB, totF, totB);
    unsigned kf[4], kb[4];
#pragma unroll
    for (int i = 0; i < 4; ++i) { const float k0 = bf2f(Z[(size_t)(r0 + tg * 8 + 2 * i) * ZP + C_GK + h * 64 + d]), k1 = bf2f(Z[(size_t)(r0 + tg * 8 + 2 * i + 1) * ZP + C_GK + h * 64 + d]);
        kf[i] = cvt_pk_bf16(k0 * __expf(totF - cumF[2 * i]), k1 * __expf(totF - cumF[2 * i + 1]));
        kb[i] = cvt_pk_bf16(k0 * __expf(totB - cumB[2 * i]), k1 * __expf(totB - cumB[2 * i + 1])); }
    *(LAS u32x4*)(lds + GL_QF + d * GROW + tg * 16) = (u32x4){kf[0], kf[1], kf[2], kf[3]};
    *(LAS u32x4*)(lds + GL_KF + d * GROW + tg * 16) = (u32x4){kb[0], kb[1], kb[2], kb[3]};
    gla_load_vT(a, wv, lds, r0, h);
    if (tg == 0) { float* dec = (float*)(a.ws + WS_DEC) + (size_t)u * 128; dec[d] = __expf(totF); dec[64 + d] = __expf(totB); }
    __syncthreads();
    const int dir = wave >> 2, eb0 = 2 * (wave & 3);
    const LAS unsigned char* kd = lds + (dir ? GL_KF : GL_QF);
    float* CT = (float*)(a.ws + WS_CT) + ((size_t)u * 2 + dir) * 8192;
#pragma unroll
    for (int eb = 0; eb < 2; ++eb) {
        bf16x8 vf[2];
#pragma unroll
        for (int ks = 0; ks < 2; ++ks) vf[ks] = *(const LAS bf16x8*)(lds + GL_VT + (16 * (eb0 + eb) + fr) * GROW + (32 * ks + 8 * fq) * 2);
#pragma unroll
        for (int db = 0; db < 4; ++db) { f32x4 c = {0.f, 0.f, 0.f, 0.f};
#pragma unroll
            for (int ks = 0; ks < 2; ++ks) { const bf16x8 kfr = *(const LAS bf16x8*)(kd + (16 * db + fr) * GROW + (32 * ks + 8 * fq) * 2); c = __builtin_amdgcn_mfma_f32_16x16x32_bf16(vf[ks], kfr, c, 0, 0, 0); }
#pragma unroll
            for (int j = 0; j < 4; ++j) CT[(16 * (eb0 + eb) + 4 * fq + j) * 64 + 16 * db + fr] = c[j]; }
    }
    __syncthreads();
}

__device__ __forceinline__ void gla_scan(const Args& a, int wv, int vcu, int G) {
    const int gt = vcu * 512 + otid(wv), NT = G * 512;
    float* CTb = (float*)(a.ws + WS_CT); const float* DEC = (const float*)(a.ws + WS_DEC);
    for (int it = gt; it < 32768 + 262144; it += NT) {
        int seq, N, cg0, x;
        if (it < 32768) { seq = 16 + (it >> 14); x = it & 16383; N = 32; cg0 = 64 + 32 * (seq - 16); } else { const int j = it - 32768; seq = j >> 14; x = j & 16383; N = 4; cg0 = 4 * seq; }
        const int h = x >> 12, dir = (x >> 11) & 1, e = (x >> 4) & 127, d4 = (x & 15) * 4;
        f32x4 st = {0.f, 0.f, 0.f, 0.f};
        if (seq >= 16) { const float* s0 = a.in[dir ? I_SB : I_SF] + ((size_t)((seq - 16) * 4 + h) * 64) * 128 + e;
#pragma unroll
            for (int i = 0; i < 4; ++i) st[i] = s0[(size_t)(d4 + i) * 128]; }
        for (int n0 = 0; n0 < N; n0 += 4) {
            f32x4 c[4], dc[4];
#pragma unroll
            for (int i = 0; i < 4; ++i) { const int n = dir ? (N - 1 - n0 - i) : (n0 + i); const int u = (cg0 + n) * 4 + h;
                c[i] = *(const f32x4*)(CTb + ((size_t)u * 2 + dir) * 8192 + e * 64 + d4); dc[i] = *(const f32x4*)(DEC + (size_t)u * 128 + dir * 64 + d4); }
#pragma unroll
            for (int i = 0; i < 4; ++i) { const int n = dir ? (N - 1 - n0 - i) : (n0 + i); const int u = (cg0 + n) * 4 + h;
                *(f32x4*)(CTb + ((size_t)u * 2 + dir) * 8192 + e * 64 + d4) = st; st = dc[i] * st + c[i]; }
        }
        if (seq < 16) { float* o = a.out + (dir ? O_SB : O_SF) + ((size_t)(seq * 4 + h) * 64) * 128 + e;
#pragma unroll
            for (int i = 0; i < 4; ++i) o[(size_t)(d4 + i) * 128] = st[i]; }
    }
}

__device__ __forceinline__ void gla_stepC(const Args& a, int wv, LAS unsigned char* lds, int u) {
    const int tid = otid(wv), lane = tid & 63, wave = __builtin_amdgcn_readfirstlane(tid >> 6), d = tid & 63, tg = tid >> 6, fr = lane & 15, fq = lane >> 4;
    const int cgi = u >> 2, h = u & 3, r0 = cgi * 64;
    const bf16_t* Z = (const bf16_t*)(a.ws + WS_Z);
    float cumF[8], cumB[8], totF, totB;
    gla_gates(a, wv, lds, r0, h, cumF, cumB, totF, totB);
#pragma unroll
    for (int i = 0; i < 8; ++i) { const int t = tg * 8 + i; const float q = bf2f(Z[(size_t)(r0 + t) * ZP + C_GQ + h * 64 + d]) * 0.125f, k = bf2f(Z[(size_t)(r0 + t) * ZP + C_GK + h * 64 + d]);
        *(LAS bf16_t*)(lds + GL_QF + t * GROW + d * 2) = f2bf(q * __expf(cumF[i]));
        *(LAS bf16_t*)(lds + GL_KF + t * GROW + d * 2) = f2bf(k * __expf(-cumF[i]));
        *(LAS bf16_t*)(lds + GL_QB + t * GROW + d * 2) = f2bf(q * __expf(cumB[i]));
        *(LAS bf16_t*)(lds + GL_KB + t * GROW + d * 2) = f2bf(k * __expf(-cumB[i])); }
    gla_load_vT(a, wv, lds, r0, h);
    __syncthreads();
    const int ch = wave & 1, eq = wave >> 1;
    f32x4 oT[2][2];
#pragma unroll
    for (int i = 0; i < 2; ++i)
#pragma unroll
        for (int j = 0; j < 2; ++j) oT[i][j] = (f32x4){0.f, 0.f, 0.f, 0.f};
#pragma unroll
    for (int dir = 0; dir < 2; ++dir) {
        const LAS unsigned char* qe = lds + (dir ? GL_QB : GL_QF); const LAS unsigned char* ke = lds + (dir ? GL_KB : GL_KF);
        const float* ST = (const float*)(a.ws + WS_CT) + ((size_t)u * 2 + dir) * 8192;
        bf16x8 sf[2][2];
#pragma unroll
        for (int eb = 0; eb < 2; ++eb)
#pragma unroll
            for (int ks = 0; ks < 2; ++ks) { const float* p = ST + (16 * (2 * eq + eb) + fr) * 64 + 32 * ks + 8 * fq; const f32x4 x0 = *(const f32x4*)p, x1 = *(const f32x4*)(p + 4);
                u32x4 w; w.x = cvt_pk_bf16(x0[0], x0[1]); w.y = cvt_pk_bf16(x0[2], x0[3]); w.z = cvt_pk_bf16(x1[0], x1[1]); w.w = cvt_pk_bf16(x1[2], x1[3]); sf[eb][ks] = __builtin_bit_cast(bf16x8, w); }
#pragma unroll
        for (int cb = 0; cb < 2; ++cb) {
            const int cbg = 2 * ch + cb;
            bf16x8 qf[2];
#pragma unroll
            for (int ks = 0; ks < 2; ++ks) qf[ks] = *(const LAS bf16x8*)(qe + (16 * cbg + fr) * GROW + (32 * ks + 8 * fq) * 2);
            f32x4 att[4];
#pragma unroll
            for (int sb = 0; sb < 4; ++sb) {
                f32x4 acc = {0.f, 0.f, 0.f, 0.f};
                const bool need = dir == 0 ? (sb <= cbg) : (sb >= cbg);
                if (need) {
#pragma unroll
                    for (int ks = 0; ks < 2; ++ks) { const bf16x8 kfr = *(const LAS bf16x8*)(ke + (16 * sb + fr) * GROW + (32 * ks + 8 * fq) * 2); acc = __builtin_amdgcn_mfma_f32_16x16x32_bf16(kfr, qf[ks], acc, 0, 0, 0); }
                    if (sb == cbg) {
#pragma unroll
                        for (int j = 0; j < 4; ++j) { const int sl = 4 * fq + j; const bool keep = dir == 0 ? (sl <= fr) : (sl >= fr); acc[j] = keep ? acc[j] : 0.f; } }
                }
                att[sb] = acc;
            }
#pragma unroll
            for (int kp = 0; kp < 2; ++kp) {
                u32x4 w; w.x = cvt_pk_bf16(att[2 * kp][0], att[2 * kp][1]); w.y = cvt_pk_bf16(att[2 * kp][2], att[2 * kp][3]); w.z = cvt_pk_bf16(att[2 * kp + 1][0], att[2 * kp + 1][1]); w.w = cvt_pk_bf16(att[2 * kp + 1][2], att[2 * kp + 1][3]);
                const bf16x8 pb = __builtin_bit_cast(bf16x8, w);
#pragma unroll
                for (int eb = 0; eb < 2; ++eb) { const LAS unsigned char* vp = lds + GL_VT + (16 * (2 * eq + eb) + fr) * GROW + (32 * kp + 4 * fq) * 2;
                    const u32x2 v0 = *(const LAS u32x2*)vp, v1 = *(const LAS u32x2*)(vp + 32); const u32x4 vv = {v0.x, v0.y, v1.x, v1.y};
                    oT[eb][cb] = __builtin_amdgcn_mfma_f32_16x16x32_bf16(__builtin_bit_cast(bf16x8, vv), pb, oT[eb][cb], 0, 0, 0); }
            }
#pragma unroll
            for (int ks = 0; ks < 2; ++ks)
#pragma unroll
                for (int eb = 0; eb < 2; ++eb) oT[eb][cb] = __builtin_amdgcn_mfma_f32_16x16x32_bf16(sf[eb][ks], qf[ks], oT[eb][cb], 0, 0, 0);
        }
    }
    LAS float* red = (LAS float*)(lds + GL_RED);
#pragma unroll
    for (int cb = 0; cb < 2; ++cb) { float s = 0.f;
#pragma unroll
        for (int eb = 0; eb < 2; ++eb)
#pragma unroll
            for (int j = 0; j < 4; ++j) s += oT[eb][cb][j] * oT[eb][cb][j];
        s += __shfl_xor(s, 16); s += __shfl_xor(s, 32);
        if (fq == 0) red[eq * 64 + 16 * (2 * ch + cb) + fr] = s; }
    __syncthreads();
    bf16_t* MIX = (bf16_t*)(a.ws + WS_MIX);
#pragma unroll
    for (int cb = 0; cb < 2; ++cb) { const int c = 16 * (2 * ch + cb) + fr; const float tot = red[c] + red[64 + c] + red[128 + c] + red[192 + c]; const float rstd = rsqrtf(tot * (1.f / 128.f) + EPS);
#pragma unroll
        for (int eb = 0; eb < 2; ++eb) { const int e = 16 * (2 * eq + eb) + 4 * fq; const f32x4 gn = *(const f32x4*)(a.in[I_GLAN] + e);
            const u32x2 gw = *(const u32x2*)(Z + (size_t)(r0 + c) * ZP + C_GOUT + h * 128 + e);
            const float g0 = bflo(gw.x), g1 = bfhi(gw.x), g2 = bflo(gw.y), g3 = bfhi(gw.y);
            const f32x4 o = oT[eb][cb] * rstd * gn; u32x2 w; w.x = cvt_pk_bf16(o[0] * silu_f(g0), o[1] * silu_f(g1)); w.y = cvt_pk_bf16(o[2] * silu_f(g2), o[3] * silu_f(g3));
            *(u32x2*)(MIX + (size_t)(r0 + c) * D + 512 + h * 128 + e) = w; } }
    __syncthreads();
}

constexpr int AT_KROW = 208, AT_VROW = 144, AT_KB = 64 * AT_KROW  , AT_STAGE = AT_KB + 64 * AT_VROW  ;
__device__ __forceinline__ void attn_unit(const Args& a, int wv, LAS unsigned char* lds, int idx) {
    const int tid = otid(wv), lane = tid & 63, wave = __builtin_amdgcn_readfirstlane(tid >> 6), fr = lane & 15, fq = lane >> 4;
    int row0, S, nt; const bf16_t* Kb; const bf16_t* Vb; int h;
    if (idx < 256) { const int b = idx >> 7, qb = idx & 15; h = (idx >> 4) & 7; row0 = MP + b * 2048 + qb * 128; S = SKS; nt = 36;
        Kb = (const bf16_t*)(a.ws + WS_KS) + (size_t)(b * 8 + h) * SKS * 96; Vb = (const bf16_t*)(a.ws + WS_VTS) + (size_t)(b * 8 + h) * 64 * SKS; }
    else { const int j = idx - 256; const int b = j >> 4, qb = j & 1; h = (j >> 1) & 7; row0 = b * 256 + qb * 128; S = 256; nt = 4;
        Kb = (const bf16_t*)(a.ws + WS_KP) + (size_t)(b * 8 + h) * 256 * 96; Vb = (const bf16_t*)(a.ws + WS_VTP) + (size_t)(b * 8 + h) * 64 * 256; }
    const char* src[3]; unsigned step[3]; unsigned dst[3]; bool valid[3];
#pragma unroll
    for (int j = 0; j < 3; ++j) { const int ins = wave + 8 * j; valid[j] = ins < 22;
        if (ins < 13) { const int ck = ins * 64 + lane, r = ck / 13, cc = ck % 13; src[j] = (const char*)Kb + (size_t)r * 192 + (cc < 12 ? cc : 11) * 16; step[j] = 64 * 192; dst[j] = ins * 1024; }
        else { const int cv = (ins - 13) * 64 + lane, r = cv / 9, cc = cv % 9; src[j] = (const char*)Vb + (size_t)r * S * 2 + (cc < 8 ? cc : 7) * 16; step[j] = 128; dst[j] = AT_KB + (ins - 13) * 1024; } }
#define AT_ISSUE(t, buf) do { _Pragma("unroll") for (int j = 0; j < 3; ++j) if (valid[j]) \
        __builtin_amdgcn_global_load_lds((const unsigned*)(src[j] + (size_t)(t) * step[j]), (LAS unsigned*)(lds + (buf) * AT_STAGE + dst[j]), 16, 0, 0); } while (0)
    AT_ISSUE(0, 0);
    const bf16_t* Q = (const bf16_t*)(a.ws + WS_Q) + (size_t)(row0 + wave * 16 + fr) * 768 + h * 96 + 8 * fq;
    bf16x8 qf[3];
#pragma unroll
    for (int ks = 0; ks < 3; ++ks) qf[ks] = *(const bf16x8*)(Q + 32 * ks);
    float mrun = -1e30f, lsum = 0.f;
    f32x4 o[4];
#pragma unroll
    for (int i = 0; i < 4; ++i) o[i] = (f32x4){0.f, 0.f, 0.f, 0.f};
    for (int t = 0; t < nt; ++t) {
        VM_WAIT(); __syncthreads();
        if (t + 1 < nt) AT_ISSUE(t + 1, (t + 1) & 1);
        const LAS unsigned char* kt = lds + (t & 1) * AT_STAGE; const LAS unsigned char* vt = kt + AT_KB;
        f32x4 s[4];
#pragma unroll
        for (int kb = 0; kb < 4; ++kb) { s[kb] = (f32x4){0.f, 0.f, 0.f, 0.f};
#pragma unroll
            for (int ks = 0; ks < 3; ++ks) { const bf16x8 kf = *(const LAS bf16x8*)(kt + (16 * kb + fr) * AT_KROW + (32 * ks + 8 * fq) * 2); s[kb] = __builtin_amdgcn_mfma_f32_16x16x32_bf16(kf, qf[ks], s[kb], 0, 0, 0); } }
        float mx = fmaxf(fmaxf(fmaxf(s[0][0], s[0][1]), fmaxf(s[0][2], s[0][3])), fmaxf(fmaxf(s[1][0], s[1][1]), fmaxf(s[1][2], s[1][3])));
        mx = fmaxf(mx, fmaxf(fmaxf(fmaxf(s[2][0], s[2][1]), fmaxf(s[2][2], s[2][3])), fmaxf(fmaxf(s[3][0], s[3][1]), fmaxf(s[3][2], s[3][3]))));
        mx = fmaxf(mx, __shfl_xor(mx, 16)); mx = fmaxf(mx, __shfl_xor(mx, 32));
        const float mnew = fmaxf(mrun, mx); const float alpha = __builtin_amdgcn_exp2f(mrun - mnew); mrun = mnew;
        float ps = 0.f;
#pragma unroll
        for (int kb = 0; kb < 4; ++kb)
#pragma unroll
            for (int j = 0; j < 4; ++j) { s[kb][j] = __builtin_amdgcn_exp2f(s[kb][j] - mnew); ps += s[kb][j]; }
        lsum = lsum * alpha + ps;
#pragma unroll
        for (int i = 0; i < 4; ++i) o[i] = o[i] * alpha;
#pragma unroll
        for (int kp = 0; kp < 2; ++kp) {
            u32x4 w; w.x = cvt_pk_bf16(s[2 * kp][0], s[2 * kp][1]); w.y = cvt_pk_bf16(s[2 * kp][2], s[2 * kp][3]); w.z = cvt_pk_bf16(s[2 * kp + 1][0], s[2 * kp + 1][1]); w.w = cvt_pk_bf16(s[2 * kp + 1][2], s[2 * kp + 1][3]);
            const bf16x8 pb = __builtin_bit_cast(bf16x8, w);
#pragma unroll
            for (int mb = 0; mb < 4; ++mb) { const LAS unsigned char* vp = vt + (16 * mb + fr) * AT_VROW + (32 * kp + 4 * fq) * 2;
                const u32x2 v0 = *(const LAS u32x2*)vp, v1 = *(const LAS u32x2*)(vp + 32); const u32x4 vv = {v0.x, v0.y, v1.x, v1.y};
                o[mb] = __builtin_amdgcn_mfma_f32_16x16x32_bf16(__builtin_bit_cast(bf16x8, vv), pb, o[mb], 0, 0, 0); }
        }
    }
    lsum += __shfl_xor(lsum, 16); lsum += __shfl_xor(lsum, 32);
    const float il = fast_rcp(lsum);
    bf16_t* MIX = (bf16_t*)(a.ws + WS_MIX) + (size_t)(row0 + wave * 16 + fr) * D + h * 64 + 4 * fq;
#pragma unroll
    for (int mb = 0; mb < 4; ++mb) { u32x2 w; w.x = cvt_pk_bf16(o[mb][0] * il, o[mb][1] * il); w.y = cvt_pk_bf16(o[mb][2] * il, o[mb][3] * il); *(u32x2*)(MIX + 16 * mb) = w; }
    __syncthreads();
#undef AT_ISSUE
}

__device__ unsigned g_bar[64 * 52];
#define GB(i) (g_bar + 64 * (i))
__device__ __forceinline__ unsigned gb_ld(unsigned* p) { return __hip_atomic_load(p, __ATOMIC_RELAXED, __HIP_MEMORY_SCOPE_AGENT); }
__device__ __forceinline__ unsigned gb_add(unsigned* p, unsigned v) { return __hip_atomic_fetch_add(p, v, __ATOMIC_RELAXED, __HIP_MEMORY_SCOPE_AGENT); }
__device__ __forceinline__ unsigned xcc_id() { return (unsigned)__builtin_amdgcn_s_getreg((3 << 11) | 20) & 0xFu; }
__device__ __forceinline__ void my_grid_barrier(unsigned nth, unsigned G, int tid, LAS unsigned* st) {
    asm volatile("s_waitcnt vmcnt(0) lgkmcnt(0)" ::: "memory");
    __syncthreads();
    if (tid == 0) {
        if (nth == 1u) {
            const unsigned x = xcc_id(); unsigned sum, cnt, mine;
            for (;;) { sum = 0u; cnt = 0u; mine = 0u;
#pragma unroll
                for (unsigned j = 0; j < 16; ++j) { const unsigned c = gb_ld(GB(4 + j)); sum += c; cnt += (c > 0u) ? 1u : 0u; mine = (j == x) ? c : mine; }
                if (sum >= G) break; __builtin_amdgcn_s_sleep(1); }
            st[0] = mine; st[1] = cnt; st[2] = x;
        }
        const unsigned nloc = st[0], nx = st[1], x = st[2];
        const unsigned old = gb_add(GB(20 + x), 1u);
        if (old + 1u == nth * nloc) {
            __builtin_amdgcn_fence(__ATOMIC_RELEASE, "agent");
            asm volatile("s_waitcnt vmcnt(0)" ::: "memory");
            const unsigned og = gb_add(GB(1), 1u);
            if (og + 1u == nth * nx) gb_add(GB(2), 1u);
            else while (gb_ld(GB(2)) < nth) __builtin_amdgcn_s_sleep(1);
            __builtin_amdgcn_fence(__ATOMIC_ACQUIRE, "agent");
            gb_add(GB(36 + x), 1u);
            asm volatile("s_waitcnt vmcnt(0)" ::: "memory");
        } else {
            while (gb_ld(GB(36 + x)) < nth) __builtin_amdgcn_s_sleep(1);
            __builtin_amdgcn_fence(__ATOMIC_ACQUIRE, "agent");
            asm volatile("s_waitcnt vmcnt(0)" ::: "memory");
        }
    }
    __syncthreads();
}
__device__ __forceinline__ void my_grid_barrier_finish(unsigned G, int tid) {
    if (tid == 0) {
        const unsigned old = gb_add(GB(0), 1u);
        if (old == G - 1u) { for (int i = 0; i < 52; ++i) __hip_atomic_store(GB(i), 0u, __ATOMIC_RELAXED, __HIP_MEMORY_SCOPE_AGENT); }
    }
}
constexpr int NPHASE = 11;
__global__ void __launch_bounds__(512, 2) mk_fwd(Args a) {
    const int wv = __builtin_amdgcn_readfirstlane((int)threadIdx.x >> 6);
    extern __shared__ __attribute__((aligned(16))) unsigned char lds_raw[];
    LAS unsigned char* lds = (LAS unsigned char*)lds_raw;
    const int G = gridDim.x, bx = blockIdx.x;
    const int vcu = (G % 8 == 0) ? (bx % 8) * (G / 8) + bx / 8 : bx;
    unsigned char* ws = a.ws;
    const int lo = a.ph_lo, hi = a.ph_hi;
#ifndef PHMASK
#define PHMASK 0x7ff
#endif
#define IN(k) (((PHMASK >> (k)) & 1) && lo <= (k) && (k) < hi)
#define SEAM(k) do { if (IN(k) && IN((k) + 1)) { ++nbar; my_grid_barrier(nbar, (unsigned)G, otid(wv), (LAS unsigned*)(lds + LDS_BYTES - 64)); } } while (0)
#ifndef PROBE_FILL
#define PROBE_FILL 0
#endif
    if (PROBE_FILL && lo == 0) { f32x4* p = (f32x4*)a.ws; const size_t n = (size_t)(PROBE_FILL_MIB) << 16; const float fv = PROBE_FILL_VAL;
        for (size_t i = (size_t)bx * 512 + threadIdx.x; i < n; i += (size_t)G * 512) { unsigned h = (unsigned)i * 2654435761u; h ^= h >> 15; h *= 2246822519u; h ^= h >> 13; const float r0 = (float)(h & 0xffff) * (1.f / 65536.f) - 0.5f + fv * 0.f; p[i] = (f32x4){r0, r0 * 1.7f, r0 * -0.3f, r0 + 0.1f}; } }
    if (PROBE_FILL == 2 && lo == 0 && bx == 0) { static const int szs[26] = {4194304, 4194304, 131072, 16384, 65536, 65536, 2048, 1024, 6291456, 6144, 1024, 2293760, 384, 294912, 256, 262144, 4096, 256, 4096, 256, 128, 1048576, 1024, 5767168, 2883584, 1024};
        float sm = 0.f; for (int i = 0; i < 26; ++i) { const int n = szs[i]; const int st = n > 1024 ? n - 1024 : 0; for (int j = st + (int)threadIdx.x; j < n; j += 512) sm += a.in[i][j]; for (int j = threadIdx.x; j < (n < 1024 ? n : 1024); j += 512) sm += a.in[i][j]; }
        ((float*)(a.ws))[threadIdx.x] = sm; }
    if (PROBE_FILL == 5 && lo == 0) { volatile float* p = (volatile float*)a.ws; const float big = p[0] * 0.f + 1e38f, tiny = p[1] * 0.f + 1e-38f, zero = p[2] * 0.f, neg = p[3] * 0.f - 1.f;
        float r = 0.f;
#if PROBE_EXC & 1
        r += big * big;
#endif
#if PROBE_EXC & 2
        r += tiny * tiny;
#endif
#if PROBE_EXC & 4
        r += 1.f / zero;
#endif
#if PROBE_EXC & 8
        r += __builtin_sqrtf(neg);
#endif
        p[4 + bx] = r; }
    unsigned nbar = 0;
    if (otid(wv) == 0) gb_add(GB(4 + xcc_id()), 1u);
    if (IN(0)) { phase0(a, wv, lds, vcu, G); } SEAM(0);
    if (IN(1) && bx >= PROBE_BLO && bx < PROBE_BHI && (bx & 7) >= PROBE_XLO && (bx & 7) < PROBE_XHI) { for (int rep = 0; rep < PROBE_REP; ++rep) phase1(a, wv, vcu, G); } SEAM(1);
    if (PROBE_HANG && lo == 1) { volatile unsigned* q = (volatile unsigned*)(a.ws + 8); while (*q != 0x12345678u) __builtin_amdgcn_s_sleep(20); }
    if (IN(2)) {
        pg8::Gemm g{(const bf16_t*)(ws + WS_H), (const bf16_t*)(ws + WS_WIN), D, D, D, wv}; pg8::Order S; S.init(MTOK, ZP, 1, G, bx);
        pg8::EpiZ E{(bf16_t*)(ws + WS_Z), (float*)(ws + WS_RSSQ), (float*)(ws + WS_RSSKV)};
        pg8::gemm_phase<pg8::EpiZ, pg8::Order>(lds, g, S, E);
    } SEAM(2);
    if (IN(3)) {
#ifndef P3MASK
#define P3MASK 0x3f
#endif
#if (P3MASK >> 0) & 1
        { pg8::Gemm g{(const bf16_t*)(ws + WS_Z) + C_QLAT, (const bf16_t*)(ws + WS_WUQ), ZP, 384, 384, wv}; pg8::Order S; S.init(MTOK, 768, 1, G, bx);
          pg8::EpiQ E{(bf16_t*)(ws + WS_Q), (const float*)(ws + WS_RSSQ)}; pg8::gemm_phase<pg8::EpiQ, pg8::Order>(lds, g, S, E); }
#endif
#if (P3MASK >> 1) & 1
        { pg8::Gemm g{(const bf16_t*)(ws + WS_Z) + C_KVLAT, (const bf16_t*)(ws + WS_WKF), ZP, 256, 256, wv}; pg8::Order S; S.init(MTOK, 512, 1, G, (bx + G - 96) % G);
          pg8::EpiK E{(bf16_t*)(ws + WS_KP), (bf16_t*)(ws + WS_KS), (const float*)(ws + WS_RSSKV), 0}; pg8::gemm_phase<pg8::EpiK, pg8::Order>(lds, g, S, E); }
#endif
#if (P3MASK >> 2) & 1
        { pg8::Gemm g{(const bf16_t*)(ws + WS_WVF), (const bf16_t*)(ws + WS_Z) + C_KVLAT, 256, ZP, 256, wv}; pg8::Order S; S.init(512, MTOK, 1, G, (bx + G - 160) % G);
          pg8::EpiVt E{(bf16_t*)(ws + WS_VTP), (bf16_t*)(ws + WS_VTS), (const float*)(ws + WS_RSSKV), 0}; pg8::gemm_phase<pg8::EpiVt, pg8::Order>(lds, g, S, E); }
#endif
#if (P3MASK >> 3) & 1
        { pg8::Gemm g{(const bf16_t*)(ws + WS_CACHEB), (const bf16_t*)(ws + WS_WKU), 256, 256, 256, wv}; pg8::Order S; S.init(512, 512, 1, G, (bx + G - 224) % G);
          pg8::EpiK E{(bf16_t*)(ws + WS_KP), (bf16_t*)(ws + WS_KS), (const float*)(ws + WS_RSSKV), 1}; pg8::gemm_phase<pg8::EpiK, pg8::Order>(lds, g, S, E); }
#endif
#if (P3MASK >> 4) & 1
        { pg8::Gemm g{(const bf16_t*)(ws + WS_WVU), (const bf16_t*)(ws + WS_CACHEB), 256, 256, 256, wv}; pg8::Order S; S.init(512, 512, 1, G, (bx + G - 228) % G);
          pg8::EpiVt E{(bf16_t*)(ws + WS_VTP), (bf16_t*)(ws + WS_VTS), (const float*)(ws + WS_RSSKV), 1}; pg8::gemm_phase<pg8::EpiVt, pg8::Order>(lds, g, S, E); }
#endif
        __syncthreads();
        const int c2 = (bx + G - 232) % G;
#if (P3MASK >> 5) & 1
        for (int u = c2; u < 512; u += G) gla_stepA(a, wv, lds, u);
#endif
        p3_row_extras(a, wv, c2 * 8 + (otid(wv) >> 6), G * 8);
    } SEAM(3);
    if (IN(4)) { gla_scan(a, wv, vcu, G); } SEAM(4);
    if (IN(5)) {
        for (int rep = 0; rep < PROBE_ATT_REP; ++rep) for (int u = vcu; u < 512; u += G) attn_unit(a, wv, lds, u);
        for (int rep = 0; rep < PROBE_GLAC_REP; ++rep) for (int u = vcu; u < 512; u += G) gla_stepC(a, wv, lds, u);
    } SEAM(5);
    if (IN(6)) {
        pg8::Gemm g{(const bf16_t*)(ws + WS_MIX), (const bf16_t*)(ws + WS_WOUT), D, D, PROBE_K6, wv}; pg8::Order S; S.init(MTOK, D, 1024 / PROBE_K6, G, bx);
        pg8::EpiPart E{(float*)(ws + WS_P0), (float*)(ws + WS_P1A)}; pg8::gemm_phase<pg8::EpiPart, pg8::Order>(lds, g, S, E);
    } SEAM(6);
    if (IN(7)) { phase6(a, wv, vcu, G); } SEAM(7);
    if (IN(8)) {
        pg8::Gemm g{(const bf16_t*)(ws + WS_H), (const bf16_t*)(ws + WS_WFFI), D, D, D, wv}; pg8::Order S; S.init(MTOK, 2 * DFF, 1, G, bx);
        pg8::EpiFFI E{(bf16_t*)(ws + WS_HFF)}; for (int rep = 0; rep < PROBE_FFI_REP; ++rep) pg8::gemm_phase<pg8::EpiFFI, pg8::Order>(lds, g, S, E);
    } SEAM(8);
    if (IN(9)) {
        pg8::Gemm g{(const bf16_t*)(ws + WS_HFF), (const bf16_t*)(ws + WS_WFFO), DFF, DFF, DFF / 2, wv}; pg8::Order S; S.init(MTOK, D, 2, G, bx);
        pg8::EpiPart E{(float*)(ws + WS_P0), (float*)(ws + WS_P1B)}; pg8::gemm_phase<pg8::EpiPart, pg8::Order>(lds, g, S, E);
    } SEAM(9);
    if (IN(10)) { phase9(a, wv, vcu, G); }
    if (PROBE_DUMP) {
        if (PROBE_DUMP != 5 && PROBE_DUMP != 7) { ++nbar; } if (PROBE_DUMP != 5 && PROBE_DUMP != 7) my_grid_barrier(nbar, (unsigned)G, otid(wv), (LAS unsigned*)(lds + LDS_BYTES - 64));
        const bf16_t* src = (const bf16_t*)(ws + (PROBE_DUMP == 1 ? WS_Z : PROBE_DUMP == 2 ? WS_MIX : WS_H)); const int pitch = PROBE_DUMP == 1 ? ZP : D;
        for (size_t i = (size_t)bx * 512 + otid(wv); i < (size_t)MTOK * D; i += (size_t)G * 512) { const int r = (int)(i >> 10), c = (int)(i & 1023); a.out[i] = PROBE_DUMP == 7 ? 1.0f : PROBE_DUMP == 6 ? (r < 2304 ? bf2f(((const bf16_t*)(ws + WS_WIN))[(size_t)r * 1024 + c]) : 0.f) : PROBE_DUMP >= 4 ? xrow_ptr(a, r)[c] * 2.f : bf2f(src[(size_t)r * pitch + c]); }
        for (size_t i = O_KV + (size_t)bx * 512 + otid(wv); i < 10616832; i += (size_t)G * 512) a.out[i] = 0.f;
    }
    for (int xb = 0; xb < PROBE_XBAR; ++xb) { ++nbar; my_grid_barrier(nbar, (unsigned)G, otid(wv), (LAS unsigned*)(lds + LDS_BYTES - 64)); }
    if (nbar) my_grid_barrier_finish((unsigned)G, otid(wv));
#undef IN
#undef SEAM
}

extern "C" void kernel_launch(void* const* d_in, const int* in_sizes, int n_in, void* d_out, int out_size, void* d_ws, size_t ws_size, hipStream_t stream) {
    static int grid = 0;
    if (grid == 0) {
        int dev = 0, cus = 0;
        static const int exp_sizes[26] = {4194304, 4194304, 131072, 16384, 65536, 65536, 2048, 1024, 6291456, 6144, 1024, 2293760, 384, 294912, 256, 262144, 4096, 256, 4096, 256, 128, 1048576, 1024, 5767168, 2883584, 1024};
        bool okk = (n_in == 26); for (int i = 0; okk && i < 26; ++i) okk = (in_sizes[i] == exp_sizes[i]);
        if (!okk || out_size != 10616832) { fprintf(stderr, "kernel_launch: unexpected input sizes\n"); grid = -1; return; }
        if (n_in != 26 || ws_size < 198 * MiB) { fprintf(stderr, "kernel_launch: unexpected n_in %d / ws %zu\n", n_in, ws_size); grid = -1; return; }
        hipGetDevice(&dev); hipDeviceGetAttribute(&cus, hipDeviceAttributeMultiprocessorCount, dev);
        if (hipFuncSetAttribute((const void*)mk_fwd, hipFuncAttributeMaxDynamicSharedMemorySize, LDS_BYTES) != hipSuccess) { fprintf(stderr, "kernel_launch: hipFuncSetAttribute failed\n"); grid = -1; return; }
        int per_cu = 0;
        if (hipOccupancyMaxActiveBlocksPerMultiprocessor(&per_cu, (const void*)mk_fwd, 512, LDS_BYTES) != hipSuccess || per_cu < 1) { fprintf(stderr, "kernel_launch: occupancy query says %d\n", per_cu); per_cu = 1; }
        (void)hipGetLastError();
        if (cus < 256) { fprintf(stderr, "kernel_launch: needs 256 CUs, got %d\n", cus); grid = -1; return; }
        grid = 256;
    }
    if (grid < 0) return;
    if (hipMemsetAsync((char*)d_ws + WS_BAR, 0, 4096, stream) != hipSuccess) { fprintf(stderr, "kernel_launch: memset failed\n"); return; }
    Args a{};
    for (int i = 0; i < 26; ++i) a.in[i] = (const float*)d_in[i];
    a.out = (float*)d_out; a.ws = (unsigned char*)d_ws;
#if MK_PER_PHASE_LAUNCH
    for (int p = 0; p < NPHASE; ++p) { if (PROBE_ONLY_LAUNCH >= 0 && p != PROBE_ONLY_LAUNCH) continue; a.ph_lo = p; a.ph_hi = p + 1; hipLaunchKernelGGL(mk_fwd, dim3(grid), dim3(512), LDS_BYTES, stream, a); }
#else
    a.ph_lo = 0; a.ph_hi = NPHASE;
#if MK_COOP
    void* args[] = {&a};
    hipError_t e = hipLaunchCooperativeKernel((const void*)mk_fwd, dim3(grid), dim3(512), args, LDS_BYTES, stream);
    if (e != hipSuccess) fprintf(stderr, "cooperative launch failed: %s (grid %d)\n", hipGetErrorString(e), grid);
#else
    hipLaunchKernelGGL(mk_fwd, dim3(grid), dim3(512), LDS_BYTES, stream, a);
#endif
#endif
}
```

```cpp
#include <hip/hip_runtime.h>
#include <hip/hip_cooperative_groups.h>
#include <cstdio>
#include <cstdint>
namespace cg = cooperative_groups;

#define PROBE_FILL 0
#define PROBE_EXC 0
#define PROBE_BLO 0
#define PROBE_BHI 256
#define PROBE_RSTRIDE 1
#define PROBE_REP 1
#define PROBE_XLO 0
#define PROBE_XHI 8
#define PROBE_HANG 0
#define PROBE_ATT_REP 1
#define PROBE_GLAC_REP 1
#define PROBE_FFI_REP 1
#define PROBE_XBAR 0
#define PROBE_P0_REP 1
#define PROBE_ROW_REP 1
#define PROBE_P3_REP 1
#define PROBE_DUMP 0
#define PROBE_STATS 0
#define PROBE_K6 512
#define PROBE_ONLY_LAUNCH -1
#define PROBE_NOSTORE 0
#define PROBE_FILL_MIB 256
#define PROBE_FILL_VAL 1.2345f
#ifndef PROBE_MUL
#define PROBE_MUL 1.f
#endif
#ifndef PROBE_MODOFF
#define PROBE_MODOFF 0u
#endif
#ifndef MK_COOP
#define MK_COOP 0
#endif
#ifndef MK_PER_PHASE_LAUNCH
#define MK_PER_PHASE_LAUNCH 0
#endif

#define LAS __attribute__((address_space(3)))
typedef unsigned short bf16_t;
typedef short bf16x8 __attribute__((ext_vector_type(8)));
typedef float f32x4 __attribute__((ext_vector_type(4)));
typedef float f32x2 __attribute__((ext_vector_type(2)));
typedef unsigned u32x4 __attribute__((ext_vector_type(4)));
typedef unsigned u32x2 __attribute__((ext_vector_type(2)));

constexpr int D = 1024, MTOK = 8192, MP = 4096;
constexpr int ZP = 2304;
constexpr int C_QLAT = 0, C_KVLAT = 384, C_KROPE = 640, C_GQ = 672, C_GK = 928, C_GV = 1184, C_GFL = 1696, C_GOUT = 1728;
constexpr int DFF = 2816;
constexpr float EPS = 1e-6f;
constexpr float QSCALE = 0.10206207261596577f * 1.4426950408889634f;
constexpr int SKS = 2304;

constexpr size_t MiB = 1u << 20;
constexpr size_t WS_WIN = 1 * MiB;
constexpr size_t WS_WUQ = 6 * MiB;
constexpr size_t WS_WKF = 7 * MiB, WS_WVF = 7 * MiB + 256 * 1024;
constexpr size_t WS_WKU = 7 * MiB + 512 * 1024, WS_WVU = 7 * MiB + 768 * 1024;
constexpr size_t WS_WOUT = 8 * MiB;
constexpr size_t WS_WFFI = 10 * MiB;
constexpr size_t WS_WFFO = 21 * MiB;
constexpr size_t WS_BAR = 27 * MiB - 4096;
constexpr size_t WS_MOD = 27 * MiB;
constexpr size_t WS_RSSQ = 29 * MiB;
constexpr size_t WS_RSSKV = WS_RSSQ;
constexpr size_t WS_CACHEB = 27 * MiB + 512 * 1024;
constexpr size_t WS_DEC = 28 * MiB;
constexpr size_t WS_H = 32 * MiB;
constexpr size_t WS_Z = 48 * MiB;
constexpr size_t WS_Q = 84 * MiB;
constexpr size_t WS_HFF = 48 * MiB;
constexpr size_t WS_KP = 96 * MiB;
constexpr size_t WS_KS = 102 * MiB;
constexpr size_t WS_VTP = 109 * MiB;
constexpr size_t WS_VTS = 113 * MiB;
constexpr size_t WS_CT = 118 * MiB;
constexpr size_t WS_MIX = 150 * MiB;
constexpr size_t WS_X1 = 166 * MiB;
constexpr size_t WS_P0 = 96 * MiB;
constexpr size_t WS_P1A = 48 * MiB, WS_P1B = 128 * MiB;
constexpr size_t O_Y = 0, O_KV = 8388608, O_KR = O_KV + 1048576, O_SF = O_KR + 131072, O_SB = O_SF + 524288;

constexpr int LDS_BYTES = 147456;

__device__ __forceinline__ unsigned f2bf_sw(float f) { unsigned u = __builtin_bit_cast(unsigned, f); return (u + 0x7fffu + ((u >> 16) & 1u)) >> 16; }
__device__ __forceinline__ unsigned cvt_pk_bf16(float lo, float hi) { unsigned r; asm volatile("v_cvt_pk_bf16_f32 %0, %1, %2" : "=v"(r) : "v"(lo), "v"(hi)); return r; }
__device__ __forceinline__ bf16_t f2bf(float f) { return (bf16_t)(cvt_pk_bf16(f, 0.f) & 0xffffu); }
__device__ __forceinline__ float bf2f(bf16_t b) { return __uint_as_float((unsigned)b << 16); }
__device__ __forceinline__ float bflo(unsigned w) { return __uint_as_float(w << 16); }
__device__ __forceinline__ float bfhi(unsigned w) { return __uint_as_float(w & 0xffff0000u); }
__device__ __forceinline__ float wave_sum(float v) {
#pragma unroll
    for (int o = 1; o < 64; o <<= 1) v += __shfl_xor(v, o);
    return v;
}
__device__ __forceinline__ float fast_rcp(float x) { return __builtin_amdgcn_rcpf(x); }
__device__ __forceinline__ float silu_f(float a) { return a * fast_rcp(1.f + __expf(-a)); }
__device__ __forceinline__ float logsigmoid_f(float x) { return fminf(x, 0.f) - __logf(1.f + __expf(-fabsf(x))); }
__device__ __forceinline__ int opaque_lane() { int l; asm volatile("v_mbcnt_lo_u32_b32 %0, -1, 0\n\tv_mbcnt_hi_u32_b32 %0, -1, %0" : "=v"(l)); return l; }
__device__ __forceinline__ int otid(int wv) { int t = (int)threadIdx.x; asm volatile("" : "+v"(t)); return t; }
#define LDS_WAIT() asm volatile("s_waitcnt lgkmcnt(0)" ::: "memory")
#define VM_WAIT() asm volatile("s_waitcnt vmcnt(0)" ::: "memory")

namespace pg8 {
constexpr int BM = 256, BK = 64, HALF = 128, HTB = HALF * BK * 2, STAGE_BYTES = 8 * HTB, NXCD = 8, WGM = 8;
__host__ __device__ __forceinline__ int lds_byte(int r, int c) { const int st = (r >> 4) * 2 + (c >> 5), rr = r & 15, cc = c & 31, ob = rr * 64 + cc * 2; return st * 1024 + (ob ^ (((ob >> 9) & 1) << 5)); }
__host__ __device__ __forceinline__ void stage_rc(int b, int& R, int& C) { const int st = b / 1024, sb = b % 1024, swz = sb ^ (((sb >> 9) & 1) << 5); R = (st >> 1) * 16 + swz / 64; C = (st & 1) * 32 + (swz % 64) / 2; }
__host__ __device__ __forceinline__ int perm32(int rho) { const int n = rho >> 4, i = rho & 15; return 8 * (i >> 2) + 4 * n + (i & 3); }

struct Unit { int pm, pn, ks; };
struct Gemm { const bf16_t* A; const bf16_t* Bt; int lda, ldb, K, wv; };

struct Order {
    int nM, nN, nNs, nwg, G, c;
    __device__ void init(int M, int N, int nsplit, int G_, int c_) { nM = M / BM; nN = N / BM; nNs = nN * nsplit; nwg = nM * nNs; G = G_; c = c_; }
    __device__ bool next(int i, Unit& u) const {
        const long L = (long)i * G + c; if (L >= nwg) return false;
        int wgid = (int)L; { const int q = nwg / NXCD, r = nwg % NXCD, xcd = wgid % NXCD, off = wgid / NXCD; wgid = (xcd < r ? xcd * (q + 1) : r * (q + 1) + (xcd - r) * q) + off; }
        const int nig = WGM * nNs, gid = wgid / nig, fm = gid * WGM, gsz = (nM - fm) < WGM ? (nM - fm) : WGM;
        u.pm = fm + ((wgid % nig) % gsz); const int pn2 = (wgid % nig) / gsz; u.pn = pn2 % nN; u.ks = pn2 / nN; return true;
    }
};

template <class Epi, class Sched, bool ALIGN_EPI = true, bool SP2 = true>
__device__ __forceinline__ void gemm_phase(LAS unsigned char* lds, const Gemm g, const Sched& S, const Epi& E) {
    const int tid = otid(g.wv), wid = g.wv, lane = tid & 63, wr = wid >> 2, wc = wid & 3, fr = lane & 15, fq = lane >> 4;
    const int K = g.K, nt = K / BK;
    unsigned voffA[2], voffB[2];
#pragma unroll
    for (int i = 0; i < 2; ++i) { int R, C; stage_rc(tid * 16 + i * 8192, R, C); const int Rb = Epi::PERM ? ((R & ~31) + perm32(R & 31)) : R;
        voffA[i] = (unsigned)(R * g.lda + C) * 2u; voffB[i] = (unsigned)(Rb * g.ldb + C) * 2u; }
    const size_t kstep = (size_t)(BK * 2);
    const size_t hstepA = (size_t)HALF * g.lda * 2, hstepB = (size_t)HALF * g.ldb * 2;
    const size_t tstepA = 2 * hstepA, tstepB = 2 * hstepB;
    const size_t ksplit = (size_t)K * 2;
    const unsigned ldsw = (unsigned)wid * 1024u;
    const int aoff = lds_byte(wr * 64 + fr, fq * 8), boff = lds_byte(wc * 32 + fr, fq * 8);
#define PG8_SA(b, h) (((b) * 2 + (h)) * HTB)
#define PG8_SB(b, h) ((4 + (b) * 2 + (h)) * HTB)
#define PG8_STAGE(bufoff, gbase, voff) do { _Pragma("unroll") for (int _i = 0; _i < 2; ++_i) \
        __builtin_amdgcn_global_load_lds((const unsigned*)((const char*)(gbase) + (voff)[_i]), (LAS unsigned*)(lds + (bufoff) + ldsw + _i * 8192), 16, 0, 0); } while (0)
#define PG8_LDA(dst, b, h) do { _Pragma("unroll") for (int m = 0; m < 4; ++m) _Pragma("unroll") for (int k = 0; k < 2; ++k) dst[m][k] = *(const LAS bf16x8*)(lds + PG8_SA(b, h) + aoff + m * 2048 + k * 1024); } while (0)
#define PG8_LDB(dst, b, h) do { _Pragma("unroll") for (int n = 0; n < 2; ++n) _Pragma("unroll") for (int k = 0; k < 2; ++k) dst[n][k] = *(const LAS bf16x8*)(lds + PG8_SB(b, h) + boff + n * 2048 + k * 1024); } while (0)
#define PG8_MMA(ai, bj, At, Bt) do { __builtin_amdgcn_s_setprio(1); _Pragma("unroll") for (int m = 0; m < 4; ++m) _Pragma("unroll") for (int n = 0; n < 2; ++n) _Pragma("unroll") for (int k = 0; k < 2; ++k) \
        acc[ai][bj][m][n] = __builtin_amdgcn_mfma_f32_16x16x32_bf16(Bt[n][k], At[m][k], acc[ai][bj][m][n], 0, 0, 0); __builtin_amdgcn_s_setprio(0); } while (0)
#define PG8_WAIT_V(n) asm volatile("s_waitcnt vmcnt(" #n ")" ::: "memory")
#define PG8_WAIT_L(n) asm volatile("s_waitcnt lgkmcnt(" #n ")" ::: "memory")
#define PG8_BAR __builtin_amdgcn_s_barrier()
#define PG8_SCHED __builtin_amdgcn_sched_barrier(0)
    Unit cur, nxt; int ui = 0;
    if (!S.next(0, cur)) return;
    f32x4 acc[2][2][4][2];
#pragma unroll
    for (int a = 0; a < 2; ++a)
#pragma unroll
        for (int b = 0; b < 2; ++b)
#pragma unroll
            for (int m = 0; m < 4; ++m)
#pragma unroll
                for (int n = 0; n < 2; ++n) acc[a][b][m][n] = (f32x4){0.f, 0.f, 0.f, 0.f};
    bf16x8 At[4][2], B0[2][2], B1[2][2];
    const char* cA = (const char*)g.A + (size_t)cur.pm * tstepA + (size_t)cur.ks * ksplit; const char* cB = (const char*)g.Bt + (size_t)cur.pn * tstepB + (size_t)cur.ks * ksplit;
    if constexpr (SP2) {
        PG8_STAGE(PG8_SB(0, 0), cB, voffB); PG8_STAGE(PG8_SB(0, 1), cB + hstepB, voffB); PG8_STAGE(PG8_SA(0, 0), cA, voffA); PG8_STAGE(PG8_SA(0, 1), cA + hstepA, voffA);
        if (wr == 1) PG8_BAR;
        PG8_WAIT_V(2); PG8_BAR;
        PG8_STAGE(PG8_SB(1, 0), cB + kstep, voffB); PG8_STAGE(PG8_SA(1, 0), cA + kstep, voffA); PG8_STAGE(PG8_SB(1, 1), cB + hstepB + kstep, voffB);
        PG8_WAIT_V(6); PG8_BAR;
    } else {
        PG8_STAGE(PG8_SB(0, 0), cB, voffB); PG8_STAGE(PG8_SA(0, 0), cA, voffA); PG8_STAGE(PG8_SB(0, 1), cB + hstepB, voffB); PG8_STAGE(PG8_SA(0, 1), cA + hstepA, voffA);
        if (wr == 1) PG8_BAR;
        PG8_WAIT_V(4); PG8_BAR;
        PG8_STAGE(PG8_SB(1, 0), cB + kstep, voffB); PG8_STAGE(PG8_SA(1, 0), cA + kstep, voffA); PG8_STAGE(PG8_SB(1, 1), cB + hstepB + kstep, voffB);
        PG8_WAIT_V(6); PG8_BAR;
    }
    for (;;) {
        const bool has_next = S.next(ui + 1, nxt);
        const char* nA = has_next ? (const char*)g.A + (size_t)nxt.pm * tstepA + (size_t)nxt.ks * ksplit : cA; const char* nB = has_next ? (const char*)g.Bt + (size_t)nxt.pn * tstepB + (size_t)nxt.ks * ksplit : cB;
#pragma nounroll
        for (int t = 0; t < nt; t += 2) {
            const bool last = (t == nt - 2);
            const char* a1 = cA + (size_t)(t + 1) * kstep;
            const char* a2 = last ? nA : cA + (size_t)(t + 2) * kstep; const char* b2 = last ? nB : cB + (size_t)(t + 2) * kstep;
            const char* a3 = a2 + kstep; const char* b3 = b2 + kstep;
            if constexpr (SP2) {
            PG8_LDB(B0, 0, 0); PG8_LDB(B1, 0, 1); PG8_SCHED; PG8_LDA(At, 0, 0); PG8_STAGE(PG8_SA(1, 1), a1 + hstepA, voffA);
            PG8_WAIT_V(8); PG8_WAIT_L(0); PG8_BAR; PG8_MMA(0, 0, At, B0); PG8_MMA(0, 1, At, B1); PG8_BAR; PG8_SCHED;
            PG8_LDA(At, 0, 1); PG8_STAGE(PG8_SB(0, 0), b2, voffB); PG8_STAGE(PG8_SB(0, 1), b2 + hstepB, voffB); PG8_STAGE(PG8_SA(0, 0), a2, voffA);
            PG8_WAIT_V(8); PG8_WAIT_L(0); PG8_BAR; PG8_MMA(1, 0, At, B0); PG8_MMA(1, 1, At, B1); PG8_BAR; PG8_SCHED;
            PG8_LDB(B0, 1, 0); PG8_LDB(B1, 1, 1); PG8_SCHED; PG8_LDA(At, 1, 0); PG8_STAGE(PG8_SA(0, 1), a2 + hstepA, voffA);
            PG8_WAIT_V(8); PG8_WAIT_L(0); PG8_BAR; PG8_MMA(0, 0, At, B0); PG8_MMA(0, 1, At, B1); PG8_BAR; PG8_SCHED;
            PG8_LDA(At, 1, 1); PG8_STAGE(PG8_SB(1, 0), b3, voffB); PG8_STAGE(PG8_SB(1, 1), b3 + hstepB, voffB); PG8_STAGE(PG8_SA(1, 0), a3, voffA);
            PG8_WAIT_V(8); PG8_WAIT_L(0); PG8_BAR; PG8_MMA(1, 0, At, B0); PG8_MMA(1, 1, At, B1); PG8_BAR; PG8_SCHED;
            } else {
            PG8_LDB(B0, 0, 0); PG8_SCHED; PG8_LDA(At, 0, 0); PG8_STAGE(PG8_SA(1, 1), a1 + hstepA, voffA);
            PG8_WAIT_L(8); PG8_BAR; PG8_WAIT_L(0); PG8_MMA(0, 0, At, B0); PG8_BAR; PG8_SCHED;
            PG8_LDB(B1, 0, 1); PG8_STAGE(PG8_SB(0, 0), b2, voffB);
            PG8_BAR; PG8_WAIT_L(0); PG8_MMA(0, 1, At, B1); PG8_BAR;
            PG8_LDA(At, 0, 1); PG8_STAGE(PG8_SA(0, 0), a2, voffA);
            PG8_BAR; PG8_WAIT_L(0); PG8_MMA(1, 0, At, B0); PG8_BAR; PG8_SCHED;
            PG8_STAGE(PG8_SB(0, 1), b2 + hstepB, voffB);
            PG8_WAIT_V(6); PG8_BAR; PG8_MMA(1, 1, At, B1); PG8_BAR;
            PG8_LDB(B0, 1, 0); PG8_SCHED; PG8_LDA(At, 1, 0); PG8_STAGE(PG8_SA(0, 1), a2 + hstepA, voffA);
            PG8_WAIT_L(8); PG8_BAR; PG8_WAIT_L(0); PG8_MMA(0, 0, At, B0); PG8_BAR; PG8_SCHED;
            PG8_LDB(B1, 1, 1); PG8_STAGE(PG8_SB(1, 0), b3, voffB);
            PG8_BAR; PG8_WAIT_L(0); PG8_MMA(0, 1, At, B1); PG8_BAR;
            PG8_LDA(At, 1, 1); PG8_STAGE(PG8_SA(1, 0), a3, voffA);
            PG8_BAR; PG8_WAIT_L(0); PG8_MMA(1, 0, At, B0); PG8_BAR; PG8_SCHED;
            PG8_STAGE(PG8_SB(1, 1), b3 + hstepB, voffB);
            PG8_WAIT_V(6); PG8_BAR; PG8_MMA(1, 1, At, B1); PG8_BAR;
            }
        }
        if constexpr (ALIGN_EPI) { if (wr == 0) PG8_BAR; }
        E(acc, cur, wr, wc, fr, fq);
        if (!has_next) break;
#pragma unroll
        for (int a = 0; a < 2; ++a)
#pragma unroll
            for (int b = 0; b < 2; ++b)
#pragma unroll
                for (int m = 0; m < 4; ++m)
#pragma unroll
                    for (int n = 0; n < 2; ++n) acc[a][b][m][n] = (f32x4){0.f, 0.f, 0.f, 0.f};
        cur = nxt; cA = nA; cB = nB; ++ui;
        if constexpr (ALIGN_EPI) { if (wr == 1) PG8_BAR; }
    }
    PG8_WAIT_V(0);
    if constexpr (!ALIGN_EPI) { if (wr == 0) PG8_BAR; }
    PG8_BAR;
#undef PG8_SA
#undef PG8_SB
#undef PG8_STAGE
#undef PG8_LDA
#undef PG8_LDB
#undef PG8_MMA
#undef PG8_WAIT_V
#undef PG8_WAIT_L
#undef PG8_BAR
#undef PG8_SCHED
}

__device__ __forceinline__ float rss_q(const float* rss, int row) { float s = 0.f;
#pragma unroll
    for (int p = 0; p < 12; ++p) s += rss[(size_t)p * MTOK + row]; return s; }
__device__ __forceinline__ float rss_kv(const float* rss, int row) { float s = 0.f;
#pragma unroll
    for (int p = 12; p < 20; ++p) s += rss[(size_t)p * MTOK + row]; return s; }
#define EPI_ROWS_BEGIN _Pragma("unroll") for (int ai = 0; ai < 2; ++ai) _Pragma("unroll") for (int m = 0; m < 4; ++m) { const int row = u.pm * BM + wr * 64 + fr + ai * HALF + m * 16;
#define EPI_ROWS_END asm volatile("" ::: "memory"); }

struct EpiZ {
    static constexpr bool PERM = true;
    bf16_t* Z; float* rssq; float* rsskv;
    __device__ __forceinline__ void operator()(const f32x4 (&acc)[2][2][4][2], const Unit& u, int wr, int wc, int fr_, int fq_) const {
        int lane_e = (int)threadIdx.x & 63; asm volatile("" : "+v"(lane_e)); const int fr = lane_e & 15, fq = lane_e >> 4;
        const int col0 = u.pn * BM + wc * 32 + 8 * fq;
        EPI_ROWS_BEGIN
            bf16_t* rowp = Z + (size_t)row * ZP + col0;
#pragma unroll
            for (int bj = 0; bj < 2; ++bj) { const f32x4 v0 = acc[ai][bj][m][0], v1 = acc[ai][bj][m][1];
                u32x4 w; w.x = cvt_pk_bf16(v0[0], v0[1]); w.y = cvt_pk_bf16(v0[2], v0[3]); w.z = cvt_pk_bf16(v1[0], v1[1]); w.w = cvt_pk_bf16(v1[2], v1[3]);
                *(u32x4*)(rowp + bj * HALF) = w;
                const int hc = 2 * u.pn + bj;
                if (hc < 5) { float s = (v0[0] * v0[0] + v0[1] * v0[1]) + (v0[2] * v0[2] + v0[3] * v0[3]) + (v1[0] * v1[0] + v1[1] * v1[1]) + (v1[2] * v1[2] + v1[3] * v1[3]);
                    s += __shfl_xor(s, 16); s += __shfl_xor(s, 32);
                    if (fq == 0) rssq[(size_t)(hc * 4 + wc) * MTOK + row] = s; } }
        EPI_ROWS_END
    }
};

struct EpiQ {
    static constexpr bool PERM = true;
    bf16_t* Q; const float* rssq;
    __device__ __forceinline__ void operator()(const f32x4 (&acc)[2][2][4][2], const Unit& u, int wr, int wc, int fr_, int fq_) const {
        int lane_e = (int)threadIdx.x & 63; asm volatile("" : "+v"(lane_e)); const int fr = lane_e & 15, fq = lane_e >> 4;
        const int col0 = u.pn * BM + wc * 32 + 8 * fq;
        const float inv[8] = {1.f, 0.316227766f, 0.1f, 0.0316227766f, 0.01f, 0.00316227766f, 0.001f, 0.000316227766f};
        EPI_ROWS_BEGIN
            const float rs = rsqrtf(rss_q(rssq, row) * (1.f / 384.f) + EPS) * QSCALE;
            const int t = (row - MP) & 2047;
#pragma unroll
            for (int bj = 0; bj < 2; ++bj) { const int c = col0 + bj * HALF; const int j0 = c % 96;
                const bool rp = (row >= MP && j0 >= 64);
                const float pos = (float)((j0 < 80) ? (t >> 6) : (t & 63)) * 0.15915494309189535f;
                const float sg = (j0 & 8) ? 1.f : -1.f;
#pragma unroll
                for (int n = 0; n < 2; ++n) {
                    f32x4 v = acc[ai][bj][m][n] * rs;
#pragma unroll
                    for (int i = 0; i < 4; ++i) { const float p = __shfl_xor(v[i], 16);
                        const float rev = pos * inv[4 * n + i]; const float rf = rev - floorf(rev);
                        const float cs = __builtin_amdgcn_cosf(rf), sn = __builtin_amdgcn_sinf(rf); v[i] = rp ? v[i] * cs + sg * p * sn : v[i]; }
                    u32x2 w; w.x = cvt_pk_bf16(v[0], v[1]); w.y = cvt_pk_bf16(v[2], v[3]);
                    *(u32x2*)(Q + (size_t)row * 768 + c + 4 * n) = w; } }
        EPI_ROWS_END
    }
};

struct EpiK {
    static constexpr bool PERM = true;
    bf16_t* Kp; bf16_t* Ks; const float* rsskv; int ctx;
    __device__ __forceinline__ void operator()(const f32x4 (&acc)[2][2][4][2], const Unit& u, int wr, int wc, int fr_, int fq_) const {
        int lane_e = (int)threadIdx.x & 63; asm volatile("" : "+v"(lane_e)); const int fr = lane_e & 15, fq = lane_e >> 4;
        EPI_ROWS_BEGIN
            float rs = 1.f; unsigned off; bool smp;
            if (ctx) { off = ((unsigned)(row >> 8) * 8u * SKS + (row & 255)) * 96u; smp = true; }
            else { rs = rsqrtf(rss_kv(rsskv, row) * (1.f / 256.f) + EPS);
                if (row < MP) { off = ((unsigned)(row >> 8) * 8u * 256u + (row & 255)) * 96u; smp = false; } else { off = ((unsigned)((row - MP) >> 11) * 8u * SKS + 256u + ((row - MP) & 2047)) * 96u; smp = true; } }
            bf16_t* base = smp ? Ks : Kp; const unsigned hs = (smp ? SKS : 256) * 96u;
#pragma unroll
            for (int bj = 0; bj < 2; ++bj) { const unsigned h = 4 * u.pn + 2 * bj + (wc >> 1); const unsigned j = (wc & 1) * 32 + 8 * fq;
                const f32x4 v0 = acc[ai][bj][m][0] * rs, v1 = acc[ai][bj][m][1] * rs;
                u32x4 w; w.x = cvt_pk_bf16(v0[0], v0[1]); w.y = cvt_pk_bf16(v0[2], v0[3]); w.z = cvt_pk_bf16(v1[0], v1[1]); w.w = cvt_pk_bf16(v1[2], v1[3]);
                *(u32x4*)(base + (off + h * hs + j)) = w; }
        EPI_ROWS_END
    }
};

struct EpiVt {
    static constexpr bool PERM = true;
    bf16_t* Vtp; bf16_t* Vts; const float* rsskv; int ctx;
    __device__ __forceinline__ void operator()(const f32x4 (&acc)[2][2][4][2], const Unit& u, int wr, int wc, int fr_, int fq_) const {
        int lane_e = (int)threadIdx.x & 63; asm volatile("" : "+v"(lane_e)); const int fr = lane_e & 15, fq = lane_e >> 4;
#pragma unroll
        for (int bj = 0; bj < 2; ++bj) {
            const int tok = u.pn * BM + bj * HALF + wc * 32 + 8 * fq;
            f32x4 r0 = {1.f, 1.f, 1.f, 1.f}, r1 = {1.f, 1.f, 1.f, 1.f}; unsigned off; bool smp; unsigned S;
            if (ctx) { off = (unsigned)(tok >> 8) * 8u * 64u * SKS + (tok & 255); smp = true; S = SKS; }
            else { f32x4 q0 = {0.f, 0.f, 0.f, 0.f}, q1 = {0.f, 0.f, 0.f, 0.f};
#pragma unroll
                for (int p = 12; p < 20; ++p) { q0 += *(const f32x4*)(rsskv + (size_t)p * MTOK + tok); q1 += *(const f32x4*)(rsskv + (size_t)p * MTOK + tok + 4); }
#pragma unroll
                for (int i = 0; i < 4; ++i) { r0[i] = rsqrtf(q0[i] * (1.f / 256.f) + EPS); r1[i] = rsqrtf(q1[i] * (1.f / 256.f) + EPS); }
                if (tok < MP) { off = (unsigned)(tok >> 8) * 8u * 64u * 256u + (tok & 255); smp = false; S = 256; } else { off = (unsigned)((tok - MP) >> 11) * 8u * 64u * SKS + 256u + ((tok - MP) & 2047); smp = true; S = SKS; } }
            bf16_t* base = smp ? Vts : Vtp;
#pragma unroll
            for (int ai = 0; ai < 2; ++ai)
#pragma unroll
                for (int m = 0; m < 4; ++m) { const unsigned hd = u.pm * BM + wr * 64 + fr + ai * HALF + m * 16;
                    const f32x4 v0 = acc[ai][bj][m][0] * r0, v1 = acc[ai][bj][m][1] * r1;
                    u32x4 w; w.x = cvt_pk_bf16(v0[0], v0[1]); w.y = cvt_pk_bf16(v0[2], v0[3]); w.z = cvt_pk_bf16(v1[0], v1[1]); w.w = cvt_pk_bf16(v1[2], v1[3]);
                    *(u32x4*)(base + (off + hd * S)) = w; }
            asm volatile("" ::: "memory");
        }
    }
};

struct EpiPart {
    static constexpr bool PERM = true;
    bf16_t* P0; bf16_t* P1;
    __device__ __forceinline__ void operator()(const f32x4 (&acc)[2][2][4][2], const Unit& u, int wr, int wc, int fr_, int fq_) const {
        int lane_e = (int)threadIdx.x & 63; asm volatile("" : "+v"(lane_e)); const int fr = lane_e & 15, fq = lane_e >> 4;
        const int col0 = u.pn * BM + wc * 32 + 8 * fq; bf16_t* P = u.ks ? P1 : P0;
        EPI_ROWS_BEGIN
            bf16_t* rowp = P + (size_t)row * D + col0;
#pragma unroll
            for (int bj = 0; bj < 2; ++bj) { const f32x4 v0 = acc[ai][bj][m][0], v1 = acc[ai][bj][m][1];
                u32x4 w; w.x = cvt_pk_bf16(v0[0], v0[1]); w.y = cvt_pk_bf16(v0[2], v0[3]); w.z = cvt_pk_bf16(v1[0], v1[1]); w.w = cvt_pk_bf16(v1[2], v1[3]);
                *(u32x4*)(rowp + bj * HALF) = w; }
        EPI_ROWS_END
    }
};

struct EpiFFI {
    static constexpr bool PERM = true;
    bf16_t* H;
    __device__ __forceinline__ void operator()(const f32x4 (&acc)[2][2][4][2], const Unit& u, int wr, int wc, int fr_, int fq_) const {
        int lane_e = (int)threadIdx.x & 63; asm volatile("" : "+v"(lane_e)); const int fr = lane_e & 15, fq = lane_e >> 4;
        const int col0 = u.pn * HALF + wc * 32 + 8 * fq;
        EPI_ROWS_BEGIN
            float o[8];
#pragma unroll
            for (int i = 0; i < 4; ++i) { o[i] = silu_f(acc[ai][0][m][0][i]) * acc[ai][1][m][0][i]; o[4 + i] = silu_f(acc[ai][0][m][1][i]) * acc[ai][1][m][1][i]; }
            u32x4 w; w.x = cvt_pk_bf16(o[0], o[1]); w.y = cvt_pk_bf16(o[2], o[3]); w.z = cvt_pk_bf16(o[4], o[5]); w.w = cvt_pk_bf16(o[6], o[7]);
            *(u32x4*)(H + (size_t)row * DFF + col0) = w;
        EPI_ROWS_END
    }
};
}

struct Args { const float* in[26]; float* out; unsigned char* ws; int ph_lo, ph_hi; };
enum { I_XP = 0, I_XS, I_CKV, I_CKR, I_SF, I_SB, I_C, I_CCTX, I_WADA, I_BADA, I_NATT, I_WIN, I_QN, I_WUQ, I_KVN, I_WUKV, I_WGF, I_BGF, I_WGB, I_BGB, I_GLAN, I_WOUT, I_NFFN, I_WFFI, I_WFFO, I_FN };

__device__ __forceinline__ const float* xrow_ptr(const Args& a, int r) { return r < MP ? a.in[I_XP] + (size_t)r * D : a.in[I_XS] + (size_t)(r - MP) * D; }
__device__ __forceinline__ int cond_of_row(int r) { return r < MP ? 0 : 1 + ((r - MP) >> 11); }

__device__ __forceinline__ void p0_tr(const float* W, int K, int N, bf16_t* WT, bf16_t* WT2, const float* kscale, int kb, int nb, int drow, LAS float* scr, int lane) {
    const int k0 = 64 * kb, n0 = 32 * nb;
#pragma unroll 8
    for (int i = 0; i < 32; ++i) { const int kk = 2 * i + (lane >> 5); scr[kk * 33 + (lane & 31)] = W[(size_t)(k0 + kk) * N + n0 + (lane & 31)]; }
    LDS_WAIT();
    const int c = lane & 7;
    float sc[8];
#pragma unroll
    for (int i = 0; i < 8; ++i) sc[i] = kscale ? kscale[k0 + 8 * c + i] : 1.f;
#pragma unroll
    for (int j = 0; j < 4; ++j) { const int n = (lane >> 3) + 8 * j; const LAS float* s = scr + (8 * c) * 33 + n;
        float v[8];
#pragma unroll
        for (int i = 0; i < 8; ++i) v[i] = s[i * 33];
        if (WT2) { u32x4 o; o.x = cvt_pk_bf16(v[0], v[1]); o.y = cvt_pk_bf16(v[2], v[3]); o.z = cvt_pk_bf16(v[4], v[5]); o.w = cvt_pk_bf16(v[6], v[7]);
            *(u32x4*)(WT2 + (size_t)(drow + n0 + n) * K + k0 + 8 * c) = o; }
        u32x4 o; o.x = cvt_pk_bf16(v[0] * sc[0], v[1] * sc[1]); o.y = cvt_pk_bf16(v[2] * sc[2], v[3] * sc[3]); o.z = cvt_pk_bf16(v[4] * sc[4], v[5] * sc[5]); o.w = cvt_pk_bf16(v[6] * sc[6], v[7] * sc[7]);
        *(u32x4*)(WT + (size_t)(drow + n0 + n) * K + k0 + 8 * c) = o; }
    LDS_WAIT();
}

__device__ __forceinline__ void phase0(const Args& a, int wv, LAS unsigned char* lds, int vcu, int G) {
    const int tid = otid(wv), lane = tid & 63, wave = __builtin_amdgcn_readfirstlane(tid >> 6);
    unsigned char* ws = a.ws;
#ifndef P0MASK
#define P0MASK 7
#endif
    if (P0MASK & 2) {
        LAS float* scr = (LAS float*)(lds + wave * 16384);
        LAS float* scnd = (LAS float*)(lds + 131072);
        for (int i = tid; i < 3072; i += 512) { const int ci = i >> 10, k = i & 1023; scnd[i] = silu_f(ci == 0 ? a.in[I_CCTX][k] : a.in[I_C][(ci - 1) * D + k]); }
        __syncthreads();
        const int gw = vcu * 8 + wave, NGW = G * 8;
        constexpr int T_IN = 16 * 70, T_UQ = 6 * 24, T_UKV = 4 * 32, T_OUT = 16 * 32, T_FFI = 16 * 176, T_FFO = 44 * 32, T_ZERO = 64, T_ADA = 768;
        constexpr int NIT = T_ADA + T_IN + T_UQ + T_UKV + T_OUT + T_FFI + T_FFO + T_ZERO;
        for (int it = gw; it < NIT; it += NGW) {
            int r = it;
            if (r < T_ADA) {
                const int nbq = r >> 2, kq = r & 3; const int n0 = 32 * nbq; const float* W = a.in[I_WADA];
                const int n = lane & 31, hf = lane >> 5; float s0 = 0.f, s1 = 0.f, s2 = 0.f;
                for (int kb = 4 * kq; kb < 4 * kq + 4; ++kb) { const int k0 = 64 * kb;
#pragma unroll 8
                    for (int i = 0; i < 32; ++i) { const int kk = 2 * i + (lane >> 5); scr[kk * 33 + (lane & 31)] = W[(size_t)(k0 + kk) * 6144 + n0 + (lane & 31)]; }
                    LDS_WAIT();
#pragma unroll 8
                    for (int j = 0; j < 32; ++j) { const int kk = hf * 32 + j; const float w = scr[kk * 33 + n];
                        s0 += w * scnd[k0 + kk]; s1 += w * scnd[1024 + k0 + kk]; s2 += w * scnd[2048 + k0 + kk]; }
                    LDS_WAIT(); }
                s0 += __shfl_xor(s0, 32); s1 += __shfl_xor(s1, 32); s2 += __shfl_xor(s2, 32);
                float* MOD = (float*)(ws + WS_MOD) + (size_t)kq * 18432;
                if (hf == 0) { MOD[n0 + n] = s0; MOD[6144 + n0 + n] = s1; MOD[12288 + n0 + n] = s2; }
                continue; } r -= T_ADA;
            if (r < T_FFI) { const int kb = r / 176, nb = r % 176; const int n0 = nb * 32; const int drow = n0 < DFF ? (n0 / 128) * 256 + (n0 % 128) : ((n0 - DFF) / 128) * 256 + 128 + ((n0 - DFF) % 128);
                p0_tr(a.in[I_WFFI], 1024, 5632, (bf16_t*)(ws + WS_WFFI), nullptr, nullptr, kb, nb, drow - n0, scr, lane); continue; } r -= T_FFI;
            if (r < T_FFO) { p0_tr(a.in[I_WFFO], DFF, 1024, (bf16_t*)(ws + WS_WFFO), nullptr, nullptr, r / 32, r % 32, 0, scr, lane); continue; } r -= T_FFO;
            if (r < T_IN) { p0_tr(a.in[I_WIN], 1024, 2240, (bf16_t*)(ws + WS_WIN), nullptr, nullptr, r / 70, r % 70, 0, scr, lane); continue; } r -= T_IN;
            if (r < T_OUT) { p0_tr(a.in[I_WOUT], 1024, 1024, (bf16_t*)(ws + WS_WOUT), nullptr, nullptr, r / 32, r % 32, 0, scr, lane); continue; } r -= T_OUT;
            if (r < T_UQ) { p0_tr(a.in[I_WUQ], 384, 768, (bf16_t*)(ws + WS_WUQ), nullptr, a.in[I_QN], r / 24, r % 24, 0, scr, lane); continue; } r -= T_UQ;
            if (r < T_UKV) { const int nb = r % 32, n0 = nb * 32, hh = n0 >> 7, j0 = n0 & 127; const bool isv = j0 >= 64; const int drow = hh * 64 + (j0 & 63);
                p0_tr(a.in[I_WUKV], 256, 1024, (bf16_t*)(ws + (isv ? WS_WVF : WS_WKF)), (bf16_t*)(ws + (isv ? WS_WVU : WS_WKU)), a.in[I_KVN], r / 32, nb, drow - n0, scr, lane); continue; } r -= T_UKV;
            { u32x4 z = {0u, 0u, 0u, 0u}; u32x4* p = (u32x4*)((bf16_t*)(ws + WS_WIN) + (size_t)(2240 + r) * 1024); p[lane] = z; p[64 + lane] = z; }
        }
    }
    if (P0MASK & 4) {
        const int gt = vcu * 512 + tid, NT = G * 512;
        for (int i = gt; i < 32768; i += NT) { const f32x4 v = ((const f32x4*)a.in[I_CKV])[i]; u32x2 w; w.x = cvt_pk_bf16(v[0], v[1]); w.y = cvt_pk_bf16(v[2], v[3]); ((u32x2*)(ws + WS_CACHEB))[i] = w; }
    }
}

__device__ __forceinline__ f32x4 mod4(const float* modp, const float* bias, int ci, int off) {
    const float* p = modp + ci * 6144 + off;
    return ((*(const f32x4*)p + *(const f32x4*)(p + 18432)) + (*(const f32x4*)(p + 36864) + *(const f32x4*)(p + 55296))) + *(const f32x4*)(bias + off);
}
__device__ __forceinline__ void phase1(const Args& a, int wv, int vcu, int G) {
    if (PROBE_FILL == 3) { float* m = (float*)(a.ws + WS_MOD); for (int i = otid(wv); i < 3 * 6144; i += 512) { unsigned h = (unsigned)i * 2654435761u; h ^= h >> 15; h *= 2246822519u; h ^= h >> 13; m[i] = ((float)(h & 0xffff) * (1.f / 65536.f) - 0.5f) * 2.f; } __syncthreads(); }
    const int tid_ = otid(wv); const int lane = tid_ & 63, wave = tid_ >> 6; const int gw = vcu * 8 + wave, NGW = G * 8;
    const float* mod = (const float*)(a.ws + WS_MOD + PROBE_MODOFF); bf16_t* H = (bf16_t*)(a.ws + WS_H);
    for (int r = gw; r < MTOK; r += NGW * PROBE_RSTRIDE) {
        const f32x4* xr = (const f32x4*)xrow_ptr(a, r) + lane; const int ci_ = cond_of_row(r);
        f32x4 v[4]; float s = 0.f;
#pragma unroll
        for (int j = 0; j < 4; ++j) { v[j] = xr[64 * j]; s += (v[j][0] * v[j][0] + v[j][1] * v[j][1]) + (v[j][2] * v[j][2] + v[j][3] * v[j][3]); }
        const float rstd = rsqrtf(wave_sum(s) * (1.f / D) + EPS);
        u32x2* o = (u32x2*)(H + (size_t)r * D) + lane;
#pragma unroll
        for (int j = 0; j < 4; ++j) { const int c = 4 * lane + 256 * j; const f32x4 w = *(const f32x4*)(a.in[I_NATT] + c), sh = mod4(mod, a.in[I_BADA], ci_, c), scv = mod4(mod, a.in[I_BADA], ci_, 1024 + c);
            const f32x4 y = v[j] * rstd * w * (scv * PROBE_MUL + 1.f) + sh * PROBE_MUL; u32x2 p; p.x = cvt_pk_bf16(y[0], y[1]); p.y = cvt_pk_bf16(y[2], y[3]); if (PROBE_NOSTORE) { if ((p.x ^ p.y) == 0x12345u) o[64 * j] = p; } else o[64 * j] = p; }
    }
}
__device__ __forceinline__ void phase6(const Args& a, int wv, int vcu, int G) {
    const int tid_ = otid(wv); const int lane = tid_ & 63, wave = tid_ >> 6; const int gw = vcu * 8 + wave, NGW = G * 8;
    const float* mod = (const float*)(a.ws + WS_MOD); bf16_t* H = (bf16_t*)(a.ws + WS_H); float* X1 = (float*)(a.ws + WS_X1);
    const bf16_t* P0 = (const bf16_t*)(a.ws + WS_P0); const bf16_t* P1 = (const bf16_t*)(a.ws + WS_P1A);
    for (int r = gw; r < MTOK; r += NGW) {
        const f32x4* xr = (const f32x4*)xrow_ptr(a, r) + lane; const int ci_ = cond_of_row(r);
        const u32x2* p0 = (const u32x2*)(P0 + (size_t)r * D) + lane; const u32x2* p1 = (const u32x2*)(P1 + (size_t)r * D) + lane;
        f32x4 v[4]; float s = 0.f;
#pragma unroll
        for (int j = 0; j < 4; ++j) { const int c = 4 * lane + 256 * j; const f32x4 gt = mod4(mod, a.in[I_BADA], ci_, 2048 + c);
            { const u32x2 qa = p0[64 * j], qb = p1[64 * j]; const f32x4 ps = {bflo(qa.x) + bflo(qb.x), bfhi(qa.x) + bfhi(qb.x), bflo(qa.y) + bflo(qb.y), bfhi(qa.y) + bfhi(qb.y)}; v[j] = xr[64 * j] + gt * ps; } s += (v[j][0] * v[j][0] + v[j][1] * v[j][1]) + (v[j][2] * v[j][2] + v[j][3] * v[j][3]); }
        const float rstd = rsqrtf(wave_sum(s) * (1.f / D) + EPS);
        f32x4* x1 = (f32x4*)(X1 + (size_t)r * D) + lane; u32x2* o = (u32x2*)(H + (size_t)r * D) + lane;
#pragma unroll
        for (int j = 0; j < 4; ++j) { const int c = 4 * lane + 256 * j; x1[64 * j] = v[j];
            const f32x4 w = *(const f32x4*)(a.in[I_NFFN] + c), sh = mod4(mod, a.in[I_BADA], ci_, 3072 + c), scv = mod4(mod, a.in[I_BADA], ci_, 4096 + c);
            const f32x4 y = v[j] * rstd * w * (scv + 1.f) + sh; u32x2 p; p.x = cvt_pk_bf16(y[0], y[1]); p.y = cvt_pk_bf16(y[2], y[3]); o[64 * j] = p; }
    }
}
__device__ __forceinline__ void phase9(const Args& a, int wv, int vcu, int G) {
    const int tid_ = otid(wv); const int lane = tid_ & 63, wave = tid_ >> 6; const int gw = vcu * 8 + wave, NGW = G * 8;
    const float* mod = (const float*)(a.ws + WS_MOD); const float* X1 = (const float*)(a.ws + WS_X1);
    const bf16_t* P0 = (const bf16_t*)(a.ws + WS_P0); const bf16_t* P1 = (const bf16_t*)(a.ws + WS_P1B);
    for (int r = gw; r < MTOK; r += NGW) {
        const f32x4* xr = (const f32x4*)(X1 + (size_t)r * D) + lane; const int ci_ = cond_of_row(r);
        const u32x2* p0 = (const u32x2*)(P0 + (size_t)r * D) + lane; const u32x2* p1 = (const u32x2*)(P1 + (size_t)r * D) + lane;
        f32x4 v[4]; float s = 0.f;
#pragma unroll
        for (int j = 0; j < 4; ++j) { const int c = 4 * lane + 256 * j; const f32x4 gt = mod4(mod, a.in[I_BADA], ci_, 5120 + c);
            { const u32x2 qa = p0[64 * j], qb = p1[64 * j]; const f32x4 ps = {bflo(qa.x) + bflo(qb.x), bfhi(qa.x) + bfhi(qb.x), bflo(qa.y) + bflo(qb.y), bfhi(qa.y) + bfhi(qb.y)}; v[j] = xr[64 * j] + gt * ps; } s += (v[j][0] * v[j][0] + v[j][1] * v[j][1]) + (v[j][2] * v[j][2] + v[j][3] * v[j][3]); }
        const float rstd = rsqrtf(wave_sum(s) * (1.f / D) + EPS);
        f32x4* y = (f32x4*)(a.out + O_Y + (size_t)r * D) + lane;
#pragma unroll
        for (int j = 0; j < 4; ++j) { const int c = 4 * lane + 256 * j; const f32x4 w = *(const f32x4*)(a.in[I_FN] + c); y[64 * j] = v[j] * rstd * w; }
    }
}

__device__ __forceinline__ void p3_row_extras(const Args& a, int wv, int gw, int NGW) {
    const int lane = otid(wv) & 63;
    const bf16_t* Z = (const bf16_t*)(a.ws + WS_Z); const float* rsskv = (const float*)(a.ws + WS_RSSKV);
    bf16_t* Kp = (bf16_t*)(a.ws + WS_KP); bf16_t* Ks = (bf16_t*)(a.ws + WS_KS);
    const float inv[8] = {1.f, 0.316227766f, 0.1f, 0.0316227766f, 0.01f, 0.00316227766f, 0.001f, 0.000316227766f};
    for (int r = gw; r < MTOK + 512; r += NGW) {
        if (r < MTOK) {
            const bf16_t* zr = Z + (size_t)r * ZP;
            if (r < MP) {
                const float rs = rsqrtf(pg8::rss_kv(rsskv, r) * (1.f / 256.f) + EPS);
                const u32x2 w = *(const u32x2*)(zr + C_KVLAT + 4 * lane); const f32x4 g = *(const f32x4*)(a.in[I_KVN] + 4 * lane);
                f32x4 o; o[0] = bflo(w.x) * rs * g[0]; o[1] = bfhi(w.x) * rs * g[1]; o[2] = bflo(w.y) * rs * g[2]; o[3] = bfhi(w.y) * rs * g[3];
                *(f32x4*)(a.out + O_KV + (size_t)r * 256 + 4 * lane) = o;
            }
            const int i = lane & 31;
            float v = bf2f(zr[C_KROPE + i]);
            if (r < MP && lane < 32) a.out[O_KR + (size_t)r * 32 + i] = v;
            const float pv = __shfl_xor(v, 8);
            int b, s; bf16_t* kb;
            if (r >= MP) { const int t = (r - MP) & 2047; const float pos = (float)((i < 16) ? (t >> 6) : (t & 63));
                const float rev = pos * inv[i & 7] * 0.15915494309189535f; const float rf = rev - floorf(rev);
                const float cs = __builtin_amdgcn_cosf(rf), sn = __builtin_amdgcn_sinf(rf); v = v * cs + ((i & 8) ? pv : -pv) * sn;
                b = (r - MP) >> 11; s = 256 + t; kb = Ks + ((size_t)(b * 8) * SKS + s) * 96 + 64 + i;
                const bf16_t o = f2bf(v);
                if (lane < 32) { for (int h = 0; h < 8; ++h) kb[(size_t)h * SKS * 96] = o; }
            } else { b = r >> 8; s = r & 255; kb = Kp + ((size_t)(b * 8) * 256 + s) * 96 + 64 + i; const bf16_t o = f2bf(v);
                if (lane < 32) { for (int h = 0; h < 8; ++h) kb[(size_t)h * 256 * 96] = o; } }
        } else {
            const int rr = r - MTOK, b = rr >> 8, s = rr & 255, i = lane & 31;
            const bf16_t o = f2bf(a.in[I_CKR][(size_t)rr * 32 + i]); bf16_t* kb = Ks + ((size_t)(b * 8) * SKS + s) * 96 + 64 + i;
            if (lane < 32) { for (int h = 0; h < 8; ++h) kb[(size_t)h * SKS * 96] = o; }
        }
    }
}

constexpr int GL_LOW = 0, GL_WG = 8192, GL_BG = 16384, GL_SEG = 16896, GL_RED = 20992, GL_VT = 22528, GL_QF = 40960, GL_KF = GL_QF + 9216, GL_QB = GL_KF + 9216, GL_KB = GL_QB + 9216;
constexpr int GROW = 144;

__device__ __forceinline__ void gla_gates(const Args& a, int wv, LAS unsigned char* lds, int r0, int h, float (&cumF)[8], float (&cumB)[8], float& totF, float& totB) {
    const int tid = otid(wv), d = tid & 63, tg = tid >> 6;
    const bf16_t* Z = (const bf16_t*)(a.ws + WS_Z);
    LAS float* low = (LAS float*)(lds + GL_LOW); LAS float* wg = (LAS float*)(lds + GL_WG); LAS float* bg = (LAS float*)(lds + GL_BG); LAS float* seg = (LAS float*)(lds + GL_SEG);
    { const int t = tid >> 3, r4 = (tid & 7) * 4; const u32x2 w = *(const u32x2*)(Z + (size_t)(r0 + t) * ZP + C_GFL + r4);
      low[t * 32 + r4] = bflo(w.x); low[t * 32 + r4 + 1] = bfhi(w.x); low[t * 32 + r4 + 2] = bflo(w.y); low[t * 32 + r4 + 3] = bfhi(w.y); }
    { const int dir = tid >> 8, r = (tid >> 4) & 15, d4 = (tid & 15) * 4; const f32x4 w = *(const f32x4*)(a.in[dir ? I_WGB : I_WGF] + r * 256 + h * 64 + d4);
      *(LAS f32x4*)(wg + (dir * 16 + r) * 64 + d4) = w; }
    if (tid < 128) { const int dir = tid >> 6; bg[tid] = a.in[dir ? I_BGB : I_BGF][h * 64 + (tid & 63)]; }
    __syncthreads();
    float wf[16], wb[16];
#pragma unroll
    for (int r = 0; r < 16; ++r) { wf[r] = wg[r * 64 + d]; wb[r] = wg[(16 + r) * 64 + d]; }
    const float bf_ = bg[d], bb_ = bg[64 + d];
    float gf[8], gb[8];
#pragma unroll
    for (int i = 0; i < 8; ++i) { const int t = tg * 8 + i; float xf = bf_, xb = bb_;
#pragma unroll
        for (int r = 0; r < 16; ++r) { xf += low[t * 32 + r] * wf[r]; xb += low[t * 32 + 16 + r] * wb[r]; }
        gf[i] = logsigmoid_f(xf) * (1.f / 16.f); gb[i] = logsigmoid_f(xb) * (1.f / 16.f); }
#pragma unroll
    for (int i = 1; i < 8; ++i) gf[i] += gf[i - 1];
#pragma unroll
    for (int i = 6; i >= 0; --i) gb[i] += gb[i + 1];
    seg[tg * 64 + d] = gf[7]; seg[512 + tg * 64 + d] = gb[0];
    __syncthreads();
    float offF = 0.f, offB = 0.f; totF = 0.f; totB = 0.f;
#pragma unroll
    for (int g = 0; g < 8; ++g) { const float sf = seg[g * 64 + d], sb = seg[512 + g * 64 + d]; totF += sf; totB += sb; if (g < tg) offF += sf; if (g > tg) offB += sb; }
#pragma unroll
    for (int i = 0; i < 8; ++i) { cumF[i] = gf[i] + offF; cumB[i] = gb[i] + offB; }
}
__device__ __forceinline__ void gla_load_vT(const Args& a, int wv, LAS unsigned char* lds, int r0, int h) {
    const int tid = otid(wv), e = tid & 127, tq = tid >> 7;
    const bf16_t* Z = (const bf16_t*)(a.ws + WS_Z) + (size_t)r0 * ZP + C_GV + h * 128 + e;
    unsigned w[8];
#pragma unroll
    for (int i = 0; i < 8; ++i) { const unsigned lo = Z[(size_t)(tq * 16 + 2 * i) * ZP], hi = Z[(size_t)(tq * 16 + 2 * i + 1) * ZP]; w[i] = lo | (hi << 16); }
    LAS u32x4* p = (LAS u32x4*)(lds + GL_VT + e * GROW + tq * 32);
    p[0] = (u32x4){w[0], w[1], w[2], w[3]}; p[1] = (u32x4){w[4], w[5], w[6], w[7]};
}

__device__ __forceinline__ void gla_stepA(const Args& a, int wv, LAS unsigned char* lds, int u) {
    const int tid = otid(wv), lane = tid & 63, wave = __builtin_amdgcn_readfirstlane(tid >> 6), d = tid & 63, tg = tid >> 6, fr = lane & 15, fq = lane >> 4;
    const int cgi = u >> 2, h = u & 3, r0 = cgi * 64;
    const bf16_t* Z = (const bf16_t*)(a.ws + WS_Z);
    float cumF[8], cumB[8], totF, totB;
    gla_gates(a, wv, lds, r0, h, cumF, cumB, totF, totB);
    unsigned kf[4], kb[4];
#pragma unroll
    for (int i = 0; i < 4; ++i) { const float k0 = bf2f(Z[(size_t)(r0 + tg * 8 + 2 * i) * ZP + C_GK + h * 64 + d]), k1 = bf2f(Z[(size_t)(r0 + tg * 8 + 2 * i + 1) * ZP + C_GK + h * 64 + d]);
        kf[i] = cvt_pk_bf16(k0 * __expf(totF - cumF[2 * i]), k1 * __expf(totF - cumF[2 * i + 1]));
        kb[i] = cvt_pk_bf16(k0 * __expf(totB - cumB[2 * i]), k1 * __expf(totB - cumB[2 * i + 1])); }
    *(LAS u32x4*)(lds + GL_QF + d * GROW + tg * 16) = (u32x4){kf[0], kf[1], kf[2], kf[3]};
    *(LAS u32x4*)(lds + GL_KF + d * GROW + tg * 16) = (u32x4){kb[0], kb[1], kb[2], kb[3]};
    gla_load_vT(a, wv, lds, r0, h);
    if (tg == 0) { float* dec = (float*)(a.ws + WS_DEC) + (size_t)u * 128; dec[d] = __expf(totF); dec[64 + d] = __expf(totB); }
    __syncthreads();
    const int dir = wave >> 2, eb0 = 2 * (wave & 3);
    const LAS unsigned char* kd = lds + (dir ? GL_KF : GL_QF);
    float* CT = (float*)(a.ws + WS_CT) + ((size_t)u * 2 + dir) * 8192;
#pragma unroll
    for (int eb = 0; eb < 2; ++eb) {
        bf16x8 vf[2];
#pragma unroll
        for (int ks = 0; ks < 2; ++ks) vf[ks] = *(const LAS bf16x8*)(lds + GL_VT + (16 * (eb0 + eb) + fr) * GROW + (32 * ks + 8 * fq) * 2);
#pragma unroll
        for (int db = 0; db < 4; ++db) { f32x4 c = {0.f, 0.f, 0.f, 0.f};
#pragma unroll
            for (int ks = 0; ks < 2; ++ks) { const bf16x8 kfr = *(const LAS bf16x8*)(kd + (16 * db + fr) * GROW + (32 * ks + 8 * fq) * 2); c = __builtin_amdgcn_mfma_f32_16x16x32_bf16(vf[ks], kfr, c, 0, 0, 0); }
#pragma unroll
            for (int j = 0; j < 4; ++j) CT[(16 * (eb0 + eb) + 4 * fq + j) * 64 + 16 * db + fr] = c[j]; }
    }
    __syncthreads();
}

__device__ __forceinline__ void gla_scan(const Args& a, int wv, int vcu, int G) {
    const int gt = vcu * 512 + otid(wv), NT = G * 512;
    float* CTb = (float*)(a.ws + WS_CT); const float* DEC = (const float*)(a.ws + WS_DEC);
    for (int it = gt; it < 32768 + 262144; it += NT) {
        int seq, N, cg0, x;
        if (it < 32768) { seq = 16 + (it >> 14); x = it & 16383; N = 32; cg0 = 64 + 32 * (seq - 16); } else { const int j = it - 32768; seq = j >> 14; x = j & 16383; N = 4; cg0 = 4 * seq; }
        const int h = x >> 12, dir = (x >> 11) & 1, e = (x >> 4) & 127, d4 = (x & 15) * 4;
        f32x4 st = {0.f, 0.f, 0.f, 0.f};
        if (seq >= 16) { const float* s0 = a.in[dir ? I_SB : I_SF] + ((size_t)((seq - 16) * 4 + h) * 64) * 128 + e;
#pragma unroll
            for (int i = 0; i < 4; ++i) st[i] = s0[(size_t)(d4 + i) * 128]; }
        for (int n0 = 0; n0 < N; n0 += 4) {
            f32x4 c[4], dc[4];
#pragma unroll
            for (int i = 0; i < 4; ++i) { const int n = dir ? (N - 1 - n0 - i) : (n0 + i); const int u = (cg0 + n) * 4 + h;
                c[i] = *(const f32x4*)(CTb + ((size_t)u * 2 + dir) * 8192 + e * 64 + d4); dc[i] = *(const f32x4*)(DEC + (size_t)u * 128 + dir * 64 + d4); }
#pragma unroll
            for (int i = 0; i < 4; ++i) { const int n = dir ? (N - 1 - n0 - i) : (n0 + i); const int u = (cg0 + n) * 4 + h;
                *(f32x4*)(CTb + ((size_t)u * 2 + dir) * 8192 + e * 64 + d4) = st; st = dc[i] * st + c[i]; }
        }
        if (seq < 16) { float* o = a.out + (dir ? O_SB : O_SF) + ((size_t)(seq * 4 + h) * 64) * 128 + e;
#pragma unroll
            for (int i = 0; i < 4; ++i) o[(size_t)(d4 + i) * 128] = st[i]; }
    }
}

__device__ __forceinline__ void gla_stepC(const Args& a, int wv, LAS unsigned char* lds, int u) {
    const int tid = otid(wv), lane = tid & 63, wave = __builtin_amdgcn_readfirstlane(tid >> 6), d = tid & 63, tg = tid >> 6, fr = lane & 15, fq = lane >> 4;
    const int cgi = u >> 2, h = u & 3, r0 = cgi * 64;
    const bf16_t* Z = (const bf16_t*)(a.ws + WS_Z);
    float cumF[8], cumB[8], totF, totB;
    gla_gates(a, wv, lds, r0, h, cumF, cumB, totF, totB);
#pragma unroll
    for (int i = 0; i < 8; ++i) { const int t = tg * 8 + i; const float q = bf2f(Z[(size_t)(r0 + t) * ZP + C_GQ + h * 64 + d]) * 0.125f, k = bf2f(Z[(size_t)(r0 + t) * ZP + C_GK + h * 64 + d]);
        *(LAS bf16_t*)(lds + GL_QF + t * GROW + d * 2) = f2bf(q * __expf(cumF[i]));
        *(LAS bf16_t*)(lds + GL_KF + t * GROW + d * 2) = f2bf(k * __expf(-cumF[i]));
        *(LAS bf16_t*)(lds + GL_QB + t * GROW + d * 2) = f2bf(q * __expf(cumB[i]));
        *(LAS bf16_t*)(lds + GL_KB + t * GROW + d * 2) = f2bf(k * __expf(-cumB[i])); }
    gla_load_vT(a, wv, lds, r0, h);
    __syncthreads();
    const int ch = wave & 1, eq = wave >> 1;
    f32x4 oT[2][2];
#pragma unroll
    for (int i = 0; i < 2; ++i)
#pragma unroll
        for (int j = 0; j < 2; ++j) oT[i][j] = (f32x4){0.f, 0.f, 0.f, 0.f};
#pragma unroll
    for (int dir = 0; dir < 2; ++dir) {
        const LAS unsigned char* qe = lds + (dir ? GL_QB : GL_QF); const LAS unsigned char* ke = lds + (dir ? GL_KB : GL_KF);
        const float* ST = (const float*)(a.ws + WS_CT) + ((size_t)u * 2 + dir) * 8192;
        bf16x8 sf[2][2];
#pragma unroll
        for (int eb = 0; eb < 2; ++eb)
#pragma unroll
            for (int ks = 0; ks < 2; ++ks) { const float* p = ST + (16 * (2 * eq + eb) + fr) * 64 + 32 * ks + 8 * fq; const f32x4 x0 = *(const f32x4*)p, x1 = *(const f32x4*)(p + 4);
                u32x4 w; w.x = cvt_pk_bf16(x0[0], x0[1]); w.y = cvt_pk_bf16(x0[2], x0[3]); w.z = cvt_pk_bf16(x1[0], x1[1]); w.w = cvt_pk_bf16(x1[2], x1[3]); sf[eb][ks] = __builtin_bit_cast(bf16x8, w); }
#pragma unroll
        for (int cb = 0; cb < 2; ++cb) {
            const int cbg = 2 * ch + cb;
            bf16x8 qf[2];
#pragma unroll
            for (int ks = 0; ks < 2; ++ks) qf[ks] = *(const LAS bf16x8*)(qe + (16 * cbg + fr) * GROW + (32 * ks + 8 * fq) * 2);
            f32x4 att[4];
#pragma unroll
            for (int sb = 0; sb < 4; ++sb) {
                f32x4 acc = {0.f, 0.f, 0.f, 0.f};
                const bool need = dir == 0 ? (sb <= cbg) : (sb >= cbg);
                if (need) {
#pragma unroll
                    for (int ks = 0; ks < 2; ++ks) { const bf16x8 kfr = *(const LAS bf16x8*)(ke + (16 * sb + fr) * GROW + (32 * ks + 8 * fq) * 2); acc = __builtin_amdgcn_mfma_f32_16x16x32_bf16(kfr, qf[ks], acc, 0, 0, 0); }
                    if (sb == cbg) {
#pragma unroll
                        for (int j = 0; j < 4; ++j) { const int sl = 4 * fq + j; const bool keep = dir == 0 ? (sl <= fr) : (sl >= fr); acc[j] = keep ? acc[j] : 0.f; } }
                }
                att[sb] = acc;
            }
#pragma unroll
            for (int kp = 0; kp < 2; ++kp) {
                u32x4 w; w.x = cvt_pk_bf16(att[2 * kp][0], att[2 * kp][1]); w.y = cvt_pk_bf16(att[2 * kp][2], att[2 * kp][3]); w.z = cvt_pk_bf16(att[2 * kp + 1][0], att[2 * kp + 1][1]); w.w = cvt_pk_bf16(att[2 * kp + 1][2], att[2 * kp + 1][3]);
                const bf16x8 pb = __builtin_bit_cast(bf16x8, w);
#pragma unroll
                for (int eb = 0; eb < 2; ++eb) { const LAS unsigned char* vp = lds + GL_VT + (16 * (2 * eq + eb) + fr) * GROW + (32 * kp + 4 * fq) * 2;
                    const u32x2 v0 = *(const LAS u32x2*)vp, v1 = *(const LAS u32x2*)(vp + 32); const u32x4 vv = {v0.x, v0.y, v1.x, v1.y};
                    oT[eb][cb] = __builtin_amdgcn_mfma_f32_16x16x32_bf16(__builtin_bit_cast(bf16x8, vv), pb, oT[eb][cb], 0, 0, 0); }
            }
#pragma unroll
            for (int ks = 0; ks < 2; ++ks)
#pragma unroll
                for (int eb = 0; eb < 2; ++eb) oT[eb][cb] = __builtin_amdgcn_mfma_f32_16x16x32_bf16(sf[eb][ks], qf[ks], oT[eb][cb], 0, 0, 0);
        }
    }
    LAS float* red = (LAS float*)(lds + GL_RED);
#pragma unroll
    for (int cb = 0; cb < 2; ++cb) { float s = 0.f;
#pragma unroll
        for (int eb = 0; eb < 2; ++eb)
#pragma unroll
            for (int j = 0; j < 4; ++j) s += oT[eb][cb][j] * oT[eb][cb][j];
        s += __shfl_xor(s, 16); s += __shfl_xor(s, 32);
        if (fq == 0) red[eq * 64 + 16 * (2 * ch + cb) + fr] = s; }
    __syncthreads();
    bf16_t* MIX = (bf16_t*)(a.ws + WS_MIX);
#pragma unroll
    for (int cb = 0; cb < 2; ++cb) { const int c = 16 * (2 * ch + cb) + fr; const float tot = red[c] + red[64 + c] + red[128 + c] + red[192 + c]; const float rstd = rsqrtf(tot * (1.f / 128.f) + EPS);
#pragma unroll
        for (int eb = 0; eb < 2; ++eb) { const int e = 16 * (2 * eq + eb) + 4 * fq; const f32x4 gn = *(const f32x4*)(a.in[I_GLAN] + e);
            const u32x2 gw = *(const u32x2*)(Z + (size_t)(r0 + c) * ZP + C_GOUT + h * 128 + e);
            const float g0 = bflo(gw.x), g1 = bfhi(gw.x), g2 = bflo(gw.y), g3 = bfhi(gw.y);
            const f32x4 o = oT[eb][cb] * rstd * gn; u32x2 w; w.x = cvt_pk_bf16(o[0] * silu_f(g0), o[1] * silu_f(g1)); w.y = cvt_pk_bf16(o[2] * silu_f(g2), o[3] * silu_f(g3));
            *(u32x2*)(MIX + (size_t)(r0 + c) * D + 512 + h * 128 + e) = w; } }
    __syncthreads();
}

constexpr int AT_KROW = 208, AT_VROW = 144, AT_KB = 64 * AT_KROW  , AT_STAGE = AT_KB + 64 * AT_VROW  ;
__device__ __forceinline__ void attn_unit(const Args& a, int wv, LAS unsigned char* lds, int idx) {
    const int tid = otid(wv), lane = tid & 63, wave = __builtin_amdgcn_readfirstlane(tid >> 6), fr = lane & 15, fq = lane >> 4;
    int row0, S, nt; const bf16_t* Kb; const bf16_t* Vb; int h;
    if (idx < 256) { const int b = idx >> 7, qb = idx & 15; h = (idx >> 4) & 7; row0 = MP + b * 2048 + qb * 128; S = SKS; nt = 36;
        Kb = (const bf16_t*)(a.ws + WS_KS) + (size_t)(b * 8 + h) * SKS * 96; Vb = (const bf16_t*)(a.ws + WS_VTS) + (size_t)(b * 8 + h) * 64 * SKS; }
    else { const int j = idx - 256; const int b = j >> 4, qb = j & 1; h = (j >> 1) & 7; row0 = b * 256 + qb * 128; S = 256; nt = 4;
        Kb = (const bf16_t*)(a.ws + WS_KP) + (size_t)(b * 8 + h) * 256 * 96; Vb = (const bf16_t*)(a.ws + WS_VTP) + (size_t)(b * 8 + h) * 64 * 256; }
    const char* src[3]; unsigned step[3]; unsigned dst[3]; bool valid[3];
#pragma unroll
    for (int j = 0; j < 3; ++j) { const int ins = wave + 8 * j; valid[j] = ins < 22;
        if (ins < 13) { const int ck = ins * 64 + lane, r = ck / 13, cc = ck % 13; src[j] = (const char*)Kb + (size_t)r * 192 + (cc < 12 ? cc : 11) * 16; step[j] = 64 * 192; dst[j] = ins * 1024; }
        else { const int cv = (ins - 13) * 64 + lane, r = cv / 9, cc = cv % 9; src[j] = (const char*)Vb + (size_t)r * S * 2 + (cc < 8 ? cc : 7) * 16; step[j] = 128; dst[j] = AT_KB + (ins - 13) * 1024; } }
#define AT_ISSUE(t, buf) do { _Pragma("unroll") for (int j = 0; j < 3; ++j) if (valid[j]) \
        __builtin_amdgcn_global_load_lds((const unsigned*)(src[j] + (size_t)(t) * step[j]), (LAS unsigned*)(lds + (buf) * AT_STAGE + dst[j]), 16, 0, 0); } while (0)
    AT_ISSUE(0, 0);
    const bf16_t* Q = (const bf16_t*)(a.ws + WS_Q) + (size_t)(row0 + wave * 16 + fr) * 768 + h * 96 + 8 * fq;
    bf16x8 qf[3];
#pragma unroll
    for (int ks = 0; ks < 3; ++ks) qf[ks] = *(const bf16x8*)(Q + 32 * ks);
    float mrun = -1e30f, lsum = 0.f;
    f32x4 o[4];
#pragma unroll
    for (int i = 0; i < 4; ++i) o[i] = (f32x4){0.f, 0.f, 0.f, 0.f};
    for (int t = 0; t < nt; ++t) {
        VM_WAIT(); __syncthreads();
        if (t + 1 < nt) AT_ISSUE(t + 1, (t + 1) & 1);
        const LAS unsigned char* kt = lds + (t & 1) * AT_STAGE; const LAS unsigned char* vt = kt + AT_KB;
        f32x4 s[4];
#pragma unroll
        for (int kb = 0; kb < 4; ++kb) { s[kb] = (f32x4){0.f, 0.f, 0.f, 0.f};
#pragma unroll
            for (int ks = 0; ks < 3; ++ks) { const bf16x8 kf = *(const LAS bf16x8*)(kt + (16 * kb + fr) * AT_KROW + (32 * ks + 8 * fq) * 2); s[kb] = __builtin_amdgcn_mfma_f32_16x16x32_bf16(kf, qf[ks], s[kb], 0, 0, 0); } }
        float mx = fmaxf(fmaxf(fmaxf(s[0][0], s[0][1]), fmaxf(s[0][2], s[0][3])), fmaxf(fmaxf(s[1][0], s[1][1]), fmaxf(s[1][2], s[1][3])));
        mx = fmaxf(mx, fmaxf(fmaxf(fmaxf(s[2][0], s[2][1]), fmaxf(s[2][2], s[2][3])), fmaxf(fmaxf(s[3][0], s[3][1]), fmaxf(s[3][2], s[3][3]))));
        mx = fmaxf(mx, __shfl_xor(mx, 16)); mx = fmaxf(mx, __shfl_xor(mx, 32));
        const float mnew = fmaxf(mrun, mx); const float alpha = __builtin_amdgcn_exp2f(mrun - mnew); mrun = mnew;
        float ps = 0.f;
#pragma unroll
        for (int kb = 0; kb < 4; ++kb)
#pragma unroll
            for (int j = 0; j < 4; ++j) { s[kb][j] = __builtin_amdgcn_exp2f(s[kb][j] - mnew); ps += s[kb][j]; }
        lsum = lsum * alpha + ps;
#pragma unroll
        for (int i = 0; i < 4; ++i) o[i] = o[i] * alpha;
#pragma unroll
        for (int kp = 0; kp < 2; ++kp) {
            u32x4 w; w.x = cvt_pk_bf16(s[2 * kp][0], s[2 * kp][1]); w.y = cvt_pk_bf16(s[2 * kp][2], s[2 * kp][3]); w.z = cvt_pk_bf16(s[2 * kp + 1][0], s[2 * kp + 1][1]); w.w = cvt_pk_bf16(s[2 * kp + 1][2], s[2 * kp + 1][3]);
            const bf16x8 pb = __builtin_bit_cast(bf16x8, w);
#pragma unroll
            for (int mb = 0; mb < 4; ++mb) { const LAS unsigned char* vp = vt + (16 * mb + fr) * AT_VROW + (32 * kp + 4 * fq) * 2;
                const u32x2 v0 = *(const LAS u32x2*)vp, v1 = *(const LAS u32x2*)(vp + 32); const u32x4 vv = {v0.x, v0.y, v1.x, v1.y};
                o[mb] = __builtin_amdgcn_mfma_f32_16x16x32_bf16(__builtin_bit_cast(bf16x8, vv), pb, o[mb], 0, 0, 0); }
        }
    }
    lsum += __shfl_xor(lsum, 16); lsum += __shfl_xor(lsum, 32);
    const float il = fast_rcp(lsum);
    bf16_t* MIX = (bf16_t*)(a.ws + WS_MIX) + (size_t)(row0 + wave * 16 + fr) * D + h * 64 + 4 * fq;
#pragma unroll
    for (int mb = 0; mb < 4; ++mb) { u32x2 w; w.x = cvt_pk_bf16(o[mb][0] * il, o[mb][1] * il); w.y = cvt_pk_bf16(o[mb][2] * il, o[mb][3] * il); *(u32x2*)(MIX + 16 * mb) = w; }
    __syncthreads();
#undef AT_ISSUE
}

__device__ unsigned g_bar[64 * 52];
#define GB(i) (g_bar + 64 * (i))
__device__ __forceinline__ unsigned gb_ld(unsigned* p) { return __hip_atomic_load(p, __ATOMIC_RELAXED, __HIP_MEMORY_SCOPE_AGENT); }
__device__ __forceinline__ unsigned gb_add(unsigned* p, unsigned v) { return __hip_atomic_fetch_add(p, v, __ATOMIC_RELAXED, __HIP_MEMORY_SCOPE_AGENT); }
__device__ __forceinline__ unsigned xcc_id() { return (unsigned)__builtin_amdgcn_s_getreg((3 << 11) | 20) & 0xFu; }
__device__ __forceinline__ void my_grid_barrier(unsigned nth, unsigned G, int tid, LAS unsigned* st) {
    asm volatile("s_waitcnt vmcnt(0) lgkmcnt(0)" ::: "memory");
    __syncthreads();
    if (tid == 0) {
        if (nth == 1u) {
            const unsigned x = xcc_id(); unsigned sum, cnt, mine;
            for (;;) { sum = 0u; cnt = 0u; mine = 0u;
#pragma unroll
                for (unsigned j = 0; j < 16; ++j) { const unsigned c = gb_ld(GB(4 + j)); sum += c; cnt += (c > 0u) ? 1u : 0u; mine = (j == x) ? c : mine; }
                if (sum >= G) break; __builtin_amdgcn_s_sleep(1); }
            st[0] = mine; st[1] = cnt; st[2] = x;
        }
        const unsigned nloc = st[0], nx = st[1], x = st[2];
        const unsigned old = gb_add(GB(20 + x), 1u);
        if (old + 1u == nth * nloc) {
            __builtin_amdgcn_fence(__ATOMIC_RELEASE, "agent");
            asm volatile("s_waitcnt vmcnt(0)" ::: "memory");
            const unsigned og = gb_add(GB(1), 1u);
            if (og + 1u == nth * nx) gb_add(GB(2), 1u);
            else while (gb_ld(GB(2)) < nth) __builtin_amdgcn_s_sleep(1);
            __builtin_amdgcn_fence(__ATOMIC_ACQUIRE, "agent");
            gb_add(GB(36 + x), 1u);
            asm volatile("s_waitcnt vmcnt(0)" ::: "memory");
        } else {
            while (gb_ld(GB(36 + x)) < nth) __builtin_amdgcn_s_sleep(1);
            __builtin_amdgcn_fence(__ATOMIC_ACQUIRE, "agent");
            asm volatile("s_waitcnt vmcnt(0)" ::: "memory");
        }
    }
    __syncthreads();
}
__device__ __forceinline__ void my_grid_barrier_finish(unsigned G, int tid) {
    if (tid == 0) {
        const unsigned old = gb_add(GB(0), 1u);
        if (old == G - 1u) { for (int i = 0; i < 52; ++i) __hip_atomic_store(GB(i), 0u, __ATOMIC_RELAXED, __HIP_MEMORY_SCOPE_AGENT); }
    }
}
constexpr int NPHASE = 11;
__global__ void __launch_bounds__(512, 2) mk_fwd(Args a) {
    const int wv = __builtin_amdgcn_readfirstlane((int)threadIdx.x >> 6);
    extern __shared__ __attribute__((aligned(16))) unsigned char lds_raw[];
    LAS unsigned char* lds = (LAS unsigned char*)lds_raw;
    const int G = gridDim.x, bx = blockIdx.x;
    const int vcu = (G % 8 == 0) ? (bx % 8) * (G / 8) + bx / 8 : bx;
    unsigned char* ws = a.ws;
    const int lo = a.ph_lo, hi = a.ph_hi;
#ifndef PHMASK
#define PHMASK 0x7ff
#endif
#define IN(k) (((PHMASK >> (k)) & 1) && lo <= (k) && (k) < hi)
#define SEAM(k) do { if (IN(k) && IN((k) + 1)) { ++nbar; my_grid_barrier(nbar, (unsigned)G, otid(wv), (LAS unsigned*)(lds + LDS_BYTES - 64)); } } while (0)
#ifndef PROBE_FILL
#define PROBE_FILL 0
#endif
    if (PROBE_FILL && lo == 0) { f32x4* p = (f32x4*)a.ws; const size_t n = (size_t)(PROBE_FILL_MIB) << 16; const float fv = PROBE_FILL_VAL;
        for (size_t i = (size_t)bx * 512 + threadIdx.x; i < n; i += (size_t)G * 512) { unsigned h = (unsigned)i * 2654435761u; h ^= h >> 15; h *= 2246822519u; h ^= h >> 13; const float r0 = (float)(h & 0xffff) * (1.f / 65536.f) - 0.5f + fv * 0.f; p[i] = (f32x4){r0, r0 * 1.7f, r0 * -0.3f, r0 + 0.1f}; } }
    if (PROBE_FILL == 2 && lo == 0 && bx == 0) { static const int szs[26] = {4194304, 4194304, 131072, 16384, 65536, 65536, 2048, 1024, 6291456, 6144, 1024, 2293760, 384, 294912, 256, 262144, 4096, 256, 4096, 256, 128, 1048576, 1024, 5767168, 2883584, 1024};
        float sm = 0.f; for (int i = 0; i < 26; ++i) { const int n = szs[i]; const int st = n > 1024 ? n - 1024 : 0; for (int j = st + (int)threadIdx.x; j < n; j += 512) sm += a.in[i][j]; for (int j = threadIdx.x; j < (n < 1024 ? n : 1024); j += 512) sm += a.in[i][j]; }
        ((float*)(a.ws))[threadIdx.x] = sm; }
    if (PROBE_FILL == 5 && lo == 0) { volatile float* p = (volatile float*)a.ws; const float big = p[0] * 0.f + 1e38f, tiny = p[1] * 0.f + 1e-38f, zero = p[2] * 0.f, neg = p[3] * 0.f - 1.f;
        float r = 0.f;
#if PROBE_EXC & 1
        r += big * big;
#endif
#if PROBE_EXC & 2
        r += tiny * tiny;
#endif
#if PROBE_EXC & 4
        r += 1.f / zero;
#endif
#if PROBE_EXC & 8
        r += __builtin_sqrtf(neg);
#endif
        p[4 + bx] = r; }
    unsigned nbar = 0;
    if (otid(wv) == 0) gb_add(GB(4 + xcc_id()), 1u);
    if (IN(0)) { for (int rep = 0; rep < PROBE_P0_REP; ++rep) { phase0(a, wv, lds, vcu, G); __syncthreads(); } } SEAM(0);
    if (IN(1)) { for (int rep = 0; rep < PROBE_ROW_REP; ++rep) phase1(a, wv, vcu, G); } SEAM(1);
    if (PROBE_HANG && lo == 1) { volatile unsigned* q = (volatile unsigned*)(a.ws + 8); while (*q != 0x12345678u) __builtin_amdgcn_s_sleep(20); }
    if (IN(2)) {
        pg8::Gemm g{(const bf16_t*)(ws + WS_H), (const bf16_t*)(ws + WS_WIN), D, D, D, wv}; pg8::Order S; S.init(MTOK, ZP, 1, G, bx);
        pg8::EpiZ E{(bf16_t*)(ws + WS_Z), (float*)(ws + WS_RSSQ), (float*)(ws + WS_RSSKV)};
        pg8::gemm_phase<pg8::EpiZ, pg8::Order>(lds, g, S, E);
    } SEAM(2);
    if (IN(3)) {
#ifndef P3MASK
#define P3MASK 0x3f
#endif
#if (P3MASK >> 0) & 1
        { pg8::Gemm g{(const bf16_t*)(ws + WS_Z) + C_QLAT, (const bf16_t*)(ws + WS_WUQ), ZP, 384, 384, wv}; pg8::Order S; S.init(MTOK, 768, 1, G, bx);
          pg8::EpiQ E{(bf16_t*)(ws + WS_Q), (const float*)(ws + WS_RSSQ)}; pg8::gemm_phase<pg8::EpiQ, pg8::Order>(lds, g, S, E); }
#endif
#if (P3MASK >> 1) & 1
        { pg8::Gemm g{(const bf16_t*)(ws + WS_Z) + C_KVLAT, (const bf16_t*)(ws + WS_WKF), ZP, 256, 256, wv}; pg8::Order S; S.init(MTOK, 512, 1, G, (bx + G - 96) % G);
          pg8::EpiK E{(bf16_t*)(ws + WS_KP), (bf16_t*)(ws + WS_KS), (const float*)(ws + WS_RSSKV), 0}; pg8::gemm_phase<pg8::EpiK, pg8::Order>(lds, g, S, E); }
#endif
#if (P3MASK >> 2) & 1
        { pg8::Gemm g{(const bf16_t*)(ws + WS_WVF), (const bf16_t*)(ws + WS_Z) + C_KVLAT, 256, ZP, 256, wv}; pg8::Order S; S.init(512, MTOK, 1, G, (bx + G - 160) % G);
          pg8::EpiVt E{(bf16_t*)(ws + WS_VTP), (bf16_t*)(ws + WS_VTS), (const float*)(ws + WS_RSSKV), 0}; pg8::gemm_phase<pg8::EpiVt, pg8::Order>(lds, g, S, E); }
#endif
#if (P3MASK >> 3) & 1
        { pg8::Gemm g{(const bf16_t*)(ws + WS_CACHEB), (const bf16_t*)(ws + WS_WKU), 256, 256, 256, wv}; pg8::Order S; S.init(512, 512, 1, G, (bx + G - 224) % G);
          pg8::EpiK E{(bf16_t*)(ws + WS_KP), (bf16_t*)(ws + WS_KS), (const float*)(ws + WS_RSSKV), 1}; pg8::gemm_phase<pg8::EpiK, pg8::Order>(lds, g, S, E); }
#endif
#if (P3MASK >> 4) & 1
        { pg8::Gemm g{(const bf16_t*)(ws + WS_WVU), (const bf16_t*)(ws + WS_CACHEB), 256, 256, 256, wv}; pg8::Order S; S.init(512, 512, 1, G, (bx + G - 228) % G);
          pg8::EpiVt E{(bf16_t*)(ws + WS_VTP), (bf16_t*)(ws + WS_VTS), (const float*)(ws + WS_RSSKV), 1}; pg8::gemm_phase<pg8::EpiVt, pg8::Order>(lds, g, S, E); }
#endif
        __syncthreads();
        const int c2 = (bx + G - 232) % G;
#if (P3MASK >> 5) & 1
        for (int rep = 0; rep < PROBE_P3_REP; ++rep) for (int u = c2; u < 512; u += G) gla_stepA(a, wv, lds, u);
#endif
        for (int rep = 0; rep < PROBE_P3_REP; ++rep) p3_row_extras(a, wv, c2 * 8 + (otid(wv) >> 6), G * 8);
    } SEAM(3);
    if (IN(4)) { gla_scan(a, wv, vcu, G); } SEAM(4);
    if (IN(5)) {
        for (int rep = 0; rep < PROBE_ATT_REP; ++rep) for (int u = vcu; u < 512; u += G) attn_unit(a, wv, lds, u);
        for (int rep = 0; rep < PROBE_GLAC_REP; ++rep) for (int u = vcu; u < 512; u += G) gla_stepC(a, wv, lds, u);
    } SEAM(5);
    if (IN(6)) {
        pg8::Gemm g{(const bf16_t*)(ws + WS_MIX), (const bf16_t*)(ws + WS_WOUT), D, D, PROBE_K6, wv}; pg8::Order S; S.init(MTOK, D, 1024 / PROBE_K6, G, bx);
        pg8::EpiPart E{(bf16_t*)(ws + WS_P0), (bf16_t*)(ws + WS_P1A)}; pg8::gemm_phase<pg8::EpiPart, pg8::Order>(lds, g, S, E);
    } SEAM(6);
    if (IN(7)) { for (int rep = 0; rep < PROBE_ROW_REP; ++rep) phase6(a, wv, vcu, G); } SEAM(7);
    if (IN(8)) {
        pg8::Gemm g{(const bf16_t*)(ws + WS_H), (const bf16_t*)(ws + WS_WFFI), D, D, D, wv}; pg8::Order S; S.init(MTOK, 2 * DFF, 1, G, bx);
        pg8::EpiFFI E{(bf16_t*)(ws + WS_HFF)}; for (int rep = 0; rep < PROBE_FFI_REP; ++rep) pg8::gemm_phase<pg8::EpiFFI, pg8::Order>(lds, g, S, E);
    } SEAM(8);
    if (IN(9)) {
        pg8::Gemm g{(const bf16_t*)(ws + WS_HFF), (const bf16_t*)(ws + WS_WFFO), DFF, DFF, DFF / 2, wv}; pg8::Order S; S.init(MTOK, D, 2, G, bx);
        pg8::EpiPart E{(bf16_t*)(ws + WS_P0), (bf16_t*)(ws + WS_P1B)}; pg8::gemm_phase<pg8::EpiPart, pg8::Order>(lds, g, S, E);
    } SEAM(9);
    if (IN(10)) { for (int rep = 0; rep < PROBE_ROW_REP; ++rep) phase9(a, wv, vcu, G); }
    if (PROBE_DUMP) {
        if (PROBE_DUMP != 5 && PROBE_DUMP != 7) { ++nbar; } if (PROBE_DUMP != 5 && PROBE_DUMP != 7) my_grid_barrier(nbar, (unsigned)G, otid(wv), (LAS unsigned*)(lds + LDS_BYTES - 64));
        const bf16_t* src = (const bf16_t*)(ws + (PROBE_DUMP == 1 ? WS_Z : PROBE_DUMP == 2 ? WS_MIX : WS_H)); const int pitch = PROBE_DUMP == 1 ? ZP : D;
        for (size_t i = (size_t)bx * 512 + otid(wv); i < (size_t)MTOK * D; i += (size_t)G * 512) { const int r = (int)(i >> 10), c = (int)(i & 1023); a.out[i] = PROBE_DUMP == 7 ? 1.0f : PROBE_DUMP == 6 ? (r < 2304 ? bf2f(((const bf16_t*)(ws + WS_WIN))[(size_t)r * 1024 + c]) : 0.f) : PROBE_DUMP >= 4 ? xrow_ptr(a, r)[c] * 2.f : bf2f(src[(size_t)r * pitch + c]); }
        for (size_t i = O_KV + (size_t)bx * 512 + otid(wv); i < 10616832; i += (size_t)G * 512) a.out[i] = 0.f;
    }
    for (int xb = 0; xb < PROBE_XBAR; ++xb) { ++nbar; my_grid_barrier(nbar, (unsigned)G, otid(wv), (LAS unsigned*)(lds + LDS_BYTES - 64)); }
    if (nbar) my_grid_barrier_finish((unsigned)G, otid(wv));
#undef IN
#undef SEAM
}

extern "C" void kernel_launch(void* const* d_in, const int* in_sizes, int n_in, void* d_out, int out_size, void* d_ws, size_t ws_size, hipStream_t stream) {
    static int grid = 0;
    if (grid == 0) {
        int dev = 0, cus = 0;
        static const int exp_sizes[26] = {4194304, 4194304, 131072, 16384, 65536, 65536, 2048, 1024, 6291456, 6144, 1024, 2293760, 384, 294912, 256, 262144, 4096, 256, 4096, 256, 128, 1048576, 1024, 5767168, 2883584, 1024};
        bool okk = (n_in == 26); for (int i = 0; okk && i < 26; ++i) okk = (in_sizes[i] == exp_sizes[i]);
        if (!okk || out_size != 10616832) { fprintf(stderr, "kernel_launch: unexpected input sizes\n"); grid = -1; return; }
        if (n_in != 26 || ws_size < 198 * MiB) { fprintf(stderr, "kernel_launch: unexpected n_in %d / ws %zu\n", n_in, ws_size); grid = -1; return; }
        hipGetDevice(&dev); hipDeviceGetAttribute(&cus, hipDeviceAttributeMultiprocessorCount, dev);
        if (hipFuncSetAttribute((const void*)mk_fwd, hipFuncAttributeMaxDynamicSharedMemorySize, LDS_BYTES) != hipSuccess) { fprintf(stderr, "kernel_launch: hipFuncSetAttribute failed\n"); grid = -1; return; }
        int per_cu = 0;
        if (hipOccupancyMaxActiveBlocksPerMultiprocessor(&per_cu, (const void*)mk_fwd, 512, LDS_BYTES) != hipSuccess || per_cu < 1) { fprintf(stderr, "kernel_launch: occupancy query says %d\n", per_cu); per_cu = 1; }
        (void)hipGetLastError();
        if (cus < 256) { fprintf(stderr, "kernel_launch: needs 256 CUs, got %d\n", cus); grid = -1; return; }
        grid = 256;
    }
    if (grid < 0) return;
    if (hipMemsetAsync((char*)d_ws + WS_BAR, 0, 4096, stream) != hipSuccess) { fprintf(stderr, "kernel_launch: memset failed\n"); return; }
    Args a{};
    for (int i = 0; i < 26; ++i) a.in[i] = (const float*)d_in[i];
    a.out = (float*)d_out; a.ws = (unsigned char*)d_ws;
#if MK_PER_PHASE_LAUNCH
    for (int p = 0; p < NPHASE; ++p) { if (PROBE_ONLY_LAUNCH >= 0 && p != PROBE_ONLY_LAUNCH) continue; a.ph_lo = p; a.ph_hi = p + 1; hipLaunchKernelGGL(mk_fwd, dim3(grid), dim3(512), LDS_BYTES, stream, a); }
#else
    a.ph_lo = 0; a.ph_hi = NPHASE;
#if MK_COOP
    void* args[] = {&a};
    hipError_t e = hipLaunchCooperativeKernel((const void*)mk_fwd, dim3(grid), dim3(512), args, LDS_BYTES, stream);
    if (e != hipSuccess) fprintf(stderr, "cooperative launch failed: %s (grid %d)\n", hipGetErrorString(e), grid);
#else
    hipLaunchKernelGGL(mk_fwd, dim3(grid), dim3(512), LDS_BYTES, stream, a);
#endif
#endif
}
```

```cpp
#include <hip/hip_runtime.h>
#include <hip/hip_cooperative_groups.h>
#include <cstdio>
#include <cstdint>
namespace cg = cooperative_groups;

#define PROBE_FILL 0
#define PROBE_EXC 0
#define PROBE_BLO 0
#define PROBE_BHI 256
#define PROBE_RSTRIDE 1
#define PROBE_REP 1
#define PROBE_XLO 0
#define PROBE_XHI 8
#define PROBE_HANG 0
#define PROBE_ATT_REP 1
#define PROBE_GLAC_REP 1
#define PROBE_FFI_REP 1
#define PROBE_XBAR 0
#define PROBE_P0_REP 1
#define PROBE_ROW_REP 1
#define PROBE_P3_REP 1
#define PROBE_DUMP 0
#define PROBE_STATS 0
#define PROBE_K6 512
#define PROBE_ONLY_LAUNCH -1
#define PROBE_NOSTORE 0
#define PROBE_FILL_MIB 256
#define PROBE_FILL_VAL 1.2345f
#ifndef PROBE_MUL
#define PROBE_MUL 1.f
#endif
#ifndef PROBE_MODOFF
#define PROBE_MODOFF 0u
#endif
#ifndef MK_COOP
#define MK_COOP 0
#endif
#ifndef MK_PER_PHASE_LAUNCH
#define MK_PER_PHASE_LAUNCH 0
#endif

#define LAS __attribute__((address_space(3)))
typedef unsigned short bf16_t;
typedef short bf16x8 __attribute__((ext_vector_type(8)));
typedef float f32x4 __attribute__((ext_vector_type(4)));
typedef float f32x2 __attribute__((ext_vector_type(2)));
typedef unsigned u32x4 __attribute__((ext_vector_type(4)));
typedef unsigned u32x2 __attribute__((ext_vector_type(2)));

constexpr int D = 1024, MTOK = 8192, MP = 4096;
constexpr int ZP = 2304;
constexpr int C_QLAT = 0, C_KVLAT = 384, C_KROPE = 640, C_GQ = 672, C_GK = 928, C_GV = 1184, C_GFL = 1696, C_GOUT = 1728;
constexpr int DFF = 2816;
constexpr float EPS = 1e-6f;
constexpr float QSCALE = 0.10206207261596577f * 1.4426950408889634f;
constexpr int SKS = 2304;

constexpr size_t MiB = 1u << 20;
constexpr size_t WS_WIN = 1 * MiB;
constexpr size_t WS_WUQ = 6 * MiB;
constexpr size_t WS_WKF = 7 * MiB, WS_WVF = 7 * MiB + 256 * 1024;
constexpr size_t WS_WKU = 7 * MiB + 512 * 1024, WS_WVU = 7 * MiB + 768 * 1024;
constexpr size_t WS_WOUT = 8 * MiB;
constexpr size_t WS_WFFI = 10 * MiB;
constexpr size_t WS_WFFO = 21 * MiB;
constexpr size_t WS_BAR = 27 * MiB - 4096;
constexpr size_t WS_MOD = 27 * MiB;
constexpr size_t WS_RSSQ = 29 * MiB;
constexpr size_t WS_RSSKV = WS_RSSQ;
constexpr size_t WS_CACHEB = 27 * MiB + 512 * 1024;
constexpr size_t WS_DEC = 28 * MiB;
constexpr size_t WS_H = 32 * MiB;
constexpr size_t WS_Z = 48 * MiB;
constexpr size_t WS_Q = 84 * MiB;
constexpr size_t WS_HFF = 48 * MiB;
constexpr size_t WS_KP = 96 * MiB;
constexpr size_t WS_KS = 102 * MiB;
constexpr size_t WS_VTP = 109 * MiB;
constexpr size_t WS_VTS = 113 * MiB;
constexpr size_t WS_CT = 118 * MiB;
constexpr size_t WS_MIX = 150 * MiB;
constexpr size_t WS_X1 = 166 * MiB;
constexpr size_t WS_P0 = 96 * MiB;
constexpr size_t WS_P1A = 48 * MiB, WS_P1B = 128 * MiB;
constexpr size_t O_Y = 0, O_KV = 8388608, O_KR = O_KV + 1048576, O_SF = O_KR + 131072, O_SB = O_SF + 524288;

constexpr int LDS_BYTES = 147456;

__device__ __forceinline__ unsigned f2bf_sw(float f) { unsigned u = __builtin_bit_cast(unsigned, f); return (u + 0x7fffu + ((u >> 16) & 1u)) >> 16; }
__device__ __forceinline__ unsigned cvt_pk_bf16(float lo, float hi) { unsigned r; asm volatile("v_cvt_pk_bf16_f32 %0, %1, %2" : "=v"(r) : "v"(lo), "v"(hi)); return r; }
__device__ __forceinline__ bf16_t f2bf(float f) { return (bf16_t)(cvt_pk_bf16(f, 0.f) & 0xffffu); }
__device__ __forceinline__ float bf2f(bf16_t b) { return __uint_as_float((unsigned)b << 16); }
__device__ __forceinline__ float bflo(unsigned w) { return __uint_as_float(w << 16); }
__device__ __forceinline__ float bfhi(unsigned w) { return __uint_as_float(w & 0xffff0000u); }
__device__ __forceinline__ float wave_sum(float v) {
#pragma unroll
    for (int o = 1; o < 64; o <<= 1) v += __shfl_xor(v, o);
    return v;
}
__device__ __forceinline__ float fast_rcp(float x) { return __builtin_amdgcn_rcpf(x); }
__device__ __forceinline__ float silu_f(float a) { return a * fast_rcp(1.f + __expf(-a)); }
__device__ __forceinline__ float logsigmoid_f(float x) { return fminf(x, 0.f) - __logf(1.f + __expf(-fabsf(x))); }
__device__ __forceinline__ int opaque_lane() { int l; asm volatile("v_mbcnt_lo_u32_b32 %0, -1, 0\n\tv_mbcnt_hi_u32_b32 %0, -1, %0" : "=v"(l)); return l; }
__device__ __forceinline__ int otid(int wv) { int t = (int)threadIdx.x; asm volatile("" : "+v"(t)); return t; }
#define LDS_WAIT() asm volatile("s_waitcnt lgkmcnt(0)" ::: "memory")
#define VM_WAIT() asm volatile("s_waitcnt vmcnt(0)" ::: "memory")

namespace pg8 {
constexpr int BM = 256, BK = 64, HALF = 128, HTB = HALF * BK * 2, STAGE_BYTES = 8 * HTB, NXCD = 8, WGM = 8;
__host__ __device__ __forceinline__ int lds_byte(int r, int c) { const int st = (r >> 4) * 2 + (c >> 5), rr = r & 15, cc = c & 31, ob = rr * 64 + cc * 2; return st * 1024 + (ob ^ (((ob >> 9) & 1) << 5)); }
__host__ __device__ __forceinline__ void stage_rc(int b, int& R, int& C) { const int st = b / 1024, sb = b % 1024, swz = sb ^ (((sb >> 9) & 1) << 5); R = (st >> 1) * 16 + swz / 64; C = (st & 1) * 32 + (swz % 64) / 2; }
__host__ __device__ __forceinline__ int perm32(int rho) { const int n = rho >> 4, i = rho & 15; return 8 * (i >> 2) + 4 * n + (i & 3); }

struct Unit { int pm, pn, ks; };
struct Gemm { const bf16_t* A; const bf16_t* Bt; int lda, ldb, K, wv; };

struct Order {
    int nM, nN, nNs, nwg, G, c;
    __device__ void init(int M, int N, int nsplit, int G_, int c_) { nM = M / BM; nN = N / BM; nNs = nN * nsplit; nwg = nM * nNs; G = G_; c = c_; }
    __device__ bool next(int i, Unit& u) const {
        const long L = (long)i * G + c; if (L >= nwg) return false;
        int wgid = (int)L; { const int q = nwg / NXCD, r = nwg % NXCD, xcd = wgid % NXCD, off = wgid / NXCD; wgid = (xcd < r ? xcd * (q + 1) : r * (q + 1) + (xcd - r) * q) + off; }
        const int nig = WGM * nNs, gid = wgid / nig, fm = gid * WGM, gsz = (nM - fm) < WGM ? (nM - fm) : WGM;
        u.pm = fm + ((wgid % nig) % gsz); const int pn2 = (wgid % nig) / gsz; u.pn = pn2 % nN; u.ks = pn2 / nN; return true;
    }
};

template <class Epi, class Sched, bool ALIGN_EPI = true, bool SP2 = true>
__device__ __forceinline__ void gemm_phase(LAS unsigned char* lds, const Gemm g, const Sched& S, const Epi& E) {
    const int tid = otid(g.wv), wid = g.wv, lane = tid & 63, wr = wid >> 2, wc = wid & 3, fr = lane & 15, fq = lane >> 4;
    const int K = g.K, nt = K / BK;
    unsigned voffA[2], voffB[2];
#pragma unroll
    for (int i = 0; i < 2; ++i) { int R, C; stage_rc(tid * 16 + i * 8192, R, C); const int Rb = Epi::PERM ? ((R & ~31) + perm32(R & 31)) : R;
        voffA[i] = (unsigned)(R * g.lda + C) * 2u; voffB[i] = (unsigned)(Rb * g.ldb + C) * 2u; }
    const size_t kstep = (size_t)(BK * 2);
    const size_t hstepA = (size_t)HALF * g.lda * 2, hstepB = (size_t)HALF * g.ldb * 2;
    const size_t tstepA = 2 * hstepA, tstepB = 2 * hstepB;
    const size_t ksplit = (size_t)K * 2;
    const unsigned ldsw = (unsigned)wid * 1024u;
    const int aoff = lds_byte(wr * 64 + fr, fq * 8), boff = lds_byte(wc * 32 + fr, fq * 8);
#define PG8_SA(b, h) (((b) * 2 + (h)) * HTB)
#define PG8_SB(b, h) ((4 + (b) * 2 + (h)) * HTB)
#define PG8_STAGE(bufoff, gbase, voff) do { _Pragma("unroll") for (int _i = 0; _i < 2; ++_i) \
        __builtin_amdgcn_global_load_lds((const unsigned*)((const char*)(gbase) + (voff)[_i]), (LAS unsigned*)(lds + (bufoff) + ldsw + _i * 8192), 16, 0, 0); } while (0)
#define PG8_LDA(dst, b, h) do { _Pragma("unroll") for (int m = 0; m < 4; ++m) _Pragma("unroll") for (int k = 0; k < 2; ++k) dst[m][k] = *(const LAS bf16x8*)(lds + PG8_SA(b, h) + aoff + m * 2048 + k * 1024); } while (0)
#define PG8_LDB(dst, b, h) do { _Pragma("unroll") for (int n = 0; n < 2; ++n) _Pragma("unroll") for (int k = 0; k < 2; ++k) dst[n][k] = *(const LAS bf16x8*)(lds + PG8_SB(b, h) + boff + n * 2048 + k * 1024); } while (0)
#define PG8_MMA(ai, bj, At, Bt) do { __builtin_amdgcn_s_setprio(1); _Pragma("unroll") for (int m = 0; m < 4; ++m) _Pragma("unroll") for (int n = 0; n < 2; ++n) _Pragma("unroll") for (int k = 0; k < 2; ++k) \
        acc[ai][bj][m][n] = __builtin_amdgcn_mfma_f32_16x16x32_bf16(Bt[n][k], At[m][k], acc[ai][bj][m][n], 0, 0, 0); __builtin_amdgcn_s_setprio(0); } while (0)
#define PG8_WAIT_V(n) asm volatile("s_waitcnt vmcnt(" #n ")" ::: "memory")
#define PG8_WAIT_L(n) asm volatile("s_waitcnt lgkmcnt(" #n ")" ::: "memory")
#define PG8_BAR __builtin_amdgcn_s_barrier()
#define PG8_SCHED __builtin_amdgcn_sched_barrier(0)
    Unit cur, nxt; int ui = 0;
    if (!S.next(0, cur)) return;
    f32x4 acc[2][2][4][2];
#pragma unroll
    for (int a = 0; a < 2; ++a)
#pragma unroll
        for (int b = 0; b < 2; ++b)
#pragma unroll
            for (int m = 0; m < 4; ++m)
#pragma unroll
                for (int n = 0; n < 2; ++n) acc[a][b][m][n] = (f32x4){0.f, 0.f, 0.f, 0.f};
    bf16x8 At[4][2], B0[2][2], B1[2][2];
    const char* cA = (const char*)g.A + (size_t)cur.pm * tstepA + (size_t)cur.ks * ksplit; const char* cB = (const char*)g.Bt + (size_t)cur.pn * tstepB + (size_t)cur.ks * ksplit;
    if constexpr (SP2) {
        PG8_STAGE(PG8_SB(0, 0), cB, voffB); PG8_STAGE(PG8_SB(0, 1), cB + hstepB, voffB); PG8_STAGE(PG8_SA(0, 0), cA, voffA); PG8_STAGE(PG8_SA(0, 1), cA + hstepA, voffA);
        if (wr == 1) PG8_BAR;
        PG8_WAIT_V(2); PG8_BAR;
        PG8_STAGE(PG8_SB(1, 0), cB + kstep, voffB); PG8_STAGE(PG8_SA(1, 0), cA + kstep, voffA); PG8_STAGE(PG8_SB(1, 1), cB + hstepB + kstep, voffB);
        PG8_WAIT_V(6); PG8_BAR;
    } else {
        PG8_STAGE(PG8_SB(0, 0), cB, voffB); PG8_STAGE(PG8_SA(0, 0), cA, voffA); PG8_STAGE(PG8_SB(0, 1), cB + hstepB, voffB); PG8_STAGE(PG8_SA(0, 1), cA + hstepA, voffA);
        if (wr == 1) PG8_BAR;
        PG8_WAIT_V(4); PG8_BAR;
        PG8_STAGE(PG8_SB(1, 0), cB + kstep, voffB); PG8_STAGE(PG8_SA(1, 0), cA + kstep, voffA); PG8_STAGE(PG8_SB(1, 1), cB + hstepB + kstep, voffB);
        PG8_WAIT_V(6); PG8_BAR;
    }
    for (;;) {
        const bool has_next = S.next(ui + 1, nxt);
        const char* nA = has_next ? (const char*)g.A + (size_t)nxt.pm * tstepA + (size_t)nxt.ks * ksplit : cA; const char* nB = has_next ? (const char*)g.Bt + (size_t)nxt.pn * tstepB + (size_t)nxt.ks * ksplit : cB;
#pragma nounroll
        for (int t = 0; t < nt; t += 2) {
            const bool last = (t == nt - 2);
            const char* a1 = cA + (size_t)(t + 1) * kstep;
            const char* a2 = last ? nA : cA + (size_t)(t + 2) * kstep; const char* b2 = last ? nB : cB + (size_t)(t + 2) * kstep;
            const char* a3 = a2 + kstep; const char* b3 = b2 + kstep;
            if constexpr (SP2) {
            PG8_LDB(B0, 0, 0); PG8_LDB(B1, 0, 1); PG8_SCHED; PG8_LDA(At, 0, 0); PG8_STAGE(PG8_SA(1, 1), a1 + hstepA, voffA);
            PG8_WAIT_V(8); PG8_WAIT_L(0); PG8_BAR; PG8_MMA(0, 0, At, B0); PG8_MMA(0, 1, At, B1); PG8_BAR; PG8_SCHED;
            PG8_LDA(At, 0, 1); PG8_STAGE(PG8_SB(0, 0), b2, voffB); PG8_STAGE(PG8_SB(0, 1), b2 + hstepB, voffB); PG8_STAGE(PG8_SA(0, 0), a2, voffA);
            PG8_WAIT_V(8); PG8_WAIT_L(0); PG8_BAR; PG8_MMA(1, 0, At, B0); PG8_MMA(1, 1, At, B1); PG8_BAR; PG8_SCHED;
            PG8_LDB(B0, 1, 0); PG8_LDB(B1, 1, 1); PG8_SCHED; PG8_LDA(At, 1, 0); PG8_STAGE(PG8_SA(0, 1), a2 + hstepA, voffA);
            PG8_WAIT_V(8); PG8_WAIT_L(0); PG8_BAR; PG8_MMA(0, 0, At, B0); PG8_MMA(0, 1, At, B1); PG8_BAR; PG8_SCHED;
            PG8_LDA(At, 1, 1); PG8_STAGE(PG8_SB(1, 0), b3, voffB); PG8_STAGE(PG8_SB(1, 1), b3 + hstepB, voffB); PG8_STAGE(PG8_SA(1, 0), a3, voffA);
            PG8_WAIT_V(8); PG8_WAIT_L(0); PG8_BAR; PG8_MMA(1, 0, At, B0); PG8_MMA(1, 1, At, B1); PG8_BAR; PG8_SCHED;
            } else {
            PG8_LDB(B0, 0, 0); PG8_SCHED; PG8_LDA(At, 0, 0); PG8_STAGE(PG8_SA(1, 1), a1 + hstepA, voffA);
            PG8_WAIT_L(8); PG8_BAR; PG8_WAIT_L(0); PG8_MMA(0, 0, At, B0); PG8_BAR; PG8_SCHED;
            PG8_LDB(B1, 0, 1); PG8_STAGE(PG8_SB(0, 0), b2, voffB);
            PG8_BAR; PG8_WAIT_L(0); PG8_MMA(0, 1, At, B1); PG8_BAR;
            PG8_LDA(At, 0, 1); PG8_STAGE(PG8_SA(0, 0), a2, voffA);
            PG8_BAR; PG8_WAIT_L(0); PG8_MMA(1, 0, At, B0); PG8_BAR; PG8_SCHED;
            PG8_STAGE(PG8_SB(0, 1), b2 + hstepB, voffB);
            PG8_WAIT_V(6); PG8_BAR; PG8_MMA(1, 1, At, B1); PG8_BAR;
            PG8_LDB(B0, 1, 0); PG8_SCHED; PG8_LDA(At, 1, 0); PG8_STAGE(PG8_SA(0, 1), a2 + hstepA, voffA);
            PG8_WAIT_L(8); PG8_BAR; PG8_WAIT_L(0); PG8_MMA(0, 0, At, B0); PG8_BAR; PG8_SCHED;
            PG8_LDB(B1, 1, 1); PG8_STAGE(PG8_SB(1, 0), b3, voffB);
            PG8_BAR; PG8_WAIT_L(0); PG8_MMA(0, 1, At, B1); PG8_BAR;
            PG8_LDA(At, 1, 1); PG8_STAGE(PG8_SA(1, 0), a3, voffA);
            PG8_BAR; PG8_WAIT_L(0); PG8_MMA(1, 0, At, B0); PG8_BAR; PG8_SCHED;
            PG8_STAGE(PG8_SB(1, 1), b3 + hstepB, voffB);
            PG8_WAIT_V(6); PG8_BAR; PG8_MMA(1, 1, At, B1); PG8_BAR;
            }
        }
        if constexpr (ALIGN_EPI) { if (wr == 0) PG8_BAR; }
        E(acc, cur, wr, wc, fr, fq);
        if (!has_next) break;
#pragma unroll
        for (int a = 0; a < 2; ++a)
#pragma unroll
            for (int b = 0; b < 2; ++b)
#pragma unroll
                for (int m = 0; m < 4; ++m)
#pragma unroll
                    for (int n = 0; n < 2; ++n) acc[a][b][m][n] = (f32x4){0.f, 0.f, 0.f, 0.f};
        cur = nxt; cA = nA; cB = nB; ++ui;
        if constexpr (ALIGN_EPI) { if (wr == 1) PG8_BAR; }
    }
    PG8_WAIT_V(0);
    if constexpr (!ALIGN_EPI) { if (wr == 0) PG8_BAR; }
    PG8_BAR;
#undef PG8_SA
#undef PG8_SB
#undef PG8_STAGE
#undef PG8_LDA
#undef PG8_LDB
#undef PG8_MMA
#undef PG8_WAIT_V
#undef PG8_WAIT_L
#undef PG8_BAR
#undef PG8_SCHED
}

__device__ __forceinline__ float rss_q(const float* rss, int row) { float s = 0.f;
#pragma unroll
    for (int p = 0; p < 12; ++p) s += rss[(size_t)p * MTOK + row]; return s; }
__device__ __forceinline__ float rss_kv(const float* rss, int row) { float s = 0.f;
#pragma unroll
    for (int p = 12; p < 20; ++p) s += rss[(size_t)p * MTOK + row]; return s; }
#define EPI_ROWS_BEGIN _Pragma("unroll") for (int ai = 0; ai < 2; ++ai) _Pragma("unroll") for (int m = 0; m < 4; ++m) { const int row = u.pm * BM + wr * 64 + fr + ai * HALF + m * 16;
#define EPI_ROWS_END asm volatile("" ::: "memory"); }

struct EpiZ {
    static constexpr bool PERM = true;
    bf16_t* Z; float* rssq; float* rsskv; int pn_off;
    __device__ __forceinline__ void operator()(const f32x4 (&acc)[2][2][4][2], const Unit& u, int wr, int wc, int fr_, int fq_) const {
        int lane_e = (int)threadIdx.x & 63; asm volatile("" : "+v"(lane_e)); const int fr = lane_e & 15, fq = lane_e >> 4;
        const int col0 = (u.pn + pn_off) * BM + wc * 32 + 8 * fq;
        EPI_ROWS_BEGIN
            bf16_t* rowp = Z + (size_t)row * ZP + col0;
#pragma unroll
            for (int bj = 0; bj < 2; ++bj) { const f32x4 v0 = acc[ai][bj][m][0], v1 = acc[ai][bj][m][1];
                u32x4 w; w.x = cvt_pk_bf16(v0[0], v0[1]); w.y = cvt_pk_bf16(v0[2], v0[3]); w.z = cvt_pk_bf16(v1[0], v1[1]); w.w = cvt_pk_bf16(v1[2], v1[3]);
                *(u32x4*)(rowp + bj * HALF) = w;
                const int hc = 2 * (u.pn + pn_off) + bj;
                if (hc < 5) { float s = (v0[0] * v0[0] + v0[1] * v0[1]) + (v0[2] * v0[2] + v0[3] * v0[3]) + (v1[0] * v1[0] + v1[1] * v1[1]) + (v1[2] * v1[2] + v1[3] * v1[3]);
                    s += __shfl_xor(s, 16); s += __shfl_xor(s, 32);
                    if (fq == 0) rssq[(size_t)(hc * 4 + wc) * MTOK + row] = s; } }
        EPI_ROWS_END
    }
};

struct EpiQ {
    static constexpr bool PERM = true;
    bf16_t* Q; const float* rssq;
    __device__ __forceinline__ void operator()(const f32x4 (&acc)[2][2][4][2], const Unit& u, int wr, int wc, int fr_, int fq_) const {
        int lane_e = (int)threadIdx.x & 63; asm volatile("" : "+v"(lane_e)); const int fr = lane_e & 15, fq = lane_e >> 4;
        const int col0 = u.pn * BM + wc * 32 + 8 * fq;
        const float inv[8] = {1.f, 0.316227766f, 0.1f, 0.0316227766f, 0.01f, 0.00316227766f, 0.001f, 0.000316227766f};
        EPI_ROWS_BEGIN
            const float rs = rsqrtf(rss_q(rssq, row) * (1.f / 384.f) + EPS) * QSCALE;
            const int t = (row - MP) & 2047;
#pragma unroll
            for (int bj = 0; bj < 2; ++bj) { const int c = col0 + bj * HALF; const int j0 = c % 96;
                const bool rp = (row >= MP && j0 >= 64);
                const float pos = (float)((j0 < 80) ? (t >> 6) : (t & 63)) * 0.15915494309189535f;
                const float sg = (j0 & 8) ? 1.f : -1.f;
#pragma unroll
                for (int n = 0; n < 2; ++n) {
                    f32x4 v = acc[ai][bj][m][n] * rs;
#pragma unroll
                    for (int i = 0; i < 4; ++i) { const float p = __shfl_xor(v[i], 16);
                        const float rev = pos * inv[4 * n + i]; const float rf = rev - floorf(rev);
                        const float cs = __builtin_amdgcn_cosf(rf), sn = __builtin_amdgcn_sinf(rf); v[i] = rp ? v[i] * cs + sg * p * sn : v[i]; }
                    u32x2 w; w.x = cvt_pk_bf16(v[0], v[1]); w.y = cvt_pk_bf16(v[2], v[3]);
                    *(u32x2*)(Q + (size_t)row * 768 + c + 4 * n) = w; } }
        EPI_ROWS_END
    }
};

struct EpiK {
    static constexpr bool PERM = true;
    bf16_t* Kp; bf16_t* Ks; const float* rsskv; int ctx;
    __device__ __forceinline__ void operator()(const f32x4 (&acc)[2][2][4][2], const Unit& u, int wr, int wc, int fr_, int fq_) const {
        int lane_e = (int)threadIdx.x & 63; asm volatile("" : "+v"(lane_e)); const int fr = lane_e & 15, fq = lane_e >> 4;
        EPI_ROWS_BEGIN
            float rs = 1.f; unsigned off; bool smp;
            if (ctx) { off = ((unsigned)(row >> 8) * 8u * SKS + (row & 255)) * 96u; smp = true; }
            else { rs = rsqrtf(rss_kv(rsskv, row) * (1.f / 256.f) + EPS);
                if (row < MP) { off = ((unsigned)(row >> 8) * 8u * 256u + (row & 255)) * 96u; smp = false; } else { off = ((unsigned)((row - MP) >> 11) * 8u * SKS + 256u + ((row - MP) & 2047)) * 96u; smp = true; } }
            bf16_t* base = smp ? Ks : Kp; const unsigned hs = (smp ? SKS : 256) * 96u;
#pragma unroll
            for (int bj = 0; bj < 2; ++bj) { const unsigned h = 4 * u.pn + 2 * bj + (wc >> 1); const unsigned j = (wc & 1) * 32 + 8 * fq;
                const f32x4 v0 = acc[ai][bj][m][0] * rs, v1 = acc[ai][bj][m][1] * rs;
                u32x4 w; w.x = cvt_pk_bf16(v0[0], v0[1]); w.y = cvt_pk_bf16(v0[2], v0[3]); w.z = cvt_pk_bf16(v1[0], v1[1]); w.w = cvt_pk_bf16(v1[2], v1[3]);
                *(u32x4*)(base + (off + h * hs + j)) = w; }
        EPI_ROWS_END
    }
};

struct EpiVt {
    static constexpr bool PERM = true;
    bf16_t* Vtp; bf16_t* Vts; const float* rsskv; int ctx;
    __device__ __forceinline__ void operator()(const f32x4 (&acc)[2][2][4][2], const Unit& u, int wr, int wc, int fr_, int fq_) const {
        int lane_e = (int)threadIdx.x & 63; asm volatile("" : "+v"(lane_e)); const int fr = lane_e & 15, fq = lane_e >> 4;
#pragma unroll
        for (int bj = 0; bj < 2; ++bj) {
            const int tok = u.pn * BM + bj * HALF + wc * 32 + 8 * fq;
            f32x4 r0 = {1.f, 1.f, 1.f, 1.f}, r1 = {1.f, 1.f, 1.f, 1.f}; unsigned off; bool smp; unsigned S;
            if (ctx) { off = (unsigned)(tok >> 8) * 8u * 64u * SKS + (tok & 255); smp = true; S = SKS; }
            else { f32x4 q0 = {0.f, 0.f, 0.f, 0.f}, q1 = {0.f, 0.f, 0.f, 0.f};
#pragma unroll
                for (int p = 12; p < 20; ++p) { q0 += *(const f32x4*)(rsskv + (size_t)p * MTOK + tok); q1 += *(const f32x4*)(rsskv + (size_t)p * MTOK + tok + 4); }
#pragma unroll
                for (int i = 0; i < 4; ++i) { r0[i] = rsqrtf(q0[i] * (1.f / 256.f) + EPS); r1[i] = rsqrtf(q1[i] * (1.f / 256.f) + EPS); }
                if (tok < MP) { off = (unsigned)(tok >> 8) * 8u * 64u * 256u + (tok & 255); smp = false; S = 256; } else { off = (unsigned)((tok - MP) >> 11) * 8u * 64u * SKS + 256u + ((tok - MP) & 2047); smp = true; S = SKS; } }
            bf16_t* base = smp ? Vts : Vtp;
#pragma unroll
            for (int ai = 0; ai < 2; ++ai)
#pragma unroll
                for (int m = 0; m < 4; ++m) { const unsigned hd = u.pm * BM + wr * 64 + fr + ai * HALF + m * 16;
                    const f32x4 v0 = acc[ai][bj][m][0] * r0, v1 = acc[ai][bj][m][1] * r1;
                    u32x4 w; w.x = cvt_pk_bf16(v0[0], v0[1]); w.y = cvt_pk_bf16(v0[2], v0[3]); w.z = cvt_pk_bf16(v1[0], v1[1]); w.w = cvt_pk_bf16(v1[2], v1[3]);
                    *(u32x4*)(base + (off + hd * S)) = w; }
            asm volatile("" ::: "memory");
        }
    }
};

struct EpiPart {
    static constexpr bool PERM = true;
    bf16_t* P0; bf16_t* P1;
    __device__ __forceinline__ void operator()(const f32x4 (&acc)[2][2][4][2], const Unit& u, int wr, int wc, int fr_, int fq_) const {
        int lane_e = (int)threadIdx.x & 63; asm volatile("" : "+v"(lane_e)); const int fr = lane_e & 15, fq = lane_e >> 4;
        const int col0 = u.pn * BM + wc * 32 + 8 * fq; bf16_t* P = u.ks ? P1 : P0;
        EPI_ROWS_BEGIN
            bf16_t* rowp = P + (size_t)row * D + col0;
#pragma unroll
            for (int bj = 0; bj < 2; ++bj) { const f32x4 v0 = acc[ai][bj][m][0], v1 = acc[ai][bj][m][1];
                u32x4 w; w.x = cvt_pk_bf16(v0[0], v0[1]); w.y = cvt_pk_bf16(v0[2], v0[3]); w.z = cvt_pk_bf16(v1[0], v1[1]); w.w = cvt_pk_bf16(v1[2], v1[3]);
                *(u32x4*)(rowp + bj * HALF) = w; }
        EPI_ROWS_END
    }
};

struct EpiFFI {
    static constexpr bool PERM = true;
    bf16_t* H;
    __device__ __forceinline__ void operator()(const f32x4 (&acc)[2][2][4][2], const Unit& u, int wr, int wc, int fr_, int fq_) const {
        int lane_e = (int)threadIdx.x & 63; asm volatile("" : "+v"(lane_e)); const int fr = lane_e & 15, fq = lane_e >> 4;
        const int col0 = u.pn * HALF + wc * 32 + 8 * fq;
        EPI_ROWS_BEGIN
            float o[8];
#pragma unroll
            for (int i = 0; i < 4; ++i) { o[i] = silu_f(acc[ai][0][m][0][i]) * acc[ai][1][m][0][i]; o[4 + i] = silu_f(acc[ai][0][m][1][i]) * acc[ai][1][m][1][i]; }
            u32x4 w; w.x = cvt_pk_bf16(o[0], o[1]); w.y = cvt_pk_bf16(o[2], o[3]); w.z = cvt_pk_bf16(o[4], o[5]); w.w = cvt_pk_bf16(o[6], o[7]);
            *(u32x4*)(H + (size_t)row * DFF + col0) = w;
        EPI_ROWS_END
    }
};
}

struct Args { const float* in[26]; float* out; unsigned char* ws; int ph_lo, ph_hi; };
enum { I_XP = 0, I_XS, I_CKV, I_CKR, I_SF, I_SB, I_C, I_CCTX, I_WADA, I_BADA, I_NATT, I_WIN, I_QN, I_WUQ, I_KVN, I_WUKV, I_WGF, I_BGF, I_WGB, I_BGB, I_GLAN, I_WOUT, I_NFFN, I_WFFI, I_WFFO, I_FN };

__device__ __forceinline__ const float* xrow_ptr(const Args& a, int r) { return r < MP ? a.in[I_XP] + (size_t)r * D : a.in[I_XS] + (size_t)(r - MP) * D; }
__device__ __forceinline__ int cond_of_row(int r) { return r < MP ? 0 : 1 + ((r - MP) >> 11); }

__device__ __forceinline__ void p0_tr(const float* W, int K, int N, bf16_t* WT, bf16_t* WT2, const float* kscale, int kb, int nb, int drow, LAS float* scr, int lane) {
    const int k0 = 64 * kb, n0 = 32 * nb;
#pragma unroll 8
    for (int i = 0; i < 32; ++i) { const int kk = 2 * i + (lane >> 5); scr[kk * 33 + (lane & 31)] = W[(size_t)(k0 + kk) * N + n0 + (lane & 31)]; }
    LDS_WAIT();
    const int c = lane & 7;
    float sc[8];
#pragma unroll
    for (int i = 0; i < 8; ++i) sc[i] = kscale ? kscale[k0 + 8 * c + i] : 1.f;
#pragma unroll
    for (int j = 0; j < 4; ++j) { const int n = (lane >> 3) + 8 * j; const LAS float* s = scr + (8 * c) * 33 + n;
        float v[8];
#pragma unroll
        for (int i = 0; i < 8; ++i) v[i] = s[i * 33];
        if (WT2) { u32x4 o; o.x = cvt_pk_bf16(v[0], v[1]); o.y = cvt_pk_bf16(v[2], v[3]); o.z = cvt_pk_bf16(v[4], v[5]); o.w = cvt_pk_bf16(v[6], v[7]);
            *(u32x4*)(WT2 + (size_t)(drow + n0 + n) * K + k0 + 8 * c) = o; }
        u32x4 o; o.x = cvt_pk_bf16(v[0] * sc[0], v[1] * sc[1]); o.y = cvt_pk_bf16(v[2] * sc[2], v[3] * sc[3]); o.z = cvt_pk_bf16(v[4] * sc[4], v[5] * sc[5]); o.w = cvt_pk_bf16(v[6] * sc[6], v[7] * sc[7]);
        *(u32x4*)(WT + (size_t)(drow + n0 + n) * K + k0 + 8 * c) = o; }
    LDS_WAIT();
}

__device__ __forceinline__ void phase0(const Args& a, int wv, LAS unsigned char* lds, int vcu, int G) {
    const int tid = otid(wv), lane = tid & 63, wave = __builtin_amdgcn_readfirstlane(tid >> 6);
    unsigned char* ws = a.ws;
#ifndef P0MASK
#define P0MASK 7
#endif
    if (P0MASK & 2) {
        LAS float* scr = (LAS float*)(lds + wave * 16384);
        LAS float* scnd = (LAS float*)(lds + 131072);
        for (int i = tid; i < 3072; i += 512) { const int ci = i >> 10, k = i & 1023; scnd[i] = silu_f(ci == 0 ? a.in[I_CCTX][k] : a.in[I_C][(ci - 1) * D + k]); }
        __syncthreads();
        const int gw = vcu * 8 + wave, NGW = G * 8;
        constexpr int T_IN = 16 * 70, T_UQ = 6 * 24, T_UKV = 4 * 32, T_OUT = 16 * 32, T_FFI = 16 * 176, T_FFO = 44 * 32, T_ZERO = 64, T_ADA = 768;
        constexpr int NIT = T_ADA + T_IN + T_UQ + T_UKV + T_OUT + T_FFI + T_FFO + T_ZERO;
        for (int it = gw; it < NIT; it += NGW) {
            int r = it;
            if (r < T_ADA) {
                const int nbq = r >> 2, kq = r & 3; const int n0 = 32 * nbq; const float* W = a.in[I_WADA];
                const int n = lane & 31, hf = lane >> 5; float s0 = 0.f, s1 = 0.f, s2 = 0.f;
                for (int kb = 4 * kq; kb < 4 * kq + 4; ++kb) { const int k0 = 64 * kb;
#pragma unroll 8
                    for (int i = 0; i < 32; ++i) { const int kk = 2 * i + (lane >> 5); scr[kk * 33 + (lane & 31)] = W[(size_t)(k0 + kk) * 6144 + n0 + (lane & 31)]; }
                    LDS_WAIT();
#pragma unroll 8
                    for (int j = 0; j < 32; ++j) { const int kk = hf * 32 + j; const float w = scr[kk * 33 + n];
                        s0 += w * scnd[k0 + kk]; s1 += w * scnd[1024 + k0 + kk]; s2 += w * scnd[2048 + k0 + kk]; }
                    LDS_WAIT(); }
                s0 += __shfl_xor(s0, 32); s1 += __shfl_xor(s1, 32); s2 += __shfl_xor(s2, 32);
                float* MOD = (float*)(ws + WS_MOD) + (size_t)kq * 18432;
                if (hf == 0) { MOD[n0 + n] = s0; MOD[6144 + n0 + n] = s1; MOD[12288 + n0 + n] = s2; }
                continue; } r -= T_ADA;
            if (r < T_FFI) { const int kb = r / 176, nb = r % 176; const int n0 = nb * 32; const int drow = n0 < DFF ? (n0 / 128) * 256 + (n0 % 128) : ((n0 - DFF) / 128) * 256 + 128 + ((n0 - DFF) % 128);
                p0_tr(a.in[I_WFFI], 1024, 5632, (bf16_t*)(ws + WS_WFFI), nullptr, nullptr, kb, nb, drow - n0, scr, lane); continue; } r -= T_FFI;
            if (r < T_FFO) { p0_tr(a.in[I_WFFO], DFF, 1024, (bf16_t*)(ws + WS_WFFO), nullptr, nullptr, r / 32, r % 32, 0, scr, lane); continue; } r -= T_FFO;
            if (r < T_IN) { p0_tr(a.in[I_WIN], 1024, 2240, (bf16_t*)(ws + WS_WIN), nullptr, nullptr, r / 70, r % 70, 0, scr, lane); continue; } r -= T_IN;
            if (r < T_OUT) { p0_tr(a.in[I_WOUT], 1024, 1024, (bf16_t*)(ws + WS_WOUT), nullptr, nullptr, r / 32, r % 32, 0, scr, lane); continue; } r -= T_OUT;
            if (r < T_UQ) { p0_tr(a.in[I_WUQ], 384, 768, (bf16_t*)(ws + WS_WUQ), nullptr, a.in[I_QN], r / 24, r % 24, 0, scr, lane); continue; } r -= T_UQ;
            if (r < T_UKV) { const int nb = r % 32, n0 = nb * 32, hh = n0 >> 7, j0 = n0 & 127; const bool isv = j0 >= 64; const int drow = hh * 64 + (j0 & 63);
                p0_tr(a.in[I_WUKV], 256, 1024, (bf16_t*)(ws + (isv ? WS_WVF : WS_WKF)), (bf16_t*)(ws + (isv ? WS_WVU : WS_WKU)), a.in[I_KVN], r / 32, nb, drow - n0, scr, lane); continue; } r -= T_UKV;
            { u32x4 z = {0u, 0u, 0u, 0u}; u32x4* p = (u32x4*)((bf16_t*)(ws + WS_WIN) + (size_t)(2240 + r) * 1024); p[lane] = z; p[64 + lane] = z; }
        }
    }
    if (P0MASK & 4) {
        const int gt = vcu * 512 + tid, NT = G * 512;
        for (int i = gt; i < 32768; i += NT) { const f32x4 v = ((const f32x4*)a.in[I_CKV])[i]; u32x2 w; w.x = cvt_pk_bf16(v[0], v[1]); w.y = cvt_pk_bf16(v[2], v[3]); ((u32x2*)(ws + WS_CACHEB))[i] = w; }
    }
}

__device__ __forceinline__ f32x4 mod4(const float* modp, const float* bias, int ci, int off) {
    const float* p = modp + ci * 6144 + off;
    return ((*(const f32x4*)p + *(const f32x4*)(p + 18432)) + (*(const f32x4*)(p + 36864) + *(const f32x4*)(p + 55296))) + *(const f32x4*)(bias + off);
}
__device__ __forceinline__ void phase1(const Args& a, int wv, int vcu, int G) {
    if (PROBE_FILL == 3) { float* m = (float*)(a.ws + WS_MOD); for (int i = otid(wv); i < 3 * 6144; i += 512) { unsigned h = (unsigned)i * 2654435761u; h ^= h >> 15; h *= 2246822519u; h ^= h >> 13; m[i] = ((float)(h & 0xffff) * (1.f / 65536.f) - 0.5f) * 2.f; } __syncthreads(); }
    const int tid_ = otid(wv); const int lane = tid_ & 63, wave = tid_ >> 6; const int gw = vcu * 8 + wave, NGW = G * 8;
    const float* mod = (const float*)(a.ws + WS_MOD + PROBE_MODOFF); bf16_t* H = (bf16_t*)(a.ws + WS_H);
    for (int r = gw; r < MTOK; r += NGW * PROBE_RSTRIDE) {
        const f32x4* xr = (const f32x4*)xrow_ptr(a, r) + lane; const int ci_ = cond_of_row(r);
        f32x4 v[4]; float s = 0.f;
#pragma unroll
        for (int j = 0; j < 4; ++j) { v[j] = xr[64 * j]; s += (v[j][0] * v[j][0] + v[j][1] * v[j][1]) + (v[j][2] * v[j][2] + v[j][3] * v[j][3]); }
        const float rstd = rsqrtf(wave_sum(s) * (1.f / D) + EPS);
        u32x2* o = (u32x2*)(H + (size_t)r * D) + lane;
#pragma unroll
        for (int j = 0; j < 4; ++j) { const int c = 4 * lane + 256 * j; const f32x4 w = *(const f32x4*)(a.in[I_NATT] + c), sh = mod4(mod, a.in[I_BADA], ci_, c), scv = mod4(mod, a.in[I_BADA], ci_, 1024 + c);
            const f32x4 y = v[j] * rstd * w * (scv * PROBE_MUL + 1.f) + sh * PROBE_MUL; u32x2 p; p.x = cvt_pk_bf16(y[0], y[1]); p.y = cvt_pk_bf16(y[2], y[3]); if (PROBE_NOSTORE) { if ((p.x ^ p.y) == 0x12345u) o[64 * j] = p; } else o[64 * j] = p; }
    }
}
__device__ __forceinline__ void phase6(const Args& a, int wv, int vcu, int G) {
    const int tid_ = otid(wv); const int lane = tid_ & 63, wave = tid_ >> 6; const int gw = vcu * 8 + wave, NGW = G * 8;
    const float* mod = (const float*)(a.ws + WS_MOD); bf16_t* H = (bf16_t*)(a.ws + WS_H); float* X1 = (float*)(a.ws + WS_X1);
    const bf16_t* P0 = (const bf16_t*)(a.ws + WS_P0); const bf16_t* P1 = (const bf16_t*)(a.ws + WS_P1A);
    for (int r = gw; r < MTOK; r += NGW) {
        const f32x4* xr = (const f32x4*)xrow_ptr(a, r) + lane; const int ci_ = cond_of_row(r);
        const u32x2* p0 = (const u32x2*)(P0 + (size_t)r * D) + lane; const u32x2* p1 = (const u32x2*)(P1 + (size_t)r * D) + lane;
        f32x4 v[4]; float s = 0.f;
#pragma unroll
        for (int j = 0; j < 4; ++j) { const int c = 4 * lane + 256 * j; const f32x4 gt = mod4(mod, a.in[I_BADA], ci_, 2048 + c);
            { const u32x2 qa = p0[64 * j], qb = p1[64 * j]; const f32x4 ps = {bflo(qa.x) + bflo(qb.x), bfhi(qa.x) + bfhi(qb.x), bflo(qa.y) + bflo(qb.y), bfhi(qa.y) + bfhi(qb.y)}; v[j] = xr[64 * j] + gt * ps; } s += (v[j][0] * v[j][0] + v[j][1] * v[j][1]) + (v[j][2] * v[j][2] + v[j][3] * v[j][3]); }
        const float rstd = rsqrtf(wave_sum(s) * (1.f / D) + EPS);
        f32x4* x1 = (f32x4*)(X1 + (size_t)r * D) + lane; u32x2* o = (u32x2*)(H + (size_t)r * D) + lane;
#pragma unroll
        for (int j = 0; j < 4; ++j) { const int c = 4 * lane + 256 * j; x1[64 * j] = v[j];
            const f32x4 w = *(const f32x4*)(a.in[I_NFFN] + c), sh = mod4(mod, a.in[I_BADA], ci_, 3072 + c), scv = mod4(mod, a.in[I_BADA], ci_, 4096 + c);
            const f32x4 y = v[j] * rstd * w * (scv + 1.f) + sh; u32x2 p; p.x = cvt_pk_bf16(y[0], y[1]); p.y = cvt_pk_bf16(y[2], y[3]); o[64 * j] = p; }
    }
}
__device__ __forceinline__ void phase9(const Args& a, int wv, int vcu, int G) {
    const int tid_ = otid(wv); const int lane = tid_ & 63, wave = tid_ >> 6; const int gw = vcu * 8 + wave, NGW = G * 8;
    const float* mod = (const float*)(a.ws + WS_MOD); const float* X1 = (const float*)(a.ws + WS_X1);
    const bf16_t* P0 = (const bf16_t*)(a.ws + WS_P0); const bf16_t* P1 = (const bf16_t*)(a.ws + WS_P1B);
    for (int r = gw; r < MTOK; r += NGW) {
        const f32x4* xr = (const f32x4*)(X1 + (size_t)r * D) + lane; const int ci_ = cond_of_row(r);
        const u32x2* p0 = (const u32x2*)(P0 + (size_t)r * D) + lane; const u32x2* p1 = (const u32x2*)(P1 + (size_t)r * D) + lane;
        f32x4 v[4]; float s = 0.f;
#pragma unroll
        for (int j = 0; j < 4; ++j) { const int c = 4 * lane + 256 * j; const f32x4 gt = mod4(mod, a.in[I_BADA], ci_, 5120 + c);
            { const u32x2 qa = p0[64 * j], qb = p1[64 * j]; const f32x4 ps = {bflo(qa.x) + bflo(qb.x), bfhi(qa.x) + bfhi(qb.x), bflo(qa.y) + bflo(qb.y), bfhi(qa.y) + bfhi(qb.y)}; v[j] = xr[64 * j] + gt * ps; } s += (v[j][0] * v[j][0] + v[j][1] * v[j][1]) + (v[j][2] * v[j][2] + v[j][3] * v[j][3]); }
        const float rstd = rsqrtf(wave_sum(s) * (1.f / D) + EPS);
        f32x4* y = (f32x4*)(a.out + O_Y + (size_t)r * D) + lane;
#pragma unroll
        for (int j = 0; j < 4; ++j) { const int c = 4 * lane + 256 * j; const f32x4 w = *(const f32x4*)(a.in[I_FN] + c); y[64 * j] = v[j] * rstd * w; }
    }
}

__device__ __forceinline__ void p3_row_extras(const Args& a, int wv, int gw, int NGW) {
    const int lane = otid(wv) & 63;
    const bf16_t* Z = (const bf16_t*)(a.ws + WS_Z); const float* rsskv = (const float*)(a.ws + WS_RSSKV);
    bf16_t* Kp = (bf16_t*)(a.ws + WS_KP); bf16_t* Ks = (bf16_t*)(a.ws + WS_KS);
    const float inv[8] = {1.f, 0.316227766f, 0.1f, 0.0316227766f, 0.01f, 0.00316227766f, 0.001f, 0.000316227766f};
    for (int r = gw; r < MTOK + 512; r += NGW) {
        if (r < MTOK) {
            const bf16_t* zr = Z + (size_t)r * ZP;
            if (r < MP) {
                const float rs = rsqrtf(pg8::rss_kv(rsskv, r) * (1.f / 256.f) + EPS);
                const u32x2 w = *(const u32x2*)(zr + C_KVLAT + 4 * lane); const f32x4 g = *(const f32x4*)(a.in[I_KVN] + 4 * lane);
                f32x4 o; o[0] = bflo(w.x) * rs * g[0]; o[1] = bfhi(w.x) * rs * g[1]; o[2] = bflo(w.y) * rs * g[2]; o[3] = bfhi(w.y) * rs * g[3];
                *(f32x4*)(a.out + O_KV + (size_t)r * 256 + 4 * lane) = o;
            }
            const int i = lane & 31;
            float v = bf2f(zr[C_KROPE + i]);
            if (r < MP && lane < 32) a.out[O_KR + (size_t)r * 32 + i] = v;
            const float pv = __shfl_xor(v, 8);
            int b, s; bf16_t* kb;
            if (r >= MP) { const int t = (r - MP) & 2047; const float pos = (float)((i < 16) ? (t >> 6) : (t & 63));
                const float rev = pos * inv[i & 7] * 0.15915494309189535f; const float rf = rev - floorf(rev);
                const float cs = __builtin_amdgcn_cosf(rf), sn = __builtin_amdgcn_sinf(rf); v = v * cs + ((i & 8) ? pv : -pv) * sn;
                b = (r - MP) >> 11; s = 256 + t; kb = Ks + ((size_t)(b * 8) * SKS + s) * 96 + 64 + i;
                const bf16_t o = f2bf(v);
                if (lane < 32) { for (int h = 0; h < 8; ++h) kb[(size_t)h * SKS * 96] = o; }
            } else { b = r >> 8; s = r & 255; kb = Kp + ((size_t)(b * 8) * 256 + s) * 96 + 64 + i; const bf16_t o = f2bf(v);
                if (lane < 32) { for (int h = 0; h < 8; ++h) kb[(size_t)h * 256 * 96] = o; } }
        } else {
            const int rr = r - MTOK, b = rr >> 8, s = rr & 255, i = lane & 31;
            const bf16_t o = f2bf(a.in[I_CKR][(size_t)rr * 32 + i]); bf16_t* kb = Ks + ((size_t)(b * 8) * SKS + s) * 96 + 64 + i;
            if (lane < 32) { for (int h = 0; h < 8; ++h) kb[(size_t)h * SKS * 96] = o; }
        }
    }
}

constexpr int GL_LOW = 0, GL_WG = 8192, GL_BG = 16384, GL_SEG = 16896, GL_RED = 20992, GL_VT = 22528, GL_QF = 40960, GL_KF = GL_QF + 9216, GL_QB = GL_KF + 9216, GL_KB = GL_QB + 9216;
constexpr int GROW = 144;

__device__ __forceinline__ void gla_gates(const Args& a, int wv, LAS unsigned char* lds, int r0, int h, float (&cumF)[8], float (&cumB)[8], float& totF, float& totB) {
    const int tid = otid(wv), d = tid & 63, tg = tid >> 6;
    const bf16_t* Z = (const bf16_t*)(a.ws + WS_Z);
    LAS float* low = (LAS float*)(lds + GL_LOW); LAS float* wg = (LAS float*)(lds + GL_WG); LAS float* bg = (LAS float*)(lds + GL_BG); LAS float* seg = (LAS float*)(lds + GL_SEG);
    { const int t = tid >> 3, r4 = (tid & 7) * 4; const u32x2 w = *(const u32x2*)(Z + (size_t)(r0 + t) * ZP + C_GFL + r4);
      low[t * 32 + r4] = bflo(w.x); low[t * 32 + r4 + 1] = bfhi(w.x); low[t * 32 + r4 + 2] = bflo(w.y); low[t * 32 + r4 + 3] = bfhi(w.y); }
    { const int dir = tid >> 8, r = (tid >> 4) & 15, d4 = (tid & 15) * 4; const f32x4 w = *(const f32x4*)(a.in[dir ? I_WGB : I_WGF] + r * 256 + h * 64 + d4);
      *(LAS f32x4*)(wg + (dir * 16 + r) * 64 + d4) = w; }
    if (tid < 128) { const int dir = tid >> 6; bg[tid] = a.in[dir ? I_BGB : I_BGF][h * 64 + (tid & 63)]; }
    __syncthreads();
    float wf[16], wb[16];
#pragma unroll
    for (int r = 0; r < 16; ++r) { wf[r] = wg[r * 64 + d]; wb[r] = wg[(16 + r) * 64 + d]; }
    const float bf_ = bg[d], bb_ = bg[64 + d];
    float gf[8], gb[8];
#pragma unroll
    for (int i = 0; i < 8; ++i) { const int t = tg * 8 + i; float xf = bf_, xb = bb_;
#pragma unroll
        for (int r = 0; r < 16; ++r) { xf += low[t * 32 + r] * wf[r]; xb += low[t * 32 + 16 + r] * wb[r]; }
        gf[i] = logsigmoid_f(xf) * (1.f / 16.f); gb[i] = logsigmoid_f(xb) * (1.f / 16.f); }
#pragma unroll
    for (int i = 1; i < 8; ++i) gf[i] += gf[i - 1];
#pragma unroll
    for (int i = 6; i >= 0; --i) gb[i] += gb[i + 1];
    seg[tg * 64 + d] = gf[7]; seg[512 + tg * 64 + d] = gb[0];
    __syncthreads();
    float offF = 0.f, offB = 0.f; totF = 0.f; totB = 0.f;
#pragma unroll
    for (int g = 0; g < 8; ++g) { const float sf = seg[g * 64 + d], sb = seg[512 + g * 64 + d]; totF += sf; totB += sb; if (g < tg) offF += sf; if (g > tg) offB += sb; }
#pragma unroll
    for (int i = 0; i < 8; ++i) { cumF[i] = gf[i] + offF; cumB[i] = gb[i] + offB; }
}
__device__ __forceinline__ void gla_load_vT(const Args& a, int wv, LAS unsigned char* lds, int r0, int h) {
    const int tid = otid(wv), e = tid & 127, tq = tid >> 7;
    const bf16_t* Z = (const bf16_t*)(a.ws + WS_Z) + (size_t)r0 * ZP + C_GV + h * 128 + e;
    unsigned w[8];
#pragma unroll
    for (int i = 0; i < 8; ++i) { const unsigned lo = Z[(size_t)(tq * 16 + 2 * i) * ZP], hi = Z[(size_t)(tq * 16 + 2 * i + 1) * ZP]; w[i] = lo | (hi << 16); }
    LAS u32x4* p = (LAS u32x4*)(lds + GL_VT + e * GROW + tq * 32);
    p[0] = (u32x4){w[0], w[1], w[2], w[3]}; p[1] = (u32x4){w[4], w[5], w[6], w[7]};
}

__device__ __forceinline__ void gla_stepA(const Args& a, int wv, LAS unsigned char* lds, int u) {
    const int tid = otid(wv), lane = tid & 63, wave = __builtin_amdgcn_readfirstlane(tid >> 6), d = tid & 63, tg = tid >> 6, fr = lane & 15, fq = lane >> 4;
    const int cgi = u >> 2, h = u & 3, r0 = cgi * 64;
    const bf16_t* Z = (const bf16_t*)(a.ws + WS_Z);
    float cumF[8], cumB[8], totF, totB;
    gla_gates(a, wv, lds, r0, h, cumF, cumB, totF, totB);
    unsigned kf[4], kb[4];
#pragma unroll
    for (int i = 0; i < 4; ++i) { const float k0 = bf2f(Z[(size_t)(r0 + tg * 8 + 2 * i) * ZP + C_GK + h * 64 + d]), k1 = bf2f(Z[(size_t)(r0 + tg * 8 + 2 * i + 1) * ZP + C_GK + h * 64 + d]);
        kf[i] = cvt_pk_bf16(k0 * __expf(totF - cumF[2 * i]), k1 * __expf(totF - cumF[2 * i + 1]));
        kb[i] = cvt_pk_bf16(k0 * __expf(totB - cumB[2 * i]), k1 * __expf(totB - cumB[2 * i + 1])); }
    *(LAS u32x4*)(lds + GL_QF + d * GROW + tg * 16) = (u32x4){kf[0], kf[1], kf[2], kf[3]};
    *(LAS u32x4*)(lds + GL_KF + d * GROW + tg * 16) = (u32x4){kb[0], kb[1], kb[2], kb[3]};
    gla_load_vT(a, wv, lds, r0, h);
    if (tg == 0) { float* dec = (float*)(a.ws + WS_DEC) + (size_t)u * 128; dec[d] = __expf(totF); dec[64 + d] = __expf(totB); }
    __syncthreads();
    const int dir = wave >> 2, eb0 = 2 * (wave & 3);
    const LAS unsigned char* kd = lds + (dir ? GL_KF : GL_QF);
    float* CT = (float*)(a.ws + WS_CT) + ((size_t)u * 2 + dir) * 8192;
#pragma unroll
    for (int eb = 0; eb < 2; ++eb) {
        bf16x8 vf[2];
#pragma unroll
        for (int ks = 0; ks < 2; ++ks) vf[ks] = *(const LAS bf16x8*)(lds + GL_VT + (16 * (eb0 + eb) + fr) * GROW + (32 * ks + 8 * fq) * 2);
#pragma unroll
        for (int db = 0; db < 4; ++db) { f32x4 c = {0.f, 0.f, 0.f, 0.f};
#pragma unroll
            for (int ks = 0; ks < 2; ++ks) { const bf16x8 kfr = *(const LAS bf16x8*)(kd + (16 * db + fr) * GROW + (32 * ks + 8 * fq) * 2); c = __builtin_amdgcn_mfma_f32_16x16x32_bf16(vf[ks], kfr, c, 0, 0, 0); }
#pragma unroll
            for (int j = 0; j < 4; ++j) CT[(16 * (eb0 + eb) + 4 * fq + j) * 64 + 16 * db + fr] = c[j]; }
    }
    __syncthreads();
}

__device__ __forceinline__ void gla_scan(const Args& a, int wv, int vcu, int G) {
    const int gt = vcu * 512 + otid(wv), NT = G * 512;
    float* CTb = (float*)(a.ws + WS_CT); const float* DEC = (const float*)(a.ws + WS_DEC);
    for (int it = gt; it < 32768 + 262144; it += NT) {
        int seq, N, cg0, x;
        if (it < 32768) { seq = 16 + (it >> 14); x = it & 16383; N = 32; cg0 = 64 + 32 * (seq - 16); } else { const int j = it - 32768; seq = j >> 14; x = j & 16383; N = 4; cg0 = 4 * seq; }
        const int h = x >> 12, dir = (x >> 11) & 1, e = (x >> 4) & 127, d4 = (x & 15) * 4;
        f32x4 st = {0.f, 0.f, 0.f, 0.f};
        if (seq >= 16) { const float* s0 = a.in[dir ? I_SB : I_SF] + ((size_t)((seq - 16) * 4 + h) * 64) * 128 + e;
#pragma unroll
            for (int i = 0; i < 4; ++i) st[i] = s0[(size_t)(d4 + i) * 128]; }
        for (int n0 = 0; n0 < N; n0 += 4) {
            f32x4 c[4], dc[4];
#pragma unroll
            for (int i = 0; i < 4; ++i) { const int n = dir ? (N - 1 - n0 - i) : (n0 + i); const int u = (cg0 + n) * 4 + h;
                c[i] = *(const f32x4*)(CTb + ((size_t)u * 2 + dir) * 8192 + e * 64 + d4); dc[i] = *(const f32x4*)(DEC + (size_t)u * 128 + dir * 64 + d4); }
#pragma unroll
            for (int i = 0; i < 4; ++i) { const int n = dir ? (N - 1 - n0 - i) : (n0 + i); const int u = (cg0 + n) * 4 + h;
                *(f32x4*)(CTb + ((size_t)u * 2 + dir) * 8192 + e * 64 + d4) = st; st = dc[i] * st + c[i]; }
        }
        if (seq < 16) { float* o = a.out + (dir ? O_SB : O_SF) + ((size_t)(seq * 4 + h) * 64) * 128 + e;
#pragma unroll
            for (int i = 0; i < 4; ++i) o[(size_t)(d4 + i) * 128] = st[i]; }
    }
}

__device__ __forceinline__ void gla_stepC(const Args& a, int wv, LAS unsigned char* lds, int u) {
    const int tid = otid(wv), lane = tid & 63, wave = __builtin_amdgcn_readfirstlane(tid >> 6), d = tid & 63, tg = tid >> 6, fr = lane & 15, fq = lane >> 4;
    const int cgi = u >> 2, h = u & 3, r0 = cgi * 64;
    const bf16_t* Z = (const bf16_t*)(a.ws + WS_Z);
    float cumF[8], cumB[8], totF, totB;
    gla_gates(a, wv, lds, r0, h, cumF, cumB, totF, totB);
#pragma unroll
    for (int i = 0; i < 8; ++i) { const int t = tg * 8 + i; const float q = bf2f(Z[(size_t)(r0 + t) * ZP + C_GQ + h * 64 + d]) * 0.125f, k = bf2f(Z[(size_t)(r0 + t) * ZP + C_GK + h * 64 + d]);
        *(LAS bf16_t*)(lds + GL_QF + t * GROW + d * 2) = f2bf(q * __expf(cumF[i]));
        *(LAS bf16_t*)(lds + GL_KF + t * GROW + d * 2) = f2bf(k * __expf(-cumF[i]));
        *(LAS bf16_t*)(lds + GL_QB + t * GROW + d * 2) = f2bf(q * __expf(cumB[i]));
        *(LAS bf16_t*)(lds + GL_KB + t * GROW + d * 2) = f2bf(k * __expf(-cumB[i])); }
    gla_load_vT(a, wv, lds, r0, h);
    __syncthreads();
    const int ch = wave & 1, eq = wave >> 1;
    f32x4 oT[2][2];
#pragma unroll
    for (int i = 0; i < 2; ++i)
#pragma unroll
        for (int j = 0; j < 2; ++j) oT[i][j] = (f32x4){0.f, 0.f, 0.f, 0.f};
#pragma unroll
    for (int dir = 0; dir < 2; ++dir) {
        const LAS unsigned char* qe = lds + (dir ? GL_QB : GL_QF); const LAS unsigned char* ke = lds + (dir ? GL_KB : GL_KF);
        const float* ST = (const float*)(a.ws + WS_CT) + ((size_t)u * 2 + dir) * 8192;
        bf16x8 sf[2][2];
#pragma unroll
        for (int eb = 0; eb < 2; ++eb)
#pragma unroll
            for (int ks = 0; ks < 2; ++ks) { const float* p = ST + (16 * (2 * eq + eb) + fr) * 64 + 32 * ks + 8 * fq; const f32x4 x0 = *(const f32x4*)p, x1 = *(const f32x4*)(p + 4);
                u32x4 w; w.x = cvt_pk_bf16(x0[0], x0[1]); w.y = cvt_pk_bf16(x0[2], x0[3]); w.z = cvt_pk_bf16(x1[0], x1[1]); w.w = cvt_pk_bf16(x1[2], x1[3]); sf[eb][ks] = __builtin_bit_cast(bf16x8, w); }
#pragma unroll
        for (int cb = 0; cb < 2; ++cb) {
            const int cbg = 2 * ch + cb;
            bf16x8 qf[2];
#pragma unroll
            for (int ks = 0; ks < 2; ++ks) qf[ks] = *(const LAS bf16x8*)(qe + (16 * cbg + fr) * GROW + (32 * ks + 8 * fq) * 2);
            f32x4 att[4];
#pragma unroll
            for (int sb = 0; sb < 4; ++sb) {
                f32x4 acc = {0.f, 0.f, 0.f, 0.f};
                const bool need = dir == 0 ? (sb <= cbg) : (sb >= cbg);
                if (need) {
#pragma unroll
                    for (int ks = 0; ks < 2; ++ks) { const bf16x8 kfr = *(const LAS bf16x8*)(ke + (16 * sb + fr) * GROW + (32 * ks + 8 * fq) * 2); acc = __builtin_amdgcn_mfma_f32_16x16x32_bf16(kfr, qf[ks], acc, 0, 0, 0); }
                    if (sb == cbg) {
#pragma unroll
                        for (int j = 0; j < 4; ++j) { const int sl = 4 * fq + j; const bool keep = dir == 0 ? (sl <= fr) : (sl >= fr); acc[j] = keep ? acc[j] : 0.f; } }
                }
                att[sb] = acc;
            }
#pragma unroll
            for (int kp = 0; kp < 2; ++kp) {
                u32x4 w; w.x = cvt_pk_bf16(att[2 * kp][0], att[2 * kp][1]); w.y = cvt_pk_bf16(att[2 * kp][2], att[2 * kp][3]); w.z = cvt_pk_bf16(att[2 * kp + 1][0], att[2 * kp + 1][1]); w.w = cvt_pk_bf16(att[2 * kp + 1][2], att[2 * kp + 1][3]);
                const bf16x8 pb = __builtin_bit_cast(bf16x8, w);
#pragma unroll
                for (int eb = 0; eb < 2; ++eb) { const LAS unsigned char* vp = lds + GL_VT + (16 * (2 * eq + eb) + fr) * GROW + (32 * kp + 4 * fq) * 2;
                    const u32x2 v0 = *(const LAS u32x2*)vp, v1 = *(const LAS u32x2*)(vp + 32); const u32x4 vv = {v0.x, v0.y, v1.x, v1.y};
                    oT[eb][cb] = __builtin_amdgcn_mfma_f32_16x16x32_bf16(__builtin_bit_cast(bf16x8, vv), pb, oT[eb][cb], 0, 0, 0); }
            }
#pragma unroll
            for (int ks = 0; ks < 2; ++ks)
#pragma unroll
                for (int eb = 0; eb < 2; ++eb) oT[eb][cb] = __builtin_amdgcn_mfma_f32_16x16x32_bf16(sf[eb][ks], qf[ks], oT[eb][cb], 0, 0, 0);
        }
    }
    LAS float* red = (LAS float*)(lds + GL_RED);
#pragma unroll
    for (int cb = 0; cb < 2; ++cb) { float s = 0.f;
#pragma unroll
        for (int eb = 0; eb < 2; ++eb)
#pragma unroll
            for (int j = 0; j < 4; ++j) s += oT[eb][cb][j] * oT[eb][cb][j];
        s += __shfl_xor(s, 16); s += __shfl_xor(s, 32);
        if (fq == 0) red[eq * 64 + 16 * (2 * ch + cb) + fr] = s; }
    __syncthreads();
    bf16_t* MIX = (bf16_t*)(a.ws + WS_MIX);
#pragma unroll
    for (int cb = 0; cb < 2; ++cb) { const int c = 16 * (2 * ch + cb) + fr; const float tot = red[c] + red[64 + c] + red[128 + c] + red[192 + c]; const float rstd = rsqrtf(tot * (1.f / 128.f) + EPS);
#pragma unroll
        for (int eb = 0; eb < 2; ++eb) { const int e = 16 * (2 * eq + eb) + 4 * fq; const f32x4 gn = *(const f32x4*)(a.in[I_GLAN] + e);
            const u32x2 gw = *(const u32x2*)(Z + (size_t)(r0 + c) * ZP + C_GOUT + h * 128 + e);
            const float g0 = bflo(gw.x), g1 = bfhi(gw.x), g2 = bflo(gw.y), g3 = bfhi(gw.y);
            const f32x4 o = oT[eb][cb] * rstd * gn; u32x2 w; w.x = cvt_pk_bf16(o[0] * silu_f(g0), o[1] * silu_f(g1)); w.y = cvt_pk_bf16(o[2] * silu_f(g2), o[3] * silu_f(g3));
            *(u32x2*)(MIX + (size_t)(r0 + c) * D + 512 + h * 128 + e) = w; } }
    __syncthreads();
}

constexpr int AT_KROW = 208, AT_VROW = 144, AT_KB = 64 * AT_KROW  , AT_STAGE = AT_KB + 64 * AT_VROW  ;
__device__ __forceinline__ void attn_unit(const Args& a, int wv, LAS unsigned char* lds, int idx) {
    const int tid = otid(wv), lane = tid & 63, wave = __builtin_amdgcn_readfirstlane(tid >> 6), fr = lane & 15, fq = lane >> 4;
    int row0, S, nt; const bf16_t* Kb; const bf16_t* Vb; int h;
    if (idx < 256) { const int b = idx >> 7, qb = idx & 15; h = (idx >> 4) & 7; row0 = MP + b * 2048 + qb * 128; S = SKS; nt = 36;
        Kb = (const bf16_t*)(a.ws + WS_KS) + (size_t)(b * 8 + h) * SKS * 96; Vb = (const bf16_t*)(a.ws + WS_VTS) + (size_t)(b * 8 + h) * 64 * SKS; }
    else { const int j = idx - 256; const int b = j >> 4, qb = j & 1; h = (j >> 1) & 7; row0 = b * 256 + qb * 128; S = 256; nt = 4;
        Kb = (const bf16_t*)(a.ws + WS_KP) + (size_t)(b * 8 + h) * 256 * 96; Vb = (const bf16_t*)(a.ws + WS_VTP) + (size_t)(b * 8 + h) * 64 * 256; }
    const char* src[3]; unsigned step[3]; unsigned dst[3]; bool valid[3];
#pragma unroll
    for (int j = 0; j < 3; ++j) { const int ins = wave + 8 * j; valid[j] = ins < 22;
        if (ins < 13) { const int ck = ins * 64 + lane, r = ck / 13, cc = ck % 13; src[j] = (const char*)Kb + (size_t)r * 192 + (cc < 12 ? cc : 11) * 16; step[j] = 64 * 192; dst[j] = ins * 1024; }
        else { const int cv = (ins - 13) * 64 + lane, r = cv / 9, cc = cv % 9; src[j] = (const char*)Vb + (size_t)r * S * 2 + (cc < 8 ? cc : 7) * 16; step[j] = 128; dst[j] = AT_KB + (ins - 13) * 1024; } }
#define AT_ISSUE(t, buf) do { _Pragma("unroll") for (int j = 0; j < 3; ++j) if (valid[j]) \
        __builtin_amdgcn_global_load_lds((const unsigned*)(src[j] + (size_t)(t) * step[j]), (LAS unsigned*)(lds + (buf) * AT_STAGE + dst[j]), 16, 0, 0); } while (0)
    AT_ISSUE(0, 0);
    const bf16_t* Q = (const bf16_t*)(a.ws + WS_Q) + (size_t)(row0 + wave * 16 + fr) * 768 + h * 96 + 8 * fq;
    bf16x8 qf[3];
#pragma unroll
    for (int ks = 0; ks < 3; ++ks) qf[ks] = *(const bf16x8*)(Q + 32 * ks);
    float mrun = -1e30f, lsum = 0.f;
    f32x4 o[4];
#pragma unroll
    for (int i = 0; i < 4; ++i) o[i] = (f32x4){0.f, 0.f, 0.f, 0.f};
    for (int t = 0; t < nt; ++t) {
        VM_WAIT(); __syncthreads();
        if (t + 1 < nt) AT_ISSUE(t + 1, (t + 1) & 1);
        const LAS unsigned char* kt = lds + (t & 1) * AT_STAGE; const LAS unsigned char* vt = kt + AT_KB;
        f32x4 s[4];
#pragma unroll
        for (int kb = 0; kb < 4; ++kb) { s[kb] = (f32x4){0.f, 0.f, 0.f, 0.f};
#pragma unroll
            for (int ks = 0; ks < 3; ++ks) { const bf16x8 kf = *(const LAS bf16x8*)(kt + (16 * kb + fr) * AT_KROW + (32 * ks + 8 * fq) * 2); s[kb] = __builtin_amdgcn_mfma_f32_16x16x32_bf16(kf, qf[ks], s[kb], 0, 0, 0); } }
        float mx = fmaxf(fmaxf(fmaxf(s[0][0], s[0][1]), fmaxf(s[0][2], s[0][3])), fmaxf(fmaxf(s[1][0], s[1][1]), fmaxf(s[1][2], s[1][3])));
        mx = fmaxf(mx, fmaxf(fmaxf(fmaxf(s[2][0], s[2][1]), fmaxf(s[2][2], s[2][3])), fmaxf(fmaxf(s[3][0], s[3][1]), fmaxf(s[3][2], s[3][3]))));
        mx = fmaxf(mx, __shfl_xor(mx, 16)); mx = fmaxf(mx, __shfl_xor(mx, 32));
        const float mnew = fmaxf(mrun, mx); const float alpha = __builtin_amdgcn_exp2f(mrun - mnew); mrun = mnew;
        float ps = 0.f;
#pragma unroll
        for (int kb = 0; kb < 4; ++kb)
#pragma unroll
            for (int j = 0; j < 4; ++j) { s[kb][j] = __builtin_amdgcn_exp2f(s[kb][j] - mnew); ps += s[kb][j]; }
        lsum = lsum * alpha + ps;
#pragma unroll
        for (int i = 0; i < 4; ++i) o[i] = o[i] * alpha;
#pragma unroll
        for (int kp = 0; kp < 2; ++kp) {
            u32x4 w; w.x = cvt_pk_bf16(s[2 * kp][0], s[2 * kp][1]); w.y = cvt_pk_bf16(s[2 * kp][2], s[2 * kp][3]); w.z = cvt_pk_bf16(s[2 * kp + 1][0], s[2 * kp + 1][1]); w.w = cvt_pk_bf16(s[2 * kp + 1][2], s[2 * kp + 1][3]);
            const bf16x8 pb = __builtin_bit_cast(bf16x8, w);
#pragma unroll
            for (int mb = 0; mb < 4; ++mb) { const LAS unsigned char* vp = vt + (16 * mb + fr) * AT_VROW + (32 * kp + 4 * fq) * 2;
                const u32x2 v0 = *(const LAS u32x2*)vp, v1 = *(const LAS u32x2*)(vp + 32); const u32x4 vv = {v0.x, v0.y, v1.x, v1.y};
                o[mb] = __builtin_amdgcn_mfma_f32_16x16x32_bf16(__builtin_bit_cast(bf16x8, vv), pb, o[mb], 0, 0, 0); }
        }
    }
    lsum += __shfl_xor(lsum, 16); lsum += __shfl_xor(lsum, 32);
    const float il = fast_rcp(lsum);
    bf16_t* MIX = (bf16_t*)(a.ws + WS_MIX) + (size_t)(row0 + wave * 16 + fr) * D + h * 64 + 4 * fq;
#pragma unroll
    for (int mb = 0; mb < 4; ++mb) { u32x2 w; w.x = cvt_pk_bf16(o[mb][0] * il, o[mb][1] * il); w.y = cvt_pk_bf16(o[mb][2] * il, o[mb][3] * il); *(u32x2*)(MIX + 16 * mb) = w; }
    __syncthreads();
#undef AT_ISSUE
}

__device__ unsigned g_bar[64 * 52];
#define GB(i) (g_bar + 64 * (i))
__device__ __forceinline__ unsigned gb_ld(unsigned* p) { return __hip_atomic_load(p, __ATOMIC_RELAXED, __HIP_MEMORY_SCOPE_AGENT); }
__device__ __forceinline__ unsigned gb_add(unsigned* p, unsigned v) { return __hip_atomic_fetch_add(p, v, __ATOMIC_RELAXED, __HIP_MEMORY_SCOPE_AGENT); }
__device__ __forceinline__ unsigned xcc_id() { return (unsigned)__builtin_amdgcn_s_getreg((3 << 11) | 20) & 0xFu; }
__device__ __forceinline__ void my_grid_barrier(unsigned nth, unsigned G, int tid, LAS unsigned* st) {
    asm volatile("s_waitcnt vmcnt(0) lgkmcnt(0)" ::: "memory");
    __syncthreads();
    if (tid == 0) {
        if (nth == 1u) {
            const unsigned x = xcc_id(); unsigned sum, cnt, mine;
            for (;;) { sum = 0u; cnt = 0u; mine = 0u;
#pragma unroll
                for (unsigned j = 0; j < 16; ++j) { const unsigned c = gb_ld(GB(4 + j)); sum += c; cnt += (c > 0u) ? 1u : 0u; mine = (j == x) ? c : mine; }
                if (sum >= G) break; __builtin_amdgcn_s_sleep(1); }
            st[0] = mine; st[1] = cnt; st[2] = x;
        }
        const unsigned nloc = st[0], nx = st[1], x = st[2];
        const unsigned old = gb_add(GB(20 + x), 1u);
        if (old + 1u == nth * nloc) {
            __builtin_amdgcn_fence(__ATOMIC_RELEASE, "agent");
            asm volatile("s_waitcnt vmcnt(0)" ::: "memory");
            const unsigned og = gb_add(GB(1), 1u);
            if (og + 1u == nth * nx) gb_add(GB(2), 1u);
            else while (gb_ld(GB(2)) < nth) __builtin_amdgcn_s_sleep(1);
            __builtin_amdgcn_fence(__ATOMIC_ACQUIRE, "agent");
            gb_add(GB(36 + x), 1u);
            asm volatile("s_waitcnt vmcnt(0)" ::: "memory");
        } else {
            while (gb_ld(GB(36 + x)) < nth) __builtin_amdgcn_s_sleep(1);
            __builtin_amdgcn_fence(__ATOMIC_ACQUIRE, "agent");
            asm volatile("s_waitcnt vmcnt(0)" ::: "memory");
        }
    }
    __syncthreads();
}
__device__ __forceinline__ void my_grid_barrier_finish(unsigned G, int tid) {
    if (tid == 0) {
        const unsigned old = gb_add(GB(0), 1u);
        if (old == G - 1u) { for (int i = 0; i < 52; ++i) __hip_atomic_store(GB(i), 0u, __ATOMIC_RELAXED, __HIP_MEMORY_SCOPE_AGENT); }
    }
}
constexpr int NPHASE = 11;
__global__ void __launch_bounds__(512, 2) mk_fwd(Args a) {
    const int wv = __builtin_amdgcn_readfirstlane((int)threadIdx.x >> 6);
    extern __shared__ __attribute__((aligned(16))) unsigned char lds_raw[];
    LAS unsigned char* lds = (LAS unsigned char*)lds_raw;
    const int G = gridDim.x, bx = blockIdx.x;
    const int vcu = (G % 8 == 0) ? (bx % 8) * (G / 8) + bx / 8 : bx;
    unsigned char* ws = a.ws;
    const int lo = a.ph_lo, hi = a.ph_hi;
#ifndef PHMASK
#define PHMASK 0x7ff
#endif
#define IN(k) (((PHMASK >> (k)) & 1) && lo <= (k) && (k) < hi)
#define SEAM(k) do { if (IN(k) && IN((k) + 1)) { ++nbar; my_grid_barrier(nbar, (unsigned)G, otid(wv), (LAS unsigned*)(lds + LDS_BYTES - 64)); } } while (0)
#ifndef PROBE_FILL
#define PROBE_FILL 0
#endif
    if (PROBE_FILL && lo == 0) { f32x4* p = (f32x4*)a.ws; const size_t n = (size_t)(PROBE_FILL_MIB) << 16; const float fv = PROBE_FILL_VAL;
        for (size_t i = (size_t)bx * 512 + threadIdx.x; i < n; i += (size_t)G * 512) { unsigned h = (unsigned)i * 2654435761u; h ^= h >> 15; h *= 2246822519u; h ^= h >> 13; const float r0 = (float)(h & 0xffff) * (1.f / 65536.f) - 0.5f + fv * 0.f; p[i] = (f32x4){r0, r0 * 1.7f, r0 * -0.3f, r0 + 0.1f}; } }
    if (PROBE_FILL == 2 && lo == 0 && bx == 0) { static const int szs[26] = {4194304, 4194304, 131072, 16384, 65536, 65536, 2048, 1024, 6291456, 6144, 1024, 2293760, 384, 294912, 256, 262144, 4096, 256, 4096, 256, 128, 1048576, 1024, 5767168, 2883584, 1024};
        float sm = 0.f; for (int i = 0; i < 26; ++i) { const int n = szs[i]; const int st = n > 1024 ? n - 1024 : 0; for (int j = st + (int)threadIdx.x; j < n; j += 512) sm += a.in[i][j]; for (int j = threadIdx.x; j < (n < 1024 ? n : 1024); j += 512) sm += a.in[i][j]; }
        ((float*)(a.ws))[threadIdx.x] = sm; }
    if (PROBE_FILL == 5 && lo == 0) { volatile float* p = (volatile float*)a.ws; const float big = p[0] * 0.f + 1e38f, tiny = p[1] * 0.f + 1e-38f, zero = p[2] * 0.f, neg = p[3] * 0.f - 1.f;
        float r = 0.f;
#if PROBE_EXC & 1
        r += big * big;
#endif
#if PROBE_EXC & 2
        r += tiny * tiny;
#endif
#if PROBE_EXC & 4
        r += 1.f / zero;
#endif
#if PROBE_EXC & 8
        r += __builtin_sqrtf(neg);
#endif
        p[4 + bx] = r; }
    unsigned nbar = 0;
    if (otid(wv) == 0) gb_add(GB(4 + xcc_id()), 1u);
    if (IN(0)) { for (int rep = 0; rep < PROBE_P0_REP; ++rep) { phase0(a, wv, lds, vcu, G); __syncthreads(); } } SEAM(0);
    if (IN(1)) { for (int rep = 0; rep < PROBE_ROW_REP; ++rep) phase1(a, wv, vcu, G); } SEAM(1);
    if (PROBE_HANG && lo == 1) { volatile unsigned* q = (volatile unsigned*)(a.ws + 8); while (*q != 0x12345678u) __builtin_amdgcn_s_sleep(20); }
    if (IN(2)) {
        pg8::Gemm g{(const bf16_t*)(ws + WS_H), (const bf16_t*)(ws + WS_WIN), D, D, D, wv}; pg8::Order S; S.init(MTOK, 2048, 1, G, bx);
        pg8::EpiZ E{(bf16_t*)(ws + WS_Z), (float*)(ws + WS_RSSQ), (float*)(ws + WS_RSSKV), 0};
        pg8::gemm_phase<pg8::EpiZ, pg8::Order>(lds, g, S, E);
    } SEAM(2);
    if (IN(3)) {
#ifndef P3MASK
#define P3MASK 0x3f
#endif
#if (P3MASK >> 0) & 1
        { pg8::Gemm g{(const bf16_t*)(ws + WS_Z) + C_QLAT, (const bf16_t*)(ws + WS_WUQ), ZP, 384, 384, wv}; pg8::Order S; S.init(MTOK, 768, 1, G, bx);
          pg8::EpiQ E{(bf16_t*)(ws + WS_Q), (const float*)(ws + WS_RSSQ)}; pg8::gemm_phase<pg8::EpiQ, pg8::Order>(lds, g, S, E); }
#endif
#if (P3MASK >> 1) & 1
        { pg8::Gemm g{(const bf16_t*)(ws + WS_Z) + C_KVLAT, (const bf16_t*)(ws + WS_WKF), ZP, 256, 256, wv}; pg8::Order S; S.init(MTOK, 512, 1, G, (bx + G - 96) % G);
          pg8::EpiK E{(bf16_t*)(ws + WS_KP), (bf16_t*)(ws + WS_KS), (const float*)(ws + WS_RSSKV), 0}; pg8::gemm_phase<pg8::EpiK, pg8::Order>(lds, g, S, E); }
#endif
#if (P3MASK >> 2) & 1
        { pg8::Gemm g{(const bf16_t*)(ws + WS_WVF), (const bf16_t*)(ws + WS_Z) + C_KVLAT, 256, ZP, 256, wv}; pg8::Order S; S.init(512, MTOK, 1, G, (bx + G - 160) % G);
          pg8::EpiVt E{(bf16_t*)(ws + WS_VTP), (bf16_t*)(ws + WS_VTS), (const float*)(ws + WS_RSSKV), 0}; pg8::gemm_phase<pg8::EpiVt, pg8::Order>(lds, g, S, E); }
#endif
        { pg8::Gemm g{(const bf16_t*)(ws + WS_H), (const bf16_t*)(ws + WS_WIN) + (size_t)2048 * D, D, D, D, wv}; pg8::Order S; S.init(MTOK, 256, 1, G, (bx + G - 224) % G);
          pg8::EpiZ E{(bf16_t*)(ws + WS_Z), (float*)(ws + WS_RSSQ), (float*)(ws + WS_RSSKV), 8}; pg8::gemm_phase<pg8::EpiZ, pg8::Order>(lds, g, S, E); }
#if (P3MASK >> 3) & 1
        { pg8::Gemm g{(const bf16_t*)(ws + WS_CACHEB), (const bf16_t*)(ws + WS_WKU), 256, 256, 256, wv}; pg8::Order S; S.init(512, 512, 1, G, (bx + G - 224) % G);
          pg8::EpiK E{(bf16_t*)(ws + WS_KP), (bf16_t*)(ws + WS_KS), (const float*)(ws + WS_RSSKV), 1}; pg8::gemm_phase<pg8::EpiK, pg8::Order>(lds, g, S, E); }
#endif
#if (P3MASK >> 4) & 1
        { pg8::Gemm g{(const bf16_t*)(ws + WS_WVU), (const bf16_t*)(ws + WS_CACHEB), 256, 256, 256, wv}; pg8::Order S; S.init(512, 512, 1, G, (bx + G - 228) % G);
          pg8::EpiVt E{(bf16_t*)(ws + WS_VTP), (bf16_t*)(ws + WS_VTS), (const float*)(ws + WS_RSSKV), 1}; pg8::gemm_phase<pg8::EpiVt, pg8::Order>(lds, g, S, E); }
#endif
        __syncthreads();
        const int c2 = (bx + G - 232) % G;
#if (P3MASK >> 5) & 1
        for (int rep = 0; rep < PROBE_P3_REP; ++rep) for (int u = c2; u < 512; u += G) gla_stepA(a, wv, lds, u);
#endif
        for (int rep = 0; rep < PROBE_P3_REP; ++rep) p3_row_extras(a, wv, c2 * 8 + (otid(wv) >> 6), G * 8);
    } SEAM(3);
    if (IN(4)) { gla_scan(a, wv, vcu, G); } SEAM(4);
    if (IN(5)) {
        for (int rep = 0; rep < PROBE_ATT_REP; ++rep) for (int u = vcu; u < 512; u += G) attn_unit(a, wv, lds, u);
        for (int rep = 0; rep < PROBE_GLAC_REP; ++rep) for (int u = vcu; u < 512; u += G) gla_stepC(a, wv, lds, u);
    } SEAM(5);
    if (IN(6)) {
        pg8::Gemm g{(const bf16_t*)(ws + WS_MIX), (const bf16_t*)(ws + WS_WOUT), D, D, PROBE_K6, wv}; pg8::Order S; S.init(MTOK, D, 1024 / PROBE_K6, G, bx);
        pg8::EpiPart E{(bf16_t*)(ws + WS_P0), (bf16_t*)(ws + WS_P1A)}; pg8::gemm_phase<pg8::EpiPart, pg8::Order>(lds, g, S, E);
    } SEAM(6);
    if (IN(7)) { for (int rep = 0; rep < PROBE_ROW_REP; ++rep) phase6(a, wv, vcu, G); } SEAM(7);
    if (IN(8)) {
        pg8::Gemm g{(const bf16_t*)(ws + WS_H), (const bf16_t*)(ws + WS_WFFI), D, D, D, wv}; pg8::Order S; S.init(MTOK, 2 * DFF, 1, G, bx);
        pg8::EpiFFI E{(bf16_t*)(ws + WS_HFF)}; for (int rep = 0; rep < PROBE_FFI_REP; ++rep) pg8::gemm_phase<pg8::EpiFFI, pg8::Order>(lds, g, S, E);
    } SEAM(8);
    if (IN(9)) {
        pg8::Gemm g{(const bf16_t*)(ws + WS_HFF), (const bf16_t*)(ws + WS_WFFO), DFF, DFF, DFF / 2, wv}; pg8::Order S; S.init(MTOK, D, 2, G, bx);
        pg8::EpiPart E{(bf16_t*)(ws + WS_P0), (bf16_t*)(ws + WS_P1B)}; pg8::gemm_phase<pg8::EpiPart, pg8::Order>(lds, g, S, E);
    } SEAM(9);
    if (IN(10)) { for (int rep = 0; rep < PROBE_ROW_REP; ++rep) phase9(a, wv, vcu, G); }
    if (PROBE_DUMP) {
        if (PROBE_DUMP != 5 && PROBE_DUMP != 7) { ++nbar; } if (PROBE_DUMP != 5 && PROBE_DUMP != 7) my_grid_barrier(nbar, (unsigned)G, otid(wv), (LAS unsigned*)(lds + LDS_BYTES - 64));
        const bf16_t* src = (const bf16_t*)(ws + (PROBE_DUMP == 1 ? WS_Z : PROBE_DUMP == 2 ? WS_MIX : WS_H)); const int pitch = PROBE_DUMP == 1 ? ZP : D;
        for (size_t i = (size_t)bx * 512 + otid(wv); i < (size_t)MTOK * D; i += (size_t)G * 512) { const int r = (int)(i >> 10), c = (int)(i & 1023); a.out[i] = PROBE_DUMP == 7 ? 1.0f : PROBE_DUMP == 6 ? (r < 2304 ? bf2f(((const bf16_t*)(ws + WS_WIN))[(size_t)r * 1024 + c]) : 0.f) : PROBE_DUMP >= 4 ? xrow_ptr(a, r)[c] * 2.f : bf2f(src[(size_t)r * pitch + c]); }
        for (size_t i = O_KV + (size_t)bx * 512 + otid(wv); i < 10616832; i += (size_t)G * 512) a.out[i] = 0.f;
    }
    for (int xb = 0; xb < PROBE_XBAR; ++xb) { ++nbar; my_grid_barrier(nbar, (unsigned)G, otid(wv), (LAS unsigned*)(lds + LDS_BYTES - 64)); }
    if (nbar) my_grid_barrier_finish((unsigned)G, otid(wv));
#undef IN
#undef SEAM
}

extern "C" void kernel_launch(void* const* d_in, const int* in_sizes, int n_in, void* d_out, int out_size, void* d_ws, size_t ws_size, hipStream_t stream) {
    static int grid = 0;
    if (grid == 0) {
        int dev = 0, cus = 0;
        static const int exp_sizes[26] = {4194304, 4194304, 131072, 16384, 65536, 65536, 2048, 1024, 6291456, 6144, 1024, 2293760, 384, 294912, 256, 262144, 4096, 256, 4096, 256, 128, 1048576, 1024, 5767168, 2883584, 1024};
        bool okk = (n_in == 26); for (int i = 0; okk && i < 26; ++i) okk = (in_sizes[i] == exp_sizes[i]);
        if (!okk || out_size != 10616832) { fprintf(stderr, "kernel_launch: unexpected input sizes\n"); grid = -1; return; }
        if (n_in != 26 || ws_size < 198 * MiB) { fprintf(stderr, "kernel_launch: unexpected n_in %d / ws %zu\n", n_in, ws_size); grid = -1; return; }
        hipGetDevice(&dev); hipDeviceGetAttribute(&cus, hipDeviceAttributeMultiprocessorCount, dev);
        if (hipFuncSetAttribute((const void*)mk_fwd, hipFuncAttributeMaxDynamicSharedMemorySize, LDS_BYTES) != hipSuccess) { fprintf(stderr, "kernel_launch: hipFuncSetAttribute failed\n"); grid = -1; return; }
        int per_cu = 0;
        if (hipOccupancyMaxActiveBlocksPerMultiprocessor(&per_cu, (const void*)mk_fwd, 512, LDS_BYTES) != hipSuccess || per_cu < 1) { fprintf(stderr, "kernel_launch: occupancy query says %d\n", per_cu); per_cu = 1; }
        (void)hipGetLastError();
        if (cus < 256) { fprintf(stderr, "kernel_launch: needs 256 CUs, got %d\n", cus); grid = -1; return; }
        grid = 256;
    }
    if (grid < 0) return;
    if (hipMemsetAsync((char*)d_ws + WS_BAR, 0, 4096, stream) != hipSuccess) { fprintf(stderr, "kernel_launch: memset failed\n"); return; }
    Args a{};
    for (int i = 0; i < 26; ++i) a.in[i] = (const float*)d_in[i];
    a.out = (float*)d_out; a.ws = (unsigned char*)d_ws;
#if MK_PER_PHASE_LAUNCH
    for (int p = 0; p < NPHASE; ++p) { if (PROBE_ONLY_LAUNCH >= 0 && p != PROBE_ONLY_LAUNCH) continue; a.ph_lo = p; a.ph_hi = p + 1; hipLaunchKernelGGL(mk_fwd, dim3(grid), dim3(512), LDS_BYTES, stream, a); }
#else
    a.ph_lo = 0; a.ph_hi = NPHASE;
#if MK_COOP
    void* args[] = {&a};
    hipError_t e = hipLaunchCooperativeKernel((const void*)mk_fwd, dim3(grid), dim3(512), args, LDS_BYTES, stream);
    if (e != hipSuccess) fprintf(stderr, "cooperative launch failed: %s (grid %d)\n", hipGetErrorString(e), grid);
#else
    hipLaunchKernelGGL(mk_fwd, dim3(grid), dim3(512), LDS_BYTES, stream, a);
#endif
#endif
}
```

```cpp
#include <hip/hip_runtime.h>
#include <hip/hip_cooperative_groups.h>
#include <cstdio>
#include <cstdint>
namespace cg = cooperative_groups;

#define PROBE_FILL 0
#define PROBE_EXC 0
#define PROBE_BLO 0
#define PROBE_BHI 256
#define PROBE_RSTRIDE 1
#define PROBE_REP 1
#define PROBE_XLO 0
#define PROBE_XHI 8
#define PROBE_HANG 0
#define PROBE_ATT_REP 1
#define PROBE_GLAC_REP 1
#define PROBE_FFI_REP 1
#define PROBE_XBAR 0
#define PROBE_P0_REP 1
#define PROBE_ROW_REP 1
#define PROBE_P3_REP 1
#define PROBE_DUMP 0
#define PROBE_STATS 0
#define PROBE_K6 512
#define PROBE_ONLY_LAUNCH -1
#define PROBE_NOSTORE 0
#define PROBE_FILL_MIB 256
#define PROBE_FILL_VAL 1.2345f
#ifndef PROBE_MUL
#define PROBE_MUL 1.f
#endif
#ifndef PROBE_MODOFF
#define PROBE_MODOFF 0u
#endif
#ifndef MK_COOP
#define MK_COOP 0
#endif
#ifndef MK_PER_PHASE_LAUNCH
#define MK_PER_PHASE_LAUNCH 0
#endif

#define LAS __attribute__((address_space(3)))
typedef unsigned short bf16_t;
typedef short bf16x8 __attribute__((ext_vector_type(8)));
typedef float f32x4 __attribute__((ext_vector_type(4)));
typedef float f32x2 __attribute__((ext_vector_type(2)));
typedef unsigned u32x4 __attribute__((ext_vector_type(4)));
typedef unsigned u32x2 __attribute__((ext_vector_type(2)));

constexpr int D = 1024, MTOK = 8192, MP = 4096;
constexpr int ZP = 2304;
constexpr int C_QLAT = 0, C_KVLAT = 384, C_KROPE = 640, C_GQ = 672, C_GK = 928, C_GV = 1184, C_GFL = 1696, C_GOUT = 1728;
constexpr int DFF = 2816;
constexpr float EPS = 1e-6f;
constexpr float QSCALE = 0.10206207261596577f * 1.4426950408889634f;
constexpr int SKS = 2304;

constexpr size_t MiB = 1u << 20;
constexpr size_t WS_WIN = 1 * MiB;
constexpr size_t WS_WUQ = 6 * MiB;
constexpr size_t WS_WKF = 7 * MiB, WS_WVF = 7 * MiB + 256 * 1024;
constexpr size_t WS_WKU = 7 * MiB + 512 * 1024, WS_WVU = 7 * MiB + 768 * 1024;
constexpr size_t WS_WOUT = 8 * MiB;
constexpr size_t WS_WFFI = 10 * MiB;
constexpr size_t WS_WFFO = 21 * MiB;
constexpr size_t WS_BAR = 27 * MiB - 4096;
constexpr size_t WS_MOD = 27 * MiB;
constexpr size_t WS_RSSQ = 29 * MiB;
constexpr size_t WS_RSSKV = WS_RSSQ;
constexpr size_t WS_CACHEB = 27 * MiB + 512 * 1024;
constexpr size_t WS_DEC = 28 * MiB;
constexpr size_t WS_H = 32 * MiB;
constexpr size_t WS_Z = 48 * MiB;
constexpr size_t WS_Q = 84 * MiB;
constexpr size_t WS_HFF = 48 * MiB;
constexpr size_t WS_KP = 96 * MiB;
constexpr size_t WS_KS = 102 * MiB;
constexpr size_t WS_VTP = 109 * MiB;
constexpr size_t WS_VTS = 113 * MiB;
constexpr size_t WS_CT = 118 * MiB;
constexpr size_t WS_MIX = 150 * MiB;
constexpr size_t WS_X1 = 166 * MiB;
constexpr size_t WS_P0 = 96 * MiB;
constexpr size_t WS_P1A = 48 * MiB, WS_P1B = 128 * MiB;
constexpr size_t O_Y = 0, O_KV = 8388608, O_KR = O_KV + 1048576, O_SF = O_KR + 131072, O_SB = O_SF + 524288;

constexpr int LDS_BYTES = 147456;

__device__ __forceinline__ unsigned f2bf_sw(float f) { unsigned u = __builtin_bit_cast(unsigned, f); return (u + 0x7fffu + ((u >> 16) & 1u)) >> 16; }
__device__ __forceinline__ unsigned cvt_pk_bf16(float lo, float hi) { unsigned r; asm volatile("v_cvt_pk_bf16_f32 %0, %1, %2" : "=v"(r) : "v"(lo), "v"(hi)); return r; }
__device__ __forceinline__ bf16_t f2bf(float f) { return (bf16_t)(cvt_pk_bf16(f, 0.f) & 0xffffu); }
__device__ __forceinline__ float bf2f(bf16_t b) { return __uint_as_float((unsigned)b << 16); }
__device__ __forceinline__ float bflo(unsigned w) { return __uint_as_float(w << 16); }
__device__ __forceinline__ float bfhi(unsigned w) { return __uint_as_float(w & 0xffff0000u); }
__device__ __forceinline__ float wave_sum(float v) {
#pragma unroll
    for (int o = 1; o < 64; o <<= 1) v += __shfl_xor(v, o);
    return v;
}
__device__ __forceinline__ float fast_rcp(float x) { return __builtin_amdgcn_rcpf(x); }
__device__ __forceinline__ float silu_f(float a) { return a * fast_rcp(1.f + __expf(-a)); }
__device__ __forceinline__ float logsigmoid_f(float x) { return fminf(x, 0.f) - __logf(1.f + __expf(-fabsf(x))); }
__device__ __forceinline__ int opaque_lane() { int l; asm volatile("v_mbcnt_lo_u32_b32 %0, -1, 0\n\tv_mbcnt_hi_u32_b32 %0, -1, %0" : "=v"(l)); return l; }
__device__ __forceinline__ int otid(int wv) { int t = (int)threadIdx.x; asm volatile("" : "+v"(t)); return t; }
#define LDS_WAIT() asm volatile("s_waitcnt lgkmcnt(0)" ::: "memory")
#define VM_WAIT() asm volatile("s_waitcnt vmcnt(0)" ::: "memory")

namespace pg8 {
constexpr int BM = 256, BK = 64, HALF = 128, HTB = HALF * BK * 2, STAGE_BYTES = 8 * HTB, NXCD = 8, WGM = 8;
__host__ __device__ __forceinline__ int lds_byte(int r, int c) { const int st = (r >> 4) * 2 + (c >> 5), rr = r & 15, cc = c & 31, ob = rr * 64 + cc * 2; return st * 1024 + (ob ^ (((ob >> 9) & 1) << 5)); }
__host__ __device__ __forceinline__ void stage_rc(int b, int& R, int& C) { const int st = b / 1024, sb = b % 1024, swz = sb ^ (((sb >> 9) & 1) << 5); R = (st >> 1) * 16 + swz / 64; C = (st & 1) * 32 + (swz % 64) / 2; }
__host__ __device__ __forceinline__ int perm32(int rho) { const int n = rho >> 4, i = rho & 15; return 8 * (i >> 2) + 4 * n + (i & 3); }

struct Unit { int pm, pn, ks; };
struct Gemm { const bf16_t* A; const bf16_t* Bt; int lda, ldb, K, wv; };

struct Order {
    int nM, nN, nNs, nwg, G, c;
    __device__ void init(int M, int N, int nsplit, int G_, int c_) { nM = M / BM; nN = N / BM; nNs = nN * nsplit; nwg = nM * nNs; G = G_; c = c_; }
    __device__ bool next(int i, Unit& u) const {
        const long L = (long)i * G + c; if (L >= nwg) return false;
        int wgid = (int)L; { const int q = nwg / NXCD, r = nwg % NXCD, xcd = wgid % NXCD, off = wgid / NXCD; wgid = (xcd < r ? xcd * (q + 1) : r * (q + 1) + (xcd - r) * q) + off; }
        const int nig = WGM * nNs, gid = wgid / nig, fm = gid * WGM, gsz = (nM - fm) < WGM ? (nM - fm) : WGM;
        u.pm = fm + ((wgid % nig) % gsz); const int pn2 = (wgid % nig) / gsz; u.pn = pn2 % nN; u.ks = pn2 / nN; return true;
    }
};

template <class Epi, class Sched, bool ALIGN_EPI = true, bool SP2 = true>
__device__ __forceinline__ void gemm_phase(LAS unsigned char* lds, const Gemm g, const Sched& S, const Epi& E) {
    const int tid = otid(g.wv), wid = g.wv, lane = tid & 63, wr = wid >> 2, wc = wid & 3, fr = lane & 15, fq = lane >> 4;
    const int K = g.K, nt = K / BK;
    unsigned voffA[2], voffB[2];
#pragma unroll
    for (int i = 0; i < 2; ++i) { int R, C; stage_rc(tid * 16 + i * 8192, R, C); const int Rb = Epi::PERM ? ((R & ~31) + perm32(R & 31)) : R;
        voffA[i] = (unsigned)(R * g.lda + C) * 2u; voffB[i] = (unsigned)(Rb * g.ldb + C) * 2u; }
    const size_t kstep = (size_t)(BK * 2);
    const size_t hstepA = (size_t)HALF * g.lda * 2, hstepB = (size_t)HALF * g.ldb * 2;
    const size_t tstepA = 2 * hstepA, tstepB = 2 * hstepB;
    const size_t ksplit = (size_t)K * 2;
    const unsigned ldsw = (unsigned)wid * 1024u;
    const int aoff = lds_byte(wr * 64 + fr, fq * 8), boff = lds_byte(wc * 32 + fr, fq * 8);
#define PG8_SA(b, h) (((b) * 2 + (h)) * HTB)
#define PG8_SB(b, h) ((4 + (b) * 2 + (h)) * HTB)
#define PG8_STAGE(bufoff, gbase, voff) do { _Pragma("unroll") for (int _i = 0; _i < 2; ++_i) \
        __builtin_amdgcn_global_load_lds((const unsigned*)((const char*)(gbase) + (voff)[_i]), (LAS unsigned*)(lds + (bufoff) + ldsw + _i * 8192), 16, 0, 0); } while (0)
#define PG8_LDA(dst, b, h) do { _Pragma("unroll") for (int m = 0; m < 4; ++m) _Pragma("unroll") for (int k = 0; k < 2; ++k) dst[m][k] = *(const LAS bf16x8*)(lds + PG8_SA(b, h) + aoff + m * 2048 + k * 1024); } while (0)
#define PG8_LDB(dst, b, h) do { _Pragma("unroll") for (int n = 0; n < 2; ++n) _Pragma("unroll") for (int k = 0; k < 2; ++k) dst[n][k] = *(const LAS bf16x8*)(lds + PG8_SB(b, h) + boff + n * 2048 + k * 1024); } while (0)
#define PG8_MMA(ai, bj, At, Bt) do { __builtin_amdgcn_s_setprio(1); _Pragma("unroll") for (int m = 0; m < 4; ++m) _Pragma("unroll") for (int n = 0; n < 2; ++n) _Pragma("unroll") for (int k = 0; k < 2; ++k) \
        acc[ai][bj][m][n] = __builtin_amdgcn_mfma_f32_16x16x32_bf16(Bt[n][k], At[m][k], acc[ai][bj][m][n], 0, 0, 0); __builtin_amdgcn_s_setprio(0); } while (0)
#define PG8_WAIT_V(n) asm volatile("s_waitcnt vmcnt(" #n ")" ::: "memory")
#define PG8_WAIT_L(n) asm volatile("s_waitcnt lgkmcnt(" #n ")" ::: "memory")
#define PG8_BAR __builtin_amdgcn_s_barrier()
#define PG8_SCHED __builtin_amdgcn_sched_barrier(0)
    Unit cur, nxt; int ui = 0;
    if (!S.next(0, cur)) return;
    f32x4 acc[2][2][4][2];
#pragma unroll
    for (int a = 0; a < 2; ++a)
#pragma unroll
        for (int b = 0; b < 2; ++b)
#pragma unroll
            for (int m = 0; m < 4; ++m)
#pragma unroll
                for (int n = 0; n < 2; ++n) acc[a][b][m][n] = (f32x4){0.f, 0.f, 0.f, 0.f};
    bf16x8 At[4][2], B0[2][2], B1[2][2];
    const char* cA = (const char*)g.A + (size_t)cur.pm * tstepA + (size_t)cur.ks * ksplit; const char* cB = (const char*)g.Bt + (size_t)cur.pn * tstepB + (size_t)cur.ks * ksplit;
    if constexpr (SP2) {
        PG8_STAGE(PG8_SB(0, 0), cB, voffB); PG8_STAGE(PG8_SB(0, 1), cB + hstepB, voffB); PG8_STAGE(PG8_SA(0, 0), cA, voffA); PG8_STAGE(PG8_SA(0, 1), cA + hstepA, voffA);
        if (wr == 1) PG8_BAR;
        PG8_WAIT_V(2); PG8_BAR;
        PG8_STAGE(PG8_SB(1, 0), cB + kstep, voffB); PG8_STAGE(PG8_SA(1, 0), cA + kstep, voffA); PG8_STAGE(PG8_SB(1, 1), cB + hstepB + kstep, voffB);
        PG8_WAIT_V(6); PG8_BAR;
    } else {
        PG8_STAGE(PG8_SB(0, 0), cB, voffB); PG8_STAGE(PG8_SA(0, 0), cA, voffA); PG8_STAGE(PG8_SB(0, 1), cB + hstepB, voffB); PG8_STAGE(PG8_SA(0, 1), cA + hstepA, voffA);
        if (wr == 1) PG8_BAR;
        PG8_WAIT_V(4); PG8_BAR;
        PG8_STAGE(PG8_SB(1, 0), cB + kstep, voffB); PG8_STAGE(PG8_SA(1, 0), cA + kstep, voffA); PG8_STAGE(PG8_SB(1, 1), cB + hstepB + kstep, voffB);
        PG8_WAIT_V(6); PG8_BAR;
    }
    for (;;) {
        const bool has_next = S.next(ui + 1, nxt);
        const char* nA = has_next ? (const char*)g.A + (size_t)nxt.pm * tstepA + (size_t)nxt.ks * ksplit : cA; const char* nB = has_next ? (const char*)g.Bt + (size_t)nxt.pn * tstepB + (size_t)nxt.ks * ksplit : cB;
#pragma nounroll
        for (int t = 0; t < nt; t += 2) {
            const bool last = (t == nt - 2);
            const char* a1 = cA + (size_t)(t + 1) * kstep;
            const char* a2 = last ? nA : cA + (size_t)(t + 2) * kstep; const char* b2 = last ? nB : cB + (size_t)(t + 2) * kstep;
            const char* a3 = a2 + kstep; const char* b3 = b2 + kstep;
            if constexpr (SP2) {
            PG8_LDB(B0, 0, 0); PG8_LDB(B1, 0, 1); PG8_SCHED; PG8_LDA(At, 0, 0); PG8_STAGE(PG8_SA(1, 1), a1 + hstepA, voffA);
            PG8_WAIT_V(8); PG8_WAIT_L(0); PG8_BAR; PG8_MMA(0, 0, At, B0); PG8_MMA(0, 1, At, B1); PG8_BAR; PG8_SCHED;
            PG8_LDA(At, 0, 1); PG8_STAGE(PG8_SB(0, 0), b2, voffB); PG8_STAGE(PG8_SB(0, 1), b2 + hstepB, voffB); PG8_STAGE(PG8_SA(0, 0), a2, voffA);
            PG8_WAIT_V(8); PG8_WAIT_L(0); PG8_BAR; PG8_MMA(1, 0, At, B0); PG8_MMA(1, 1, At, B1); PG8_BAR; PG8_SCHED;
            PG8_LDB(B0, 1, 0); PG8_LDB(B1, 1, 1); PG8_SCHED; PG8_LDA(At, 1, 0); PG8_STAGE(PG8_SA(0, 1), a2 + hstepA, voffA);
            PG8_WAIT_V(8); PG8_WAIT_L(0); PG8_BAR; PG8_MMA(0, 0, At, B0); PG8_MMA(0, 1, At, B1); PG8_BAR; PG8_SCHED;
            PG8_LDA(At, 1, 1); PG8_STAGE(PG8_SB(1, 0), b3, voffB); PG8_STAGE(PG8_SB(1, 1), b3 + hstepB, voffB); PG8_STAGE(PG8_SA(1, 0), a3, voffA);
            PG8_WAIT_V(8); PG8_WAIT_L(0); PG8_BAR; PG8_MMA(1, 0, At, B0); PG8_MMA(1, 1, At, B1); PG8_BAR; PG8_SCHED;
            } else {
            PG8_LDB(B0, 0, 0); PG8_SCHED; PG8_LDA(At, 0, 0); PG8_STAGE(PG8_SA(1, 1), a1 + hstepA, voffA);
            PG8_WAIT_L(8); PG8_BAR; PG8_WAIT_L(0); PG8_MMA(0, 0, At, B0); PG8_BAR; PG8_SCHED;
            PG8_LDB(B1, 0, 1); PG8_STAGE(PG8_SB(0, 0), b2, voffB);
            PG8_BAR; PG8_WAIT_L(0); PG8_MMA(0, 1, At, B1); PG8_BAR;
            PG8_LDA(At, 0, 1); PG8_STAGE(PG8_SA(0, 0), a2, voffA);
            PG8_BAR; PG8_WAIT_L(0); PG8_MMA(1, 0, At, B0); PG8_BAR; PG8_SCHED;
            PG8_STAGE(PG8_SB(0, 1), b2 + hstepB, voffB);
            PG8_WAIT_V(6); PG8_BAR; PG8_MMA(1, 1, At, B1); PG8_BAR;
            PG8_LDB(B0, 1, 0); PG8_SCHED; PG8_LDA(At, 1, 0); PG8_STAGE(PG8_SA(0, 1), a2 + hstepA, voffA);
            PG8_WAIT_L(8); PG8_BAR; PG8_WAIT_L(0); PG8_MMA(0, 0, At, B0); PG8_BAR; PG8_SCHED;
            PG8_LDB(B1, 1, 1); PG8_STAGE(PG8_SB(1, 0), b3, voffB);
            PG8_BAR; PG8_WAIT_L(0); PG8_MMA(0, 1, At, B1); PG8_BAR;
            PG8_LDA(At, 1, 1); PG8_STAGE(PG8_SA(1, 0), a3, voffA);
            PG8_BAR; PG8_WAIT_L(0); PG8_MMA(1, 0, At, B0); PG8_BAR; PG8_SCHED;
            PG8_STAGE(PG8_SB(1, 1), b3 + hstepB, voffB);
            PG8_WAIT_V(6); PG8_BAR; PG8_MMA(1, 1, At, B1); PG8_BAR;
            }
        }
        if constexpr (ALIGN_EPI) { if (wr == 0) PG8_BAR; }
        E(acc, cur, wr, wc, fr, fq);
        if (!has_next) break;
#pragma unroll
        for (int a = 0; a < 2; ++a)
#pragma unroll
            for (int b = 0; b < 2; ++b)
#pragma unroll
                for (int m = 0; m < 4; ++m)
#pragma unroll
                    for (int n = 0; n < 2; ++n) acc[a][b][m][n] = (f32x4){0.f, 0.f, 0.f, 0.f};
        cur = nxt; cA = nA; cB = nB; ++ui;
        if constexpr (ALIGN_EPI) { if (wr == 1) PG8_BAR; }
    }
    PG8_WAIT_V(0);
    if constexpr (!ALIGN_EPI) { if (wr == 0) PG8_BAR; }
    PG8_BAR;
#undef PG8_SA
#undef PG8_SB
#undef PG8_STAGE
#undef PG8_LDA
#undef PG8_LDB
#undef PG8_MMA
#undef PG8_WAIT_V
#undef PG8_WAIT_L
#undef PG8_BAR
#undef PG8_SCHED
}

__device__ __forceinline__ float rss_q(const float* rss, int row) { float s = 0.f;
#pragma unroll
    for (int p = 0; p < 12; ++p) s += rss[(size_t)p * MTOK + row]; return s; }
__device__ __forceinline__ float rss_kv(const float* rss, int row) { float s = 0.f;
#pragma unroll
    for (int p = 12; p < 20; ++p) s += rss[(size_t)p * MTOK + row]; return s; }
#define EPI_ROWS_BEGIN _Pragma("unroll") for (int ai = 0; ai < 2; ++ai) _Pragma("unroll") for (int m = 0; m < 4; ++m) { const int row = u.pm * BM + wr * 64 + fr + ai * HALF + m * 16;
#define EPI_ROWS_END asm volatile("" ::: "memory"); }

struct EpiZ {
    static constexpr bool PERM = true;
    bf16_t* Z; float* rssq; float* rsskv; int pn_off;
    __device__ __forceinline__ void operator()(const f32x4 (&acc)[2][2][4][2], const Unit& u, int wr, int wc, int fr_, int fq_) const {
        int lane_e = (int)threadIdx.x & 63; asm volatile("" : "+v"(lane_e)); const int fr = lane_e & 15, fq = lane_e >> 4;
        const int col0 = (u.pn + pn_off) * BM + wc * 32 + 8 * fq;
        EPI_ROWS_BEGIN
            bf16_t* rowp = Z + (size_t)row * ZP + col0;
#pragma unroll
            for (int bj = 0; bj < 2; ++bj) { const f32x4 v0 = acc[ai][bj][m][0], v1 = acc[ai][bj][m][1];
                u32x4 w; w.x = cvt_pk_bf16(v0[0], v0[1]); w.y = cvt_pk_bf16(v0[2], v0[3]); w.z = cvt_pk_bf16(v1[0], v1[1]); w.w = cvt_pk_bf16(v1[2], v1[3]);
                *(u32x4*)(rowp + bj * HALF) = w;
                const int hc = 2 * (u.pn + pn_off) + bj;
                if (hc < 5) { float s = (v0[0] * v0[0] + v0[1] * v0[1]) + (v0[2] * v0[2] + v0[3] * v0[3]) + (v1[0] * v1[0] + v1[1] * v1[1]) + (v1[2] * v1[2] + v1[3] * v1[3]);
                    s += __shfl_xor(s, 16); s += __shfl_xor(s, 32);
                    if (fq == 0) rssq[(size_t)(hc * 4 + wc) * MTOK + row] = s; } }
        EPI_ROWS_END
    }
};

struct EpiQ {
    static constexpr bool PERM = true;
    bf16_t* Q; const float* rssq;
    __device__ __forceinline__ void operator()(const f32x4 (&acc)[2][2][4][2], const Unit& u, int wr, int wc, int fr_, int fq_) const {
        int lane_e = (int)threadIdx.x & 63; asm volatile("" : "+v"(lane_e)); const int fr = lane_e & 15, fq = lane_e >> 4;
        const int col0 = u.pn * BM + wc * 32 + 8 * fq;
        const float inv[8] = {1.f, 0.316227766f, 0.1f, 0.0316227766f, 0.01f, 0.00316227766f, 0.001f, 0.000316227766f};
        EPI_ROWS_BEGIN
            const float rs = rsqrtf(rss_q(rssq, row) * (1.f / 384.f) + EPS) * QSCALE;
            const int t = (row - MP) & 2047;
#pragma unroll
            for (int bj = 0; bj < 2; ++bj) { const int c = col0 + bj * HALF; const int j0 = c % 96;
                const bool rp = (row >= MP && j0 >= 64);
                const float pos = (float)((j0 < 80) ? (t >> 6) : (t & 63)) * 0.15915494309189535f;
                const float sg = (j0 & 8) ? 1.f : -1.f;
#pragma unroll
                for (int n = 0; n < 2; ++n) {
                    f32x4 v = acc[ai][bj][m][n] * rs;
#pragma unroll
                    for (int i = 0; i < 4; ++i) { const float p = __shfl_xor(v[i], 16);
                        const float rev = pos * inv[4 * n + i]; const float rf = rev - floorf(rev);
                        const float cs = __builtin_amdgcn_cosf(rf), sn = __builtin_amdgcn_sinf(rf); v[i] = rp ? v[i] * cs + sg * p * sn : v[i]; }
                    u32x2 w; w.x = cvt_pk_bf16(v[0], v[1]); w.y = cvt_pk_bf16(v[2], v[3]);
                    *(u32x2*)(Q + (size_t)row * 768 + c + 4 * n) = w; } }
        EPI_ROWS_END
    }
};

struct EpiK {
    static constexpr bool PERM = true;
    bf16_t* Kp; bf16_t* Ks; const float* rsskv; int ctx;
    __device__ __forceinline__ void operator()(const f32x4 (&acc)[2][2][4][2], const Unit& u, int wr, int wc, int fr_, int fq_) const {
        int lane_e = (int)threadIdx.x & 63; asm volatile("" : "+v"(lane_e)); const int fr = lane_e & 15, fq = lane_e >> 4;
        EPI_ROWS_BEGIN
            float rs = 1.f; unsigned off; bool smp;
            if (ctx) { off = ((unsigned)(row >> 8) * 8u * SKS + (row & 255)) * 96u; smp = true; }
            else { rs = rsqrtf(rss_kv(rsskv, row) * (1.f / 256.f) + EPS);
                if (row < MP) { off = ((unsigned)(row >> 8) * 8u * 256u + (row & 255)) * 96u; smp = false; } else { off = ((unsigned)((row - MP) >> 11) * 8u * SKS + 256u + ((row - MP) & 2047)) * 96u; smp = true; } }
            bf16_t* base = smp ? Ks : Kp; const unsigned hs = (smp ? SKS : 256) * 96u;
#pragma unroll
            for (int bj = 0; bj < 2; ++bj) { const unsigned h = 4 * u.pn + 2 * bj + (wc >> 1); const unsigned j = (wc & 1) * 32 + 8 * fq;
                const f32x4 v0 = acc[ai][bj][m][0] * rs, v1 = acc[ai][bj][m][1] * rs;
                u32x4 w; w.x = cvt_pk_bf16(v0[0], v0[1]); w.y = cvt_pk_bf16(v0[2], v0[3]); w.z = cvt_pk_bf16(v1[0], v1[1]); w.w = cvt_pk_bf16(v1[2], v1[3]);
                *(u32x4*)(base + (off + h * hs + j)) = w; }
        EPI_ROWS_END
    }
};

struct EpiVt {
    static constexpr bool PERM = true;
    bf16_t* Vtp; bf16_t* Vts; const float* rsskv; int ctx;
    __device__ __forceinline__ void operator()(const f32x4 (&acc)[2][2][4][2], const Unit& u, int wr, int wc, int fr_, int fq_) const {
        int lane_e = (int)threadIdx.x & 63; asm volatile("" : "+v"(lane_e)); const int fr = lane_e & 15, fq = lane_e >> 4;
#pragma unroll
        for (int bj = 0; bj < 2; ++bj) {
            const int tok = u.pn * BM + bj * HALF + wc * 32 + 8 * fq;
            f32x4 r0 = {1.f, 1.f, 1.f, 1.f}, r1 = {1.f, 1.f, 1.f, 1.f}; unsigned off; bool smp; unsigned S;
            if (ctx) { off = (unsigned)(tok >> 8) * 8u * 64u * SKS + (tok & 255); smp = true; S = SKS; }
            else { f32x4 q0 = {0.f, 0.f, 0.f, 0.f}, q1 = {0.f, 0.f, 0.f, 0.f};
#pragma unroll
                for (int p = 12; p < 20; ++p) { q0 += *(const f32x4*)(rsskv + (size_t)p * MTOK + tok); q1 += *(const f32x4*)(rsskv + (size_t)p * MTOK + tok + 4); }
#pragma unroll
                for (int i = 0; i < 4; ++i) { r0[i] = rsqrtf(q0[i] * (1.f / 256.f) + EPS); r1[i] = rsqrtf(q1[i] * (1.f / 256.f) + EPS); }
                if (tok < MP) { off = (unsigned)(tok >> 8) * 8u * 64u * 256u + (tok & 255); smp = false; S = 256; } else { off = (unsigned)((tok - MP) >> 11) * 8u * 64u * SKS + 256u + ((tok - MP) & 2047); smp = true; S = SKS; } }
            bf16_t* base = smp ? Vts : Vtp;
#pragma unroll
            for (int ai = 0; ai < 2; ++ai)
#pragma unroll
                for (int m = 0; m < 4; ++m) { const unsigned hd = u.pm * BM + wr * 64 + fr + ai * HALF + m * 16;
                    const f32x4 v0 = acc[ai][bj][m][0] * r0, v1 = acc[ai][bj][m][1] * r1;
                    u32x4 w; w.x = cvt_pk_bf16(v0[0], v0[1]); w.y = cvt_pk_bf16(v0[2], v0[3]); w.z = cvt_pk_bf16(v1[0], v1[1]); w.w = cvt_pk_bf16(v1[2], v1[3]);
                    *(u32x4*)(base + (off + hd * S)) = w; }
            asm volatile("" ::: "memory");
        }
    }
};

struct EpiPart {
    static constexpr bool PERM = true;
    bf16_t* P0; bf16_t* P1;
    __device__ __forceinline__ void operator()(const f32x4 (&acc)[2][2][4][2], const Unit& u, int wr, int wc, int fr_, int fq_) const {
        int lane_e = (int)threadIdx.x & 63; asm volatile("" : "+v"(lane_e)); const int fr = lane_e & 15, fq = lane_e >> 4;
        const int col0 = u.pn * BM + wc * 32 + 8 * fq; bf16_t* P = u.ks ? P1 : P0;
        EPI_ROWS_BEGIN
            bf16_t* rowp = P + (size_t)row * D + col0;
#pragma unroll
            for (int bj = 0; bj < 2; ++bj) { const f32x4 v0 = acc[ai][bj][m][0], v1 = acc[ai][bj][m][1];
                u32x4 w; w.x = cvt_pk_bf16(v0[0], v0[1]); w.y = cvt_pk_bf16(v0[2], v0[3]); w.z = cvt_pk_bf16(v1[0], v1[1]); w.w = cvt_pk_bf16(v1[2], v1[3]);
                *(u32x4*)(rowp + bj * HALF) = w; }
        EPI_ROWS_END
    }
};

struct EpiFFI {
    static constexpr bool PERM = true;
    bf16_t* H;
    __device__ __forceinline__ void operator()(const f32x4 (&acc)[2][2][4][2], const Unit& u, int wr, int wc, int fr_, int fq_) const {
        int lane_e = (int)threadIdx.x & 63; asm volatile("" : "+v"(lane_e)); const int fr = lane_e & 15, fq = lane_e >> 4;
        const int col0 = u.pn * HALF + wc * 32 + 8 * fq;
        EPI_ROWS_BEGIN
            float o[8];
#pragma unroll
            for (int i = 0; i < 4; ++i) { o[i] = silu_f(acc[ai][0][m][0][i]) * acc[ai][1][m][0][i]; o[4 + i] = silu_f(acc[ai][0][m][1][i]) * acc[ai][1][m][1][i]; }
            u32x4 w; w.x = cvt_pk_bf16(o[0], o[1]); w.y = cvt_pk_bf16(o[2], o[3]); w.z = cvt_pk_bf16(o[4], o[5]); w.w = cvt_pk_bf16(o[6], o[7]);
            *(u32x4*)(H + (size_t)row * DFF + col0) = w;
        EPI_ROWS_END
    }
};
}

struct Args { const float* in[26]; float* out; unsigned char* ws; int ph_lo, ph_hi; };
enum { I_XP = 0, I_XS, I_CKV, I_CKR, I_SF, I_SB, I_C, I_CCTX, I_WADA, I_BADA, I_NATT, I_WIN, I_QN, I_WUQ, I_KVN, I_WUKV, I_WGF, I_BGF, I_WGB, I_BGB, I_GLAN, I_WOUT, I_NFFN, I_WFFI, I_WFFO, I_FN };

__device__ __forceinline__ const float* xrow_ptr(const Args& a, int r) { return r < MP ? a.in[I_XP] + (size_t)r * D : a.in[I_XS] + (size_t)(r - MP) * D; }
__device__ __forceinline__ int cond_of_row(int r) { return r < MP ? 0 : 1 + ((r - MP) >> 11); }

__device__ __forceinline__ void p0_tr(const float* W, int K, int N, bf16_t* WT, bf16_t* WT2, const float* kscale, int kb, int nb, int drow, LAS float* scr, int lane) {
    const int k0 = 64 * kb, n0 = 32 * nb;
#pragma unroll 8
    for (int i = 0; i < 32; ++i) { const int kk = 2 * i + (lane >> 5); scr[kk * 33 + (lane & 31)] = W[(size_t)(k0 + kk) * N + n0 + (lane & 31)]; }
    LDS_WAIT();
    const int c = lane & 7;
    float sc[8];
#pragma unroll
    for (int i = 0; i < 8; ++i) sc[i] = kscale ? kscale[k0 + 8 * c + i] : 1.f;
#pragma unroll
    for (int j = 0; j < 4; ++j) { const int n = (lane >> 3) + 8 * j; const LAS float* s = scr + (8 * c) * 33 + n;
        float v[8];
#pragma unroll
        for (int i = 0; i < 8; ++i) v[i] = s[i * 33];
        if (WT2) { u32x4 o; o.x = cvt_pk_bf16(v[0], v[1]); o.y = cvt_pk_bf16(v[2], v[3]); o.z = cvt_pk_bf16(v[4], v[5]); o.w = cvt_pk_bf16(v[6], v[7]);
            *(u32x4*)(WT2 + (size_t)(drow + n0 + n) * K + k0 + 8 * c) = o; }
        u32x4 o; o.x = cvt_pk_bf16(v[0] * sc[0], v[1] * sc[1]); o.y = cvt_pk_bf16(v[2] * sc[2], v[3] * sc[3]); o.z = cvt_pk_bf16(v[4] * sc[4], v[5] * sc[5]); o.w = cvt_pk_bf16(v[6] * sc[6], v[7] * sc[7]);
        *(u32x4*)(WT + (size_t)(drow + n0 + n) * K + k0 + 8 * c) = o; }
    LDS_WAIT();
}

__device__ __forceinline__ void phase0(const Args& a, int wv, LAS unsigned char* lds, int vcu, int G) {
    const int tid = otid(wv), lane = tid & 63, wave = __builtin_amdgcn_readfirstlane(tid >> 6);
    unsigned char* ws = a.ws;
#ifndef P0MASK
#define P0MASK 7
#endif
    if (P0MASK & 2) {
        LAS float* scr = (LAS float*)(lds + wave * 16384);
        LAS float* scnd = (LAS float*)(lds + 131072);
        for (int i = tid; i < 3072; i += 512) { const int ci = i >> 10, k = i & 1023; scnd[i] = silu_f(ci == 0 ? a.in[I_CCTX][k] : a.in[I_C][(ci - 1) * D + k]); }
        __syncthreads();
        const int gw = vcu * 8 + wave, NGW = G * 8;
        constexpr int T_IN = 16 * 70, T_UQ = 6 * 24, T_UKV = 4 * 32, T_OUT = 16 * 32, T_FFI = 16 * 176, T_FFO = 44 * 32, T_ZERO = 64, T_ADA = 768;
        constexpr int NIT = T_ADA + T_IN + T_UQ + T_UKV + T_OUT + T_FFI + T_FFO + T_ZERO;
        for (int it = gw; it < NIT; it += NGW) {
            int r = it;
            if (r < T_ADA) {
                const int nbq = r >> 2, kq = r & 3; const int n0 = 32 * nbq; const float* W = a.in[I_WADA];
                const int n = lane & 31, hf = lane >> 5; float s0 = 0.f, s1 = 0.f, s2 = 0.f;
                for (int kb = 4 * kq; kb < 4 * kq + 4; ++kb) { const int k0 = 64 * kb;
#pragma unroll 8
                    for (int i = 0; i < 32; ++i) { const int kk = 2 * i + (lane >> 5); scr[kk * 33 + (lane & 31)] = W[(size_t)(k0 + kk) * 6144 + n0 + (lane & 31)]; }
                    LDS_WAIT();
#pragma unroll 8
                    for (int j = 0; j < 32; ++j) { const int kk = hf * 32 + j; const float w = scr[kk * 33 + n];
                        s0 += w * scnd[k0 + kk]; s1 += w * scnd[1024 + k0 + kk]; s2 += w * scnd[2048 + k0 + kk]; }
                    LDS_WAIT(); }
                s0 += __shfl_xor(s0, 32); s1 += __shfl_xor(s1, 32); s2 += __shfl_xor(s2, 32);
                float* MOD = (float*)(ws + WS_MOD) + (size_t)kq * 18432;
                if (hf == 0) { MOD[n0 + n] = s0; MOD[6144 + n0 + n] = s1; MOD[12288 + n0 + n] = s2; }
                continue; } r -= T_ADA;
            if (r < T_FFI) { const int kb = r / 176, nb = r % 176; const int n0 = nb * 32; const int drow = n0 < DFF ? (n0 / 128) * 256 + (n0 % 128) : ((n0 - DFF) / 128) * 256 + 128 + ((n0 - DFF) % 128);
                p0_tr(a.in[I_WFFI], 1024, 5632, (bf16_t*)(ws + WS_WFFI), nullptr, nullptr, kb, nb, drow - n0, scr, lane); continue; } r -= T_FFI;
            if (r < T_FFO) { p0_tr(a.in[I_WFFO], DFF, 1024, (bf16_t*)(ws + WS_WFFO), nullptr, nullptr, r / 32, r % 32, 0, scr, lane); continue; } r -= T_FFO;
            if (r < T_IN) { p0_tr(a.in[I_WIN], 1024, 2240, (bf16_t*)(ws + WS_WIN), nullptr, nullptr, r / 70, r % 70, 0, scr, lane); continue; } r -= T_IN;
            if (r < T_OUT) { p0_tr(a.in[I_WOUT], 1024, 1024, (bf16_t*)(ws + WS_WOUT), nullptr, nullptr, r / 32, r % 32, 0, scr, lane); continue; } r -= T_OUT;
            if (r < T_UQ) { p0_tr(a.in[I_WUQ], 384, 768, (bf16_t*)(ws + WS_WUQ), nullptr, a.in[I_QN], r / 24, r % 24, 0, scr, lane); continue; } r -= T_UQ;
            if (r < T_UKV) { const int nb = r % 32, n0 = nb * 32, hh = n0 >> 7, j0 = n0 & 127; const bool isv = j0 >= 64; const int drow = hh * 64 + (j0 & 63);
                p0_tr(a.in[I_WUKV], 256, 1024, (bf16_t*)(ws + (isv ? WS_WVF : WS_WKF)), (bf16_t*)(ws + (isv ? WS_WVU : WS_WKU)), a.in[I_KVN], r / 32, nb, drow - n0, scr, lane); continue; } r -= T_UKV;
            { u32x4 z = {0u, 0u, 0u, 0u}; u32x4* p = (u32x4*)((bf16_t*)(ws + WS_WIN) + (size_t)(2240 + r) * 1024); p[lane] = z; p[64 + lane] = z; }
        }
    }
    if (P0MASK & 4) {
        const int gt = vcu * 512 + tid, NT = G * 512;
        for (int i = gt; i < 32768; i += NT) { const f32x4 v = ((const f32x4*)a.in[I_CKV])[i]; u32x2 w; w.x = cvt_pk_bf16(v[0], v[1]); w.y = cvt_pk_bf16(v[2], v[3]); ((u32x2*)(ws + WS_CACHEB))[i] = w; }
    }
}

__device__ __forceinline__ f32x4 mod4(const float* modp, const float* bias, int ci, int off) {
    const float* p = modp + ci * 6144 + off;
    return ((*(const f32x4*)p + *(const f32x4*)(p + 18432)) + (*(const f32x4*)(p + 36864) + *(const f32x4*)(p + 55296))) + *(const f32x4*)(bias + off);
}
__device__ __forceinline__ void phase1(const Args& a, int wv, int vcu, int G) {
    if (PROBE_FILL == 3) { float* m = (float*)(a.ws + WS_MOD); for (int i = otid(wv); i < 3 * 6144; i += 512) { unsigned h = (unsigned)i * 2654435761u; h ^= h >> 15; h *= 2246822519u; h ^= h >> 13; m[i] = ((float)(h & 0xffff) * (1.f / 65536.f) - 0.5f) * 2.f; } __syncthreads(); }
    const int tid_ = otid(wv); const int lane = tid_ & 63, wave = tid_ >> 6; const int gw = vcu * 8 + wave, NGW = G * 8;
    const float* mod = (const float*)(a.ws + WS_MOD + PROBE_MODOFF); bf16_t* H = (bf16_t*)(a.ws + WS_H);
    for (int r = gw; r < MTOK; r += NGW * PROBE_RSTRIDE) {
        const f32x4* xr = (const f32x4*)xrow_ptr(a, r) + lane; const int ci_ = cond_of_row(r);
        f32x4 v[4]; float s = 0.f;
#pragma unroll
        for (int j = 0; j < 4; ++j) { v[j] = xr[64 * j]; s += (v[j][0] * v[j][0] + v[j][1] * v[j][1]) + (v[j][2] * v[j][2] + v[j][3] * v[j][3]); }
        const float rstd = rsqrtf(wave_sum(s) * (1.f / D) + EPS);
        u32x2* o = (u32x2*)(H + (size_t)r * D) + lane;
#pragma unroll
        for (int j = 0; j < 4; ++j) { const int c = 4 * lane + 256 * j; const f32x4 w = *(const f32x4*)(a.in[I_NATT] + c), sh = mod4(mod, a.in[I_BADA], ci_, c), scv = mod4(mod, a.in[I_BADA], ci_, 1024 + c);
            const f32x4 y = v[j] * rstd * w * (scv * PROBE_MUL + 1.f) + sh * PROBE_MUL; u32x2 p; p.x = cvt_pk_bf16(y[0], y[1]); p.y = cvt_pk_bf16(y[2], y[3]); if (PROBE_NOSTORE) { if ((p.x ^ p.y) == 0x12345u) o[64 * j] = p; } else o[64 * j] = p; }
    }
}
__device__ __forceinline__ void phase6(const Args& a, int wv, int vcu, int G) {
    const int tid_ = otid(wv); const int lane = tid_ & 63, wave = tid_ >> 6; const int gw = vcu * 8 + wave, NGW = G * 8;
    const float* mod = (const float*)(a.ws + WS_MOD); bf16_t* H = (bf16_t*)(a.ws + WS_H); float* X1 = (float*)(a.ws + WS_X1);
    const bf16_t* P0 = (const bf16_t*)(a.ws + WS_P0); const bf16_t* P1 = (const bf16_t*)(a.ws + WS_P1A);
    for (int r = gw; r < MTOK; r += NGW) {
        const f32x4* xr = (const f32x4*)xrow_ptr(a, r) + lane; const int ci_ = cond_of_row(r);
        const u32x2* p0 = (const u32x2*)(P0 + (size_t)r * D) + lane; const u32x2* p1 = (const u32x2*)(P1 + (size_t)r * D) + lane;
        f32x4 v[4]; float s = 0.f;
#pragma unroll
        for (int j = 0; j < 4; ++j) { const int c = 4 * lane + 256 * j; const f32x4 gt = mod4(mod, a.in[I_BADA], ci_, 2048 + c);
            { const u32x2 qa = p0[64 * j], qb = p1[64 * j]; const f32x4 ps = {bflo(qa.x) + bflo(qb.x), bfhi(qa.x) + bfhi(qb.x), bflo(qa.y) + bflo(qb.y), bfhi(qa.y) + bfhi(qb.y)}; v[j] = xr[64 * j] + gt * ps; } s += (v[j][0] * v[j][0] + v[j][1] * v[j][1]) + (v[j][2] * v[j][2] + v[j][3] * v[j][3]); }
        const float rstd = rsqrtf(wave_sum(s) * (1.f / D) + EPS);
        f32x4* x1 = (f32x4*)(X1 + (size_t)r * D) + lane; u32x2* o = (u32x2*)(H + (size_t)r * D) + lane;
#pragma unroll
        for (int j = 0; j < 4; ++j) { const int c = 4 * lane + 256 * j; x1[64 * j] = v[j];
            const f32x4 w = *(const f32x4*)(a.in[I_NFFN] + c), sh = mod4(mod, a.in[I_BADA], ci_, 3072 + c), scv = mod4(mod, a.in[I_BADA], ci_, 4096 + c);
            const f32x4 y = v[j] * rstd * w * (scv + 1.f) + sh; u32x2 p; p.x = cvt_pk_bf16(y[0], y[1]); p.y = cvt_pk_bf16(y[2], y[3]); o[64 * j] = p; }
    }
}
__device__ __forceinline__ void phase9(const Args& a, int wv, int vcu, int G) {
    const int tid_ = otid(wv); const int lane = tid_ & 63, wave = tid_ >> 6; const int gw = vcu * 8 + wave, NGW = G * 8;
    const float* mod = (const float*)(a.ws + WS_MOD); const float* X1 = (const float*)(a.ws + WS_X1);
    const bf16_t* P0 = (const bf16_t*)(a.ws + WS_P0); const bf16_t* P1 = (const bf16_t*)(a.ws + WS_P1B);
    for (int r = gw; r < MTOK; r += NGW) {
        const f32x4* xr = (const f32x4*)(X1 + (size_t)r * D) + lane; const int ci_ = cond_of_row(r);
        const u32x2* p0 = (const u32x2*)(P0 + (size_t)r * D) + lane; const u32x2* p1 = (const u32x2*)(P1 + (size_t)r * D) + lane;
        f32x4 v[4]; float s = 0.f;
#pragma unroll
        for (int j = 0; j < 4; ++j) { const int c = 4 * lane + 256 * j; const f32x4 gt = mod4(mod, a.in[I_BADA], ci_, 5120 + c);
            { const u32x2 qa = p0[64 * j], qb = p1[64 * j]; const f32x4 ps = {bflo(qa.x) + bflo(qb.x), bfhi(qa.x) + bfhi(qb.x), bflo(qa.y) + bflo(qb.y), bfhi(qa.y) + bfhi(qb.y)}; v[j] = xr[64 * j] + gt * ps; } s += (v[j][0] * v[j][0] + v[j][1] * v[j][1]) + (v[j][2] * v[j][2] + v[j][3] * v[j][3]); }
        const float rstd = rsqrtf(wave_sum(s) * (1.f / D) + EPS);
        f32x4* y = (f32x4*)(a.out + O_Y + (size_t)r * D) + lane;
#pragma unroll
        for (int j = 0; j < 4; ++j) { const int c = 4 * lane + 256 * j; const f32x4 w = *(const f32x4*)(a.in[I_FN] + c); y[64 * j] = v[j] * rstd * w; }
    }
}

__device__ __forceinline__ void p3_row_extras(const Args& a, int wv, int gw, int NGW) {
    const int lane = otid(wv) & 63;
    const bf16_t* Z = (const bf16_t*)(a.ws + WS_Z); const float* rsskv = (const float*)(a.ws + WS_RSSKV);
    bf16_t* Kp = (bf16_t*)(a.ws + WS_KP); bf16_t* Ks = (bf16_t*)(a.ws + WS_KS);
    const float inv[8] = {1.f, 0.316227766f, 0.1f, 0.0316227766f, 0.01f, 0.00316227766f, 0.001f, 0.000316227766f};
    for (int r = gw; r < MTOK + 512; r += NGW) {
        if (r < MTOK) {
            const bf16_t* zr = Z + (size_t)r * ZP;
            if (r < MP) {
                const float rs = rsqrtf(pg8::rss_kv(rsskv, r) * (1.f / 256.f) + EPS);
                const u32x2 w = *(const u32x2*)(zr + C_KVLAT + 4 * lane); const f32x4 g = *(const f32x4*)(a.in[I_KVN] + 4 * lane);
                f32x4 o; o[0] = bflo(w.x) * rs * g[0]; o[1] = bfhi(w.x) * rs * g[1]; o[2] = bflo(w.y) * rs * g[2]; o[3] = bfhi(w.y) * rs * g[3];
                *(f32x4*)(a.out + O_KV + (size_t)r * 256 + 4 * lane) = o;
            }
            const int i = lane & 31;
            float v = bf2f(zr[C_KROPE + i]);
            if (r < MP && lane < 32) a.out[O_KR + (size_t)r * 32 + i] = v;
            const float pv = __shfl_xor(v, 8);
            int b, s; bf16_t* kb;
            if (r >= MP) { const int t = (r - MP) & 2047; const float pos = (float)((i < 16) ? (t >> 6) : (t & 63));
                const float rev = pos * inv[i & 7] * 0.15915494309189535f; const float rf = rev - floorf(rev);
                const float cs = __builtin_amdgcn_cosf(rf), sn = __builtin_amdgcn_sinf(rf); v = v * cs + ((i & 8) ? pv : -pv) * sn;
                b = (r - MP) >> 11; s = 256 + t; kb = Ks + ((size_t)(b * 8) * SKS + s) * 96 + 64 + i;
                const bf16_t o = f2bf(v);
                if (lane < 32) { for (int h = 0; h < 8; ++h) kb[(size_t)h * SKS * 96] = o; }
            } else { b = r >> 8; s = r & 255; kb = Kp + ((size_t)(b * 8) * 256 + s) * 96 + 64 + i; const bf16_t o = f2bf(v);
                if (lane < 32) { for (int h = 0; h < 8; ++h) kb[(size_t)h * 256 * 96] = o; } }
        } else {
            const int rr = r - MTOK, b = rr >> 8, s = rr & 255, i = lane & 31;
            const bf16_t o = f2bf(a.in[I_CKR][(size_t)rr * 32 + i]); bf16_t* kb = Ks + ((size_t)(b * 8) * SKS + s) * 96 + 64 + i;
            if (lane < 32) { for (int h = 0; h < 8; ++h) kb[(size_t)h * SKS * 96] = o; }
        }
    }
}

constexpr int GL_LOW = 0, GL_WG = 8192, GL_BG = 16384, GL_SEG = 16896, GL_RED = 20992, GL_VT = 22528, GL_QF = 40960, GL_KF = GL_QF + 9216, GL_QB = GL_KF + 9216, GL_KB = GL_QB + 9216;
constexpr int GROW = 144;

__device__ __forceinline__ void gla_gates(const Args& a, int wv, LAS unsigned char* lds, int r0, int h, float (&cumF)[8], float (&cumB)[8], float& totF, float& totB) {
    const int tid = otid(wv), d = tid & 63, tg = tid >> 6;
    const bf16_t* Z = (const bf16_t*)(a.ws + WS_Z);
    LAS float* low = (LAS float*)(lds + GL_LOW); LAS float* wg = (LAS float*)(lds + GL_WG); LAS float* bg = (LAS float*)(lds + GL_BG); LAS float* seg = (LAS float*)(lds + GL_SEG);
    { const int t = tid >> 3, r4 = (tid & 7) * 4; const u32x2 w = *(const u32x2*)(Z + (size_t)(r0 + t) * ZP + C_GFL + r4);
      low[t * 32 + r4] = bflo(w.x); low[t * 32 + r4 + 1] = bfhi(w.x); low[t * 32 + r4 + 2] = bflo(w.y); low[t * 32 + r4 + 3] = bfhi(w.y); }
    { const int dir = tid >> 8, r = (tid >> 4) & 15, d4 = (tid & 15) * 4; const f32x4 w = *(const f32x4*)(a.in[dir ? I_WGB : I_WGF] + r * 256 + h * 64 + d4);
      *(LAS f32x4*)(wg + (dir * 16 + r) * 64 + d4) = w; }
    if (tid < 128) { const int dir = tid >> 6; bg[tid] = a.in[dir ? I_BGB : I_BGF][h * 64 + (tid & 63)]; }
    __syncthreads();
    float wf[16], wb[16];
#pragma unroll
    for (int r = 0; r < 16; ++r) { wf[r] = wg[r * 64 + d]; wb[r] = wg[(16 + r) * 64 + d]; }
    const float bf_ = bg[d], bb_ = bg[64 + d];
    float gf[8], gb[8];
#pragma unroll
    for (int i = 0; i < 8; ++i) { const int t = tg * 8 + i; float xf = bf_, xb = bb_;
#pragma unroll
        for (int r = 0; r < 16; ++r) { xf += low[t * 32 + r] * wf[r]; xb += low[t * 32 + 16 + r] * wb[r]; }
        gf[i] = logsigmoid_f(xf) * (1.f / 16.f); gb[i] = logsigmoid_f(xb) * (1.f / 16.f); }
#pragma unroll
    for (int i = 1; i < 8; ++i) gf[i] += gf[i - 1];
#pragma unroll
    for (int i = 6; i >= 0; --i) gb[i] += gb[i + 1];
    seg[tg * 64 + d] = gf[7]; seg[512 + tg * 64 + d] = gb[0];
    __syncthreads();
    float offF = 0.f, offB = 0.f; totF = 0.f; totB = 0.f;
#pragma unroll
    for (int g = 0; g < 8; ++g) { const float sf = seg[g * 64 + d], sb = seg[512 + g * 64 + d]; totF += sf; totB += sb; if (g < tg) offF += sf; if (g > tg) offB += sb; }
#pragma unroll
    for (int i = 0; i < 8; ++i) { cumF[i] = gf[i] + offF; cumB[i] = gb[i] + offB; }
}
__device__ __forceinline__ void gla_load_vT(const Args& a, int wv, LAS unsigned char* lds, int r0, int h) {
    const int tid = otid(wv), e = tid & 127, tq = tid >> 7;
    const bf16_t* Z = (const bf16_t*)(a.ws + WS_Z) + (size_t)r0 * ZP + C_GV + h * 128 + e;
    unsigned w[8];
#pragma unroll
    for (int i = 0; i < 8; ++i) { const unsigned lo = Z[(size_t)(tq * 16 + 2 * i) * ZP], hi = Z[(size_t)(tq * 16 + 2 * i + 1) * ZP]; w[i] = lo | (hi << 16); }
    LAS u32x4* p = (LAS u32x4*)(lds + GL_VT + e * GROW + tq * 32);
    p[0] = (u32x4){w[0], w[1], w[2], w[3]}; p[1] = (u32x4){w[4], w[5], w[6], w[7]};
}

__device__ __forceinline__ void gla_stepA(const Args& a, int wv, LAS unsigned char* lds, int u) {
    const int tid = otid(wv), lane = tid & 63, wave = __builtin_amdgcn_readfirstlane(tid >> 6), d = tid & 63, tg = tid >> 6, fr = lane & 15, fq = lane >> 4;
    const int cgi = u >> 2, h = u & 3, r0 = cgi * 64;
    const bf16_t* Z = (const bf16_t*)(a.ws + WS_Z);
    float cumF[8], cumB[8], totF, totB;
    gla_gates(a, wv, lds, r0, h, cumF, cumB, totF, totB);
    unsigned kf[4], kb[4];
#pragma unroll
    for (int i = 0; i < 4; ++i) { const float k0 = bf2f(Z[(size_t)(r0 + tg * 8 + 2 * i) * ZP + C_GK + h * 64 + d]), k1 = bf2f(Z[(size_t)(r0 + tg * 8 + 2 * i + 1) * ZP + C_GK + h * 64 + d]);
        kf[i] = cvt_pk_bf16(k0 * __expf(totF - cumF[2 * i]), k1 * __expf(totF - cumF[2 * i + 1]));
        kb[i] = cvt_pk_bf16(k0 * __expf(totB - cumB[2 * i]), k1 * __expf(totB - cumB[2 * i + 1])); }
    *(LAS u32x4*)(lds + GL_QF + d * GROW + tg * 16) = (u32x4){kf[0], kf[1], kf[2], kf[3]};
    *(LAS u32x4*)(lds + GL_KF + d * GROW + tg * 16) = (u32x4){kb[0], kb[1], kb[2], kb[3]};
    gla_load_vT(a, wv, lds, r0, h);
    if (tg == 0) { float* dec = (float*)(a.ws + WS_DEC) + (size_t)u * 128; dec[d] = __expf(totF); dec[64 + d] = __expf(totB); }
    __syncthreads();
    const int dir = wave >> 2, eb0 = 2 * (wave & 3);
    const LAS unsigned char* kd = lds + (dir ? GL_KF : GL_QF);
    float* CT = (float*)(a.ws + WS_CT) + ((size_t)u * 2 + dir) * 8192;
#pragma unroll
    for (int eb = 0; eb < 2; ++eb) {
        bf16x8 vf[2];
#pragma unroll
        for (int ks = 0; ks < 2; ++ks) vf[ks] = *(const LAS bf16x8*)(lds + GL_VT + (16 * (eb0 + eb) + fr) * GROW + (32 * ks + 8 * fq) * 2);
#pragma unroll
        for (int db = 0; db < 4; ++db) { f32x4 c = {0.f, 0.f, 0.f, 0.f};
#pragma unroll
            for (int ks = 0; ks < 2; ++ks) { const bf16x8 kfr = *(const LAS bf16x8*)(kd + (16 * db + fr) * GROW + (32 * ks + 8 * fq) * 2); c = __builtin_amdgcn_mfma_f32_16x16x32_bf16(vf[ks], kfr, c, 0, 0, 0); }
#pragma unroll
            for (int j = 0; j < 4; ++j) CT[(16 * (eb0 + eb) + 4 * fq + j) * 64 + 16 * db + fr] = c[j]; }
    }
    __syncthreads();
}

__device__ __forceinline__ void gla_scan(const Args& a, int wv, int vcu, int G) {
    const int gt = vcu * 512 + otid(wv), NT = G * 512;
    float* CTb = (float*)(a.ws + WS_CT); const float* DEC = (const float*)(a.ws + WS_DEC);
    for (int it = gt; it < 32768 + 262144; it += NT) {
        int seq, N, cg0, x;
        if (it < 32768) { seq = 16 + (it >> 14); x = it & 16383; N = 32; cg0 = 64 + 32 * (seq - 16); } else { const int j = it - 32768; seq = j >> 14; x = j & 16383; N = 4; cg0 = 4 * seq; }
        const int h = x >> 12, dir = (x >> 11) & 1, e = (x >> 4) & 127, d4 = (x & 15) * 4;
        f32x4 st = {0.f, 0.f, 0.f, 0.f};
        if (seq >= 16) { const float* s0 = a.in[dir ? I_SB : I_SF] + ((size_t)((seq - 16) * 4 + h) * 64) * 128 + e;
#pragma unroll
            for (int i = 0; i < 4; ++i) st[i] = s0[(size_t)(d4 + i) * 128]; }
        if (N == 32) {
            for (int n0 = 0; n0 < 32; n0 += 8) {
                f32x4 c[8], dc[8];
#pragma unroll
                for (int i = 0; i < 8; ++i) { const int n = dir ? (31 - n0 - i) : (n0 + i); const int u = (cg0 + n) * 4 + h;
                    c[i] = *(const f32x4*)(CTb + ((size_t)u * 2 + dir) * 8192 + e * 64 + d4); dc[i] = *(const f32x4*)(DEC + (size_t)u * 128 + dir * 64 + d4); }
#pragma unroll
                for (int i = 0; i < 8; ++i) { const int n = dir ? (31 - n0 - i) : (n0 + i); const int u = (cg0 + n) * 4 + h;
                    *(f32x4*)(CTb + ((size_t)u * 2 + dir) * 8192 + e * 64 + d4) = st; st = dc[i] * st + c[i]; }
            }
        } else {
            f32x4 c[4], dc[4];
#pragma unroll
            for (int i = 0; i < 4; ++i) { const int n = dir ? (3 - i) : i; const int u = (cg0 + n) * 4 + h;
                c[i] = *(const f32x4*)(CTb + ((size_t)u * 2 + dir) * 8192 + e * 64 + d4); dc[i] = *(const f32x4*)(DEC + (size_t)u * 128 + dir * 64 + d4); }
#pragma unroll
            for (int i = 0; i < 4; ++i) { const int n = dir ? (3 - i) : i; const int u = (cg0 + n) * 4 + h;
                *(f32x4*)(CTb + ((size_t)u * 2 + dir) * 8192 + e * 64 + d4) = st; st = dc[i] * st + c[i]; }
        }
        if (seq < 16) { float* o = a.out + (dir ? O_SB : O_SF) + ((size_t)(seq * 4 + h) * 64) * 128 + e;
#pragma unroll
            for (int i = 0; i < 4; ++i) o[(size_t)(d4 + i) * 128] = st[i]; }
    }
}

__device__ __forceinline__ void gla_stepC(const Args& a, int wv, LAS unsigned char* lds, int u) {
    const int tid = otid(wv), lane = tid & 63, wave = __builtin_amdgcn_readfirstlane(tid >> 6), d = tid & 63, tg = tid >> 6, fr = lane & 15, fq = lane >> 4;
    const int cgi = u >> 2, h = u & 3, r0 = cgi * 64;
    const bf16_t* Z = (const bf16_t*)(a.ws + WS_Z);
    float cumF[8], cumB[8], totF, totB;
    gla_gates(a, wv, lds, r0, h, cumF, cumB, totF, totB);
#pragma unroll
    for (int i = 0; i < 8; ++i) { const int t = tg * 8 + i; const float q = bf2f(Z[(size_t)(r0 + t) * ZP + C_GQ + h * 64 + d]) * 0.125f, k = bf2f(Z[(size_t)(r0 + t) * ZP + C_GK + h * 64 + d]);
        *(LAS bf16_t*)(lds + GL_QF + t * GROW + d * 2) = f2bf(q * __expf(cumF[i]));
        *(LAS bf16_t*)(lds + GL_KF + t * GROW + d * 2) = f2bf(k * __expf(-cumF[i]));
        *(LAS bf16_t*)(lds + GL_QB + t * GROW + d * 2) = f2bf(q * __expf(cumB[i]));
        *(LAS bf16_t*)(lds + GL_KB + t * GROW + d * 2) = f2bf(k * __expf(-cumB[i])); }
    gla_load_vT(a, wv, lds, r0, h);
    __syncthreads();
    const int ch = wave & 1, eq = wave >> 1;
    f32x4 oT[2][2];
#pragma unroll
    for (int i = 0; i < 2; ++i)
#pragma unroll
        for (int j = 0; j < 2; ++j) oT[i][j] = (f32x4){0.f, 0.f, 0.f, 0.f};
#pragma unroll
    for (int dir = 0; dir < 2; ++dir) {
        const LAS unsigned char* qe = lds + (dir ? GL_QB : GL_QF); const LAS unsigned char* ke = lds + (dir ? GL_KB : GL_KF);
        const float* ST = (const float*)(a.ws + WS_CT) + ((size_t)u * 2 + dir) * 8192;
        bf16x8 sf[2][2];
#pragma unroll
        for (int eb = 0; eb < 2; ++eb)
#pragma unroll
            for (int ks = 0; ks < 2; ++ks) { const float* p = ST + (16 * (2 * eq + eb) + fr) * 64 + 32 * ks + 8 * fq; const f32x4 x0 = *(const f32x4*)p, x1 = *(const f32x4*)(p + 4);
                u32x4 w; w.x = cvt_pk_bf16(x0[0], x0[1]); w.y = cvt_pk_bf16(x0[2], x0[3]); w.z = cvt_pk_bf16(x1[0], x1[1]); w.w = cvt_pk_bf16(x1[2], x1[3]); sf[eb][ks] = __builtin_bit_cast(bf16x8, w); }
#pragma unroll
        for (int cb = 0; cb < 2; ++cb) {
            const int cbg = 2 * ch + cb;
            bf16x8 qf[2];
#pragma unroll
            for (int ks = 0; ks < 2; ++ks) qf[ks] = *(const LAS bf16x8*)(qe + (16 * cbg + fr) * GROW + (32 * ks + 8 * fq) * 2);
            f32x4 att[4];
#pragma unroll
            for (int sb = 0; sb < 4; ++sb) {
                f32x4 acc = {0.f, 0.f, 0.f, 0.f};
                const bool need = dir == 0 ? (sb <= cbg) : (sb >= cbg);
                if (need) {
#pragma unroll
                    for (int ks = 0; ks < 2; ++ks) { const bf16x8 kfr = *(const LAS bf16x8*)(ke + (16 * sb + fr) * GROW + (32 * ks + 8 * fq) * 2); acc = __builtin_amdgcn_mfma_f32_16x16x32_bf16(kfr, qf[ks], acc, 0, 0, 0); }
                    if (sb == cbg) {
#pragma unroll
                        for (int j = 0; j < 4; ++j) { const int sl = 4 * fq + j; const bool keep = dir == 0 ? (sl <= fr) : (sl >= fr); acc[j] = keep ? acc[j] : 0.f; } }
                }
                att[sb] = acc;
            }
#pragma unroll
            for (int kp = 0; kp < 2; ++kp) {
                u32x4 w; w.x = cvt_pk_bf16(att[2 * kp][0], att[2 * kp][1]); w.y = cvt_pk_bf16(att[2 * kp][2], att[2 * kp][3]); w.z = cvt_pk_bf16(att[2 * kp + 1][0], att[2 * kp + 1][1]); w.w = cvt_pk_bf16(att[2 * kp + 1][2], att[2 * kp + 1][3]);
                const bf16x8 pb = __builtin_bit_cast(bf16x8, w);
#pragma unroll
                for (int eb = 0; eb < 2; ++eb) { const LAS unsigned char* vp = lds + GL_VT + (16 * (2 * eq + eb) + fr) * GROW + (32 * kp + 4 * fq) * 2;
                    const u32x2 v0 = *(const LAS u32x2*)vp, v1 = *(const LAS u32x2*)(vp + 32); const u32x4 vv = {v0.x, v0.y, v1.x, v1.y};
                    oT[eb][cb] = __builtin_amdgcn_mfma_f32_16x16x32_bf16(__builtin_bit_cast(bf16x8, vv), pb, oT[eb][cb], 0, 0, 0); }
            }
#pragma unroll
            for (int ks = 0; ks < 2; ++ks)
#pragma unroll
                for (int eb = 0; eb < 2; ++eb) oT[eb][cb] = __builtin_amdgcn_mfma_f32_16x16x32_bf16(sf[eb][ks], qf[ks], oT[eb][cb], 0, 0, 0);
        }
    }
    LAS float* red = (LAS float*)(lds + GL_RED);
#pragma unroll
    for (int cb = 0; cb < 2; ++cb) { float s = 0.f;
#pragma unroll
        for (int eb = 0; eb < 2; ++eb)
#pragma unroll
            for (int j = 0; j < 4; ++j) s += oT[eb][cb][j] * oT[eb][cb][j];
        s += __shfl_xor(s, 16); s += __shfl_xor(s, 32);
        if (fq == 0) red[eq * 64 + 16 * (2 * ch + cb) + fr] = s; }
    __syncthreads();
    bf16_t* MIX = (bf16_t*)(a.ws + WS_MIX);
#pragma unroll
    for (int cb = 0; cb < 2; ++cb) { const int c = 16 * (2 * ch + cb) + fr; const float tot = red[c] + red[64 + c] + red[128 + c] + red[192 + c]; const float rstd = rsqrtf(tot * (1.f / 128.f) + EPS);
#pragma unroll
        for (int eb = 0; eb < 2; ++eb) { const int e = 16 * (2 * eq + eb) + 4 * fq; const f32x4 gn = *(const f32x4*)(a.in[I_GLAN] + e);
            const u32x2 gw = *(const u32x2*)(Z + (size_t)(r0 + c) * ZP + C_GOUT + h * 128 + e);
            const float g0 = bflo(gw.x), g1 = bfhi(gw.x), g2 = bflo(gw.y), g3 = bfhi(gw.y);
            const f32x4 o = oT[eb][cb] * rstd * gn; u32x2 w; w.x = cvt_pk_bf16(o[0] * silu_f(g0), o[1] * silu_f(g1)); w.y = cvt_pk_bf16(o[2] * silu_f(g2), o[3] * silu_f(g3));
            *(u32x2*)(MIX + (size_t)(r0 + c) * D + 512 + h * 128 + e) = w; } }
    __syncthreads();
}

constexpr int AT_KROW = 208, AT_VROW = 144, AT_KB = 64 * AT_KROW  , AT_STAGE = AT_KB + 64 * AT_VROW  ;
__device__ __forceinline__ void attn_unit(const Args& a, int wv, LAS unsigned char* lds, int idx) {
    const int tid = otid(wv), lane = tid & 63, wave = __builtin_amdgcn_readfirstlane(tid >> 6), fr = lane & 15, fq = lane >> 4;
    int row0, S, nt; const bf16_t* Kb; const bf16_t* Vb; int h;
    if (idx < 256) { const int b = idx >> 7, qb = idx & 15; h = (idx >> 4) & 7; row0 = MP + b * 2048 + qb * 128; S = SKS; nt = 36;
        Kb = (const bf16_t*)(a.ws + WS_KS) + (size_t)(b * 8 + h) * SKS * 96; Vb = (const bf16_t*)(a.ws + WS_VTS) + (size_t)(b * 8 + h) * 64 * SKS; }
    else { const int j = idx - 256; const int b = j >> 4, qb = j & 1; h = (j >> 1) & 7; row0 = b * 256 + qb * 128; S = 256; nt = 4;
        Kb = (const bf16_t*)(a.ws + WS_KP) + (size_t)(b * 8 + h) * 256 * 96; Vb = (const bf16_t*)(a.ws + WS_VTP) + (size_t)(b * 8 + h) * 64 * 256; }
    const char* src[3]; unsigned step[3]; unsigned dst[3]; bool valid[3];
#pragma unroll
    for (int j = 0; j < 3; ++j) { const int ins = wave + 8 * j; valid[j] = ins < 22;
        if (ins < 13) { const int ck = ins * 64 + lane, r = ck / 13, cc = ck % 13; src[j] = (const char*)Kb + (size_t)r * 192 + (cc < 12 ? cc : 11) * 16; step[j] = 64 * 192; dst[j] = ins * 1024; }
        else { const int cv = (ins - 13) * 64 + lane, r = cv / 9, cc = cv % 9; src[j] = (const char*)Vb + (size_t)r * S * 2 + (cc < 8 ? cc : 7) * 16; step[j] = 128; dst[j] = AT_KB + (ins - 13) * 1024; } }
#define AT_ISSUE(t, buf) do { _Pragma("unroll") for (int j = 0; j < 3; ++j) if (valid[j]) \
        __builtin_amdgcn_global_load_lds((const unsigned*)(src[j] + (size_t)(t) * step[j]), (LAS unsigned*)(lds + (buf) * AT_STAGE + dst[j]), 16, 0, 0); } while (0)
    AT_ISSUE(0, 0);
    const bf16_t* Q = (const bf16_t*)(a.ws + WS_Q) + (size_t)(row0 + wave * 16 + fr) * 768 + h * 96 + 8 * fq;
    bf16x8 qf[3];
#pragma unroll
    for (int ks = 0; ks < 3; ++ks) qf[ks] = *(const bf16x8*)(Q + 32 * ks);
    float mrun = -1e30f, lsum = 0.f;
    f32x4 o[4];
#pragma unroll
    for (int i = 0; i < 4; ++i) o[i] = (f32x4){0.f, 0.f, 0.f, 0.f};
    for (int t = 0; t < nt; ++t) {
        VM_WAIT(); __syncthreads();
        if (t + 1 < nt) AT_ISSUE(t + 1, (t + 1) & 1);
        const LAS unsigned char* kt = lds + (t & 1) * AT_STAGE; const LAS unsigned char* vt = kt + AT_KB;
        f32x4 s[4];
#pragma unroll
        for (int kb = 0; kb < 4; ++kb) { s[kb] = (f32x4){0.f, 0.f, 0.f, 0.f};
#pragma unroll
            for (int ks = 0; ks < 3; ++ks) { const bf16x8 kf = *(const LAS bf16x8*)(kt + (16 * kb + fr) * AT_KROW + (32 * ks + 8 * fq) * 2); s[kb] = __builtin_amdgcn_mfma_f32_16x16x32_bf16(kf, qf[ks], s[kb], 0, 0, 0); } }
        float mx = fmaxf(fmaxf(fmaxf(s[0][0], s[0][1]), fmaxf(s[0][2], s[0][3])), fmaxf(fmaxf(s[1][0], s[1][1]), fmaxf(s[1][2], s[1][3])));
        mx = fmaxf(mx, fmaxf(fmaxf(fmaxf(s[2][0], s[2][1]), fmaxf(s[2][2], s[2][3])), fmaxf(fmaxf(s[3][0], s[3][1]), fmaxf(s[3][2], s[3][3]))));
        mx = fmaxf(mx, __shfl_xor(mx, 16)); mx = fmaxf(mx, __shfl_xor(mx, 32));
        const float mnew = fmaxf(mrun, mx); const float alpha = __builtin_amdgcn_exp2f(mrun - mnew); mrun = mnew;
        float ps = 0.f;
#pragma unroll
        for (int kb = 0; kb < 4; ++kb)
#pragma unroll
            for (int j = 0; j < 4; ++j) { s[kb][j] = __builtin_amdgcn_exp2f(s[kb][j] - mnew); ps += s[kb][j]; }
        lsum = lsum * alpha + ps;
#pragma unroll
        for (int i = 0; i < 4; ++i) o[i] = o[i] * alpha;
#pragma unroll
        for (int kp = 0; kp < 2; ++kp) {
            u32x4 w; w.x = cvt_pk_bf16(s[2 * kp][0], s[2 * kp][1]); w.y = cvt_pk_bf16(s[2 * kp][2], s[2 * kp][3]); w.z = cvt_pk_bf16(s[2 * kp + 1][0], s[2 * kp + 1][1]); w.w = cvt_pk_bf16(s[2 * kp + 1][2], s[2 * kp + 1][3]);
            const bf16x8 pb = __builtin_bit_cast(bf16x8, w);
#pragma unroll
            for (int mb = 0; mb < 4; ++mb) { const LAS unsigned char* vp = vt + (16 * mb + fr) * AT_VROW + (32 * kp + 4 * fq) * 2;
                const u32x2 v0 = *(const LAS u32x2*)vp, v1 = *(const LAS u32x2*)(vp + 32); const u32x4 vv = {v0.x, v0.y, v1.x, v1.y};
                o[mb] = __builtin_amdgcn_mfma_f32_16x16x32_bf16(__builtin_bit_cast(bf16x8, vv), pb, o[mb], 0, 0, 0); }
        }
    }
    lsum += __shfl_xor(lsum, 16); lsum += __shfl_xor(lsum, 32);
    const float il = fast_rcp(lsum);
    bf16_t* MIX = (bf16_t*)(a.ws + WS_MIX) + (size_t)(row0 + wave * 16 + fr) * D + h * 64 + 4 * fq;
#pragma unroll
    for (int mb = 0; mb < 4; ++mb) { u32x2 w; w.x = cvt_pk_bf16(o[mb][0] * il, o[mb][1] * il); w.y = cvt_pk_bf16(o[mb][2] * il, o[mb][3] * il); *(u32x2*)(MIX + 16 * mb) = w; }
    __syncthreads();
#undef AT_ISSUE
}

__device__ unsigned g_bar[64 * 52];
#define GB(i) (g_bar + 64 * (i))
__device__ __forceinline__ unsigned gb_ld(unsigned* p) { return __hip_atomic_load(p, __ATOMIC_RELAXED, __HIP_MEMORY_SCOPE_AGENT); }
__device__ __forceinline__ unsigned gb_add(unsigned* p, unsigned v) { return __hip_atomic_fetch_add(p, v, __ATOMIC_RELAXED, __HIP_MEMORY_SCOPE_AGENT); }
__device__ __forceinline__ unsigned xcc_id() { return (unsigned)__builtin_amdgcn_s_getreg((3 << 11) | 20) & 0xFu; }
__device__ __forceinline__ void my_grid_barrier(unsigned nth, unsigned G, int tid, LAS unsigned* st) {
    asm volatile("s_waitcnt vmcnt(0) lgkmcnt(0)" ::: "memory");
    __syncthreads();
    if (tid == 0) {
        if (nth == 1u) {
            const unsigned x = xcc_id(); unsigned sum, cnt, mine;
            for (;;) { sum = 0u; cnt = 0u; mine = 0u;
#pragma unroll
                for (unsigned j = 0; j < 16; ++j) { const unsigned c = gb_ld(GB(4 + j)); sum += c; cnt += (c > 0u) ? 1u : 0u; mine = (j == x) ? c : mine; }
                if (sum >= G) break; __builtin_amdgcn_s_sleep(1); }
            st[0] = mine; st[1] = cnt; st[2] = x;
        }
        const unsigned nloc = st[0], nx = st[1], x = st[2];
        const unsigned old = gb_add(GB(20 + x), 1u);
        if (old + 1u == nth * nloc) {
            __builtin_amdgcn_fence(__ATOMIC_RELEASE, "agent");
            asm volatile("s_waitcnt vmcnt(0)" ::: "memory");
            const unsigned og = gb_add(GB(1), 1u);
            if (og + 1u == nth * nx) gb_add(GB(2), 1u);
            else while (gb_ld(GB(2)) < nth) __builtin_amdgcn_s_sleep(1);
            __builtin_amdgcn_fence(__ATOMIC_ACQUIRE, "agent");
            gb_add(GB(36 + x), 1u);
            asm volatile("s_waitcnt vmcnt(0)" ::: "memory");
        } else {
            while (gb_ld(GB(36 + x)) < nth) __builtin_amdgcn_s_sleep(1);
            __builtin_amdgcn_fence(__ATOMIC_ACQUIRE, "agent");
            asm volatile("s_waitcnt vmcnt(0)" ::: "memory");
        }
    }
    __syncthreads();
}
__device__ __forceinline__ void my_grid_barrier_finish(unsigned G, int tid) {
    if (tid == 0) {
        const unsigned old = gb_add(GB(0), 1u);
        if (old == G - 1u) { for (int i = 0; i < 52; ++i) __hip_atomic_store(GB(i), 0u, __ATOMIC_RELAXED, __HIP_MEMORY_SCOPE_AGENT); }
    }
}
constexpr int NPHASE = 11;
__global__ void __launch_bounds__(512, 2) mk_fwd(Args a) {
    const int wv = __builtin_amdgcn_readfirstlane((int)threadIdx.x >> 6);
    extern __shared__ __attribute__((aligned(16))) unsigned char lds_raw[];
    LAS unsigned char* lds = (LAS unsigned char*)lds_raw;
    const int G = gridDim.x, bx = blockIdx.x;
    const int vcu = (G % 8 == 0) ? (bx % 8) * (G / 8) + bx / 8 : bx;
    unsigned char* ws = a.ws;
    const int lo = a.ph_lo, hi = a.ph_hi;
#ifndef PHMASK
#define PHMASK 0x7ff
#endif
#define IN(k) (((PHMASK >> (k)) & 1) && lo <= (k) && (k) < hi)
#define SEAM(k) do { if (IN(k) && IN((k) + 1)) { ++nbar; my_grid_barrier(nbar, (unsigned)G, otid(wv), (LAS unsigned*)(lds + LDS_BYTES - 64)); } } while (0)
#ifndef PROBE_FILL
#define PROBE_FILL 0
#endif
    if (PROBE_FILL && lo == 0) { f32x4* p = (f32x4*)a.ws; const size_t n = (size_t)(PROBE_FILL_MIB) << 16; const float fv = PROBE_FILL_VAL;
        for (size_t i = (size_t)bx * 512 + threadIdx.x; i < n; i += (size_t)G * 512) { unsigned h = (unsigned)i * 2654435761u; h ^= h >> 15; h *= 2246822519u; h ^= h >> 13; const float r0 = (float)(h & 0xffff) * (1.f / 65536.f) - 0.5f + fv * 0.f; p[i] = (f32x4){r0, r0 * 1.7f, r0 * -0.3f, r0 + 0.1f}; } }
    if (PROBE_FILL == 2 && lo == 0 && bx == 0) { static const int szs[26] = {4194304, 4194304, 131072, 16384, 65536, 65536, 2048, 1024, 6291456, 6144, 1024, 2293760, 384, 294912, 256, 262144, 4096, 256, 4096, 256, 128, 1048576, 1024, 5767168, 2883584, 1024};
        float sm = 0.f; for (int i = 0; i < 26; ++i) { const int n = szs[i]; const int st = n > 1024 ? n - 1024 : 0; for (int j = st + (int)threadIdx.x; j < n; j += 512) sm += a.in[i][j]; for (int j = threadIdx.x; j < (n < 1024 ? n : 1024); j += 512) sm += a.in[i][j]; }
        ((float*)(a.ws))[threadIdx.x] = sm; }
    if (PROBE_FILL == 5 && lo == 0) { volatile float* p = (volatile float*)a.ws; const float big = p[0] * 0.f + 1e38f, tiny = p[1] * 0.f + 1e-38f, zero = p[2] * 0.f, neg = p[3] * 0.f - 1.f;
        float r = 0.f;
#if PROBE_EXC & 1
        r += big * big;
#endif
#if PROBE_EXC & 2
        r += tiny * tiny;
#endif
#if PROBE_EXC & 4
        r += 1.f / zero;
#endif
#if PROBE_EXC & 8
        r += __builtin_sqrtf(neg);
#endif
        p[4 + bx] = r; }
    unsigned nbar = 0;
    if (otid(wv) == 0) gb_add(GB(4 + xcc_id()), 1u);
    if (IN(0)) { for (int rep = 0; rep < PROBE_P0_REP; ++rep) { phase0(a, wv, lds, vcu, G); __syncthreads(); } } SEAM(0);
    if (IN(1)) { for (int rep = 0; rep < PROBE_ROW_REP; ++rep) phase1(a, wv, vcu, G); } SEAM(1);
    if (PROBE_HANG && lo == 1) { volatile unsigned* q = (volatile unsigned*)(a.ws + 8); while (*q != 0x12345678u) __builtin_amdgcn_s_sleep(20); }
    if (IN(2)) {
        pg8::Gemm g{(const bf16_t*)(ws + WS_H), (const bf16_t*)(ws + WS_WIN), D, D, D, wv}; pg8::Order S; S.init(MTOK, 2048, 1, G, bx);
        pg8::EpiZ E{(bf16_t*)(ws + WS_Z), (float*)(ws + WS_RSSQ), (float*)(ws + WS_RSSKV), 0};
        pg8::gemm_phase<pg8::EpiZ, pg8::Order>(lds, g, S, E);
    } SEAM(2);
    if (IN(3)) {
#ifndef P3MASK
#define P3MASK 0x3f
#endif
#if (P3MASK >> 0) & 1
        { pg8::Gemm g{(const bf16_t*)(ws + WS_Z) + C_QLAT, (const bf16_t*)(ws + WS_WUQ), ZP, 384, 384, wv}; pg8::Order S; S.init(MTOK, 768, 1, G, bx);
          pg8::EpiQ E{(bf16_t*)(ws + WS_Q), (const float*)(ws + WS_RSSQ)}; pg8::gemm_phase<pg8::EpiQ, pg8::Order>(lds, g, S, E); }
#endif
#if (P3MASK >> 1) & 1
        { pg8::Gemm g{(const bf16_t*)(ws + WS_Z) + C_KVLAT, (const bf16_t*)(ws + WS_WKF), ZP, 256, 256, wv}; pg8::Order S; S.init(MTOK, 512, 1, G, (bx + G - 96) % G);
          pg8::EpiK E{(bf16_t*)(ws + WS_KP), (bf16_t*)(ws + WS_KS), (const float*)(ws + WS_RSSKV), 0}; pg8::gemm_phase<pg8::EpiK, pg8::Order>(lds, g, S, E); }
#endif
#if (P3MASK >> 2) & 1
        { pg8::Gemm g{(const bf16_t*)(ws + WS_WVF), (const bf16_t*)(ws + WS_Z) + C_KVLAT, 256, ZP, 256, wv}; pg8::Order S; S.init(512, MTOK, 1, G, (bx + G - 160) % G);
          pg8::EpiVt E{(bf16_t*)(ws + WS_VTP), (bf16_t*)(ws + WS_VTS), (const float*)(ws + WS_RSSKV), 0}; pg8::gemm_phase<pg8::EpiVt, pg8::Order>(lds, g, S, E); }
#endif
        { pg8::Gemm g{(const bf16_t*)(ws + WS_H), (const bf16_t*)(ws + WS_WIN) + (size_t)2048 * D, D, D, D, wv}; pg8::Order S; S.init(MTOK, 256, 1, G, (bx + G - 224) % G);
          pg8::EpiZ E{(bf16_t*)(ws + WS_Z), (float*)(ws + WS_RSSQ), (float*)(ws + WS_RSSKV), 8}; pg8::gemm_phase<pg8::EpiZ, pg8::Order>(lds, g, S, E); }
#if (P3MASK >> 3) & 1
        { pg8::Gemm g{(const bf16_t*)(ws + WS_CACHEB), (const bf16_t*)(ws + WS_WKU), 256, 256, 256, wv}; pg8::Order S; S.init(512, 512, 1, G, (bx + G - 224) % G);
          pg8::EpiK E{(bf16_t*)(ws + WS_KP), (bf16_t*)(ws + WS_KS), (const float*)(ws + WS_RSSKV), 1}; pg8::gemm_phase<pg8::EpiK, pg8::Order>(lds, g, S, E); }
#endif
#if (P3MASK >> 4) & 1
        { pg8::Gemm g{(const bf16_t*)(ws + WS_WVU), (const bf16_t*)(ws + WS_CACHEB), 256, 256, 256, wv}; pg8::Order S; S.init(512, 512, 1, G, (bx + G - 228) % G);
          pg8::EpiVt E{(bf16_t*)(ws + WS_VTP), (bf16_t*)(ws + WS_VTS), (const float*)(ws + WS_RSSKV), 1}; pg8::gemm_phase<pg8::EpiVt, pg8::Order>(lds, g, S, E); }
#endif
        __syncthreads();
        if (bx < 224) {
            for (int u = bx; u < 512; u += 224) gla_stepA(a, wv, lds, u);
            p3_row_extras(a, wv, bx * 8 + (otid(wv) >> 6), 224 * 8);
        }
    } SEAM(3);
    if (IN(4)) { gla_scan(a, wv, vcu, G); } SEAM(4);
    if (IN(5)) {
        for (int rep = 0; rep < PROBE_ATT_REP; ++rep) for (int u = vcu; u < 512; u += G) attn_unit(a, wv, lds, u);
        for (int rep = 0; rep < PROBE_GLAC_REP; ++rep) for (int u = vcu; u < 512; u += G) gla_stepC(a, wv, lds, u);
    } SEAM(5);
    if (IN(6)) {
        pg8::Gemm g{(const bf16_t*)(ws + WS_MIX), (const bf16_t*)(ws + WS_WOUT), D, D, PROBE_K6, wv}; pg8::Order S; S.init(MTOK, D, 1024 / PROBE_K6, G, bx);
        pg8::EpiPart E{(bf16_t*)(ws + WS_P0), (bf16_t*)(ws + WS_P1A)}; pg8::gemm_phase<pg8::EpiPart, pg8::Order>(lds, g, S, E);
    } SEAM(6);
    if (IN(7)) { for (int rep = 0; rep < PROBE_ROW_REP; ++rep) phase6(a, wv, vcu, G); } SEAM(7);
    if (IN(8)) {
        pg8::Gemm g{(const bf16_t*)(ws + WS_H), (const bf16_t*)(ws + WS_WFFI), D, D, D, wv}; pg8::Order S; S.init(MTOK, 2 * DFF, 1, G, bx);
        pg8::EpiFFI E{(bf16_t*)(ws + WS_HFF)}; for (int rep = 0; rep < PROBE_FFI_REP; ++rep) pg8::gemm_phase<pg8::EpiFFI, pg8::Order>(lds, g, S, E);
    } SEAM(8);
    if (IN(9)) {
        pg8::Gemm g{(const bf16_t*)(ws + WS_HFF), (const bf16_t*)(ws + WS_WFFO), DFF, DFF, DFF / 2, wv}; pg8::Order S; S.init(MTOK, D, 2, G, bx);
        pg8::EpiPart E{(bf16_t*)(ws + WS_P0), (bf16_t*)(ws + WS_P1B)}; pg8::gemm_phase<pg8::EpiPart, pg8::Order>(lds, g, S, E);
    } SEAM(9);
    if (IN(10)) { for (int rep = 0; rep < PROBE_ROW_REP; ++rep) phase9(a, wv, vcu, G); }
    if (PROBE_DUMP) {
        if (PROBE_DUMP != 5 && PROBE_DUMP != 7) { ++nbar; } if (PROBE_DUMP != 5 && PROBE_DUMP != 7) my_grid_barrier(nbar, (unsigned)G, otid(wv), (LAS unsigned*)(lds + LDS_BYTES - 64));
        const bf16_t* src = (const bf16_t*)(ws + (PROBE_DUMP == 1 ? WS_Z : PROBE_DUMP == 2 ? WS_MIX : WS_H)); const int pitch = PROBE_DUMP == 1 ? ZP : D;
        for (size_t i = (size_t)bx * 512 + otid(wv); i < (size_t)MTOK * D; i += (size_t)G * 512) { const int r = (int)(i >> 10), c = (int)(i & 1023); a.out[i] = PROBE_DUMP == 7 ? 1.0f : PROBE_DUMP == 6 ? (r < 2304 ? bf2f(((const bf16_t*)(ws + WS_WIN))[(size_t)r * 1024 + c]) : 0.f) : PROBE_DUMP >= 4 ? xrow_ptr(a, r)[c] * 2.f : bf2f(src[(size_t)r * pitch + c]); }
        for (size_t i = O_KV + (size_t)bx * 512 + otid(wv); i < 10616832; i += (size_t)G * 512) a.out[i] = 0.f;
    }
    for (int xb = 0; xb < PROBE_XBAR; ++xb) { ++nbar; my_grid_barrier(nbar, (unsigned)G, otid(wv), (LAS unsigned*)(lds + LDS_BYTES - 64)); }
    if (nbar) my_grid_barrier_finish((unsigned)G, otid(wv));
#undef IN
#undef SEAM
}

extern "C" void kernel_launch(void* const* d_in, const int* in_sizes, int n_in, void* d_out, int out_size, void* d_ws, size_t ws_size, hipStream_t stream) {
    static int grid = 0;
    if (grid == 0) {
        int dev = 0, cus = 0;
        static const int exp_sizes[26] = {4194304, 4194304, 131072, 16384, 65536, 65536, 2048, 1024, 6291456, 6144, 1024, 2293760, 384, 294912, 256, 262144, 4096, 256, 4096, 256, 128, 1048576, 1024, 5767168, 2883584, 1024};
        bool okk = (n_in == 26); for (int i = 0; okk && i < 26; ++i) okk = (in_sizes[i] == exp_sizes[i]);
        if (!okk || out_size != 10616832) { fprintf(stderr, "kernel_launch: unexpected input sizes\n"); grid = -1; return; }
        if (n_in != 26 || ws_size < 198 * MiB) { fprintf(stderr, "kernel_launch: unexpected n_in %d / ws %zu\n", n_in, ws_size); grid = -1; return; }
        hipGetDevice(&dev); hipDeviceGetAttribute(&cus, hipDeviceAttributeMultiprocessorCount, dev);
        if (hipFuncSetAttribute((const void*)mk_fwd, hipFuncAttributeMaxDynamicSharedMemorySize, LDS_BYTES) != hipSuccess) { fprintf(stderr, "kernel_launch: hipFuncSetAttribute failed\n"); grid = -1; return; }
        int per_cu = 0;
        if (hipOccupancyMaxActiveBlocksPerMultiprocessor(&per_cu, (const void*)mk_fwd, 512, LDS_BYTES) != hipSuccess || per_cu < 1) { fprintf(stderr, "kernel_launch: occupancy query says %d\n", per_cu); per_cu = 1; }
        (void)hipGetLastError();
        if (cus < 256) { fprintf(stderr, "kernel_launch: needs 256 CUs, got %d\n", cus); grid = -1; return; }
        grid = 256;
    }
    if (grid < 0) return;
    if (hipMemsetAsync((char*)d_ws + WS_BAR, 0, 4096, stream) != hipSuccess) { fprintf(stderr, "kernel_launch: memset failed\n"); return; }
    Args a{};
    for (int i = 0; i < 26; ++i) a.in[i] = (const float*)d_in[i];
    a.out = (float*)d_out; a.ws = (unsigned char*)d_ws;
#if MK_PER_PHASE_LAUNCH
    for (int p = 0; p < NPHASE; ++p) { if (PROBE_ONLY_LAUNCH >= 0 && p != PROBE_ONLY_LAUNCH) continue; a.ph_lo = p; a.ph_hi = p + 1; hipLaunchKernelGGL(mk_fwd, dim3(grid), dim3(512), LDS_BYTES, stream, a); }
#else
    a.ph_lo = 0; a.ph_hi = NPHASE;
#if MK_COOP
    void* args[] = {&a};
    hipError_t e = hipLaunchCooperativeKernel((const void*)mk_fwd, dim3(grid), dim3(512), args, LDS_BYTES, stream);
    if (e != hipSuccess) fprintf(stderr, "cooperative launch failed: %s (grid %d)\n", hipGetErrorString(e), grid);
#else
    hipLaunchKernelGGL(mk_fwd, dim3(grid), dim3(512), LDS_BYTES, stream, a);
#endif
#endif
}
```

```cpp
#include <hip/hip_runtime.h>
#include <hip/hip_cooperative_groups.h>
#include <cstdio>
#include <cstdint>
namespace cg = cooperative_groups;

#define PROBE_FILL 0
#define PROBE_EXC 0
#define PROBE_BLO 0
#define PROBE_BHI 256
#define PROBE_RSTRIDE 1
#define PROBE_REP 1
#define PROBE_XLO 0
#define PROBE_XHI 8
#define PROBE_HANG 0
#define PROBE_ATT_REP 1
#define PROBE_GLAC_REP 1
#define PROBE_FFI_REP 1
#define PROBE_XBAR 0
#define PROBE_P0_REP 1
#define PROBE_ROW_REP 1
#define PROBE_P3_REP 1
#define PROBE_DUMP 0
#define PROBE_STATS 0
#define PROBE_K6 512
#define PROBE_ONLY_LAUNCH -1
#define PROBE_NOSTORE 0
#define PROBE_FILL_MIB 256
#define PROBE_FILL_VAL 1.2345f
#ifndef PROBE_MUL
#define PROBE_MUL 1.f
#endif
#ifndef PROBE_MODOFF
#define PROBE_MODOFF 0u
#endif
#ifndef MK_COOP
#define MK_COOP 0
#endif
#ifndef MK_PER_PHASE_LAUNCH
#define MK_PER_PHASE_LAUNCH 0
#endif

#define LAS __attribute__((address_space(3)))
typedef unsigned short bf16_t;
typedef short bf16x8 __attribute__((ext_vector_type(8)));
typedef float f32x4 __attribute__((ext_vector_type(4)));
typedef float f32x2 __attribute__((ext_vector_type(2)));
typedef unsigned u32x4 __attribute__((ext_vector_type(4)));
typedef unsigned u32x2 __attribute__((ext_vector_type(2)));

constexpr int D = 1024, MTOK = 8192, MP = 4096;
constexpr int ZP = 2304;
constexpr int C_QLAT = 0, C_KVLAT = 384, C_KROPE = 640, C_GQ = 672, C_GK = 928, C_GV = 1184, C_GFL = 1696, C_GOUT = 1728;
constexpr int DFF = 2816;
constexpr float EPS = 1e-6f;
constexpr float QSCALE = 0.10206207261596577f * 1.4426950408889634f;
constexpr int SKS = 2304;

constexpr size_t MiB = 1u << 20;
constexpr size_t WS_WIN = 1 * MiB;
constexpr size_t WS_WUQ = 6 * MiB;
constexpr size_t WS_WKF = 7 * MiB, WS_WVF = 7 * MiB + 256 * 1024;
constexpr size_t WS_WKU = 7 * MiB + 512 * 1024, WS_WVU = 7 * MiB + 768 * 1024;
constexpr size_t WS_WOUT = 8 * MiB;
constexpr size_t WS_WFFI = 10 * MiB;
constexpr size_t WS_WFFO = 21 * MiB;
constexpr size_t WS_BAR = 27 * MiB - 4096;
constexpr size_t WS_MOD = 27 * MiB;
constexpr size_t WS_RSSQ = 29 * MiB;
constexpr size_t WS_RSSKV = WS_RSSQ;
constexpr size_t WS_CACHEB = 27 * MiB + 512 * 1024;
constexpr size_t WS_DEC = 28 * MiB;
constexpr size_t WS_H = 32 * MiB;
constexpr size_t WS_Z = 48 * MiB;
constexpr size_t WS_Q = 84 * MiB;
constexpr size_t WS_HFF = 48 * MiB;
constexpr size_t WS_KP = 96 * MiB;
constexpr size_t WS_KS = 102 * MiB;
constexpr size_t WS_VTP = 109 * MiB;
constexpr size_t WS_VTS = 113 * MiB;
constexpr size_t WS_CT = 118 * MiB;
constexpr size_t WS_MIX = 150 * MiB;
constexpr size_t WS_X1 = 166 * MiB;
constexpr size_t WS_P0 = 96 * MiB;
constexpr size_t WS_P1A = 48 * MiB, WS_P1B = 128 * MiB;
constexpr size_t O_Y = 0, O_KV = 8388608, O_KR = O_KV + 1048576, O_SF = O_KR + 131072, O_SB = O_SF + 524288;

constexpr int LDS_BYTES = 147456;

__device__ __forceinline__ unsigned f2bf_sw(float f) { unsigned u = __builtin_bit_cast(unsigned, f); return (u + 0x7fffu + ((u >> 16) & 1u)) >> 16; }
__device__ __forceinline__ unsigned cvt_pk_bf16(float lo, float hi) { unsigned r; asm volatile("v_cvt_pk_bf16_f32 %0, %1, %2" : "=v"(r) : "v"(lo), "v"(hi)); return r; }
__device__ __forceinline__ bf16_t f2bf(float f) { return (bf16_t)(cvt_pk_bf16(f, 0.f) & 0xffffu); }
__device__ __forceinline__ float bf2f(bf16_t b) { return __uint_as_float((unsigned)b << 16); }
__device__ __forceinline__ float bflo(unsigned w) { return __uint_as_float(w << 16); }
__device__ __forceinline__ float bfhi(unsigned w) { return __uint_as_float(w & 0xffff0000u); }
__device__ __forceinline__ float wave_sum(float v) {
#pragma unroll
    for (int o = 1; o < 64; o <<= 1) v += __shfl_xor(v, o);
    return v;
}
__device__ __forceinline__ float fast_rcp(float x) { return __builtin_amdgcn_rcpf(x); }
__device__ __forceinline__ float silu_f(float a) { return a * fast_rcp(1.f + __expf(-a)); }
__device__ __forceinline__ float logsigmoid_f(float x) { return fminf(x, 0.f) - __logf(1.f + __expf(-fabsf(x))); }
__device__ __forceinline__ int opaque_lane() { int l; asm volatile("v_mbcnt_lo_u32_b32 %0, -1, 0\n\tv_mbcnt_hi_u32_b32 %0, -1, %0" : "=v"(l)); return l; }
__device__ __forceinline__ int otid(int wv) { int t = (int)threadIdx.x; asm volatile("" : "+v"(t)); return t; }
#define LDS_WAIT() asm volatile("s_waitcnt lgkmcnt(0)" ::: "memory")
#define VM_WAIT() asm volatile("s_waitcnt vmcnt(0)" ::: "memory")

namespace pg8 {
constexpr int BM = 256, BK = 64, HALF = 128, HTB = HALF * BK * 2, STAGE_BYTES = 8 * HTB, NXCD = 8, WGM = 8;
__host__ __device__ __forceinline__ int lds_byte(int r, int c) { const int st = (r >> 4) * 2 + (c >> 5), rr = r & 15, cc = c & 31, ob = rr * 64 + cc * 2; return st * 1024 + (ob ^ (((ob >> 9) & 1) << 5)); }
__host__ __device__ __forceinline__ void stage_rc(int b, int& R, int& C) { const int st = b / 1024, sb = b % 1024, swz = sb ^ (((sb >> 9) & 1) << 5); R = (st >> 1) * 16 + swz / 64; C = (st & 1) * 32 + (swz % 64) / 2; }
__host__ __device__ __forceinline__ int perm32(int rho) { const int n = rho >> 4, i = rho & 15; return 8 * (i >> 2) + 4 * n + (i & 3); }

struct Unit { int pm, pn, ks; };
struct Gemm { const bf16_t* A; const bf16_t* Bt; int lda, ldb, K, wv; };

struct Order {
    int nM, nN, nNs, nwg, G, c;
    __device__ void init(int M, int N, int nsplit, int G_, int c_) { nM = M / BM; nN = N / BM; nNs = nN * nsplit; nwg = nM * nNs; G = G_; c = c_; }
    __device__ bool next(int i, Unit& u) const {
        const long L = (long)i * G + c; if (L >= nwg) return false;
        int wgid = (int)L; { const int q = nwg / NXCD, r = nwg % NXCD, xcd = wgid % NXCD, off = wgid / NXCD; wgid = (xcd < r ? xcd * (q + 1) : r * (q + 1) + (xcd - r) * q) + off; }
        const int nig = WGM * nNs, gid = wgid / nig, fm = gid * WGM, gsz = (nM - fm) < WGM ? (nM - fm) : WGM;
        u.pm = fm + ((wgid % nig) % gsz); const int pn2 = (wgid % nig) / gsz; u.pn = pn2 % nN; u.ks = pn2 / nN; return true;
    }
};

template <class Epi, class Sched, bool ALIGN_EPI = true, bool SP2 = true>
__device__ __forceinline__ void gemm_phase(LAS unsigned char* lds, const Gemm g, const Sched& S, const Epi& E) {
    const int tid = otid(g.wv), wid = g.wv, lane = tid & 63, wr = wid >> 2, wc = wid & 3, fr = lane & 15, fq = lane >> 4;
    const int K = g.K, nt = K / BK;
    unsigned voffA[2], voffB[2];
#pragma unroll
    for (int i = 0; i < 2; ++i) { int R, C; stage_rc(tid * 16 + i * 8192, R, C); const int Rb = Epi::PERM ? ((R & ~31) + perm32(R & 31)) : R;
        voffA[i] = (unsigned)(R * g.lda + C) * 2u; voffB[i] = (unsigned)(Rb * g.ldb + C) * 2u; }
    const size_t kstep = (size_t)(BK * 2);
    const size_t hstepA = (size_t)HALF * g.lda * 2, hstepB = (size_t)HALF * g.ldb * 2;
    const size_t tstepA = 2 * hstepA, tstepB = 2 * hstepB;
    const size_t ksplit = (size_t)K * 2;
    const unsigned ldsw = (unsigned)wid * 1024u;
    const int aoff = lds_byte(wr * 64 + fr, fq * 8), boff = lds_byte(wc * 32 + fr, fq * 8);
#define PG8_SA(b, h) (((b) * 2 + (h)) * HTB)
#define PG8_SB(b, h) ((4 + (b) * 2 + (h)) * HTB)
#define PG8_STAGE(bufoff, gbase, voff) do { _Pragma("unroll") for (int _i = 0; _i < 2; ++_i) \
        __builtin_amdgcn_global_load_lds((const unsigned*)((const char*)(gbase) + (voff)[_i]), (LAS unsigned*)(lds + (bufoff) + ldsw + _i * 8192), 16, 0, 0); } while (0)
#define PG8_LDA(dst, b, h) do { _Pragma("unroll") for (int m = 0; m < 4; ++m) _Pragma("unroll") for (int k = 0; k < 2; ++k) dst[m][k] = *(const LAS bf16x8*)(lds + PG8_SA(b, h) + aoff + m * 2048 + k * 1024); } while (0)
#define PG8_LDB(dst, b, h) do { _Pragma("unroll") for (int n = 0; n < 2; ++n) _Pragma("unroll") for (int k = 0; k < 2; ++k) dst[n][k] = *(const LAS bf16x8*)(lds + PG8_SB(b, h) + boff + n * 2048 + k * 1024); } while (0)
#define PG8_MMA(ai, bj, At, Bt) do { __builtin_amdgcn_s_setprio(1); _Pragma("unroll") for (int m = 0; m < 4; ++m) _Pragma("unroll") for (int n = 0; n < 2; ++n) _Pragma("unroll") for (int k = 0; k < 2; ++k) \
        acc[ai][bj][m][n] = __builtin_amdgcn_mfma_f32_16x16x32_bf16(Bt[n][k], At[m][k], acc[ai][bj][m][n], 0, 0, 0); __builtin_amdgcn_s_setprio(0); } while (0)
#define PG8_WAIT_V(n) asm volatile("s_waitcnt vmcnt(" #n ")" ::: "memory")
#define PG8_WAIT_L(n) asm volatile("s_waitcnt lgkmcnt(" #n ")" ::: "memory")
#define PG8_BAR __builtin_amdgcn_s_barrier()
#define PG8_SCHED __builtin_amdgcn_sched_barrier(0)
    Unit cur, nxt; int ui = 0;
    if (!S.next(0, cur)) return;
    f32x4 acc[2][2][4][2];
#pragma unroll
    for (int a = 0; a < 2; ++a)
#pragma unroll
        for (int b = 0; b < 2; ++b)
#pragma unroll
            for (int m = 0; m < 4; ++m)
#pragma unroll
                for (int n = 0; n < 2; ++n) acc[a][b][m][n] = (f32x4){0.f, 0.f, 0.f, 0.f};
    bf16x8 At[4][2], B0[2][2], B1[2][2];
    const char* cA = (const char*)g.A + (size_t)cur.pm * tstepA + (size_t)cur.ks * ksplit; const char* cB = (const char*)g.Bt + (size_t)cur.pn * tstepB + (size_t)cur.ks * ksplit;
    if constexpr (SP2) {
        PG8_STAGE(PG8_SB(0, 0), cB, voffB); PG8_STAGE(PG8_SB(0, 1), cB + hstepB, voffB); PG8_STAGE(PG8_SA(0, 0), cA, voffA); PG8_STAGE(PG8_SA(0, 1), cA + hstepA, voffA);
        if (wr == 1) PG8_BAR;
        PG8_WAIT_V(2); PG8_BAR;
        PG8_STAGE(PG8_SB(1, 0), cB + kstep, voffB); PG8_STAGE(PG8_SA(1, 0), cA + kstep, voffA); PG8_STAGE(PG8_SB(1, 1), cB + hstepB + kstep, voffB);
        PG8_WAIT_V(6); PG8_BAR;
    } else {
        PG8_STAGE(PG8_SB(0, 0), cB, voffB); PG8_STAGE(PG8_SA(0, 0), cA, voffA); PG8_STAGE(PG8_SB(0, 1), cB + hstepB, voffB); PG8_STAGE(PG8_SA(0, 1), cA + hstepA, voffA);
        if (wr == 1) PG8_BAR;
        PG8_WAIT_V(4); PG8_BAR;
        PG8_STAGE(PG8_SB(1, 0), cB + kstep, voffB); PG8_STAGE(PG8_SA(1, 0), cA + kstep, voffA); PG8_STAGE(PG8_SB(1, 1), cB + hstepB + kstep, voffB);
        PG8_WAIT_V(6); PG8_BAR;
    }
    for (;;) {
        const bool has_next = S.next(ui + 1, nxt);
        const char* nA = has_next ? (const char*)g.A + (size_t)nxt.pm * tstepA + (size_t)nxt.ks * ksplit : cA; const char* nB = has_next ? (const char*)g.Bt + (size_t)nxt.pn * tstepB + (size_t)nxt.ks * ksplit : cB;
#pragma nounroll
        for (int t = 0; t < nt; t += 2) {
            const bool last = (t == nt - 2);
            const char* a1 = cA + (size_t)(t + 1) * kstep;
            const char* a2 = last ? nA : cA + (size_t)(t + 2) * kstep; const char* b2 = last ? nB : cB + (size_t)(t + 2) * kstep;
            const char* a3 = a2 + kstep; const char* b3 = b2 + kstep;
            if constexpr (SP2) {
            PG8_LDB(B0, 0, 0); PG8_LDB(B1, 0, 1); PG8_SCHED; PG8_LDA(At, 0, 0); PG8_STAGE(PG8_SA(1, 1), a1 + hstepA, voffA);
            PG8_WAIT_V(8); PG8_WAIT_L(0); PG8_BAR; PG8_MMA(0, 0, At, B0); PG8_MMA(0, 1, At, B1); PG8_BAR; PG8_SCHED;
            PG8_LDA(At, 0, 1); PG8_STAGE(PG8_SB(0, 0), b2, voffB); PG8_STAGE(PG8_SB(0, 1), b2 + hstepB, voffB); PG8_STAGE(PG8_SA(0, 0), a2, voffA);
            PG8_WAIT_V(8); PG8_WAIT_L(0); PG8_BAR; PG8_MMA(1, 0, At, B0); PG8_MMA(1, 1, At, B1); PG8_BAR; PG8_SCHED;
            PG8_LDB(B0, 1, 0); PG8_LDB(B1, 1, 1); PG8_SCHED; PG8_LDA(At, 1, 0); PG8_STAGE(PG8_SA(0, 1), a2 + hstepA, voffA);
            PG8_WAIT_V(8); PG8_WAIT_L(0); PG8_BAR; PG8_MMA(0, 0, At, B0); PG8_MMA(0, 1, At, B1); PG8_BAR; PG8_SCHED;
            PG8_LDA(At, 1, 1); PG8_STAGE(PG8_SB(1, 0), b3, voffB); PG8_STAGE(PG8_SB(1, 1), b3 + hstepB, voffB); PG8_STAGE(PG8_SA(1, 0), a3, voffA);
            PG8_WAIT_V(8); PG8_WAIT_L(0); PG8_BAR; PG8_MMA(1, 0, At, B0); PG8_MMA(1, 1, At, B1); PG8_BAR; PG8_SCHED;
            } else {
            PG8_LDB(B0, 0, 0); PG8_SCHED; PG8_LDA(At, 0, 0); PG8_STAGE(PG8_SA(1, 1), a1 + hstepA, voffA);
            PG8_WAIT_L(8); PG8_BAR; PG8_WAIT_L(0); PG8_MMA(0, 0, At, B0); PG8_BAR; PG8_SCHED;
            PG8_LDB(B1, 0, 1); PG8_STAGE(PG8_SB(0, 0), b2, voffB);
            PG8_BAR; PG8_WAIT_L(0); PG8_MMA(0, 1, At, B1); PG8_BAR;
            PG8_LDA(At, 0, 1); PG8_STAGE(PG8_SA(0, 0), a2, voffA);
            PG8_BAR; PG8_WAIT_L(0); PG8_MMA(1, 0, At, B0); PG8_BAR; PG8_SCHED;
            PG8_STAGE(PG8_SB(0, 1), b2 + hstepB, voffB);
            PG8_WAIT_V(6); PG8_BAR; PG8_MMA(1, 1, At, B1); PG8_BAR;
            PG8_LDB(B0, 1, 0); PG8_SCHED; PG8_LDA(At, 1, 0); PG8_STAGE(PG8_SA(0, 1), a2 + hstepA, voffA);
            PG8_WAIT_L(8); PG8_BAR; PG8_WAIT_L(0); PG8_MMA(0, 0, At, B0); PG8_BAR; PG8_SCHED;
            PG8_LDB(B1, 1, 1); PG8_STAGE(PG8_SB(1, 0), b3, voffB);
            PG8_BAR; PG8_WAIT_L(0); PG8_MMA(0, 1, At, B1); PG8_BAR;
            PG8_LDA(At, 1, 1); PG8_STAGE(PG8_SA(1, 0), a3, voffA);
            PG8_BAR; PG8_WAIT_L(0); PG8_MMA(1, 0, At, B0); PG8_BAR; PG8_SCHED;
            PG8_STAGE(PG8_SB(1, 1), b3 + hstepB, voffB);
            PG8_WAIT_V(6); PG8_BAR; PG8_MMA(1, 1, At, B1); PG8_BAR;
            }
        }
        if constexpr (ALIGN_EPI) { if (wr == 0) PG8_BAR; }
        E(acc, cur, wr, wc, fr, fq);
        if (!has_next) break;
#pragma unroll
        for (int a = 0; a < 2; ++a)
#pragma unroll
            for (int b = 0; b < 2; ++b)
#pragma unroll
                for (int m = 0; m < 4; ++m)
#pragma unroll
                    for (int n = 0; n < 2; ++n) acc[a][b][m][n] = (f32x4){0.f, 0.f, 0.f, 0.f};
        cur = nxt; cA = nA; cB = nB; ++ui;
        if constexpr (ALIGN_EPI) { if (wr == 1) PG8_BAR; }
    }
    PG8_WAIT_V(0);
    if constexpr (!ALIGN_EPI) { if (wr == 0) PG8_BAR; }
    PG8_BAR;
#undef PG8_SA
#undef PG8_SB
#undef PG8_STAGE
#undef PG8_LDA
#undef PG8_LDB
#undef PG8_MMA
#undef PG8_WAIT_V
#undef PG8_WAIT_L
#undef PG8_BAR
#undef PG8_SCHED
}

__device__ __forceinline__ float rss_q(const float* rss, int row) { float s = 0.f;
#pragma unroll
    for (int p = 0; p < 12; ++p) s += rss[(size_t)p * MTOK + row]; return s; }
__device__ __forceinline__ float rss_kv(const float* rss, int row) { float s = 0.f;
#pragma unroll
    for (int p = 12; p < 20; ++p) s += rss[(size_t)p * MTOK + row]; return s; }
#define EPI_ROWS_BEGIN _Pragma("unroll") for (int ai = 0; ai < 2; ++ai) _Pragma("unroll") for (int m = 0; m < 4; ++m) { const int row = u.pm * BM + wr * 64 + fr + ai * HALF + m * 16;
#define EPI_ROWS_END asm volatile("" ::: "memory"); }

struct EpiZ {
    static constexpr bool PERM = true;
    bf16_t* Z; float* rssq; float* rsskv; int pn_off;
    __device__ __forceinline__ void operator()(const f32x4 (&acc)[2][2][4][2], const Unit& u, int wr, int wc, int fr_, int fq_) const {
        int lane_e = (int)threadIdx.x & 63; asm volatile("" : "+v"(lane_e)); const int fr = lane_e & 15, fq = lane_e >> 4;
        const int col0 = (u.pn + pn_off) * BM + wc * 32 + 8 * fq;
        EPI_ROWS_BEGIN
            bf16_t* rowp = Z + (size_t)row * ZP + col0;
#pragma unroll
            for (int bj = 0; bj < 2; ++bj) { const f32x4 v0 = acc[ai][bj][m][0], v1 = acc[ai][bj][m][1];
                u32x4 w; w.x = cvt_pk_bf16(v0[0], v0[1]); w.y = cvt_pk_bf16(v0[2], v0[3]); w.z = cvt_pk_bf16(v1[0], v1[1]); w.w = cvt_pk_bf16(v1[2], v1[3]);
                *(u32x4*)(rowp + bj * HALF) = w;
                const int hc = 2 * (u.pn + pn_off) + bj;
                if (hc < 5) { float s = (v0[0] * v0[0] + v0[1] * v0[1]) + (v0[2] * v0[2] + v0[3] * v0[3]) + (v1[0] * v1[0] + v1[1] * v1[1]) + (v1[2] * v1[2] + v1[3] * v1[3]);
                    s += __shfl_xor(s, 16); s += __shfl_xor(s, 32);
                    if (fq == 0) rssq[(size_t)(hc * 4 + wc) * MTOK + row] = s; } }
        EPI_ROWS_END
    }
};

struct EpiQ {
    static constexpr bool PERM = true;
    bf16_t* Q; const float* rssq;
    __device__ __forceinline__ void operator()(const f32x4 (&acc)[2][2][4][2], const Unit& u, int wr, int wc, int fr_, int fq_) const {
        int lane_e = (int)threadIdx.x & 63; asm volatile("" : "+v"(lane_e)); const int fr = lane_e & 15, fq = lane_e >> 4;
        const int col0 = u.pn * BM + wc * 32 + 8 * fq;
        const float inv[8] = {1.f, 0.316227766f, 0.1f, 0.0316227766f, 0.01f, 0.00316227766f, 0.001f, 0.000316227766f};
        EPI_ROWS_BEGIN
            const float rs = rsqrtf(rss_q(rssq, row) * (1.f / 384.f) + EPS) * QSCALE;
            const int t = (row - MP) & 2047;
#pragma unroll
            for (int bj = 0; bj < 2; ++bj) { const int c = col0 + bj * HALF; const int j0 = c % 96;
                const bool rp = (row >= MP && j0 >= 64);
                const float pos = (float)((j0 < 80) ? (t >> 6) : (t & 63)) * 0.15915494309189535f;
                const float sg = (j0 & 8) ? 1.f : -1.f;
#pragma unroll
                for (int n = 0; n < 2; ++n) {
                    f32x4 v = acc[ai][bj][m][n] * rs;
#pragma unroll
                    for (int i = 0; i < 4; ++i) { const float p = __shfl_xor(v[i], 16);
                        const float rev = pos * inv[4 * n + i]; const float rf = rev - floorf(rev);
                        const float cs = __builtin_amdgcn_cosf(rf), sn = __builtin_amdgcn_sinf(rf); v[i] = rp ? v[i] * cs + sg * p * sn : v[i]; }
                    u32x2 w; w.x = cvt_pk_bf16(v[0], v[1]); w.y = cvt_pk_bf16(v[2], v[3]);
                    *(u32x2*)(Q + (size_t)row * 768 + c + 4 * n) = w; } }
        EPI_ROWS_END
    }
};

struct EpiK {
    static constexpr bool PERM = true;
    bf16_t* Kp; bf16_t* Ks; const float* rsskv; int ctx;
    __device__ __forceinline__ void operator()(const f32x4 (&acc)[2][2][4][2], const Unit& u, int wr, int wc, int fr_, int fq_) const {
        int lane_e = (int)threadIdx.x & 63; asm volatile("" : "+v"(lane_e)); const int fr = lane_e & 15, fq = lane_e >> 4;
        EPI_ROWS_BEGIN
            float rs = 1.f; unsigned off; bool smp;
            if (ctx) { off = ((unsigned)(row >> 8) * 8u * SKS + (row & 255)) * 96u; smp = true; }
            else { rs = rsqrtf(rss_kv(rsskv, row) * (1.f / 256.f) + EPS);
                if (row < MP) { off = ((unsigned)(row >> 8) * 8u * 256u + (row & 255)) * 96u; smp = false; } else { off = ((unsigned)((row - MP) >> 11) * 8u * SKS + 256u + ((row - MP) & 2047)) * 96u; smp = true; } }
            bf16_t* base = smp ? Ks : Kp; const unsigned hs = (smp ? SKS : 256) * 96u;
#pragma unroll
            for (int bj = 0; bj < 2; ++bj) { const unsigned h = 4 * u.pn + 2 * bj + (wc >> 1); const unsigned j = (wc & 1) * 32 + 8 * fq;
                const f32x4 v0 = acc[ai][bj][m][0] * rs, v1 = acc[ai][bj][m][1] * rs;
                u32x4 w; w.x = cvt_pk_bf16(v0[0], v0[1]); w.y = cvt_pk_bf16(v0[2], v0[3]); w.z = cvt_pk_bf16(v1[0], v1[1]); w.w = cvt_pk_bf16(v1[2], v1[3]);
                *(u32x4*)(base + (off + h * hs + j)) = w; }
        EPI_ROWS_END
    }
};

struct EpiVt {
    static constexpr bool PERM = true;
    bf16_t* Vtp; bf16_t* Vts; const float* rsskv; int ctx;
    __device__ __forceinline__ void operator()(const f32x4 (&acc)[2][2][4][2], const Unit& u, int wr, int wc, int fr_, int fq_) const {
        int lane_e = (int)threadIdx.x & 63; asm volatile("" : "+v"(lane_e)); const int fr = lane_e & 15, fq = lane_e >> 4;
#pragma unroll
        for (int bj = 0; bj < 2; ++bj) {
            const int tok = u.pn * BM + bj * HALF + wc * 32 + 8 * fq;
            f32x4 r0 = {1.f, 1.f, 1.f, 1.f}, r1 = {1.f, 1.f, 1.f, 1.f}; unsigned off; bool smp; unsigned S;
            if (ctx) { off = (unsigned)(tok >> 8) * 8u * 64u * SKS + (tok & 255); smp = true; S = SKS; }
            else { f32x4 q0 = {0.f, 0.f, 0.f, 0.f}, q1 = {0.f, 0.f, 0.f, 0.f};
#pragma unroll
                for (int p = 12; p < 20; ++p) { q0 += *(const f32x4*)(rsskv + (size_t)p * MTOK + tok); q1 += *(const f32x4*)(rsskv + (size_t)p * MTOK + tok + 4); }
#pragma unroll
                for (int i = 0; i < 4; ++i) { r0[i] = rsqrtf(q0[i] * (1.f / 256.f) + EPS); r1[i] = rsqrtf(q1[i] * (1.f / 256.f) + EPS); }
                if (tok < MP) { off = (unsigned)(tok >> 8) * 8u * 64u * 256u + (tok & 255); smp = false; S = 256; } else { off = (unsigned)((tok - MP) >> 11) * 8u * 64u * SKS + 256u + ((tok - MP) & 2047); smp = true; S = SKS; } }
            bf16_t* base = smp ? Vts : Vtp;
#pragma unroll
            for (int ai = 0; ai < 2; ++ai)
#pragma unroll
                for (int m = 0; m < 4; ++m) { const unsigned hd = u.pm * BM + wr * 64 + fr + ai * HALF + m * 16;
                    const f32x4 v0 = acc[ai][bj][m][0] * r0, v1 = acc[ai][bj][m][1] * r1;
                    u32x4 w; w.x = cvt_pk_bf16(v0[0], v0[1]); w.y = cvt_pk_bf16(v0[2], v0[3]); w.z = cvt_pk_bf16(v1[0], v1[1]); w.w = cvt_pk_bf16(v1[2], v1[3]);
                    *(u32x4*)(base + (off + hd * S)) = w; }
            asm volatile("" ::: "memory");
        }
    }
};

struct EpiPart {
    static constexpr bool PERM = true;
    bf16_t* P0; bf16_t* P1;
    __device__ __forceinline__ void operator()(const f32x4 (&acc)[2][2][4][2], const Unit& u, int wr, int wc, int fr_, int fq_) const {
        int lane_e = (int)threadIdx.x & 63; asm volatile("" : "+v"(lane_e)); const int fr = lane_e & 15, fq = lane_e >> 4;
        const int col0 = u.pn * BM + wc * 32 + 8 * fq; bf16_t* P = u.ks ? P1 : P0;
        EPI_ROWS_BEGIN
            bf16_t* rowp = P + (size_t)row * D + col0;
#pragma unroll
            for (int bj = 0; bj < 2; ++bj) { const f32x4 v0 = acc[ai][bj][m][0], v1 = acc[ai][bj][m][1];
                u32x4 w; w.x = cvt_pk_bf16(v0[0], v0[1]); w.y = cvt_pk_bf16(v0[2], v0[3]); w.z = cvt_pk_bf16(v1[0], v1[1]); w.w = cvt_pk_bf16(v1[2], v1[3]);
                *(u32x4*)(rowp + bj * HALF) = w; }
        EPI_ROWS_END
    }
};

struct EpiFFI {
    static constexpr bool PERM = true;
    bf16_t* H;
    __device__ __forceinline__ void operator()(const f32x4 (&acc)[2][2][4][2], const Unit& u, int wr, int wc, int fr_, int fq_) const {
        int lane_e = (int)threadIdx.x & 63; asm volatile("" : "+v"(lane_e)); const int fr = lane_e & 15, fq = lane_e >> 4;
        const int col0 = u.pn * HALF + wc * 32 + 8 * fq;
        EPI_ROWS_BEGIN
            float o[8];
#pragma unroll
            for (int i = 0; i < 4; ++i) { o[i] = silu_f(acc[ai][0][m][0][i]) * acc[ai][1][m][0][i]; o[4 + i] = silu_f(acc[ai][0][m][1][i]) * acc[ai][1][m][1][i]; }
            u32x4 w; w.x = cvt_pk_bf16(o[0], o[1]); w.y = cvt_pk_bf16(o[2], o[3]); w.z = cvt_pk_bf16(o[4], o[5]); w.w = cvt_pk_bf16(o[6], o[7]);
            *(u32x4*)(H + (size_t)row * DFF + col0) = w;
        EPI_ROWS_END
    }
};
}

struct Args { const float* in[26]; float* out; unsigned char* ws; int ph_lo, ph_hi; };
enum { I_XP = 0, I_XS, I_CKV, I_CKR, I_SF, I_SB, I_C, I_CCTX, I_WADA, I_BADA, I_NATT, I_WIN, I_QN, I_WUQ, I_KVN, I_WUKV, I_WGF, I_BGF, I_WGB, I_BGB, I_GLAN, I_WOUT, I_NFFN, I_WFFI, I_WFFO, I_FN };

__device__ __forceinline__ const float* xrow_ptr(const Args& a, int r) { return r < MP ? a.in[I_XP] + (size_t)r * D : a.in[I_XS] + (size_t)(r - MP) * D; }
__device__ __forceinline__ int cond_of_row(int r) { return r < MP ? 0 : 1 + ((r - MP) >> 11); }

__device__ __forceinline__ void p0_tr(const float* W, int K, int N, bf16_t* WT, bf16_t* WT2, const float* kscale, int kb, int nb, int drow, LAS float* scr, int lane) {
    const int k0 = 64 * kb, n0 = 32 * nb;
#pragma unroll 8
    for (int i = 0; i < 32; ++i) { const int kk = 2 * i + (lane >> 5); scr[kk * 33 + (lane & 31)] = W[(size_t)(k0 + kk) * N + n0 + (lane & 31)]; }
    LDS_WAIT();
    const int c = lane & 7;
    float sc[8];
#pragma unroll
    for (int i = 0; i < 8; ++i) sc[i] = kscale ? kscale[k0 + 8 * c + i] : 1.f;
#pragma unroll
    for (int j = 0; j < 4; ++j) { const int n = (lane >> 3) + 8 * j; const LAS float* s = scr + (8 * c) * 33 + n;
        float v[8];
#pragma unroll
        for (int i = 0; i < 8; ++i) v[i] = s[i * 33];
        if (WT2) { u32x4 o; o.x = cvt_pk_bf16(v[0], v[1]); o.y = cvt_pk_bf16(v[2], v[3]); o.z = cvt_pk_bf16(v[4], v[5]); o.w = cvt_pk_bf16(v[6], v[7]);
            *(u32x4*)(WT2 + (size_t)(drow + n0 + n) * K + k0 + 8 * c) = o; }
        u32x4 o; o.x = cvt_pk_bf16(v[0] * sc[0], v[1] * sc[1]); o.y = cvt_pk_bf16(v[2] * sc[2], v[3] * sc[3]); o.z = cvt_pk_bf16(v[4] * sc[4], v[5] * sc[5]); o.w = cvt_pk_bf16(v[6] * sc[6], v[7] * sc[7]);
        *(u32x4*)(WT + (size_t)(drow + n0 + n) * K + k0 + 8 * c) = o; }
    LDS_WAIT();
}

__device__ __forceinline__ void phase0(const Args& a, int wv, LAS unsigned char* lds, int vcu, int G) {
    const int tid = otid(wv), lane = tid & 63, wave = __builtin_amdgcn_readfirstlane(tid >> 6);
    unsigned char* ws = a.ws;
#ifndef P0MASK
#define P0MASK 7
#endif
    if (P0MASK & 2) {
        LAS float* scr = (LAS float*)(lds + wave * 16384);
        LAS float* scnd = (LAS float*)(lds + 131072);
        for (int i = tid; i < 3072; i += 512) { const int ci = i >> 10, k = i & 1023; scnd[i] = silu_f(ci == 0 ? a.in[I_CCTX][k] : a.in[I_C][(ci - 1) * D + k]); }
        __syncthreads();
        const int gw = vcu * 8 + wave, NGW = G * 8;
        constexpr int T_IN = 16 * 70, T_UQ = 6 * 24, T_UKV = 4 * 32, T_OUT = 16 * 32, T_FFI = 16 * 176, T_FFO = 44 * 32, T_ZERO = 64, T_ADA = 768;
        constexpr int NIT = T_ADA + T_IN + T_UQ + T_UKV + T_OUT + T_FFI + T_FFO + T_ZERO;
        for (int it = gw; it < NIT; it += NGW) {
            int r = it;
            if (r < T_ADA) {
                const int nbq = r >> 2, kq = r & 3; const int n0 = 32 * nbq; const float* W = a.in[I_WADA];
                const int n = lane & 31, hf = lane >> 5; float s0 = 0.f, s1 = 0.f, s2 = 0.f;
                for (int kb = 4 * kq; kb < 4 * kq + 4; ++kb) { const int k0 = 64 * kb;
#pragma unroll 8
                    for (int i = 0; i < 32; ++i) { const int kk = 2 * i + (lane >> 5); scr[kk * 33 + (lane & 31)] = W[(size_t)(k0 + kk) * 6144 + n0 + (lane & 31)]; }
                    LDS_WAIT();
#pragma unroll 8
                    for (int j = 0; j < 32; ++j) { const int kk = hf * 32 + j; const float w = scr[kk * 33 + n];
                        s0 += w * scnd[k0 + kk]; s1 += w * scnd[1024 + k0 + kk]; s2 += w * scnd[2048 + k0 + kk]; }
                    LDS_WAIT(); }
                s0 += __shfl_xor(s0, 32); s1 += __shfl_xor(s1, 32); s2 += __shfl_xor(s2, 32);
                float* MOD = (float*)(ws + WS_MOD) + (size_t)kq * 18432;
                if (hf == 0) { MOD[n0 + n] = s0; MOD[6144 + n0 + n] = s1; MOD[12288 + n0 + n] = s2; }
                continue; } r -= T_ADA;
            if (r < T_FFI) { const int kb = r / 176, nb = r % 176; const int n0 = nb * 32; const int drow = n0 < DFF ? (n0 / 128) * 256 + (n0 % 128) : ((n0 - DFF) / 128) * 256 + 128 + ((n0 - DFF) % 128);
                p0_tr(a.in[I_WFFI], 1024, 5632, (bf16_t*)(ws + WS_WFFI), nullptr, nullptr, kb, nb, drow - n0, scr, lane); continue; } r -= T_FFI;
            if (r < T_FFO) { p0_tr(a.in[I_WFFO], DFF, 1024, (bf16_t*)(ws + WS_WFFO), nullptr, nullptr, r / 32, r % 32, 0, scr, lane); continue; } r -= T_FFO;
            if (r < T_IN) { p0_tr(a.in[I_WIN], 1024, 2240, (bf16_t*)(ws + WS_WIN), nullptr, nullptr, r / 70, r % 70, 0, scr, lane); continue; } r -= T_IN;
            if (r < T_OUT) { p0_tr(a.in[I_WOUT], 1024, 1024, (bf16_t*)(ws + WS_WOUT), nullptr, nullptr, r / 32, r % 32, 0, scr, lane); continue; } r -= T_OUT;
            if (r < T_UQ) { p0_tr(a.in[I_WUQ], 384, 768, (bf16_t*)(ws + WS_WUQ), nullptr, a.in[I_QN], r / 24, r % 24, 0, scr, lane); continue; } r -= T_UQ;
            if (r < T_UKV) { const int nb = r % 32, n0 = nb * 32, hh = n0 >> 7, j0 = n0 & 127; const bool isv = j0 >= 64; const int drow = hh * 64 + (j0 & 63);
                p0_tr(a.in[I_WUKV], 256, 1024, (bf16_t*)(ws + (isv ? WS_WVF : WS_WKF)), (bf16_t*)(ws + (isv ? WS_WVU : WS_WKU)), a.in[I_KVN], r / 32, nb, drow - n0, scr, lane); continue; } r -= T_UKV;
            { u32x4 z = {0u, 0u, 0u, 0u}; u32x4* p = (u32x4*)((bf16_t*)(ws + WS_WIN) + (size_t)(2240 + r) * 1024); p[lane] = z; p[64 + lane] = z; }
        }
    }
    if (P0MASK & 4) {
        const int gt = vcu * 512 + tid, NT = G * 512;
        for (int i = gt; i < 32768; i += NT) { const f32x4 v = ((const f32x4*)a.in[I_CKV])[i]; u32x2 w; w.x = cvt_pk_bf16(v[0], v[1]); w.y = cvt_pk_bf16(v[2], v[3]); ((u32x2*)(ws + WS_CACHEB))[i] = w; }
    }
}

__device__ __forceinline__ f32x4 mod4(const float* modp, const float* bias, int ci, int off) {
    const float* p = modp + ci * 6144 + off;
    return ((*(const f32x4*)p + *(const f32x4*)(p + 18432)) + (*(const f32x4*)(p + 36864) + *(const f32x4*)(p + 55296))) + *(const f32x4*)(bias + off);
}
__device__ __forceinline__ void phase1(const Args& a, int wv, int vcu, int G) {
    if (PROBE_FILL == 3) { float* m = (float*)(a.ws + WS_MOD); for (int i = otid(wv); i < 3 * 6144; i += 512) { unsigned h = (unsigned)i * 2654435761u; h ^= h >> 15; h *= 2246822519u; h ^= h >> 13; m[i] = ((float)(h & 0xffff) * (1.f / 65536.f) - 0.5f) * 2.f; } __syncthreads(); }
    const int tid_ = otid(wv); const int lane = tid_ & 63, wave = tid_ >> 6; const int gw = vcu * 8 + wave, NGW = G * 8;
    const float* mod = (const float*)(a.ws + WS_MOD + PROBE_MODOFF); bf16_t* H = (bf16_t*)(a.ws + WS_H);
    for (int r = gw; r < MTOK; r += NGW * PROBE_RSTRIDE) {
        const f32x4* xr = (const f32x4*)xrow_ptr(a, r) + lane; const int ci_ = cond_of_row(r);
        f32x4 v[4]; float s = 0.f;
#pragma unroll
        for (int j = 0; j < 4; ++j) { v[j] = xr[64 * j]; s += (v[j][0] * v[j][0] + v[j][1] * v[j][1]) + (v[j][2] * v[j][2] + v[j][3] * v[j][3]); }
        const float rstd = rsqrtf(wave_sum(s) * (1.f / D) + EPS);
        u32x2* o = (u32x2*)(H + (size_t)r * D) + lane;
#pragma unroll
        for (int j = 0; j < 4; ++j) { const int c = 4 * lane + 256 * j; const f32x4 w = *(const f32x4*)(a.in[I_NATT] + c), sh = mod4(mod, a.in[I_BADA], ci_, c), scv = mod4(mod, a.in[I_BADA], ci_, 1024 + c);
            const f32x4 y = v[j] * rstd * w * (scv * PROBE_MUL + 1.f) + sh * PROBE_MUL; u32x2 p; p.x = cvt_pk_bf16(y[0], y[1]); p.y = cvt_pk_bf16(y[2], y[3]); if (PROBE_NOSTORE) { if ((p.x ^ p.y) == 0x12345u) o[64 * j] = p; } else o[64 * j] = p; }
    }
}
__device__ __forceinline__ void phase6(const Args& a, int wv, int vcu, int G) {
    const int tid_ = otid(wv); const int lane = tid_ & 63, wave = tid_ >> 6; const int gw = vcu * 8 + wave, NGW = G * 8;
    const float* mod = (const float*)(a.ws + WS_MOD); bf16_t* H = (bf16_t*)(a.ws + WS_H); float* X1 = (float*)(a.ws + WS_X1);
    const bf16_t* P0 = (const bf16_t*)(a.ws + WS_P0); const bf16_t* P1 = (const bf16_t*)(a.ws + WS_P1A);
    for (int r = gw; r < MTOK; r += NGW) {
        const f32x4* xr = (const f32x4*)xrow_ptr(a, r) + lane; const int ci_ = cond_of_row(r);
        const u32x2* p0 = (const u32x2*)(P0 + (size_t)r * D) + lane; const u32x2* p1 = (const u32x2*)(P1 + (size_t)r * D) + lane;
        f32x4 v[4]; float s = 0.f;
#pragma unroll
        for (int j = 0; j < 4; ++j) { const int c = 4 * lane + 256 * j; const f32x4 gt = mod4(mod, a.in[I_BADA], ci_, 2048 + c);
            { const u32x2 qa = p0[64 * j], qb = p1[64 * j]; const f32x4 ps = {bflo(qa.x) + bflo(qb.x), bfhi(qa.x) + bfhi(qb.x), bflo(qa.y) + bflo(qb.y), bfhi(qa.y) + bfhi(qb.y)}; v[j] = xr[64 * j] + gt * ps; } s += (v[j][0] * v[j][0] + v[j][1] * v[j][1]) + (v[j][2] * v[j][2] + v[j][3] * v[j][3]); }
        const float rstd = rsqrtf(wave_sum(s) * (1.f / D) + EPS);
        u32x2* x1 = (u32x2*)((bf16_t*)X1 + (size_t)r * D) + lane; u32x2* o = (u32x2*)(H + (size_t)r * D) + lane;
#pragma unroll
        for (int j = 0; j < 4; ++j) { const int c = 4 * lane + 256 * j; { u32x2 xw; xw.x = cvt_pk_bf16(v[j][0], v[j][1]); xw.y = cvt_pk_bf16(v[j][2], v[j][3]); x1[64 * j] = xw; }
            const f32x4 w = *(const f32x4*)(a.in[I_NFFN] + c), sh = mod4(mod, a.in[I_BADA], ci_, 3072 + c), scv = mod4(mod, a.in[I_BADA], ci_, 4096 + c);
            const f32x4 y = v[j] * rstd * w * (scv + 1.f) + sh; u32x2 p; p.x = cvt_pk_bf16(y[0], y[1]); p.y = cvt_pk_bf16(y[2], y[3]); o[64 * j] = p; }
    }
}
__device__ __forceinline__ void phase9(const Args& a, int wv, int vcu, int G) {
    const int tid_ = otid(wv); const int lane = tid_ & 63, wave = tid_ >> 6; const int gw = vcu * 8 + wave, NGW = G * 8;
    const float* mod = (const float*)(a.ws + WS_MOD); const float* X1 = (const float*)(a.ws + WS_X1);
    const bf16_t* P0 = (const bf16_t*)(a.ws + WS_P0); const bf16_t* P1 = (const bf16_t*)(a.ws + WS_P1B);
    for (int r = gw; r < MTOK; r += NGW) {
        const u32x2* xr = (const u32x2*)((const bf16_t*)X1 + (size_t)r * D) + lane; const int ci_ = cond_of_row(r);
        const u32x2* p0 = (const u32x2*)(P0 + (size_t)r * D) + lane; const u32x2* p1 = (const u32x2*)(P1 + (size_t)r * D) + lane;
        f32x4 v[4]; float s = 0.f;
#pragma unroll
        for (int j = 0; j < 4; ++j) { const int c = 4 * lane + 256 * j; const f32x4 gt = mod4(mod, a.in[I_BADA], ci_, 5120 + c);
            { const u32x2 qa = p0[64 * j], qb = p1[64 * j]; const f32x4 ps = {bflo(qa.x) + bflo(qb.x), bfhi(qa.x) + bfhi(qb.x), bflo(qa.y) + bflo(qb.y), bfhi(qa.y) + bfhi(qb.y)}; const u32x2 xq = xr[64 * j]; const f32x4 xv = {bflo(xq.x), bfhi(xq.x), bflo(xq.y), bfhi(xq.y)}; v[j] = xv + gt * ps; } s += (v[j][0] * v[j][0] + v[j][1] * v[j][1]) + (v[j][2] * v[j][2] + v[j][3] * v[j][3]); }
        const float rstd = rsqrtf(wave_sum(s) * (1.f / D) + EPS);
        f32x4* y = (f32x4*)(a.out + O_Y + (size_t)r * D) + lane;
#pragma unroll
        for (int j = 0; j < 4; ++j) { const int c = 4 * lane + 256 * j; const f32x4 w = *(const f32x4*)(a.in[I_FN] + c); y[64 * j] = v[j] * rstd * w; }
    }
}

__device__ __forceinline__ void p3_row_extras(const Args& a, int wv, int gw, int NGW) {
    const int lane = otid(wv) & 63;
    const bf16_t* Z = (const bf16_t*)(a.ws + WS_Z); const float* rsskv = (const float*)(a.ws + WS_RSSKV);
    bf16_t* Kp = (bf16_t*)(a.ws + WS_KP); bf16_t* Ks = (bf16_t*)(a.ws + WS_KS);
    const float inv[8] = {1.f, 0.316227766f, 0.1f, 0.0316227766f, 0.01f, 0.00316227766f, 0.001f, 0.000316227766f};
    for (int r = gw; r < MTOK + 512; r += NGW) {
        if (r < MTOK) {
            const bf16_t* zr = Z + (size_t)r * ZP;
            if (r < MP) {
                const float rs = rsqrtf(pg8::rss_kv(rsskv, r) * (1.f / 256.f) + EPS);
                const u32x2 w = *(const u32x2*)(zr + C_KVLAT + 4 * lane); const f32x4 g = *(const f32x4*)(a.in[I_KVN] + 4 * lane);
                f32x4 o; o[0] = bflo(w.x) * rs * g[0]; o[1] = bfhi(w.x) * rs * g[1]; o[2] = bflo(w.y) * rs * g[2]; o[3] = bfhi(w.y) * rs * g[3];
                *(f32x4*)(a.out + O_KV + (size_t)r * 256 + 4 * lane) = o;
            }
            const int i = lane & 31;
            float v = bf2f(zr[C_KROPE + i]);
            if (r < MP && lane < 32) a.out[O_KR + (size_t)r * 32 + i] = v;
            const float pv = __shfl_xor(v, 8);
            int b, s; bf16_t* kb;
            if (r >= MP) { const int t = (r - MP) & 2047; const float pos = (float)((i < 16) ? (t >> 6) : (t & 63));
                const float rev = pos * inv[i & 7] * 0.15915494309189535f; const float rf = rev - floorf(rev);
                const float cs = __builtin_amdgcn_cosf(rf), sn = __builtin_amdgcn_sinf(rf); v = v * cs + ((i & 8) ? pv : -pv) * sn;
                b = (r - MP) >> 11; s = 256 + t; kb = Ks + ((size_t)(b * 8) * SKS + s) * 96 + 64 + i;
                const bf16_t o = f2bf(v);
                if (lane < 32) { for (int h = 0; h < 8; ++h) kb[(size_t)h * SKS * 96] = o; }
            } else { b = r >> 8; s = r & 255; kb = Kp + ((size_t)(b * 8) * 256 + s) * 96 + 64 + i; const bf16_t o = f2bf(v);
                if (lane < 32) { for (int h = 0; h < 8; ++h) kb[(size_t)h * 256 * 96] = o; } }
        } else {
            const int rr = r - MTOK, b = rr >> 8, s = rr & 255, i = lane & 31;
            const bf16_t o = f2bf(a.in[I_CKR][(size_t)rr * 32 + i]); bf16_t* kb = Ks + ((size_t)(b * 8) * SKS + s) * 96 + 64 + i;
            if (lane < 32) { for (int h = 0; h < 8; ++h) kb[(size_t)h * SKS * 96] = o; }
        }
    }
}

constexpr int GL_LOW = 0, GL_WG = 8192, GL_BG = 16384, GL_SEG = 16896, GL_RED = 20992, GL_VT = 22528, GL_QF = 40960, GL_KF = GL_QF + 9216, GL_QB = GL_KF + 9216, GL_KB = GL_QB + 9216;
constexpr int GROW = 144;

__device__ __forceinline__ void gla_gates(const Args& a, int wv, LAS unsigned char* lds, int r0, int h, float (&cumF)[8], float (&cumB)[8], float& totF, float& totB) {
    const int tid = otid(wv), d = tid & 63, tg = tid >> 6;
    const bf16_t* Z = (const bf16_t*)(a.ws + WS_Z);
    LAS float* low = (LAS float*)(lds + GL_LOW); LAS float* wg = (LAS float*)(lds + GL_WG); LAS float* bg = (LAS float*)(lds + GL_BG); LAS float* seg = (LAS float*)(lds + GL_SEG);
    { const int t = tid >> 3, r4 = (tid & 7) * 4; const u32x2 w = *(const u32x2*)(Z + (size_t)(r0 + t) * ZP + C_GFL + r4);
      low[t * 32 + r4] = bflo(w.x); low[t * 32 + r4 + 1] = bfhi(w.x); low[t * 32 + r4 + 2] = bflo(w.y); low[t * 32 + r4 + 3] = bfhi(w.y); }
    { const int dir = tid >> 8, r = (tid >> 4) & 15, d4 = (tid & 15) * 4; const f32x4 w = *(const f32x4*)(a.in[dir ? I_WGB : I_WGF] + r * 256 + h * 64 + d4);
      *(LAS f32x4*)(wg + (dir * 16 + r) * 64 + d4) = w; }
    if (tid < 128) { const int dir = tid >> 6; bg[tid] = a.in[dir ? I_BGB : I_BGF][h * 64 + (tid & 63)]; }
    __syncthreads();
    float wf[16], wb[16];
#pragma unroll
    for (int r = 0; r < 16; ++r) { wf[r] = wg[r * 64 + d]; wb[r] = wg[(16 + r) * 64 + d]; }
    const float bf_ = bg[d], bb_ = bg[64 + d];
    float gf[8], gb[8];
#pragma unroll
    for (int i = 0; i < 8; ++i) { const int t = tg * 8 + i; float xf = bf_, xb = bb_;
#pragma unroll
        for (int r = 0; r < 16; ++r) { xf += low[t * 32 + r] * wf[r]; xb += low[t * 32 + 16 + r] * wb[r]; }
        gf[i] = logsigmoid_f(xf) * (1.f / 16.f); gb[i] = logsigmoid_f(xb) * (1.f / 16.f); }
#pragma unroll
    for (int i = 1; i < 8; ++i) gf[i] += gf[i - 1];
#pragma unroll
    for (int i = 6; i >= 0; --i) gb[i] += gb[i + 1];
    seg[tg * 64 + d] = gf[7]; seg[512 + tg * 64 + d] = gb[0];
    __syncthreads();
    float offF = 0.f, offB = 0.f; totF = 0.f; totB = 0.f;
#pragma unroll
    for (int g = 0; g < 8; ++g) { const float sf = seg[g * 64 + d], sb = seg[512 + g * 64 + d]; totF += sf; totB += sb; if (g < tg) offF += sf; if (g > tg) offB += sb; }
#pragma unroll
    for (int i = 0; i < 8; ++i) { cumF[i] = gf[i] + offF; cumB[i] = gb[i] + offB; }
}
__device__ __forceinline__ void gla_load_vT(const Args& a, int wv, LAS unsigned char* lds, int r0, int h) {
    const int tid = otid(wv), e = tid & 127, tq = tid >> 7;
    const bf16_t* Z = (const bf16_t*)(a.ws + WS_Z) + (size_t)r0 * ZP + C_GV + h * 128 + e;
    unsigned w[8];
#pragma unroll
    for (int i = 0; i < 8; ++i) { const unsigned lo = Z[(size_t)(tq * 16 + 2 * i) * ZP], hi = Z[(size_t)(tq * 16 + 2 * i + 1) * ZP]; w[i] = lo | (hi << 16); }
    LAS u32x4* p = (LAS u32x4*)(lds + GL_VT + e * GROW + tq * 32);
    p[0] = (u32x4){w[0], w[1], w[2], w[3]}; p[1] = (u32x4){w[4], w[5], w[6], w[7]};
}

__device__ __forceinline__ void gla_stepA(const Args& a, int wv, LAS unsigned char* lds, int u) {
    const int tid = otid(wv), lane = tid & 63, wave = __builtin_amdgcn_readfirstlane(tid >> 6), d = tid & 63, tg = tid >> 6, fr = lane & 15, fq = lane >> 4;
    const int cgi = u >> 2, h = u & 3, r0 = cgi * 64;
    const bf16_t* Z = (const bf16_t*)(a.ws + WS_Z);
    float cumF[8], cumB[8], totF, totB;
    gla_gates(a, wv, lds, r0, h, cumF, cumB, totF, totB);
    unsigned kf[4], kb[4];
#pragma unroll
    for (int i = 0; i < 4; ++i) { const float k0 = bf2f(Z[(size_t)(r0 + tg * 8 + 2 * i) * ZP + C_GK + h * 64 + d]), k1 = bf2f(Z[(size_t)(r0 + tg * 8 + 2 * i + 1) * ZP + C_GK + h * 64 + d]);
        kf[i] = cvt_pk_bf16(k0 * __expf(totF - cumF[2 * i]), k1 * __expf(totF - cumF[2 * i + 1]));
        kb[i] = cvt_pk_bf16(k0 * __expf(totB - cumB[2 * i]), k1 * __expf(totB - cumB[2 * i + 1])); }
    *(LAS u32x4*)(lds + GL_QF + d * GROW + tg * 16) = (u32x4){kf[0], kf[1], kf[2], kf[3]};
    *(LAS u32x4*)(lds + GL_KF + d * GROW + tg * 16) = (u32x4){kb[0], kb[1], kb[2], kb[3]};
    gla_load_vT(a, wv, lds, r0, h);
    if (tg == 0) { float* dec = (float*)(a.ws + WS_DEC) + (size_t)u * 128; dec[d] = __expf(totF); dec[64 + d] = __expf(totB); }
    __syncthreads();
    const int dir = wave >> 2, eb0 = 2 * (wave & 3);
    const LAS unsigned char* kd = lds + (dir ? GL_KF : GL_QF);
    float* CT = (float*)(a.ws + WS_CT) + ((size_t)u * 2 + dir) * 8192;
#pragma unroll
    for (int eb = 0; eb < 2; ++eb) {
        bf16x8 vf[2];
#pragma unroll
        for (int ks = 0; ks < 2; ++ks) vf[ks] = *(const LAS bf16x8*)(lds + GL_VT + (16 * (eb0 + eb) + fr) * GROW + (32 * ks + 8 * fq) * 2);
#pragma unroll
        for (int db = 0; db < 4; ++db) { f32x4 c = {0.f, 0.f, 0.f, 0.f};
#pragma unroll
            for (int ks = 0; ks < 2; ++ks) { const bf16x8 kfr = *(const LAS bf16x8*)(kd + (16 * db + fr) * GROW + (32 * ks + 8 * fq) * 2); c = __builtin_amdgcn_mfma_f32_16x16x32_bf16(vf[ks], kfr, c, 0, 0, 0); }
#pragma unroll
            for (int j = 0; j < 4; ++j) CT[(16 * (eb0 + eb) + 4 * fq + j) * 64 + 16 * db + fr] = c[j]; }
    }
    __syncthreads();
}

__device__ __forceinline__ void gla_scan(const Args& a, int wv, int vcu, int G) {
    const int gt = vcu * 512 + otid(wv), NT = G * 512;
    float* CTb = (float*)(a.ws + WS_CT); const float* DEC = (const float*)(a.ws + WS_DEC);
    for (int it = gt; it < 32768 + 262144; it += NT) {
        int seq, N, cg0, x;
        if (it < 32768) { seq = 16 + (it >> 14); x = it & 16383; N = 32; cg0 = 64 + 32 * (seq - 16); } else { const int j = it - 32768; seq = j >> 14; x = j & 16383; N = 4; cg0 = 4 * seq; }
        const int h = x >> 12, dir = (x >> 11) & 1, e = (x >> 4) & 127, d4 = (x & 15) * 4;
        f32x4 st = {0.f, 0.f, 0.f, 0.f};
        if (seq >= 16) { const float* s0 = a.in[dir ? I_SB : I_SF] + ((size_t)((seq - 16) * 4 + h) * 64) * 128 + e;
#pragma unroll
            for (int i = 0; i < 4; ++i) st[i] = s0[(size_t)(d4 + i) * 128]; }
        if (N == 32) {
            for (int n0 = 0; n0 < 32; n0 += 8) {
                f32x4 c[8], dc[8];
#pragma unroll
                for (int i = 0; i < 8; ++i) { const int n = dir ? (31 - n0 - i) : (n0 + i); const int u = (cg0 + n) * 4 + h;
                    c[i] = *(const f32x4*)(CTb + ((size_t)u * 2 + dir) * 8192 + e * 64 + d4); dc[i] = *(const f32x4*)(DEC + (size_t)u * 128 + dir * 64 + d4); }
#pragma unroll
                for (int i = 0; i < 8; ++i) { const int n = dir ? (31 - n0 - i) : (n0 + i); const int u = (cg0 + n) * 4 + h;
                    *(f32x4*)(CTb + ((size_t)u * 2 + dir) * 8192 + e * 64 + d4) = st; st = dc[i] * st + c[i]; }
            }
        } else {
            f32x4 c[4], dc[4];
#pragma unroll
            for (int i = 0; i < 4; ++i) { const int n = dir ? (3 - i) : i; const int u = (cg0 + n) * 4 + h;
                c[i] = *(const f32x4*)(CTb + ((size_t)u * 2 + dir) * 8192 + e * 64 + d4); dc[i] = *(const f32x4*)(DEC + (size_t)u * 128 + dir * 64 + d4); }
#pragma unroll
            for (int i = 0; i < 4; ++i) { const int n = dir ? (3 - i) : i; const int u = (cg0 + n) * 4 + h;
                *(f32x4*)(CTb + ((size_t)u * 2 + dir) * 8192 + e * 64 + d4) = st; st = dc[i] * st + c[i]; }
        }
        if (seq < 16) { float* o = a.out + (dir ? O_SB : O_SF) + ((size_t)(seq * 4 + h) * 64) * 128 + e;
#pragma unroll
            for (int i = 0; i < 4; ++i) o[(size_t)(d4 + i) * 128] = st[i]; }
    }
}

__device__ __forceinline__ void gla_stepC(const Args& a, int wv, LAS unsigned char* lds, int u) {
    const int tid = otid(wv), lane = tid & 63, wave = __builtin_amdgcn_readfirstlane(tid >> 6), d = tid & 63, tg = tid >> 6, fr = lane & 15, fq = lane >> 4;
    const int cgi = u >> 2, h = u & 3, r0 = cgi * 64;
    const bf16_t* Z = (const bf16_t*)(a.ws + WS_Z);
    float cumF[8], cumB[8], totF, totB;
    gla_gates(a, wv, lds, r0, h, cumF, cumB, totF, totB);
#pragma unroll
    for (int i = 0; i < 8; ++i) { const int t = tg * 8 + i; const float q = bf2f(Z[(size_t)(r0 + t) * ZP + C_GQ + h * 64 + d]) * 0.125f, k = bf2f(Z[(size_t)(r0 + t) * ZP + C_GK + h * 64 + d]);
        *(LAS bf16_t*)(lds + GL_QF + t * GROW + d * 2) = f2bf(q * __expf(cumF[i]));
        *(LAS bf16_t*)(lds + GL_KF + t * GROW + d * 2) = f2bf(k * __expf(-cumF[i]));
        *(LAS bf16_t*)(lds + GL_QB + t * GROW + d * 2) = f2bf(q * __expf(cumB[i]));
        *(LAS bf16_t*)(lds + GL_KB + t * GROW + d * 2) = f2bf(k * __expf(-cumB[i])); }
    gla_load_vT(a, wv, lds, r0, h);
    __syncthreads();
    const int ch = wave & 1, eq = wave >> 1;
    f32x4 oT[2][2];
#pragma unroll
    for (int i = 0; i < 2; ++i)
#pragma unroll
        for (int j = 0; j < 2; ++j) oT[i][j] = (f32x4){0.f, 0.f, 0.f, 0.f};
#pragma unroll
    for (int dir = 0; dir < 2; ++dir) {
        const LAS unsigned char* qe = lds + (dir ? GL_QB : GL_QF); const LAS unsigned char* ke = lds + (dir ? GL_KB : GL_KF);
        const float* ST = (const float*)(a.ws + WS_CT) + ((size_t)u * 2 + dir) * 8192;
        bf16x8 sf[2][2];
#pragma unroll
        for (int eb = 0; eb < 2; ++eb)
#pragma unroll
            for (int ks = 0; ks < 2; ++ks) { const float* p = ST + (16 * (2 * eq + eb) + fr) * 64 + 32 * ks + 8 * fq; const f32x4 x0 = *(const f32x4*)p, x1 = *(const f32x4*)(p + 4);
                u32x4 w; w.x = cvt_pk_bf16(x0[0], x0[1]); w.y = cvt_pk_bf16(x0[2], x0[3]); w.z = cvt_pk_bf16(x1[0], x1[1]); w.w = cvt_pk_bf16(x1[2], x1[3]); sf[eb][ks] = __builtin_bit_cast(bf16x8, w); }
#pragma unroll
        for (int cb = 0; cb < 2; ++cb) {
            const int cbg = 2 * ch + cb;
            bf16x8 qf[2];
#pragma unroll
            for (int ks = 0; ks < 2; ++ks) qf[ks] = *(const LAS bf16x8*)(qe + (16 * cbg + fr) * GROW + (32 * ks + 8 * fq) * 2);
            f32x4 att[4];
#pragma unroll
            for (int sb = 0; sb < 4; ++sb) {
                f32x4 acc = {0.f, 0.f, 0.f, 0.f};
                const bool need = dir == 0 ? (sb <= cbg) : (sb >= cbg);
                if (need) {
#pragma unroll
                    for (int ks = 0; ks < 2; ++ks) { const bf16x8 kfr = *(const LAS bf16x8*)(ke + (16 * sb + fr) * GROW + (32 * ks + 8 * fq) * 2); acc = __builtin_amdgcn_mfma_f32_16x16x32_bf16(kfr, qf[ks], acc, 0, 0, 0); }
                    if (sb == cbg) {
#pragma unroll
                        for (int j = 0; j < 4; ++j) { const int sl = 4 * fq + j; const bool keep = dir == 0 ? (sl <= fr) : (sl >= fr); acc[j] = keep ? acc[j] : 0.f; } }
                }
                att[sb] = acc;
            }
#pragma unroll
            for (int kp = 0; kp < 2; ++kp) {
                u32x4 w; w.x = cvt_pk_bf16(att[2 * kp][0], att[2 * kp][1]); w.y = cvt_pk_bf16(att[2 * kp][2], att[2 * kp][3]); w.z = cvt_pk_bf16(att[2 * kp + 1][0], att[2 * kp + 1][1]); w.w = cvt_pk_bf16(att[2 * kp + 1][2], att[2 * kp + 1][3]);
                const bf16x8 pb = __builtin_bit_cast(bf16x8, w);
#pragma unroll
                for (int eb = 0; eb < 2; ++eb) { const LAS unsigned char* vp = lds + GL_VT + (16 * (2 * eq + eb) + fr) * GROW + (32 * kp + 4 * fq) * 2;
                    const u32x2 v0 = *(const LAS u32x2*)vp, v1 = *(const LAS u32x2*)(vp + 32); const u32x4 vv = {v0.x, v0.y, v1.x, v1.y};
                    oT[eb][cb] = __builtin_amdgcn_mfma_f32_16x16x32_bf16(__builtin_bit_cast(bf16x8, vv), pb, oT[eb][cb], 0, 0, 0); }
            }
#pragma unroll
            for (int ks = 0; ks < 2; ++ks)
#pragma unroll
                for (int eb = 0; eb < 2; ++eb) oT[eb][cb] = __builtin_amdgcn_mfma_f32_16x16x32_bf16(sf[eb][ks], qf[ks], oT[eb][cb], 0, 0, 0);
        }
    }
    LAS float* red = (LAS float*)(lds + GL_RED);
#pragma unroll
    for (int cb = 0; cb < 2; ++cb) { float s = 0.f;
#pragma unroll
        for (int eb = 0; eb < 2; ++eb)
#pragma unroll
            for (int j = 0; j < 4; ++j) s += oT[eb][cb][j] * oT[eb][cb][j];
        s += __shfl_xor(s, 16); s += __shfl_xor(s, 32);
        if (fq == 0) red[eq * 64 + 16 * (2 * ch + cb) + fr] = s; }
    __syncthreads();
    bf16_t* MIX = (bf16_t*)(a.ws + WS_MIX);
#pragma unroll
    for (int cb = 0; cb < 2; ++cb) { const int c = 16 * (2 * ch + cb) + fr; const float tot = red[c] + red[64 + c] + red[128 + c] + red[192 + c]; const float rstd = rsqrtf(tot * (1.f / 128.f) + EPS);
#pragma unroll
        for (int eb = 0; eb < 2; ++eb) { const int e = 16 * (2 * eq + eb) + 4 * fq; const f32x4 gn = *(const f32x4*)(a.in[I_GLAN] + e);
            const u32x2 gw = *(const u32x2*)(Z + (size_t)(r0 + c) * ZP + C_GOUT + h * 128 + e);
            const float g0 = bflo(gw.x), g1 = bfhi(gw.x), g2 = bflo(gw.y), g3 = bfhi(gw.y);
            const f32x4 o = oT[eb][cb] * rstd * gn; u32x2 w; w.x = cvt_pk_bf16(o[0] * silu_f(g0), o[1] * silu_f(g1)); w.y = cvt_pk_bf16(o[2] * silu_f(g2), o[3] * silu_f(g3));
            *(u32x2*)(MIX + (size_t)(r0 + c) * D + 512 + h * 128 + e) = w; } }
    __syncthreads();
}

constexpr int AT_KROW = 208, AT_VROW = 144, AT_KB = 64 * AT_KROW  , AT_STAGE = AT_KB + 64 * AT_VROW  ;
__device__ __forceinline__ void attn_unit(const Args& a, int wv, LAS unsigned char* lds, int idx) {
    const int tid = otid(wv), lane = tid & 63, wave = __builtin_amdgcn_readfirstlane(tid >> 6), fr = lane & 15, fq = lane >> 4;
    int row0, S, nt; const bf16_t* Kb; const bf16_t* Vb; int h;
    if (idx < 256) { const int b = idx >> 7, qb = idx & 15; h = (idx >> 4) & 7; row0 = MP + b * 2048 + qb * 128; S = SKS; nt = 36;
        Kb = (const bf16_t*)(a.ws + WS_KS) + (size_t)(b * 8 + h) * SKS * 96; Vb = (const bf16_t*)(a.ws + WS_VTS) + (size_t)(b * 8 + h) * 64 * SKS; }
    else { const int j = idx - 256; const int b = j >> 4, qb = j & 1; h = (j >> 1) & 7; row0 = b * 256 + qb * 128; S = 256; nt = 4;
        Kb = (const bf16_t*)(a.ws + WS_KP) + (size_t)(b * 8 + h) * 256 * 96; Vb = (const bf16_t*)(a.ws + WS_VTP) + (size_t)(b * 8 + h) * 64 * 256; }
    const char* src[3]; unsigned step[3]; unsigned dst[3]; bool valid[3];
#pragma unroll
    for (int j = 0; j < 3; ++j) { const int ins = wave + 8 * j; valid[j] = ins < 22;
        if (ins < 13) { const int ck = ins * 64 + lane, r = ck / 13, cc = ck % 13; src[j] = (const char*)Kb + (size_t)r * 192 + (cc < 12 ? cc : 11) * 16; step[j] = 64 * 192; dst[j] = ins * 1024; }
        else { const int cv = (ins - 13) * 64 + lane, r = cv / 9, cc = cv % 9; src[j] = (const char*)Vb + (size_t)r * S * 2 + (cc < 8 ? cc : 7) * 16; step[j] = 128; dst[j] = AT_KB + (ins - 13) * 1024; } }
#define AT_ISSUE(t, buf) do { _Pragma("unroll") for (int j = 0; j < 3; ++j) if (valid[j]) \
        __builtin_amdgcn_global_load_lds((const unsigned*)(src[j] + (size_t)(t) * step[j]), (LAS unsigned*)(lds + (buf) * AT_STAGE + dst[j]), 16, 0, 0); } while (0)
    AT_ISSUE(0, 0);
    const bf16_t* Q = (const bf16_t*)(a.ws + WS_Q) + (size_t)(row0 + wave * 16 + fr) * 768 + h * 96 + 8 * fq;
    bf16x8 qf[3];
#pragma unroll
    for (int ks = 0; ks < 3; ++ks) qf[ks] = *(const bf16x8*)(Q + 32 * ks);
    float mrun = -1e30f, lsum = 0.f;
    f32x4 o[4];
#pragma unroll
    for (int i = 0; i < 4; ++i) o[i] = (f32x4){0.f, 0.f, 0.f, 0.f};
    for (int t = 0; t < nt; ++t) {
        VM_WAIT(); __syncthreads();
        if (t + 1 < nt) AT_ISSUE(t + 1, (t + 1) & 1);
        const LAS unsigned char* kt = lds + (t & 1) * AT_STAGE; const LAS unsigned char* vt = kt + AT_KB;
        f32x4 s[4];
#pragma unroll
        for (int kb = 0; kb < 4; ++kb) { s[kb] = (f32x4){0.f, 0.f, 0.f, 0.f};
#pragma unroll
            for (int ks = 0; ks < 3; ++ks) { const bf16x8 kf = *(const LAS bf16x8*)(kt + (16 * kb + fr) * AT_KROW + (32 * ks + 8 * fq) * 2); s[kb] = __builtin_amdgcn_mfma_f32_16x16x32_bf16(kf, qf[ks], s[kb], 0, 0, 0); } }
        float mx = fmaxf(fmaxf(fmaxf(s[0][0], s[0][1]), fmaxf(s[0][2], s[0][3])), fmaxf(fmaxf(s[1][0], s[1][1]), fmaxf(s[1][2], s[1][3])));
        mx = fmaxf(mx, fmaxf(fmaxf(fmaxf(s[2][0], s[2][1]), fmaxf(s[2][2], s[2][3])), fmaxf(fmaxf(s[3][0], s[3][1]), fmaxf(s[3][2], s[3][3]))));
        mx = fmaxf(mx, __shfl_xor(mx, 16)); mx = fmaxf(mx, __shfl_xor(mx, 32));
        const float mnew = fmaxf(mrun, mx); const float alpha = __builtin_amdgcn_exp2f(mrun - mnew); mrun = mnew;
        float ps = 0.f;
#pragma unroll
        for (int kb = 0; kb < 4; ++kb)
#pragma unroll
            for (int j = 0; j < 4; ++j) { s[kb][j] = __builtin_amdgcn_exp2f(s[kb][j] - mnew); ps += s[kb][j]; }
        lsum = lsum * alpha + ps;
#pragma unroll
        for (int i = 0; i < 4; ++i) o[i] = o[i] * alpha;
#pragma unroll
        for (int kp = 0; kp < 2; ++kp) {
            u32x4 w; w.x = cvt_pk_bf16(s[2 * kp][0], s[2 * kp][1]); w.y = cvt_pk_bf16(s[2 * kp][2], s[2 * kp][3]); w.z = cvt_pk_bf16(s[2 * kp + 1][0], s[2 * kp + 1][1]); w.w = cvt_pk_bf16(s[2 * kp + 1][2], s[2 * kp + 1][3]);
            const bf16x8 pb = __builtin_bit_cast(bf16x8, w);
#pragma unroll
            for (int mb = 0; mb < 4; ++mb) { const LAS unsigned char* vp = vt + (16 * mb + fr) * AT_VROW + (32 * kp + 4 * fq) * 2;
                const u32x2 v0 = *(const LAS u32x2*)vp, v1 = *(const LAS u32x2*)(vp + 32); const u32x4 vv = {v0.x, v0.y, v1.x, v1.y};
                o[mb] = __builtin_amdgcn_mfma_f32_16x16x32_bf16(__builtin_bit_cast(bf16x8, vv), pb, o[mb], 0, 0, 0); }
        }
    }
    lsum += __shfl_xor(lsum, 16); lsum += __shfl_xor(lsum, 32);
    const float il = fast_rcp(lsum);
    bf16_t* MIX = (bf16_t*)(a.ws + WS_MIX) + (size_t)(row0 + wave * 16 + fr) * D + h * 64 + 4 * fq;
#pragma unroll
    for (int mb = 0; mb < 4; ++mb) { u32x2 w; w.x = cvt_pk_bf16(o[mb][0] * il, o[mb][1] * il); w.y = cvt_pk_bf16(o[mb][2] * il, o[mb][3] * il); *(u32x2*)(MIX + 16 * mb) = w; }
    __syncthreads();
#undef AT_ISSUE
}

__device__ unsigned g_bar[64 * 52];
#define GB(i) (g_bar + 64 * (i))
__device__ __forceinline__ unsigned gb_ld(unsigned* p) { return __hip_atomic_load(p, __ATOMIC_RELAXED, __HIP_MEMORY_SCOPE_AGENT); }
__device__ __forceinline__ unsigned gb_add(unsigned* p, unsigned v) { return __hip_atomic_fetch_add(p, v, __ATOMIC_RELAXED, __HIP_MEMORY_SCOPE_AGENT); }
__device__ __forceinline__ unsigned xcc_id() { return (unsigned)__builtin_amdgcn_s_getreg((3 << 11) | 20) & 0xFu; }
__device__ __forceinline__ void my_grid_barrier(unsigned nth, unsigned G, int tid, LAS unsigned* st) {
    asm volatile("s_waitcnt vmcnt(0) lgkmcnt(0)" ::: "memory");
    __syncthreads();
    if (tid == 0) {
        if (nth == 1u) {
            const unsigned x = xcc_id(); unsigned sum, cnt, mine;
            for (;;) { sum = 0u; cnt = 0u; mine = 0u;
#pragma unroll
                for (unsigned j = 0; j < 16; ++j) { const unsigned c = gb_ld(GB(4 + j)); sum += c; cnt += (c > 0u) ? 1u : 0u; mine = (j == x) ? c : mine; }
                if (sum >= G) break; __builtin_amdgcn_s_sleep(1); }
            st[0] = mine; st[1] = cnt; st[2] = x;
        }
        const unsigned nloc = st[0], nx = st[1], x = st[2];
        const unsigned old = gb_add(GB(20 + x), 1u);
        if (old + 1u == nth * nloc) {
            __builtin_amdgcn_fence(__ATOMIC_RELEASE, "agent");
            asm volatile("s_waitcnt vmcnt(0)" ::: "memory");
            const unsigned og = gb_add(GB(1), 1u);
            if (og + 1u == nth * nx) gb_add(GB(2), 1u);
            else while (gb_ld(GB(2)) < nth) __builtin_amdgcn_s_sleep(1);
            __builtin_amdgcn_fence(__ATOMIC_ACQUIRE, "agent");
            gb_add(GB(36 + x), 1u);
            asm volatile("s_waitcnt vmcnt(0)" ::: "memory");
        } else {
            while (gb_ld(GB(36 + x)) < nth) __builtin_amdgcn_s_sleep(1);
            __builtin_amdgcn_fence(__ATOMIC_ACQUIRE, "agent");
            asm volatile("s_waitcnt vmcnt(0)" ::: "memory");
        }
    }
    __syncthreads();
}
__device__ __forceinline__ void my_grid_barrier_finish(unsigned G, int tid) {
    if (tid == 0) {
        const unsigned old = gb_add(GB(0), 1u);
        if (old == G - 1u) { for (int i = 0; i < 52; ++i) __hip_atomic_store(GB(i), 0u, __ATOMIC_RELAXED, __HIP_MEMORY_SCOPE_AGENT); }
    }
}
constexpr int NPHASE = 11;
__global__ void __launch_bounds__(512, 2) mk_fwd(Args a) {
    const int wv = __builtin_amdgcn_readfirstlane((int)threadIdx.x >> 6);
    extern __shared__ __attribute__((aligned(16))) unsigned char lds_raw[];
    LAS unsigned char* lds = (LAS unsigned char*)lds_raw;
    const int G = gridDim.x, bx = blockIdx.x;
    const int vcu = (G % 8 == 0) ? (bx % 8) * (G / 8) + bx / 8 : bx;
    unsigned char* ws = a.ws;
    const int lo = a.ph_lo, hi = a.ph_hi;
#ifndef PHMASK
#define PHMASK 0x7ff
#endif
#define IN(k) (((PHMASK >> (k)) & 1) && lo <= (k) && (k) < hi)
#define SEAM(k) do { if (IN(k) && IN((k) + 1)) { ++nbar; my_grid_barrier(nbar, (unsigned)G, otid(wv), (LAS unsigned*)(lds + LDS_BYTES - 64)); } } while (0)
#ifndef PROBE_FILL
#define PROBE_FILL 0
#endif
    if (PROBE_FILL && lo == 0) { f32x4* p = (f32x4*)a.ws; const size_t n = (size_t)(PROBE_FILL_MIB) << 16; const float fv = PROBE_FILL_VAL;
        for (size_t i = (size_t)bx * 512 + threadIdx.x; i < n; i += (size_t)G * 512) { unsigned h = (unsigned)i * 2654435761u; h ^= h >> 15; h *= 2246822519u; h ^= h >> 13; const float r0 = (float)(h & 0xffff) * (1.f / 65536.f) - 0.5f + fv * 0.f; p[i] = (f32x4){r0, r0 * 1.7f, r0 * -0.3f, r0 + 0.1f}; } }
    if (PROBE_FILL == 2 && lo == 0 && bx == 0) { static const int szs[26] = {4194304, 4194304, 131072, 16384, 65536, 65536, 2048, 1024, 6291456, 6144, 1024, 2293760, 384, 294912, 256, 262144, 4096, 256, 4096, 256, 128, 1048576, 1024, 5767168, 2883584, 1024};
        float sm = 0.f; for (int i = 0; i < 26; ++i) { const int n = szs[i]; const int st = n > 1024 ? n - 1024 : 0; for (int j = st + (int)threadIdx.x; j < n; j += 512) sm += a.in[i][j]; for (int j = threadIdx.x; j < (n < 1024 ? n : 1024); j += 512) sm += a.in[i][j]; }
        ((float*)(a.ws))[threadIdx.x] = sm; }
    if (PROBE_FILL == 5 && lo == 0) { volatile float* p = (volatile float*)a.ws; const float big = p[0] * 0.f + 1e38f, tiny = p[1] * 0.f + 1e-38f, zero = p[2] * 0.f, neg = p[3] * 0.f - 1.f;
        float r = 0.f;
#if PROBE_EXC & 1
        r += big * big;
#endif
#if PROBE_EXC & 2
        r += tiny * tiny;
#endif
#if PROBE_EXC & 4
        r += 1.f / zero;
#endif
#if PROBE_EXC & 8
        r += __builtin_sqrtf(neg);
#endif
        p[4 + bx] = r; }
    unsigned nbar = 0;
    if (otid(wv) == 0) gb_add(GB(4 + xcc_id()), 1u);
    if (IN(0)) { for (int rep = 0; rep < PROBE_P0_REP; ++rep) { phase0(a, wv, lds, vcu, G); __syncthreads(); } } SEAM(0);
    if (IN(1)) { for (int rep = 0; rep < PROBE_ROW_REP; ++rep) phase1(a, wv, vcu, G); } SEAM(1);
    if (PROBE_HANG && lo == 1) { volatile unsigned* q = (volatile unsigned*)(a.ws + 8); while (*q != 0x12345678u) __builtin_amdgcn_s_sleep(20); }
    if (IN(2)) {
        pg8::Gemm g{(const bf16_t*)(ws + WS_H), (const bf16_t*)(ws + WS_WIN), D, D, D, wv}; pg8::Order S; S.init(MTOK, 2048, 1, G, bx);
        pg8::EpiZ E{(bf16_t*)(ws + WS_Z), (float*)(ws + WS_RSSQ), (float*)(ws + WS_RSSKV), 0};
        pg8::gemm_phase<pg8::EpiZ, pg8::Order>(lds, g, S, E);
    } SEAM(2);
    if (IN(3)) {
#ifndef P3MASK
#define P3MASK 0x3f
#endif
#if (P3MASK >> 0) & 1
        { pg8::Gemm g{(const bf16_t*)(ws + WS_Z) + C_QLAT, (const bf16_t*)(ws + WS_WUQ), ZP, 384, 384, wv}; pg8::Order S; S.init(MTOK, 768, 1, G, bx);
          pg8::EpiQ E{(bf16_t*)(ws + WS_Q), (const float*)(ws + WS_RSSQ)}; pg8::gemm_phase<pg8::EpiQ, pg8::Order>(lds, g, S, E); }
#endif
#if (P3MASK >> 1) & 1
        { pg8::Gemm g{(const bf16_t*)(ws + WS_Z) + C_KVLAT, (const bf16_t*)(ws + WS_WKF), ZP, 256, 256, wv}; pg8::Order S; S.init(MTOK, 512, 1, G, (bx + G - 96) % G);
          pg8::EpiK E{(bf16_t*)(ws + WS_KP), (bf16_t*)(ws + WS_KS), (const float*)(ws + WS_RSSKV), 0}; pg8::gemm_phase<pg8::EpiK, pg8::Order>(lds, g, S, E); }
#endif
#if (P3MASK >> 2) & 1
        { pg8::Gemm g{(const bf16_t*)(ws + WS_WVF), (const bf16_t*)(ws + WS_Z) + C_KVLAT, 256, ZP, 256, wv}; pg8::Order S; S.init(512, MTOK, 1, G, (bx + G - 160) % G);
          pg8::EpiVt E{(bf16_t*)(ws + WS_VTP), (bf16_t*)(ws + WS_VTS), (const float*)(ws + WS_RSSKV), 0}; pg8::gemm_phase<pg8::EpiVt, pg8::Order>(lds, g, S, E); }
#endif
        { pg8::Gemm g{(const bf16_t*)(ws + WS_H), (const bf16_t*)(ws + WS_WIN) + (size_t)2048 * D, D, D, D, wv}; pg8::Order S; S.init(MTOK, 256, 1, G, (bx + G - 224) % G);
          pg8::EpiZ E{(bf16_t*)(ws + WS_Z), (float*)(ws + WS_RSSQ), (float*)(ws + WS_RSSKV), 8}; pg8::gemm_phase<pg8::EpiZ, pg8::Order>(lds, g, S, E); }
#if (P3MASK >> 3) & 1
        { pg8::Gemm g{(const bf16_t*)(ws + WS_CACHEB), (const bf16_t*)(ws + WS_WKU), 256, 256, 256, wv}; pg8::Order S; S.init(512, 512, 1, G, (bx + G - 224) % G);
          pg8::EpiK E{(bf16_t*)(ws + WS_KP), (bf16_t*)(ws + WS_KS), (const float*)(ws + WS_RSSKV), 1}; pg8::gemm_phase<pg8::EpiK, pg8::Order>(lds, g, S, E); }
#endif
#if (P3MASK >> 4) & 1
        { pg8::Gemm g{(const bf16_t*)(ws + WS_WVU), (const bf16_t*)(ws + WS_CACHEB), 256, 256, 256, wv}; pg8::Order S; S.init(512, 512, 1, G, (bx + G - 228) % G);
          pg8::EpiVt E{(bf16_t*)(ws + WS_VTP), (bf16_t*)(ws + WS_VTS), (const float*)(ws + WS_RSSKV), 1}; pg8::gemm_phase<pg8::EpiVt, pg8::Order>(lds, g, S, E); }
#endif
        __syncthreads();
        if (bx < 224) {
            for (int u = bx; u < 512; u += 224) gla_stepA(a, wv, lds, u);
            p3_row_extras(a, wv, bx * 8 + (otid(wv) >> 6), 224 * 8);
        }
    } SEAM(3);
    if (IN(4)) { gla_scan(a, wv, vcu, G); } SEAM(4);
    if (IN(5)) {
        for (int rep = 0; rep < PROBE_ATT_REP; ++rep) for (int u = vcu; u < 512; u += G) attn_unit(a, wv, lds, u);
        for (int rep = 0; rep < PROBE_GLAC_REP; ++rep) for (int u = vcu; u < 512; u += G) gla_stepC(a, wv, lds, u);
    } SEAM(5);
    if (IN(6)) {
        pg8::Gemm g{(const bf16_t*)(ws + WS_MIX), (const bf16_t*)(ws + WS_WOUT), D, D, PROBE_K6, wv}; pg8::Order S; S.init(MTOK, D, 1024 / PROBE_K6, G, bx);
        pg8::EpiPart E{(bf16_t*)(ws + WS_P0), (bf16_t*)(ws + WS_P1A)}; pg8::gemm_phase<pg8::EpiPart, pg8::Order>(lds, g, S, E);
    } SEAM(6);
    if (IN(7)) { for (int rep = 0; rep < PROBE_ROW_REP; ++rep) phase6(a, wv, vcu, G); } SEAM(7);
    if (IN(8)) {
        pg8::Gemm g{(const bf16_t*)(ws + WS_H), (const bf16_t*)(ws + WS_WFFI), D, D, D, wv}; pg8::Order S; S.init(MTOK, 2 * DFF, 1, G, bx);
        pg8::EpiFFI E{(bf16_t*)(ws + WS_HFF)}; for (int rep = 0; rep < PROBE_FFI_REP; ++rep) pg8::gemm_phase<pg8::EpiFFI, pg8::Order>(lds, g, S, E);
    } SEAM(8);
    if (IN(9)) {
        pg8::Gemm g{(const bf16_t*)(ws + WS_HFF), (const bf16_t*)(ws + WS_WFFO), DFF, DFF, DFF / 2, wv}; pg8::Order S; S.init(MTOK, D, 2, G, bx);
        pg8::EpiPart E{(bf16_t*)(ws + WS_P0), (bf16_t*)(ws + WS_P1B)}; pg8::gemm_phase<pg8::EpiPart, pg8::Order>(lds, g, S, E);
    } SEAM(9);
    if (IN(10)) { for (int rep = 0; rep < PROBE_ROW_REP; ++rep) phase9(a, wv, vcu, G); }
    if (PROBE_DUMP) {
        if (PROBE_DUMP != 5 && PROBE_DUMP != 7) { ++nbar; } if (PROBE_DUMP != 5 && PROBE_DUMP != 7) my_grid_barrier(nbar, (unsigned)G, otid(wv), (LAS unsigned*)(lds + LDS_BYTES - 64));
        const bf16_t* src = (const bf16_t*)(ws + (PROBE_DUMP == 1 ? WS_Z : PROBE_DUMP == 2 ? WS_MIX : WS_H)); const int pitch = PROBE_DUMP == 1 ? ZP : D;
        for (size_t i = (size_t)bx * 512 + otid(wv); i < (size_t)MTOK * D; i += (size_t)G * 512) { const int r = (int)(i >> 10), c = (int)(i & 1023); a.out[i] = PROBE_DUMP == 7 ? 1.0f : PROBE_DUMP == 6 ? (r < 2304 ? bf2f(((const bf16_t*)(ws + WS_WIN))[(size_t)r * 1024 + c]) : 0.f) : PROBE_DUMP >= 4 ? xrow_ptr(a, r)[c] * 2.f : bf2f(src[(size_t)r * pitch + c]); }
        for (size_t i = O_KV + (size_t)bx * 512 + otid(wv); i < 10616832; i += (size_t)G * 512) a.out[i] = 0.f;
    }
    for (int xb = 0; xb < PROBE_XBAR; ++xb) { ++nbar; my_grid_barrier(nbar, (unsigned)G, otid(wv), (LAS unsigned*)(lds + LDS_BYTES - 64)); }
    if (nbar) my_grid_barrier_finish((unsigned)G, otid(wv));
#undef IN
#undef SEAM
}

extern "C" void kernel_launch(void* const* d_in, const int* in_sizes, int n_in, void* d_out, int out_size, void* d_ws, size_t ws_size, hipStream_t stream) {
    static int grid = 0;
    if (grid == 0) {
        int dev = 0, cus = 0;
        static const int exp_sizes[26] = {4194304, 4194304, 131072, 16384, 65536, 65536, 2048, 1024, 6291456, 6144, 1024, 2293760, 384, 294912, 256, 262144, 4096, 256, 4096, 256, 128, 1048576, 1024, 5767168, 2883584, 1024};
        bool okk = (n_in == 26); for (int i = 0; okk && i < 26; ++i) okk = (in_sizes[i] == exp_sizes[i]);
        if (!okk || out_size != 10616832) { fprintf(stderr, "kernel_launch: unexpected input sizes\n"); grid = -1; return; }
        if (n_in != 26 || ws_size < 198 * MiB) { fprintf(stderr, "kernel_launch: unexpected n_in %d / ws %zu\n", n_in, ws_size); grid = -1; return; }
        hipGetDevice(&dev); hipDeviceGetAttribute(&cus, hipDeviceAttributeMultiprocessorCount, dev);
        if (hipFuncSetAttribute((const void*)mk_fwd, hipFuncAttributeMaxDynamicSharedMemorySize, LDS_BYTES) != hipSuccess) { fprintf(stderr, "kernel_launch: hipFuncSetAttribute failed\n"); grid = -1; return; }
        int per_cu = 0;
        if (hipOccupancyMaxActiveBlocksPerMultiprocessor(&per_cu, (const void*)mk_fwd, 512, LDS_BYTES) != hipSuccess || per_cu < 1) { fprintf(stderr, "kernel_launch: occupancy query says %d\n", per_cu); per_cu = 1; }
        (void)hipGetLastError();
        if (cus < 256) { fprintf(stderr, "kernel_launch: needs 256 CUs, got %d\n", cus); grid = -1; return; }
        grid = 256;
    }
    if (grid < 0) return;
    if (hipMemsetAsync((char*)d_ws + WS_BAR, 0, 4096, stream) != hipSuccess) { fprintf(stderr, "kernel_launch: memset failed\n"); return; }
    Args a{};
    for (int i = 0; i < 26; ++i) a.in[i] = (const float*)d_in[i];
    a.out = (float*)d_out; a.ws = (unsigned char*)d_ws;
#if MK_PER_PHASE_LAUNCH
    for (int p = 0; p < NPHASE; ++p) { if (PROBE_ONLY_LAUNCH >= 0 && p != PROBE_ONLY_LAUNCH) continue; a.ph_lo = p; a.ph_hi = p + 1; hipLaunchKernelGGL(mk_fwd, dim3(grid), dim3(512), LDS_BYTES, stream, a); }
#else
    a.ph_lo = 0; a.ph_hi = NPHASE;
#if MK_COOP
    void* args[] = {&a};
    hipError_t e = hipLaunchCooperativeKernel((const void*)mk_fwd, dim3(grid), dim3(512), args, LDS_BYTES, stream);
    if (e != hipSuccess) fprintf(stderr, "cooperative launch failed: %s (grid %d)\n", hipGetErrorString(e), grid);
#else
    hipLaunchKernelGGL(mk_fwd, dim3(grid), dim3(512), LDS_BYTES, stream, a);
#endif
#endif
}
```

```cpp
#include <hip/hip_runtime.h>
#include <hip/hip_cooperative_groups.h>
#include <cstdio>
#include <cstdint>
namespace cg = cooperative_groups;

#define PROBE_FILL 0
#define PROBE_EXC 0
#define PROBE_BLO 0
#define PROBE_BHI 256
#define PROBE_RSTRIDE 1
#define PROBE_REP 1
#define PROBE_XLO 0
#define PROBE_XHI 8
#define PROBE_HANG 0
#define PROBE_ATT_REP 1
#define PROBE_GLAC_REP 1
#define PROBE_FFI_REP 1
#define PROBE_XBAR 0
#define PROBE_P0_REP 1
#define PROBE_ROW_REP 1
#define PROBE_P3_REP 1
#define PROBE_DUMP 0
#define PROBE_STATS 0
#define PROBE_K6 512
#define PROBE_ONLY_LAUNCH -1
#define PROBE_NOSTORE 0
#define PROBE_FILL_MIB 256
#define PROBE_FILL_VAL 1.2345f
#ifndef PROBE_MUL
#define PROBE_MUL 1.f
#endif
#ifndef PROBE_MODOFF
#define PROBE_MODOFF 0u
#endif
#ifndef MK_COOP
#define MK_COOP 0
#endif
#ifndef MK_PER_PHASE_LAUNCH
#define MK_PER_PHASE_LAUNCH 0
#endif

#define LAS __attribute__((address_space(3)))
typedef unsigned short bf16_t;
typedef short bf16x8 __attribute__((ext_vector_type(8)));
typedef float f32x4 __attribute__((ext_vector_type(4)));
typedef float f32x2 __attribute__((ext_vector_type(2)));
typedef unsigned u32x4 __attribute__((ext_vector_type(4)));
typedef unsigned u32x2 __attribute__((ext_vector_type(2)));

constexpr int D = 1024, MTOK = 8192, MP = 4096;
constexpr int ZP = 2304;
constexpr int C_QLAT = 0, C_KVLAT = 384, C_KROPE = 640, C_GQ = 672, C_GK = 928, C_GV = 1184, C_GFL = 1696, C_GOUT = 1728;
constexpr int DFF = 2816;
constexpr float EPS = 1e-6f;
constexpr float QSCALE = 0.10206207261596577f * 1.4426950408889634f;
constexpr int SKS = 2304;

constexpr size_t MiB = 1u << 20;
constexpr size_t WS_WIN = 1 * MiB;
constexpr size_t WS_WUQ = 6 * MiB;
constexpr size_t WS_WKF = 7 * MiB, WS_WVF = 7 * MiB + 256 * 1024;
constexpr size_t WS_WKU = 7 * MiB + 512 * 1024, WS_WVU = 7 * MiB + 768 * 1024;
constexpr size_t WS_WOUT = 8 * MiB;
constexpr size_t WS_WFFI = 10 * MiB;
constexpr size_t WS_WFFO = 21 * MiB;
constexpr size_t WS_BAR = 27 * MiB - 4096;
constexpr size_t WS_MOD = 27 * MiB;
constexpr size_t WS_RSSQ = 29 * MiB;
constexpr size_t WS_RSSKV = WS_RSSQ;
constexpr size_t WS_CACHEB = 27 * MiB + 512 * 1024;
constexpr size_t WS_DEC = 28 * MiB;
constexpr size_t WS_H = 32 * MiB;
constexpr size_t WS_Z = 48 * MiB;
constexpr size_t WS_Q = 84 * MiB;
constexpr size_t WS_HFF = 48 * MiB;
constexpr size_t WS_KP = 96 * MiB;
constexpr size_t WS_KS = 102 * MiB;
constexpr size_t WS_VTP = 109 * MiB;
constexpr size_t WS_VTS = 113 * MiB;
constexpr size_t WS_CT = 118 * MiB;
constexpr size_t WS_MIX = 150 * MiB;
constexpr size_t WS_X1 = 166 * MiB;
constexpr size_t WS_P0 = 96 * MiB;
constexpr size_t WS_P1A = 48 * MiB, WS_P1B = 128 * MiB;
constexpr size_t O_Y = 0, O_KV = 8388608, O_KR = O_KV + 1048576, O_SF = O_KR + 131072, O_SB = O_SF + 524288;

constexpr int LDS_BYTES = 147456;

__device__ __forceinline__ unsigned f2bf_sw(float f) { unsigned u = __builtin_bit_cast(unsigned, f); return (u + 0x7fffu + ((u >> 16) & 1u)) >> 16; }
__device__ __forceinline__ unsigned cvt_pk_bf16(float lo, float hi) { unsigned r; asm volatile("v_cvt_pk_bf16_f32 %0, %1, %2" : "=v"(r) : "v"(lo), "v"(hi)); return r; }
__device__ __forceinline__ bf16_t f2bf(float f) { return (bf16_t)(cvt_pk_bf16(f, 0.f) & 0xffffu); }
__device__ __forceinline__ float bf2f(bf16_t b) { return __uint_as_float((unsigned)b << 16); }
__device__ __forceinline__ float bflo(unsigned w) { return __uint_as_float(w << 16); }
__device__ __forceinline__ float bfhi(unsigned w) { return __uint_as_float(w & 0xffff0000u); }
__device__ __forceinline__ float wave_sum(float v) {
#pragma unroll
    for (int o = 1; o < 64; o <<= 1) v += __shfl_xor(v, o);
    return v;
}
__device__ __forceinline__ float fast_rcp(float x) { return __builtin_amdgcn_rcpf(x); }
__device__ __forceinline__ float silu_f(float a) { return a * fast_rcp(1.f + __expf(-a)); }
__device__ __forceinline__ float logsigmoid_f(float x) { return fminf(x, 0.f) - __logf(1.f + __expf(-fabsf(x))); }
__device__ __forceinline__ int opaque_lane() { int l; asm volatile("v_mbcnt_lo_u32_b32 %0, -1, 0\n\tv_mbcnt_hi_u32_b32 %0, -1, %0" : "=v"(l)); return l; }
__device__ __forceinline__ int otid(int wv) { int t = (int)threadIdx.x; asm volatile("" : "+v"(t)); return t; }
#define LDS_WAIT() asm volatile("s_waitcnt lgkmcnt(0)" ::: "memory")
#define VM_WAIT() asm volatile("s_waitcnt vmcnt(0)" ::: "memory")

namespace pg8 {
constexpr int BM = 256, BK = 64, HALF = 128, HTB = HALF * BK * 2, STAGE_BYTES = 8 * HTB, NXCD = 8, WGM = 8;
__host__ __device__ __forceinline__ int lds_byte(int r, int c) { const int st = (r >> 4) * 2 + (c >> 5), rr = r & 15, cc = c & 31, ob = rr * 64 + cc * 2; return st * 1024 + (ob ^ (((ob >> 9) & 1) << 5)); }
__host__ __device__ __forceinline__ void stage_rc(int b, int& R, int& C) { const int st = b / 1024, sb = b % 1024, swz = sb ^ (((sb >> 9) & 1) << 5); R = (st >> 1) * 16 + swz / 64; C = (st & 1) * 32 + (swz % 64) / 2; }
__host__ __device__ __forceinline__ int perm32(int rho) { const int n = rho >> 4, i = rho & 15; return 8 * (i >> 2) + 4 * n + (i & 3); }

struct Unit { int pm, pn, ks; };
struct Gemm { const bf16_t* A; const bf16_t* Bt; int lda, ldb, K, wv; };

struct Order {
    int nM, nN, nNs, nwg, G, c;
    __device__ void init(int M, int N, int nsplit, int G_, int c_) { nM = M / BM; nN = N / BM; nNs = nN * nsplit; nwg = nM * nNs; G = G_; c = c_; }
    __device__ bool next(int i, Unit& u) const {
        const long L = (long)i * G + c; if (L >= nwg) return false;
        int wgid = (int)L; { const int q = nwg / NXCD, r = nwg % NXCD, xcd = wgid % NXCD, off = wgid / NXCD; wgid = (xcd < r ? xcd * (q + 1) : r * (q + 1) + (xcd - r) * q) + off; }
        const int nig = WGM * nNs, gid = wgid / nig, fm = gid * WGM, gsz = (nM - fm) < WGM ? (nM - fm) : WGM;
        u.pm = fm + ((wgid % nig) % gsz); const int pn2 = (wgid % nig) / gsz; u.pn = pn2 % nN; u.ks = pn2 / nN; return true;
    }
};

template <class Epi, class Sched, bool ALIGN_EPI = true, bool SP2 = true>
__device__ __forceinline__ void gemm_phase(LAS unsigned char* lds, const Gemm g, const Sched& S, const Epi& E) {
    const int tid = otid(g.wv), wid = g.wv, lane = tid & 63, wr = wid >> 2, wc = wid & 3, fr = lane & 15, fq = lane >> 4;
    const int K = g.K, nt = K / BK;
    unsigned voffA[2], voffB[2];
#pragma unroll
    for (int i = 0; i < 2; ++i) { int R, C; stage_rc(tid * 16 + i * 8192, R, C); const int Rb = Epi::PERM ? ((R & ~31) + perm32(R & 31)) : R;
        voffA[i] = (unsigned)(R * g.lda + C) * 2u; voffB[i] = (unsigned)(Rb * g.ldb + C) * 2u; }
    const size_t kstep = (size_t)(BK * 2);
    const size_t hstepA = (size_t)HALF * g.lda * 2, hstepB = (size_t)HALF * g.ldb * 2;
    const size_t tstepA = 2 * hstepA, tstepB = 2 * hstepB;
    const size_t ksplit = (size_t)K * 2;
    const unsigned ldsw = (unsigned)wid * 1024u;
    const int aoff = lds_byte(wr * 64 + fr, fq * 8), boff = lds_byte(wc * 32 + fr, fq * 8);
#define PG8_SA(b, h) (((b) * 2 + (h)) * HTB)
#define PG8_SB(b, h) ((4 + (b) * 2 + (h)) * HTB)
#define PG8_STAGE(bufoff, gbase, voff) do { _Pragma("unroll") for (int _i = 0; _i < 2; ++_i) \
        __builtin_amdgcn_global_load_lds((const unsigned*)((const char*)(gbase) + (voff)[_i]), (LAS unsigned*)(lds + (bufoff) + ldsw + _i * 8192), 16, 0, 0); } while (0)
#define PG8_LDA(dst, b, h) do { _Pragma("unroll") for (int m = 0; m < 4; ++m) _Pragma("unroll") for (int k = 0; k < 2; ++k) dst[m][k] = *(const LAS bf16x8*)(lds + PG8_SA(b, h) + aoff + m * 2048 + k * 1024); } while (0)
#define PG8_LDB(dst, b, h) do { _Pragma("unroll") for (int n = 0; n < 2; ++n) _Pragma("unroll") for (int k = 0; k < 2; ++k) dst[n][k] = *(const LAS bf16x8*)(lds + PG8_SB(b, h) + boff + n * 2048 + k * 1024); } while (0)
#define PG8_MMA(ai, bj, At, Bt) do { __builtin_amdgcn_s_setprio(1); _Pragma("unroll") for (int m = 0; m < 4; ++m) _Pragma("unroll") for (int n = 0; n < 2; ++n) _Pragma("unroll") for (int k = 0; k < 2; ++k) \
        acc[ai][bj][m][n] = __builtin_amdgcn_mfma_f32_16x16x32_bf16(Bt[n][k], At[m][k], acc[ai][bj][m][n], 0, 0, 0); __builtin_amdgcn_s_setprio(0); } while (0)
#define PG8_WAIT_V(n) asm volatile("s_waitcnt vmcnt(" #n ")" ::: "memory")
#define PG8_WAIT_L(n) asm volatile("s_waitcnt lgkmcnt(" #n ")" ::: "memory")
#define PG8_BAR __builtin_amdgcn_s_barrier()
#define PG8_SCHED __builtin_amdgcn_sched_barrier(0)
    Unit cur, nxt; int ui = 0;
    if (!S.next(0, cur)) return;
    f32x4 acc[2][2][4][2];
#pragma unroll
    for (int a = 0; a < 2; ++a)
#pragma unroll
        for (int b = 0; b < 2; ++b)
#pragma unroll
            for (int m = 0; m < 4; ++m)
#pragma unroll
                for (int n = 0; n < 2; ++n) acc[a][b][m][n] = (f32x4){0.f, 0.f, 0.f, 0.f};
    bf16x8 At[4][2], B0[2][2], B1[2][2];
    const char* cA = (const char*)g.A + (size_t)cur.pm * tstepA + (size_t)cur.ks * ksplit; const char* cB = (const char*)g.Bt + (size_t)cur.pn * tstepB + (size_t)cur.ks * ksplit;
    if constexpr (SP2) {
        PG8_STAGE(PG8_SB(0, 0), cB, voffB); PG8_STAGE(PG8_SB(0, 1), cB + hstepB, voffB); PG8_STAGE(PG8_SA(0, 0), cA, voffA); PG8_STAGE(PG8_SA(0, 1), cA + hstepA, voffA);
        if (wr == 1) PG8_BAR;
        PG8_WAIT_V(2); PG8_BAR;
        PG8_STAGE(PG8_SB(1, 0), cB + kstep, voffB); PG8_STAGE(PG8_SA(1, 0), cA + kstep, voffA); PG8_STAGE(PG8_SB(1, 1), cB + hstepB + kstep, voffB);
        PG8_WAIT_V(6); PG8_BAR;
    } else {
        PG8_STAGE(PG8_SB(0, 0), cB, voffB); PG8_STAGE(PG8_SA(0, 0), cA, voffA); PG8_STAGE(PG8_SB(0, 1), cB + hstepB, voffB); PG8_STAGE(PG8_SA(0, 1), cA + hstepA, voffA);
        if (wr == 1) PG8_BAR;
        PG8_WAIT_V(4); PG8_BAR;
        PG8_STAGE(PG8_SB(1, 0), cB + kstep, voffB); PG8_STAGE(PG8_SA(1, 0), cA + kstep, voffA); PG8_STAGE(PG8_SB(1, 1), cB + hstepB + kstep, voffB);
        PG8_WAIT_V(6); PG8_BAR;
    }
    for (;;) {
        const bool has_next = S.next(ui + 1, nxt);
        const char* nA = has_next ? (const char*)g.A + (size_t)nxt.pm * tstepA + (size_t)nxt.ks * ksplit : cA; const char* nB = has_next ? (const char*)g.Bt + (size_t)nxt.pn * tstepB + (size_t)nxt.ks * ksplit : cB;
#pragma nounroll
        for (int t = 0; t < nt; t += 2) {
            const bool last = (t == nt - 2);
            const char* a1 = cA + (size_t)(t + 1) * kstep;
            const char* a2 = last ? nA : cA + (size_t)(t + 2) * kstep; const char* b2 = last ? nB : cB + (size_t)(t + 2) * kstep;
            const char* a3 = a2 + kstep; const char* b3 = b2 + kstep;
            if constexpr (SP2) {
            PG8_LDB(B0, 0, 0); PG8_LDB(B1, 0, 1); PG8_SCHED; PG8_LDA(At, 0, 0); PG8_STAGE(PG8_SA(1, 1), a1 + hstepA, voffA);
            PG8_WAIT_V(8); PG8_WAIT_L(0); PG8_BAR; PG8_MMA(0, 0, At, B0); PG8_MMA(0, 1, At, B1); PG8_BAR; PG8_SCHED;
            PG8_LDA(At, 0, 1); PG8_STAGE(PG8_SB(0, 0), b2, voffB); PG8_STAGE(PG8_SB(0, 1), b2 + hstepB, voffB); PG8_STAGE(PG8_SA(0, 0), a2, voffA);
            PG8_WAIT_V(8); PG8_WAIT_L(0); PG8_BAR; PG8_MMA(1, 0, At, B0); PG8_MMA(1, 1, At, B1); PG8_BAR; PG8_SCHED;
            PG8_LDB(B0, 1, 0); PG8_LDB(B1, 1, 1); PG8_SCHED; PG8_LDA(At, 1, 0); PG8_STAGE(PG8_SA(0, 1), a2 + hstepA, voffA);
            PG8_WAIT_V(8); PG8_WAIT_L(0); PG8_BAR; PG8_MMA(0, 0, At, B0); PG8_MMA(0, 1, At, B1); PG8_BAR; PG8_SCHED;
            PG8_LDA(At, 1, 1); PG8_STAGE(PG8_SB(1, 0), b3, voffB); PG8_STAGE(PG8_SB(1, 1), b3 + hstepB, voffB); PG8_STAGE(PG8_SA(1, 0), a3, voffA);
            PG8_WAIT_V(8); PG8_WAIT_L(0); PG8_BAR; PG8_MMA(1, 0, At, B0); PG8_MMA(1, 1, At, B1); PG8_BAR; PG8_SCHED;
            } else {
            PG8_LDB(B0, 0, 0); PG8_SCHED; PG8_LDA(At, 0, 0); PG8_STAGE(PG8_SA(1, 1), a1 + hstepA, voffA);
            PG8_WAIT_L(8); PG8_BAR; PG8_WAIT_L(0); PG8_MMA(0, 0, At, B0); PG8_BAR; PG8_SCHED;
            PG8_LDB(B1, 0, 1); PG8_STAGE(PG8_SB(0, 0), b2, voffB);
            PG8_BAR; PG8_WAIT_L(0); PG8_MMA(0, 1, At, B1); PG8_BAR;
            PG8_LDA(At, 0, 1); PG8_STAGE(PG8_SA(0, 0), a2, voffA);
            PG8_BAR; PG8_WAIT_L(0); PG8_MMA(1, 0, At, B0); PG8_BAR; PG8_SCHED;
            PG8_STAGE(PG8_SB(0, 1), b2 + hstepB, voffB);
            PG8_WAIT_V(6); PG8_BAR; PG8_MMA(1, 1, At, B1); PG8_BAR;
            PG8_LDB(B0, 1, 0); PG8_SCHED; PG8_LDA(At, 1, 0); PG8_STAGE(PG8_SA(0, 1), a2 + hstepA, voffA);
            PG8_WAIT_L(8); PG8_BAR; PG8_WAIT_L(0); PG8_MMA(0, 0, At, B0); PG8_BAR; PG8_SCHED;
            PG8_LDB(B1, 1, 1); PG8_STAGE(PG8_SB(1, 0), b3, voffB);
            PG8_BAR; PG8_WAIT_L(0); PG8_MMA(0, 1, At, B1); PG8_BAR;
            PG8_LDA(At, 1, 1); PG8_STAGE(PG8_SA(1, 0), a3, voffA);
            PG8_BAR; PG8_WAIT_L(0); PG8_MMA(1, 0, At, B0); PG8_BAR; PG8_SCHED;
            PG8_STAGE(PG8_SB(1, 1), b3 + hstepB, voffB);
            PG8_WAIT_V(6); PG8_BAR; PG8_MMA(1, 1, At, B1); PG8_BAR;
            }
        }
        if constexpr (ALIGN_EPI) { if (wr == 0) PG8_BAR; }
        E(acc, cur, wr, wc, fr, fq);
        if (!has_next) break;
#pragma unroll
        for (int a = 0; a < 2; ++a)
#pragma unroll
            for (int b = 0; b < 2; ++b)
#pragma unroll
                for (int m = 0; m < 4; ++m)
#pragma unroll
                    for (int n = 0; n < 2; ++n) acc[a][b][m][n] = (f32x4){0.f, 0.f, 0.f, 0.f};
        cur = nxt; cA = nA; cB = nB; ++ui;
        if constexpr (ALIGN_EPI) { if (wr == 1) PG8_BAR; }
    }
    PG8_WAIT_V(0);
    if constexpr (!ALIGN_EPI) { if (wr == 0) PG8_BAR; }
    PG8_BAR;
#undef PG8_SA
#undef PG8_SB
#undef PG8_STAGE
#undef PG8_LDA
#undef PG8_LDB
#undef PG8_MMA
#undef PG8_WAIT_V
#undef PG8_WAIT_L
#undef PG8_BAR
#undef PG8_SCHED
}

__device__ __forceinline__ float rss_q(const float* rss, int row) { float s = 0.f;
#pragma unroll
    for (int p = 0; p < 12; ++p) s += rss[(size_t)p * MTOK + row]; return s; }
__device__ __forceinline__ float rss_kv(const float* rss, int row) { float s = 0.f;
#pragma unroll
    for (int p = 12; p < 20; ++p) s += rss[(size_t)p * MTOK + row]; return s; }
#define EPI_ROWS_BEGIN _Pragma("unroll") for (int ai = 0; ai < 2; ++ai) _Pragma("unroll") for (int m = 0; m < 4; ++m) { const int row = u.pm * BM + wr * 64 + fr + ai * HALF + m * 16;
#define EPI_ROWS_END asm volatile("" ::: "memory"); }

struct EpiZ {
    static constexpr bool PERM = true;
    bf16_t* Z; float* rssq; float* rsskv; int pn_off;
    __device__ __forceinline__ void operator()(const f32x4 (&acc)[2][2][4][2], const Unit& u, int wr, int wc, int fr_, int fq_) const {
        int lane_e = (int)threadIdx.x & 63; asm volatile("" : "+v"(lane_e)); const int fr = lane_e & 15, fq = lane_e >> 4;
        const int col0 = (u.pn + pn_off) * BM + wc * 32 + 8 * fq;
        EPI_ROWS_BEGIN
            bf16_t* rowp = Z + (size_t)row * ZP + col0;
#pragma unroll
            for (int bj = 0; bj < 2; ++bj) { const f32x4 v0 = acc[ai][bj][m][0], v1 = acc[ai][bj][m][1];
                u32x4 w; w.x = cvt_pk_bf16(v0[0], v0[1]); w.y = cvt_pk_bf16(v0[2], v0[3]); w.z = cvt_pk_bf16(v1[0], v1[1]); w.w = cvt_pk_bf16(v1[2], v1[3]);
                *(u32x4*)(rowp + bj * HALF) = w;
                const int hc = 2 * (u.pn + pn_off) + bj;
                if (hc < 5) { float s = (v0[0] * v0[0] + v0[1] * v0[1]) + (v0[2] * v0[2] + v0[3] * v0[3]) + (v1[0] * v1[0] + v1[1] * v1[1]) + (v1[2] * v1[2] + v1[3] * v1[3]);
                    s += __shfl_xor(s, 16); s += __shfl_xor(s, 32);
                    if (fq == 0) rssq[(size_t)(hc * 4 + wc) * MTOK + row] = s; } }
        EPI_ROWS_END
    }
};

struct EpiQ {
    static constexpr bool PERM = true;
    bf16_t* Q; const float* rssq;
    __device__ __forceinline__ void operator()(const f32x4 (&acc)[2][2][4][2], const Unit& u, int wr, int wc, int fr_, int fq_) const {
        int lane_e = (int)threadIdx.x & 63; asm volatile("" : "+v"(lane_e)); const int fr = lane_e & 15, fq = lane_e >> 4;
        const int col0 = u.pn * BM + wc * 32 + 8 * fq;
        const float inv[8] = {1.f, 0.316227766f, 0.1f, 0.0316227766f, 0.01f, 0.00316227766f, 0.001f, 0.000316227766f};
        EPI_ROWS_BEGIN
            const float rs = rsqrtf(rss_q(rssq, row) * (1.f / 384.f) + EPS) * QSCALE;
            const int t = (row - MP) & 2047;
#pragma unroll
            for (int bj = 0; bj < 2; ++bj) { const int c = col0 + bj * HALF; const int j0 = c % 96;
                const bool rp = (row >= MP && j0 >= 64);
                const float pos = (float)((j0 < 80) ? (t >> 6) : (t & 63)) * 0.15915494309189535f;
                const float sg = (j0 & 8) ? 1.f : -1.f;
#pragma unroll
                for (int n = 0; n < 2; ++n) {
                    f32x4 v = acc[ai][bj][m][n] * rs;
#pragma unroll
                    for (int i = 0; i < 4; ++i) { const float p = __shfl_xor(v[i], 16);
                        const float rev = pos * inv[4 * n + i]; const float rf = rev - floorf(rev);
                        const float cs = __builtin_amdgcn_cosf(rf), sn = __builtin_amdgcn_sinf(rf); v[i] = rp ? v[i] * cs + sg * p * sn : v[i]; }
                    u32x2 w; w.x = cvt_pk_bf16(v[0], v[1]); w.y = cvt_pk_bf16(v[2], v[3]);
                    *(u32x2*)(Q + (size_t)row * 768 + c + 4 * n) = w; } }
        EPI_ROWS_END
    }
};

struct EpiK {
    static constexpr bool PERM = true;
    bf16_t* Kp; bf16_t* Ks; const float* rsskv; int ctx;
    __device__ __forceinline__ void operator()(const f32x4 (&acc)[2][2][4][2], const Unit& u, int wr, int wc, int fr_, int fq_) const {
        int lane_e = (int)threadIdx.x & 63; asm volatile("" : "+v"(lane_e)); const int fr = lane_e & 15, fq = lane_e >> 4;
        EPI_ROWS_BEGIN
            float rs = 1.f; unsigned off; bool smp;
            if (ctx) { off = ((unsigned)(row >> 8) * 8u * SKS + (row & 255)) * 96u; smp = true; }
            else { rs = rsqrtf(rss_kv(rsskv, row) * (1.f / 256.f) + EPS);
                if (row < MP) { off = ((unsigned)(row >> 8) * 8u * 256u + (row & 255)) * 96u; smp = false; } else { off = ((unsigned)((row - MP) >> 11) * 8u * SKS + 256u + ((row - MP) & 2047)) * 96u; smp = true; } }
            bf16_t* base = smp ? Ks : Kp; const unsigned hs = (smp ? SKS : 256) * 96u;
#pragma unroll
            for (int bj = 0; bj < 2; ++bj) { const unsigned h = 4 * u.pn + 2 * bj + (wc >> 1); const unsigned j = (wc & 1) * 32 + 8 * fq;
                const f32x4 v0 = acc[ai][bj][m][0] * rs, v1 = acc[ai][bj][m][1] * rs;
                u32x4 w; w.x = cvt_pk_bf16(v0[0], v0[1]); w.y = cvt_pk_bf16(v0[2], v0[3]); w.z = cvt_pk_bf16(v1[0], v1[1]); w.w = cvt_pk_bf16(v1[2], v1[3]);
                *(u32x4*)(base + (off + h * hs + j)) = w; }
        EPI_ROWS_END
    }
};

struct EpiVt {
    static constexpr bool PERM = true;
    bf16_t* Vtp; bf16_t* Vts; const float* rsskv; int ctx;
    __device__ __forceinline__ void operator()(const f32x4 (&acc)[2][2][4][2], const Unit& u, int wr, int wc, int fr_, int fq_) const {
        int lane_e = (int)threadIdx.x & 63; asm volatile("" : "+v"(lane_e)); const int fr = lane_e & 15, fq = lane_e >> 4;
#pragma unroll
        for (int bj = 0; bj < 2; ++bj) {
            const int tok = u.pn * BM + bj * HALF + wc * 32 + 8 * fq;
            f32x4 r0 = {1.f, 1.f, 1.f, 1.f}, r1 = {1.f, 1.f, 1.f, 1.f}; unsigned off; bool smp; unsigned S;
            if (ctx) { off = (unsigned)(tok >> 8) * 8u * 64u * SKS + (tok & 255); smp = true; S = SKS; }
            else { f32x4 q0 = {0.f, 0.f, 0.f, 0.f}, q1 = {0.f, 0.f, 0.f, 0.f};
#pragma unroll
                for (int p = 12; p < 20; ++p) { q0 += *(const f32x4*)(rsskv + (size_t)p * MTOK + tok); q1 += *(const f32x4*)(rsskv + (size_t)p * MTOK + tok + 4); }
#pragma unroll
                for (int i = 0; i < 4; ++i) { r0[i] = rsqrtf(q0[i] * (1.f / 256.f) + EPS); r1[i] = rsqrtf(q1[i] * (1.f / 256.f) + EPS); }
                if (tok < MP) { off = (unsigned)(tok >> 8) * 8u * 64u * 256u + (tok & 255); smp = false; S = 256; } else { off = (unsigned)((tok - MP) >> 11) * 8u * 64u * SKS + 256u + ((tok - MP) & 2047); smp = true; S = SKS; } }
            bf16_t* base = smp ? Vts : Vtp;
#pragma unroll
            for (int ai = 0; ai < 2; ++ai)
#pragma unroll
                for (int m = 0; m < 4; ++m) { const unsigned hd = u.pm * BM + wr * 64 + fr + ai * HALF + m * 16;
                    const f32x4 v0 = acc[ai][bj][m][0] * r0, v1 = acc[ai][bj][m][1] * r1;
                    u32x4 w; w.x = cvt_pk_bf16(v0[0], v0[1]); w.y = cvt_pk_bf16(v0[2], v0[3]); w.z = cvt_pk_bf16(v1[0], v1[1]); w.w = cvt_pk_bf16(v1[2], v1[3]);
                    *(u32x4*)(base + (off + hd * S)) = w; }
            asm volatile("" ::: "memory");
        }
    }
};

struct EpiPart {
    static constexpr bool PERM = true;
    bf16_t* P0; bf16_t* P1;
    __device__ __forceinline__ void operator()(const f32x4 (&acc)[2][2][4][2], const Unit& u, int wr, int wc, int fr_, int fq_) const {
        int lane_e = (int)threadIdx.x & 63; asm volatile("" : "+v"(lane_e)); const int fr = lane_e & 15, fq = lane_e >> 4;
        const int col0 = u.pn * BM + wc * 32 + 8 * fq; bf16_t* P = u.ks ? P1 : P0;
        EPI_ROWS_BEGIN
            bf16_t* rowp = P + (size_t)row * D + col0;
#pragma unroll
            for (int bj = 0; bj < 2; ++bj) { const f32x4 v0 = acc[ai][bj][m][0], v1 = acc[ai][bj][m][1];
                u32x4 w; w.x = cvt_pk_bf16(v0[0], v0[1]); w.y = cvt_pk_bf16(v0[2], v0[3]); w.z = cvt_pk_bf16(v1[0], v1[1]); w.w = cvt_pk_bf16(v1[2], v1[3]);
                *(u32x4*)(rowp + bj * HALF) = w; }
        EPI_ROWS_END
    }
};

struct EpiFFI {
    static constexpr bool PERM = true;
    bf16_t* H;
    __device__ __forceinline__ void operator()(const f32x4 (&acc)[2][2][4][2], const Unit& u, int wr, int wc, int fr_, int fq_) const {
        int lane_e = (int)threadIdx.x & 63; asm volatile("" : "+v"(lane_e)); const int fr = lane_e & 15, fq = lane_e >> 4;
        const int col0 = u.pn * HALF + wc * 32 + 8 * fq;
        EPI_ROWS_BEGIN
            float o[8];
#pragma unroll
            for (int i = 0; i < 4; ++i) { o[i] = silu_f(acc[ai][0][m][0][i]) * acc[ai][1][m][0][i]; o[4 + i] = silu_f(acc[ai][0][m][1][i]) * acc[ai][1][m][1][i]; }
            u32x4 w; w.x = cvt_pk_bf16(o[0], o[1]); w.y = cvt_pk_bf16(o[2], o[3]); w.z = cvt_pk_bf16(o[4], o[5]); w.w = cvt_pk_bf16(o[6], o[7]);
            *(u32x4*)(H + (size_t)row * DFF + col0) = w;
        EPI_ROWS_END
    }
};
}

struct Args { const float* in[26]; float* out; unsigned char* ws; int ph_lo, ph_hi; };
enum { I_XP = 0, I_XS, I_CKV, I_CKR, I_SF, I_SB, I_C, I_CCTX, I_WADA, I_BADA, I_NATT, I_WIN, I_QN, I_WUQ, I_KVN, I_WUKV, I_WGF, I_BGF, I_WGB, I_BGB, I_GLAN, I_WOUT, I_NFFN, I_WFFI, I_WFFO, I_FN };

__device__ __forceinline__ const float* xrow_ptr(const Args& a, int r) { return r < MP ? a.in[I_XP] + (size_t)r * D : a.in[I_XS] + (size_t)(r - MP) * D; }
__device__ __forceinline__ int cond_of_row(int r) { return r < MP ? 0 : 1 + ((r - MP) >> 11); }

__device__ __forceinline__ void p0_tr(const float* W, int K, int N, bf16_t* WT, bf16_t* WT2, const float* kscale, int kb, int nb, int drow, LAS float* scr, int lane) {
    const int k0 = 64 * kb, n0 = 32 * nb;
#pragma unroll 8
    for (int i = 0; i < 32; ++i) { const int kk = 2 * i + (lane >> 5); scr[kk * 33 + (lane & 31)] = W[(size_t)(k0 + kk) * N + n0 + (lane & 31)]; }
    LDS_WAIT();
    const int c = lane & 7;
    float sc[8];
#pragma unroll
    for (int i = 0; i < 8; ++i) sc[i] = kscale ? kscale[k0 + 8 * c + i] : 1.f;
#pragma unroll
    for (int j = 0; j < 4; ++j) { const int n = (lane >> 3) + 8 * j; const LAS float* s = scr + (8 * c) * 33 + n;
        float v[8];
#pragma unroll
        for (int i = 0; i < 8; ++i) v[i] = s[i * 33];
        if (WT2) { u32x4 o; o.x = cvt_pk_bf16(v[0], v[1]); o.y = cvt_pk_bf16(v[2], v[3]); o.z = cvt_pk_bf16(v[4], v[5]); o.w = cvt_pk_bf16(v[6], v[7]);
            *(u32x4*)(WT2 + (size_t)(drow + n0 + n) * K + k0 + 8 * c) = o; }
        u32x4 o; o.x = cvt_pk_bf16(v[0] * sc[0], v[1] * sc[1]); o.y = cvt_pk_bf16(v[2] * sc[2], v[3] * sc[3]); o.z = cvt_pk_bf16(v[4] * sc[4], v[5] * sc[5]); o.w = cvt_pk_bf16(v[6] * sc[6], v[7] * sc[7]);
        *(u32x4*)(WT + (size_t)(drow + n0 + n) * K + k0 + 8 * c) = o; }
    LDS_WAIT();
}

__device__ __forceinline__ void phase0(const Args& a, int wv, LAS unsigned char* lds, int vcu, int G) {
    const int tid = otid(wv), lane = tid & 63, wave = __builtin_amdgcn_readfirstlane(tid >> 6);
    unsigned char* ws = a.ws;
#ifndef P0MASK
#define P0MASK 7
#endif
    if (P0MASK & 2) {
        LAS float* scr = (LAS float*)(lds + wave * 16384);
        LAS float* scnd = (LAS float*)(lds + 131072);
        for (int i = tid; i < 3072; i += 512) { const int ci = i >> 10, k = i & 1023; scnd[i] = silu_f(ci == 0 ? a.in[I_CCTX][k] : a.in[I_C][(ci - 1) * D + k]); }
        __syncthreads();
        const int gw = vcu * 8 + wave, NGW = G * 8;
        constexpr int T_IN = 16 * 70, T_UQ = 6 * 24, T_UKV = 4 * 32, T_OUT = 16 * 32, T_FFI = 16 * 176, T_FFO = 44 * 32, T_ZERO = 64, T_ADA = 768;
        constexpr int NIT = T_ADA + T_IN + T_UQ + T_UKV + T_OUT + T_FFI + T_FFO + T_ZERO;
        for (int it = gw; it < NIT; it += NGW) {
            int r = it;
            if (r < T_ADA) {
                const int nbq = r >> 2, kq = r & 3; const int n0 = 32 * nbq; const float* W = a.in[I_WADA];
                const int n = lane & 31, hf = lane >> 5; float s0 = 0.f, s1 = 0.f, s2 = 0.f;
                for (int kb = 4 * kq; kb < 4 * kq + 4; ++kb) { const int k0 = 64 * kb;
#pragma unroll 8
                    for (int i = 0; i < 32; ++i) { const int kk = 2 * i + (lane >> 5); scr[kk * 33 + (lane & 31)] = W[(size_t)(k0 + kk) * 6144 + n0 + (lane & 31)]; }
                    LDS_WAIT();
#pragma unroll 8
                    for (int j = 0; j < 32; ++j) { const int kk = hf * 32 + j; const float w = scr[kk * 33 + n];
                        s0 += w * scnd[k0 + kk]; s1 += w * scnd[1024 + k0 + kk]; s2 += w * scnd[2048 + k0 + kk]; }
                    LDS_WAIT(); }
                s0 += __shfl_xor(s0, 32); s1 += __shfl_xor(s1, 32); s2 += __shfl_xor(s2, 32);
                float* MOD = (float*)(ws + WS_MOD) + (size_t)kq * 18432;
                if (hf == 0) { MOD[n0 + n] = s0; MOD[6144 + n0 + n] = s1; MOD[12288 + n0 + n] = s2; }
                continue; } r -= T_ADA;
            if (r < T_FFI) { const int kb = r / 176, nb = r % 176; const int n0 = nb * 32; const int drow = n0 < DFF ? (n0 / 128) * 256 + (n0 % 128) : ((n0 - DFF) / 128) * 256 + 128 + ((n0 - DFF) % 128);
                p0_tr(a.in[I_WFFI], 1024, 5632, (bf16_t*)(ws + WS_WFFI), nullptr, nullptr, kb, nb, drow - n0, scr, lane); continue; } r -= T_FFI;
            if (r < T_FFO) { p0_tr(a.in[I_WFFO], DFF, 1024, (bf16_t*)(ws + WS_WFFO), nullptr, nullptr, r / 32, r % 32, 0, scr, lane); continue; } r -= T_FFO;
            if (r < T_IN) { p0_tr(a.in[I_WIN], 1024, 2240, (bf16_t*)(ws + WS_WIN), nullptr, nullptr, r / 70, r % 70, 0, scr, lane); continue; } r -= T_IN;
            if (r < T_OUT) { p0_tr(a.in[I_WOUT], 1024, 1024, (bf16_t*)(ws + WS_WOUT), nullptr, nullptr, r / 32, r % 32, 0, scr, lane); continue; } r -= T_OUT;
            if (r < T_UQ) { p0_tr(a.in[I_WUQ], 384, 768, (bf16_t*)(ws + WS_WUQ), nullptr, a.in[I_QN], r / 24, r % 24, 0, scr, lane); continue; } r -= T_UQ;
            if (r < T_UKV) { const int nb = r % 32, n0 = nb * 32, hh = n0 >> 7, j0 = n0 & 127; const bool isv = j0 >= 64; const int drow = hh * 64 + (j0 & 63);
                p0_tr(a.in[I_WUKV], 256, 1024, (bf16_t*)(ws + (isv ? WS_WVF : WS_WKF)), (bf16_t*)(ws + (isv ? WS_WVU : WS_WKU)), a.in[I_KVN], r / 32, nb, drow - n0, scr, lane); continue; } r -= T_UKV;
            { u32x4 z = {0u, 0u, 0u, 0u}; u32x4* p = (u32x4*)((bf16_t*)(ws + WS_WIN) + (size_t)(2240 + r) * 1024); p[lane] = z; p[64 + lane] = z; }
        }
    }
    if (P0MASK & 4) {
        const int gt = vcu * 512 + tid, NT = G * 512;
        for (int i = gt; i < 32768; i += NT) { const f32x4 v = ((const f32x4*)a.in[I_CKV])[i]; u32x2 w; w.x = cvt_pk_bf16(v[0], v[1]); w.y = cvt_pk_bf16(v[2], v[3]); ((u32x2*)(ws + WS_CACHEB))[i] = w; }
    }
}

__device__ __forceinline__ f32x4 mod4(const float* modp, const float* bias, int ci, int off) {
    const float* p = modp + ci * 6144 + off;
    return ((*(const f32x4*)p + *(const f32x4*)(p + 18432)) + (*(const f32x4*)(p + 36864) + *(const f32x4*)(p + 55296))) + *(const f32x4*)(bias + off);
}
__device__ __forceinline__ void phase1(const Args& a, int wv, int vcu, int G) {
    if (PROBE_FILL == 3) { float* m = (float*)(a.ws + WS_MOD); for (int i = otid(wv); i < 3 * 6144; i += 512) { unsigned h = (unsigned)i * 2654435761u; h ^= h >> 15; h *= 2246822519u; h ^= h >> 13; m[i] = ((float)(h & 0xffff) * (1.f / 65536.f) - 0.5f) * 2.f; } __syncthreads(); }
    const int tid_ = otid(wv); const int lane = tid_ & 63, wave = tid_ >> 6; const int gw = vcu * 8 + wave, NGW = G * 8;
    const float* mod = (const float*)(a.ws + WS_MOD + PROBE_MODOFF); bf16_t* H = (bf16_t*)(a.ws + WS_H);
    for (int r = gw; r < MTOK; r += NGW * PROBE_RSTRIDE) {
        const f32x4* xr = (const f32x4*)xrow_ptr(a, r) + lane; const int ci_ = cond_of_row(r);
        f32x4 v[4]; float s = 0.f;
#pragma unroll
        for (int j = 0; j < 4; ++j) { v[j] = xr[64 * j]; s += (v[j][0] * v[j][0] + v[j][1] * v[j][1]) + (v[j][2] * v[j][2] + v[j][3] * v[j][3]); }
        const float rstd = rsqrtf(wave_sum(s) * (1.f / D) + EPS);
        u32x2* o = (u32x2*)(H + (size_t)r * D) + lane;
#pragma unroll
        for (int j = 0; j < 4; ++j) { const int c = 4 * lane + 256 * j; const f32x4 w = *(const f32x4*)(a.in[I_NATT] + c), sh = mod4(mod, a.in[I_BADA], ci_, c), scv = mod4(mod, a.in[I_BADA], ci_, 1024 + c);
            const f32x4 y = v[j] * rstd * w * (scv * PROBE_MUL + 1.f) + sh * PROBE_MUL; u32x2 p; p.x = cvt_pk_bf16(y[0], y[1]); p.y = cvt_pk_bf16(y[2], y[3]); if (PROBE_NOSTORE) { if ((p.x ^ p.y) == 0x12345u) o[64 * j] = p; } else o[64 * j] = p; }
    }
}
__device__ __forceinline__ void phase6(const Args& a, int wv, int vcu, int G) {
    const int tid_ = otid(wv); const int lane = tid_ & 63, wave = tid_ >> 6; const int gw = vcu * 8 + wave, NGW = G * 8;
    const float* mod = (const float*)(a.ws + WS_MOD); bf16_t* H = (bf16_t*)(a.ws + WS_H); float* X1 = (float*)(a.ws + WS_X1);
    const bf16_t* P0 = (const bf16_t*)(a.ws + WS_P0); const bf16_t* P1 = (const bf16_t*)(a.ws + WS_P1A);
    for (int r = gw; r < MTOK; r += NGW) {
        const f32x4* xr = (const f32x4*)xrow_ptr(a, r) + lane; const int ci_ = cond_of_row(r);
        const u32x2* p0 = (const u32x2*)(P0 + (size_t)r * D) + lane; const u32x2* p1 = (const u32x2*)(P1 + (size_t)r * D) + lane;
        f32x4 v[4]; float s = 0.f;
#pragma unroll
        for (int j = 0; j < 4; ++j) { const int c = 4 * lane + 256 * j; const f32x4 gt = mod4(mod, a.in[I_BADA], ci_, 2048 + c);
            { const u32x2 qa = p0[64 * j], qb = p1[64 * j]; const f32x4 ps = {bflo(qa.x) + bflo(qb.x), bfhi(qa.x) + bfhi(qb.x), bflo(qa.y) + bflo(qb.y), bfhi(qa.y) + bfhi(qb.y)}; v[j] = xr[64 * j] + gt * ps; } s += (v[j][0] * v[j][0] + v[j][1] * v[j][1]) + (v[j][2] * v[j][2] + v[j][3] * v[j][3]); }
        const float rstd = rsqrtf(wave_sum(s) * (1.f / D) + EPS);
        u32x2* x1 = (u32x2*)((bf16_t*)X1 + (size_t)r * D) + lane; u32x2* o = (u32x2*)(H + (size_t)r * D) + lane;
#pragma unroll
        for (int j = 0; j < 4; ++j) { const int c = 4 * lane + 256 * j; { u32x2 xw; xw.x = cvt_pk_bf16(v[j][0], v[j][1]); xw.y = cvt_pk_bf16(v[j][2], v[j][3]); x1[64 * j] = xw; }
            const f32x4 w = *(const f32x4*)(a.in[I_NFFN] + c), sh = mod4(mod, a.in[I_BADA], ci_, 3072 + c), scv = mod4(mod, a.in[I_BADA], ci_, 4096 + c);
            const f32x4 y = v[j] * rstd * w * (scv + 1.f) + sh; u32x2 p; p.x = cvt_pk_bf16(y[0], y[1]); p.y = cvt_pk_bf16(y[2], y[3]); o[64 * j] = p; }
    }
}
__device__ __forceinline__ void phase9(const Args& a, int wv, int vcu, int G) {
    const int tid_ = otid(wv); const int lane = tid_ & 63, wave = tid_ >> 6; const int gw = vcu * 8 + wave, NGW = G * 8;
    const float* mod = (const float*)(a.ws + WS_MOD); const float* X1 = (const float*)(a.ws + WS_X1);
    const bf16_t* P0 = (const bf16_t*)(a.ws + WS_P0); const bf16_t* P1 = (const bf16_t*)(a.ws + WS_P1B);
    for (int r = gw; r < MTOK; r += NGW) {
        const u32x2* xr = (const u32x2*)((const bf16_t*)X1 + (size_t)r * D) + lane; const int ci_ = cond_of_row(r);
        const u32x2* p0 = (const u32x2*)(P0 + (size_t)r * D) + lane; const u32x2* p1 = (const u32x2*)(P1 + (size_t)r * D) + lane;
        f32x4 v[4]; float s = 0.f;
#pragma unroll
        for (int j = 0; j < 4; ++j) { const int c = 4 * lane + 256 * j; const f32x4 gt = mod4(mod, a.in[I_BADA], ci_, 5120 + c);
            { const u32x2 qa = p0[64 * j], qb = p1[64 * j]; const f32x4 ps = {bflo(qa.x) + bflo(qb.x), bfhi(qa.x) + bfhi(qb.x), bflo(qa.y) + bflo(qb.y), bfhi(qa.y) + bfhi(qb.y)}; const u32x2 xq = xr[64 * j]; const f32x4 xv = {bflo(xq.x), bfhi(xq.x), bflo(xq.y), bfhi(xq.y)}; v[j] = xv + gt * ps; } s += (v[j][0] * v[j][0] + v[j][1] * v[j][1]) + (v[j][2] * v[j][2] + v[j][3] * v[j][3]); }
        const float rstd = rsqrtf(wave_sum(s) * (1.f / D) + EPS);
        f32x4* y = (f32x4*)(a.out + O_Y + (size_t)r * D) + lane;
#pragma unroll
        for (int j = 0; j < 4; ++j) { const int c = 4 * lane + 256 * j; const f32x4 w = *(const f32x4*)(a.in[I_FN] + c); y[64 * j] = v[j] * rstd * w; }
    }
}

__device__ __forceinline__ void p3_row_extras(const Args& a, int wv, int gw, int NGW) {
    const int lane = otid(wv) & 63;
    const bf16_t* Z = (const bf16_t*)(a.ws + WS_Z); const float* rsskv = (const float*)(a.ws + WS_RSSKV);
    bf16_t* Kp = (bf16_t*)(a.ws + WS_KP); bf16_t* Ks = (bf16_t*)(a.ws + WS_KS);
    const float inv[8] = {1.f, 0.316227766f, 0.1f, 0.0316227766f, 0.01f, 0.00316227766f, 0.001f, 0.000316227766f};
    for (int r = gw; r < MTOK + 512; r += NGW) {
        if (r < MTOK) {
            const bf16_t* zr = Z + (size_t)r * ZP;
            if (r < MP) {
                const float rs = rsqrtf(pg8::rss_kv(rsskv, r) * (1.f / 256.f) + EPS);
                const u32x2 w = *(const u32x2*)(zr + C_KVLAT + 4 * lane); const f32x4 g = *(const f32x4*)(a.in[I_KVN] + 4 * lane);
                f32x4 o; o[0] = bflo(w.x) * rs * g[0]; o[1] = bfhi(w.x) * rs * g[1]; o[2] = bflo(w.y) * rs * g[2]; o[3] = bfhi(w.y) * rs * g[3];
                *(f32x4*)(a.out + O_KV + (size_t)r * 256 + 4 * lane) = o;
            }
            const int i = lane & 31;
            float v = bf2f(zr[C_KROPE + i]);
            if (r < MP && lane < 32) a.out[O_KR + (size_t)r * 32 + i] = v;
            const float pv = __shfl_xor(v, 8);
            int b, s; bf16_t* kb;
            if (r >= MP) { const int t = (r - MP) & 2047; const float pos = (float)((i < 16) ? (t >> 6) : (t & 63));
                const float rev = pos * inv[i & 7] * 0.15915494309189535f; const float rf = rev - floorf(rev);
                const float cs = __builtin_amdgcn_cosf(rf), sn = __builtin_amdgcn_sinf(rf); v = v * cs + ((i & 8) ? pv : -pv) * sn;
                b = (r - MP) >> 11; s = 256 + t; kb = Ks + ((size_t)(b * 8) * SKS + s) * 96 + 64 + i;
                const bf16_t o = f2bf(v);
                if (lane < 32) { for (int h = 0; h < 8; ++h) kb[(size_t)h * SKS * 96] = o; }
            } else { b = r >> 8; s = r & 255; kb = Kp + ((size_t)(b * 8) * 256 + s) * 96 + 64 + i; const bf16_t o = f2bf(v);
                if (lane < 32) { for (int h = 0; h < 8; ++h) kb[(size_t)h * 256 * 96] = o; } }
        } else {
            const int rr = r - MTOK, b = rr >> 8, s = rr & 255, i = lane & 31;
            const bf16_t o = f2bf(a.in[I_CKR][(size_t)rr * 32 + i]); bf16_t* kb = Ks + ((size_t)(b * 8) * SKS + s) * 96 + 64 + i;
            if (lane < 32) { for (int h = 0; h < 8; ++h) kb[(size_t)h * SKS * 96] = o; }
        }
    }
}

constexpr int GL_LOW = 0, GL_WG = 8192, GL_BG = 16384, GL_SEG = 16896, GL_RED = 20992, GL_VT = 22528, GL_QF = 40960, GL_KF = GL_QF + 9216, GL_QB = GL_KF + 9216, GL_KB = GL_QB + 9216;
constexpr int GROW = 144;

__device__ __forceinline__ void gla_gates(const Args& a, int wv, LAS unsigned char* lds, int r0, int h, float (&cumF)[8], float (&cumB)[8], float& totF, float& totB) {
    const int tid = otid(wv), d = tid & 63, tg = tid >> 6;
    const bf16_t* Z = (const bf16_t*)(a.ws + WS_Z);
    LAS float* low = (LAS float*)(lds + GL_LOW); LAS float* wg = (LAS float*)(lds + GL_WG); LAS float* bg = (LAS float*)(lds + GL_BG); LAS float* seg = (LAS float*)(lds + GL_SEG);
    { const int t = tid >> 3, r4 = (tid & 7) * 4; const u32x2 w = *(const u32x2*)(Z + (size_t)(r0 + t) * ZP + C_GFL + r4);
      low[t * 32 + r4] = bflo(w.x); low[t * 32 + r4 + 1] = bfhi(w.x); low[t * 32 + r4 + 2] = bflo(w.y); low[t * 32 + r4 + 3] = bfhi(w.y); }
    { const int dir = tid >> 8, r = (tid >> 4) & 15, d4 = (tid & 15) * 4; const f32x4 w = *(const f32x4*)(a.in[dir ? I_WGB : I_WGF] + r * 256 + h * 64 + d4);
      *(LAS f32x4*)(wg + (dir * 16 + r) * 64 + d4) = w; }
    if (tid < 128) { const int dir = tid >> 6; bg[tid] = a.in[dir ? I_BGB : I_BGF][h * 64 + (tid & 63)]; }
    __syncthreads();
    float wf[16], wb[16];
#pragma unroll
    for (int r = 0; r < 16; ++r) { wf[r] = wg[r * 64 + d]; wb[r] = wg[(16 + r) * 64 + d]; }
    const float bf_ = bg[d], bb_ = bg[64 + d];
    float gf[8], gb[8];
#pragma unroll
    for (int i = 0; i < 8; ++i) { const int t = tg * 8 + i; float xf = bf_, xb = bb_;
#pragma unroll
        for (int r = 0; r < 16; ++r) { xf += low[t * 32 + r] * wf[r]; xb += low[t * 32 + 16 + r] * wb[r]; }
        gf[i] = logsigmoid_f(xf) * (1.f / 16.f); gb[i] = logsigmoid_f(xb) * (1.f / 16.f); }
#pragma unroll
    for (int i = 1; i < 8; ++i) gf[i] += gf[i - 1];
#pragma unroll
    for (int i = 6; i >= 0; --i) gb[i] += gb[i + 1];
    seg[tg * 64 + d] = gf[7]; seg[512 + tg * 64 + d] = gb[0];
    __syncthreads();
    float offF = 0.f, offB = 0.f; totF = 0.f; totB = 0.f;
#pragma unroll
    for (int g = 0; g < 8; ++g) { const float sf = seg[g * 64 + d], sb = seg[512 + g * 64 + d]; totF += sf; totB += sb; if (g < tg) offF += sf; if (g > tg) offB += sb; }
#pragma unroll
    for (int i = 0; i < 8; ++i) { cumF[i] = gf[i] + offF; cumB[i] = gb[i] + offB; }
}
__device__ __forceinline__ void gla_load_vT(const Args& a, int wv, LAS unsigned char* lds, int r0, int h) {
    const int tid = otid(wv), e = tid & 127, tq = tid >> 7;
    const bf16_t* Z = (const bf16_t*)(a.ws + WS_Z) + (size_t)r0 * ZP + C_GV + h * 128 + e;
    unsigned w[8];
#pragma unroll
    for (int i = 0; i < 8; ++i) { const unsigned lo = Z[(size_t)(tq * 16 + 2 * i) * ZP], hi = Z[(size_t)(tq * 16 + 2 * i + 1) * ZP]; w[i] = lo | (hi << 16); }
    LAS u32x4* p = (LAS u32x4*)(lds + GL_VT + e * GROW + tq * 32);
    p[0] = (u32x4){w[0], w[1], w[2], w[3]}; p[1] = (u32x4){w[4], w[5], w[6], w[7]};
}

__device__ __forceinline__ void gla_stepA(const Args& a, int wv, LAS unsigned char* lds, int u) {
    const int tid = otid(wv), lane = tid & 63, wave = __builtin_amdgcn_readfirstlane(tid >> 6), d = tid & 63, tg = tid >> 6, fr = lane & 15, fq = lane >> 4;
    const int cgi = u >> 2, h = u & 3, r0 = cgi * 64;
    const bf16_t* Z = (const bf16_t*)(a.ws + WS_Z);
    float cumF[8], cumB[8], totF, totB;
    gla_gates(a, wv, lds, r0, h, cumF, cumB, totF, totB);
    unsigned kf[4], kb[4];
#pragma unroll
    for (int i = 0; i < 4; ++i) { const float k0 = bf2f(Z[(size_t)(r0 + tg * 8 + 2 * i) * ZP + C_GK + h * 64 + d]), k1 = bf2f(Z[(size_t)(r0 + tg * 8 + 2 * i + 1) * ZP + C_GK + h * 64 + d]);
        kf[i] = cvt_pk_bf16(k0 * __expf(totF - cumF[2 * i]), k1 * __expf(totF - cumF[2 * i + 1]));
        kb[i] = cvt_pk_bf16(k0 * __expf(totB - cumB[2 * i]), k1 * __expf(totB - cumB[2 * i + 1])); }
    *(LAS u32x4*)(lds + GL_QF + d * GROW + tg * 16) = (u32x4){kf[0], kf[1], kf[2], kf[3]};
    *(LAS u32x4*)(lds + GL_KF + d * GROW + tg * 16) = (u32x4){kb[0], kb[1], kb[2], kb[3]};
    gla_load_vT(a, wv, lds, r0, h);
    if (tg == 0) { float* dec = (float*)(a.ws + WS_DEC) + (size_t)u * 128; dec[d] = __expf(totF); dec[64 + d] = __expf(totB); }
    __syncthreads();
    const int dir = wave >> 2, eb0 = 2 * (wave & 3);
    const LAS unsigned char* kd = lds + (dir ? GL_KF : GL_QF);
    float* CT = (float*)(a.ws + WS_CT) + ((size_t)u * 2 + dir) * 8192;
#pragma unroll
    for (int eb = 0; eb < 2; ++eb) {
        bf16x8 vf[2];
#pragma unroll
        for (int ks = 0; ks < 2; ++ks) vf[ks] = *(const LAS bf16x8*)(lds + GL_VT + (16 * (eb0 + eb) + fr) * GROW + (32 * ks + 8 * fq) * 2);
#pragma unroll
        for (int db = 0; db < 4; ++db) { f32x4 c = {0.f, 0.f, 0.f, 0.f};
#pragma unroll
            for (int ks = 0; ks < 2; ++ks) { const bf16x8 kfr = *(const LAS bf16x8*)(kd + (16 * db + fr) * GROW + (32 * ks + 8 * fq) * 2); c = __builtin_amdgcn_mfma_f32_16x16x32_bf16(vf[ks], kfr, c, 0, 0, 0); }
#pragma unroll
            for (int j = 0; j < 4; ++j) CT[(16 * (eb0 + eb) + 4 * fq + j) * 64 + 16 * db + fr] = c[j]; }
    }
    __syncthreads();
}

__device__ __forceinline__ void gla_scan(const Args& a, int wv, int vcu, int G) {
    const int gt = vcu * 512 + otid(wv), NT = G * 512;
    float* CTb = (float*)(a.ws + WS_CT); const float* DEC = (const float*)(a.ws + WS_DEC);
    for (int it = gt; it < 32768 + 262144; it += NT) {
        int seq, N, cg0, x;
        if (it < 32768) { seq = 16 + (it >> 14); x = it & 16383; N = 32; cg0 = 64 + 32 * (seq - 16); } else { const int j = it - 32768; seq = j >> 14; x = j & 16383; N = 4; cg0 = 4 * seq; }
        const int h = x >> 12, dir = (x >> 11) & 1, e = (x >> 4) & 127, d4 = (x & 15) * 4;
        f32x4 st = {0.f, 0.f, 0.f, 0.f};
        if (seq >= 16) { const float* s0 = a.in[dir ? I_SB : I_SF] + ((size_t)((seq - 16) * 4 + h) * 64) * 128 + e;
#pragma unroll
            for (int i = 0; i < 4; ++i) st[i] = s0[(size_t)(d4 + i) * 128]; }
        if (N == 32) {
            for (int n0 = 0; n0 < 32; n0 += 8) {
                f32x4 c[8], dc[8];
#pragma unroll
                for (int i = 0; i < 8; ++i) { const int n = dir ? (31 - n0 - i) : (n0 + i); const int u = (cg0 + n) * 4 + h;
                    c[i] = *(const f32x4*)(CTb + ((size_t)u * 2 + dir) * 8192 + e * 64 + d4); dc[i] = *(const f32x4*)(DEC + (size_t)u * 128 + dir * 64 + d4); }
#pragma unroll
                for (int i = 0; i < 8; ++i) { const int n = dir ? (31 - n0 - i) : (n0 + i); const int u = (cg0 + n) * 4 + h;
                    *(f32x4*)(CTb + ((size_t)u * 2 + dir) * 8192 + e * 64 + d4) = st; st = dc[i] * st + c[i]; }
            }
        } else {
            f32x4 c[4], dc[4];
#pragma unroll
            for (int i = 0; i < 4; ++i) { const int n = dir ? (3 - i) : i; const int u = (cg0 + n) * 4 + h;
                c[i] = *(const f32x4*)(CTb + ((size_t)u * 2 + dir) * 8192 + e * 64 + d4); dc[i] = *(const f32x4*)(DEC + (size_t)u * 128 + dir * 64 + d4); }
#pragma unroll
            for (int i = 0; i < 4; ++i) { const int n = dir ? (3 - i) : i; const int u = (cg0 + n) * 4 + h;
                *(f32x4*)(CTb + ((size_t)u * 2 + dir) * 8192 + e * 64 + d4) = st; st = dc[i] * st + c[i]; }
        }
        if (seq < 16) { float* o = a.out + (dir ? O_SB : O_SF) + ((size_t)(seq * 4 + h) * 64) * 128 + e;
#pragma unroll
            for (int i = 0; i < 4; ++i) o[(size_t)(d4 + i) * 128] = st[i]; }
    }
}

__device__ __forceinline__ void gla_stepC(const Args& a, int wv, LAS unsigned char* lds, int u) {
    const int tid = otid(wv), lane = tid & 63, wave = __builtin_amdgcn_readfirstlane(tid >> 6), d = tid & 63, tg = tid >> 6, fr = lane & 15, fq = lane >> 4;
    const int cgi = u >> 2, h = u & 3, r0 = cgi * 64;
    const bf16_t* Z = (const bf16_t*)(a.ws + WS_Z);
    float cumF[8], cumB[8], totF, totB;
    gla_gates(a, wv, lds, r0, h, cumF, cumB, totF, totB);
#pragma unroll
    for (int i = 0; i < 8; ++i) { const int t = tg * 8 + i; const float q = bf2f(Z[(size_t)(r0 + t) * ZP + C_GQ + h * 64 + d]) * 0.125f, k = bf2f(Z[(size_t)(r0 + t) * ZP + C_GK + h * 64 + d]);
        *(LAS bf16_t*)(lds + GL_QF + t * GROW + d * 2) = f2bf(q * __expf(cumF[i]));
        *(LAS bf16_t*)(lds + GL_KF + t * GROW + d * 2) = f2bf(k * __expf(-cumF[i]));
        *(LAS bf16_t*)(lds + GL_QB + t * GROW + d * 2) = f2bf(q * __expf(cumB[i]));
        *(LAS bf16_t*)(lds + GL_KB + t * GROW + d * 2) = f2bf(k * __expf(-cumB[i])); }
    gla_load_vT(a, wv, lds, r0, h);
    __syncthreads();
    const int ch = wave & 1, eq = wave >> 1;
    f32x4 oT[2][2];
#pragma unroll
    for (int i = 0; i < 2; ++i)
#pragma unroll
        for (int j = 0; j < 2; ++j) oT[i][j] = (f32x4){0.f, 0.f, 0.f, 0.f};
#pragma unroll
    for (int dir = 0; dir < 2; ++dir) {
        const LAS unsigned char* qe = lds + (dir ? GL_QB : GL_QF); const LAS unsigned char* ke = lds + (dir ? GL_KB : GL_KF);
        const float* ST = (const float*)(a.ws + WS_CT) + ((size_t)u * 2 + dir) * 8192;
        bf16x8 sf[2][2];
#pragma unroll
        for (int eb = 0; eb < 2; ++eb)
#pragma unroll
            for (int ks = 0; ks < 2; ++ks) { const float* p = ST + (16 * (2 * eq + eb) + fr) * 64 + 32 * ks + 8 * fq; const f32x4 x0 = *(const f32x4*)p, x1 = *(const f32x4*)(p + 4);
                u32x4 w; w.x = cvt_pk_bf16(x0[0], x0[1]); w.y = cvt_pk_bf16(x0[2], x0[3]); w.z = cvt_pk_bf16(x1[0], x1[1]); w.w = cvt_pk_bf16(x1[2], x1[3]); sf[eb][ks] = __builtin_bit_cast(bf16x8, w); }
#pragma unroll
        for (int cb = 0; cb < 2; ++cb) {
            const int cbg = 2 * ch + cb;
            bf16x8 qf[2];
#pragma unroll
            for (int ks = 0; ks < 2; ++ks) qf[ks] = *(const LAS bf16x8*)(qe + (16 * cbg + fr) * GROW + (32 * ks + 8 * fq) * 2);
            f32x4 att[4];
#pragma unroll
            for (int sb = 0; sb < 4; ++sb) {
                f32x4 acc = {0.f, 0.f, 0.f, 0.f};
                const bool need = dir == 0 ? (sb <= cbg) : (sb >= cbg);
                if (need) {
#pragma unroll
                    for (int ks = 0; ks < 2; ++ks) { const bf16x8 kfr = *(const LAS bf16x8*)(ke + (16 * sb + fr) * GROW + (32 * ks + 8 * fq) * 2); acc = __builtin_amdgcn_mfma_f32_16x16x32_bf16(kfr, qf[ks], acc, 0, 0, 0); }
                    if (sb == cbg) {
#pragma unroll
                        for (int j = 0; j < 4; ++j) { const int sl = 4 * fq + j; const bool keep = dir == 0 ? (sl <= fr) : (sl >= fr); acc[j] = keep ? acc[j] : 0.f; } }
                }
                att[sb] = acc;
            }
#pragma unroll
            for (int kp = 0; kp < 2; ++kp) {
                u32x4 w; w.x = cvt_pk_bf16(att[2 * kp][0], att[2 * kp][1]); w.y = cvt_pk_bf16(att[2 * kp][2], att[2 * kp][3]); w.z = cvt_pk_bf16(att[2 * kp + 1][0], att[2 * kp + 1][1]); w.w = cvt_pk_bf16(att[2 * kp + 1][2], att[2 * kp + 1][3]);
                const bf16x8 pb = __builtin_bit_cast(bf16x8, w);
#pragma unroll
                for (int eb = 0; eb < 2; ++eb) { const LAS unsigned char* vp = lds + GL_VT + (16 * (2 * eq + eb) + fr) * GROW + (32 * kp + 4 * fq) * 2;
                    const u32x2 v0 = *(const LAS u32x2*)vp, v1 = *(const LAS u32x2*)(vp + 32); const u32x4 vv = {v0.x, v0.y, v1.x, v1.y};
                    oT[eb][cb] = __builtin_amdgcn_mfma_f32_16x16x32_bf16(__builtin_bit_cast(bf16x8, vv), pb, oT[eb][cb], 0, 0, 0); }
            }
#pragma unroll
            for (int ks = 0; ks < 2; ++ks)
#pragma unroll
                for (int eb = 0; eb < 2; ++eb) oT[eb][cb] = __builtin_amdgcn_mfma_f32_16x16x32_bf16(sf[eb][ks], qf[ks], oT[eb][cb], 0, 0, 0);
        }
    }
    LAS float* red = (LAS float*)(lds + GL_RED);
#pragma unroll
    for (int cb = 0; cb < 2; ++cb) { float s = 0.f;
#pragma unroll
        for (int eb = 0; eb < 2; ++eb)
#pragma unroll
            for (int j = 0; j < 4; ++j) s += oT[eb][cb][j] * oT[eb][cb][j];
        s += __shfl_xor(s, 16); s += __shfl_xor(s, 32);
        if (fq == 0) red[eq * 64 + 16 * (2 * ch + cb) + fr] = s; }
    __syncthreads();
    bf16_t* MIX = (bf16_t*)(a.ws + WS_MIX);
#pragma unroll
    for (int cb = 0; cb < 2; ++cb) { const int c = 16 * (2 * ch + cb) + fr; const float tot = red[c] + red[64 + c] + red[128 + c] + red[192 + c]; const float rstd = rsqrtf(tot * (1.f / 128.f) + EPS);
#pragma unroll
        for (int eb = 0; eb < 2; ++eb) { const int e = 16 * (2 * eq + eb) + 4 * fq; const f32x4 gn = *(const f32x4*)(a.in[I_GLAN] + e);
            const u32x2 gw = *(const u32x2*)(Z + (size_t)(r0 + c) * ZP + C_GOUT + h * 128 + e);
            const float g0 = bflo(gw.x), g1 = bfhi(gw.x), g2 = bflo(gw.y), g3 = bfhi(gw.y);
            const f32x4 o = oT[eb][cb] * rstd * gn; u32x2 w; w.x = cvt_pk_bf16(o[0] * silu_f(g0), o[1] * silu_f(g1)); w.y = cvt_pk_bf16(o[2] * silu_f(g2), o[3] * silu_f(g3));
            *(u32x2*)(MIX + (size_t)(r0 + c) * D + 512 + h * 128 + e) = w; } }
    __syncthreads();
}

constexpr int AT_KROW = 208, AT_VROW = 144, AT_KB = 64 * AT_KROW  , AT_STAGE = AT_KB + 64 * AT_VROW  ;
__device__ __forceinline__ void attn_unit(const Args& a, int wv, LAS unsigned char* lds, int idx) {
    const int tid = otid(wv), lane = tid & 63, wave = __builtin_amdgcn_readfirstlane(tid >> 6), fr = lane & 15, fq = lane >> 4;
    int row0, S, nt; const bf16_t* Kb; const bf16_t* Vb; int h;
    if (idx < 256) { const int b = idx >> 7, qb = idx & 15; h = (idx >> 4) & 7; row0 = MP + b * 2048 + qb * 128; S = SKS; nt = 36;
        Kb = (const bf16_t*)(a.ws + WS_KS) + (size_t)(b * 8 + h) * SKS * 96; Vb = (const bf16_t*)(a.ws + WS_VTS) + (size_t)(b * 8 + h) * 64 * SKS; }
    else { const int j = idx - 256; const int b = j >> 4, qb = j & 1; h = (j >> 1) & 7; row0 = b * 256 + qb * 128; S = 256; nt = 4;
        Kb = (const bf16_t*)(a.ws + WS_KP) + (size_t)(b * 8 + h) * 256 * 96; Vb = (const bf16_t*)(a.ws + WS_VTP) + (size_t)(b * 8 + h) * 64 * 256; }
    const char* src[3]; unsigned step[3]; unsigned dst[3]; bool valid[3];
#pragma unroll
    for (int j = 0; j < 3; ++j) { const int ins = wave + 8 * j; valid[j] = ins < 22;
        if (ins < 13) { const int ck = ins * 64 + lane, r = ck / 13, cc = ck % 13; src[j] = (const char*)Kb + (size_t)r * 192 + (cc < 12 ? cc : 11) * 16; step[j] = 64 * 192; dst[j] = ins * 1024; }
        else { const int cv = (ins - 13) * 64 + lane, r = cv / 9, cc = cv % 9; src[j] = (const char*)Vb + (size_t)r * S * 2 + (cc < 8 ? cc : 7) * 16; step[j] = 128; dst[j] = AT_KB + (ins - 13) * 1024; } }
#define AT_ISSUE(t, buf) do { _Pragma("unroll") for (int j = 0; j < 3; ++j) if (valid[j]) \
        __builtin_amdgcn_global_load_lds((const unsigned*)(src[j] + (size_t)(t) * step[j]), (LAS unsigned*)(lds + (buf) * AT_STAGE + dst[j]), 16, 0, 0); } while (0)
    AT_ISSUE(0, 0);
    const bf16_t* Q = (const bf16_t*)(a.ws + WS_Q) + (size_t)(row0 + wave * 16 + fr) * 768 + h * 96 + 8 * fq;
    bf16x8 qf[3];
#pragma unroll
    for (int ks = 0; ks < 3; ++ks) qf[ks] = *(const bf16x8*)(Q + 32 * ks);
    float mrun = -1e30f, lsum = 0.f;
    f32x4 o[4];
#pragma unroll
    for (int i = 0; i < 4; ++i) o[i] = (f32x4){0.f, 0.f, 0.f, 0.f};
    for (int t = 0; t < nt; ++t) {
        VM_WAIT(); __syncthreads();
        if (t + 1 < nt) AT_ISSUE(t + 1, (t + 1) & 1);
        const LAS unsigned char* kt = lds + (t & 1) * AT_STAGE; const LAS unsigned char* vt = kt + AT_KB;
        f32x4 s[4];
#pragma unroll
        for (int kb = 0; kb < 4; ++kb) { s[kb] = (f32x4){0.f, 0.f, 0.f, 0.f};
#pragma unroll
            for (int ks = 0; ks < 3; ++ks) { const bf16x8 kf = *(const LAS bf16x8*)(kt + (16 * kb + fr) * AT_KROW + (32 * ks + 8 * fq) * 2); s[kb] = __builtin_amdgcn_mfma_f32_16x16x32_bf16(kf, qf[ks], s[kb], 0, 0, 0); } }
        float mx = fmaxf(fmaxf(fmaxf(s[0][0], s[0][1]), fmaxf(s[0][2], s[0][3])), fmaxf(fmaxf(s[1][0], s[1][1]), fmaxf(s[1][2], s[1][3])));
        mx = fmaxf(mx, fmaxf(fmaxf(fmaxf(s[2][0], s[2][1]), fmaxf(s[2][2], s[2][3])), fmaxf(fmaxf(s[3][0], s[3][1]), fmaxf(s[3][2], s[3][3]))));
        mx = fmaxf(mx, __shfl_xor(mx, 16)); mx = fmaxf(mx, __shfl_xor(mx, 32));
        const float mnew = fmaxf(mrun, mx); const float alpha = __builtin_amdgcn_exp2f(mrun - mnew); mrun = mnew;
        float ps = 0.f;
#pragma unroll
        for (int kb = 0; kb < 4; ++kb)
#pragma unroll
            for (int j = 0; j < 4; ++j) { s[kb][j] = __builtin_amdgcn_exp2f(s[kb][j] - mnew); ps += s[kb][j]; }
        lsum = lsum * alpha + ps;
#pragma unroll
        for (int i = 0; i < 4; ++i) o[i] = o[i] * alpha;
#pragma unroll
        for (int kp = 0; kp < 2; ++kp) {
            u32x4 w; w.x = cvt_pk_bf16(s[2 * kp][0], s[2 * kp][1]); w.y = cvt_pk_bf16(s[2 * kp][2], s[2 * kp][3]); w.z = cvt_pk_bf16(s[2 * kp + 1][0], s[2 * kp + 1][1]); w.w = cvt_pk_bf16(s[2 * kp + 1][2], s[2 * kp + 1][3]);
            const bf16x8 pb = __builtin_bit_cast(bf16x8, w);
#pragma unroll
            for (int mb = 0; mb < 4; ++mb) { const LAS unsigned char* vp = vt + (16 * mb + fr) * AT_VROW + (32 * kp + 4 * fq) * 2;
                const u32x2 v0 = *(const LAS u32x2*)vp, v1 = *(const LAS u32x2*)(vp + 32); const u32x4 vv = {v0.x, v0.y, v1.x, v1.y};
                o[mb] = __builtin_amdgcn_mfma_f32_16x16x32_bf16(__builtin_bit_cast(bf16x8, vv), pb, o[mb], 0, 0, 0); }
        }
    }
    lsum += __shfl_xor(lsum, 16); lsum += __shfl_xor(lsum, 32);
    const float il = fast_rcp(lsum);
    bf16_t* MIX = (bf16_t*)(a.ws + WS_MIX) + (size_t)(row0 + wave * 16 + fr) * D + h * 64 + 4 * fq;
#pragma unroll
    for (int mb = 0; mb < 4; ++mb) { u32x2 w; w.x = cvt_pk_bf16(o[mb][0] * il, o[mb][1] * il); w.y = cvt_pk_bf16(o[mb][2] * il, o[mb][3] * il); *(u32x2*)(MIX + 16 * mb) = w; }
    __syncthreads();
#undef AT_ISSUE
}

__device__ unsigned g_bar[64 * 52];
#define GB(i) (g_bar + 64 * (i))
__device__ __forceinline__ unsigned gb_ld(unsigned* p) { return __hip_atomic_load(p, __ATOMIC_RELAXED, __HIP_MEMORY_SCOPE_AGENT); }
__device__ __forceinline__ unsigned gb_add(unsigned* p, unsigned v) { return __hip_atomic_fetch_add(p, v, __ATOMIC_RELAXED, __HIP_MEMORY_SCOPE_AGENT); }
__device__ __forceinline__ unsigned xcc_id() { return (unsigned)__builtin_amdgcn_s_getreg((3 << 11) | 20) & 0xFu; }
__device__ __forceinline__ void my_grid_barrier(unsigned nth, unsigned G, int tid, LAS unsigned* st) {
    asm volatile("s_waitcnt vmcnt(0) lgkmcnt(0)" ::: "memory");
    __syncthreads();
    if (tid == 0) {
        if (nth == 1u) {
            const unsigned x = xcc_id(); unsigned sum, cnt, mine;
            for (;;) { sum = 0u; cnt = 0u; mine = 0u;
#pragma unroll
                for (unsigned j = 0; j < 16; ++j) { const unsigned c = gb_ld(GB(4 + j)); sum += c; cnt += (c > 0u) ? 1u : 0u; mine = (j == x) ? c : mine; }
                if (sum >= G) break; __builtin_amdgcn_s_sleep(1); }
            st[0] = mine; st[1] = cnt; st[2] = x;
        }
        const unsigned nloc = st[0], nx = st[1], x = st[2];
        const unsigned old = gb_add(GB(20 + x), 1u);
        if (old + 1u == nth * nloc) {
            __builtin_amdgcn_fence(__ATOMIC_RELEASE, "agent");
            asm volatile("s_waitcnt vmcnt(0)" ::: "memory");
            const unsigned og = gb_add(GB(1), 1u);
            if (og + 1u == nth * nx) gb_add(GB(2), 1u);
            else while (gb_ld(GB(2)) < nth) __builtin_amdgcn_s_sleep(1);
            __builtin_amdgcn_fence(__ATOMIC_ACQUIRE, "agent");
            gb_add(GB(36 + x), 1u);
            asm volatile("s_waitcnt vmcnt(0)" ::: "memory");
        } else {
            while (gb_ld(GB(36 + x)) < nth) __builtin_amdgcn_s_sleep(1);
            __builtin_amdgcn_fence(__ATOMIC_ACQUIRE, "agent");
            asm volatile("s_waitcnt vmcnt(0)" ::: "memory");
        }
    }
    __syncthreads();
}
__device__ __forceinline__ void my_grid_barrier_finish(unsigned G, int tid) {
    if (tid == 0) {
        const unsigned old = gb_add(GB(0), 1u);
        if (old == G - 1u) { for (int i = 0; i < 52; ++i) __hip_atomic_store(GB(i), 0u, __ATOMIC_RELAXED, __HIP_MEMORY_SCOPE_AGENT); }
    }
}
constexpr int NPHASE = 11;
__global__ void __launch_bounds__(512, 2) mk_fwd(Args a) {
    const int wv = __builtin_amdgcn_readfirstlane((int)threadIdx.x >> 6);
    extern __shared__ __attribute__((aligned(16))) unsigned char lds_raw[];
    LAS unsigned char* lds = (LAS unsigned char*)lds_raw;
    const int G = gridDim.x, bx = blockIdx.x;
    const int vcu = (G % 8 == 0) ? (bx % 8) * (G / 8) + bx / 8 : bx;
    unsigned char* ws = a.ws;
    const int lo = a.ph_lo, hi = a.ph_hi;
#ifndef PHMASK
#define PHMASK 0x7ff
#endif
#define IN(k) (((PHMASK >> (k)) & 1) && lo <= (k) && (k) < hi)
#define SEAM(k) do { if (IN(k) && IN((k) + 1)) { ++nbar; my_grid_barrier(nbar, (unsigned)G, otid(wv), (LAS unsigned*)(lds + LDS_BYTES - 64)); } } while (0)
#ifndef PROBE_FILL
#define PROBE_FILL 0
#endif
    if (PROBE_FILL && lo == 0) { f32x4* p = (f32x4*)a.ws; const size_t n = (size_t)(PROBE_FILL_MIB) << 16; const float fv = PROBE_FILL_VAL;
        for (size_t i = (size_t)bx * 512 + threadIdx.x; i < n; i += (size_t)G * 512) { unsigned h = (unsigned)i * 2654435761u; h ^= h >> 15; h *= 2246822519u; h ^= h >> 13; const float r0 = (float)(h & 0xffff) * (1.f / 65536.f) - 0.5f + fv * 0.f; p[i] = (f32x4){r0, r0 * 1.7f, r0 * -0.3f, r0 + 0.1f}; } }
    if (PROBE_FILL == 2 && lo == 0 && bx == 0) { static const int szs[26] = {4194304, 4194304, 131072, 16384, 65536, 65536, 2048, 1024, 6291456, 6144, 1024, 2293760, 384, 294912, 256, 262144, 4096, 256, 4096, 256, 128, 1048576, 1024, 5767168, 2883584, 1024};
        float sm = 0.f; for (int i = 0; i < 26; ++i) { const int n = szs[i]; const int st = n > 1024 ? n - 1024 : 0; for (int j = st + (int)threadIdx.x; j < n; j += 512) sm += a.in[i][j]; for (int j = threadIdx.x; j < (n < 1024 ? n : 1024); j += 512) sm += a.in[i][j]; }
        ((float*)(a.ws))[threadIdx.x] = sm; }
    if (PROBE_FILL == 5 && lo == 0) { volatile float* p = (volatile float*)a.ws; const float big = p[0] * 0.f + 1e38f, tiny = p[1] * 0.f + 1e-38f, zero = p[2] * 0.f, neg = p[3] * 0.f - 1.f;
        float r = 0.f;
#if PROBE_EXC & 1
        r += big * big;
#endif
#if PROBE_EXC & 2
        r += tiny * tiny;
#endif
#if PROBE_EXC & 4
        r += 1.f / zero;
#endif
#if PROBE_EXC & 8
        r += __builtin_sqrtf(neg);
#endif
        p[4 + bx] = r; }
    unsigned nbar = 0;
    if (otid(wv) == 0) gb_add(GB(4 + xcc_id()), 1u);
    if (IN(0)) { for (int rep = 0; rep < PROBE_P0_REP; ++rep) { phase0(a, wv, lds, vcu, G); __syncthreads(); } } SEAM(0);
    if (IN(1)) { for (int rep = 0; rep < PROBE_ROW_REP; ++rep) phase1(a, wv, vcu, G); } SEAM(1);
    if (PROBE_HANG && lo == 1) { volatile unsigned* q = (volatile unsigned*)(a.ws + 8); while (*q != 0x12345678u) __builtin_amdgcn_s_sleep(20); }
    if (IN(2)) {
        pg8::Gemm g{(const bf16_t*)(ws + WS_H), (const bf16_t*)(ws + WS_WIN), D, D, D, wv}; pg8::Order S; S.init(MTOK, 2048, 1, G, bx);
        pg8::EpiZ E{(bf16_t*)(ws + WS_Z), (float*)(ws + WS_RSSQ), (float*)(ws + WS_RSSKV), 0};
        pg8::gemm_phase<pg8::EpiZ, pg8::Order>(lds, g, S, E);
    } SEAM(2);
    if (IN(3)) {
#ifndef P3MASK
#define P3MASK 0x3f
#endif
#if (P3MASK >> 0) & 1
        { pg8::Gemm g{(const bf16_t*)(ws + WS_Z) + C_QLAT, (const bf16_t*)(ws + WS_WUQ), ZP, 384, 384, wv}; pg8::Order S; S.init(MTOK, 768, 1, G, bx);
          pg8::EpiQ E{(bf16_t*)(ws + WS_Q), (const float*)(ws + WS_RSSQ)}; pg8::gemm_phase<pg8::EpiQ, pg8::Order>(lds, g, S, E); }
#endif
#if (P3MASK >> 1) & 1
        { pg8::Gemm g{(const bf16_t*)(ws + WS_Z) + C_KVLAT, (const bf16_t*)(ws + WS_WKF), ZP, 256, 256, wv}; pg8::Order S; S.init(MTOK, 512, 1, G, (bx + G - 96) % G);
          pg8::EpiK E{(bf16_t*)(ws + WS_KP), (bf16_t*)(ws + WS_KS), (const float*)(ws + WS_RSSKV), 0}; pg8::gemm_phase<pg8::EpiK, pg8::Order>(lds, g, S, E); }
#endif
#if (P3MASK >> 2) & 1
        { pg8::Gemm g{(const bf16_t*)(ws + WS_WVF), (const bf16_t*)(ws + WS_Z) + C_KVLAT, 256, ZP, 256, wv}; pg8::Order S; S.init(512, MTOK, 1, G, (bx + G - 160) % G);
          pg8::EpiVt E{(bf16_t*)(ws + WS_VTP), (bf16_t*)(ws + WS_VTS), (const float*)(ws + WS_RSSKV), 0}; pg8::gemm_phase<pg8::EpiVt, pg8::Order>(lds, g, S, E); }
#endif
        { pg8::Gemm g{(const bf16_t*)(ws + WS_H), (const bf16_t*)(ws + WS_WIN) + (size_t)2048 * D, D, D, D, wv}; pg8::Order S; S.init(MTOK, 256, 1, G, (bx + G - 224) % G);
          pg8::EpiZ E{(bf16_t*)(ws + WS_Z), (float*)(ws + WS_RSSQ), (float*)(ws + WS_RSSKV), 8}; pg8::gemm_phase<pg8::EpiZ, pg8::Order>(lds, g, S, E); }
#if (P3MASK >> 3) & 1
        { pg8::Gemm g{(const bf16_t*)(ws + WS_CACHEB), (const bf16_t*)(ws + WS_WKU), 256, 256, 256, wv}; pg8::Order S; S.init(512, 512, 1, G, (bx + G - 224) % G);
          pg8::EpiK E{(bf16_t*)(ws + WS_KP), (bf16_t*)(ws + WS_KS), (const float*)(ws + WS_RSSKV), 1}; pg8::gemm_phase<pg8::EpiK, pg8::Order>(lds, g, S, E); }
#endif
#if (P3MASK >> 4) & 1
        { pg8::Gemm g{(const bf16_t*)(ws + WS_WVU), (const bf16_t*)(ws + WS_CACHEB), 256, 256, 256, wv}; pg8::Order S; S.init(512, 512, 1, G, (bx + G - 228) % G);
          pg8::EpiVt E{(bf16_t*)(ws + WS_VTP), (bf16_t*)(ws + WS_VTS), (const float*)(ws + WS_RSSKV), 1}; pg8::gemm_phase<pg8::EpiVt, pg8::Order>(lds, g, S, E); }
#endif
        __syncthreads();
        if (bx < 224) {
            for (int u = bx; u < 512; u += 224) gla_stepA(a, wv, lds, u);
            p3_row_extras(a, wv, bx * 8 + (otid(wv) >> 6), 224 * 8);
        }
    } SEAM(3);
    if (IN(4)) { gla_scan(a, wv, vcu, G); } SEAM(4);
    if (IN(5)) {
        for (int rep = 0; rep < PROBE_ATT_REP; ++rep) for (int u = vcu; u < 512; u += G) attn_unit(a, wv, lds, u);
        for (int rep = 0; rep < PROBE_GLAC_REP; ++rep) for (int u = vcu; u < 512; u += G) gla_stepC(a, wv, lds, u);
    } SEAM(5);
    if (IN(6)) {
        pg8::Gemm g{(const bf16_t*)(ws + WS_MIX), (const bf16_t*)(ws + WS_WOUT), D, D, PROBE_K6, wv}; pg8::Order S; S.init(MTOK, D, 1024 / PROBE_K6, G, bx);
        pg8::EpiPart E{(bf16_t*)(ws + WS_P0), (bf16_t*)(ws + WS_P1A)}; pg8::gemm_phase<pg8::EpiPart, pg8::Order>(lds, g, S, E);
    } SEAM(6);
    if (IN(7)) { for (int rep = 0; rep < PROBE_ROW_REP; ++rep) phase6(a, wv, vcu, G); } SEAM(7);
    if (IN(8)) {
        pg8::Gemm g{(const bf16_t*)(ws + WS_H), (const bf16_t*)(ws + WS_WFFI), D, D, D, wv}; pg8::Order S; S.init(MTOK, 2 * DFF, 1, G, bx);
        pg8::EpiFFI E{(bf16_t*)(ws + WS_HFF)}; for (int rep = 0; rep < PROBE_FFI_REP; ++rep) pg8::gemm_phase<pg8::EpiFFI, pg8::Order>(lds, g, S, E);
    } SEAM(8);
    if (IN(9)) {
        pg8::Gemm g{(const bf16_t*)(ws + WS_HFF), (const bf16_t*)(ws + WS_WFFO), DFF, DFF, DFF / 2, wv}; pg8::Order S; S.init(MTOK, D, 2, G, bx);
        pg8::EpiPart E{(bf16_t*)(ws + WS_P0), (bf16_t*)(ws + WS_P1B)}; pg8::gemm_phase<pg8::EpiPart, pg8::Order>(lds, g, S, E);
    } SEAM(9);
    if (IN(10)) { for (int rep = 0; rep < PROBE_ROW_REP; ++rep) phase9(a, wv, vcu, G); }
    if (PROBE_DUMP) {
        if (PROBE_DUMP != 5 && PROBE_DUMP != 7) { ++nbar; } if (PROBE_DUMP != 5 && PROBE_DUMP != 7) my_grid_barrier(nbar, (unsigned)G, otid(wv), (LAS unsigned*)(lds + LDS_BYTES - 64));
        const bf16_t* src = (const bf16_t*)(ws + (PROBE_DUMP == 1 ? WS_Z : PROBE_DUMP == 2 ? WS_MIX : WS_H)); const int pitch = PROBE_DUMP == 1 ? ZP : D;
        for (size_t i = (size_t)bx * 512 + otid(wv); i < (size_t)MTOK * D; i += (size_t)G * 512) { const int r = (int)(i >> 10), c = (int)(i & 1023); a.out[i] = PROBE_DUMP == 7 ? 1.0f : PROBE_DUMP == 6 ? (r < 2304 ? bf2f(((const bf16_t*)(ws + WS_WIN))[(size_t)r * 1024 + c]) : 0.f) : PROBE_DUMP >= 4 ? xrow_ptr(a, r)[c] * 2.f : bf2f(src[(size_t)r * pitch + c]); }
        for (size_t i = O_KV + (size_t)bx * 512 + otid(wv); i < 10616832; i += (size_t)G * 512) a.out[i] = 0.f;
    }
    for (int xb = 0; xb < PROBE_XBAR; ++xb) { ++nbar; my_grid_barrier(nbar, (unsigned)G, otid(wv), (LAS unsigned*)(lds + LDS_BYTES - 64)); }
    if (nbar) my_grid_barrier_finish((unsigned)G, otid(wv));
#undef IN
#undef SEAM
}

extern "C" void kernel_launch(void* const* d_in, const int* in_sizes, int n_in, void* d_out, int out_size, void* d_ws, size_t ws_size, hipStream_t stream) {
    static int grid = 0;
    if (grid == 0) {
        int dev = 0, cus = 0;
        static const int exp_sizes[26] = {4194304, 4194304, 131072, 16384, 65536, 65536, 2048, 1024, 6291456, 6144, 1024, 2293760, 384, 294912, 256, 262144, 4096, 256, 4096, 256, 128, 1048576, 1024, 5767168, 2883584, 1024};
        bool okk = (n_in == 26); for (int i = 0; okk && i < 26; ++i) okk = (in_sizes[i] == exp_sizes[i]);
        if (!okk || out_size != 10616832) { fprintf(stderr, "kernel_launch: unexpected input sizes\n"); grid = -1; return; }
        if (n_in != 26 || ws_size < 198 * MiB) { fprintf(stderr, "kernel_launch: unexpected n_in %d / ws %zu\n", n_in, ws_size); grid = -1; return; }
        hipGetDevice(&dev); hipDeviceGetAttribute(&cus, hipDeviceAttributeMultiprocessorCount, dev);
        if (hipFuncSetAttribute((const void*)mk_fwd, hipFuncAttributeMaxDynamicSharedMemorySize, LDS_BYTES) != hipSuccess) { fprintf(stderr, "kernel_launch: hipFuncSetAttribute failed\n"); grid = -1; return; }
        int per_cu = 0;
        if (hipOccupancyMaxActiveBlocksPerMultiprocessor(&per_cu, (const void*)mk_fwd, 512, LDS_BYTES) != hipSuccess || per_cu < 1) { fprintf(stderr, "kernel_launch: occupancy query says %d\n", per_cu); per_cu = 1; }
        (void)hipGetLastError();
        if (cus < 256) { fprintf(stderr, "kernel_launch: needs 256 CUs, got %d\n", cus); grid = -1; return; }
        grid = 256;
    }
    if (grid < 0) return;
    Args a{};
    for (int i = 0; i < 26; ++i) a.in[i] = (const float*)d_in[i];
    a.out = (float*)d_out; a.ws = (unsigned char*)d_ws;
#if MK_PER_PHASE_LAUNCH
    for (int p = 0; p < NPHASE; ++p) { if (PROBE_ONLY_LAUNCH >= 0 && p != PROBE_ONLY_LAUNCH) continue; a.ph_lo = p; a.ph_hi = p + 1; hipLaunchKernelGGL(mk_fwd, dim3(grid), dim3(512), LDS_BYTES, stream, a); }
#else
    a.ph_lo = 0; a.ph_hi = NPHASE;
#if MK_COOP
    void* args[] = {&a};
    hipError_t e = hipLaunchCooperativeKernel((const void*)mk_fwd, dim3(grid), dim3(512), args, LDS_BYTES, stream);
    if (e != hipSuccess) fprintf(stderr, "cooperative launch failed: %s (grid %d)\n", hipGetErrorString(e), grid);
#else
    hipLaunchKernelGGL(mk_fwd, dim3(grid), dim3(512), LDS_BYTES, stream, a);
#endif
#endif
}
```

```cpp
#include <hip/hip_runtime.h>
#include <hip/hip_cooperative_groups.h>
#include <cstdio>
#include <cstdint>
namespace cg = cooperative_groups;

#define PROBE_FILL 0
#define PROBE_EXC 0
#define PROBE_BLO 0
#define PROBE_BHI 256
#define PROBE_RSTRIDE 1
#define PROBE_REP 1
#define PROBE_XLO 0
#define PROBE_XHI 8
#define PROBE_HANG 0
#define PROBE_ATT_REP 1
#define PROBE_GLAC_REP 1
#define PROBE_FFI_REP 1
#define PROBE_XBAR 0
#define PROBE_P0_REP 1
#define PROBE_ROW_REP 1
#define PROBE_P3_REP 1
#define PROBE_DUMP 0
#define PROBE_STATS 0
#define PROBE_K6 512
#define PROBE_ONLY_LAUNCH -1
#define PROBE_NOSTORE 0
#define PROBE_FILL_MIB 256
#define PROBE_FILL_VAL 1.2345f
#ifndef PROBE_MUL
#define PROBE_MUL 1.f
#endif
#ifndef PROBE_MODOFF
#define PROBE_MODOFF 0u
#endif
#ifndef MK_COOP
#define MK_COOP 0
#endif
#ifndef MK_PER_PHASE_LAUNCH
#define MK_PER_PHASE_LAUNCH 0
#endif

#define LAS __attribute__((address_space(3)))
typedef unsigned short bf16_t;
typedef short bf16x8 __attribute__((ext_vector_type(8)));
typedef float f32x4 __attribute__((ext_vector_type(4)));
typedef float f32x2 __attribute__((ext_vector_type(2)));
typedef unsigned u32x4 __attribute__((ext_vector_type(4)));
typedef unsigned u32x2 __attribute__((ext_vector_type(2)));

constexpr int D = 1024, MTOK = 8192, MP = 4096;
constexpr int ZP = 2304;
constexpr int C_QLAT = 0, C_KVLAT = 384, C_KROPE = 640, C_GQ = 672, C_GK = 928, C_GV = 1184, C_GFL = 1696, C_GOUT = 1728;
constexpr int DFF = 2816;
constexpr float EPS = 1e-6f;
constexpr float QSCALE = 0.10206207261596577f * 1.4426950408889634f;
constexpr int SKS = 2304;

constexpr size_t MiB = 1u << 20;
constexpr size_t WS_WIN = 1 * MiB;
constexpr size_t WS_WUQ = 6 * MiB;
constexpr size_t WS_WKF = 7 * MiB, WS_WVF = 7 * MiB + 256 * 1024;
constexpr size_t WS_WKU = 7 * MiB + 512 * 1024, WS_WVU = 7 * MiB + 768 * 1024;
constexpr size_t WS_WOUT = 8 * MiB;
constexpr size_t WS_WFFI = 10 * MiB;
constexpr size_t WS_WFFO = 21 * MiB;
constexpr size_t WS_BAR = 27 * MiB - 4096;
constexpr size_t WS_MOD = 27 * MiB;
constexpr size_t WS_RSSQ = 29 * MiB;
constexpr size_t WS_RSSKV = WS_RSSQ;
constexpr size_t WS_CACHEB = 27 * MiB + 512 * 1024;
constexpr size_t WS_DEC = 28 * MiB;
constexpr size_t WS_H = 32 * MiB;
constexpr size_t WS_Z = 48 * MiB;
constexpr size_t WS_Q = 84 * MiB;
constexpr size_t WS_HFF = 48 * MiB;
constexpr size_t WS_KP = 96 * MiB;
constexpr size_t WS_KS = 102 * MiB;
constexpr size_t WS_VTP = 109 * MiB;
constexpr size_t WS_VTS = 113 * MiB;
constexpr size_t WS_CT = 118 * MiB;
constexpr size_t WS_MIX = 150 * MiB;
constexpr size_t WS_X1 = 166 * MiB;
constexpr size_t WS_P0 = 96 * MiB;
constexpr size_t WS_P1A = 48 * MiB, WS_P1B = 128 * MiB;
constexpr size_t O_Y = 0, O_KV = 8388608, O_KR = O_KV + 1048576, O_SF = O_KR + 131072, O_SB = O_SF + 524288;

constexpr int LDS_BYTES = 147456;

__device__ __forceinline__ unsigned f2bf_sw(float f) { unsigned u = __builtin_bit_cast(unsigned, f); return (u + 0x7fffu + ((u >> 16) & 1u)) >> 16; }
__device__ __forceinline__ unsigned cvt_pk_bf16(float lo, float hi) { unsigned r; asm volatile("v_cvt_pk_bf16_f32 %0, %1, %2" : "=v"(r) : "v"(lo), "v"(hi)); return r; }
__device__ __forceinline__ bf16_t f2bf(float f) { return (bf16_t)(cvt_pk_bf16(f, 0.f) & 0xffffu); }
__device__ __forceinline__ float bf2f(bf16_t b) { return __uint_as_float((unsigned)b << 16); }
__device__ __forceinline__ float bflo(unsigned w) { return __uint_as_float(w << 16); }
__device__ __forceinline__ float bfhi(unsigned w) { return __uint_as_float(w & 0xffff0000u); }
__device__ __forceinline__ float wave_sum(float v) {
#pragma unroll
    for (int o = 1; o < 64; o <<= 1) v += __shfl_xor(v, o);
    return v;
}
__device__ __forceinline__ float fast_rcp(float x) { return __builtin_amdgcn_rcpf(x); }
__device__ __forceinline__ float silu_f(float a) { return a * fast_rcp(1.f + __expf(-a)); }
__device__ __forceinline__ float logsigmoid_f(float x) { return fminf(x, 0.f) - __logf(1.f + __expf(-fabsf(x))); }
__device__ __forceinline__ int opaque_lane() { int l; asm volatile("v_mbcnt_lo_u32_b32 %0, -1, 0\n\tv_mbcnt_hi_u32_b32 %0, -1, %0" : "=v"(l)); return l; }
__device__ __forceinline__ int otid(int wv) { int t = (int)threadIdx.x; asm volatile("" : "+v"(t)); return t; }
#define LDS_WAIT() asm volatile("s_waitcnt lgkmcnt(0)" ::: "memory")
#define VM_WAIT() asm volatile("s_waitcnt vmcnt(0)" ::: "memory")

namespace pg8 {
constexpr int BM = 256, BK = 64, HALF = 128, HTB = HALF * BK * 2, STAGE_BYTES = 8 * HTB, NXCD = 8, WGM = 8;
__host__ __device__ __forceinline__ int lds_byte(int r, int c) { const int st = (r >> 4) * 2 + (c >> 5), rr = r & 15, cc = c & 31, ob = rr * 64 + cc * 2; return st * 1024 + (ob ^ (((ob >> 9) & 1) << 5)); }
__host__ __device__ __forceinline__ void stage_rc(int b, int& R, int& C) { const int st = b / 1024, sb = b % 1024, swz = sb ^ (((sb >> 9) & 1) << 5); R = (st >> 1) * 16 + swz / 64; C = (st & 1) * 32 + (swz % 64) / 2; }
__host__ __device__ __forceinline__ int perm32(int rho) { const int n = rho >> 4, i = rho & 15; return 8 * (i >> 2) + 4 * n + (i & 3); }

struct Unit { int pm, pn, ks; };
struct Gemm { const bf16_t* A; const bf16_t* Bt; int lda, ldb, K, wv; };

struct Order {
    int nM, nN, nNs, nwg, G, c;
    __device__ void init(int M, int N, int nsplit, int G_, int c_) { nM = M / BM; nN = N / BM; nNs = nN * nsplit; nwg = nM * nNs; G = G_; c = c_; }
    __device__ bool next(int i, Unit& u) const {
        const long L = (long)i * G + c; if (L >= nwg) return false;
        int wgid = (int)L; { const int q = nwg / NXCD, r = nwg % NXCD, xcd = wgid % NXCD, off = wgid / NXCD; wgid = (xcd < r ? xcd * (q + 1) : r * (q + 1) + (xcd - r) * q) + off; }
        const int nig = WGM * nNs, gid = wgid / nig, fm = gid * WGM, gsz = (nM - fm) < WGM ? (nM - fm) : WGM;
        u.pm = fm + ((wgid % nig) % gsz); const int pn2 = (wgid % nig) / gsz; u.pn = pn2 % nN; u.ks = pn2 / nN; return true;
    }
};

template <class Epi, class Sched, bool ALIGN_EPI = true, bool SP2 = true>
__device__ __forceinline__ void gemm_phase(LAS unsigned char* lds, const Gemm g, const Sched& S, const Epi& E) {
    const int tid = otid(g.wv), wid = g.wv, lane = tid & 63, wr = wid >> 2, wc = wid & 3, fr = lane & 15, fq = lane >> 4;
    const int K = g.K, nt = K / BK;
    unsigned voffA[2], voffB[2];
#pragma unroll
    for (int i = 0; i < 2; ++i) { int R, C; stage_rc(tid * 16 + i * 8192, R, C); const int Rb = Epi::PERM ? ((R & ~31) + perm32(R & 31)) : R;
        voffA[i] = (unsigned)(R * g.lda + C) * 2u; voffB[i] = (unsigned)(Rb * g.ldb + C) * 2u; }
    const size_t kstep = (size_t)(BK * 2);
    const size_t hstepA = (size_t)HALF * g.lda * 2, hstepB = (size_t)HALF * g.ldb * 2;
    const size_t tstepA = 2 * hstepA, tstepB = 2 * hstepB;
    const size_t ksplit = (size_t)K * 2;
    const unsigned ldsw = (unsigned)wid * 1024u;
    const int aoff = lds_byte(wr * 64 + fr, fq * 8), boff = lds_byte(wc * 32 + fr, fq * 8);
#define PG8_SA(b, h) (((b) * 2 + (h)) * HTB)
#define PG8_SB(b, h) ((4 + (b) * 2 + (h)) * HTB)
#define PG8_STAGE(bufoff, gbase, voff) do { _Pragma("unroll") for (int _i = 0; _i < 2; ++_i) \
        __builtin_amdgcn_global_load_lds((const unsigned*)((const char*)(gbase) + (voff)[_i]), (LAS unsigned*)(lds + (bufoff) + ldsw + _i * 8192), 16, 0, 0); } while (0)
#define PG8_LDA(dst, b, h) do { _Pragma("unroll") for (int m = 0; m < 4; ++m) _Pragma("unroll") for (int k = 0; k < 2; ++k) dst[m][k] = *(const LAS bf16x8*)(lds + PG8_SA(b, h) + aoff + m * 2048 + k * 1024); } while (0)
#define PG8_LDB(dst, b, h) do { _Pragma("unroll") for (int n = 0; n < 2; ++n) _Pragma("unroll") for (int k = 0; k < 2; ++k) dst[n][k] = *(const LAS bf16x8*)(lds + PG8_SB(b, h) + boff + n * 2048 + k * 1024); } while (0)
#define PG8_MMA(ai, bj, At, Bt) do { __builtin_amdgcn_s_setprio(1); _Pragma("unroll") for (int m = 0; m < 4; ++m) _Pragma("unroll") for (int n = 0; n < 2; ++n) _Pragma("unroll") for (int k = 0; k < 2; ++k) \
        acc[ai][bj][m][n] = __builtin_amdgcn_mfma_f32_16x16x32_bf16(Bt[n][k], At[m][k], acc[ai][bj][m][n], 0, 0, 0); __builtin_amdgcn_s_setprio(0); } while (0)
#define PG8_WAIT_V(n) asm volatile("s_waitcnt vmcnt(" #n ")" ::: "memory")
#define PG8_WAIT_L(n) asm volatile("s_waitcnt lgkmcnt(" #n ")" ::: "memory")
#define PG8_BAR __builtin_amdgcn_s_barrier()
#define PG8_SCHED __builtin_amdgcn_sched_barrier(0)
    Unit cur, nxt; int ui = 0;
    if (!S.next(0, cur)) return;
    f32x4 acc[2][2][4][2];
#pragma unroll
    for (int a = 0; a < 2; ++a)
#pragma unroll
        for (int b = 0; b < 2; ++b)
#pragma unroll
            for (int m = 0; m < 4; ++m)
#pragma unroll
                for (int n = 0; n < 2; ++n) acc[a][b][m][n] = (f32x4){0.f, 0.f, 0.f, 0.f};
    bf16x8 At[4][2], B0[2][2], B1[2][2];
    const char* cA = (const char*)g.A + (size_t)cur.pm * tstepA + (size_t)cur.ks * ksplit; const char* cB = (const char*)g.Bt + (size_t)cur.pn * tstepB + (size_t)cur.ks * ksplit;
    if constexpr (SP2) {
        PG8_STAGE(PG8_SB(0, 0), cB, voffB); PG8_STAGE(PG8_SB(0, 1), cB + hstepB, voffB); PG8_STAGE(PG8_SA(0, 0), cA, voffA); PG8_STAGE(PG8_SA(0, 1), cA + hstepA, voffA);
        if (wr == 1) PG8_BAR;
        PG8_WAIT_V(2); PG8_BAR;
        PG8_STAGE(PG8_SB(1, 0), cB + kstep, voffB); PG8_STAGE(PG8_SA(1, 0), cA + kstep, voffA); PG8_STAGE(PG8_SB(1, 1), cB + hstepB + kstep, voffB);
        PG8_WAIT_V(6); PG8_BAR;
    } else {
        PG8_STAGE(PG8_SB(0, 0), cB, voffB); PG8_STAGE(PG8_SA(0, 0), cA, voffA); PG8_STAGE(PG8_SB(0, 1), cB + hstepB, voffB); PG8_STAGE(PG8_SA(0, 1), cA + hstepA, voffA);
        if (wr == 1) PG8_BAR;
        PG8_WAIT_V(4); PG8_BAR;
        PG8_STAGE(PG8_SB(1, 0), cB + kstep, voffB); PG8_STAGE(PG8_SA(1, 0), cA + kstep, voffA); PG8_STAGE(PG8_SB(1, 1), cB + hstepB + kstep, voffB);
        PG8_WAIT_V(6); PG8_BAR;
    }
    for (;;) {
        const bool has_next = S.next(ui + 1, nxt);
        const char* nA = has_next ? (const char*)g.A + (size_t)nxt.pm * tstepA + (size_t)nxt.ks * ksplit : cA; const char* nB = has_next ? (const char*)g.Bt + (size_t)nxt.pn * tstepB + (size_t)nxt.ks * ksplit : cB;
#pragma nounroll
        for (int t = 0; t < nt; t += 2) {
            const bool last = (t == nt - 2);
            const char* a1 = cA + (size_t)(t + 1) * kstep;
            const char* a2 = last ? nA : cA + (size_t)(t + 2) * kstep; const char* b2 = last ? nB : cB + (size_t)(t + 2) * kstep;
            const char* a3 = a2 + kstep; const char* b3 = b2 + kstep;
            if constexpr (SP2) {
            PG8_LDB(B0, 0, 0); PG8_LDB(B1, 0, 1); PG8_SCHED; PG8_LDA(At, 0, 0); PG8_STAGE(PG8_SA(1, 1), a1 + hstepA, voffA);
            PG8_WAIT_V(8); PG8_WAIT_L(0); PG8_BAR; PG8_MMA(0, 0, At, B0); PG8_MMA(0, 1, At, B1); PG8_BAR; PG8_SCHED;
            PG8_LDA(At, 0, 1); PG8_STAGE(PG8_SB(0, 0), b2, voffB); PG8_STAGE(PG8_SB(0, 1), b2 + hstepB, voffB); PG8_STAGE(PG8_SA(0, 0), a2, voffA);
            PG8_WAIT_V(8); PG8_WAIT_L(0); PG8_BAR; PG8_MMA(1, 0, At, B0); PG8_MMA(1, 1, At, B1); PG8_BAR; PG8_SCHED;
            PG8_LDB(B0, 1, 0); PG8_LDB(B1, 1, 1); PG8_SCHED; PG8_LDA(At, 1, 0); PG8_STAGE(PG8_SA(0, 1), a2 + hstepA, voffA);
            PG8_WAIT_V(8); PG8_WAIT_L(0); PG8_BAR; PG8_MMA(0, 0, At, B0); PG8_MMA(0, 1, At, B1); PG8_BAR; PG8_SCHED;
            PG8_LDA(At, 1, 1); PG8_STAGE(PG8_SB(1, 0), b3, voffB); PG8_STAGE(PG8_SB(1, 1), b3 + hstepB, voffB); PG8_STAGE(PG8_SA(1, 0), a3, voffA);
            PG8_WAIT_V(8); PG8_WAIT_L(0); PG8_BAR; PG8_MMA(1, 0, At, B0); PG8_MMA(1, 1, At, B1); PG8_BAR; PG8_SCHED;
            } else {
            PG8_LDB(B0, 0, 0); PG8_SCHED; PG8_LDA(At, 0, 0); PG8_STAGE(PG8_SA(1, 1), a1 + hstepA, voffA);
            PG8_WAIT_L(8); PG8_BAR; PG8_WAIT_L(0); PG8_MMA(0, 0, At, B0); PG8_BAR; PG8_SCHED;
            PG8_LDB(B1, 0, 1); PG8_STAGE(PG8_SB(0, 0), b2, voffB);
            PG8_BAR; PG8_WAIT_L(0); PG8_MMA(0, 1, At, B1); PG8_BAR;
            PG8_LDA(At, 0, 1); PG8_STAGE(PG8_SA(0, 0), a2, voffA);
            PG8_BAR; PG8_WAIT_L(0); PG8_MMA(1, 0, At, B0); PG8_BAR; PG8_SCHED;
            PG8_STAGE(PG8_SB(0, 1), b2 + hstepB, voffB);
            PG8_WAIT_V(6); PG8_BAR; PG8_MMA(1, 1, At, B1); PG8_BAR;
            PG8_LDB(B0, 1, 0); PG8_SCHED; PG8_LDA(At, 1, 0); PG8_STAGE(PG8_SA(0, 1), a2 + hstepA, voffA);
            PG8_WAIT_L(8); PG8_BAR; PG8_WAIT_L(0); PG8_MMA(0, 0, At, B0); PG8_BAR; PG8_SCHED;
            PG8_LDB(B1, 1, 1); PG8_STAGE(PG8_SB(1, 0), b3, voffB);
            PG8_BAR; PG8_WAIT_L(0); PG8_MMA(0, 1, At, B1); PG8_BAR;
            PG8_LDA(At, 1, 1); PG8_STAGE(PG8_SA(1, 0), a3, voffA);
            PG8_BAR; PG8_WAIT_L(0); PG8_MMA(1, 0, At, B0); PG8_BAR; PG8_SCHED;
            PG8_STAGE(PG8_SB(1, 1), b3 + hstepB, voffB);
            PG8_WAIT_V(6); PG8_BAR; PG8_MMA(1, 1, At, B1); PG8_BAR;
            }
        }
        if constexpr (ALIGN_EPI) { if (wr == 0) PG8_BAR; }
        E(acc, cur, wr, wc, fr, fq);
        if (!has_next) break;
#pragma unroll
        for (int a = 0; a < 2; ++a)
#pragma unroll
            for (int b = 0; b < 2; ++b)
#pragma unroll
                for (int m = 0; m < 4; ++m)
#pragma unroll
                    for (int n = 0; n < 2; ++n) acc[a][b][m][n] = (f32x4){0.f, 0.f, 0.f, 0.f};
        cur = nxt; cA = nA; cB = nB; ++ui;
        if constexpr (ALIGN_EPI) { if (wr == 1) PG8_BAR; }
    }
    PG8_WAIT_V(0);
    if constexpr (!ALIGN_EPI) { if (wr == 0) PG8_BAR; }
    PG8_BAR;
#undef PG8_SA
#undef PG8_SB
#undef PG8_STAGE
#undef PG8_LDA
#undef PG8_LDB
#undef PG8_MMA
#undef PG8_WAIT_V
#undef PG8_WAIT_L
#undef PG8_BAR
#undef PG8_SCHED
}

__device__ __forceinline__ float rss_q(const float* rss, int row) { float s = 0.f;
#pragma unroll
    for (int p = 0; p < 12; ++p) s += rss[(size_t)p * MTOK + row]; return s; }
__device__ __forceinline__ float rss_kv(const float* rss, int row) { float s = 0.f;
#pragma unroll
    for (int p = 12; p < 20; ++p) s += rss[(size_t)p * MTOK + row]; return s; }
#define EPI_ROWS_BEGIN _Pragma("unroll") for (int ai = 0; ai < 2; ++ai) _Pragma("unroll") for (int m = 0; m < 4; ++m) { const int row = u.pm * BM + wr * 64 + fr + ai * HALF + m * 16;
#define EPI_ROWS_END asm volatile("" ::: "memory"); }

struct EpiZ {
    static constexpr bool PERM = true;
    bf16_t* Z; float* rssq; float* rsskv; int pn_off;
    __device__ __forceinline__ void operator()(const f32x4 (&acc)[2][2][4][2], const Unit& u, int wr, int wc, int fr_, int fq_) const {
        int lane_e = (int)threadIdx.x & 63; asm volatile("" : "+v"(lane_e)); const int fr = lane_e & 15, fq = lane_e >> 4;
        const int col0 = (u.pn + pn_off) * BM + wc * 32 + 8 * fq;
        EPI_ROWS_BEGIN
            bf16_t* rowp = Z + (size_t)row * ZP + col0;
#pragma unroll
            for (int bj = 0; bj < 2; ++bj) { const f32x4 v0 = acc[ai][bj][m][0], v1 = acc[ai][bj][m][1];
                u32x4 w; w.x = cvt_pk_bf16(v0[0], v0[1]); w.y = cvt_pk_bf16(v0[2], v0[3]); w.z = cvt_pk_bf16(v1[0], v1[1]); w.w = cvt_pk_bf16(v1[2], v1[3]);
                *(u32x4*)(rowp + bj * HALF) = w;
                const int hc = 2 * (u.pn + pn_off) + bj;
                if (hc < 5) { float s = (v0[0] * v0[0] + v0[1] * v0[1]) + (v0[2] * v0[2] + v0[3] * v0[3]) + (v1[0] * v1[0] + v1[1] * v1[1]) + (v1[2] * v1[2] + v1[3] * v1[3]);
                    s += __shfl_xor(s, 16); s += __shfl_xor(s, 32);
                    if (fq == 0) rssq[(size_t)(hc * 4 + wc) * MTOK + row] = s; } }
        EPI_ROWS_END
    }
};

struct EpiQ {
    static constexpr bool PERM = true;
    bf16_t* Q; const float* rssq;
    __device__ __forceinline__ void operator()(const f32x4 (&acc)[2][2][4][2], const Unit& u, int wr, int wc, int fr_, int fq_) const {
        int lane_e = (int)threadIdx.x & 63; asm volatile("" : "+v"(lane_e)); const int fr = lane_e & 15, fq = lane_e >> 4;
        const int col0 = u.pn * BM + wc * 32 + 8 * fq;
        const float inv[8] = {1.f, 0.316227766f, 0.1f, 0.0316227766f, 0.01f, 0.00316227766f, 0.001f, 0.000316227766f};
        EPI_ROWS_BEGIN
            const float rs = rsqrtf(rss_q(rssq, row) * (1.f / 384.f) + EPS) * QSCALE;
            const int t = (row - MP) & 2047;
#pragma unroll
            for (int bj = 0; bj < 2; ++bj) { const int c = col0 + bj * HALF; const int j0 = c % 96;
                const bool rp = (row >= MP && j0 >= 64);
                const float pos = (float)((j0 < 80) ? (t >> 6) : (t & 63)) * 0.15915494309189535f;
                const float sg = (j0 & 8) ? 1.f : -1.f;
#pragma unroll
                for (int n = 0; n < 2; ++n) {
                    f32x4 v = acc[ai][bj][m][n] * rs;
#pragma unroll
                    for (int i = 0; i < 4; ++i) { const float p = __shfl_xor(v[i], 16);
                        const float rev = pos * inv[4 * n + i]; const float rf = rev - floorf(rev);
                        const float cs = __builtin_amdgcn_cosf(rf), sn = __builtin_amdgcn_sinf(rf); v[i] = rp ? v[i] * cs + sg * p * sn : v[i]; }
                    u32x2 w; w.x = cvt_pk_bf16(v[0], v[1]); w.y = cvt_pk_bf16(v[2], v[3]);
                    *(u32x2*)(Q + (size_t)row * 768 + c + 4 * n) = w; } }
        EPI_ROWS_END
    }
};

struct EpiK {
    static constexpr bool PERM = true;
    bf16_t* Kp; bf16_t* Ks; const float* rsskv; int ctx;
    __device__ __forceinline__ void operator()(const f32x4 (&acc)[2][2][4][2], const Unit& u, int wr, int wc, int fr_, int fq_) const {
        int lane_e = (int)threadIdx.x & 63; asm volatile("" : "+v"(lane_e)); const int fr = lane_e & 15, fq = lane_e >> 4;
        EPI_ROWS_BEGIN
            float rs = 1.f; unsigned off; bool smp;
            if (ctx) { off = ((unsigned)(row >> 8) * 8u * SKS + (row & 255)) * 96u; smp = true; }
            else { rs = rsqrtf(rss_kv(rsskv, row) * (1.f / 256.f) + EPS);
                if (row < MP) { off = ((unsigned)(row >> 8) * 8u * 256u + (row & 255)) * 96u; smp = false; } else { off = ((unsigned)((row - MP) >> 11) * 8u * SKS + 256u + ((row - MP) & 2047)) * 96u; smp = true; } }
            bf16_t* base = smp ? Ks : Kp; const unsigned hs = (smp ? SKS : 256) * 96u;
#pragma unroll
            for (int bj = 0; bj < 2; ++bj) { const unsigned h = 4 * u.pn + 2 * bj + (wc >> 1); const unsigned j = (wc & 1) * 32 + 8 * fq;
                const f32x4 v0 = acc[ai][bj][m][0] * rs, v1 = acc[ai][bj][m][1] * rs;
                u32x4 w; w.x = cvt_pk_bf16(v0[0], v0[1]); w.y = cvt_pk_bf16(v0[2], v0[3]); w.z = cvt_pk_bf16(v1[0], v1[1]); w.w = cvt_pk_bf16(v1[2], v1[3]);
                *(u32x4*)(base + (off + h * hs + j)) = w; }
        EPI_ROWS_END
    }
};

struct EpiVt {
    static constexpr bool PERM = true;
    bf16_t* Vtp; bf16_t* Vts; const float* rsskv; int ctx;
    __device__ __forceinline__ void operator()(const f32x4 (&acc)[2][2][4][2], const Unit& u, int wr, int wc, int fr_, int fq_) const {
        int lane_e = (int)threadIdx.x & 63; asm volatile("" : "+v"(lane_e)); const int fr = lane_e & 15, fq = lane_e >> 4;
#pragma unroll
        for (int bj = 0; bj < 2; ++bj) {
            const int tok = u.pn * BM + bj * HALF + wc * 32 + 8 * fq;
            f32x4 r0 = {1.f, 1.f, 1.f, 1.f}, r1 = {1.f, 1.f, 1.f, 1.f}; unsigned off; bool smp; unsigned S;
            if (ctx) { off = (unsigned)(tok >> 8) * 8u * 64u * SKS + (tok & 255); smp = true; S = SKS; }
            else { f32x4 q0 = {0.f, 0.f, 0.f, 0.f}, q1 = {0.f, 0.f, 0.f, 0.f};
#pragma unroll
                for (int p = 12; p < 20; ++p) { q0 += *(const f32x4*)(rsskv + (size_t)p * MTOK + tok); q1 += *(const f32x4*)(rsskv + (size_t)p * MTOK + tok + 4); }
#pragma unroll
                for (int i = 0; i < 4; ++i) { r0[i] = rsqrtf(q0[i] * (1.f / 256.f) + EPS); r1[i] = rsqrtf(q1[i] * (1.f / 256.f) + EPS); }
                if (tok < MP) { off = (unsigned)(tok >> 8) * 8u * 64u * 256u + (tok & 255); smp = false; S = 256; } else { off = (unsigned)((tok - MP) >> 11) * 8u * 64u * SKS + 256u + ((tok - MP) & 2047); smp = true; S = SKS; } }
            bf16_t* base = smp ? Vts : Vtp;
#pragma unroll
            for (int ai = 0; ai < 2; ++ai)
#pragma unroll
                for (int m = 0; m < 4; ++m) { const unsigned hd = u.pm * BM + wr * 64 + fr + ai * HALF + m * 16;
                    const f32x4 v0 = acc[ai][bj][m][0] * r0, v1 = acc[ai][bj][m][1] * r1;
                    u32x4 w; w.x = cvt_pk_bf16(v0[0], v0[1]); w.y = cvt_pk_bf16(v0[2], v0[3]); w.z = cvt_pk_bf16(v1[0], v1[1]); w.w = cvt_pk_bf16(v1[2], v1[3]);
                    *(u32x4*)(base + (off + hd * S)) = w; }
            asm volatile("" ::: "memory");
        }
    }
};

struct EpiPart {
    static constexpr bool PERM = true;
    bf16_t* P0; bf16_t* P1;
    __device__ __forceinline__ void operator()(const f32x4 (&acc)[2][2][4][2], const Unit& u, int wr, int wc, int fr_, int fq_) const {
        int lane_e = (int)threadIdx.x & 63; asm volatile("" : "+v"(lane_e)); const int fr = lane_e & 15, fq = lane_e >> 4;
        const int col0 = u.pn * BM + wc * 32 + 8 * fq; bf16_t* P = u.ks ? P1 : P0;
        EPI_ROWS_BEGIN
            bf16_t* rowp = P + (size_t)row * D + col0;
#pragma unroll
            for (int bj = 0; bj < 2; ++bj) { const f32x4 v0 = acc[ai][bj][m][0], v1 = acc[ai][bj][m][1];
                u32x4 w; w.x = cvt_pk_bf16(v0[0], v0[1]); w.y = cvt_pk_bf16(v0[2], v0[3]); w.z = cvt_pk_bf16(v1[0], v1[1]); w.w = cvt_pk_bf16(v1[2], v1[3]);
                *(u32x4*)(rowp + bj * HALF) = w; }
        EPI_ROWS_END
    }
};

struct EpiFFI {
    static constexpr bool PERM = true;
    bf16_t* H;
    __device__ __forceinline__ void operator()(const f32x4 (&acc)[2][2][4][2], const Unit& u, int wr, int wc, int fr_, int fq_) const {
        int lane_e = (int)threadIdx.x & 63; asm volatile("" : "+v"(lane_e)); const int fr = lane_e & 15, fq = lane_e >> 4;
        const int col0 = u.pn * HALF + wc * 32 + 8 * fq;
        EPI_ROWS_BEGIN
            float o[8];
#pragma unroll
            for (int i = 0; i < 4; ++i) { o[i] = silu_f(acc[ai][0][m][0][i]) * acc[ai][1][m][0][i]; o[4 + i] = silu_f(acc[ai][0][m][1][i]) * acc[ai][1][m][1][i]; }
            u32x4 w; w.x = cvt_pk_bf16(o[0], o[1]); w.y = cvt_pk_bf16(o[2], o[3]); w.z = cvt_pk_bf16(o[4], o[5]); w.w = cvt_pk_bf16(o[6], o[7]);
            *(u32x4*)(H + (size_t)row * DFF + col0) = w;
        EPI_ROWS_END
    }
};
}

struct Args { const float* in[26]; float* out; unsigned char* ws; int ph_lo, ph_hi; };
enum { I_XP = 0, I_XS, I_CKV, I_CKR, I_SF, I_SB, I_C, I_CCTX, I_WADA, I_BADA, I_NATT, I_WIN, I_QN, I_WUQ, I_KVN, I_WUKV, I_WGF, I_BGF, I_WGB, I_BGB, I_GLAN, I_WOUT, I_NFFN, I_WFFI, I_WFFO, I_FN };

__device__ __forceinline__ const float* xrow_ptr(const Args& a, int r) { return r < MP ? a.in[I_XP] + (size_t)r * D : a.in[I_XS] + (size_t)(r - MP) * D; }
__device__ __forceinline__ int cond_of_row(int r) { return r < MP ? 0 : 1 + ((r - MP) >> 11); }

__device__ __forceinline__ void p0_tr(const float* W, int K, int N, bf16_t* WT, bf16_t* WT2, const float* kscale, int kb, int nb, int drow, LAS float* scr, int lane) {
    const int k0 = 64 * kb, n0 = 32 * nb;
#pragma unroll 8
    for (int i = 0; i < 32; ++i) { const int kk = 2 * i + (lane >> 5); scr[kk * 33 + (lane & 31)] = W[(size_t)(k0 + kk) * N + n0 + (lane & 31)]; }
    LDS_WAIT();
    const int c = lane & 7;
    float sc[8];
#pragma unroll
    for (int i = 0; i < 8; ++i) sc[i] = kscale ? kscale[k0 + 8 * c + i] : 1.f;
#pragma unroll
    for (int j = 0; j < 4; ++j) { const int n = (lane >> 3) + 8 * j; const LAS float* s = scr + (8 * c) * 33 + n;
        float v[8];
#pragma unroll
        for (int i = 0; i < 8; ++i) v[i] = s[i * 33];
        if (WT2) { u32x4 o; o.x = cvt_pk_bf16(v[0], v[1]); o.y = cvt_pk_bf16(v[2], v[3]); o.z = cvt_pk_bf16(v[4], v[5]); o.w = cvt_pk_bf16(v[6], v[7]);
            *(u32x4*)(WT2 + (size_t)(drow + n0 + n) * K + k0 + 8 * c) = o; }
        u32x4 o; o.x = cvt_pk_bf16(v[0] * sc[0], v[1] * sc[1]); o.y = cvt_pk_bf16(v[2] * sc[2], v[3] * sc[3]); o.z = cvt_pk_bf16(v[4] * sc[4], v[5] * sc[5]); o.w = cvt_pk_bf16(v[6] * sc[6], v[7] * sc[7]);
        *(u32x4*)(WT + (size_t)(drow + n0 + n) * K + k0 + 8 * c) = o; }
    LDS_WAIT();
}

__device__ __forceinline__ void phase0(const Args& a, int wv, LAS unsigned char* lds, int vcu, int G) {
    const int tid = otid(wv), lane = tid & 63, wave = __builtin_amdgcn_readfirstlane(tid >> 6);
    unsigned char* ws = a.ws;
#ifndef P0MASK
#define P0MASK 7
#endif
    if (P0MASK & 2) {
        LAS float* scr = (LAS float*)(lds + wave * 16384);
        LAS float* scnd = (LAS float*)(lds + 131072);
        for (int i = tid; i < 3072; i += 512) { const int ci = i >> 10, k = i & 1023; scnd[i] = silu_f(ci == 0 ? a.in[I_CCTX][k] : a.in[I_C][(ci - 1) * D + k]); }
        __syncthreads();
        const int gw = vcu * 8 + wave, NGW = G * 8;
        constexpr int T_IN = 16 * 70, T_UQ = 6 * 24, T_UKV = 4 * 32, T_OUT = 16 * 32, T_FFI = 16 * 176, T_FFO = 44 * 32, T_ZERO = 64, T_ADA = 768;
        constexpr int NIT = T_ADA + T_IN + T_UQ + T_UKV + T_OUT + T_FFI + T_FFO + T_ZERO;
        constexpr int NTR = NIT - T_ADA;
        const int nslot = wave < 3 ? 2 : 5;
        for (int sl = 0; sl < nslot; ++sl) {
            int r;
            if (wave < 3) { if (sl == 0) { r = wave * G + vcu; if (r >= T_ADA) continue; } else { const int t = vcu + G * wave; if (t >= NTR) continue; r = T_ADA + t; } }
            else { const int j = 3 + (wave - 3) + 5 * sl; const int t = vcu + G * j; if (t >= NTR) continue; r = T_ADA + t; }
            if (r < T_ADA) {
                const int nbq = r >> 2, kq = r & 3; const int n0 = 32 * nbq; const float* W = a.in[I_WADA];
                const int n = lane & 31, hf = lane >> 5; float s0 = 0.f, s1 = 0.f, s2 = 0.f;
                for (int kb = 4 * kq; kb < 4 * kq + 4; ++kb) { const int k0 = 64 * kb;
#pragma unroll 8
                    for (int i = 0; i < 32; ++i) { const int kk = 2 * i + (lane >> 5); scr[kk * 33 + (lane & 31)] = W[(size_t)(k0 + kk) * 6144 + n0 + (lane & 31)]; }
                    LDS_WAIT();
#pragma unroll 8
                    for (int j = 0; j < 32; ++j) { const int kk = hf * 32 + j; const float w = scr[kk * 33 + n];
                        s0 += w * scnd[k0 + kk]; s1 += w * scnd[1024 + k0 + kk]; s2 += w * scnd[2048 + k0 + kk]; }
                    LDS_WAIT(); }
                s0 += __shfl_xor(s0, 32); s1 += __shfl_xor(s1, 32); s2 += __shfl_xor(s2, 32);
                float* MOD = (float*)(ws + WS_MOD) + (size_t)kq * 18432;
                if (hf == 0) { MOD[n0 + n] = s0; MOD[6144 + n0 + n] = s1; MOD[12288 + n0 + n] = s2; }
                continue; } r -= T_ADA;
            if (r < T_FFI) { const int kb = r / 176, nb = r % 176; const int n0 = nb * 32; const int drow = n0 < DFF ? (n0 / 128) * 256 + (n0 % 128) : ((n0 - DFF) / 128) * 256 + 128 + ((n0 - DFF) % 128);
                p0_tr(a.in[I_WFFI], 1024, 5632, (bf16_t*)(ws + WS_WFFI), nullptr, nullptr, kb, nb, drow - n0, scr, lane); continue; } r -= T_FFI;
            if (r < T_FFO) { p0_tr(a.in[I_WFFO], DFF, 1024, (bf16_t*)(ws + WS_WFFO), nullptr, nullptr, r / 32, r % 32, 0, scr, lane); continue; } r -= T_FFO;
            if (r < T_IN) { p0_tr(a.in[I_WIN], 1024, 2240, (bf16_t*)(ws + WS_WIN), nullptr, nullptr, r / 70, r % 70, 0, scr, lane); continue; } r -= T_IN;
            if (r < T_OUT) { p0_tr(a.in[I_WOUT], 1024, 1024, (bf16_t*)(ws + WS_WOUT), nullptr, nullptr, r / 32, r % 32, 0, scr, lane); continue; } r -= T_OUT;
            if (r < T_UQ) { p0_tr(a.in[I_WUQ], 384, 768, (bf16_t*)(ws + WS_WUQ), nullptr, a.in[I_QN], r / 24, r % 24, 0, scr, lane); continue; } r -= T_UQ;
            if (r < T_UKV) { const int nb = r % 32, n0 = nb * 32, hh = n0 >> 7, j0 = n0 & 127; const bool isv = j0 >= 64; const int drow = hh * 64 + (j0 & 63);
                p0_tr(a.in[I_WUKV], 256, 1024, (bf16_t*)(ws + (isv ? WS_WVF : WS_WKF)), (bf16_t*)(ws + (isv ? WS_WVU : WS_WKU)), a.in[I_KVN], r / 32, nb, drow - n0, scr, lane); continue; } r -= T_UKV;
            { u32x4 z = {0u, 0u, 0u, 0u}; u32x4* p = (u32x4*)((bf16_t*)(ws + WS_WIN) + (size_t)(2240 + r) * 1024); p[lane] = z; p[64 + lane] = z; }
        }
    }
    if (P0MASK & 4) {
        const int gt = vcu * 512 + tid, NT = G * 512;
        for (int i = gt; i < 32768; i += NT) { const f32x4 v = ((const f32x4*)a.in[I_CKV])[i]; u32x2 w; w.x = cvt_pk_bf16(v[0], v[1]); w.y = cvt_pk_bf16(v[2], v[3]); ((u32x2*)(ws + WS_CACHEB))[i] = w; }
    }
}

__device__ __forceinline__ f32x4 mod4(const float* modp, const float* bias, int ci, int off) {
    const float* p = modp + ci * 6144 + off;
    return ((*(const f32x4*)p + *(const f32x4*)(p + 18432)) + (*(const f32x4*)(p + 36864) + *(const f32x4*)(p + 55296))) + *(const f32x4*)(bias + off);
}
__device__ __forceinline__ void phase1(const Args& a, int wv, int vcu, int G) {
    if (PROBE_FILL == 3) { float* m = (float*)(a.ws + WS_MOD); for (int i = otid(wv); i < 3 * 6144; i += 512) { unsigned h = (unsigned)i * 2654435761u; h ^= h >> 15; h *= 2246822519u; h ^= h >> 13; m[i] = ((float)(h & 0xffff) * (1.f / 65536.f) - 0.5f) * 2.f; } __syncthreads(); }
    const int tid_ = otid(wv); const int lane = tid_ & 63, wave = tid_ >> 6; const int gw = vcu * 8 + wave, NGW = G * 8;
    const float* mod = (const float*)(a.ws + WS_MOD + PROBE_MODOFF); bf16_t* H = (bf16_t*)(a.ws + WS_H);
    for (int r = gw; r < MTOK; r += NGW * PROBE_RSTRIDE) {
        const f32x4* xr = (const f32x4*)xrow_ptr(a, r) + lane; const int ci_ = cond_of_row(r);
        f32x4 v[4]; float s = 0.f;
#pragma unroll
        for (int j = 0; j < 4; ++j) { v[j] = xr[64 * j]; s += (v[j][0] * v[j][0] + v[j][1] * v[j][1]) + (v[j][2] * v[j][2] + v[j][3] * v[j][3]); }
        const float rstd = rsqrtf(wave_sum(s) * (1.f / D) + EPS);
        u32x2* o = (u32x2*)(H + (size_t)r * D) + lane;
#pragma unroll
        for (int j = 0; j < 4; ++j) { const int c = 4 * lane + 256 * j; const f32x4 w = *(const f32x4*)(a.in[I_NATT] + c), sh = mod4(mod, a.in[I_BADA], ci_, c), scv = mod4(mod, a.in[I_BADA], ci_, 1024 + c);
            const f32x4 y = v[j] * rstd * w * (scv * PROBE_MUL + 1.f) + sh * PROBE_MUL; u32x2 p; p.x = cvt_pk_bf16(y[0], y[1]); p.y = cvt_pk_bf16(y[2], y[3]); if (PROBE_NOSTORE) { if ((p.x ^ p.y) == 0x12345u) o[64 * j] = p; } else o[64 * j] = p; }
    }
}
__device__ __forceinline__ void phase6(const Args& a, int wv, int vcu, int G) {
    const int tid_ = otid(wv); const int lane = tid_ & 63, wave = tid_ >> 6; const int gw = vcu * 8 + wave, NGW = G * 8;
    const float* mod = (const float*)(a.ws + WS_MOD); bf16_t* H = (bf16_t*)(a.ws + WS_H); float* X1 = (float*)(a.ws + WS_X1);
    const bf16_t* P0 = (const bf16_t*)(a.ws + WS_P0); const bf16_t* P1 = (const bf16_t*)(a.ws + WS_P1A);
    for (int r = gw; r < MTOK; r += NGW) {
        const f32x4* xr = (const f32x4*)xrow_ptr(a, r) + lane; const int ci_ = cond_of_row(r);
        const u32x2* p0 = (const u32x2*)(P0 + (size_t)r * D) + lane; const u32x2* p1 = (const u32x2*)(P1 + (size_t)r * D) + lane;
        f32x4 v[4]; float s = 0.f;
#pragma unroll
        for (int j = 0; j < 4; ++j) { const int c = 4 * lane + 256 * j; const f32x4 gt = mod4(mod, a.in[I_BADA], ci_, 2048 + c);
            { const u32x2 qa = p0[64 * j], qb = p1[64 * j]; const f32x4 ps = {bflo(qa.x) + bflo(qb.x), bfhi(qa.x) + bfhi(qb.x), bflo(qa.y) + bflo(qb.y), bfhi(qa.y) + bfhi(qb.y)}; v[j] = xr[64 * j] + gt * ps; } s += (v[j][0] * v[j][0] + v[j][1] * v[j][1]) + (v[j][2] * v[j][2] + v[j][3] * v[j][3]); }
        const float rstd = rsqrtf(wave_sum(s) * (1.f / D) + EPS);
        u32x2* x1 = (u32x2*)((bf16_t*)X1 + (size_t)r * D) + lane; u32x2* o = (u32x2*)(H + (size_t)r * D) + lane;
#pragma unroll
        for (int j = 0; j < 4; ++j) { const int c = 4 * lane + 256 * j; { u32x2 xw; xw.x = cvt_pk_bf16(v[j][0], v[j][1]); xw.y = cvt_pk_bf16(v[j][2], v[j][3]); x1[64 * j] = xw; }
            const f32x4 w = *(const f32x4*)(a.in[I_NFFN] + c), sh = mod4(mod, a.in[I_BADA], ci_, 3072 + c), scv = mod4(mod, a.in[I_BADA], ci_, 4096 + c);
            const f32x4 y = v[j] * rstd * w * (scv + 1.f) + sh; u32x2 p; p.x = cvt_pk_bf16(y[0], y[1]); p.y = cvt_pk_bf16(y[2], y[3]); o[64 * j] = p; }
    }
}
__device__ __forceinline__ void phase9(const Args& a, int wv, int vcu, int G) {
    const int tid_ = otid(wv); const int lane = tid_ & 63, wave = tid_ >> 6; const int gw = vcu * 8 + wave, NGW = G * 8;
    const float* mod = (const float*)(a.ws + WS_MOD); const float* X1 = (const float*)(a.ws + WS_X1);
    const bf16_t* P0 = (const bf16_t*)(a.ws + WS_P0); const bf16_t* P1 = (const bf16_t*)(a.ws + WS_P1B);
    for (int r = gw; r < MTOK; r += NGW) {
        const u32x2* xr = (const u32x2*)((const bf16_t*)X1 + (size_t)r * D) + lane; const int ci_ = cond_of_row(r);
        const u32x2* p0 = (const u32x2*)(P0 + (size_t)r * D) + lane; const u32x2* p1 = (const u32x2*)(P1 + (size_t)r * D) + lane;
        f32x4 v[4]; float s = 0.f;
#pragma unroll
        for (int j = 0; j < 4; ++j) { const int c = 4 * lane + 256 * j; const f32x4 gt = mod4(mod, a.in[I_BADA], ci_, 5120 + c);
            { const u32x2 qa = p0[64 * j], qb = p1[64 * j]; const f32x4 ps = {bflo(qa.x) + bflo(qb.x), bfhi(qa.x) + bfhi(qb.x), bflo(qa.y) + bflo(qb.y), bfhi(qa.y) + bfhi(qb.y)}; const u32x2 xq = xr[64 * j]; const f32x4 xv = {bflo(xq.x), bfhi(xq.x), bflo(xq.y), bfhi(xq.y)}; v[j] = xv + gt * ps; } s += (v[j][0] * v[j][0] + v[j][1] * v[j][1]) + (v[j][2] * v[j][2] + v[j][3] * v[j][3]); }
        const float rstd = rsqrtf(wave_sum(s) * (1.f / D) + EPS);
        f32x4* y = (f32x4*)(a.out + O_Y + (size_t)r * D) + lane;
#pragma unroll
        for (int j = 0; j < 4; ++j) { const int c = 4 * lane + 256 * j; const f32x4 w = *(const f32x4*)(a.in[I_FN] + c); y[64 * j] = v[j] * rstd * w; }
    }
}

__device__ __forceinline__ void p3_row_extras(const Args& a, int wv, int gw, int NGW) {
    const int lane = otid(wv) & 63;
    const bf16_t* Z = (const bf16_t*)(a.ws + WS_Z); const float* rsskv = (const float*)(a.ws + WS_RSSKV);
    bf16_t* Kp = (bf16_t*)(a.ws + WS_KP); bf16_t* Ks = (bf16_t*)(a.ws + WS_KS);
    const float inv[8] = {1.f, 0.316227766f, 0.1f, 0.0316227766f, 0.01f, 0.00316227766f, 0.001f, 0.000316227766f};
    for (int r = gw; r < MTOK + 512; r += NGW) {
        if (r < MTOK) {
            const bf16_t* zr = Z + (size_t)r * ZP;
            if (r < MP) {
                const float rs = rsqrtf(pg8::rss_kv(rsskv, r) * (1.f / 256.f) + EPS);
                const u32x2 w = *(const u32x2*)(zr + C_KVLAT + 4 * lane); const f32x4 g = *(const f32x4*)(a.in[I_KVN] + 4 * lane);
                f32x4 o; o[0] = bflo(w.x) * rs * g[0]; o[1] = bfhi(w.x) * rs * g[1]; o[2] = bflo(w.y) * rs * g[2]; o[3] = bfhi(w.y) * rs * g[3];
                *(f32x4*)(a.out + O_KV + (size_t)r * 256 + 4 * lane) = o;
            }
            const int i = lane & 31;
            float v = bf2f(zr[C_KROPE + i]);
            if (r < MP && lane < 32) a.out[O_KR + (size_t)r * 32 + i] = v;
            const float pv = __shfl_xor(v, 8);
            int b, s; bf16_t* kb;
            if (r >= MP) { const int t = (r - MP) & 2047; const float pos = (float)((i < 16) ? (t >> 6) : (t & 63));
                const float rev = pos * inv[i & 7] * 0.15915494309189535f; const float rf = rev - floorf(rev);
                const float cs = __builtin_amdgcn_cosf(rf), sn = __builtin_amdgcn_sinf(rf); v = v * cs + ((i & 8) ? pv : -pv) * sn;
                b = (r - MP) >> 11; s = 256 + t; kb = Ks + ((size_t)(b * 8) * SKS + s) * 96 + 64 + i;
                const bf16_t o = f2bf(v);
                if (lane < 32) { for (int h = 0; h < 8; ++h) kb[(size_t)h * SKS * 96] = o; }
            } else { b = r >> 8; s = r & 255; kb = Kp + ((size_t)(b * 8) * 256 + s) * 96 + 64 + i; const bf16_t o = f2bf(v);
                if (lane < 32) { for (int h = 0; h < 8; ++h) kb[(size_t)h * 256 * 96] = o; } }
        } else {
            const int rr = r - MTOK, b = rr >> 8, s = rr & 255, i = lane & 31;
            const bf16_t o = f2bf(a.in[I_CKR][(size_t)rr * 32 + i]); bf16_t* kb = Ks + ((size_t)(b * 8) * SKS + s) * 96 + 64 + i;
            if (lane < 32) { for (int h = 0; h < 8; ++h) kb[(size_t)h * SKS * 96] = o; }
        }
    }
}

constexpr int GL_LOW = 0, GL_WG = 8192, GL_BG = 16384, GL_SEG = 16896, GL_RED = 20992, GL_VT = 22528, GL_QF = 40960, GL_KF = GL_QF + 9216, GL_QB = GL_KF + 9216, GL_KB = GL_QB + 9216;
constexpr int GROW = 144;

__device__ __forceinline__ void gla_gates(const Args& a, int wv, LAS unsigned char* lds, int r0, int h, float (&cumF)[8], float (&cumB)[8], float& totF, float& totB) {
    const int tid = otid(wv), d = tid & 63, tg = tid >> 6;
    const bf16_t* Z = (const bf16_t*)(a.ws + WS_Z);
    LAS float* low = (LAS float*)(lds + GL_LOW); LAS float* wg = (LAS float*)(lds + GL_WG); LAS float* bg = (LAS float*)(lds + GL_BG); LAS float* seg = (LAS float*)(lds + GL_SEG);
    { const int t = tid >> 3, r4 = (tid & 7) * 4; const u32x2 w = *(const u32x2*)(Z + (size_t)(r0 + t) * ZP + C_GFL + r4);
      low[t * 32 + r4] = bflo(w.x); low[t * 32 + r4 + 1] = bfhi(w.x); low[t * 32 + r4 + 2] = bflo(w.y); low[t * 32 + r4 + 3] = bfhi(w.y); }
    { const int dir = tid >> 8, r = (tid >> 4) & 15, d4 = (tid & 15) * 4; const f32x4 w = *(const f32x4*)(a.in[dir ? I_WGB : I_WGF] + r * 256 + h * 64 + d4);
      *(LAS f32x4*)(wg + (dir * 16 + r) * 64 + d4) = w; }
    if (tid < 128) { const int dir = tid >> 6; bg[tid] = a.in[dir ? I_BGB : I_BGF][h * 64 + (tid & 63)]; }
    __syncthreads();
    float wf[16], wb[16];
#pragma unroll
    for (int r = 0; r < 16; ++r) { wf[r] = wg[r * 64 + d]; wb[r] = wg[(16 + r) * 64 + d]; }
    const float bf_ = bg[d], bb_ = bg[64 + d];
    float gf[8], gb[8];
#pragma unroll
    for (int i = 0; i < 8; ++i) { const int t = tg * 8 + i; float xf = bf_, xb = bb_;
#pragma unroll
        for (int r = 0; r < 16; ++r) { xf += low[t * 32 + r] * wf[r]; xb += low[t * 32 + 16 + r] * wb[r]; }
        gf[i] = logsigmoid_f(xf) * (1.f / 16.f); gb[i] = logsigmoid_f(xb) * (1.f / 16.f); }
#pragma unroll
    for (int i = 1; i < 8; ++i) gf[i] += gf[i - 1];
#pragma unroll
    for (int i = 6; i >= 0; --i) gb[i] += gb[i + 1];
    seg[tg * 64 + d] = gf[7]; seg[512 + tg * 64 + d] = gb[0];
    __syncthreads();
    float offF = 0.f, offB = 0.f; totF = 0.f; totB = 0.f;
#pragma unroll
    for (int g = 0; g < 8; ++g) { const float sf = seg[g * 64 + d], sb = seg[512 + g * 64 + d]; totF += sf; totB += sb; if (g < tg) offF += sf; if (g > tg) offB += sb; }
#pragma unroll
    for (int i = 0; i < 8; ++i) { cumF[i] = gf[i] + offF; cumB[i] = gb[i] + offB; }
}
__device__ __forceinline__ void gla_load_vT(const Args& a, int wv, LAS unsigned char* lds, int r0, int h) {
    const int tid = otid(wv), e = tid & 127, tq = tid >> 7;
    const bf16_t* Z = (const bf16_t*)(a.ws + WS_Z) + (size_t)r0 * ZP + C_GV + h * 128 + e;
    unsigned w[8];
#pragma unroll
    for (int i = 0; i < 8; ++i) { const unsigned lo = Z[(size_t)(tq * 16 + 2 * i) * ZP], hi = Z[(size_t)(tq * 16 + 2 * i + 1) * ZP]; w[i] = lo | (hi << 16); }
    LAS u32x4* p = (LAS u32x4*)(lds + GL_VT + e * GROW + tq * 32);
    p[0] = (u32x4){w[0], w[1], w[2], w[3]}; p[1] = (u32x4){w[4], w[5], w[6], w[7]};
}

__device__ __forceinline__ void gla_stepA(const Args& a, int wv, LAS unsigned char* lds, int u) {
    const int tid = otid(wv), lane = tid & 63, wave = __builtin_amdgcn_readfirstlane(tid >> 6), d = tid & 63, tg = tid >> 6, fr = lane & 15, fq = lane >> 4;
    const int cgi = u >> 2, h = u & 3, r0 = cgi * 64;
    const bf16_t* Z = (const bf16_t*)(a.ws + WS_Z);
    float cumF[8], cumB[8], totF, totB;
    gla_gates(a, wv, lds, r0, h, cumF, cumB, totF, totB);
    unsigned kf[4], kb[4];
#pragma unroll
    for (int i = 0; i < 4; ++i) { const float k0 = bf2f(Z[(size_t)(r0 + tg * 8 + 2 * i) * ZP + C_GK + h * 64 + d]), k1 = bf2f(Z[(size_t)(r0 + tg * 8 + 2 * i + 1) * ZP + C_GK + h * 64 + d]);
        kf[i] = cvt_pk_bf16(k0 * __expf(totF - cumF[2 * i]), k1 * __expf(totF - cumF[2 * i + 1]));
        kb[i] = cvt_pk_bf16(k0 * __expf(totB - cumB[2 * i]), k1 * __expf(totB - cumB[2 * i + 1])); }
    *(LAS u32x4*)(lds + GL_QF + d * GROW + tg * 16) = (u32x4){kf[0], kf[1], kf[2], kf[3]};
    *(LAS u32x4*)(lds + GL_KF + d * GROW + tg * 16) = (u32x4){kb[0], kb[1], kb[2], kb[3]};
    gla_load_vT(a, wv, lds, r0, h);
    if (tg == 0) { float* dec = (float*)(a.ws + WS_DEC) + (size_t)u * 128; dec[d] = __expf(totF); dec[64 + d] = __expf(totB); }
    __syncthreads();
    const int dir = wave >> 2, eb0 = 2 * (wave & 3);
    const LAS unsigned char* kd = lds + (dir ? GL_KF : GL_QF);
    float* CT = (float*)(a.ws + WS_CT) + ((size_t)u * 2 + dir) * 8192;
#pragma unroll
    for (int eb = 0; eb < 2; ++eb) {
        bf16x8 vf[2];
#pragma unroll
        for (int ks = 0; ks < 2; ++ks) vf[ks] = *(const LAS bf16x8*)(lds + GL_VT + (16 * (eb0 + eb) + fr) * GROW + (32 * ks + 8 * fq) * 2);
#pragma unroll
        for (int db = 0; db < 4; ++db) { f32x4 c = {0.f, 0.f, 0.f, 0.f};
#pragma unroll
            for (int ks = 0; ks < 2; ++ks) { const bf16x8 kfr = *(const LAS bf16x8*)(kd + (16 * db + fr) * GROW + (32 * ks + 8 * fq) * 2); c = __builtin_amdgcn_mfma_f32_16x16x32_bf16(vf[ks], kfr, c, 0, 0, 0); }
#pragma unroll
            for (int j = 0; j < 4; ++j) CT[(16 * (eb0 + eb) + 4 * fq + j) * 64 + 16 * db + fr] = c[j]; }
    }
    __syncthreads();
}

__device__ __forceinline__ void gla_scan(const Args& a, int wv, int vcu, int G) {
    const int gt = vcu * 512 + otid(wv), NT = G * 512;
    float* CTb = (float*)(a.ws + WS_CT); const float* DEC = (const float*)(a.ws + WS_DEC);
    for (int it = gt; it < 32768 + 262144; it += NT) {
        int seq, N, cg0, x;
        if (it < 32768) { seq = 16 + (it >> 14); x = it & 16383; N = 32; cg0 = 64 + 32 * (seq - 16); } else { const int j = it - 32768; seq = j >> 14; x = j & 16383; N = 4; cg0 = 4 * seq; }
        const int h = x >> 12, dir = (x >> 11) & 1, e = (x >> 4) & 127, d4 = (x & 15) * 4;
        f32x4 st = {0.f, 0.f, 0.f, 0.f};
        if (seq >= 16) { const float* s0 = a.in[dir ? I_SB : I_SF] + ((size_t)((seq - 16) * 4 + h) * 64) * 128 + e;
#pragma unroll
            for (int i = 0; i < 4; ++i) st[i] = s0[(size_t)(d4 + i) * 128]; }
        if (N == 32) {
            for (int n0 = 0; n0 < 32; n0 += 8) {
                f32x4 c[8], dc[8];
#pragma unroll
                for (int i = 0; i < 8; ++i) { const int n = dir ? (31 - n0 - i) : (n0 + i); const int u = (cg0 + n) * 4 + h;
                    c[i] = *(const f32x4*)(CTb + ((size_t)u * 2 + dir) * 8192 + e * 64 + d4); dc[i] = *(const f32x4*)(DEC + (size_t)u * 128 + dir * 64 + d4); }
#pragma unroll
                for (int i = 0; i < 8; ++i) { const int n = dir ? (31 - n0 - i) : (n0 + i); const int u = (cg0 + n) * 4 + h;
                    *(f32x4*)(CTb + ((size_t)u * 2 + dir) * 8192 + e * 64 + d4) = st; st = dc[i] * st + c[i]; }
            }
        } else {
            f32x4 c[4], dc[4];
#pragma unroll
            for (int i = 0; i < 4; ++i) { const int n = dir ? (3 - i) : i; const int u = (cg0 + n) * 4 + h;
                c[i] = *(const f32x4*)(CTb + ((size_t)u * 2 + dir) * 8192 + e * 64 + d4); dc[i] = *(const f32x4*)(DEC + (size_t)u * 128 + dir * 64 + d4); }
#pragma unroll
            for (int i = 0; i < 4; ++i) { const int n = dir ? (3 - i) : i; const int u = (cg0 + n) * 4 + h;
                *(f32x4*)(CTb + ((size_t)u * 2 + dir) * 8192 + e * 64 + d4) = st; st = dc[i] * st + c[i]; }
        }
        if (seq < 16) { float* o = a.out + (dir ? O_SB : O_SF) + ((size_t)(seq * 4 + h) * 64) * 128 + e;
#pragma unroll
            for (int i = 0; i < 4; ++i) o[(size_t)(d4 + i) * 128] = st[i]; }
    }
}

__device__ __forceinline__ void gla_stepC(const Args& a, int wv, LAS unsigned char* lds, int u) {
    const int tid = otid(wv), lane = tid & 63, wave = __builtin_amdgcn_readfirstlane(tid >> 6), d = tid & 63, tg = tid >> 6, fr = lane & 15, fq = lane >> 4;
    const int cgi = u >> 2, h = u & 3, r0 = cgi * 64;
    const bf16_t* Z = (const bf16_t*)(a.ws + WS_Z);
    float cumF[8], cumB[8], totF, totB;
    gla_gates(a, wv, lds, r0, h, cumF, cumB, totF, totB);
#pragma unroll
    for (int i = 0; i < 8; ++i) { const int t = tg * 8 + i; const float q = bf2f(Z[(size_t)(r0 + t) * ZP + C_GQ + h * 64 + d]) * 0.125f, k = bf2f(Z[(size_t)(r0 + t) * ZP + C_GK + h * 64 + d]);
        *(LAS bf16_t*)(lds + GL_QF + t * GROW + d * 2) = f2bf(q * __expf(cumF[i]));
        *(LAS bf16_t*)(lds + GL_KF + t * GROW + d * 2) = f2bf(k * __expf(-cumF[i]));
        *(LAS bf16_t*)(lds + GL_QB + t * GROW + d * 2) = f2bf(q * __expf(cumB[i]));
        *(LAS bf16_t*)(lds + GL_KB + t * GROW + d * 2) = f2bf(k * __expf(-cumB[i])); }
    gla_load_vT(a, wv, lds, r0, h);
    __syncthreads();
    const int ch = wave & 1, eq = wave >> 1;
    f32x4 oT[2][2];
#pragma unroll
    for (int i = 0; i < 2; ++i)
#pragma unroll
        for (int j = 0; j < 2; ++j) oT[i][j] = (f32x4){0.f, 0.f, 0.f, 0.f};
#pragma unroll
    for (int dir = 0; dir < 2; ++dir) {
        const LAS unsigned char* qe = lds + (dir ? GL_QB : GL_QF); const LAS unsigned char* ke = lds + (dir ? GL_KB : GL_KF);
        const float* ST = (const float*)(a.ws + WS_CT) + ((size_t)u * 2 + dir) * 8192;
        bf16x8 sf[2][2];
#pragma unroll
        for (int eb = 0; eb < 2; ++eb)
#pragma unroll
            for (int ks = 0; ks < 2; ++ks) { const float* p = ST + (16 * (2 * eq + eb) + fr) * 64 + 32 * ks + 8 * fq; const f32x4 x0 = *(const f32x4*)p, x1 = *(const f32x4*)(p + 4);
                u32x4 w; w.x = cvt_pk_bf16(x0[0], x0[1]); w.y = cvt_pk_bf16(x0[2], x0[3]); w.z = cvt_pk_bf16(x1[0], x1[1]); w.w = cvt_pk_bf16(x1[2], x1[3]); sf[eb][ks] = __builtin_bit_cast(bf16x8, w); }
#pragma unroll
        for (int cb = 0; cb < 2; ++cb) {
            const int cbg = 2 * ch + cb;
            bf16x8 qf[2];
#pragma unroll
            for (int ks = 0; ks < 2; ++ks) qf[ks] = *(const LAS bf16x8*)(qe + (16 * cbg + fr) * GROW + (32 * ks + 8 * fq) * 2);
            f32x4 att[4];
#pragma unroll
            for (int sb = 0; sb < 4; ++sb) {
                f32x4 acc = {0.f, 0.f, 0.f, 0.f};
                const bool need = dir == 0 ? (sb <= cbg) : (sb >= cbg);
                if (need) {
#pragma unroll
                    for (int ks = 0; ks < 2; ++ks) { const bf16x8 kfr = *(const LAS bf16x8*)(ke + (16 * sb + fr) * GROW + (32 * ks + 8 * fq) * 2); acc = __builtin_amdgcn_mfma_f32_16x16x32_bf16(kfr, qf[ks], acc, 0, 0, 0); }
                    if (sb == cbg) {
#pragma unroll
                        for (int j = 0; j < 4; ++j) { const int sl = 4 * fq + j; const bool keep = dir == 0 ? (sl <= fr) : (sl >= fr); acc[j] = keep ? acc[j] : 0.f; } }
                }
                att[sb] = acc;
            }
#pragma unroll
            for (int kp = 0; kp < 2; ++kp) {
                u32x4 w; w.x = cvt_pk_bf16(att[2 * kp][0], att[2 * kp][1]); w.y = cvt_pk_bf16(att[2 * kp][2], att[2 * kp][3]); w.z = cvt_pk_bf16(att[2 * kp + 1][0], att[2 * kp + 1][1]); w.w = cvt_pk_bf16(att[2 * kp + 1][2], att[2 * kp + 1][3]);
                const bf16x8 pb = __builtin_bit_cast(bf16x8, w);
#pragma unroll
                for (int eb = 0; eb < 2; ++eb) { const LAS unsigned char* vp = lds + GL_VT + (16 * (2 * eq + eb) + fr) * GROW + (32 * kp + 4 * fq) * 2;
                    const u32x2 v0 = *(const LAS u32x2*)vp, v1 = *(const LAS u32x2*)(vp + 32); const u32x4 vv = {v0.x, v0.y, v1.x, v1.y};
                    oT[eb][cb] = __builtin_amdgcn_mfma_f32_16x16x32_bf16(__builtin_bit_cast(bf16x8, vv), pb, oT[eb][cb], 0, 0, 0); }
            }
#pragma unroll
            for (int ks = 0; ks < 2; ++ks)
#pragma unroll
                for (int eb = 0; eb < 2; ++eb) oT[eb][cb] = __builtin_amdgcn_mfma_f32_16x16x32_bf16(sf[eb][ks], qf[ks], oT[eb][cb], 0, 0, 0);
        }
    }
    LAS float* red = (LAS float*)(lds + GL_RED);
#pragma unroll
    for (int cb = 0; cb < 2; ++cb) { float s = 0.f;
#pragma unroll
        for (int eb = 0; eb < 2; ++eb)
#pragma unroll
            for (int j = 0; j < 4; ++j) s += oT[eb][cb][j] * oT[eb][cb][j];
        s += __shfl_xor(s, 16); s += __shfl_xor(s, 32);
        if (fq == 0) red[eq * 64 + 16 * (2 * ch + cb) + fr] = s; }
    __syncthreads();
    bf16_t* MIX = (bf16_t*)(a.ws + WS_MIX);
#pragma unroll
    for (int cb = 0; cb < 2; ++cb) { const int c = 16 * (2 * ch + cb) + fr; const float tot = red[c] + red[64 + c] + red[128 + c] + red[192 + c]; const float rstd = rsqrtf(tot * (1.f / 128.f) + EPS);
#pragma unroll
        for (int eb = 0; eb < 2; ++eb) { const int e = 16 * (2 * eq + eb) + 4 * fq; const f32x4 gn = *(const f32x4*)(a.in[I_GLAN] + e);
            const u32x2 gw = *(const u32x2*)(Z + (size_t)(r0 + c) * ZP + C_GOUT + h * 128 + e);
            const float g0 = bflo(gw.x), g1 = bfhi(gw.x), g2 = bflo(gw.y), g3 = bfhi(gw.y);
            const f32x4 o = oT[eb][cb] * rstd * gn; u32x2 w; w.x = cvt_pk_bf16(o[0] * silu_f(g0), o[1] * silu_f(g1)); w.y = cvt_pk_bf16(o[2] * silu_f(g2), o[3] * silu_f(g3));
            *(u32x2*)(MIX + (size_t)(r0 + c) * D + 512 + h * 128 + e) = w; } }
    __syncthreads();
}

constexpr int AT_KROW = 208, AT_VROW = 144, AT_KB = 64 * AT_KROW  , AT_STAGE = AT_KB + 64 * AT_VROW  ;
__device__ __forceinline__ void attn_unit(const Args& a, int wv, LAS unsigned char* lds, int idx) {
    const int tid = otid(wv), lane = tid & 63, wave = __builtin_amdgcn_readfirstlane(tid >> 6), fr = lane & 15, fq = lane >> 4;
    int row0, S, nt; const bf16_t* Kb; const bf16_t* Vb; int h;
    if (idx < 256) { const int b = idx >> 7, qb = idx & 15; h = (idx >> 4) & 7; row0 = MP + b * 2048 + qb * 128; S = SKS; nt = 36;
        Kb = (const bf16_t*)(a.ws + WS_KS) + (size_t)(b * 8 + h) * SKS * 96; Vb = (const bf16_t*)(a.ws + WS_VTS) + (size_t)(b * 8 + h) * 64 * SKS; }
    else { const int j = idx - 256; const int b = j >> 4, qb = j & 1; h = (j >> 1) & 7; row0 = b * 256 + qb * 128; S = 256; nt = 4;
        Kb = (const bf16_t*)(a.ws + WS_KP) + (size_t)(b * 8 + h) * 256 * 96; Vb = (const bf16_t*)(a.ws + WS_VTP) + (size_t)(b * 8 + h) * 64 * 256; }
    const char* src[3]; unsigned step[3]; unsigned dst[3]; bool valid[3];
#pragma unroll
    for (int j = 0; j < 3; ++j) { const int ins = wave + 8 * j; valid[j] = ins < 22;
        if (ins < 13) { const int ck = ins * 64 + lane, r = ck / 13, cc = ck % 13; src[j] = (const char*)Kb + (size_t)r * 192 + (cc < 12 ? cc : 11) * 16; step[j] = 64 * 192; dst[j] = ins * 1024; }
        else { const int cv = (ins - 13) * 64 + lane, r = cv / 9, cc = cv % 9; src[j] = (const char*)Vb + (size_t)r * S * 2 + (cc < 8 ? cc : 7) * 16; step[j] = 128; dst[j] = AT_KB + (ins - 13) * 1024; } }
#define AT_ISSUE(t, buf) do { _Pragma("unroll") for (int j = 0; j < 3; ++j) if (valid[j]) \
        __builtin_amdgcn_global_load_lds((const unsigned*)(src[j] + (size_t)(t) * step[j]), (LAS unsigned*)(lds + (buf) * AT_STAGE + dst[j]), 16, 0, 0); } while (0)
    AT_ISSUE(0, 0);
    const bf16_t* Q = (const bf16_t*)(a.ws + WS_Q) + (size_t)(row0 + wave * 16 + fr) * 768 + h * 96 + 8 * fq;
    bf16x8 qf[3];
#pragma unroll
    for (int ks = 0; ks < 3; ++ks) qf[ks] = *(const bf16x8*)(Q + 32 * ks);
    float mrun = -1e30f, lsum = 0.f;
    f32x4 o[4];
#pragma unroll
    for (int i = 0; i < 4; ++i) o[i] = (f32x4){0.f, 0.f, 0.f, 0.f};
    for (int t = 0; t < nt; ++t) {
        VM_WAIT(); __syncthreads();
        if (t + 1 < nt) AT_ISSUE(t + 1, (t + 1) & 1);
        const LAS unsigned char* kt = lds + (t & 1) * AT_STAGE; const LAS unsigned char* vt = kt + AT_KB;
        f32x4 s[4];
#pragma unroll
        for (int kb = 0; kb < 4; ++kb) { s[kb] = (f32x4){0.f, 0.f, 0.f, 0.f};
#pragma unroll
            for (int ks = 0; ks < 3; ++ks) { const bf16x8 kf = *(const LAS bf16x8*)(kt + (16 * kb + fr) * AT_KROW + (32 * ks + 8 * fq) * 2); s[kb] = __builtin_amdgcn_mfma_f32_16x16x32_bf16(kf, qf[ks], s[kb], 0, 0, 0); } }
        float mx = fmaxf(fmaxf(fmaxf(s[0][0], s[0][1]), fmaxf(s[0][2], s[0][3])), fmaxf(fmaxf(s[1][0], s[1][1]), fmaxf(s[1][2], s[1][3])));
        mx = fmaxf(mx, fmaxf(fmaxf(fmaxf(s[2][0], s[2][1]), fmaxf(s[2][2], s[2][3])), fmaxf(fmaxf(s[3][0], s[3][1]), fmaxf(s[3][2], s[3][3]))));
        mx = fmaxf(mx, __shfl_xor(mx, 16)); mx = fmaxf(mx, __shfl_xor(mx, 32));
        const float mnew = fmaxf(mrun, mx); const float alpha = __builtin_amdgcn_exp2f(mrun - mnew); mrun = mnew;
        float ps = 0.f;
#pragma unroll
        for (int kb = 0; kb < 4; ++kb)
#pragma unroll
            for (int j = 0; j < 4; ++j) { s[kb][j] = __builtin_amdgcn_exp2f(s[kb][j] - mnew); ps += s[kb][j]; }
        lsum = lsum * alpha + ps;
#pragma unroll
        for (int i = 0; i < 4; ++i) o[i] = o[i] * alpha;
#pragma unroll
        for (int kp = 0; kp < 2; ++kp) {
            u32x4 w; w.x = cvt_pk_bf16(s[2 * kp][0], s[2 * kp][1]); w.y = cvt_pk_bf16(s[2 * kp][2], s[2 * kp][3]); w.z = cvt_pk_bf16(s[2 * kp + 1][0], s[2 * kp + 1][1]); w.w = cvt_pk_bf16(s[2 * kp + 1][2], s[2 * kp + 1][3]);
            const bf16x8 pb = __builtin_bit_cast(bf16x8, w);
#pragma unroll
            for (int mb = 0; mb < 4; ++mb) { const LAS unsigned char* vp = vt + (16 * mb + fr) * AT_VROW + (32 * kp + 4 * fq) * 2;
                const u32x2 v0 = *(const LAS u32x2*)vp, v1 = *(const LAS u32x2*)(vp + 32); const u32x4 vv = {v0.x, v0.y, v1.x, v1.y};
                o[mb] = __builtin_amdgcn_mfma_f32_16x16x32_bf16(__builtin_bit_cast(bf16x8, vv), pb, o[mb], 0, 0, 0); }
        }
    }
    lsum += __shfl_xor(lsum, 16); lsum += __shfl_xor(lsum, 32);
    const float il = fast_rcp(lsum);
    bf16_t* MIX = (bf16_t*)(a.ws + WS_MIX) + (size_t)(row0 + wave * 16 + fr) * D + h * 64 + 4 * fq;
#pragma unroll
    for (int mb = 0; mb < 4; ++mb) { u32x2 w; w.x = cvt_pk_bf16(o[mb][0] * il, o[mb][1] * il); w.y = cvt_pk_bf16(o[mb][2] * il, o[mb][3] * il); *(u32x2*)(MIX + 16 * mb) = w; }
    __syncthreads();
#undef AT_ISSUE
}

__device__ unsigned g_bar[64 * 52];
#define GB(i) (g_bar + 64 * (i))
__device__ __forceinline__ unsigned gb_ld(unsigned* p) { return __hip_atomic_load(p, __ATOMIC_RELAXED, __HIP_MEMORY_SCOPE_AGENT); }
__device__ __forceinline__ unsigned gb_add(unsigned* p, unsigned v) { return __hip_atomic_fetch_add(p, v, __ATOMIC_RELAXED, __HIP_MEMORY_SCOPE_AGENT); }
__device__ __forceinline__ unsigned xcc_id() { return (unsigned)__builtin_amdgcn_s_getreg((3 << 11) | 20) & 0xFu; }
__device__ __forceinline__ void my_grid_barrier(unsigned nth, unsigned G, int tid, LAS unsigned* st) {
    asm volatile("s_waitcnt vmcnt(0) lgkmcnt(0)" ::: "memory");
    __syncthreads();
    if (tid == 0) {
        if (nth == 1u) {
            const unsigned x = xcc_id(); unsigned sum, cnt, mine;
            for (;;) { sum = 0u; cnt = 0u; mine = 0u;
#pragma unroll
                for (unsigned j = 0; j < 16; ++j) { const unsigned c = gb_ld(GB(4 + j)); sum += c; cnt += (c > 0u) ? 1u : 0u; mine = (j == x) ? c : mine; }
                if (sum >= G) break; __builtin_amdgcn_s_sleep(1); }
            st[0] = mine; st[1] = cnt; st[2] = x;
        }
        const unsigned nloc = st[0], nx = st[1], x = st[2];
        const unsigned old = gb_add(GB(20 + x), 1u);
        if (old + 1u == nth * nloc) {
            __builtin_amdgcn_fence(__ATOMIC_RELEASE, "agent");
            asm volatile("s_waitcnt vmcnt(0)" ::: "memory");
            const unsigned og = gb_add(GB(1), 1u);
            if (og + 1u == nth * nx) gb_add(GB(2), 1u);
            else while (gb_ld(GB(2)) < nth) __builtin_amdgcn_s_sleep(1);
            __builtin_amdgcn_fence(__ATOMIC_ACQUIRE, "agent");
            gb_add(GB(36 + x), 1u);
            asm volatile("s_waitcnt vmcnt(0)" ::: "memory");
        } else {
            while (gb_ld(GB(36 + x)) < nth) __builtin_amdgcn_s_sleep(1);
            __builtin_amdgcn_fence(__ATOMIC_ACQUIRE, "agent");
            asm volatile("s_waitcnt vmcnt(0)" ::: "memory");
        }
    }
    __syncthreads();
}
__device__ __forceinline__ void my_grid_barrier_finish(unsigned G, int tid) {
    if (tid == 0) {
        const unsigned old = gb_add(GB(0), 1u);
        if (old == G - 1u) { for (int i = 0; i < 52; ++i) __hip_atomic_store(GB(i), 0u, __ATOMIC_RELAXED, __HIP_MEMORY_SCOPE_AGENT); }
    }
}
constexpr int NPHASE = 11;
__global__ void __launch_bounds__(512, 2) mk_fwd(Args a) {
    const int wv = __builtin_amdgcn_readfirstlane((int)threadIdx.x >> 6);
    extern __shared__ __attribute__((aligned(16))) unsigned char lds_raw[];
    LAS unsigned char* lds = (LAS unsigned char*)lds_raw;
    const int G = gridDim.x, bx = blockIdx.x;
    const int vcu = (G % 8 == 0) ? (bx % 8) * (G / 8) + bx / 8 : bx;
    unsigned char* ws = a.ws;
    const int lo = a.ph_lo, hi = a.ph_hi;
#ifndef PHMASK
#define PHMASK 0x7ff
#endif
#define IN(k) (((PHMASK >> (k)) & 1) && lo <= (k) && (k) < hi)
#define SEAM(k) do { if (IN(k) && IN((k) + 1)) { ++nbar; my_grid_barrier(nbar, (unsigned)G, otid(wv), (LAS unsigned*)(lds + LDS_BYTES - 64)); } } while (0)
#ifndef PROBE_FILL
#define PROBE_FILL 0
#endif
    if (PROBE_FILL && lo == 0) { f32x4* p = (f32x4*)a.ws; const size_t n = (size_t)(PROBE_FILL_MIB) << 16; const float fv = PROBE_FILL_VAL;
        for (size_t i = (size_t)bx * 512 + threadIdx.x; i < n; i += (size_t)G * 512) { unsigned h = (unsigned)i * 2654435761u; h ^= h >> 15; h *= 2246822519u; h ^= h >> 13; const float r0 = (float)(h & 0xffff) * (1.f / 65536.f) - 0.5f + fv * 0.f; p[i] = (f32x4){r0, r0 * 1.7f, r0 * -0.3f, r0 + 0.1f}; } }
    if (PROBE_FILL == 2 && lo == 0 && bx == 0) { static const int szs[26] = {4194304, 4194304, 131072, 16384, 65536, 65536, 2048, 1024, 6291456, 6144, 1024, 2293760, 384, 294912, 256, 262144, 4096, 256, 4096, 256, 128, 1048576, 1024, 5767168, 2883584, 1024};
        float sm = 0.f; for (int i = 0; i < 26; ++i) { const int n = szs[i]; const int st = n > 1024 ? n - 1024 : 0; for (int j = st + (int)threadIdx.x; j < n; j += 512) sm += a.in[i][j]; for (int j = threadIdx.x; j < (n < 1024 ? n : 1024); j += 512) sm += a.in[i][j]; }
        ((float*)(a.ws))[threadIdx.x] = sm; }
    if (PROBE_FILL == 5 && lo == 0) { volatile float* p = (volatile float*)a.ws; const float big = p[0] * 0.f + 1e38f, tiny = p[1] * 0.f + 1e-38f, zero = p[2] * 0.f, neg = p[3] * 0.f - 1.f;
        float r = 0.f;
#if PROBE_EXC & 1
        r += big * big;
#endif
#if PROBE_EXC & 2
        r += tiny * tiny;
#endif
#if PROBE_EXC & 4
        r += 1.f / zero;
#endif
#if PROBE_EXC & 8
        r += __builtin_sqrtf(neg);
#endif
        p[4 + bx] = r; }
    unsigned nbar = 0;
    if (otid(wv) == 0) gb_add(GB(4 + xcc_id()), 1u);
    if (IN(0)) { for (int rep = 0; rep < PROBE_P0_REP; ++rep) { phase0(a, wv, lds, vcu, G); __syncthreads(); } } SEAM(0);
    if (IN(1)) { for (int rep = 0; rep < PROBE_ROW_REP; ++rep) phase1(a, wv, vcu, G); } SEAM(1);
    if (PROBE_HANG && lo == 1) { volatile unsigned* q = (volatile unsigned*)(a.ws + 8); while (*q != 0x12345678u) __builtin_amdgcn_s_sleep(20); }
    if (IN(2)) {
        pg8::Gemm g{(const bf16_t*)(ws + WS_H), (const bf16_t*)(ws + WS_WIN), D, D, D, wv}; pg8::Order S; S.init(MTOK, 2048, 1, G, bx);
        pg8::EpiZ E{(bf16_t*)(ws + WS_Z), (float*)(ws + WS_RSSQ), (float*)(ws + WS_RSSKV), 0};
        pg8::gemm_phase<pg8::EpiZ, pg8::Order>(lds, g, S, E);
    } SEAM(2);
    if (IN(3)) {
#ifndef P3MASK
#define P3MASK 0x3f
#endif
#if (P3MASK >> 0) & 1
        { pg8::Gemm g{(const bf16_t*)(ws + WS_Z) + C_QLAT, (const bf16_t*)(ws + WS_WUQ), ZP, 384, 384, wv}; pg8::Order S; S.init(MTOK, 768, 1, G, bx);
          pg8::EpiQ E{(bf16_t*)(ws + WS_Q), (const float*)(ws + WS_RSSQ)}; pg8::gemm_phase<pg8::EpiQ, pg8::Order>(lds, g, S, E); }
#endif
#if (P3MASK >> 1) & 1
        { pg8::Gemm g{(const bf16_t*)(ws + WS_Z) + C_KVLAT, (const bf16_t*)(ws + WS_WKF), ZP, 256, 256, wv}; pg8::Order S; S.init(MTOK, 512, 1, G, (bx + G - 96) % G);
          pg8::EpiK E{(bf16_t*)(ws + WS_KP), (bf16_t*)(ws + WS_KS), (const float*)(ws + WS_RSSKV), 0}; pg8::gemm_phase<pg8::EpiK, pg8::Order>(lds, g, S, E); }
#endif
#if (P3MASK >> 2) & 1
        { pg8::Gemm g{(const bf16_t*)(ws + WS_WVF), (const bf16_t*)(ws + WS_Z) + C_KVLAT, 256, ZP, 256, wv}; pg8::Order S; S.init(512, MTOK, 1, G, (bx + G - 160) % G);
          pg8::EpiVt E{(bf16_t*)(ws + WS_VTP), (bf16_t*)(ws + WS_VTS), (const float*)(ws + WS_RSSKV), 0}; pg8::gemm_phase<pg8::EpiVt, pg8::Order>(lds, g, S, E); }
#endif
        { pg8::Gemm g{(const bf16_t*)(ws + WS_H), (const bf16_t*)(ws + WS_WIN) + (size_t)2048 * D, D, D, D, wv}; pg8::Order S; S.init(MTOK, 256, 1, G, (bx + G - 224) % G);
          pg8::EpiZ E{(bf16_t*)(ws + WS_Z), (float*)(ws + WS_RSSQ), (float*)(ws + WS_RSSKV), 8}; pg8::gemm_phase<pg8::EpiZ, pg8::Order>(lds, g, S, E); }
#if (P3MASK >> 3) & 1
        { pg8::Gemm g{(const bf16_t*)(ws + WS_CACHEB), (const bf16_t*)(ws + WS_WKU), 256, 256, 256, wv}; pg8::Order S; S.init(512, 512, 1, G, (bx + G - 224) % G);
          pg8::EpiK E{(bf16_t*)(ws + WS_KP), (bf16_t*)(ws + WS_KS), (const float*)(ws + WS_RSSKV), 1}; pg8::gemm_phase<pg8::EpiK, pg8::Order>(lds, g, S, E); }
#endif
#if (P3MASK >> 4) & 1
        { pg8::Gemm g{(const bf16_t*)(ws + WS_WVU), (const bf16_t*)(ws + WS_CACHEB), 256, 256, 256, wv}; pg8::Order S; S.init(512, 512, 1, G, (bx + G - 228) % G);
          pg8::EpiVt E{(bf16_t*)(ws + WS_VTP), (bf16_t*)(ws + WS_VTS), (const float*)(ws + WS_RSSKV), 1}; pg8::gemm_phase<pg8::EpiVt, pg8::Order>(lds, g, S, E); }
#endif
        __syncthreads();
        if (bx < 224) {
            for (int u = bx; u < 512; u += 224) gla_stepA(a, wv, lds, u);
            p3_row_extras(a, wv, bx * 8 + (otid(wv) >> 6), 224 * 8);
        }
    } SEAM(3);
    if (IN(4)) { gla_scan(a, wv, vcu, G); } SEAM(4);
    if (IN(5)) {
        for (int rep = 0; rep < PROBE_ATT_REP; ++rep) for (int u = vcu; u < 512; u += G) attn_unit(a, wv, lds, u);
        for (int rep = 0; rep < PROBE_GLAC_REP; ++rep) for (int u = vcu; u < 512; u += G) gla_stepC(a, wv, lds, u);
    } SEAM(5);
    if (IN(6)) {
        pg8::Gemm g{(const bf16_t*)(ws + WS_MIX), (const bf16_t*)(ws + WS_WOUT), D, D, PROBE_K6, wv}; pg8::Order S; S.init(MTOK, D, 1024 / PROBE_K6, G, bx);
        pg8::EpiPart E{(bf16_t*)(ws + WS_P0), (bf16_t*)(ws + WS_P1A)}; pg8::gemm_phase<pg8::EpiPart, pg8::Order>(lds, g, S, E);
    } SEAM(6);
    if (IN(7)) { for (int rep = 0; rep < PROBE_ROW_REP; ++rep) phase6(a, wv, vcu, G); } SEAM(7);
    if (IN(8)) {
        pg8::Gemm g{(const bf16_t*)(ws + WS_H), (const bf16_t*)(ws + WS_WFFI), D, D, D, wv}; pg8::Order S; S.init(MTOK, 2 * DFF, 1, G, bx);
        pg8::EpiFFI E{(bf16_t*)(ws + WS_HFF)}; for (int rep = 0; rep < PROBE_FFI_REP; ++rep) pg8::gemm_phase<pg8::EpiFFI, pg8::Order>(lds, g, S, E);
    } SEAM(8);
    if (IN(9)) {
        pg8::Gemm g{(const bf16_t*)(ws + WS_HFF), (const bf16_t*)(ws + WS_WFFO), DFF, DFF, DFF / 2, wv}; pg8::Order S; S.init(MTOK, D, 2, G, bx);
        pg8::EpiPart E{(bf16_t*)(ws + WS_P0), (bf16_t*)(ws + WS_P1B)}; pg8::gemm_phase<pg8::EpiPart, pg8::Order>(lds, g, S, E);
    } SEAM(9);
    if (IN(10)) { for (int rep = 0; rep < PROBE_ROW_REP; ++rep) phase9(a, wv, vcu, G); }
    if (PROBE_DUMP) {
        if (PROBE_DUMP != 5 && PROBE_DUMP != 7) { ++nbar; } if (PROBE_DUMP != 5 && PROBE_DUMP != 7) my_grid_barrier(nbar, (unsigned)G, otid(wv), (LAS unsigned*)(lds + LDS_BYTES - 64));
        const bf16_t* src = (const bf16_t*)(ws + (PROBE_DUMP == 1 ? WS_Z : PROBE_DUMP == 2 ? WS_MIX : WS_H)); const int pitch = PROBE_DUMP == 1 ? ZP : D;
        for (size_t i = (size_t)bx * 512 + otid(wv); i < (size_t)MTOK * D; i += (size_t)G * 512) { const int r = (int)(i >> 10), c = (int)(i & 1023); a.out[i] = PROBE_DUMP == 7 ? 1.0f : PROBE_DUMP == 6 ? (r < 2304 ? bf2f(((const bf16_t*)(ws + WS_WIN))[(size_t)r * 1024 + c]) : 0.f) : PROBE_DUMP >= 4 ? xrow_ptr(a, r)[c] * 2.f : bf2f(src[(size_t)r * pitch + c]); }
        for (size_t i = O_KV + (size_t)bx * 512 + otid(wv); i < 10616832; i += (size_t)G * 512) a.out[i] = 0.f;
    }
    for (int xb = 0; xb < PROBE_XBAR; ++xb) { ++nbar; my_grid_barrier(nbar, (unsigned)G, otid(wv), (LAS unsigned*)(lds + LDS_BYTES - 64)); }
    if (nbar) my_grid_barrier_finish((unsigned)G, otid(wv));
#undef IN
#undef SEAM
}

extern "C" void kernel_launch(void* const* d_in, const int* in_sizes, int n_in, void* d_out, int out_size, void* d_ws, size_t ws_size, hipStream_t stream) {
    static int grid = 0;
    if (grid == 0) {
        int dev = 0, cus = 0;
        static const int exp_sizes[26] = {4194304, 4194304, 131072, 16384, 65536, 65536, 2048, 1024, 6291456, 6144, 1024, 2293760, 384, 294912, 256, 262144, 4096, 256, 4096, 256, 128, 1048576, 1024, 5767168, 2883584, 1024};
        bool okk = (n_in == 26); for (int i = 0; okk && i < 26; ++i) okk = (in_sizes[i] == exp_sizes[i]);
        if (!okk || out_size != 10616832) { fprintf(stderr, "kernel_launch: unexpected input sizes\n"); grid = -1; return; }
        if (n_in != 26 || ws_size < 198 * MiB) { fprintf(stderr, "kernel_launch: unexpected n_in %d / ws %zu\n", n_in, ws_size); grid = -1; return; }
        hipGetDevice(&dev); hipDeviceGetAttribute(&cus, hipDeviceAttributeMultiprocessorCount, dev);
        if (hipFuncSetAttribute((const void*)mk_fwd, hipFuncAttributeMaxDynamicSharedMemorySize, LDS_BYTES) != hipSuccess) { fprintf(stderr, "kernel_launch: hipFuncSetAttribute failed\n"); grid = -1; return; }
        int per_cu = 0;
        if (hipOccupancyMaxActiveBlocksPerMultiprocessor(&per_cu, (const void*)mk_fwd, 512, LDS_BYTES) != hipSuccess || per_cu < 1) { fprintf(stderr, "kernel_launch: occupancy query says %d\n", per_cu); per_cu = 1; }
        (void)hipGetLastError();
        if (cus < 256) { fprintf(stderr, "kernel_launch: needs 256 CUs, got %d\n", cus); grid = -1; return; }
        grid = 256;
    }
    if (grid < 0) return;
    Args a{};
    for (int i = 0; i < 26; ++i) a.in[i] = (const float*)d_in[i];
    a.out = (float*)d_out; a.ws = (unsigned char*)d_ws;
#if MK_PER_PHASE_LAUNCH
    for (int p = 0; p < NPHASE; ++p) { if (PROBE_ONLY_LAUNCH >= 0 && p != PROBE_ONLY_LAUNCH) continue; a.ph_lo = p; a.ph_hi = p + 1; hipLaunchKernelGGL(mk_fwd, dim3(grid), dim3(512), LDS_BYTES, stream, a); }
#else
    a.ph_lo = 0; a.ph_hi = NPHASE;
#if MK_COOP
    void* args[] = {&a};
    hipError_t e = hipLaunchCooperativeKernel((const void*)mk_fwd, dim3(grid), dim3(512), args, LDS_BYTES, stream);
    if (e != hipSuccess) fprintf(stderr, "cooperative launch failed: %s (grid %d)\n", hipGetErrorString(e), grid);
#else
    hipLaunchKernelGGL(mk_fwd, dim3(grid), dim3(512), LDS_BYTES, stream, a);
#endif
#endif
}
```

```cpp
#include <hip/hip_runtime.h>
#include <hip/hip_cooperative_groups.h>
#include <cstdio>
#include <cstdint>
namespace cg = cooperative_groups;

#define PROBE_FILL 0
#define PROBE_EXC 0
#define PROBE_BLO 0
#define PROBE_BHI 256
#define PROBE_RSTRIDE 1
#define PROBE_REP 1
#define PROBE_XLO 0
#define PROBE_XHI 8
#define PROBE_HANG 0
#define PROBE_ATT_REP 1
#define PROBE_GLAC_REP 1
#define PROBE_FFI_REP 1
#define PROBE_XBAR 0
#define PROBE_P0_REP 1
#define PROBE_ROW_REP 1
#define PROBE_P3_REP 1
#define PROBE_DUMP 0
#define PROBE_STATS 0
#define PROBE_K6 512
#define PROBE_ONLY_LAUNCH -1
#define PROBE_NOSTORE 0
#define PROBE_FILL_MIB 256
#define PROBE_FILL_VAL 1.2345f
#ifndef PROBE_MUL
#define PROBE_MUL 1.f
#endif
#ifndef PROBE_MODOFF
#define PROBE_MODOFF 0u
#endif
#ifndef MK_COOP
#define MK_COOP 0
#endif
#ifndef MK_PER_PHASE_LAUNCH
#define MK_PER_PHASE_LAUNCH 0
#endif

#define LAS __attribute__((address_space(3)))
typedef unsigned short bf16_t;
typedef short bf16x8 __attribute__((ext_vector_type(8)));
typedef float f32x4 __attribute__((ext_vector_type(4)));
typedef float f32x2 __attribute__((ext_vector_type(2)));
typedef unsigned u32x4 __attribute__((ext_vector_type(4)));
typedef unsigned u32x2 __attribute__((ext_vector_type(2)));

constexpr int D = 1024, MTOK = 8192, MP = 4096;
constexpr int ZP = 2304;
constexpr int C_QLAT = 0, C_KVLAT = 384, C_KROPE = 640, C_GQ = 672, C_GK = 928, C_GV = 1184, C_GFL = 1696, C_GOUT = 1728;
constexpr int DFF = 2816;
constexpr float EPS = 1e-6f;
constexpr float QSCALE = 0.10206207261596577f * 1.4426950408889634f;
constexpr int SKS = 2304;

constexpr size_t MiB = 1u << 20;
constexpr size_t WS_WIN = 1 * MiB;
constexpr size_t WS_WUQ = 6 * MiB;
constexpr size_t WS_WKF = 7 * MiB, WS_WVF = 7 * MiB + 256 * 1024;
constexpr size_t WS_WKU = 7 * MiB + 512 * 1024, WS_WVU = 7 * MiB + 768 * 1024;
constexpr size_t WS_WOUT = 8 * MiB;
constexpr size_t WS_WFFI = 10 * MiB;
constexpr size_t WS_WFFO = 21 * MiB;
constexpr size_t WS_BAR = 27 * MiB - 4096;
constexpr size_t WS_MOD = 27 * MiB;
constexpr size_t WS_RSSQ = 29 * MiB;
constexpr size_t WS_RSSKV = WS_RSSQ;
constexpr size_t WS_CACHEB = 27 * MiB + 512 * 1024;
constexpr size_t WS_DEC = 28 * MiB;
constexpr size_t WS_H = 32 * MiB;
constexpr size_t WS_Z = 48 * MiB;
constexpr size_t WS_Q = 84 * MiB;
constexpr size_t WS_HFF = 48 * MiB;
constexpr size_t WS_KP = 96 * MiB;
constexpr size_t WS_KS = 102 * MiB;
constexpr size_t WS_VTP = 109 * MiB;
constexpr size_t WS_VTS = 113 * MiB;
constexpr size_t WS_CT = 118 * MiB;
constexpr size_t WS_MIX = 150 * MiB;
constexpr size_t WS_X1 = 166 * MiB;
constexpr size_t WS_P0 = 96 * MiB;
constexpr size_t WS_P1A = 48 * MiB, WS_P1B = 128 * MiB;
constexpr size_t O_Y = 0, O_KV = 8388608, O_KR = O_KV + 1048576, O_SF = O_KR + 131072, O_SB = O_SF + 524288;

constexpr int LDS_BYTES = 147456;

__device__ __forceinline__ unsigned f2bf_sw(float f) { unsigned u = __builtin_bit_cast(unsigned, f); return (u + 0x7fffu + ((u >> 16) & 1u)) >> 16; }
__device__ __forceinline__ unsigned cvt_pk_bf16(float lo, float hi) { unsigned r; asm volatile("v_cvt_pk_bf16_f32 %0, %1, %2" : "=v"(r) : "v"(lo), "v"(hi)); return r; }
__device__ __forceinline__ bf16_t f2bf(float f) { return (bf16_t)(cvt_pk_bf16(f, 0.f) & 0xffffu); }
__device__ __forceinline__ float bf2f(bf16_t b) { return __uint_as_float((unsigned)b << 16); }
__device__ __forceinline__ float bflo(unsigned w) { return __uint_as_float(w << 16); }
__device__ __forceinline__ float bfhi(unsigned w) { return __uint_as_float(w & 0xffff0000u); }
__device__ __forceinline__ float wave_sum(float v) {
#pragma unroll
    for (int o = 1; o < 64; o <<= 1) v += __shfl_xor(v, o);
    return v;
}
__device__ __forceinline__ float fast_rcp(float x) { return __builtin_amdgcn_rcpf(x); }
__device__ __forceinline__ float silu_f(float a) { return a * fast_rcp(1.f + __expf(-a)); }
__device__ __forceinline__ float logsigmoid_f(float x) { return fminf(x, 0.f) - __logf(1.f + __expf(-fabsf(x))); }
__device__ __forceinline__ int opaque_lane() { int l; asm volatile("v_mbcnt_lo_u32_b32 %0, -1, 0\n\tv_mbcnt_hi_u32_b32 %0, -1, %0" : "=v"(l)); return l; }
__device__ __forceinline__ int otid(int wv) { int t = (int)threadIdx.x; asm volatile("" : "+v"(t)); return t; }
#define LDS_WAIT() asm volatile("s_waitcnt lgkmcnt(0)" ::: "memory")
#define VM_WAIT() asm volatile("s_waitcnt vmcnt(0)" ::: "memory")

namespace pg8 {
constexpr int BM = 256, BK = 64, HALF = 128, HTB = HALF * BK * 2, STAGE_BYTES = 8 * HTB, NXCD = 8, WGM = 8;
__host__ __device__ __forceinline__ int lds_byte(int r, int c) { const int st = (r >> 4) * 2 + (c >> 5), rr = r & 15, cc = c & 31, ob = rr * 64 + cc * 2; return st * 1024 + (ob ^ (((ob >> 9) & 1) << 5)); }
__host__ __device__ __forceinline__ void stage_rc(int b, int& R, int& C) { const int st = b / 1024, sb = b % 1024, swz = sb ^ (((sb >> 9) & 1) << 5); R = (st >> 1) * 16 + swz / 64; C = (st & 1) * 32 + (swz % 64) / 2; }
__host__ __device__ __forceinline__ int perm32(int rho) { const int n = rho >> 4, i = rho & 15; return 8 * (i >> 2) + 4 * n + (i & 3); }

struct Unit { int pm, pn, ks; };
struct Gemm { const bf16_t* A; const bf16_t* Bt; int lda, ldb, K, wv; };

struct Order {
    int nM, nN, nNs, nwg, G, c;
    __device__ void init(int M, int N, int nsplit, int G_, int c_) { nM = M / BM; nN = N / BM; nNs = nN * nsplit; nwg = nM * nNs; G = G_; c = c_; }
    __device__ bool next(int i, Unit& u) const {
        const long L = (long)i * G + c; if (L >= nwg) return false;
        int wgid = (int)L; { const int q = nwg / NXCD, r = nwg % NXCD, xcd = wgid % NXCD, off = wgid / NXCD; wgid = (xcd < r ? xcd * (q + 1) : r * (q + 1) + (xcd - r) * q) + off; }
        const int nig = WGM * nNs, gid = wgid / nig, fm = gid * WGM, gsz = (nM - fm) < WGM ? (nM - fm) : WGM;
        u.pm = fm + ((wgid % nig) % gsz); const int pn2 = (wgid % nig) / gsz; u.pn = pn2 % nN; u.ks = pn2 / nN; return true;
    }
};

template <class Epi, class Sched, bool ALIGN_EPI = true, bool SP2 = true>
__device__ __forceinline__ void gemm_phase(LAS unsigned char* lds, const Gemm g, const Sched& S, const Epi& E) {
    const int tid = otid(g.wv), wid = g.wv, lane = tid & 63, wr = wid >> 2, wc = wid & 3, fr = lane & 15, fq = lane >> 4;
    const int K = g.K, nt = K / BK;
    unsigned voffA[2], voffB[2];
#pragma unroll
    for (int i = 0; i < 2; ++i) { int R, C; stage_rc(tid * 16 + i * 8192, R, C); const int Rb = Epi::PERM ? ((R & ~31) + perm32(R & 31)) : R;
        voffA[i] = (unsigned)(R * g.lda + C) * 2u; voffB[i] = (unsigned)(Rb * g.ldb + C) * 2u; }
    const size_t kstep = (size_t)(BK * 2);
    const size_t hstepA = (size_t)HALF * g.lda * 2, hstepB = (size_t)HALF * g.ldb * 2;
    const size_t tstepA = 2 * hstepA, tstepB = 2 * hstepB;
    const size_t ksplit = (size_t)K * 2;
    const unsigned ldsw = (unsigned)wid * 1024u;
    const int aoff = lds_byte(wr * 64 + fr, fq * 8), boff = lds_byte(wc * 32 + fr, fq * 8);
#define PG8_SA(b, h) (((b) * 2 + (h)) * HTB)
#define PG8_SB(b, h) ((4 + (b) * 2 + (h)) * HTB)
#define PG8_STAGE(bufoff, gbase, voff) do { _Pragma("unroll") for (int _i = 0; _i < 2; ++_i) \
        __builtin_amdgcn_global_load_lds((const unsigned*)((const char*)(gbase) + (voff)[_i]), (LAS unsigned*)(lds + (bufoff) + ldsw + _i * 8192), 16, 0, 0); } while (0)
#define PG8_LDA(dst, b, h) do { _Pragma("unroll") for (int m = 0; m < 4; ++m) _Pragma("unroll") for (int k = 0; k < 2; ++k) dst[m][k] = *(const LAS bf16x8*)(lds + PG8_SA(b, h) + aoff + m * 2048 + k * 1024); } while (0)
#define PG8_LDB(dst, b, h) do { _Pragma("unroll") for (int n = 0; n < 2; ++n) _Pragma("unroll") for (int k = 0; k < 2; ++k) dst[n][k] = *(const LAS bf16x8*)(lds + PG8_SB(b, h) + boff + n * 2048 + k * 1024); } while (0)
#define PG8_MMA(ai, bj, At, Bt) do { __builtin_amdgcn_s_setprio(1); _Pragma("unroll") for (int m = 0; m < 4; ++m) _Pragma("unroll") for (int n = 0; n < 2; ++n) _Pragma("unroll") for (int k = 0; k < 2; ++k) \
        acc[ai][bj][m][n] = __builtin_amdgcn_mfma_f32_16x16x32_bf16(Bt[n][k], At[m][k], acc[ai][bj][m][n], 0, 0, 0); __builtin_amdgcn_s_setprio(0); } while (0)
#define PG8_WAIT_V(n) asm volatile("s_waitcnt vmcnt(" #n ")" ::: "memory")
#define PG8_WAIT_L(n) asm volatile("s_waitcnt lgkmcnt(" #n ")" ::: "memory")
#define PG8_BAR __builtin_amdgcn_s_barrier()
#define PG8_SCHED __builtin_amdgcn_sched_barrier(0)
    Unit cur, nxt; int ui = 0;
    if (!S.next(0, cur)) return;
    f32x4 acc[2][2][4][2];
#pragma unroll
    for (int a = 0; a < 2; ++a)
#pragma unroll
        for (int b = 0; b < 2; ++b)
#pragma unroll
            for (int m = 0; m < 4; ++m)
#pragma unroll
                for (int n = 0; n < 2; ++n) acc[a][b][m][n] = (f32x4){0.f, 0.f, 0.f, 0.f};
    bf16x8 At[4][2], B0[2][2], B1[2][2];
    const char* cA = (const char*)g.A + (size_t)cur.pm * tstepA + (size_t)cur.ks * ksplit; const char* cB = (const char*)g.Bt + (size_t)cur.pn * tstepB + (size_t)cur.ks * ksplit;
    if constexpr (SP2) {
        PG8_STAGE(PG8_SB(0, 0), cB, voffB); PG8_STAGE(PG8_SB(0, 1), cB + hstepB, voffB); PG8_STAGE(PG8_SA(0, 0), cA, voffA); PG8_STAGE(PG8_SA(0, 1), cA + hstepA, voffA);
        if (wr == 1) PG8_BAR;
        PG8_WAIT_V(2); PG8_BAR;
        PG8_STAGE(PG8_SB(1, 0), cB + kstep, voffB); PG8_STAGE(PG8_SA(1, 0), cA + kstep, voffA); PG8_STAGE(PG8_SB(1, 1), cB + hstepB + kstep, voffB);
        PG8_WAIT_V(6); PG8_BAR;
    } else {
        PG8_STAGE(PG8_SB(0, 0), cB, voffB); PG8_STAGE(PG8_SA(0, 0), cA, voffA); PG8_STAGE(PG8_SB(0, 1), cB + hstepB, voffB); PG8_STAGE(PG8_SA(0, 1), cA + hstepA, voffA);
        if (wr == 1) PG8_BAR;
        PG8_WAIT_V(4); PG8_BAR;
        PG8_STAGE(PG8_SB(1, 0), cB + kstep, voffB); PG8_STAGE(PG8_SA(1, 0), cA + kstep, voffA); PG8_STAGE(PG8_SB(1, 1), cB + hstepB + kstep, voffB);
        PG8_WAIT_V(6); PG8_BAR;
    }
    for (;;) {
        const bool has_next = S.next(ui + 1, nxt);
        const char* nA = has_next ? (const char*)g.A + (size_t)nxt.pm * tstepA + (size_t)nxt.ks * ksplit : cA; const char* nB = has_next ? (const char*)g.Bt + (size_t)nxt.pn * tstepB + (size_t)nxt.ks * ksplit : cB;
#pragma nounroll
        for (int t = 0; t < nt; t += 2) {
            const bool last = (t == nt - 2);
            const char* a1 = cA + (size_t)(t + 1) * kstep;
            const char* a2 = last ? nA : cA + (size_t)(t + 2) * kstep; const char* b2 = last ? nB : cB + (size_t)(t + 2) * kstep;
            const char* a3 = a2 + kstep; const char* b3 = b2 + kstep;
            if constexpr (SP2) {
            PG8_LDB(B0, 0, 0); PG8_LDB(B1, 0, 1); PG8_SCHED; PG8_LDA(At, 0, 0); PG8_STAGE(PG8_SA(1, 1), a1 + hstepA, voffA);
            PG8_WAIT_V(8); PG8_WAIT_L(0); PG8_BAR; PG8_MMA(0, 0, At, B0); PG8_MMA(0, 1, At, B1); PG8_BAR; PG8_SCHED;
            PG8_LDA(At, 0, 1); PG8_STAGE(PG8_SB(0, 0), b2, voffB); PG8_STAGE(PG8_SB(0, 1), b2 + hstepB, voffB); PG8_STAGE(PG8_SA(0, 0), a2, voffA);
            PG8_WAIT_V(8); PG8_WAIT_L(0); PG8_BAR; PG8_MMA(1, 0, At, B0); PG8_MMA(1, 1, At, B1); PG8_BAR; PG8_SCHED;
            PG8_LDB(B0, 1, 0); PG8_LDB(B1, 1, 1); PG8_SCHED; PG8_LDA(At, 1, 0); PG8_STAGE(PG8_SA(0, 1), a2 + hstepA, voffA);
            PG8_WAIT_V(8); PG8_WAIT_L(0); PG8_BAR; PG8_MMA(0, 0, At, B0); PG8_MMA(0, 1, At, B1); PG8_BAR; PG8_SCHED;
            PG8_LDA(At, 1, 1); PG8_STAGE(PG8_SB(1, 0), b3, voffB); PG8_STAGE(PG8_SB(1, 1), b3 + hstepB, voffB); PG8_STAGE(PG8_SA(1, 0), a3, voffA);
            PG8_WAIT_V(8); PG8_WAIT_L(0); PG8_BAR; PG8_MMA(1, 0, At, B0); PG8_MMA(1, 1, At, B1); PG8_BAR; PG8_SCHED;
            } else {
            PG8_LDB(B0, 0, 0); PG8_SCHED; PG8_LDA(At, 0, 0); PG8_STAGE(PG8_SA(1, 1), a1 + hstepA, voffA);
            PG8_WAIT_L(8); PG8_BAR; PG8_WAIT_L(0); PG8_MMA(0, 0, At, B0); PG8_BAR; PG8_SCHED;
            PG8_LDB(B1, 0, 1); PG8_STAGE(PG8_SB(0, 0), b2, voffB);
            PG8_BAR; PG8_WAIT_L(0); PG8_MMA(0, 1, At, B1); PG8_BAR;
            PG8_LDA(At, 0, 1); PG8_STAGE(PG8_SA(0, 0), a2, voffA);
            PG8_BAR; PG8_WAIT_L(0); PG8_MMA(1, 0, At, B0); PG8_BAR; PG8_SCHED;
            PG8_STAGE(PG8_SB(0, 1), b2 + hstepB, voffB);
            PG8_WAIT_V(6); PG8_BAR; PG8_MMA(1, 1, At, B1); PG8_BAR;
            PG8_LDB(B0, 1, 0); PG8_SCHED; PG8_LDA(At, 1, 0); PG8_STAGE(PG8_SA(0, 1), a2 + hstepA, voffA);
            PG8_WAIT_L(8); PG8_BAR; PG8_WAIT_L(0); PG8_MMA(0, 0, At, B0); PG8_BAR; PG8_SCHED;
            PG8_LDB(B1, 1, 1); PG8_STAGE(PG8_SB(1, 0), b3, voffB);
            PG8_BAR; PG8_WAIT_L(0); PG8_MMA(0, 1, At, B1); PG8_BAR;
            PG8_LDA(At, 1, 1); PG8_STAGE(PG8_SA(1, 0), a3, voffA);
            PG8_BAR; PG8_WAIT_L(0); PG8_MMA(1, 0, At, B0); PG8_BAR; PG8_SCHED;
            PG8_STAGE(PG8_SB(1, 1), b3 + hstepB, voffB);
            PG8_WAIT_V(6); PG8_BAR; PG8_MMA(1, 1, At, B1); PG8_BAR;
            }
        }
        if constexpr (ALIGN_EPI) { if (wr == 0) PG8_BAR; }
        E(acc, cur, wr, wc, fr, fq);
        if (!has_next) break;
#pragma unroll
        for (int a = 0; a < 2; ++a)
#pragma unroll
            for (int b = 0; b < 2; ++b)
#pragma unroll
                for (int m = 0; m < 4; ++m)
#pragma unroll
                    for (int n = 0; n < 2; ++n) acc[a][b][m][n] = (f32x4){0.f, 0.f, 0.f, 0.f};
        cur = nxt; cA = nA; cB = nB; ++ui;
        if constexpr (ALIGN_EPI) { if (wr == 1) PG8_BAR; }
    }
    PG8_WAIT_V(0);
    if constexpr (!ALIGN_EPI) { if (wr == 0) PG8_BAR; }
    PG8_BAR;
#undef PG8_SA
#undef PG8_SB
#undef PG8_STAGE
#undef PG8_LDA
#undef PG8_LDB
#undef PG8_MMA
#undef PG8_WAIT_V
#undef PG8_WAIT_L
#undef PG8_BAR
#undef PG8_SCHED
}

__device__ __forceinline__ float rss_q(const float* rss, int row) { float s = 0.f;
#pragma unroll
    for (int p = 0; p < 12; ++p) s += rss[(size_t)p * MTOK + row]; return s; }
__device__ __forceinline__ float rss_kv(const float* rss, int row) { float s = 0.f;
#pragma unroll
    for (int p = 12; p < 20; ++p) s += rss[(size_t)p * MTOK + row]; return s; }
#define EPI_ROWS_BEGIN _Pragma("unroll") for (int ai = 0; ai < 2; ++ai) _Pragma("unroll") for (int m = 0; m < 4; ++m) { const int row = u.pm * BM + wr * 64 + fr + ai * HALF + m * 16;
#define EPI_ROWS_END asm volatile("" ::: "memory"); }

struct EpiZ {
    static constexpr bool PERM = true;
    bf16_t* Z; float* rssq; float* rsskv; int pn_off;
    __device__ __forceinline__ void operator()(const f32x4 (&acc)[2][2][4][2], const Unit& u, int wr, int wc, int fr_, int fq_) const {
        int lane_e = (int)threadIdx.x & 63; asm volatile("" : "+v"(lane_e)); const int fr = lane_e & 15, fq = lane_e >> 4;
        const int col0 = (u.pn + pn_off) * BM + wc * 32 + 8 * fq;
        EPI_ROWS_BEGIN
            bf16_t* rowp = Z + (size_t)row * ZP + col0;
#pragma unroll
            for (int bj = 0; bj < 2; ++bj) { const f32x4 v0 = acc[ai][bj][m][0], v1 = acc[ai][bj][m][1];
                u32x4 w; w.x = cvt_pk_bf16(v0[0], v0[1]); w.y = cvt_pk_bf16(v0[2], v0[3]); w.z = cvt_pk_bf16(v1[0], v1[1]); w.w = cvt_pk_bf16(v1[2], v1[3]);
                *(u32x4*)(rowp + bj * HALF) = w;
                const int hc = 2 * (u.pn + pn_off) + bj;
                if (hc < 5) { float s = (v0[0] * v0[0] + v0[1] * v0[1]) + (v0[2] * v0[2] + v0[3] * v0[3]) + (v1[0] * v1[0] + v1[1] * v1[1]) + (v1[2] * v1[2] + v1[3] * v1[3]);
                    s += __shfl_xor(s, 16); s += __shfl_xor(s, 32);
                    if (fq == 0) rssq[(size_t)(hc * 4 + wc) * MTOK + row] = s; } }
        EPI_ROWS_END
    }
};

struct EpiQ {
    static constexpr bool PERM = true;
    bf16_t* Q; const float* rssq;
    __device__ __forceinline__ void operator()(const f32x4 (&acc)[2][2][4][2], const Unit& u, int wr, int wc, int fr_, int fq_) const {
        int lane_e = (int)threadIdx.x & 63; asm volatile("" : "+v"(lane_e)); const int fr = lane_e & 15, fq = lane_e >> 4;
        const int col0 = u.pn * BM + wc * 32 + 8 * fq;
        const float inv[8] = {1.f, 0.316227766f, 0.1f, 0.0316227766f, 0.01f, 0.00316227766f, 0.001f, 0.000316227766f};
        EPI_ROWS_BEGIN
            const float rs = rsqrtf(rss_q(rssq, row) * (1.f / 384.f) + EPS) * QSCALE;
            const int t = (row - MP) & 2047;
#pragma unroll
            for (int bj = 0; bj < 2; ++bj) { const int c = col0 + bj * HALF; const int j0 = c % 96;
                const bool rp = (row >= MP && j0 >= 64);
                const float pos = (float)((j0 < 80) ? (t >> 6) : (t & 63)) * 0.15915494309189535f;
                const float sg = (j0 & 8) ? 1.f : -1.f;
#pragma unroll
                for (int n = 0; n < 2; ++n) {
                    f32x4 v = acc[ai][bj][m][n] * rs;
#pragma unroll
                    for (int i = 0; i < 4; ++i) { const float p = __shfl_xor(v[i], 16);
                        const float rev = pos * inv[4 * n + i]; const float rf = rev - floorf(rev);
                        const float cs = __builtin_amdgcn_cosf(rf), sn = __builtin_amdgcn_sinf(rf); v[i] = rp ? v[i] * cs + sg * p * sn : v[i]; }
                    u32x2 w; w.x = cvt_pk_bf16(v[0], v[1]); w.y = cvt_pk_bf16(v[2], v[3]);
                    *(u32x2*)(Q + (size_t)row * 768 + c + 4 * n) = w; } }
        EPI_ROWS_END
    }
};

struct EpiK {
    static constexpr bool PERM = true;
    bf16_t* Kp; bf16_t* Ks; const float* rsskv; int ctx;
    __device__ __forceinline__ void operator()(const f32x4 (&acc)[2][2][4][2], const Unit& u, int wr, int wc, int fr_, int fq_) const {
        int lane_e = (int)threadIdx.x & 63; asm volatile("" : "+v"(lane_e)); const int fr = lane_e & 15, fq = lane_e >> 4;
        EPI_ROWS_BEGIN
            float rs = 1.f; unsigned off; bool smp;
            if (ctx) { off = ((unsigned)(row >> 8) * 8u * SKS + (row & 255)) * 96u; smp = true; }
            else { rs = rsqrtf(rss_kv(rsskv, row) * (1.f / 256.f) + EPS);
                if (row < MP) { off = ((unsigned)(row >> 8) * 8u * 256u + (row & 255)) * 96u; smp = false; } else { off = ((unsigned)((row - MP) >> 11) * 8u * SKS + 256u + ((row - MP) & 2047)) * 96u; smp = true; } }
            bf16_t* base = smp ? Ks : Kp; const unsigned hs = (smp ? SKS : 256) * 96u;
#pragma unroll
            for (int bj = 0; bj < 2; ++bj) { const unsigned h = 4 * u.pn + 2 * bj + (wc >> 1); const unsigned j = (wc & 1) * 32 + 8 * fq;
                const f32x4 v0 = acc[ai][bj][m][0] * rs, v1 = acc[ai][bj][m][1] * rs;
                u32x4 w; w.x = cvt_pk_bf16(v0[0], v0[1]); w.y = cvt_pk_bf16(v0[2], v0[3]); w.z = cvt_pk_bf16(v1[0], v1[1]); w.w = cvt_pk_bf16(v1[2], v1[3]);
                *(u32x4*)(base + (off + h * hs + j)) = w; }
        EPI_ROWS_END
    }
};

struct EpiVt {
    static constexpr bool PERM = true;
    bf16_t* Vtp; bf16_t* Vts; const float* rsskv; int ctx;
    __device__ __forceinline__ void operator()(const f32x4 (&acc)[2][2][4][2], const Unit& u, int wr, int wc, int fr_, int fq_) const {
        int lane_e = (int)threadIdx.x & 63; asm volatile("" : "+v"(lane_e)); const int fr = lane_e & 15, fq = lane_e >> 4;
#pragma unroll
        for (int bj = 0; bj < 2; ++bj) {
            const int tok = u.pn * BM + bj * HALF + wc * 32 + 8 * fq;
            f32x4 r0 = {1.f, 1.f, 1.f, 1.f}, r1 = {1.f, 1.f, 1.f, 1.f}; unsigned off; bool smp; unsigned S;
            if (ctx) { off = (unsigned)(tok >> 8) * 8u * 64u * SKS + (tok & 255); smp = true; S = SKS; }
            else { f32x4 q0 = {0.f, 0.f, 0.f, 0.f}, q1 = {0.f, 0.f, 0.f, 0.f};
#pragma unroll
                for (int p = 12; p < 20; ++p) { q0 += *(const f32x4*)(rsskv + (size_t)p * MTOK + tok); q1 += *(const f32x4*)(rsskv + (size_t)p * MTOK + tok + 4); }
#pragma unroll
                for (int i = 0; i < 4; ++i) { r0[i] = rsqrtf(q0[i] * (1.f / 256.f) + EPS); r1[i] = rsqrtf(q1[i] * (1.f / 256.f) + EPS); }
                if (tok < MP) { off = (unsigned)(tok >> 8) * 8u * 64u * 256u + (tok & 255); smp = false; S = 256; } else { off = (unsigned)((tok - MP) >> 11) * 8u * 64u * SKS + 256u + ((tok - MP) & 2047); smp = true; S = SKS; } }
            bf16_t* base = smp ? Vts : Vtp;
#pragma unroll
            for (int ai = 0; ai < 2; ++ai)
#pragma unroll
                for (int m = 0; m < 4; ++m) { const unsigned hd = u.pm * BM + wr * 64 + fr + ai * HALF + m * 16;
                    const f32x4 v0 = acc[ai][bj][m][0] * r0, v1 = acc[ai][bj][m][1] * r1;
                    u32x4 w; w.x = cvt_pk_bf16(v0[0], v0[1]); w.y = cvt_pk_bf16(v0[2], v0[3]); w.z = cvt_pk_bf16(v1[0], v1[1]); w.w = cvt_pk_bf16(v1[2], v1[3]);
                    *(u32x4*)(base + (off + hd * S)) = w; }
            asm volatile("" ::: "memory");
        }
    }
};

struct EpiPart {
    static constexpr bool PERM = true;
    bf16_t* P0; bf16_t* P1;
    __device__ __forceinline__ void operator()(const f32x4 (&acc)[2][2][4][2], const Unit& u, int wr, int wc, int fr_, int fq_) const {
        int lane_e = (int)threadIdx.x & 63; asm volatile("" : "+v"(lane_e)); const int fr = lane_e & 15, fq = lane_e >> 4;
        const int col0 = u.pn * BM + wc * 32 + 8 * fq; bf16_t* P = u.ks ? P1 : P0;
        EPI_ROWS_BEGIN
            bf16_t* rowp = P + (size_t)row * D + col0;
#pragma unroll
            for (int bj = 0; bj < 2; ++bj) { const f32x4 v0 = acc[ai][bj][m][0], v1 = acc[ai][bj][m][1];
                u32x4 w; w.x = cvt_pk_bf16(v0[0], v0[1]); w.y = cvt_pk_bf16(v0[2], v0[3]); w.z = cvt_pk_bf16(v1[0], v1[1]); w.w = cvt_pk_bf16(v1[2], v1[3]);
                *(u32x4*)(rowp + bj * HALF) = w; }
        EPI_ROWS_END
    }
};

struct EpiFFI {
    static constexpr bool PERM = true;
    bf16_t* H;
    __device__ __forceinline__ void operator()(const f32x4 (&acc)[2][2][4][2], const Unit& u, int wr, int wc, int fr_, int fq_) const {
        int lane_e = (int)threadIdx.x & 63; asm volatile("" : "+v"(lane_e)); const int fr = lane_e & 15, fq = lane_e >> 4;
        const int col0 = u.pn * HALF + wc * 32 + 8 * fq;
        EPI_ROWS_BEGIN
            float o[8];
#pragma unroll
            for (int i = 0; i < 4; ++i) { o[i] = silu_f(acc[ai][0][m][0][i]) * acc[ai][1][m][0][i]; o[4 + i] = silu_f(acc[ai][0][m][1][i]) * acc[ai][1][m][1][i]; }
            u32x4 w; w.x = cvt_pk_bf16(o[0], o[1]); w.y = cvt_pk_bf16(o[2], o[3]); w.z = cvt_pk_bf16(o[4], o[5]); w.w = cvt_pk_bf16(o[6], o[7]);
            *(u32x4*)(H + (size_t)row * DFF + col0) = w;
        EPI_ROWS_END
    }
};
}

struct Args { const float* in[26]; float* out; unsigned char* ws; int ph_lo, ph_hi; };
enum { I_XP = 0, I_XS, I_CKV, I_CKR, I_SF, I_SB, I_C, I_CCTX, I_WADA, I_BADA, I_NATT, I_WIN, I_QN, I_WUQ, I_KVN, I_WUKV, I_WGF, I_BGF, I_WGB, I_BGB, I_GLAN, I_WOUT, I_NFFN, I_WFFI, I_WFFO, I_FN };

__device__ __forceinline__ const float* xrow_ptr(const Args& a, int r) { return r < MP ? a.in[I_XP] + (size_t)r * D : a.in[I_XS] + (size_t)(r - MP) * D; }
__device__ __forceinline__ int cond_of_row(int r) { return r < MP ? 0 : 1 + ((r - MP) >> 11); }

__device__ __forceinline__ void p0_tr(const float* W, int K, int N, bf16_t* WT, bf16_t* WT2, const float* kscale, int kb, int nb, int drow, LAS float* scr, int lane) {
    const int k0 = 64 * kb, n0 = 32 * nb;
#pragma unroll 8
    for (int i = 0; i < 32; ++i) { const int kk = 2 * i + (lane >> 5); scr[kk * 33 + (lane & 31)] = W[(size_t)(k0 + kk) * N + n0 + (lane & 31)]; }
    LDS_WAIT();
    const int c = lane & 7;
    float sc[8];
#pragma unroll
    for (int i = 0; i < 8; ++i) sc[i] = kscale ? kscale[k0 + 8 * c + i] : 1.f;
#pragma unroll
    for (int j = 0; j < 4; ++j) { const int n = (lane >> 3) + 8 * j; const LAS float* s = scr + (8 * c) * 33 + n;
        float v[8];
#pragma unroll
        for (int i = 0; i < 8; ++i) v[i] = s[i * 33];
        if (WT2) { u32x4 o; o.x = cvt_pk_bf16(v[0], v[1]); o.y = cvt_pk_bf16(v[2], v[3]); o.z = cvt_pk_bf16(v[4], v[5]); o.w = cvt_pk_bf16(v[6], v[7]);
            *(u32x4*)(WT2 + (size_t)(drow + n0 + n) * K + k0 + 8 * c) = o; }
        u32x4 o; o.x = cvt_pk_bf16(v[0] * sc[0], v[1] * sc[1]); o.y = cvt_pk_bf16(v[2] * sc[2], v[3] * sc[3]); o.z = cvt_pk_bf16(v[4] * sc[4], v[5] * sc[5]); o.w = cvt_pk_bf16(v[6] * sc[6], v[7] * sc[7]);
        *(u32x4*)(WT + (size_t)(drow + n0 + n) * K + k0 + 8 * c) = o; }
    LDS_WAIT();
}

__device__ __forceinline__ void phase0(const Args& a, int wv, LAS unsigned char* lds, int vcu, int G) {
    const int tid = otid(wv), lane = tid & 63, wave = __builtin_amdgcn_readfirstlane(tid >> 6);
    unsigned char* ws = a.ws;
#ifndef P0MASK
#define P0MASK 7
#endif
    if (P0MASK & 2) {
        LAS float* scr = (LAS float*)(lds + wave * 16384);
        LAS float* scnd = (LAS float*)(lds + 131072);
        for (int i = tid; i < 3072; i += 512) { const int ci = i >> 10, k = i & 1023; scnd[i] = silu_f(ci == 0 ? a.in[I_CCTX][k] : a.in[I_C][(ci - 1) * D + k]); }
        __syncthreads();
        const int gw = vcu * 8 + wave, NGW = G * 8;
        constexpr int T_IN = 16 * 70, T_UQ = 6 * 24, T_UKV = 4 * 32, T_OUT = 16 * 32, T_FFI = 16 * 176, T_FFO = 44 * 32, T_ZERO = 64, T_ADA = 768;
        constexpr int NIT = T_ADA + T_IN + T_UQ + T_UKV + T_OUT + T_FFI + T_FFO + T_ZERO;
        constexpr int NTR = NIT - T_ADA;
        const int nslot = wave < 3 ? 2 : 5;
        for (int sl = 0; sl < nslot; ++sl) {
            int r;
            if (wave < 3) { if (sl == 0) { r = wave * G + vcu; if (r >= T_ADA) continue; } else { const int t = vcu + G * wave; if (t >= NTR) continue; r = T_ADA + t; } }
            else { const int j = 3 + (wave - 3) + 5 * sl; const int t = vcu + G * j; if (t >= NTR) continue; r = T_ADA + t; }
            if (r < T_ADA) {
                const int nbq = r >> 2, kq = r & 3; const int n0 = 32 * nbq; const float* W = a.in[I_WADA];
                const int n = lane & 31, hf = lane >> 5; float s0 = 0.f, s1 = 0.f, s2 = 0.f;
                for (int kb = 4 * kq; kb < 4 * kq + 4; ++kb) { const int k0 = 64 * kb;
#pragma unroll 8
                    for (int i = 0; i < 32; ++i) { const int kk = 2 * i + (lane >> 5); scr[kk * 33 + (lane & 31)] = W[(size_t)(k0 + kk) * 6144 + n0 + (lane & 31)]; }
                    LDS_WAIT();
#pragma unroll 8
                    for (int j = 0; j < 32; ++j) { const int kk = hf * 32 + j; const float w = scr[kk * 33 + n];
                        s0 += w * scnd[k0 + kk]; s1 += w * scnd[1024 + k0 + kk]; s2 += w * scnd[2048 + k0 + kk]; }
                    LDS_WAIT(); }
                s0 += __shfl_xor(s0, 32); s1 += __shfl_xor(s1, 32); s2 += __shfl_xor(s2, 32);
                float* MOD = (float*)(ws + WS_MOD) + (size_t)kq * 18432;
                if (hf == 0) { MOD[n0 + n] = s0; MOD[6144 + n0 + n] = s1; MOD[12288 + n0 + n] = s2; }
                continue; } r -= T_ADA;
            if (r < T_FFI) { const int kb = r / 176, nb = r % 176; const int n0 = nb * 32; const int drow = n0 < DFF ? (n0 / 128) * 256 + (n0 % 128) : ((n0 - DFF) / 128) * 256 + 128 + ((n0 - DFF) % 128);
                p0_tr(a.in[I_WFFI], 1024, 5632, (bf16_t*)(ws + WS_WFFI), nullptr, nullptr, kb, nb, drow - n0, scr, lane); continue; } r -= T_FFI;
            if (r < T_FFO) { p0_tr(a.in[I_WFFO], DFF, 1024, (bf16_t*)(ws + WS_WFFO), nullptr, nullptr, r / 32, r % 32, 0, scr, lane); continue; } r -= T_FFO;
            if (r < T_IN) { p0_tr(a.in[I_WIN], 1024, 2240, (bf16_t*)(ws + WS_WIN), nullptr, nullptr, r / 70, r % 70, 0, scr, lane); continue; } r -= T_IN;
            if (r < T_OUT) { p0_tr(a.in[I_WOUT], 1024, 1024, (bf16_t*)(ws + WS_WOUT), nullptr, nullptr, r / 32, r % 32, 0, scr, lane); continue; } r -= T_OUT;
            if (r < T_UQ) { p0_tr(a.in[I_WUQ], 384, 768, (bf16_t*)(ws + WS_WUQ), nullptr, a.in[I_QN], r / 24, r % 24, 0, scr, lane); continue; } r -= T_UQ;
            if (r < T_UKV) { const int nb = r % 32, n0 = nb * 32, hh = n0 >> 7, j0 = n0 & 127; const bool isv = j0 >= 64; const int drow = hh * 64 + (j0 & 63);
                p0_tr(a.in[I_WUKV], 256, 1024, (bf16_t*)(ws + (isv ? WS_WVF : WS_WKF)), (bf16_t*)(ws + (isv ? WS_WVU : WS_WKU)), a.in[I_KVN], r / 32, nb, drow - n0, scr, lane); continue; } r -= T_UKV;
            { u32x4 z = {0u, 0u, 0u, 0u}; u32x4* p = (u32x4*)((bf16_t*)(ws + WS_WIN) + (size_t)(2240 + r) * 1024); p[lane] = z; p[64 + lane] = z; }
        }
    }
    if (P0MASK & 4) {
        const int gt = vcu * 512 + tid, NT = G * 512;
        for (int i = gt; i < 32768; i += NT) { const f32x4 v = ((const f32x4*)a.in[I_CKV])[i]; u32x2 w; w.x = cvt_pk_bf16(v[0], v[1]); w.y = cvt_pk_bf16(v[2], v[3]); ((u32x2*)(ws + WS_CACHEB))[i] = w; }
    }
}

__device__ __forceinline__ f32x4 mod4(const float* modp, const float* bias, int ci, int off) {
    const float* p = modp + ci * 6144 + off;
    return ((*(const f32x4*)p + *(const f32x4*)(p + 18432)) + (*(const f32x4*)(p + 36864) + *(const f32x4*)(p + 55296))) + *(const f32x4*)(bias + off);
}
__device__ __forceinline__ void phase1(const Args& a, int wv, int vcu, int G) {
    if (PROBE_FILL == 3) { float* m = (float*)(a.ws + WS_MOD); for (int i = otid(wv); i < 3 * 6144; i += 512) { unsigned h = (unsigned)i * 2654435761u; h ^= h >> 15; h *= 2246822519u; h ^= h >> 13; m[i] = ((float)(h & 0xffff) * (1.f / 65536.f) - 0.5f) * 2.f; } __syncthreads(); }
    const int tid_ = otid(wv); const int lane = tid_ & 63, wave = tid_ >> 6; const int gw = vcu * 8 + wave, NGW = G * 8;
    const float* mod = (const float*)(a.ws + WS_MOD + PROBE_MODOFF); bf16_t* H = (bf16_t*)(a.ws + WS_H);
    for (int r = gw; r < MTOK; r += NGW * PROBE_RSTRIDE) {
        const f32x4* xr = (const f32x4*)xrow_ptr(a, r) + lane; const int ci_ = cond_of_row(r);
        f32x4 v[4]; float s = 0.f;
#pragma unroll
        for (int j = 0; j < 4; ++j) { v[j] = xr[64 * j]; s += (v[j][0] * v[j][0] + v[j][1] * v[j][1]) + (v[j][2] * v[j][2] + v[j][3] * v[j][3]); }
        const float rstd = rsqrtf(wave_sum(s) * (1.f / D) + EPS);
        u32x2* o = (u32x2*)(H + (size_t)r * D) + lane;
#pragma unroll
        for (int j = 0; j < 4; ++j) { const int c = 4 * lane + 256 * j; const f32x4 w = *(const f32x4*)(a.in[I_NATT] + c), sh = mod4(mod, a.in[I_BADA], ci_, c), scv = mod4(mod, a.in[I_BADA], ci_, 1024 + c);
            const f32x4 y = v[j] * rstd * w * (scv * PROBE_MUL + 1.f) + sh * PROBE_MUL; u32x2 p; p.x = cvt_pk_bf16(y[0], y[1]); p.y = cvt_pk_bf16(y[2], y[3]); if (PROBE_NOSTORE) { if ((p.x ^ p.y) == 0x12345u) o[64 * j] = p; } else o[64 * j] = p; }
    }
}
__device__ __forceinline__ void phase6(const Args& a, int wv, int vcu, int G) {
    const int tid_ = otid(wv); const int lane = tid_ & 63, wave = tid_ >> 6; const int gw = vcu * 8 + wave, NGW = G * 8;
    const float* mod = (const float*)(a.ws + WS_MOD); bf16_t* H = (bf16_t*)(a.ws + WS_H); float* X1 = (float*)(a.ws + WS_X1);
    const bf16_t* P0 = (const bf16_t*)(a.ws + WS_P0); const bf16_t* P1 = (const bf16_t*)(a.ws + WS_P1A);
    for (int r = gw; r < MTOK; r += NGW) {
        const f32x4* xr = (const f32x4*)xrow_ptr(a, r) + lane; const int ci_ = cond_of_row(r);
        const u32x2* p0 = (const u32x2*)(P0 + (size_t)r * D) + lane; const u32x2* p1 = (const u32x2*)(P1 + (size_t)r * D) + lane;
        f32x4 v[4]; float s = 0.f;
#pragma unroll
        for (int j = 0; j < 4; ++j) { const int c = 4 * lane + 256 * j; const f32x4 gt = mod4(mod, a.in[I_BADA], ci_, 2048 + c);
            { const u32x2 qa = p0[64 * j], qb = p1[64 * j]; const f32x4 ps = {bflo(qa.x) + bflo(qb.x), bfhi(qa.x) + bfhi(qb.x), bflo(qa.y) + bflo(qb.y), bfhi(qa.y) + bfhi(qb.y)}; v[j] = xr[64 * j] + gt * ps; } s += (v[j][0] * v[j][0] + v[j][1] * v[j][1]) + (v[j][2] * v[j][2] + v[j][3] * v[j][3]); }
        const float rstd = rsqrtf(wave_sum(s) * (1.f / D) + EPS);
        u32x2* x1 = (u32x2*)((bf16_t*)X1 + (size_t)r * D) + lane; u32x2* o = (u32x2*)(H + (size_t)r * D) + lane;
#pragma unroll
        for (int j = 0; j < 4; ++j) { const int c = 4 * lane + 256 * j; { u32x2 xw; xw.x = cvt_pk_bf16(v[j][0], v[j][1]); xw.y = cvt_pk_bf16(v[j][2], v[j][3]); x1[64 * j] = xw; }
            const f32x4 w = *(const f32x4*)(a.in[I_NFFN] + c), sh = mod4(mod, a.in[I_BADA], ci_, 3072 + c), scv = mod4(mod, a.in[I_BADA], ci_, 4096 + c);
            const f32x4 y = v[j] * rstd * w * (scv + 1.f) + sh; u32x2 p; p.x = cvt_pk_bf16(y[0], y[1]); p.y = cvt_pk_bf16(y[2], y[3]); o[64 * j] = p; }
    }
}
__device__ __forceinline__ void phase9(const Args& a, int wv, int vcu, int G) {
    const int tid_ = otid(wv); const int lane = tid_ & 63, wave = tid_ >> 6; const int gw = vcu * 8 + wave, NGW = G * 8;
    const float* mod = (const float*)(a.ws + WS_MOD); const float* X1 = (const float*)(a.ws + WS_X1);
    const bf16_t* P0 = (const bf16_t*)(a.ws + WS_P0); const bf16_t* P1 = (const bf16_t*)(a.ws + WS_P1B);
    for (int r = gw; r < MTOK; r += NGW) {
        const u32x2* xr = (const u32x2*)((const bf16_t*)X1 + (size_t)r * D) + lane; const int ci_ = cond_of_row(r);
        const u32x2* p0 = (const u32x2*)(P0 + (size_t)r * D) + lane; const u32x2* p1 = (const u32x2*)(P1 + (size_t)r * D) + lane;
        f32x4 v[4]; float s = 0.f;
#pragma unroll
        for (int j = 0; j < 4; ++j) { const int c = 4 * lane + 256 * j; const f32x4 gt = mod4(mod, a.in[I_BADA], ci_, 5120 + c);
            { const u32x2 qa = p0[64 * j], qb = p1[64 * j]; const f32x4 ps = {bflo(qa.x) + bflo(qb.x), bfhi(qa.x) + bfhi(qb.x), bflo(qa.y) + bflo(qb.y), bfhi(qa.y) + bfhi(qb.y)}; const u32x2 xq = xr[64 * j]; const f32x4 xv = {bflo(xq.x), bfhi(xq.x), bflo(xq.y), bfhi(xq.y)}; v[j] = xv + gt * ps; } s += (v[j][0] * v[j][0] + v[j][1] * v[j][1]) + (v[j][2] * v[j][2] + v[j][3] * v[j][3]); }
        const float rstd = rsqrtf(wave_sum(s) * (1.f / D) + EPS);
        f32x4* y = (f32x4*)(a.out + O_Y + (size_t)r * D) + lane;
#pragma unroll
        for (int j = 0; j < 4; ++j) { const int c = 4 * lane + 256 * j; const f32x4 w = *(const f32x4*)(a.in[I_FN] + c); y[64 * j] = v[j] * rstd * w; }
    }
}

__device__ __forceinline__ void p3_row_extras(const Args& a, int wv, int gw, int NGW) {
    const int lane = otid(wv) & 63;
    const bf16_t* Z = (const bf16_t*)(a.ws + WS_Z); const float* rsskv = (const float*)(a.ws + WS_RSSKV);
    bf16_t* Kp = (bf16_t*)(a.ws + WS_KP); bf16_t* Ks = (bf16_t*)(a.ws + WS_KS);
    const float inv[8] = {1.f, 0.316227766f, 0.1f, 0.0316227766f, 0.01f, 0.00316227766f, 0.001f, 0.000316227766f};
    for (int r = gw; r < MTOK + 512; r += NGW) {
        if (r < MTOK) {
            const bf16_t* zr = Z + (size_t)r * ZP;
            if (r < MP) {
                const float rs = rsqrtf(pg8::rss_kv(rsskv, r) * (1.f / 256.f) + EPS);
                const u32x2 w = *(const u32x2*)(zr + C_KVLAT + 4 * lane); const f32x4 g = *(const f32x4*)(a.in[I_KVN] + 4 * lane);
                f32x4 o; o[0] = bflo(w.x) * rs * g[0]; o[1] = bfhi(w.x) * rs * g[1]; o[2] = bflo(w.y) * rs * g[2]; o[3] = bfhi(w.y) * rs * g[3];
                *(f32x4*)(a.out + O_KV + (size_t)r * 256 + 4 * lane) = o;
            }
            const int i = lane & 31;
            float v = bf2f(zr[C_KROPE + i]);
            if (r < MP && lane < 32) a.out[O_KR + (size_t)r * 32 + i] = v;
            const float pv = __shfl_xor(v, 8);
            int b, s; bf16_t* kb;
            if (r >= MP) { const int t = (r - MP) & 2047; const float pos = (float)((i < 16) ? (t >> 6) : (t & 63));
                const float rev = pos * inv[i & 7] * 0.15915494309189535f; const float rf = rev - floorf(rev);
                const float cs = __builtin_amdgcn_cosf(rf), sn = __builtin_amdgcn_sinf(rf); v = v * cs + ((i & 8) ? pv : -pv) * sn;
                b = (r - MP) >> 11; s = 256 + t; kb = Ks + ((size_t)(b * 8) * SKS + s) * 96 + 64 + i;
                const bf16_t o = f2bf(v);
                if (lane < 32) { for (int h = 0; h < 8; ++h) kb[(size_t)h * SKS * 96] = o; }
            } else { b = r >> 8; s = r & 255; kb = Kp + ((size_t)(b * 8) * 256 + s) * 96 + 64 + i; const bf16_t o = f2bf(v);
                if (lane < 32) { for (int h = 0; h < 8; ++h) kb[(size_t)h * 256 * 96] = o; } }
        } else {
            const int rr = r - MTOK, b = rr >> 8, s = rr & 255, i = lane & 31;
            const bf16_t o = f2bf(a.in[I_CKR][(size_t)rr * 32 + i]); bf16_t* kb = Ks + ((size_t)(b * 8) * SKS + s) * 96 + 64 + i;
            if (lane < 32) { for (int h = 0; h < 8; ++h) kb[(size_t)h * SKS * 96] = o; }
        }
    }
}

constexpr int GL_LOW = 0, GL_WG = 8192, GL_BG = 16384, GL_SEG = 16896, GL_RED = 20992, GL_VT = 22528, GL_QF = 40960, GL_KF = GL_QF + 9216, GL_QB = GL_KF + 9216, GL_KB = GL_QB + 9216;
constexpr int GROW = 144;

__device__ __forceinline__ void gla_gates(const Args& a, int wv, LAS unsigned char* lds, int r0, int h, float (&cumF)[8], float (&cumB)[8], float& totF, float& totB) {
    const int tid = otid(wv), d = tid & 63, tg = tid >> 6;
    const bf16_t* Z = (const bf16_t*)(a.ws + WS_Z);
    LAS float* low = (LAS float*)(lds + GL_LOW); LAS float* wg = (LAS float*)(lds + GL_WG); LAS float* bg = (LAS float*)(lds + GL_BG); LAS float* seg = (LAS float*)(lds + GL_SEG);
    { const int t = tid >> 3, r4 = (tid & 7) * 4; const u32x2 w = *(const u32x2*)(Z + (size_t)(r0 + t) * ZP + C_GFL + r4);
      low[t * 32 + r4] = bflo(w.x); low[t * 32 + r4 + 1] = bfhi(w.x); low[t * 32 + r4 + 2] = bflo(w.y); low[t * 32 + r4 + 3] = bfhi(w.y); }
    { const int dir = tid >> 8, r = (tid >> 4) & 15, d4 = (tid & 15) * 4; const f32x4 w = *(const f32x4*)(a.in[dir ? I_WGB : I_WGF] + r * 256 + h * 64 + d4);
      *(LAS f32x4*)(wg + (dir * 16 + r) * 64 + d4) = w; }
    if (tid < 128) { const int dir = tid >> 6; bg[tid] = a.in[dir ? I_BGB : I_BGF][h * 64 + (tid & 63)]; }
    __syncthreads();
    float wf[16], wb[16];
#pragma unroll
    for (int r = 0; r < 16; ++r) { wf[r] = wg[r * 64 + d]; wb[r] = wg[(16 + r) * 64 + d]; }
    const float bf_ = bg[d], bb_ = bg[64 + d];
    float gf[8], gb[8];
#pragma unroll
    for (int i = 0; i < 8; ++i) { const int t = tg * 8 + i; float xf = bf_, xb = bb_;
#pragma unroll
        for (int r = 0; r < 16; ++r) { xf += low[t * 32 + r] * wf[r]; xb += low[t * 32 + 16 + r] * wb[r]; }
        gf[i] = logsigmoid_f(xf) * (1.f / 16.f); gb[i] = logsigmoid_f(xb) * (1.f / 16.f); }
#pragma unroll
    for (int i = 1; i < 8; ++i) gf[i] += gf[i - 1];
#pragma unroll
    for (int i = 6; i >= 0; --i) gb[i] += gb[i + 1];
    seg[tg * 64 + d] = gf[7]; seg[512 + tg * 64 + d] = gb[0];
    __syncthreads();
    float offF = 0.f, offB = 0.f; totF = 0.f; totB = 0.f;
#pragma unroll
    for (int g = 0; g < 8; ++g) { const float sf = seg[g * 64 + d], sb = seg[512 + g * 64 + d]; totF += sf; totB += sb; if (g < tg) offF += sf; if (g > tg) offB += sb; }
#pragma unroll
    for (int i = 0; i < 8; ++i) { cumF[i] = gf[i] + offF; cumB[i] = gb[i] + offB; }
}
__device__ __forceinline__ void gla_load_vT(const Args& a, int wv, LAS unsigned char* lds, int r0, int h) {
    const int tid = otid(wv), e = tid & 127, tq = tid >> 7;
    const bf16_t* Z = (const bf16_t*)(a.ws + WS_Z) + (size_t)r0 * ZP + C_GV + h * 128 + e;
    unsigned w[8];
#pragma unroll
    for (int i = 0; i < 8; ++i) { const unsigned lo = Z[(size_t)(tq * 16 + 2 * i) * ZP], hi = Z[(size_t)(tq * 16 + 2 * i + 1) * ZP]; w[i] = lo | (hi << 16); }
    LAS u32x4* p = (LAS u32x4*)(lds + GL_VT + e * GROW + tq * 32);
    p[0] = (u32x4){w[0], w[1], w[2], w[3]}; p[1] = (u32x4){w[4], w[5], w[6], w[7]};
}

__device__ __forceinline__ void gla_stepA(const Args& a, int wv, LAS unsigned char* lds, int u) {
    const int tid = otid(wv), lane = tid & 63, wave = __builtin_amdgcn_readfirstlane(tid >> 6), d = tid & 63, tg = tid >> 6, fr = lane & 15, fq = lane >> 4;
    const int cgi = u >> 2, h = u & 3, r0 = cgi * 64;
    const bf16_t* Z = (const bf16_t*)(a.ws + WS_Z);
    float cumF[8], cumB[8], totF, totB;
    gla_gates(a, wv, lds, r0, h, cumF, cumB, totF, totB);
    unsigned kf[4], kb[4];
#pragma unroll
    for (int i = 0; i < 4; ++i) { const float k0 = bf2f(Z[(size_t)(r0 + tg * 8 + 2 * i) * ZP + C_GK + h * 64 + d]), k1 = bf2f(Z[(size_t)(r0 + tg * 8 + 2 * i + 1) * ZP + C_GK + h * 64 + d]);
        kf[i] = cvt_pk_bf16(k0 * __expf(totF - cumF[2 * i]), k1 * __expf(totF - cumF[2 * i + 1]));
        kb[i] = cvt_pk_bf16(k0 * __expf(totB - cumB[2 * i]), k1 * __expf(totB - cumB[2 * i + 1])); }
    *(LAS u32x4*)(lds + GL_QF + d * GROW + tg * 16) = (u32x4){kf[0], kf[1], kf[2], kf[3]};
    *(LAS u32x4*)(lds + GL_KF + d * GROW + tg * 16) = (u32x4){kb[0], kb[1], kb[2], kb[3]};
    gla_load_vT(a, wv, lds, r0, h);
    if (tg == 0) { float* dec = (float*)(a.ws + WS_DEC) + (size_t)u * 128; dec[d] = __expf(totF); dec[64 + d] = __expf(totB); }
    __syncthreads();
    const int dir = wave >> 2, eb0 = 2 * (wave & 3);
    const LAS unsigned char* kd = lds + (dir ? GL_KF : GL_QF);
    float* CT = (float*)(a.ws + WS_CT) + ((size_t)u * 2 + dir) * 8192;
#pragma unroll
    for (int eb = 0; eb < 2; ++eb) {
        bf16x8 vf[2];
#pragma unroll
        for (int ks = 0; ks < 2; ++ks) vf[ks] = *(const LAS bf16x8*)(lds + GL_VT + (16 * (eb0 + eb) + fr) * GROW + (32 * ks + 8 * fq) * 2);
#pragma unroll
        for (int db = 0; db < 4; ++db) { f32x4 c = {0.f, 0.f, 0.f, 0.f};
#pragma unroll
            for (int ks = 0; ks < 2; ++ks) { const bf16x8 kfr = *(const LAS bf16x8*)(kd + (16 * db + fr) * GROW + (32 * ks + 8 * fq) * 2); c = __builtin_amdgcn_mfma_f32_16x16x32_bf16(vf[ks], kfr, c, 0, 0, 0); }
#pragma unroll
            for (int j = 0; j < 4; ++j) CT[(16 * (eb0 + eb) + 4 * fq + j) * 64 + 16 * db + fr] = c[j]; }
    }
    __syncthreads();
}

__device__ __forceinline__ void gla_scan(const Args& a, int wv, int vcu, int G) {
    const int gt = vcu * 512 + otid(wv), NT = G * 512;
    float* CTb = (float*)(a.ws + WS_CT); const float* DEC = (const float*)(a.ws + WS_DEC);
    for (int it = gt; it < 32768 + 262144; it += NT) {
        int seq, N, cg0, x;
        if (it < 32768) { seq = 16 + (it >> 14); x = it & 16383; N = 32; cg0 = 64 + 32 * (seq - 16); } else { const int j = it - 32768; seq = j >> 14; x = j & 16383; N = 4; cg0 = 4 * seq; }
        const int h = x >> 12, dir = (x >> 11) & 1, e = (x >> 4) & 127, d4 = (x & 15) * 4;
        f32x4 st = {0.f, 0.f, 0.f, 0.f};
        if (seq >= 16) { const float* s0 = a.in[dir ? I_SB : I_SF] + ((size_t)((seq - 16) * 4 + h) * 64) * 128 + e;
#pragma unroll
            for (int i = 0; i < 4; ++i) st[i] = s0[(size_t)(d4 + i) * 128]; }
        if (N == 32) {
            for (int n0 = 0; n0 < 32; n0 += 8) {
                f32x4 c[8], dc[8];
#pragma unroll
                for (int i = 0; i < 8; ++i) { const int n = dir ? (31 - n0 - i) : (n0 + i); const int u = (cg0 + n) * 4 + h;
                    c[i] = *(const f32x4*)(CTb + ((size_t)u * 2 + dir) * 8192 + e * 64 + d4); dc[i] = *(const f32x4*)(DEC + (size_t)u * 128 + dir * 64 + d4); }
#pragma unroll
                for (int i = 0; i < 8; ++i) { const int n = dir ? (31 - n0 - i) : (n0 + i); const int u = (cg0 + n) * 4 + h;
                    *(f32x4*)(CTb + ((size_t)u * 2 + dir) * 8192 + e * 64 + d4) = st; st = dc[i] * st + c[i]; }
            }
        } else {
            f32x4 c[4], dc[4];
#pragma unroll
            for (int i = 0; i < 4; ++i) { const int n = dir ? (3 - i) : i; const int u = (cg0 + n) * 4 + h;
                c[i] = *(const f32x4*)(CTb + ((size_t)u * 2 + dir) * 8192 + e * 64 + d4); dc[i] = *(const f32x4*)(DEC + (size_t)u * 128 + dir * 64 + d4); }
#pragma unroll
            for (int i = 0; i < 4; ++i) { const int n = dir ? (3 - i) : i; const int u = (cg0 + n) * 4 + h;
                *(f32x4*)(CTb + ((size_t)u * 2 + dir) * 8192 + e * 64 + d4) = st; st = dc[i] * st + c[i]; }
        }
        if (seq < 16) { float* o = a.out + (dir ? O_SB : O_SF) + ((size_t)(seq * 4 + h) * 64) * 128 + e;
#pragma unroll
            for (int i = 0; i < 4; ++i) o[(size_t)(d4 + i) * 128] = st[i]; }
    }
}

__device__ __forceinline__ void gla_stepC(const Args& a, int wv, LAS unsigned char* lds, int u) {
    const int tid = otid(wv), lane = tid & 63, wave = __builtin_amdgcn_readfirstlane(tid >> 6), d = tid & 63, tg = tid >> 6, fr = lane & 15, fq = lane >> 4;
    const int cgi = u >> 2, h = u & 3, r0 = cgi * 64;
    const bf16_t* Z = (const bf16_t*)(a.ws + WS_Z);
    float cumF[8], cumB[8], totF, totB;
    gla_gates(a, wv, lds, r0, h, cumF, cumB, totF, totB);
#pragma unroll
    for (int i = 0; i < 8; ++i) { const int t = tg * 8 + i; const float q = bf2f(Z[(size_t)(r0 + t) * ZP + C_GQ + h * 64 + d]) * 0.125f, k = bf2f(Z[(size_t)(r0 + t) * ZP + C_GK + h * 64 + d]);
        *(LAS bf16_t*)(lds + GL_QF + t * GROW + d * 2) = f2bf(q * __expf(cumF[i]));
        *(LAS bf16_t*)(lds + GL_KF + t * GROW + d * 2) = f2bf(k * __expf(-cumF[i]));
        *(LAS bf16_t*)(lds + GL_QB + t * GROW + d * 2) = f2bf(q * __expf(cumB[i]));
        *(LAS bf16_t*)(lds + GL_KB + t * GROW + d * 2) = f2bf(k * __expf(-cumB[i])); }
    gla_load_vT(a, wv, lds, r0, h);
    __syncthreads();
    const int ch = wave & 1, eq = wave >> 1;
    f32x4 oT[2][2];
#pragma unroll
    for (int i = 0; i < 2; ++i)
#pragma unroll
        for (int j = 0; j < 2; ++j) oT[i][j] = (f32x4){0.f, 0.f, 0.f, 0.f};
#pragma unroll
    for (int dir = 0; dir < 2; ++dir) {
        const LAS unsigned char* qe = lds + (dir ? GL_QB : GL_QF); const LAS unsigned char* ke = lds + (dir ? GL_KB : GL_KF);
        const float* ST = (const float*)(a.ws + WS_CT) + ((size_t)u * 2 + dir) * 8192;
        bf16x8 sf[2][2];
#pragma unroll
        for (int eb = 0; eb < 2; ++eb)
#pragma unroll
            for (int ks = 0; ks < 2; ++ks) { const float* p = ST + (16 * (2 * eq + eb) + fr) * 64 + 32 * ks + 8 * fq; const f32x4 x0 = *(const f32x4*)p, x1 = *(const f32x4*)(p + 4);
                u32x4 w; w.x = cvt_pk_bf16(x0[0], x0[1]); w.y = cvt_pk_bf16(x0[2], x0[3]); w.z = cvt_pk_bf16(x1[0], x1[1]); w.w = cvt_pk_bf16(x1[2], x1[3]); sf[eb][ks] = __builtin_bit_cast(bf16x8, w); }
#pragma unroll
        for (int cb = 0; cb < 2; ++cb) {
            const int cbg = 2 * ch + cb;
            bf16x8 qf[2];
#pragma unroll
            for (int ks = 0; ks < 2; ++ks) qf[ks] = *(const LAS bf16x8*)(qe + (16 * cbg + fr) * GROW + (32 * ks + 8 * fq) * 2);
            f32x4 att[4];
#pragma unroll
            for (int sb = 0; sb < 4; ++sb) {
                f32x4 acc = {0.f, 0.f, 0.f, 0.f};
                const bool need = dir == 0 ? (sb <= cbg) : (sb >= cbg);
                if (need) {
#pragma unroll
                    for (int ks = 0; ks < 2; ++ks) { const bf16x8 kfr = *(const LAS bf16x8*)(ke + (16 * sb + fr) * GROW + (32 * ks + 8 * fq) * 2); acc = __builtin_amdgcn_mfma_f32_16x16x32_bf16(kfr, qf[ks], acc, 0, 0, 0); }
                    if (sb == cbg) {
#pragma unroll
                        for (int j = 0; j < 4; ++j) { const int sl = 4 * fq + j; const bool keep = dir == 0 ? (sl <= fr) : (sl >= fr); acc[j] = keep ? acc[j] : 0.f; } }
                }
                att[sb] = acc;
            }
#pragma unroll
            for (int kp = 0; kp < 2; ++kp) {
                u32x4 w; w.x = cvt_pk_bf16(att[2 * kp][0], att[2 * kp][1]); w.y = cvt_pk_bf16(att[2 * kp][2], att[2 * kp][3]); w.z = cvt_pk_bf16(att[2 * kp + 1][0], att[2 * kp + 1][1]); w.w = cvt_pk_bf16(att[2 * kp + 1][2], att[2 * kp + 1][3]);
                const bf16x8 pb = __builtin_bit_cast(bf16x8, w);
#pragma unroll
                for (int eb = 0; eb < 2; ++eb) { const LAS unsigned char* vp = lds + GL_VT + (16 * (2 * eq + eb) + fr) * GROW + (32 * kp + 4 * fq) * 2;
                    const u32x2 v0 = *(const LAS u32x2*)vp, v1 = *(const LAS u32x2*)(vp + 32); const u32x4 vv = {v0.x, v0.y, v1.x, v1.y};
                    oT[eb][cb] = __builtin_amdgcn_mfma_f32_16x16x32_bf16(__builtin_bit_cast(bf16x8, vv), pb, oT[eb][cb], 0, 0, 0); }
            }
#pragma unroll
            for (int ks = 0; ks < 2; ++ks)
#pragma unroll
                for (int eb = 0; eb < 2; ++eb) oT[eb][cb] = __builtin_amdgcn_mfma_f32_16x16x32_bf16(sf[eb][ks], qf[ks], oT[eb][cb], 0, 0, 0);
        }
    }
    LAS float* red = (LAS float*)(lds + GL_RED);
#pragma unroll
    for (int cb = 0; cb < 2; ++cb) { float s = 0.f;
#pragma unroll
        for (int eb = 0; eb < 2; ++eb)
#pragma unroll
            for (int j = 0; j < 4; ++j) s += oT[eb][cb][j] * oT[eb][cb][j];
        s += __shfl_xor(s, 16); s += __shfl_xor(s, 32);
        if (fq == 0) red[eq * 64 + 16 * (2 * ch + cb) + fr] = s; }
    __syncthreads();
    bf16_t* MIX = (bf16_t*)(a.ws + WS_MIX);
#pragma unroll
    for (int cb = 0; cb < 2; ++cb) { const int c = 16 * (2 * ch + cb) + fr; const float tot = red[c] + red[64 + c] + red[128 + c] + red[192 + c]; const float rstd = rsqrtf(tot * (1.f / 128.f) + EPS);
#pragma unroll
        for (int eb = 0; eb < 2; ++eb) { const int e = 16 * (2 * eq + eb) + 4 * fq; const f32x4 gn = *(const f32x4*)(a.in[I_GLAN] + e);
            const u32x2 gw = *(const u32x2*)(Z + (size_t)(r0 + c) * ZP + C_GOUT + h * 128 + e);
            const float g0 = bflo(gw.x), g1 = bfhi(gw.x), g2 = bflo(gw.y), g3 = bfhi(gw.y);
            const f32x4 o = oT[eb][cb] * rstd * gn; u32x2 w; w.x = cvt_pk_bf16(o[0] * silu_f(g0), o[1] * silu_f(g1)); w.y = cvt_pk_bf16(o[2] * silu_f(g2), o[3] * silu_f(g3));
            *(u32x2*)(MIX + (size_t)(r0 + c) * D + 512 + h * 128 + e) = w; } }
    __syncthreads();
}

constexpr int AT_KROW = 208, AT_VROW = 144, AT_KB = 64 * AT_KROW  , AT_STAGE = AT_KB + 64 * AT_VROW  ;
__device__ __forceinline__ void attn_unit(const Args& a, int wv, LAS unsigned char* lds, int idx) {
    const int tid = otid(wv), lane = tid & 63, wave = __builtin_amdgcn_readfirstlane(tid >> 6), fr = lane & 15, fq = lane >> 4;
    int row0, S, nt; const bf16_t* Kb; const bf16_t* Vb; int h;
    if (idx < 256) { const int b = idx >> 7, qb = idx & 15; h = (idx >> 4) & 7; row0 = MP + b * 2048 + qb * 128; S = SKS; nt = 36;
        Kb = (const bf16_t*)(a.ws + WS_KS) + (size_t)(b * 8 + h) * SKS * 96; Vb = (const bf16_t*)(a.ws + WS_VTS) + (size_t)(b * 8 + h) * 64 * SKS; }
    else { const int j = idx - 256; const int b = j >> 4, qb = j & 1; h = (j >> 1) & 7; row0 = b * 256 + qb * 128; S = 256; nt = 4;
        Kb = (const bf16_t*)(a.ws + WS_KP) + (size_t)(b * 8 + h) * 256 * 96; Vb = (const bf16_t*)(a.ws + WS_VTP) + (size_t)(b * 8 + h) * 64 * 256; }
    const char* src[3]; unsigned step[3]; unsigned dst[3]; bool valid[3];
#pragma unroll
    for (int j = 0; j < 3; ++j) { const int ins = wave + 8 * j; valid[j] = ins < 22;
        if (ins < 13) { const int ck = ins * 64 + lane, r = ck / 13, cc = ck % 13; src[j] = (const char*)Kb + (size_t)r * 192 + (cc < 12 ? cc : 11) * 16; step[j] = 64 * 192; dst[j] = ins * 1024; }
        else { const int cv = (ins - 13) * 64 + lane, r = cv / 9, cc = cv % 9; src[j] = (const char*)Vb + (size_t)r * S * 2 + (cc < 8 ? cc : 7) * 16; step[j] = 128; dst[j] = AT_KB + (ins - 13) * 1024; } }
#define AT_ISSUE(t, buf) do { _Pragma("unroll") for (int j = 0; j < 3; ++j) if (valid[j]) \
        __builtin_amdgcn_global_load_lds((const unsigned*)(src[j] + (size_t)(t) * step[j]), (LAS unsigned*)(lds + (buf) * AT_STAGE + dst[j]), 16, 0, 0); } while (0)
    AT_ISSUE(0, 0);
    const bf16_t* Q = (const bf16_t*)(a.ws + WS_Q) + (size_t)(row0 + wave * 16 + fr) * 768 + h * 96 + 8 * fq;
    bf16x8 qf[3];
#pragma unroll
    for (int ks = 0; ks < 3; ++ks) qf[ks] = *(const bf16x8*)(Q + 32 * ks);
    float mrun = -1e30f, lsum = 0.f;
    f32x4 o[4];
#pragma unroll
    for (int i = 0; i < 4; ++i) o[i] = (f32x4){0.f, 0.f, 0.f, 0.f};
    for (int t = 0; t < nt; ++t) {
        VM_WAIT(); __syncthreads();
        if (t + 1 < nt) AT_ISSUE(t + 1, (t + 1) & 1);
        const LAS unsigned char* kt = lds + (t & 1) * AT_STAGE; const LAS unsigned char* vt = kt + AT_KB;
        f32x4 s[4];
#pragma unroll
        for (int kb = 0; kb < 4; ++kb) { s[kb] = (f32x4){0.f, 0.f, 0.f, 0.f};
#pragma unroll
            for (int ks = 0; ks < 3; ++ks) { const bf16x8 kf = *(const LAS bf16x8*)(kt + (16 * kb + fr) * AT_KROW + (32 * ks + 8 * fq) * 2); s[kb] = __builtin_amdgcn_mfma_f32_16x16x32_bf16(kf, qf[ks], s[kb], 0, 0, 0); } }
        float mx = fmaxf(fmaxf(fmaxf(s[0][0], s[0][1]), fmaxf(s[0][2], s[0][3])), fmaxf(fmaxf(s[1][0], s[1][1]), fmaxf(s[1][2], s[1][3])));
        mx = fmaxf(mx, fmaxf(fmaxf(fmaxf(s[2][0], s[2][1]), fmaxf(s[2][2], s[2][3])), fmaxf(fmaxf(s[3][0], s[3][1]), fmaxf(s[3][2], s[3][3]))));
        { const float m1 = __shfl_xor(mx, 16), m2 = __shfl_xor(mx, 32), m3 = __shfl_xor(mx, 48); mx = fmaxf(fmaxf(mx, m1), fmaxf(m2, m3)); }
        const float mnew = fmaxf(mrun, mx); const float alpha = __builtin_amdgcn_exp2f(mrun - mnew); mrun = mnew;
        float ps = 0.f;
#pragma unroll
        for (int kb = 0; kb < 4; ++kb)
#pragma unroll
            for (int j = 0; j < 4; ++j) { s[kb][j] = __builtin_amdgcn_exp2f(s[kb][j] - mnew); ps += s[kb][j]; }
        lsum = lsum * alpha + ps;
#pragma unroll
        for (int i = 0; i < 4; ++i) o[i] = o[i] * alpha;
#pragma unroll
        for (int kp = 0; kp < 2; ++kp) {
            u32x4 w; w.x = cvt_pk_bf16(s[2 * kp][0], s[2 * kp][1]); w.y = cvt_pk_bf16(s[2 * kp][2], s[2 * kp][3]); w.z = cvt_pk_bf16(s[2 * kp + 1][0], s[2 * kp + 1][1]); w.w = cvt_pk_bf16(s[2 * kp + 1][2], s[2 * kp + 1][3]);
            const bf16x8 pb = __builtin_bit_cast(bf16x8, w);
#pragma unroll
            for (int mb = 0; mb < 4; ++mb) { const LAS unsigned char* vp = vt + (16 * mb + fr) * AT_VROW + (32 * kp + 4 * fq) * 2;
                const u32x2 v0 = *(const LAS u32x2*)vp, v1 = *(const LAS u32x2*)(vp + 32); const u32x4 vv = {v0.x, v0.y, v1.x, v1.y};
                o[mb] = __builtin_amdgcn_mfma_f32_16x16x32_bf16(__builtin_bit_cast(bf16x8, vv), pb, o[mb], 0, 0, 0); }
        }
    }
    lsum += __shfl_xor(lsum, 16); lsum += __shfl_xor(lsum, 32);
    const float il = fast_rcp(lsum);
    bf16_t* MIX = (bf16_t*)(a.ws + WS_MIX) + (size_t)(row0 + wave * 16 + fr) * D + h * 64 + 4 * fq;
#pragma unroll
    for (int mb = 0; mb < 4; ++mb) { u32x2 w; w.x = cvt_pk_bf16(o[mb][0] * il, o[mb][1] * il); w.y = cvt_pk_bf16(o[mb][2] * il, o[mb][3] * il); *(u32x2*)(MIX + 16 * mb) = w; }
    __syncthreads();
#undef AT_ISSUE
}

__device__ unsigned g_bar[64 * 52];
#define GB(i) (g_bar + 64 * (i))
__device__ __forceinline__ unsigned gb_ld(unsigned* p) { return __hip_atomic_load(p, __ATOMIC_RELAXED, __HIP_MEMORY_SCOPE_AGENT); }
__device__ __forceinline__ unsigned gb_add(unsigned* p, unsigned v) { return __hip_atomic_fetch_add(p, v, __ATOMIC_RELAXED, __HIP_MEMORY_SCOPE_AGENT); }
__device__ __forceinline__ unsigned xcc_id() { return (unsigned)__builtin_amdgcn_s_getreg((3 << 11) | 20) & 0xFu; }
__device__ __forceinline__ void my_grid_barrier(unsigned nth, unsigned G, int tid, LAS unsigned* st) {
    asm volatile("s_waitcnt vmcnt(0) lgkmcnt(0)" ::: "memory");
    __syncthreads();
    if (tid == 0) {
        if (nth == 1u) {
            const unsigned x = xcc_id(); unsigned sum, cnt, mine;
            for (;;) { sum = 0u; cnt = 0u; mine = 0u;
#pragma unroll
                for (unsigned j = 0; j < 16; ++j) { const unsigned c = gb_ld(GB(4 + j)); sum += c; cnt += (c > 0u) ? 1u : 0u; mine = (j == x) ? c : mine; }
                if (sum >= G) break; __builtin_amdgcn_s_sleep(1); }
            st[0] = mine; st[1] = cnt; st[2] = x;
        }
        const unsigned nloc = st[0], nx = st[1], x = st[2];
        const unsigned old = gb_add(GB(20 + x), 1u);
        if (old + 1u == nth * nloc) {
            __builtin_amdgcn_fence(__ATOMIC_RELEASE, "agent");
            asm volatile("s_waitcnt vmcnt(0)" ::: "memory");
            const unsigned og = gb_add(GB(1), 1u);
            if (og + 1u == nth * nx) gb_add(GB(2), 1u);
            else while (gb_ld(GB(2)) < nth) __builtin_amdgcn_s_sleep(1);
            __builtin_amdgcn_fence(__ATOMIC_ACQUIRE, "agent");
            gb_add(GB(36 + x), 1u);
            asm volatile("s_waitcnt vmcnt(0)" ::: "memory");
        } else {
            while (gb_ld(GB(36 + x)) < nth) __builtin_amdgcn_s_sleep(1);
            __builtin_amdgcn_fence(__ATOMIC_ACQUIRE, "agent");
            asm volatile("s_waitcnt vmcnt(0)" ::: "memory");
        }
    }
    __syncthreads();
}
__device__ __forceinline__ void my_grid_barrier_finish(unsigned G, int tid) {
    if (tid == 0) {
        const unsigned old = gb_add(GB(0), 1u);
        if (old == G - 1u) { for (int i = 0; i < 52; ++i) __hip_atomic_store(GB(i), 0u, __ATOMIC_RELAXED, __HIP_MEMORY_SCOPE_AGENT); }
    }
}
constexpr int NPHASE = 11;
__global__ void __launch_bounds__(512, 2) mk_fwd(Args a) {
    const int wv = __builtin_amdgcn_readfirstlane((int)threadIdx.x >> 6);
    extern __shared__ __attribute__((aligned(16))) unsigned char lds_raw[];
    LAS unsigned char* lds = (LAS unsigned char*)lds_raw;
    const int G = gridDim.x, bx = blockIdx.x;
    const int vcu = (G % 8 == 0) ? (bx % 8) * (G / 8) + bx / 8 : bx;
    unsigned char* ws = a.ws;
    const int lo = a.ph_lo, hi = a.ph_hi;
#ifndef PHMASK
#define PHMASK 0x7ff
#endif
#define IN(k) (((PHMASK >> (k)) & 1) && lo <= (k) && (k) < hi)
#define SEAM(k) do { if (IN(k) && IN((k) + 1)) { ++nbar; my_grid_barrier(nbar, (unsigned)G, otid(wv), (LAS unsigned*)(lds + LDS_BYTES - 64)); } } while (0)
#ifndef PROBE_FILL
#define PROBE_FILL 0
#endif
    if (PROBE_FILL && lo == 0) { f32x4* p = (f32x4*)a.ws; const size_t n = (size_t)(PROBE_FILL_MIB) << 16; const float fv = PROBE_FILL_VAL;
        for (size_t i = (size_t)bx * 512 + threadIdx.x; i < n; i += (size_t)G * 512) { unsigned h = (unsigned)i * 2654435761u; h ^= h >> 15; h *= 2246822519u; h ^= h >> 13; const float r0 = (float)(h & 0xffff) * (1.f / 65536.f) - 0.5f + fv * 0.f; p[i] = (f32x4){r0, r0 * 1.7f, r0 * -0.3f, r0 + 0.1f}; } }
    if (PROBE_FILL == 2 && lo == 0 && bx == 0) { static const int szs[26] = {4194304, 4194304, 131072, 16384, 65536, 65536, 2048, 1024, 6291456, 6144, 1024, 2293760, 384, 294912, 256, 262144, 4096, 256, 4096, 256, 128, 1048576, 1024, 5767168, 2883584, 1024};
        float sm = 0.f; for (int i = 0; i < 26; ++i) { const int n = szs[i]; const int st = n > 1024 ? n - 1024 : 0; for (int j = st + (int)threadIdx.x; j < n; j += 512) sm += a.in[i][j]; for (int j = threadIdx.x; j < (n < 1024 ? n : 1024); j += 512) sm += a.in[i][j]; }
        ((float*)(a.ws))[threadIdx.x] = sm; }
    if (PROBE_FILL == 5 && lo == 0) { volatile float* p = (volatile float*)a.ws; const float big = p[0] * 0.f + 1e38f, tiny = p[1] * 0.f + 1e-38f, zero = p[2] * 0.f, neg = p[3] * 0.f - 1.f;
        float r = 0.f;
#if PROBE_EXC & 1
        r += big * big;
#endif
#if PROBE_EXC & 2
        r += tiny * tiny;
#endif
#if PROBE_EXC & 4
        r += 1.f / zero;
#endif
#if PROBE_EXC & 8
        r += __builtin_sqrtf(neg);
#endif
        p[4 + bx] = r; }
    unsigned nbar = 0;
    if (otid(wv) == 0) gb_add(GB(4 + xcc_id()), 1u);
    if (IN(0)) { for (int rep = 0; rep < PROBE_P0_REP; ++rep) { phase0(a, wv, lds, vcu, G); __syncthreads(); } } SEAM(0);
    if (IN(1)) { for (int rep = 0; rep < PROBE_ROW_REP; ++rep) phase1(a, wv, vcu, G); } SEAM(1);
    if (PROBE_HANG && lo == 1) { volatile unsigned* q = (volatile unsigned*)(a.ws + 8); while (*q != 0x12345678u) __builtin_amdgcn_s_sleep(20); }
    if (IN(2)) {
        pg8::Gemm g{(const bf16_t*)(ws + WS_H), (const bf16_t*)(ws + WS_WIN), D, D, D, wv}; pg8::Order S; S.init(MTOK, 2048, 1, G, bx);
        pg8::EpiZ E{(bf16_t*)(ws + WS_Z), (float*)(ws + WS_RSSQ), (float*)(ws + WS_RSSKV), 0};
        pg8::gemm_phase<pg8::EpiZ, pg8::Order>(lds, g, S, E);
    } SEAM(2);
    if (IN(3)) {
#ifndef P3MASK
#define P3MASK 0x3f
#endif
#if (P3MASK >> 0) & 1
        { pg8::Gemm g{(const bf16_t*)(ws + WS_Z) + C_QLAT, (const bf16_t*)(ws + WS_WUQ), ZP, 384, 384, wv}; pg8::Order S; S.init(MTOK, 768, 1, G, bx);
          pg8::EpiQ E{(bf16_t*)(ws + WS_Q), (const float*)(ws + WS_RSSQ)}; pg8::gemm_phase<pg8::EpiQ, pg8::Order>(lds, g, S, E); }
#endif
#if (P3MASK >> 1) & 1
        { pg8::Gemm g{(const bf16_t*)(ws + WS_Z) + C_KVLAT, (const bf16_t*)(ws + WS_WKF), ZP, 256, 256, wv}; pg8::Order S; S.init(MTOK, 512, 1, G, (bx + G - 96) % G);
          pg8::EpiK E{(bf16_t*)(ws + WS_KP), (bf16_t*)(ws + WS_KS), (const float*)(ws + WS_RSSKV), 0}; pg8::gemm_phase<pg8::EpiK, pg8::Order>(lds, g, S, E); }
#endif
#if (P3MASK >> 2) & 1
        { pg8::Gemm g{(const bf16_t*)(ws + WS_WVF), (const bf16_t*)(ws + WS_Z) + C_KVLAT, 256, ZP, 256, wv}; pg8::Order S; S.init(512, MTOK, 1, G, (bx + G - 160) % G);
          pg8::EpiVt E{(bf16_t*)(ws + WS_VTP), (bf16_t*)(ws + WS_VTS), (const float*)(ws + WS_RSSKV), 0}; pg8::gemm_phase<pg8::EpiVt, pg8::Order>(lds, g, S, E); }
#endif
        { pg8::Gemm g{(const bf16_t*)(ws + WS_H), (const bf16_t*)(ws + WS_WIN) + (size_t)2048 * D, D, D, D, wv}; pg8::Order S; S.init(MTOK, 256, 1, G, (bx + G - 224) % G);
          pg8::EpiZ E{(bf16_t*)(ws + WS_Z), (float*)(ws + WS_RSSQ), (float*)(ws + WS_RSSKV), 8}; pg8::gemm_phase<pg8::EpiZ, pg8::Order>(lds, g, S, E); }
#if (P3MASK >> 3) & 1
        { pg8::Gemm g{(const bf16_t*)(ws + WS_CACHEB), (const bf16_t*)(ws + WS_WKU), 256, 256, 256, wv}; pg8::Order S; S.init(512, 512, 1, G, (bx + G - 224) % G);
          pg8::EpiK E{(bf16_t*)(ws + WS_KP), (bf16_t*)(ws + WS_KS), (const float*)(ws + WS_RSSKV), 1}; pg8::gemm_phase<pg8::EpiK, pg8::Order>(lds, g, S, E); }
#endif
#if (P3MASK >> 4) & 1
        { pg8::Gemm g{(const bf16_t*)(ws + WS_WVU), (const bf16_t*)(ws + WS_CACHEB), 256, 256, 256, wv}; pg8::Order S; S.init(512, 512, 1, G, (bx + G - 228) % G);
          pg8::EpiVt E{(bf16_t*)(ws + WS_VTP), (bf16_t*)(ws + WS_VTS), (const float*)(ws + WS_RSSKV), 1}; pg8::gemm_phase<pg8::EpiVt, pg8::Order>(lds, g, S, E); }
#endif
        __syncthreads();
        if (bx < 224) {
            for (int u = bx; u < 512; u += 224) gla_stepA(a, wv, lds, u);
            p3_row_extras(a, wv, bx * 8 + (otid(wv) >> 6), 224 * 8);
        }
    } SEAM(3);
    if (IN(4)) { gla_scan(a, wv, vcu, G); } SEAM(4);
    if (IN(5)) {
        for (int rep = 0; rep < PROBE_ATT_REP; ++rep) for (int u = vcu; u < 512; u += G) attn_unit(a, wv, lds, u);
        for (int rep = 0; rep < PROBE_GLAC_REP; ++rep) for (int u = vcu; u < 512; u += G) gla_stepC(a, wv, lds, u);
    } SEAM(5);
    if (IN(6)) {
        pg8::Gemm g{(const bf16_t*)(ws + WS_MIX), (const bf16_t*)(ws + WS_WOUT), D, D, PROBE_K6, wv}; pg8::Order S; S.init(MTOK, D, 1024 / PROBE_K6, G, bx);
        pg8::EpiPart E{(bf16_t*)(ws + WS_P0), (bf16_t*)(ws + WS_P1A)}; pg8::gemm_phase<pg8::EpiPart, pg8::Order>(lds, g, S, E);
    } SEAM(6);
    if (IN(7)) { for (int rep = 0; rep < PROBE_ROW_REP; ++rep) phase6(a, wv, vcu, G); } SEAM(7);
    if (IN(8)) {
        pg8::Gemm g{(const bf16_t*)(ws + WS_H), (const bf16_t*)(ws + WS_WFFI), D, D, D, wv}; pg8::Order S; S.init(MTOK, 2 * DFF, 1, G, bx);
        pg8::EpiFFI E{(bf16_t*)(ws + WS_HFF)}; for (int rep = 0; rep < PROBE_FFI_REP; ++rep) pg8::gemm_phase<pg8::EpiFFI, pg8::Order>(lds, g, S, E);
    } SEAM(8);
    if (IN(9)) {
        pg8::Gemm g{(const bf16_t*)(ws + WS_HFF), (const bf16_t*)(ws + WS_WFFO), DFF, DFF, DFF / 2, wv}; pg8::Order S; S.init(MTOK, D, 2, G, bx);
        pg8::EpiPart E{(bf16_t*)(ws + WS_P0), (bf16_t*)(ws + WS_P1B)}; pg8::gemm_phase<pg8::EpiPart, pg8::Order>(lds, g, S, E);
    } SEAM(9);
    if (IN(10)) { for (int rep = 0; rep < PROBE_ROW_REP; ++rep) phase9(a, wv, vcu, G); }
    if (PROBE_DUMP) {
        if (PROBE_DUMP != 5 && PROBE_DUMP != 7) { ++nbar; } if (PROBE_DUMP != 5 && PROBE_DUMP != 7) my_grid_barrier(nbar, (unsigned)G, otid(wv), (LAS unsigned*)(lds + LDS_BYTES - 64));
        const bf16_t* src = (const bf16_t*)(ws + (PROBE_DUMP == 1 ? WS_Z : PROBE_DUMP == 2 ? WS_MIX : WS_H)); const int pitch = PROBE_DUMP == 1 ? ZP : D;
        for (size_t i = (size_t)bx * 512 + otid(wv); i < (size_t)MTOK * D; i += (size_t)G * 512) { const int r = (int)(i >> 10), c = (int)(i & 1023); a.out[i] = PROBE_DUMP == 7 ? 1.0f : PROBE_DUMP == 6 ? (r < 2304 ? bf2f(((const bf16_t*)(ws + WS_WIN))[(size_t)r * 1024 + c]) : 0.f) : PROBE_DUMP >= 4 ? xrow_ptr(a, r)[c] * 2.f : bf2f(src[(size_t)r * pitch + c]); }
        for (size_t i = O_KV + (size_t)bx * 512 + otid(wv); i < 10616832; i += (size_t)G * 512) a.out[i] = 0.f;
    }
    for (int xb = 0; xb < PROBE_XBAR; ++xb) { ++nbar; my_grid_barrier(nbar, (unsigned)G, otid(wv), (LAS unsigned*)(lds + LDS_BYTES - 64)); }
    if (nbar) my_grid_barrier_finish((unsigned)G, otid(wv));
#undef IN
#undef SEAM
}

extern "C" void kernel_launch(void* const* d_in, const int* in_sizes, int n_in, void* d_out, int out_size, void* d_ws, size_t ws_size, hipStream_t stream) {
    static int grid = 0;
    if (grid == 0) {
        int dev = 0, cus = 0;
        static const int exp_sizes[26] = {4194304, 4194304, 131072, 16384, 65536, 65536, 2048, 1024, 6291456, 6144, 1024, 2293760, 384, 294912, 256, 262144, 4096, 256, 4096, 256, 128, 1048576, 1024, 5767168, 2883584, 1024};
        bool okk = (n_in == 26); for (int i = 0; okk && i < 26; ++i) okk = (in_sizes[i] == exp_sizes[i]);
        if (!okk || out_size != 10616832) { fprintf(stderr, "kernel_launch: unexpected input sizes\n"); grid = -1; return; }
        if (n_in != 26 || ws_size < 198 * MiB) { fprintf(stderr, "kernel_launch: unexpected n_in %d / ws %zu\n", n_in, ws_size); grid = -1; return; }
        hipGetDevice(&dev); hipDeviceGetAttribute(&cus, hipDeviceAttributeMultiprocessorCount, dev);
        if (hipFuncSetAttribute((const void*)mk_fwd, hipFuncAttributeMaxDynamicSharedMemorySize, LDS_BYTES) != hipSuccess) { fprintf(stderr, "kernel_launch: hipFuncSetAttribute failed\n"); grid = -1; return; }
        int per_cu = 0;
        if (hipOccupancyMaxActiveBlocksPerMultiprocessor(&per_cu, (const void*)mk_fwd, 512, LDS_BYTES) != hipSuccess || per_cu < 1) { fprintf(stderr, "kernel_launch: occupancy query says %d\n", per_cu); per_cu = 1; }
        (void)hipGetLastError();
        if (cus < 256) { fprintf(stderr, "kernel_launch: needs 256 CUs, got %d\n", cus); grid = -1; return; }
        grid = 256;
    }
    if (grid < 0) return;
    Args a{};
    for (int i = 0; i < 26; ++i) a.in[i] = (const float*)d_in[i];
    a.out = (float*)d_out; a.ws = (unsigned char*)d_ws;
#if MK_PER_PHASE_LAUNCH
    for (int p = 0; p < NPHASE; ++p) { if (PROBE_ONLY_LAUNCH >= 0 && p != PROBE_ONLY_LAUNCH) continue; a.ph_lo = p; a.ph_hi = p + 1; hipLaunchKernelGGL(mk_fwd, dim3(grid), dim3(512), LDS_BYTES, stream, a); }
#else
    a.ph_lo = 0; a.ph_hi = NPHASE;
#if MK_COOP
    void* args[] = {&a};
    hipError_t e = hipLaunchCooperativeKernel((const void*)mk_fwd, dim3(grid), dim3(512), args, LDS_BYTES, stream);
    if (e != hipSuccess) fprintf(stderr, "cooperative launch failed: %s (grid %d)\n", hipGetErrorString(e), grid);
#else
    hipLaunchKernelGGL(mk_fwd, dim3(grid), dim3(512), LDS_BYTES, stream, a);
#endif
#endif
}
```

```cpp
#include <hip/hip_runtime.h>
#include <hip/hip_cooperative_groups.h>
#include <cstdio>
#include <cstdint>
namespace cg = cooperative_groups;

#define PROBE_FILL 0
#define PROBE_EXC 0
#define PROBE_BLO 0
#define PROBE_BHI 256
#define PROBE_RSTRIDE 1
#define PROBE_REP 1
#define PROBE_XLO 0
#define PROBE_XHI 8
#define PROBE_HANG 0
#define PROBE_ATT_REP 1
#define PROBE_GLAC_REP 1
#define PROBE_FFI_REP 1
#define PROBE_XBAR 0
#define PROBE_P0_REP 1
#define PROBE_ROW_REP 1
#define PROBE_P3_REP 1
#define PROBE_DUMP 0
#define PROBE_STATS 0
#define PROBE_K6 512
#define PROBE_ONLY_LAUNCH -1
#define PROBE_NOSTORE 0
#define PROBE_FILL_MIB 256
#define PROBE_FILL_VAL 1.2345f
#ifndef PROBE_MUL
#define PROBE_MUL 1.f
#endif
#ifndef PROBE_MODOFF
#define PROBE_MODOFF 0u
#endif
#ifndef MK_COOP
#define MK_COOP 0
#endif
#ifndef MK_PER_PHASE_LAUNCH
#define MK_PER_PHASE_LAUNCH 0
#endif

#define LAS __attribute__((address_space(3)))
typedef unsigned short bf16_t;
typedef short bf16x8 __attribute__((ext_vector_type(8)));
typedef float f32x4 __attribute__((ext_vector_type(4)));
typedef float f32x2 __attribute__((ext_vector_type(2)));
typedef unsigned u32x4 __attribute__((ext_vector_type(4)));
typedef unsigned u32x2 __attribute__((ext_vector_type(2)));

constexpr int D = 1024, MTOK = 8192, MP = 4096;
constexpr int ZP = 2304;
constexpr int C_QLAT = 0, C_KVLAT = 384, C_KROPE = 640, C_GQ = 672, C_GK = 928, C_GV = 1184, C_GFL = 1696, C_GOUT = 1728;
constexpr int DFF = 2816;
constexpr float EPS = 1e-6f;
constexpr float QSCALE = 0.10206207261596577f * 1.4426950408889634f;
constexpr int SKS = 2304;

constexpr size_t MiB = 1u << 20;
constexpr size_t WS_WIN = 1 * MiB;
constexpr size_t WS_WUQ = 6 * MiB;
constexpr size_t WS_WKF = 7 * MiB, WS_WVF = 7 * MiB + 256 * 1024;
constexpr size_t WS_WKU = 7 * MiB + 512 * 1024, WS_WVU = 7 * MiB + 768 * 1024;
constexpr size_t WS_WOUT = 8 * MiB;
constexpr size_t WS_WFFI = 10 * MiB;
constexpr size_t WS_WFFO = 21 * MiB;
constexpr size_t WS_BAR = 27 * MiB - 4096;
constexpr size_t WS_MOD = 27 * MiB;
constexpr size_t WS_RSSQ = 29 * MiB;
constexpr size_t WS_RSSKV = WS_RSSQ;
constexpr size_t WS_CACHEB = 27 * MiB + 512 * 1024;
constexpr size_t WS_DEC = 28 * MiB;
constexpr size_t WS_H = 32 * MiB;
constexpr size_t WS_Z = 48 * MiB;
constexpr size_t WS_Q = 84 * MiB;
constexpr size_t WS_HFF = 48 * MiB;
constexpr size_t WS_KP = 96 * MiB;
constexpr size_t WS_KS = 102 * MiB;
constexpr size_t WS_VTP = 109 * MiB;
constexpr size_t WS_VTS = 113 * MiB;
constexpr size_t WS_CT = 118 * MiB;
constexpr size_t WS_MIX = 150 * MiB;
constexpr size_t WS_X1 = 166 * MiB;
constexpr size_t WS_P0 = 96 * MiB;
constexpr size_t WS_P1A = 48 * MiB, WS_P1B = 128 * MiB;
constexpr size_t O_Y = 0, O_KV = 8388608, O_KR = O_KV + 1048576, O_SF = O_KR + 131072, O_SB = O_SF + 524288;

constexpr int LDS_BYTES = 147456;

__device__ __forceinline__ unsigned f2bf_sw(float f) { unsigned u = __builtin_bit_cast(unsigned, f); return (u + 0x7fffu + ((u >> 16) & 1u)) >> 16; }
__device__ __forceinline__ unsigned cvt_pk_bf16(float lo, float hi) { unsigned r; asm volatile("v_cvt_pk_bf16_f32 %0, %1, %2" : "=v"(r) : "v"(lo), "v"(hi)); return r; }
__device__ __forceinline__ bf16_t f2bf(float f) { return (bf16_t)(cvt_pk_bf16(f, 0.f) & 0xffffu); }
__device__ __forceinline__ float bf2f(bf16_t b) { return __uint_as_float((unsigned)b << 16); }
__device__ __forceinline__ float bflo(unsigned w) { return __uint_as_float(w << 16); }
__device__ __forceinline__ float bfhi(unsigned w) { return __uint_as_float(w & 0xffff0000u); }
__device__ __forceinline__ float wave_sum(float v) {
#pragma unroll
    for (int o = 1; o < 64; o <<= 1) v += __shfl_xor(v, o);
    return v;
}
__device__ __forceinline__ float fast_rcp(float x) { return __builtin_amdgcn_rcpf(x); }
__device__ __forceinline__ float silu_f(float a) { return a * fast_rcp(1.f + __expf(-a)); }
__device__ __forceinline__ float logsigmoid_f(float x) { return fminf(x, 0.f) - __logf(1.f + __expf(-fabsf(x))); }
__device__ __forceinline__ int opaque_lane() { int l; asm volatile("v_mbcnt_lo_u32_b32 %0, -1, 0\n\tv_mbcnt_hi_u32_b32 %0, -1, %0" : "=v"(l)); return l; }
__device__ __forceinline__ int otid(int wv) { int t = (int)threadIdx.x; asm volatile("" : "+v"(t)); return t; }
#define LDS_WAIT() asm volatile("s_waitcnt lgkmcnt(0)" ::: "memory")
#define VM_WAIT() asm volatile("s_waitcnt vmcnt(0)" ::: "memory")

namespace pg8 {
constexpr int BM = 256, BK = 64, HALF = 128, HTB = HALF * BK * 2, STAGE_BYTES = 8 * HTB, NXCD = 8, WGM = 8;
__host__ __device__ __forceinline__ int lds_byte(int r, int c) { const int st = (r >> 4) * 2 + (c >> 5), rr = r & 15, cc = c & 31, ob = rr * 64 + cc * 2; return st * 1024 + (ob ^ (((ob >> 9) & 1) << 5)); }
__host__ __device__ __forceinline__ void stage_rc(int b, int& R, int& C) { const int st = b / 1024, sb = b % 1024, swz = sb ^ (((sb >> 9) & 1) << 5); R = (st >> 1) * 16 + swz / 64; C = (st & 1) * 32 + (swz % 64) / 2; }
__host__ __device__ __forceinline__ int perm32(int rho) { const int n = rho >> 4, i = rho & 15; return 8 * (i >> 2) + 4 * n + (i & 3); }

struct Unit { int pm, pn, ks; };
struct Gemm { const bf16_t* A; const bf16_t* Bt; int lda, ldb, K, wv; };

struct Order {
    int nM, nN, nNs, nwg, G, c;
    __device__ void init(int M, int N, int nsplit, int G_, int c_) { nM = M / BM; nN = N / BM; nNs = nN * nsplit; nwg = nM * nNs; G = G_; c = c_; }
    __device__ bool next(int i, Unit& u) const {
        const long L = (long)i * G + c; if (L >= nwg) return false;
        int wgid = (int)L; { const int q = nwg / NXCD, r = nwg % NXCD, xcd = wgid % NXCD, off = wgid / NXCD; wgid = (xcd < r ? xcd * (q + 1) : r * (q + 1) + (xcd - r) * q) + off; }
        const int nig = WGM * nNs, gid = wgid / nig, fm = gid * WGM, gsz = (nM - fm) < WGM ? (nM - fm) : WGM;
        u.pm = fm + ((wgid % nig) % gsz); const int pn2 = (wgid % nig) / gsz; u.pn = pn2 % nN; u.ks = pn2 / nN; return true;
    }
};

template <class Epi, class Sched, bool ALIGN_EPI = true, bool SP2 = true>
__device__ __forceinline__ void gemm_phase(LAS unsigned char* lds, const Gemm g, const Sched& S, const Epi& E) {
    const int tid = otid(g.wv), wid = g.wv, lane = tid & 63, wr = wid >> 2, wc = wid & 3, fr = lane & 15, fq = lane >> 4;
    const int K = g.K, nt = K / BK;
    unsigned voffA[2], voffB[2];
#pragma unroll
    for (int i = 0; i < 2; ++i) { int R, C; stage_rc(tid * 16 + i * 8192, R, C); const int Rb = Epi::PERM ? ((R & ~31) + perm32(R & 31)) : R;
        voffA[i] = (unsigned)(R * g.lda + C) * 2u; voffB[i] = (unsigned)(Rb * g.ldb + C) * 2u; }
    const size_t kstep = (size_t)(BK * 2);
    const size_t hstepA = (size_t)HALF * g.lda * 2, hstepB = (size_t)HALF * g.ldb * 2;
    const size_t tstepA = 2 * hstepA, tstepB = 2 * hstepB;
    const size_t ksplit = (size_t)K * 2;
    const unsigned ldsw = (unsigned)wid * 1024u;
    const int aoff = lds_byte(wr * 64 + fr, fq * 8), boff = lds_byte(wc * 32 + fr, fq * 8);
#define PG8_SA(b, h) (((b) * 2 + (h)) * HTB)
#define PG8_SB(b, h) ((4 + (b) * 2 + (h)) * HTB)
#define PG8_STAGE(bufoff, gbase, voff) do { _Pragma("unroll") for (int _i = 0; _i < 2; ++_i) \
        __builtin_amdgcn_global_load_lds((const unsigned*)((const char*)(gbase) + (voff)[_i]), (LAS unsigned*)(lds + (bufoff) + ldsw + _i * 8192), 16, 0, 0); } while (0)
#define PG8_LDA(dst, b, h) do { _Pragma("unroll") for (int m = 0; m < 4; ++m) _Pragma("unroll") for (int k = 0; k < 2; ++k) dst[m][k] = *(const LAS bf16x8*)(lds + PG8_SA(b, h) + aoff + m * 2048 + k * 1024); } while (0)
#define PG8_LDB(dst, b, h) do { _Pragma("unroll") for (int n = 0; n < 2; ++n) _Pragma("unroll") for (int k = 0; k < 2; ++k) dst[n][k] = *(const LAS bf16x8*)(lds + PG8_SB(b, h) + boff + n * 2048 + k * 1024); } while (0)
#define PG8_MMA(ai, bj, At, Bt) do { __builtin_amdgcn_s_setprio(1); _Pragma("unroll") for (int m = 0; m < 4; ++m) _Pragma("unroll") for (int n = 0; n < 2; ++n) _Pragma("unroll") for (int k = 0; k < 2; ++k) \
        acc[ai][bj][m][n] = __builtin_amdgcn_mfma_f32_16x16x32_bf16(Bt[n][k], At[m][k], acc[ai][bj][m][n], 0, 0, 0); __builtin_amdgcn_s_setprio(0); } while (0)
#define PG8_WAIT_V(n) asm volatile("s_waitcnt vmcnt(" #n ")" ::: "memory")
#define PG8_WAIT_L(n) asm volatile("s_waitcnt lgkmcnt(" #n ")" ::: "memory")
#define PG8_BAR __builtin_amdgcn_s_barrier()
#define PG8_SCHED __builtin_amdgcn_sched_barrier(0)
    Unit cur, nxt; int ui = 0;
    if (!S.next(0, cur)) return;
    f32x4 acc[2][2][4][2];
#pragma unroll
    for (int a = 0; a < 2; ++a)
#pragma unroll
        for (int b = 0; b < 2; ++b)
#pragma unroll
            for (int m = 0; m < 4; ++m)
#pragma unroll
                for (int n = 0; n < 2; ++n) acc[a][b][m][n] = (f32x4){0.f, 0.f, 0.f, 0.f};
    bf16x8 At[4][2], B0[2][2], B1[2][2];
    const char* cA = (const char*)g.A + (size_t)cur.pm * tstepA + (size_t)cur.ks * ksplit; const char* cB = (const char*)g.Bt + (size_t)cur.pn * tstepB + (size_t)cur.ks * ksplit;
    if constexpr (SP2) {
        PG8_STAGE(PG8_SB(0, 0), cB, voffB); PG8_STAGE(PG8_SB(0, 1), cB + hstepB, voffB); PG8_STAGE(PG8_SA(0, 0), cA, voffA); PG8_STAGE(PG8_SA(0, 1), cA + hstepA, voffA);
        if (wr == 1) PG8_BAR;
        PG8_WAIT_V(2); PG8_BAR;
        PG8_STAGE(PG8_SB(1, 0), cB + kstep, voffB); PG8_STAGE(PG8_SA(1, 0), cA + kstep, voffA); PG8_STAGE(PG8_SB(1, 1), cB + hstepB + kstep, voffB);
        PG8_WAIT_V(6); PG8_BAR;
    } else {
        PG8_STAGE(PG8_SB(0, 0), cB, voffB); PG8_STAGE(PG8_SA(0, 0), cA, voffA); PG8_STAGE(PG8_SB(0, 1), cB + hstepB, voffB); PG8_STAGE(PG8_SA(0, 1), cA + hstepA, voffA);
        if (wr == 1) PG8_BAR;
        PG8_WAIT_V(4); PG8_BAR;
        PG8_STAGE(PG8_SB(1, 0), cB + kstep, voffB); PG8_STAGE(PG8_SA(1, 0), cA + kstep, voffA); PG8_STAGE(PG8_SB(1, 1), cB + hstepB + kstep, voffB);
        PG8_WAIT_V(6); PG8_BAR;
    }
    for (;;) {
        const bool has_next = S.next(ui + 1, nxt);
        const char* nA = has_next ? (const char*)g.A + (size_t)nxt.pm * tstepA + (size_t)nxt.ks * ksplit : cA; const char* nB = has_next ? (const char*)g.Bt + (size_t)nxt.pn * tstepB + (size_t)nxt.ks * ksplit : cB;
#pragma nounroll
        for (int t = 0; t < nt; t += 2) {
            const bool last = (t == nt - 2);
            const char* a1 = cA + (size_t)(t + 1) * kstep;
            const char* a2 = last ? nA : cA + (size_t)(t + 2) * kstep; const char* b2 = last ? nB : cB + (size_t)(t + 2) * kstep;
            const char* a3 = a2 + kstep; const char* b3 = b2 + kstep;
            if constexpr (SP2) {
            PG8_LDB(B0, 0, 0); PG8_LDB(B1, 0, 1); PG8_SCHED; PG8_LDA(At, 0, 0); PG8_STAGE(PG8_SA(1, 1), a1 + hstepA, voffA);
            PG8_WAIT_V(8); PG8_WAIT_L(0); PG8_BAR; PG8_MMA(0, 0, At, B0); PG8_MMA(0, 1, At, B1); PG8_BAR; PG8_SCHED;
            PG8_LDA(At, 0, 1); PG8_STAGE(PG8_SB(0, 0), b2, voffB); PG8_STAGE(PG8_SB(0, 1), b2 + hstepB, voffB); PG8_STAGE(PG8_SA(0, 0), a2, voffA);
            PG8_WAIT_V(8); PG8_WAIT_L(0); PG8_BAR; PG8_MMA(1, 0, At, B0); PG8_MMA(1, 1, At, B1); PG8_BAR; PG8_SCHED;
            PG8_LDB(B0, 1, 0); PG8_LDB(B1, 1, 1); PG8_SCHED; PG8_LDA(At, 1, 0); PG8_STAGE(PG8_SA(0, 1), a2 + hstepA, voffA);
            PG8_WAIT_V(8); PG8_WAIT_L(0); PG8_BAR; PG8_MMA(0, 0, At, B0); PG8_MMA(0, 1, At, B1); PG8_BAR; PG8_SCHED;
            PG8_LDA(At, 1, 1); PG8_STAGE(PG8_SB(1, 0), b3, voffB); PG8_STAGE(PG8_SB(1, 1), b3 + hstepB, voffB); PG8_STAGE(PG8_SA(1, 0), a3, voffA);
            PG8_WAIT_V(8); PG8_WAIT_L(0); PG8_BAR; PG8_MMA(1, 0, At, B0); PG8_MMA(1, 1, At, B1); PG8_BAR; PG8_SCHED;
            } else {
            PG8_LDB(B0, 0, 0); PG8_SCHED; PG8_LDA(At, 0, 0); PG8_STAGE(PG8_SA(1, 1), a1 + hstepA, voffA);
            PG8_WAIT_L(8); PG8_BAR; PG8_WAIT_L(0); PG8_MMA(0, 0, At, B0); PG8_BAR; PG8_SCHED;
            PG8_LDB(B1, 0, 1); PG8_STAGE(PG8_SB(0, 0), b2, voffB);
            PG8_BAR; PG8_WAIT_L(0); PG8_MMA(0, 1, At, B1); PG8_BAR;
            PG8_LDA(At, 0, 1); PG8_STAGE(PG8_SA(0, 0), a2, voffA);
            PG8_BAR; PG8_WAIT_L(0); PG8_MMA(1, 0, At, B0); PG8_BAR; PG8_SCHED;
            PG8_STAGE(PG8_SB(0, 1), b2 + hstepB, voffB);
            PG8_WAIT_V(6); PG8_BAR; PG8_MMA(1, 1, At, B1); PG8_BAR;
            PG8_LDB(B0, 1, 0); PG8_SCHED; PG8_LDA(At, 1, 0); PG8_STAGE(PG8_SA(0, 1), a2 + hstepA, voffA);
            PG8_WAIT_L(8); PG8_BAR; PG8_WAIT_L(0); PG8_MMA(0, 0, At, B0); PG8_BAR; PG8_SCHED;
            PG8_LDB(B1, 1, 1); PG8_STAGE(PG8_SB(1, 0), b3, voffB);
            PG8_BAR; PG8_WAIT_L(0); PG8_MMA(0, 1, At, B1); PG8_BAR;
            PG8_LDA(At, 1, 1); PG8_STAGE(PG8_SA(1, 0), a3, voffA);
            PG8_BAR; PG8_WAIT_L(0); PG8_MMA(1, 0, At, B0); PG8_BAR; PG8_SCHED;
            PG8_STAGE(PG8_SB(1, 1), b3 + hstepB, voffB);
            PG8_WAIT_V(6); PG8_BAR; PG8_MMA(1, 1, At, B1); PG8_BAR;
            }
        }
        if constexpr (ALIGN_EPI) { if (wr == 0) PG8_BAR; }
        E(acc, cur, wr, wc, fr, fq);
        if (!has_next) break;
#pragma unroll
        for (int a = 0; a < 2; ++a)
#pragma unroll
            for (int b = 0; b < 2; ++b)
#pragma unroll
                for (int m = 0; m < 4; ++m)
#pragma unroll
                    for (int n = 0; n < 2; ++n) acc[a][b][m][n] = (f32x4){0.f, 0.f, 0.f, 0.f};
        cur = nxt; cA = nA; cB = nB; ++ui;
        if constexpr (ALIGN_EPI) { if (wr == 1) PG8_BAR; }
    }
    PG8_WAIT_V(0);
    if constexpr (!ALIGN_EPI) { if (wr == 0) PG8_BAR; }
    PG8_BAR;
#undef PG8_SA
#undef PG8_SB
#undef PG8_STAGE
#undef PG8_LDA
#undef PG8_LDB
#undef PG8_MMA
#undef PG8_WAIT_V
#undef PG8_WAIT_L
#undef PG8_BAR
#undef PG8_SCHED
}

__device__ __forceinline__ float rss_q(const float* rss, int row) { float s = 0.f;
#pragma unroll
    for (int p = 0; p < 12; ++p) s += rss[(size_t)p * MTOK + row]; return s; }
__device__ __forceinline__ float rss_kv(const float* rss, int row) { float s = 0.f;
#pragma unroll
    for (int p = 12; p < 20; ++p) s += rss[(size_t)p * MTOK + row]; return s; }
#define EPI_ROWS_BEGIN _Pragma("unroll") for (int ai = 0; ai < 2; ++ai) _Pragma("unroll") for (int m = 0; m < 4; ++m) { const int row = u.pm * BM + wr * 64 + fr + ai * HALF + m * 16;
#define EPI_ROWS_END asm volatile("" ::: "memory"); }

struct EpiZ {
    static constexpr bool PERM = true;
    bf16_t* Z; float* rssq; float* rsskv; int pn_off;
    __device__ __forceinline__ void operator()(const f32x4 (&acc)[2][2][4][2], const Unit& u, int wr, int wc, int fr_, int fq_) const {
        int lane_e = (int)threadIdx.x & 63; asm volatile("" : "+v"(lane_e)); const int fr = lane_e & 15, fq = lane_e >> 4;
        const int col0 = (u.pn + pn_off) * BM + wc * 32 + 8 * fq;
        EPI_ROWS_BEGIN
            bf16_t* rowp = Z + (size_t)row * ZP + col0;
#pragma unroll
            for (int bj = 0; bj < 2; ++bj) { const f32x4 v0 = acc[ai][bj][m][0], v1 = acc[ai][bj][m][1];
                u32x4 w; w.x = cvt_pk_bf16(v0[0], v0[1]); w.y = cvt_pk_bf16(v0[2], v0[3]); w.z = cvt_pk_bf16(v1[0], v1[1]); w.w = cvt_pk_bf16(v1[2], v1[3]);
                *(u32x4*)(rowp + bj * HALF) = w;
                const int hc = 2 * (u.pn + pn_off) + bj;
                if (hc < 5) { float s = (v0[0] * v0[0] + v0[1] * v0[1]) + (v0[2] * v0[2] + v0[3] * v0[3]) + (v1[0] * v1[0] + v1[1] * v1[1]) + (v1[2] * v1[2] + v1[3] * v1[3]);
                    s += __shfl_xor(s, 16); s += __shfl_xor(s, 32);
                    if (fq == 0) rssq[(size_t)(hc * 4 + wc) * MTOK + row] = s; } }
        EPI_ROWS_END
    }
};

struct EpiQ {
    static constexpr bool PERM = true;
    bf16_t* Q; const float* rssq;
    __device__ __forceinline__ void operator()(const f32x4 (&acc)[2][2][4][2], const Unit& u, int wr, int wc, int fr_, int fq_) const {
        int lane_e = (int)threadIdx.x & 63; asm volatile("" : "+v"(lane_e)); const int fr = lane_e & 15, fq = lane_e >> 4;
        const int col0 = u.pn * BM + wc * 32 + 8 * fq;
        const float inv[8] = {1.f, 0.316227766f, 0.1f, 0.0316227766f, 0.01f, 0.00316227766f, 0.001f, 0.000316227766f};
        EPI_ROWS_BEGIN
            const float rs = rsqrtf(rss_q(rssq, row) * (1.f / 384.f) + EPS) * QSCALE;
            const int t = (row - MP) & 2047;
#pragma unroll
            for (int bj = 0; bj < 2; ++bj) { const int c = col0 + bj * HALF; const int j0 = c % 96;
                const bool rp = (row >= MP && j0 >= 64);
                const float pos = (float)((j0 < 80) ? (t >> 6) : (t & 63)) * 0.15915494309189535f;
                const float sg = (j0 & 8) ? 1.f : -1.f;
#pragma unroll
                for (int n = 0; n < 2; ++n) {
                    f32x4 v = acc[ai][bj][m][n] * rs;
#pragma unroll
                    for (int i = 0; i < 4; ++i) { const float p = __shfl_xor(v[i], 16);
                        const float rev = pos * inv[4 * n + i]; const float rf = rev - floorf(rev);
                        const float cs = __builtin_amdgcn_cosf(rf), sn = __builtin_amdgcn_sinf(rf); v[i] = rp ? v[i] * cs + sg * p * sn : v[i]; }
                    u32x2 w; w.x = cvt_pk_bf16(v[0], v[1]); w.y = cvt_pk_bf16(v[2], v[3]);
                    *(u32x2*)(Q + (size_t)row * 768 + c + 4 * n) = w; } }
        EPI_ROWS_END
    }
};

struct EpiK {
    static constexpr bool PERM = true;
    bf16_t* Kp; bf16_t* Ks; const float* rsskv; int ctx;
    __device__ __forceinline__ void operator()(const f32x4 (&acc)[2][2][4][2], const Unit& u, int wr, int wc, int fr_, int fq_) const {
        int lane_e = (int)threadIdx.x & 63; asm volatile("" : "+v"(lane_e)); const int fr = lane_e & 15, fq = lane_e >> 4;
        EPI_ROWS_BEGIN
            float rs = 1.f; unsigned off; bool smp;
            if (ctx) { off = ((unsigned)(row >> 8) * 8u * SKS + (row & 255)) * 96u; smp = true; }
            else { rs = rsqrtf(rss_kv(rsskv, row) * (1.f / 256.f) + EPS);
                if (row < MP) { off = ((unsigned)(row >> 8) * 8u * 256u + (row & 255)) * 96u; smp = false; } else { off = ((unsigned)((row - MP) >> 11) * 8u * SKS + 256u + ((row - MP) & 2047)) * 96u; smp = true; } }
            bf16_t* base = smp ? Ks : Kp; const unsigned hs = (smp ? SKS : 256) * 96u;
#pragma unroll
            for (int bj = 0; bj < 2; ++bj) { const unsigned h = 4 * u.pn + 2 * bj + (wc >> 1); const unsigned j = (wc & 1) * 32 + 8 * fq;
                const f32x4 v0 = acc[ai][bj][m][0] * rs, v1 = acc[ai][bj][m][1] * rs;
                u32x4 w; w.x = cvt_pk_bf16(v0[0], v0[1]); w.y = cvt_pk_bf16(v0[2], v0[3]); w.z = cvt_pk_bf16(v1[0], v1[1]); w.w = cvt_pk_bf16(v1[2], v1[3]);
                *(u32x4*)(base + (off + h * hs + j)) = w; }
        EPI_ROWS_END
    }
};

struct EpiVt {
    static constexpr bool PERM = true;
    bf16_t* Vtp; bf16_t* Vts; const float* rsskv; int ctx;
    __device__ __forceinline__ void operator()(const f32x4 (&acc)[2][2][4][2], const Unit& u, int wr, int wc, int fr_, int fq_) const {
        int lane_e = (int)threadIdx.x & 63; asm volatile("" : "+v"(lane_e)); const int fr = lane_e & 15, fq = lane_e >> 4;
#pragma unroll
        for (int bj = 0; bj < 2; ++bj) {
            const int tok = u.pn * BM + bj * HALF + wc * 32 + 8 * fq;
            f32x4 r0 = {1.f, 1.f, 1.f, 1.f}, r1 = {1.f, 1.f, 1.f, 1.f}; unsigned off; bool smp; unsigned S;
            if (ctx) { off = (unsigned)(tok >> 8) * 8u * 64u * SKS + (tok & 255); smp = true; S = SKS; }
            else { f32x4 q0 = {0.f, 0.f, 0.f, 0.f}, q1 = {0.f, 0.f, 0.f, 0.f};
#pragma unroll
                for (int p = 12; p < 20; ++p) { q0 += *(const f32x4*)(rsskv + (size_t)p * MTOK + tok); q1 += *(const f32x4*)(rsskv + (size_t)p * MTOK + tok + 4); }
#pragma unroll
                for (int i = 0; i < 4; ++i) { r0[i] = rsqrtf(q0[i] * (1.f / 256.f) + EPS); r1[i] = rsqrtf(q1[i] * (1.f / 256.f) + EPS); }
                if (tok < MP) { off = (unsigned)(tok >> 8) * 8u * 64u * 256u + (tok & 255); smp = false; S = 256; } else { off = (unsigned)((tok - MP) >> 11) * 8u * 64u * SKS + 256u + ((tok - MP) & 2047); smp = true; S = SKS; } }
            bf16_t* base = smp ? Vts : Vtp;
#pragma unroll
            for (int ai = 0; ai < 2; ++ai)
#pragma unroll
                for (int m = 0; m < 4; ++m) { const unsigned hd = u.pm * BM + wr * 64 + fr + ai * HALF + m * 16;
                    const f32x4 v0 = acc[ai][bj][m][0] * r0, v1 = acc[ai][bj][m][1] * r1;
                    u32x4 w; w.x = cvt_pk_bf16(v0[0], v0[1]); w.y = cvt_pk_bf16(v0[2], v0[3]); w.z = cvt_pk_bf16(v1[0], v1[1]); w.w = cvt_pk_bf16(v1[2], v1[3]);
                    *(u32x4*)(base + (off + hd * S)) = w; }
            asm volatile("" ::: "memory");
        }
    }
};

struct EpiPart {
    static constexpr bool PERM = true;
    bf16_t* P0; bf16_t* P1;
    __device__ __forceinline__ void operator()(const f32x4 (&acc)[2][2][4][2], const Unit& u, int wr, int wc, int fr_, int fq_) const {
        int lane_e = (int)threadIdx.x & 63; asm volatile("" : "+v"(lane_e)); const int fr = lane_e & 15, fq = lane_e >> 4;
        const int col0 = u.pn * BM + wc * 32 + 8 * fq; bf16_t* P = u.ks ? P1 : P0;
        EPI_ROWS_BEGIN
            bf16_t* rowp = P + (size_t)row * D + col0;
#pragma unroll
            for (int bj = 0; bj < 2; ++bj) { const f32x4 v0 = acc[ai][bj][m][0], v1 = acc[ai][bj][m][1];
                u32x4 w; w.x = cvt_pk_bf16(v0[0], v0[1]); w.y = cvt_pk_bf16(v0[2], v0[3]); w.z = cvt_pk_bf16(v1[0], v1[1]); w.w = cvt_pk_bf16(v1[2], v1[3]);
                *(u32x4*)(rowp + bj * HALF) = w; }
        EPI_ROWS_END
    }
};

struct EpiFFI {
    static constexpr bool PERM = true;
    bf16_t* H;
    __device__ __forceinline__ void operator()(const f32x4 (&acc)[2][2][4][2], const Unit& u, int wr, int wc, int fr_, int fq_) const {
        int lane_e = (int)threadIdx.x & 63; asm volatile("" : "+v"(lane_e)); const int fr = lane_e & 15, fq = lane_e >> 4;
        const int col0 = u.pn * HALF + wc * 32 + 8 * fq;
        EPI_ROWS_BEGIN
            float o[8];
#pragma unroll
            for (int i = 0; i < 4; ++i) { o[i] = silu_f(acc[ai][0][m][0][i]) * acc[ai][1][m][0][i]; o[4 + i] = silu_f(acc[ai][0][m][1][i]) * acc[ai][1][m][1][i]; }
            u32x4 w; w.x = cvt_pk_bf16(o[0], o[1]); w.y = cvt_pk_bf16(o[2], o[3]); w.z = cvt_pk_bf16(o[4], o[5]); w.w = cvt_pk_bf16(o[6], o[7]);
            *(u32x4*)(H + (size_t)row * DFF + col0) = w;
        EPI_ROWS_END
    }
};
}

struct Args { const float* in[26]; float* out; unsigned char* ws; int ph_lo, ph_hi; };
enum { I_XP = 0, I_XS, I_CKV, I_CKR, I_SF, I_SB, I_C, I_CCTX, I_WADA, I_BADA, I_NATT, I_WIN, I_QN, I_WUQ, I_KVN, I_WUKV, I_WGF, I_BGF, I_WGB, I_BGB, I_GLAN, I_WOUT, I_NFFN, I_WFFI, I_WFFO, I_FN };

__device__ __forceinline__ const float* xrow_ptr(const Args& a, int r) { return r < MP ? a.in[I_XP] + (size_t)r * D : a.in[I_XS] + (size_t)(r - MP) * D; }
__device__ __forceinline__ int cond_of_row(int r) { return r < MP ? 0 : 1 + ((r - MP) >> 11); }

__device__ __forceinline__ void p0_tr(const float* W, int K, int N, bf16_t* WT, bf16_t* WT2, const float* kscale, int kb, int nb, int drow, LAS float* scr, int lane) {
    const int k0 = 64 * kb, n0 = 32 * nb;
#pragma unroll 8
    for (int i = 0; i < 32; ++i) { const int kk = 2 * i + (lane >> 5); scr[kk * 33 + (lane & 31)] = W[(size_t)(k0 + kk) * N + n0 + (lane & 31)]; }
    LDS_WAIT();
    const int c = lane & 7;
    float sc[8];
#pragma unroll
    for (int i = 0; i < 8; ++i) sc[i] = kscale ? kscale[k0 + 8 * c + i] : 1.f;
#pragma unroll
    for (int j = 0; j < 4; ++j) { const int n = (lane >> 3) + 8 * j; const LAS float* s = scr + (8 * c) * 33 + n;
        float v[8];
#pragma unroll
        for (int i = 0; i < 8; ++i) v[i] = s[i * 33];
        if (WT2) { u32x4 o; o.x = cvt_pk_bf16(v[0], v[1]); o.y = cvt_pk_bf16(v[2], v[3]); o.z = cvt_pk_bf16(v[4], v[5]); o.w = cvt_pk_bf16(v[6], v[7]);
            *(u32x4*)(WT2 + (size_t)(drow + n0 + n) * K + k0 + 8 * c) = o; }
        u32x4 o; o.x = cvt_pk_bf16(v[0] * sc[0], v[1] * sc[1]); o.y = cvt_pk_bf16(v[2] * sc[2], v[3] * sc[3]); o.z = cvt_pk_bf16(v[4] * sc[4], v[5] * sc[5]); o.w = cvt_pk_bf16(v[6] * sc[6], v[7] * sc[7]);
        *(u32x4*)(WT + (size_t)(drow + n0 + n) * K + k0 + 8 * c) = o; }
    LDS_WAIT();
}

__device__ __forceinline__ void phase0(const Args& a, int wv, LAS unsigned char* lds, int vcu, int G) {
    const int tid = otid(wv), lane = tid & 63, wave = __builtin_amdgcn_readfirstlane(tid >> 6);
    unsigned char* ws = a.ws;
#ifndef P0MASK
#define P0MASK 7
#endif
    if (P0MASK & 2) {
        LAS float* scr = (LAS float*)(lds + wave * 16384);
        LAS float* scnd = (LAS float*)(lds + 131072);
        for (int i = tid; i < 3072; i += 512) { const int ci = i >> 10, k = i & 1023; scnd[i] = silu_f(ci == 0 ? a.in[I_CCTX][k] : a.in[I_C][(ci - 1) * D + k]); }
        __syncthreads();
        const int gw = vcu * 8 + wave, NGW = G * 8;
        constexpr int T_IN = 16 * 70, T_UQ = 6 * 24, T_UKV = 4 * 32, T_OUT = 16 * 32, T_FFI = 16 * 176, T_FFO = 44 * 32, T_ZERO = 64, T_ADA = 768;
        constexpr int NIT = T_ADA + T_IN + T_UQ + T_UKV + T_OUT + T_FFI + T_FFO + T_ZERO;
        constexpr int NTR = NIT - T_ADA;
        const int nslot = wave < 3 ? 2 : 5;
        for (int sl = 0; sl < nslot; ++sl) {
            int r;
            if (wave < 3) { if (sl == 0) { r = wave * G + vcu; if (r >= T_ADA) continue; } else { const int t = vcu + G * wave; if (t >= NTR) continue; r = T_ADA + t; } }
            else { const int j = 3 + (wave - 3) + 5 * sl; const int t = vcu + G * j; if (t >= NTR) continue; r = T_ADA + t; }
            if (r < T_ADA) {
                const int nbq = r >> 2, kq = r & 3; const int n0 = 32 * nbq; const float* W = a.in[I_WADA];
                const int n = lane & 31, hf = lane >> 5; float s0 = 0.f, s1 = 0.f, s2 = 0.f;
                for (int kb = 4 * kq; kb < 4 * kq + 4; ++kb) { const int k0 = 64 * kb;
#pragma unroll 8
                    for (int i = 0; i < 32; ++i) { const int kk = 2 * i + (lane >> 5); scr[kk * 33 + (lane & 31)] = W[(size_t)(k0 + kk) * 6144 + n0 + (lane & 31)]; }
                    LDS_WAIT();
#pragma unroll 8
                    for (int j = 0; j < 32; ++j) { const int kk = hf * 32 + j; const float w = scr[kk * 33 + n];
                        s0 += w * scnd[k0 + kk]; s1 += w * scnd[1024 + k0 + kk]; s2 += w * scnd[2048 + k0 + kk]; }
                    LDS_WAIT(); }
                s0 += __shfl_xor(s0, 32); s1 += __shfl_xor(s1, 32); s2 += __shfl_xor(s2, 32);
                float* MOD = (float*)(ws + WS_MOD) + (size_t)kq * 18432;
                if (hf == 0) { MOD[n0 + n] = s0; MOD[6144 + n0 + n] = s1; MOD[12288 + n0 + n] = s2; }
                continue; } r -= T_ADA;
            if (r < T_FFI) { const int kb = r / 176, nb = r % 176; const int n0 = nb * 32; const int drow = n0 < DFF ? (n0 / 128) * 256 + (n0 % 128) : ((n0 - DFF) / 128) * 256 + 128 + ((n0 - DFF) % 128);
                p0_tr(a.in[I_WFFI], 1024, 5632, (bf16_t*)(ws + WS_WFFI), nullptr, nullptr, kb, nb, drow - n0, scr, lane); continue; } r -= T_FFI;
            if (r < T_FFO) { p0_tr(a.in[I_WFFO], DFF, 1024, (bf16_t*)(ws + WS_WFFO), nullptr, nullptr, r / 32, r % 32, 0, scr, lane); continue; } r -= T_FFO;
            if (r < T_IN) { p0_tr(a.in[I_WIN], 1024, 2240, (bf16_t*)(ws + WS_WIN), nullptr, nullptr, r / 70, r % 70, 0, scr, lane); continue; } r -= T_IN;
            if (r < T_OUT) { p0_tr(a.in[I_WOUT], 1024, 1024, (bf16_t*)(ws + WS_WOUT), nullptr, nullptr, r / 32, r % 32, 0, scr, lane); continue; } r -= T_OUT;
            if (r < T_UQ) { p0_tr(a.in[I_WUQ], 384, 768, (bf16_t*)(ws + WS_WUQ), nullptr, a.in[I_QN], r / 24, r % 24, 0, scr, lane); continue; } r -= T_UQ;
            if (r < T_UKV) { const int nb = r % 32, n0 = nb * 32, hh = n0 >> 7, j0 = n0 & 127; const bool isv = j0 >= 64; const int drow = hh * 64 + (j0 & 63);
                p0_tr(a.in[I_WUKV], 256, 1024, (bf16_t*)(ws + (isv ? WS_WVF : WS_WKF)), (bf16_t*)(ws + (isv ? WS_WVU : WS_WKU)), a.in[I_KVN], r / 32, nb, drow - n0, scr, lane); continue; } r -= T_UKV;
            { u32x4 z = {0u, 0u, 0u, 0u}; u32x4* p = (u32x4*)((bf16_t*)(ws + WS_WIN) + (size_t)(2240 + r) * 1024); p[lane] = z; p[64 + lane] = z; }
        }
    }
    if (P0MASK & 4) {
        const int gt = vcu * 512 + tid, NT = G * 512;
        for (int i = gt; i < 32768; i += NT) { const f32x4 v = ((const f32x4*)a.in[I_CKV])[i]; u32x2 w; w.x = cvt_pk_bf16(v[0], v[1]); w.y = cvt_pk_bf16(v[2], v[3]); ((u32x2*)(ws + WS_CACHEB))[i] = w; }
    }
}

__device__ __forceinline__ f32x4 mod4(const float* modp, const float* bias, int ci, int off) {
    const float* p = modp + ci * 6144 + off;
    return ((*(const f32x4*)p + *(const f32x4*)(p + 18432)) + (*(const f32x4*)(p + 36864) + *(const f32x4*)(p + 55296))) + *(const f32x4*)(bias + off);
}
__device__ __forceinline__ void phase1(const Args& a, int wv, int vcu, int G) {
    if (PROBE_FILL == 3) { float* m = (float*)(a.ws + WS_MOD); for (int i = otid(wv); i < 3 * 6144; i += 512) { unsigned h = (unsigned)i * 2654435761u; h ^= h >> 15; h *= 2246822519u; h ^= h >> 13; m[i] = ((float)(h & 0xffff) * (1.f / 65536.f) - 0.5f) * 2.f; } __syncthreads(); }
    const int tid_ = otid(wv); const int lane = tid_ & 63, wave = tid_ >> 6; const int gw = vcu * 8 + wave, NGW = G * 8;
    const float* mod = (const float*)(a.ws + WS_MOD + PROBE_MODOFF); bf16_t* H = (bf16_t*)(a.ws + WS_H);
    for (int r = gw; r < MTOK; r += NGW * PROBE_RSTRIDE) {
        const f32x4* xr = (const f32x4*)xrow_ptr(a, r) + lane; const int ci_ = cond_of_row(r);
        f32x4 v[4]; float s = 0.f;
#pragma unroll
        for (int j = 0; j < 4; ++j) { v[j] = xr[64 * j]; s += (v[j][0] * v[j][0] + v[j][1] * v[j][1]) + (v[j][2] * v[j][2] + v[j][3] * v[j][3]); }
        const float rstd = rsqrtf(wave_sum(s) * (1.f / D) + EPS);
        u32x2* o = (u32x2*)(H + (size_t)r * D) + lane;
#pragma unroll
        for (int j = 0; j < 4; ++j) { const int c = 4 * lane + 256 * j; const f32x4 w = *(const f32x4*)(a.in[I_NATT] + c), sh = mod4(mod, a.in[I_BADA], ci_, c), scv = mod4(mod, a.in[I_BADA], ci_, 1024 + c);
            const f32x4 y = v[j] * rstd * w * (scv * PROBE_MUL + 1.f) + sh * PROBE_MUL; u32x2 p; p.x = cvt_pk_bf16(y[0], y[1]); p.y = cvt_pk_bf16(y[2], y[3]); if (PROBE_NOSTORE) { if ((p.x ^ p.y) == 0x12345u) o[64 * j] = p; } else o[64 * j] = p; }
    }
}
__device__ __forceinline__ void phase6(const Args& a, int wv, int vcu, int G) {
    const int tid_ = otid(wv); const int lane = tid_ & 63, wave = tid_ >> 6; const int gw = vcu * 8 + wave, NGW = G * 8;
    const float* mod = (const float*)(a.ws + WS_MOD); bf16_t* H = (bf16_t*)(a.ws + WS_H); float* X1 = (float*)(a.ws + WS_X1);
    const bf16_t* P0 = (const bf16_t*)(a.ws + WS_P0); const bf16_t* P1 = (const bf16_t*)(a.ws + WS_P1A);
    for (int r = gw; r < MTOK; r += NGW) {
        const f32x4* xr = (const f32x4*)xrow_ptr(a, r) + lane; const int ci_ = cond_of_row(r);
        const u32x2* p0 = (const u32x2*)(P0 + (size_t)r * D) + lane; const u32x2* p1 = (const u32x2*)(P1 + (size_t)r * D) + lane;
        f32x4 v[4]; float s = 0.f;
#pragma unroll
        for (int j = 0; j < 4; ++j) { const int c = 4 * lane + 256 * j; const f32x4 gt = mod4(mod, a.in[I_BADA], ci_, 2048 + c);
            { const u32x2 qa = p0[64 * j], qb = p1[64 * j]; const f32x4 ps = {bflo(qa.x) + bflo(qb.x), bfhi(qa.x) + bfhi(qb.x), bflo(qa.y) + bflo(qb.y), bfhi(qa.y) + bfhi(qb.y)}; v[j] = xr[64 * j] + gt * ps; } s += (v[j][0] * v[j][0] + v[j][1] * v[j][1]) + (v[j][2] * v[j][2] + v[j][3] * v[j][3]); }
        const float rstd = rsqrtf(wave_sum(s) * (1.f / D) + EPS);
        u32x2* x1 = (u32x2*)((bf16_t*)X1 + (size_t)r * D) + lane; u32x2* o = (u32x2*)(H + (size_t)r * D) + lane;
#pragma unroll
        for (int j = 0; j < 4; ++j) { const int c = 4 * lane + 256 * j; { u32x2 xw; xw.x = cvt_pk_bf16(v[j][0], v[j][1]); xw.y = cvt_pk_bf16(v[j][2], v[j][3]); x1[64 * j] = xw; }
            const f32x4 w = *(const f32x4*)(a.in[I_NFFN] + c), sh = mod4(mod, a.in[I_BADA], ci_, 3072 + c), scv = mod4(mod, a.in[I_BADA], ci_, 4096 + c);
            const f32x4 y = v[j] * rstd * w * (scv + 1.f) + sh; u32x2 p; p.x = cvt_pk_bf16(y[0], y[1]); p.y = cvt_pk_bf16(y[2], y[3]); o[64 * j] = p; }
    }
}
__device__ __forceinline__ void phase9(const Args& a, int wv, int vcu, int G) {
    const int tid_ = otid(wv); const int lane = tid_ & 63, wave = tid_ >> 6; const int gw = vcu * 8 + wave, NGW = G * 8;
    const float* mod = (const float*)(a.ws + WS_MOD); const float* X1 = (const float*)(a.ws + WS_X1);
    const bf16_t* P0 = (const bf16_t*)(a.ws + WS_P0); const bf16_t* P1 = (const bf16_t*)(a.ws + WS_P1B);
    for (int r = gw; r < MTOK; r += NGW) {
        const u32x2* xr = (const u32x2*)((const bf16_t*)X1 + (size_t)r * D) + lane; const int ci_ = cond_of_row(r);
        const u32x2* p0 = (const u32x2*)(P0 + (size_t)r * D) + lane; const u32x2* p1 = (const u32x2*)(P1 + (size_t)r * D) + lane;
        f32x4 v[4]; float s = 0.f;
#pragma unroll
        for (int j = 0; j < 4; ++j) { const int c = 4 * lane + 256 * j; const f32x4 gt = mod4(mod, a.in[I_BADA], ci_, 5120 + c);
            { const u32x2 qa = p0[64 * j], qb = p1[64 * j]; const f32x4 ps = {bflo(qa.x) + bflo(qb.x), bfhi(qa.x) + bfhi(qb.x), bflo(qa.y) + bflo(qb.y), bfhi(qa.y) + bfhi(qb.y)}; const u32x2 xq = xr[64 * j]; const f32x4 xv = {bflo(xq.x), bfhi(xq.x), bflo(xq.y), bfhi(xq.y)}; v[j] = xv + gt * ps; } s += (v[j][0] * v[j][0] + v[j][1] * v[j][1]) + (v[j][2] * v[j][2] + v[j][3] * v[j][3]); }
        const float rstd = rsqrtf(wave_sum(s) * (1.f / D) + EPS);
        f32x4* y = (f32x4*)(a.out + O_Y + (size_t)r * D) + lane;
#pragma unroll
        for (int j = 0; j < 4; ++j) { const int c = 4 * lane + 256 * j; const f32x4 w = *(const f32x4*)(a.in[I_FN] + c); y[64 * j] = v[j] * rstd * w; }
    }
}

__device__ __forceinline__ void p3_row_extras(const Args& a, int wv, int gw, int NGW) {
    const int lane = otid(wv) & 63;
    const bf16_t* Z = (const bf16_t*)(a.ws + WS_Z); const float* rsskv = (const float*)(a.ws + WS_RSSKV);
    bf16_t* Kp = (bf16_t*)(a.ws + WS_KP); bf16_t* Ks = (bf16_t*)(a.ws + WS_KS);
    const float inv[8] = {1.f, 0.316227766f, 0.1f, 0.0316227766f, 0.01f, 0.00316227766f, 0.001f, 0.000316227766f};
    for (int r = gw; r < MTOK + 512; r += NGW) {
        if (r < MTOK) {
            const bf16_t* zr = Z + (size_t)r * ZP;
            if (r < MP) {
                const float rs = rsqrtf(pg8::rss_kv(rsskv, r) * (1.f / 256.f) + EPS);
                const u32x2 w = *(const u32x2*)(zr + C_KVLAT + 4 * lane); const f32x4 g = *(const f32x4*)(a.in[I_KVN] + 4 * lane);
                f32x4 o; o[0] = bflo(w.x) * rs * g[0]; o[1] = bfhi(w.x) * rs * g[1]; o[2] = bflo(w.y) * rs * g[2]; o[3] = bfhi(w.y) * rs * g[3];
                *(f32x4*)(a.out + O_KV + (size_t)r * 256 + 4 * lane) = o;
            }
            const int i = lane & 31;
            float v = bf2f(zr[C_KROPE + i]);
            if (r < MP && lane < 32) a.out[O_KR + (size_t)r * 32 + i] = v;
            const float pv = __shfl_xor(v, 8);
            int b, s; bf16_t* kb;
            if (r >= MP) { const int t = (r - MP) & 2047; const float pos = (float)((i < 16) ? (t >> 6) : (t & 63));
                const float rev = pos * inv[i & 7] * 0.15915494309189535f; const float rf = rev - floorf(rev);
                const float cs = __builtin_amdgcn_cosf(rf), sn = __builtin_amdgcn_sinf(rf); v = v * cs + ((i & 8) ? pv : -pv) * sn;
                b = (r - MP) >> 11; s = 256 + t; kb = Ks + ((size_t)(b * 8) * SKS + s) * 96 + 64 + i;
                const bf16_t o = f2bf(v);
                if (lane < 32) { for (int h = 0; h < 8; ++h) kb[(size_t)h * SKS * 96] = o; }
            } else { b = r >> 8; s = r & 255; kb = Kp + ((size_t)(b * 8) * 256 + s) * 96 + 64 + i; const bf16_t o = f2bf(v);
                if (lane < 32) { for (int h = 0; h < 8; ++h) kb[(size_t)h * 256 * 96] = o; } }
        } else {
            const int rr = r - MTOK, b = rr >> 8, s = rr & 255, i = lane & 31;
            const bf16_t o = f2bf(a.in[I_CKR][(size_t)rr * 32 + i]); bf16_t* kb = Ks + ((size_t)(b * 8) * SKS + s) * 96 + 64 + i;
            if (lane < 32) { for (int h = 0; h < 8; ++h) kb[(size_t)h * SKS * 96] = o; }
        }
    }
}

constexpr int GL_LOW = 0, GL_WG = 8192, GL_BG = 16384, GL_SEG = 16896, GL_RED = 20992, GL_VT = 22528, GL_QF = 40960, GL_KF = GL_QF + 9216, GL_QB = GL_KF + 9216, GL_KB = GL_QB + 9216;
constexpr int GROW = 144;

__device__ __forceinline__ void gla_gates(const Args& a, int wv, LAS unsigned char* lds, int r0, int h, float (&cumF)[8], float (&cumB)[8], float& totF, float& totB) {
    const int tid = otid(wv), d = tid & 63, tg = tid >> 6;
    const bf16_t* Z = (const bf16_t*)(a.ws + WS_Z);
    LAS float* low = (LAS float*)(lds + GL_LOW); LAS float* wg = (LAS float*)(lds + GL_WG); LAS float* bg = (LAS float*)(lds + GL_BG); LAS float* seg = (LAS float*)(lds + GL_SEG);
    { const int t = tid >> 3, r4 = (tid & 7) * 4; const u32x2 w = *(const u32x2*)(Z + (size_t)(r0 + t) * ZP + C_GFL + r4);
      low[t * 32 + r4] = bflo(w.x); low[t * 32 + r4 + 1] = bfhi(w.x); low[t * 32 + r4 + 2] = bflo(w.y); low[t * 32 + r4 + 3] = bfhi(w.y); }
    { const int dir = tid >> 8, r = (tid >> 4) & 15, d4 = (tid & 15) * 4; const f32x4 w = *(const f32x4*)(a.in[dir ? I_WGB : I_WGF] + r * 256 + h * 64 + d4);
      *(LAS f32x4*)(wg + (dir * 16 + r) * 64 + d4) = w; }
    if (tid < 128) { const int dir = tid >> 6; bg[tid] = a.in[dir ? I_BGB : I_BGF][h * 64 + (tid & 63)]; }
    __syncthreads();
    float wf[16], wb[16];
#pragma unroll
    for (int r = 0; r < 16; ++r) { wf[r] = wg[r * 64 + d]; wb[r] = wg[(16 + r) * 64 + d]; }
    const float bf_ = bg[d], bb_ = bg[64 + d];
    float gf[8], gb[8];
#pragma unroll
    for (int i = 0; i < 8; ++i) { const int t = tg * 8 + i; float xf = bf_, xb = bb_;
#pragma unroll
        for (int r = 0; r < 16; ++r) { xf += low[t * 32 + r] * wf[r]; xb += low[t * 32 + 16 + r] * wb[r]; }
        gf[i] = logsigmoid_f(xf) * (1.f / 16.f); gb[i] = logsigmoid_f(xb) * (1.f / 16.f); }
#pragma unroll
    for (int i = 1; i < 8; ++i) gf[i] += gf[i - 1];
#pragma unroll
    for (int i = 6; i >= 0; --i) gb[i] += gb[i + 1];
    seg[tg * 64 + d] = gf[7]; seg[512 + tg * 64 + d] = gb[0];
    __syncthreads();
    float offF = 0.f, offB = 0.f; totF = 0.f; totB = 0.f;
#pragma unroll
    for (int g = 0; g < 8; ++g) { const float sf = seg[g * 64 + d], sb = seg[512 + g * 64 + d]; totF += sf; totB += sb; if (g < tg) offF += sf; if (g > tg) offB += sb; }
#pragma unroll
    for (int i = 0; i < 8; ++i) { cumF[i] = gf[i] + offF; cumB[i] = gb[i] + offB; }
}
__device__ __forceinline__ void gla_load_vT(const Args& a, int wv, LAS unsigned char* lds, int r0, int h) {
    const int tid = otid(wv), e = tid & 127, tq = tid >> 7;
    const bf16_t* Z = (const bf16_t*)(a.ws + WS_Z) + (size_t)r0 * ZP + C_GV + h * 128 + e;
    unsigned w[8];
#pragma unroll
    for (int i = 0; i < 8; ++i) { const unsigned lo = Z[(size_t)(tq * 16 + 2 * i) * ZP], hi = Z[(size_t)(tq * 16 + 2 * i + 1) * ZP]; w[i] = lo | (hi << 16); }
    LAS u32x4* p = (LAS u32x4*)(lds + GL_VT + e * GROW + tq * 32);
    p[0] = (u32x4){w[0], w[1], w[2], w[3]}; p[1] = (u32x4){w[4], w[5], w[6], w[7]};
}

__device__ __forceinline__ void gla_stepA(const Args& a, int wv, LAS unsigned char* lds, int u) {
    const int tid = otid(wv), lane = tid & 63, wave = __builtin_amdgcn_readfirstlane(tid >> 6), d = tid & 63, tg = tid >> 6, fr = lane & 15, fq = lane >> 4;
    const int cgi = u >> 2, h = u & 3, r0 = cgi * 64;
    const bf16_t* Z = (const bf16_t*)(a.ws + WS_Z);
    float cumF[8], cumB[8], totF, totB;
    gla_gates(a, wv, lds, r0, h, cumF, cumB, totF, totB);
    unsigned kf[4], kb[4];
#pragma unroll
    for (int i = 0; i < 4; ++i) { const float k0 = bf2f(Z[(size_t)(r0 + tg * 8 + 2 * i) * ZP + C_GK + h * 64 + d]), k1 = bf2f(Z[(size_t)(r0 + tg * 8 + 2 * i + 1) * ZP + C_GK + h * 64 + d]);
        kf[i] = cvt_pk_bf16(k0 * __expf(totF - cumF[2 * i]), k1 * __expf(totF - cumF[2 * i + 1]));
        kb[i] = cvt_pk_bf16(k0 * __expf(totB - cumB[2 * i]), k1 * __expf(totB - cumB[2 * i + 1])); }
    *(LAS u32x4*)(lds + GL_QF + d * GROW + tg * 16) = (u32x4){kf[0], kf[1], kf[2], kf[3]};
    *(LAS u32x4*)(lds + GL_KF + d * GROW + tg * 16) = (u32x4){kb[0], kb[1], kb[2], kb[3]};
    gla_load_vT(a, wv, lds, r0, h);
    if (tg == 0) { float* dec = (float*)(a.ws + WS_DEC) + (size_t)u * 128; dec[d] = __expf(totF); dec[64 + d] = __expf(totB); }
    __syncthreads();
    const int dir = wave >> 2, eb0 = 2 * (wave & 3);
    const LAS unsigned char* kd = lds + (dir ? GL_KF : GL_QF);
    float* CT = (float*)(a.ws + WS_CT) + ((size_t)u * 2 + dir) * 8192;
#pragma unroll
    for (int eb = 0; eb < 2; ++eb) {
        bf16x8 vf[2];
#pragma unroll
        for (int ks = 0; ks < 2; ++ks) vf[ks] = *(const LAS bf16x8*)(lds + GL_VT + (16 * (eb0 + eb) + fr) * GROW + (32 * ks + 8 * fq) * 2);
#pragma unroll
        for (int db = 0; db < 4; ++db) { f32x4 c = {0.f, 0.f, 0.f, 0.f};
#pragma unroll
            for (int ks = 0; ks < 2; ++ks) { const bf16x8 kfr = *(const LAS bf16x8*)(kd + (16 * db + fr) * GROW + (32 * ks + 8 * fq) * 2); c = __builtin_amdgcn_mfma_f32_16x16x32_bf16(vf[ks], kfr, c, 0, 0, 0); }
#pragma unroll
            for (int j = 0; j < 4; ++j) CT[(16 * (eb0 + eb) + 4 * fq + j) * 64 + 16 * db + fr] = c[j]; }
    }
    __syncthreads();
}

__device__ __forceinline__ void gla_scan(const Args& a, int wv, int vcu, int G) {
    const int gt = vcu * 512 + otid(wv), NT = G * 512;
    float* CTb = (float*)(a.ws + WS_CT); const float* DEC = (const float*)(a.ws + WS_DEC);
    for (int it = gt; it < 32768 + 262144; it += NT) {
        int seq, N, cg0, x;
        if (it < 32768) { seq = 16 + (it >> 14); x = it & 16383; N = 32; cg0 = 64 + 32 * (seq - 16); } else { const int j = it - 32768; seq = j >> 14; x = j & 16383; N = 4; cg0 = 4 * seq; }
        const int h = x >> 12, dir = (x >> 11) & 1, e = (x >> 4) & 127, d4 = (x & 15) * 4;
        f32x4 st = {0.f, 0.f, 0.f, 0.f};
        if (seq >= 16) { const float* s0 = a.in[dir ? I_SB : I_SF] + ((size_t)((seq - 16) * 4 + h) * 64) * 128 + e;
#pragma unroll
            for (int i = 0; i < 4; ++i) st[i] = s0[(size_t)(d4 + i) * 128]; }
        if (N == 32) {
            for (int n0 = 0; n0 < 32; n0 += 8) {
                f32x4 c[8], dc[8];
#pragma unroll
                for (int i = 0; i < 8; ++i) { const int n = dir ? (31 - n0 - i) : (n0 + i); const int u = (cg0 + n) * 4 + h;
                    c[i] = *(const f32x4*)(CTb + ((size_t)u * 2 + dir) * 8192 + e * 64 + d4); dc[i] = *(const f32x4*)(DEC + (size_t)u * 128 + dir * 64 + d4); }
#pragma unroll
                for (int i = 0; i < 8; ++i) { const int n = dir ? (31 - n0 - i) : (n0 + i); const int u = (cg0 + n) * 4 + h;
                    *(f32x4*)(CTb + ((size_t)u * 2 + dir) * 8192 + e * 64 + d4) = st; st = dc[i] * st + c[i]; }
            }
        } else {
            f32x4 c[4], dc[4];
#pragma unroll
            for (int i = 0; i < 4; ++i) { const int n = dir ? (3 - i) : i; const int u = (cg0 + n) * 4 + h;
                c[i] = *(const f32x4*)(CTb + ((size_t)u * 2 + dir) * 8192 + e * 64 + d4); dc[i] = *(const f32x4*)(DEC + (size_t)u * 128 + dir * 64 + d4); }
#pragma unroll
            for (int i = 0; i < 4; ++i) { const int n = dir ? (3 - i) : i; const int u = (cg0 + n) * 4 + h;
                *(f32x4*)(CTb + ((size_t)u * 2 + dir) * 8192 + e * 64 + d4) = st; st = dc[i] * st + c[i]; }
        }
        if (seq < 16) { float* o = a.out + (dir ? O_SB : O_SF) + ((size_t)(seq * 4 + h) * 64) * 128 + e;
#pragma unroll
            for (int i = 0; i < 4; ++i) o[(size_t)(d4 + i) * 128] = st[i]; }
    }
}

__device__ __forceinline__ void gla_stepC(const Args& a, int wv, LAS unsigned char* lds, int u) {
    const int tid = otid(wv), lane = tid & 63, wave = __builtin_amdgcn_readfirstlane(tid >> 6), d = tid & 63, tg = tid >> 6, fr = lane & 15, fq = lane >> 4;
    const int cgi = u >> 2, h = u & 3, r0 = cgi * 64;
    const bf16_t* Z = (const bf16_t*)(a.ws + WS_Z);
    float cumF[8], cumB[8], totF, totB;
    gla_gates(a, wv, lds, r0, h, cumF, cumB, totF, totB);
#pragma unroll
    for (int i = 0; i < 8; ++i) { const int t = tg * 8 + i; const float q = bf2f(Z[(size_t)(r0 + t) * ZP + C_GQ + h * 64 + d]) * 0.125f, k = bf2f(Z[(size_t)(r0 + t) * ZP + C_GK + h * 64 + d]);
        *(LAS bf16_t*)(lds + GL_QF + t * GROW + d * 2) = f2bf(q * __expf(cumF[i]));
        *(LAS bf16_t*)(lds + GL_KF + t * GROW + d * 2) = f2bf(k * __expf(-cumF[i]));
        *(LAS bf16_t*)(lds + GL_QB + t * GROW + d * 2) = f2bf(q * __expf(cumB[i]));
        *(LAS bf16_t*)(lds + GL_KB + t * GROW + d * 2) = f2bf(k * __expf(-cumB[i])); }
    gla_load_vT(a, wv, lds, r0, h);
    __syncthreads();
    const int ch = wave & 1, eq = wave >> 1;
    f32x4 oT[2][2];
#pragma unroll
    for (int i = 0; i < 2; ++i)
#pragma unroll
        for (int j = 0; j < 2; ++j) oT[i][j] = (f32x4){0.f, 0.f, 0.f, 0.f};
#pragma unroll
    for (int dir = 0; dir < 2; ++dir) {
        const LAS unsigned char* qe = lds + (dir ? GL_QB : GL_QF); const LAS unsigned char* ke = lds + (dir ? GL_KB : GL_KF);
        const float* ST = (const float*)(a.ws + WS_CT) + ((size_t)u * 2 + dir) * 8192;
        bf16x8 sf[2][2];
#pragma unroll
        for (int eb = 0; eb < 2; ++eb)
#pragma unroll
            for (int ks = 0; ks < 2; ++ks) { const float* p = ST + (16 * (2 * eq + eb) + fr) * 64 + 32 * ks + 8 * fq; const f32x4 x0 = *(const f32x4*)p, x1 = *(const f32x4*)(p + 4);
                u32x4 w; w.x = cvt_pk_bf16(x0[0], x0[1]); w.y = cvt_pk_bf16(x0[2], x0[3]); w.z = cvt_pk_bf16(x1[0], x1[1]); w.w = cvt_pk_bf16(x1[2], x1[3]); sf[eb][ks] = __builtin_bit_cast(bf16x8, w); }
#pragma unroll
        for (int cb = 0; cb < 2; ++cb) {
            const int cbg = 2 * ch + cb;
            bf16x8 qf[2];
#pragma unroll
            for (int ks = 0; ks < 2; ++ks) qf[ks] = *(const LAS bf16x8*)(qe + (16 * cbg + fr) * GROW + (32 * ks + 8 * fq) * 2);
            f32x4 att[4];
#pragma unroll
            for (int sb = 0; sb < 4; ++sb) {
                f32x4 acc = {0.f, 0.f, 0.f, 0.f};
                const bool need = dir == 0 ? (sb <= cbg) : (sb >= cbg);
                if (need) {
#pragma unroll
                    for (int ks = 0; ks < 2; ++ks) { const bf16x8 kfr = *(const LAS bf16x8*)(ke + (16 * sb + fr) * GROW + (32 * ks + 8 * fq) * 2); acc = __builtin_amdgcn_mfma_f32_16x16x32_bf16(kfr, qf[ks], acc, 0, 0, 0); }
                    if (sb == cbg) {
#pragma unroll
                        for (int j = 0; j < 4; ++j) { const int sl = 4 * fq + j; const bool keep = dir == 0 ? (sl <= fr) : (sl >= fr); acc[j] = keep ? acc[j] : 0.f; } }
                }
                att[sb] = acc;
            }
#pragma unroll
            for (int kp = 0; kp < 2; ++kp) {
                u32x4 w; w.x = cvt_pk_bf16(att[2 * kp][0], att[2 * kp][1]); w.y = cvt_pk_bf16(att[2 * kp][2], att[2 * kp][3]); w.z = cvt_pk_bf16(att[2 * kp + 1][0], att[2 * kp + 1][1]); w.w = cvt_pk_bf16(att[2 * kp + 1][2], att[2 * kp + 1][3]);
                const bf16x8 pb = __builtin_bit_cast(bf16x8, w);
#pragma unroll
                for (int eb = 0; eb < 2; ++eb) { const LAS unsigned char* vp = lds + GL_VT + (16 * (2 * eq + eb) + fr) * GROW + (32 * kp + 4 * fq) * 2;
                    const u32x2 v0 = *(const LAS u32x2*)vp, v1 = *(const LAS u32x2*)(vp + 32); const u32x4 vv = {v0.x, v0.y, v1.x, v1.y};
                    oT[eb][cb] = __builtin_amdgcn_mfma_f32_16x16x32_bf16(__builtin_bit_cast(bf16x8, vv), pb, oT[eb][cb], 0, 0, 0); }
            }
#pragma unroll
            for (int ks = 0; ks < 2; ++ks)
#pragma unroll
                for (int eb = 0; eb < 2; ++eb) oT[eb][cb] = __builtin_amdgcn_mfma_f32_16x16x32_bf16(sf[eb][ks], qf[ks], oT[eb][cb], 0, 0, 0);
        }
    }
    LAS float* red = (LAS float*)(lds + GL_RED);
#pragma unroll
    for (int cb = 0; cb < 2; ++cb) { float s = 0.f;
#pragma unroll
        for (int eb = 0; eb < 2; ++eb)
#pragma unroll
            for (int j = 0; j < 4; ++j) s += oT[eb][cb][j] * oT[eb][cb][j];
        s += __shfl_xor(s, 16); s += __shfl_xor(s, 32);
        if (fq == 0) red[eq * 64 + 16 * (2 * ch + cb) + fr] = s; }
    __syncthreads();
    bf16_t* MIX = (bf16_t*)(a.ws + WS_MIX);
#pragma unroll
    for (int cb = 0; cb < 2; ++cb) { const int c = 16 * (2 * ch + cb) + fr; const float tot = red[c] + red[64 + c] + red[128 + c] + red[192 + c]; const float rstd = rsqrtf(tot * (1.f / 128.f) + EPS);
#pragma unroll
        for (int eb = 0; eb < 2; ++eb) { const int e = 16 * (2 * eq + eb) + 4 * fq; const f32x4 gn = *(const f32x4*)(a.in[I_GLAN] + e);
            const u32x2 gw = *(const u32x2*)(Z + (size_t)(r0 + c) * ZP + C_GOUT + h * 128 + e);
            const float g0 = bflo(gw.x), g1 = bfhi(gw.x), g2 = bflo(gw.y), g3 = bfhi(gw.y);
            const f32x4 o = oT[eb][cb] * rstd * gn; u32x2 w; w.x = cvt_pk_bf16(o[0] * silu_f(g0), o[1] * silu_f(g1)); w.y = cvt_pk_bf16(o[2] * silu_f(g2), o[3] * silu_f(g3));
            *(u32x2*)(MIX + (size_t)(r0 + c) * D + 512 + h * 128 + e) = w; } }
    __syncthreads();
}

constexpr int AT_KROW = 208, AT_VROW = 144, AT_KB = 64 * AT_KROW  , AT_STAGE = AT_KB + 64 * AT_VROW  ;
__device__ __forceinline__ void attn_unit(const Args& a, int wv, LAS unsigned char* lds, int idx) {
    const int tid = otid(wv), lane = tid & 63, wave = __builtin_amdgcn_readfirstlane(tid >> 6), fr = lane & 15, fq = lane >> 4;
    int row0, S, nt; const bf16_t* Kb; const bf16_t* Vb; int h;
    if (idx < 256) { const int b = idx >> 7, qb = idx & 15; h = (idx >> 4) & 7; row0 = MP + b * 2048 + qb * 128; S = SKS; nt = 36;
        Kb = (const bf16_t*)(a.ws + WS_KS) + (size_t)(b * 8 + h) * SKS * 96; Vb = (const bf16_t*)(a.ws + WS_VTS) + (size_t)(b * 8 + h) * 64 * SKS; }
    else { const int j = idx - 256; const int b = j >> 4, qb = j & 1; h = (j >> 1) & 7; row0 = b * 256 + qb * 128; S = 256; nt = 4;
        Kb = (const bf16_t*)(a.ws + WS_KP) + (size_t)(b * 8 + h) * 256 * 96; Vb = (const bf16_t*)(a.ws + WS_VTP) + (size_t)(b * 8 + h) * 64 * 256; }
    const char* src[3]; unsigned step[3]; unsigned dst[3]; bool valid[3];
#pragma unroll
    for (int j = 0; j < 3; ++j) { const int ins = wave + 8 * j; valid[j] = ins < 22;
        if (ins < 13) { const int ck = ins * 64 + lane, r = ck / 13, cc = ck % 13; src[j] = (const char*)Kb + (size_t)r * 192 + (cc < 12 ? cc : 11) * 16; step[j] = 64 * 192; dst[j] = ins * 1024; }
        else { const int cv = (ins - 13) * 64 + lane, r = cv / 9, cc = cv % 9; src[j] = (const char*)Vb + (size_t)r * S * 2 + (cc < 8 ? cc : 7) * 16; step[j] = 128; dst[j] = AT_KB + (ins - 13) * 1024; } }
#define AT_ISSUE(t, buf) do { _Pragma("unroll") for (int j = 0; j < 3; ++j) if (valid[j]) \
        __builtin_amdgcn_global_load_lds((const unsigned*)(src[j] + (size_t)(t) * step[j]), (LAS unsigned*)(lds + (buf) * AT_STAGE + dst[j]), 16, 0, 0); } while (0)
    AT_ISSUE(0, 0);
    const bf16_t* Q = (const bf16_t*)(a.ws + WS_Q) + (size_t)(row0 + wave * 16 + fr) * 768 + h * 96 + 8 * fq;
    bf16x8 qf[3];
#pragma unroll
    for (int ks = 0; ks < 3; ++ks) qf[ks] = *(const bf16x8*)(Q + 32 * ks);
    float mrun = -1e30f, lsum = 0.f;
    f32x4 o[4];
#pragma unroll
    for (int i = 0; i < 4; ++i) o[i] = (f32x4){0.f, 0.f, 0.f, 0.f};
    for (int t = 0; t < nt; ++t) {
        VM_WAIT(); __syncthreads();
        if (t + 1 < nt) AT_ISSUE(t + 1, (t + 1) & 1);
        const LAS unsigned char* kt = lds + (t & 1) * AT_STAGE; const LAS unsigned char* vt = kt + AT_KB;
        f32x4 s[4];
#pragma unroll
        for (int kb = 0; kb < 4; ++kb) { s[kb] = (f32x4){0.f, 0.f, 0.f, 0.f};
#pragma unroll
            for (int ks = 0; ks < 3; ++ks) { const bf16x8 kf = *(const LAS bf16x8*)(kt + (16 * kb + fr) * AT_KROW + (32 * ks + 8 * fq) * 2); s[kb] = __builtin_amdgcn_mfma_f32_16x16x32_bf16(kf, qf[ks], s[kb], 0, 0, 0); } }
        float mx = fmaxf(fmaxf(fmaxf(s[0][0], s[0][1]), fmaxf(s[0][2], s[0][3])), fmaxf(fmaxf(s[1][0], s[1][1]), fmaxf(s[1][2], s[1][3])));
        mx = fmaxf(mx, fmaxf(fmaxf(fmaxf(s[2][0], s[2][1]), fmaxf(s[2][2], s[2][3])), fmaxf(fmaxf(s[3][0], s[3][1]), fmaxf(s[3][2], s[3][3]))));
        { const float m1 = __shfl_xor(mx, 16), m2 = __shfl_xor(mx, 32), m3 = __shfl_xor(mx, 48); mx = fmaxf(fmaxf(mx, m1), fmaxf(m2, m3)); }
        const float mnew = fmaxf(mrun, mx);
        f32x4 psv = {0.f, 0.f, 0.f, 0.f};
#pragma unroll
        for (int kb = 0; kb < 4; ++kb) { s[kb] = s[kb] - mnew;
#pragma unroll
            for (int j = 0; j < 4; ++j) s[kb][j] = __builtin_amdgcn_exp2f(s[kb][j]);
            psv += s[kb]; }
        const float ps = (psv[0] + psv[1]) + (psv[2] + psv[3]);
        if (__builtin_amdgcn_ballot_w64(mnew != mrun) != 0ull) {
            const float alpha = __builtin_amdgcn_exp2f(mrun - mnew); mrun = mnew; lsum *= alpha;
#pragma unroll
            for (int i = 0; i < 4; ++i) o[i] = o[i] * alpha;
        }
        lsum += ps;
#pragma unroll
        for (int kp = 0; kp < 2; ++kp) {
            u32x4 w; w.x = cvt_pk_bf16(s[2 * kp][0], s[2 * kp][1]); w.y = cvt_pk_bf16(s[2 * kp][2], s[2 * kp][3]); w.z = cvt_pk_bf16(s[2 * kp + 1][0], s[2 * kp + 1][1]); w.w = cvt_pk_bf16(s[2 * kp + 1][2], s[2 * kp + 1][3]);
            const bf16x8 pb = __builtin_bit_cast(bf16x8, w);
#pragma unroll
            for (int mb = 0; mb < 4; ++mb) { const LAS unsigned char* vp = vt + (16 * mb + fr) * AT_VROW + (32 * kp + 4 * fq) * 2;
                const u32x2 v0 = *(const LAS u32x2*)vp, v1 = *(const LAS u32x2*)(vp + 32); const u32x4 vv = {v0.x, v0.y, v1.x, v1.y};
                o[mb] = __builtin_amdgcn_mfma_f32_16x16x32_bf16(__builtin_bit_cast(bf16x8, vv), pb, o[mb], 0, 0, 0); }
        }
    }
    lsum += __shfl_xor(lsum, 16); lsum += __shfl_xor(lsum, 32);
    const float il = fast_rcp(lsum);
    bf16_t* MIX = (bf16_t*)(a.ws + WS_MIX) + (size_t)(row0 + wave * 16 + fr) * D + h * 64 + 4 * fq;
#pragma unroll
    for (int mb = 0; mb < 4; ++mb) { u32x2 w; w.x = cvt_pk_bf16(o[mb][0] * il, o[mb][1] * il); w.y = cvt_pk_bf16(o[mb][2] * il, o[mb][3] * il); *(u32x2*)(MIX + 16 * mb) = w; }
    __syncthreads();
#undef AT_ISSUE
}

__device__ unsigned g_bar[64 * 52];
#define GB(i) (g_bar + 64 * (i))
__device__ __forceinline__ unsigned gb_ld(unsigned* p) { return __hip_atomic_load(p, __ATOMIC_RELAXED, __HIP_MEMORY_SCOPE_AGENT); }
__device__ __forceinline__ unsigned gb_add(unsigned* p, unsigned v) { return __hip_atomic_fetch_add(p, v, __ATOMIC_RELAXED, __HIP_MEMORY_SCOPE_AGENT); }
__device__ __forceinline__ unsigned xcc_id() { return (unsigned)__builtin_amdgcn_s_getreg((3 << 11) | 20) & 0xFu; }
__device__ __forceinline__ void my_grid_barrier(unsigned nth, unsigned G, int tid, LAS unsigned* st) {
    asm volatile("s_waitcnt vmcnt(0) lgkmcnt(0)" ::: "memory");
    __syncthreads();
    if (tid == 0) {
        if (nth == 1u) {
            const unsigned x = xcc_id(); unsigned sum, cnt, mine;
            for (;;) { sum = 0u; cnt = 0u; mine = 0u;
#pragma unroll
                for (unsigned j = 0; j < 16; ++j) { const unsigned c = gb_ld(GB(4 + j)); sum += c; cnt += (c > 0u) ? 1u : 0u; mine = (j == x) ? c : mine; }
                if (sum >= G) break; __builtin_amdgcn_s_sleep(1); }
            st[0] = mine; st[1] = cnt; st[2] = x;
        }
        const unsigned nloc = st[0], nx = st[1], x = st[2];
        const unsigned old = gb_add(GB(20 + x), 1u);
        if (old + 1u == nth * nloc) {
            __builtin_amdgcn_fence(__ATOMIC_RELEASE, "agent");
            asm volatile("s_waitcnt vmcnt(0)" ::: "memory");
            const unsigned og = gb_add(GB(1), 1u);
            if (og + 1u == nth * nx) gb_add(GB(2), 1u);
            else while (gb_ld(GB(2)) < nth) __builtin_amdgcn_s_sleep(1);
            __builtin_amdgcn_fence(__ATOMIC_ACQUIRE, "agent");
            gb_add(GB(36 + x), 1u);
            asm volatile("s_waitcnt vmcnt(0)" ::: "memory");
        } else {
            while (gb_ld(GB(36 + x)) < nth) __builtin_amdgcn_s_sleep(1);
            __builtin_amdgcn_fence(__ATOMIC_ACQUIRE, "agent");
            asm volatile("s_waitcnt vmcnt(0)" ::: "memory");
        }
    }
    __syncthreads();
}
__device__ __forceinline__ void my_grid_barrier_finish(unsigned G, int tid) {
    if (tid == 0) {
        const unsigned old = gb_add(GB(0), 1u);
        if (old == G - 1u) { for (int i = 0; i < 52; ++i) __hip_atomic_store(GB(i), 0u, __ATOMIC_RELAXED, __HIP_MEMORY_SCOPE_AGENT); }
    }
}
constexpr int NPHASE = 11;
__global__ void __launch_bounds__(512, 2) mk_fwd(Args a) {
    const int wv = __builtin_amdgcn_readfirstlane((int)threadIdx.x >> 6);
    extern __shared__ __attribute__((aligned(16))) unsigned char lds_raw[];
    LAS unsigned char* lds = (LAS unsigned char*)lds_raw;
    const int G = gridDim.x, bx = blockIdx.x;
    const int vcu = (G % 8 == 0) ? (bx % 8) * (G / 8) + bx / 8 : bx;
    unsigned char* ws = a.ws;
    const int lo = a.ph_lo, hi = a.ph_hi;
#ifndef PHMASK
#define PHMASK 0x7ff
#endif
#define IN(k) (((PHMASK >> (k)) & 1) && lo <= (k) && (k) < hi)
#define SEAM(k) do { if (IN(k) && IN((k) + 1)) { ++nbar; my_grid_barrier(nbar, (unsigned)G, otid(wv), (LAS unsigned*)(lds + LDS_BYTES - 64)); } } while (0)
#ifndef PROBE_FILL
#define PROBE_FILL 0
#endif
    if (PROBE_FILL && lo == 0) { f32x4* p = (f32x4*)a.ws; const size_t n = (size_t)(PROBE_FILL_MIB) << 16; const float fv = PROBE_FILL_VAL;
        for (size_t i = (size_t)bx * 512 + threadIdx.x; i < n; i += (size_t)G * 512) { unsigned h = (unsigned)i * 2654435761u; h ^= h >> 15; h *= 2246822519u; h ^= h >> 13; const float r0 = (float)(h & 0xffff) * (1.f / 65536.f) - 0.5f + fv * 0.f; p[i] = (f32x4){r0, r0 * 1.7f, r0 * -0.3f, r0 + 0.1f}; } }
    if (PROBE_FILL == 2 && lo == 0 && bx == 0) { static const int szs[26] = {4194304, 4194304, 131072, 16384, 65536, 65536, 2048, 1024, 6291456, 6144, 1024, 2293760, 384, 294912, 256, 262144, 4096, 256, 4096, 256, 128, 1048576, 1024, 5767168, 2883584, 1024};
        float sm = 0.f; for (int i = 0; i < 26; ++i) { const int n = szs[i]; const int st = n > 1024 ? n - 1024 : 0; for (int j = st + (int)threadIdx.x; j < n; j += 512) sm += a.in[i][j]; for (int j = threadIdx.x; j < (n < 1024 ? n : 1024); j += 512) sm += a.in[i][j]; }
        ((float*)(a.ws))[threadIdx.x] = sm; }
    if (PROBE_FILL == 5 && lo == 0) { volatile float* p = (volatile float*)a.ws; const float big = p[0] * 0.f + 1e38f, tiny = p[1] * 0.f + 1e-38f, zero = p[2] * 0.f, neg = p[3] * 0.f - 1.f;
        float r = 0.f;
#if PROBE_EXC & 1
        r += big * big;
#endif
#if PROBE_EXC & 2
        r += tiny * tiny;
#endif
#if PROBE_EXC & 4
        r += 1.f / zero;
#endif
#if PROBE_EXC & 8
        r += __builtin_sqrtf(neg);
#endif
        p[4 + bx] = r; }
    unsigned nbar = 0;
    if (otid(wv) == 0) gb_add(GB(4 + xcc_id()), 1u);
    if (IN(0)) { for (int rep = 0; rep < PROBE_P0_REP; ++rep) { phase0(a, wv, lds, vcu, G); __syncthreads(); } } SEAM(0);
    if (IN(1)) { for (int rep = 0; rep < PROBE_ROW_REP; ++rep) phase1(a, wv, vcu, G); } SEAM(1);
    if (PROBE_HANG && lo == 1) { volatile unsigned* q = (volatile unsigned*)(a.ws + 8); while (*q != 0x12345678u) __builtin_amdgcn_s_sleep(20); }
    if (IN(2)) {
        pg8::Gemm g{(const bf16_t*)(ws + WS_H), (const bf16_t*)(ws + WS_WIN), D, D, D, wv}; pg8::Order S; S.init(MTOK, 2048, 1, G, bx);
        pg8::EpiZ E{(bf16_t*)(ws + WS_Z), (float*)(ws + WS_RSSQ), (float*)(ws + WS_RSSKV), 0};
        pg8::gemm_phase<pg8::EpiZ, pg8::Order>(lds, g, S, E);
    } SEAM(2);
    if (IN(3)) {
#ifndef P3MASK
#define P3MASK 0x3f
#endif
#if (P3MASK >> 0) & 1
        { pg8::Gemm g{(const bf16_t*)(ws + WS_Z) + C_QLAT, (const bf16_t*)(ws + WS_WUQ), ZP, 384, 384, wv}; pg8::Order S; S.init(MTOK, 768, 1, G, bx);
          pg8::EpiQ E{(bf16_t*)(ws + WS_Q), (const float*)(ws + WS_RSSQ)}; pg8::gemm_phase<pg8::EpiQ, pg8::Order>(lds, g, S, E); }
#endif
#if (P3MASK >> 1) & 1
        { pg8::Gemm g{(const bf16_t*)(ws + WS_Z) + C_KVLAT, (const bf16_t*)(ws + WS_WKF), ZP, 256, 256, wv}; pg8::Order S; S.init(MTOK, 512, 1, G, (bx + G - 96) % G);
          pg8::EpiK E{(bf16_t*)(ws + WS_KP), (bf16_t*)(ws + WS_KS), (const float*)(ws + WS_RSSKV), 0}; pg8::gemm_phase<pg8::EpiK, pg8::Order>(lds, g, S, E); }
#endif
#if (P3MASK >> 2) & 1
        { pg8::Gemm g{(const bf16_t*)(ws + WS_WVF), (const bf16_t*)(ws + WS_Z) + C_KVLAT, 256, ZP, 256, wv}; pg8::Order S; S.init(512, MTOK, 1, G, (bx + G - 160) % G);
          pg8::EpiVt E{(bf16_t*)(ws + WS_VTP), (bf16_t*)(ws + WS_VTS), (const float*)(ws + WS_RSSKV), 0}; pg8::gemm_phase<pg8::EpiVt, pg8::Order>(lds, g, S, E); }
#endif
        { pg8::Gemm g{(const bf16_t*)(ws + WS_H), (const bf16_t*)(ws + WS_WIN) + (size_t)2048 * D, D, D, D, wv}; pg8::Order S; S.init(MTOK, 256, 1, G, (bx + G - 224) % G);
          pg8::EpiZ E{(bf16_t*)(ws + WS_Z), (float*)(ws + WS_RSSQ), (float*)(ws + WS_RSSKV), 8}; pg8::gemm_phase<pg8::EpiZ, pg8::Order>(lds, g, S, E); }
#if (P3MASK >> 3) & 1
        { pg8::Gemm g{(const bf16_t*)(ws + WS_CACHEB), (const bf16_t*)(ws + WS_WKU), 256, 256, 256, wv}; pg8::Order S; S.init(512, 512, 1, G, (bx + G - 224) % G);
          pg8::EpiK E{(bf16_t*)(ws + WS_KP), (bf16_t*)(ws + WS_KS), (const float*)(ws + WS_RSSKV), 1}; pg8::gemm_phase<pg8::EpiK, pg8::Order>(lds, g, S, E); }
#endif
#if (P3MASK >> 4) & 1
        { pg8::Gemm g{(const bf16_t*)(ws + WS_WVU), (const bf16_t*)(ws + WS_CACHEB), 256, 256, 256, wv}; pg8::Order S; S.init(512, 512, 1, G, (bx + G - 228) % G);
          pg8::EpiVt E{(bf16_t*)(ws + WS_VTP), (bf16_t*)(ws + WS_VTS), (const float*)(ws + WS_RSSKV), 1}; pg8::gemm_phase<pg8::EpiVt, pg8::Order>(lds, g, S, E); }
#endif
        __syncthreads();
        if (bx < 224) {
            for (int u = bx; u < 512; u += 224) gla_stepA(a, wv, lds, u);
            p3_row_extras(a, wv, bx * 8 + (otid(wv) >> 6), 224 * 8);
        }
    } SEAM(3);
    if (IN(4)) { gla_scan(a, wv, vcu, G); } SEAM(4);
    if (IN(5)) {
        for (int rep = 0; rep < PROBE_ATT_REP; ++rep) for (int u = vcu; u < 512; u += G) attn_unit(a, wv, lds, u);
        for (int rep = 0; rep < PROBE_GLAC_REP; ++rep) for (int u = vcu; u < 512; u += G) gla_stepC(a, wv, lds, u);
    } SEAM(5);
    if (IN(6)) {
        pg8::Gemm g{(const bf16_t*)(ws + WS_MIX), (const bf16_t*)(ws + WS_WOUT), D, D, PROBE_K6, wv}; pg8::Order S; S.init(MTOK, D, 1024 / PROBE_K6, G, bx);
        pg8::EpiPart E{(bf16_t*)(ws + WS_P0), (bf16_t*)(ws + WS_P1A)}; pg8::gemm_phase<pg8::EpiPart, pg8::Order>(lds, g, S, E);
    } SEAM(6);
    if (IN(7)) { for (int rep = 0; rep < PROBE_ROW_REP; ++rep) phase6(a, wv, vcu, G); } SEAM(7);
    if (IN(8)) {
        pg8::Gemm g{(const bf16_t*)(ws + WS_H), (const bf16_t*)(ws + WS_WFFI), D, D, D, wv}; pg8::Order S; S.init(MTOK, 2 * DFF, 1, G, bx);
        pg8::EpiFFI E{(bf16_t*)(ws + WS_HFF)}; for (int rep = 0; rep < PROBE_FFI_REP; ++rep) pg8::gemm_phase<pg8::EpiFFI, pg8::Order>(lds, g, S, E);
    } SEAM(8);
    if (IN(9)) {
        pg8::Gemm g{(const bf16_t*)(ws + WS_HFF), (const bf16_t*)(ws + WS_WFFO), DFF, DFF, DFF / 2, wv}; pg8::Order S; S.init(MTOK, D, 2, G, bx);
        pg8::EpiPart E{(bf16_t*)(ws + WS_P0), (bf16_t*)(ws + WS_P1B)}; pg8::gemm_phase<pg8::EpiPart, pg8::Order>(lds, g, S, E);
    } SEAM(9);
    if (IN(10)) { for (int rep = 0; rep < PROBE_ROW_REP; ++rep) phase9(a, wv, vcu, G); }
    if (PROBE_DUMP) {
        if (PROBE_DUMP != 5 && PROBE_DUMP != 7) { ++nbar; } if (PROBE_DUMP != 5 && PROBE_DUMP != 7) my_grid_barrier(nbar, (unsigned)G, otid(wv), (LAS unsigned*)(lds + LDS_BYTES - 64));
        const bf16_t* src = (const bf16_t*)(ws + (PROBE_DUMP == 1 ? WS_Z : PROBE_DUMP == 2 ? WS_MIX : WS_H)); const int pitch = PROBE_DUMP == 1 ? ZP : D;
        for (size_t i = (size_t)bx * 512 + otid(wv); i < (size_t)MTOK * D; i += (size_t)G * 512) { const int r = (int)(i >> 10), c = (int)(i & 1023); a.out[i] = PROBE_DUMP == 7 ? 1.0f : PROBE_DUMP == 6 ? (r < 2304 ? bf2f(((const bf16_t*)(ws + WS_WIN))[(size_t)r * 1024 + c]) : 0.f) : PROBE_DUMP >= 4 ? xrow_ptr(a, r)[c] * 2.f : bf2f(src[(size_t)r * pitch + c]); }
        for (size_t i = O_KV + (size_t)bx * 512 + otid(wv); i < 10616832; i += (size_t)G * 512) a.out[i] = 0.f;
    }
    for (int xb = 0; xb < PROBE_XBAR; ++xb) { ++nbar; my_grid_barrier(nbar, (unsigned)G, otid(wv), (LAS unsigned*)(lds + LDS_BYTES - 64)); }
    if (nbar) my_grid_barrier_finish((unsigned)G, otid(wv));
#undef IN
#undef SEAM
}

extern "C" void kernel_launch(void* const* d_in, const int* in_sizes, int n_in, void* d_out, int out_size, void* d_ws, size_t ws_size, hipStream_t stream) {
    static int grid = 0;
    if (grid == 0) {
        int dev = 0, cus = 0;
        static const int exp_sizes[26] = {4194304, 4194304, 131072, 16384, 65536, 65536, 2048, 1024, 6291456, 6144, 1024, 2293760, 384, 294912, 256, 262144, 4096, 256, 4096, 256, 128, 1048576, 1024, 5767168, 2883584, 1024};
        bool okk = (n_in == 26); for (int i = 0; okk && i < 26; ++i) okk = (in_sizes[i] == exp_sizes[i]);
        if (!okk || out_size != 10616832) { fprintf(stderr, "kernel_launch: unexpected input sizes\n"); grid = -1; return; }
        if (n_in != 26 || ws_size < 198 * MiB) { fprintf(stderr, "kernel_launch: unexpected n_in %d / ws %zu\n", n_in, ws_size); grid = -1; return; }
        hipGetDevice(&dev); hipDeviceGetAttribute(&cus, hipDeviceAttributeMultiprocessorCount, dev);
        if (hipFuncSetAttribute((const void*)mk_fwd, hipFuncAttributeMaxDynamicSharedMemorySize, LDS_BYTES) != hipSuccess) { fprintf(stderr, "kernel_launch: hipFuncSetAttribute failed\n"); grid = -1; return; }
        int per_cu = 0;
        if (hipOccupancyMaxActiveBlocksPerMultiprocessor(&per_cu, (const void*)mk_fwd, 512, LDS_BYTES) != hipSuccess || per_cu < 1) { fprintf(stderr, "kernel_launch: occupancy query says %d\n", per_cu); per_cu = 1; }
        (void)hipGetLastError();
        if (cus < 256) { fprintf(stderr, "kernel_launch: needs 256 CUs, got %d\n", cus); grid = -1; return; }
        grid = 256;
    }
    if (grid < 0) return;
    Args a{};
    for (int i = 0; i < 26; ++i) a.in[i] = (const float*)d_in[i];
    a.out = (float*)d_out; a.ws = (unsigned char*)d_ws;
#if MK_PER_PHASE_LAUNCH
    for (int p = 0; p < NPHASE; ++p) { if (PROBE_ONLY_LAUNCH >= 0 && p != PROBE_ONLY_LAUNCH) continue; a.ph_lo = p; a.ph_hi = p + 1; hipLaunchKernelGGL(mk_fwd, dim3(grid), dim3(512), LDS_BYTES, stream, a); }
#else
    a.ph_lo = 0; a.ph_hi = NPHASE;
#if MK_COOP
    void* args[] = {&a};
    hipError_t e = hipLaunchCooperativeKernel((const void*)mk_fwd, dim3(grid), dim3(512), args, LDS_BYTES, stream);
    if (e != hipSuccess) fprintf(stderr, "cooperative launch failed: %s (grid %d)\n", hipGetErrorString(e), grid);
#else
    hipLaunchKernelGGL(mk_fwd, dim3(grid), dim3(512), LDS_BYTES, stream, a);
#endif
#endif
}
```

```cpp
#include <hip/hip_runtime.h>
#include <hip/hip_cooperative_groups.h>
#include <cstdio>
#include <cstdint>
namespace cg = cooperative_groups;

#define PROBE_FILL 0
#define PROBE_EXC 0
#define PROBE_BLO 0
#define PROBE_BHI 256
#define PROBE_RSTRIDE 1
#define PROBE_REP 1
#define PROBE_XLO 0
#define PROBE_XHI 8
#define PROBE_HANG 0
#define PROBE_ATT_REP 1
#define PROBE_GLAC_REP 1
#define PROBE_FFI_REP 1
#define PROBE_XBAR 0
#define PROBE_P0_REP 1
#define PROBE_ROW_REP 1
#define PROBE_P3_REP 1
#define PROBE_DUMP 0
#define PROBE_STATS 0
#define PROBE_K6 512
#define PROBE_ONLY_LAUNCH -1
#define PROBE_NOSTORE 0
#define PROBE_FILL_MIB 256
#define PROBE_FILL_VAL 1.2345f
#ifndef PROBE_MUL
#define PROBE_MUL 1.f
#endif
#ifndef PROBE_MODOFF
#define PROBE_MODOFF 0u
#endif
#ifndef MK_COOP
#define MK_COOP 0
#endif
#ifndef MK_PER_PHASE_LAUNCH
#define MK_PER_PHASE_LAUNCH 0
#endif

#define LAS __attribute__((address_space(3)))
typedef unsigned short bf16_t;
typedef short bf16x8 __attribute__((ext_vector_type(8)));
typedef float f32x4 __attribute__((ext_vector_type(4)));
typedef float f32x2 __attribute__((ext_vector_type(2)));
typedef unsigned u32x4 __attribute__((ext_vector_type(4)));
typedef unsigned u32x2 __attribute__((ext_vector_type(2)));

constexpr int D = 1024, MTOK = 8192, MP = 4096;
constexpr int ZP = 2304;
constexpr int C_QLAT = 0, C_KVLAT = 384, C_KROPE = 640, C_GQ = 672, C_GK = 928, C_GV = 1184, C_GFL = 1696, C_GOUT = 1728;
constexpr int DFF = 2816;
constexpr float EPS = 1e-6f;
constexpr float QSCALE = 0.10206207261596577f * 1.4426950408889634f;
constexpr int SKS = 2304;

constexpr size_t MiB = 1u << 20;
constexpr size_t WS_WIN = 1 * MiB;
constexpr size_t WS_WUQ = 6 * MiB;
constexpr size_t WS_WKF = 7 * MiB, WS_WVF = 7 * MiB + 256 * 1024;
constexpr size_t WS_WKU = 7 * MiB + 512 * 1024, WS_WVU = 7 * MiB + 768 * 1024;
constexpr size_t WS_WOUT = 8 * MiB;
constexpr size_t WS_WFFI = 10 * MiB;
constexpr size_t WS_WFFO = 21 * MiB;
constexpr size_t WS_BAR = 27 * MiB - 4096;
constexpr size_t WS_MOD = 27 * MiB;
constexpr size_t WS_RSSQ = 29 * MiB;
constexpr size_t WS_RSSKV = WS_RSSQ;
constexpr size_t WS_CACHEB = 27 * MiB + 512 * 1024;
constexpr size_t WS_DEC = 28 * MiB;
constexpr size_t WS_H = 32 * MiB;
constexpr size_t WS_Z = 48 * MiB;
constexpr size_t WS_Q = 84 * MiB;
constexpr size_t WS_HFF = 48 * MiB;
constexpr size_t WS_KP = 96 * MiB;
constexpr size_t WS_KS = 102 * MiB;
constexpr size_t WS_VTP = 109 * MiB;
constexpr size_t WS_VTS = 113 * MiB;
constexpr size_t WS_CT = 118 * MiB;
constexpr size_t WS_MIX = 150 * MiB;
constexpr size_t WS_X1 = 166 * MiB;
constexpr size_t WS_P0 = 96 * MiB;
constexpr size_t WS_P1A = 48 * MiB, WS_P1B = 128 * MiB;
constexpr size_t O_Y = 0, O_KV = 8388608, O_KR = O_KV + 1048576, O_SF = O_KR + 131072, O_SB = O_SF + 524288;

constexpr int LDS_BYTES = 147456;

__device__ __forceinline__ unsigned f2bf_sw(float f) { unsigned u = __builtin_bit_cast(unsigned, f); return (u + 0x7fffu + ((u >> 16) & 1u)) >> 16; }
__device__ __forceinline__ unsigned cvt_pk_bf16(float lo, float hi) { unsigned r; asm volatile("v_cvt_pk_bf16_f32 %0, %1, %2" : "=v"(r) : "v"(lo), "v"(hi)); return r; }
__device__ __forceinline__ bf16_t f2bf(float f) { return (bf16_t)(cvt_pk_bf16(f, 0.f) & 0xffffu); }
__device__ __forceinline__ float bf2f(bf16_t b) { return __uint_as_float((unsigned)b << 16); }
__device__ __forceinline__ float bflo(unsigned w) { return __uint_as_float(w << 16); }
__device__ __forceinline__ float bfhi(unsigned w) { return __uint_as_float(w & 0xffff0000u); }
__device__ __forceinline__ float wave_sum(float v) {
#pragma unroll
    for (int o = 1; o < 64; o <<= 1) v += __shfl_xor(v, o);
    return v;
}
__device__ __forceinline__ float fast_rcp(float x) { return __builtin_amdgcn_rcpf(x); }
__device__ __forceinline__ float silu_f(float a) { return a * fast_rcp(1.f + __expf(-a)); }
__device__ __forceinline__ float logsigmoid_f(float x) { return fminf(x, 0.f) - __logf(1.f + __expf(-fabsf(x))); }
__device__ __forceinline__ int opaque_lane() { int l; asm volatile("v_mbcnt_lo_u32_b32 %0, -1, 0\n\tv_mbcnt_hi_u32_b32 %0, -1, %0" : "=v"(l)); return l; }
__device__ __forceinline__ int otid(int wv) { int t = (int)threadIdx.x; asm volatile("" : "+v"(t)); return t; }
#define LDS_WAIT() asm volatile("s_waitcnt lgkmcnt(0)" ::: "memory")
#define VM_WAIT() asm volatile("s_waitcnt vmcnt(0)" ::: "memory")

namespace pg8 {
constexpr int BM = 256, BK = 64, HALF = 128, HTB = HALF * BK * 2, STAGE_BYTES = 8 * HTB, NXCD = 8, WGM = 8;
__host__ __device__ __forceinline__ int lds_byte(int r, int c) { const int st = (r >> 4) * 2 + (c >> 5), rr = r & 15, cc = c & 31, ob = rr * 64 + cc * 2; return st * 1024 + (ob ^ (((ob >> 9) & 1) << 5)); }
__host__ __device__ __forceinline__ void stage_rc(int b, int& R, int& C) { const int st = b / 1024, sb = b % 1024, swz = sb ^ (((sb >> 9) & 1) << 5); R = (st >> 1) * 16 + swz / 64; C = (st & 1) * 32 + (swz % 64) / 2; }
__host__ __device__ __forceinline__ int perm32(int rho) { const int n = rho >> 4, i = rho & 15; return 8 * (i >> 2) + 4 * n + (i & 3); }

struct Unit { int pm, pn, ks; };
struct Gemm { const bf16_t* A; const bf16_t* Bt; int lda, ldb, K, wv; };

struct Order {
    int nM, nN, nNs, nwg, G, c;
    __device__ void init(int M, int N, int nsplit, int G_, int c_) { nM = M / BM; nN = N / BM; nNs = nN * nsplit; nwg = nM * nNs; G = G_; c = c_; }
    __device__ bool next(int i, Unit& u) const {
        const long L = (long)i * G + c; if (L >= nwg) return false;
        int wgid = (int)L; { const int q = nwg / NXCD, r = nwg % NXCD, xcd = wgid % NXCD, off = wgid / NXCD; wgid = (xcd < r ? xcd * (q + 1) : r * (q + 1) + (xcd - r) * q) + off; }
        const int nig = WGM * nNs, gid = wgid / nig, fm = gid * WGM, gsz = (nM - fm) < WGM ? (nM - fm) : WGM;
        u.pm = fm + ((wgid % nig) % gsz); const int pn2 = (wgid % nig) / gsz; u.pn = pn2 % nN; u.ks = pn2 / nN; return true;
    }
};

template <class Epi, class Sched, bool ALIGN_EPI = true, bool SP2 = true>
__device__ __forceinline__ void gemm_phase(LAS unsigned char* lds, const Gemm g, const Sched& S, const Epi& E) {
    const int tid = otid(g.wv), wid = g.wv, lane = tid & 63, wr = wid >> 2, wc = wid & 3, fr = lane & 15, fq = lane >> 4;
    const int K = g.K, nt = K / BK;
    unsigned voffA[2], voffB[2];
#pragma unroll
    for (int i = 0; i < 2; ++i) { int R, C; stage_rc(tid * 16 + i * 8192, R, C); const int Rb = Epi::PERM ? ((R & ~31) + perm32(R & 31)) : R;
        voffA[i] = (unsigned)(R * g.lda + C) * 2u; voffB[i] = (unsigned)(Rb * g.ldb + C) * 2u; }
    const size_t kstep = (size_t)(BK * 2);
    const size_t hstepA = (size_t)HALF * g.lda * 2, hstepB = (size_t)HALF * g.ldb * 2;
    const size_t tstepA = 2 * hstepA, tstepB = 2 * hstepB;
    const size_t ksplit = (size_t)K * 2;
    const unsigned ldsw = (unsigned)wid * 1024u;
    const int aoff = lds_byte(wr * 64 + fr, fq * 8), boff = lds_byte(wc * 32 + fr, fq * 8);
#define PG8_SA(b, h) (((b) * 2 + (h)) * HTB)
#define PG8_SB(b, h) ((4 + (b) * 2 + (h)) * HTB)
#define PG8_STAGE(bufoff, gbase, voff) do { _Pragma("unroll") for (int _i = 0; _i < 2; ++_i) \
        __builtin_amdgcn_global_load_lds((const unsigned*)((const char*)(gbase) + (voff)[_i]), (LAS unsigned*)(lds + (bufoff) + ldsw + _i * 8192), 16, 0, 0); } while (0)
#define PG8_LDA(dst, b, h) do { _Pragma("unroll") for (int m = 0; m < 4; ++m) _Pragma("unroll") for (int k = 0; k < 2; ++k) dst[m][k] = *(const LAS bf16x8*)(lds + PG8_SA(b, h) + aoff + m * 2048 + k * 1024); } while (0)
#define PG8_LDB(dst, b, h) do { _Pragma("unroll") for (int n = 0; n < 2; ++n) _Pragma("unroll") for (int k = 0; k < 2; ++k) dst[n][k] = *(const LAS bf16x8*)(lds + PG8_SB(b, h) + boff + n * 2048 + k * 1024); } while (0)
#define PG8_MMA(ai, bj, At, Bt) do { __builtin_amdgcn_s_setprio(1); _Pragma("unroll") for (int m = 0; m < 4; ++m) _Pragma("unroll") for (int n = 0; n < 2; ++n) _Pragma("unroll") for (int k = 0; k < 2; ++k) \
        acc[ai][bj][m][n] = __builtin_amdgcn_mfma_f32_16x16x32_bf16(Bt[n][k], At[m][k], acc[ai][bj][m][n], 0, 0, 0); __builtin_amdgcn_s_setprio(0); } while (0)
#define PG8_WAIT_V(n) asm volatile("s_waitcnt vmcnt(" #n ")" ::: "memory")
#define PG8_WAIT_L(n) asm volatile("s_waitcnt lgkmcnt(" #n ")" ::: "memory")
#define PG8_BAR __builtin_amdgcn_s_barrier()
#define PG8_SCHED __builtin_amdgcn_sched_barrier(0)
    Unit cur, nxt; int ui = 0;
    if (!S.next(0, cur)) return;
    f32x4 acc[2][2][4][2];
#pragma unroll
    for (int a = 0; a < 2; ++a)
#pragma unroll
        for (int b = 0; b < 2; ++b)
#pragma unroll
            for (int m = 0; m < 4; ++m)
#pragma unroll
                for (int n = 0; n < 2; ++n) acc[a][b][m][n] = (f32x4){0.f, 0.f, 0.f, 0.f};
    bf16x8 At[4][2], B0[2][2], B1[2][2];
    const char* cA = (const char*)g.A + (size_t)cur.pm * tstepA + (size_t)cur.ks * ksplit; const char* cB = (const char*)g.Bt + (size_t)cur.pn * tstepB + (size_t)cur.ks * ksplit;
    if constexpr (SP2) {
        PG8_STAGE(PG8_SB(0, 0), cB, voffB); PG8_STAGE(PG8_SB(0, 1), cB + hstepB, voffB); PG8_STAGE(PG8_SA(0, 0), cA, voffA); PG8_STAGE(PG8_SA(0, 1), cA + hstepA, voffA);
        if (wr == 1) PG8_BAR;
        PG8_WAIT_V(2); PG8_BAR;
        PG8_STAGE(PG8_SB(1, 0), cB + kstep, voffB); PG8_STAGE(PG8_SA(1, 0), cA + kstep, voffA); PG8_STAGE(PG8_SB(1, 1), cB + hstepB + kstep, voffB);
        PG8_WAIT_V(6); PG8_BAR;
    } else {
        PG8_STAGE(PG8_SB(0, 0), cB, voffB); PG8_STAGE(PG8_SA(0, 0), cA, voffA); PG8_STAGE(PG8_SB(0, 1), cB + hstepB, voffB); PG8_STAGE(PG8_SA(0, 1), cA + hstepA, voffA);
        if (wr == 1) PG8_BAR;
        PG8_WAIT_V(4); PG8_BAR;
        PG8_STAGE(PG8_SB(1, 0), cB + kstep, voffB); PG8_STAGE(PG8_SA(1, 0), cA + kstep, voffA); PG8_STAGE(PG8_SB(1, 1), cB + hstepB + kstep, voffB);
        PG8_WAIT_V(6); PG8_BAR;
    }
    for (;;) {
        const bool has_next = S.next(ui + 1, nxt);
        const char* nA = has_next ? (const char*)g.A + (size_t)nxt.pm * tstepA + (size_t)nxt.ks * ksplit : cA; const char* nB = has_next ? (const char*)g.Bt + (size_t)nxt.pn * tstepB + (size_t)nxt.ks * ksplit : cB;
#pragma nounroll
        for (int t = 0; t < nt; t += 2) {
            const bool last = (t == nt - 2);
            const char* a1 = cA + (size_t)(t + 1) * kstep;
            const char* a2 = last ? nA : cA + (size_t)(t + 2) * kstep; const char* b2 = last ? nB : cB + (size_t)(t + 2) * kstep;
            const char* a3 = a2 + kstep; const char* b3 = b2 + kstep;
            if constexpr (SP2) {
            PG8_LDB(B0, 0, 0); PG8_LDB(B1, 0, 1); PG8_SCHED; PG8_LDA(At, 0, 0); PG8_STAGE(PG8_SA(1, 1), a1 + hstepA, voffA);
            PG8_WAIT_V(8); PG8_WAIT_L(0); PG8_BAR; PG8_MMA(0, 0, At, B0); PG8_MMA(0, 1, At, B1); PG8_BAR; PG8_SCHED;
            PG8_LDA(At, 0, 1); PG8_STAGE(PG8_SB(0, 0), b2, voffB); PG8_STAGE(PG8_SB(0, 1), b2 + hstepB, voffB); PG8_STAGE(PG8_SA(0, 0), a2, voffA);
            PG8_WAIT_V(8); PG8_WAIT_L(0); PG8_BAR; PG8_MMA(1, 0, At, B0); PG8_MMA(1, 1, At, B1); PG8_BAR; PG8_SCHED;
            PG8_LDB(B0, 1, 0); PG8_LDB(B1, 1, 1); PG8_SCHED; PG8_LDA(At, 1, 0); PG8_STAGE(PG8_SA(0, 1), a2 + hstepA, voffA);
            PG8_WAIT_V(8); PG8_WAIT_L(0); PG8_BAR; PG8_MMA(0, 0, At, B0); PG8_MMA(0, 1, At, B1); PG8_BAR; PG8_SCHED;
            PG8_LDA(At, 1, 1); PG8_STAGE(PG8_SB(1, 0), b3, voffB); PG8_STAGE(PG8_SB(1, 1), b3 + hstepB, voffB); PG8_STAGE(PG8_SA(1, 0), a3, voffA);
            PG8_WAIT_V(8); PG8_WAIT_L(0); PG8_BAR; PG8_MMA(1, 0, At, B0); PG8_MMA(1, 1, At, B1); PG8_BAR; PG8_SCHED;
            } else {
            PG8_LDB(B0, 0, 0); PG8_SCHED; PG8_LDA(At, 0, 0); PG8_STAGE(PG8_SA(1, 1), a1 + hstepA, voffA);
            PG8_WAIT_L(8); PG8_BAR; PG8_WAIT_L(0); PG8_MMA(0, 0, At, B0); PG8_BAR; PG8_SCHED;
            PG8_LDB(B1, 0, 1); PG8_STAGE(PG8_SB(0, 0), b2, voffB);
            PG8_BAR; PG8_WAIT_L(0); PG8_MMA(0, 1, At, B1); PG8_BAR;
            PG8_LDA(At, 0, 1); PG8_STAGE(PG8_SA(0, 0), a2, voffA);
            PG8_BAR; PG8_WAIT_L(0); PG8_MMA(1, 0, At, B0); PG8_BAR; PG8_SCHED;
            PG8_STAGE(PG8_SB(0, 1), b2 + hstepB, voffB);
            PG8_WAIT_V(6); PG8_BAR; PG8_MMA(1, 1, At, B1); PG8_BAR;
            PG8_LDB(B0, 1, 0); PG8_SCHED; PG8_LDA(At, 1, 0); PG8_STAGE(PG8_SA(0, 1), a2 + hstepA, voffA);
            PG8_WAIT_L(8); PG8_BAR; PG8_WAIT_L(0); PG8_MMA(0, 0, At, B0); PG8_BAR; PG8_SCHED;
            PG8_LDB(B1, 1, 1); PG8_STAGE(PG8_SB(1, 0), b3, voffB);
            PG8_BAR; PG8_WAIT_L(0); PG8_MMA(0, 1, At, B1); PG8_BAR;
            PG8_LDA(At, 1, 1); PG8_STAGE(PG8_SA(1, 0), a3, voffA);
            PG8_BAR; PG8_WAIT_L(0); PG8_MMA(1, 0, At, B0); PG8_BAR; PG8_SCHED;
            PG8_STAGE(PG8_SB(1, 1), b3 + hstepB, voffB);
            PG8_WAIT_V(6); PG8_BAR; PG8_MMA(1, 1, At, B1); PG8_BAR;
            }
        }
        if constexpr (ALIGN_EPI) { if (wr == 0) PG8_BAR; }
        E(acc, cur, wr, wc, fr, fq);
        if (!has_next) break;
#pragma unroll
        for (int a = 0; a < 2; ++a)
#pragma unroll
            for (int b = 0; b < 2; ++b)
#pragma unroll
                for (int m = 0; m < 4; ++m)
#pragma unroll
                    for (int n = 0; n < 2; ++n) acc[a][b][m][n] = (f32x4){0.f, 0.f, 0.f, 0.f};
        cur = nxt; cA = nA; cB = nB; ++ui;
        if constexpr (ALIGN_EPI) { if (wr == 1) PG8_BAR; }
    }
    PG8_WAIT_V(0);
    if constexpr (!ALIGN_EPI) { if (wr == 0) PG8_BAR; }
    PG8_BAR;
#undef PG8_SA
#undef PG8_SB
#undef PG8_STAGE
#undef PG8_LDA
#undef PG8_LDB
#undef PG8_MMA
#undef PG8_WAIT_V
#undef PG8_WAIT_L
#undef PG8_BAR
#undef PG8_SCHED
}

__device__ __forceinline__ float rss_q(const float* rss, int row) { float s = 0.f;
#pragma unroll
    for (int p = 0; p < 12; ++p) s += rss[(size_t)p * MTOK + row]; return s; }
__device__ __forceinline__ float rss_kv(const float* rss, int row) { float s = 0.f;
#pragma unroll
    for (int p = 12; p < 20; ++p) s += rss[(size_t)p * MTOK + row]; return s; }
#define EPI_ROWS_BEGIN _Pragma("unroll") for (int ai = 0; ai < 2; ++ai) _Pragma("unroll") for (int m = 0; m < 4; ++m) { const int row = u.pm * BM + wr * 64 + fr + ai * HALF + m * 16;
#define EPI_ROWS_END asm volatile("" ::: "memory"); }

struct EpiZ {
    static constexpr bool PERM = true;
    bf16_t* Z; float* rssq; float* rsskv; int pn_off;
    __device__ __forceinline__ void operator()(const f32x4 (&acc)[2][2][4][2], const Unit& u, int wr, int wc, int fr_, int fq_) const {
        int lane_e = (int)threadIdx.x & 63; asm volatile("" : "+v"(lane_e)); const int fr = lane_e & 15, fq = lane_e >> 4;
        const int col0 = (u.pn + pn_off) * BM + wc * 32 + 8 * fq;
        EPI_ROWS_BEGIN
            bf16_t* rowp = Z + (size_t)row * ZP + col0;
#pragma unroll
            for (int bj = 0; bj < 2; ++bj) { const f32x4 v0 = acc[ai][bj][m][0], v1 = acc[ai][bj][m][1];
                u32x4 w; w.x = cvt_pk_bf16(v0[0], v0[1]); w.y = cvt_pk_bf16(v0[2], v0[3]); w.z = cvt_pk_bf16(v1[0], v1[1]); w.w = cvt_pk_bf16(v1[2], v1[3]);
                *(u32x4*)(rowp + bj * HALF) = w;
                const int hc = 2 * (u.pn + pn_off) + bj;
                if (hc < 5) { float s = (v0[0] * v0[0] + v0[1] * v0[1]) + (v0[2] * v0[2] + v0[3] * v0[3]) + (v1[0] * v1[0] + v1[1] * v1[1]) + (v1[2] * v1[2] + v1[3] * v1[3]);
                    s += __shfl_xor(s, 16); s += __shfl_xor(s, 32);
                    if (fq == 0) rssq[(size_t)(hc * 4 + wc) * MTOK + row] = s; } }
        EPI_ROWS_END
    }
};

struct EpiQ {
    static constexpr bool PERM = true;
    bf16_t* Q; const float* rssq;
    __device__ __forceinline__ void operator()(const f32x4 (&acc)[2][2][4][2], const Unit& u, int wr, int wc, int fr_, int fq_) const {
        int lane_e = (int)threadIdx.x & 63; asm volatile("" : "+v"(lane_e)); const int fr = lane_e & 15, fq = lane_e >> 4;
        const int col0 = u.pn * BM + wc * 32 + 8 * fq;
        const float inv[8] = {1.f, 0.316227766f, 0.1f, 0.0316227766f, 0.01f, 0.00316227766f, 0.001f, 0.000316227766f};
        EPI_ROWS_BEGIN
            const float rs = rsqrtf(rss_q(rssq, row) * (1.f / 384.f) + EPS) * QSCALE;
            const int t = (row - MP) & 2047;
#pragma unroll
            for (int bj = 0; bj < 2; ++bj) { const int c = col0 + bj * HALF; const int j0 = c % 96;
                const bool rp = (row >= MP && j0 >= 64);
                const float pos = (float)((j0 < 80) ? (t >> 6) : (t & 63)) * 0.15915494309189535f;
                const float sg = (j0 & 8) ? 1.f : -1.f;
#pragma unroll
                for (int n = 0; n < 2; ++n) {
                    f32x4 v = acc[ai][bj][m][n] * rs;
#pragma unroll
                    for (int i = 0; i < 4; ++i) { const float p = __shfl_xor(v[i], 16);
                        const float rev = pos * inv[4 * n + i]; const float rf = rev - floorf(rev);
                        const float cs = __builtin_amdgcn_cosf(rf), sn = __builtin_amdgcn_sinf(rf); v[i] = rp ? v[i] * cs + sg * p * sn : v[i]; }
                    u32x2 w; w.x = cvt_pk_bf16(v[0], v[1]); w.y = cvt_pk_bf16(v[2], v[3]);
                    *(u32x2*)(Q + (size_t)row * 768 + c + 4 * n) = w; } }
        EPI_ROWS_END
    }
};

struct EpiK {
    static constexpr bool PERM = true;
    bf16_t* Kp; bf16_t* Ks; const float* rsskv; int ctx;
    __device__ __forceinline__ void operator()(const f32x4 (&acc)[2][2][4][2], const Unit& u, int wr, int wc, int fr_, int fq_) const {
        int lane_e = (int)threadIdx.x & 63; asm volatile("" : "+v"(lane_e)); const int fr = lane_e & 15, fq = lane_e >> 4;
        EPI_ROWS_BEGIN
            float rs = 1.f; unsigned off; bool smp;
            if (ctx) { off = ((unsigned)(row >> 8) * 8u * SKS + (row & 255)) * 96u; smp = true; }
            else { rs = rsqrtf(rss_kv(rsskv, row) * (1.f / 256.f) + EPS);
                if (row < MP) { off = ((unsigned)(row >> 8) * 8u * 256u + (row & 255)) * 96u; smp = false; } else { off = ((unsigned)((row - MP) >> 11) * 8u * SKS + 256u + ((row - MP) & 2047)) * 96u; smp = true; } }
            bf16_t* base = smp ? Ks : Kp; const unsigned hs = (smp ? SKS : 256) * 96u;
#pragma unroll
            for (int bj = 0; bj < 2; ++bj) { const unsigned h = 4 * u.pn + 2 * bj + (wc >> 1); const unsigned j = (wc & 1) * 32 + 8 * fq;
                const f32x4 v0 = acc[ai][bj][m][0] * rs, v1 = acc[ai][bj][m][1] * rs;
                u32x4 w; w.x = cvt_pk_bf16(v0[0], v0[1]); w.y = cvt_pk_bf16(v0[2], v0[3]); w.z = cvt_pk_bf16(v1[0], v1[1]); w.w = cvt_pk_bf16(v1[2], v1[3]);
                *(u32x4*)(base + (off + h * hs + j)) = w; }
        EPI_ROWS_END
    }
};

struct EpiVt {
    static constexpr bool PERM = true;
    bf16_t* Vtp; bf16_t* Vts; const float* rsskv; int ctx;
    __device__ __forceinline__ void operator()(const f32x4 (&acc)[2][2][4][2], const Unit& u, int wr, int wc, int fr_, int fq_) const {
        int lane_e = (int)threadIdx.x & 63; asm volatile("" : "+v"(lane_e)); const int fr = lane_e & 15, fq = lane_e >> 4;
#pragma unroll
        for (int bj = 0; bj < 2; ++bj) {
            const int tok = u.pn * BM + bj * HALF + wc * 32 + 8 * fq;
            f32x4 r0 = {1.f, 1.f, 1.f, 1.f}, r1 = {1.f, 1.f, 1.f, 1.f}; unsigned off; bool smp; unsigned S;
            if (ctx) { off = (unsigned)(tok >> 8) * 8u * 64u * SKS + (tok & 255); smp = true; S = SKS; }
            else { f32x4 q0 = {0.f, 0.f, 0.f, 0.f}, q1 = {0.f, 0.f, 0.f, 0.f};
#pragma unroll
                for (int p = 12; p < 20; ++p) { q0 += *(const f32x4*)(rsskv + (size_t)p * MTOK + tok); q1 += *(const f32x4*)(rsskv + (size_t)p * MTOK + tok + 4); }
#pragma unroll
                for (int i = 0; i < 4; ++i) { r0[i] = rsqrtf(q0[i] * (1.f / 256.f) + EPS); r1[i] = rsqrtf(q1[i] * (1.f / 256.f) + EPS); }
                if (tok < MP) { off = (unsigned)(tok >> 8) * 8u * 64u * 256u + (tok & 255); smp = false; S = 256; } else { off = (unsigned)((tok - MP) >> 11) * 8u * 64u * SKS + 256u + ((tok - MP) & 2047); smp = true; S = SKS; } }
            bf16_t* base = smp ? Vts : Vtp;
#pragma unroll
            for (int ai = 0; ai < 2; ++ai)
#pragma unroll
                for (int m = 0; m < 4; ++m) { const unsigned hd = u.pm * BM + wr * 64 + fr + ai * HALF + m * 16;
                    const f32x4 v0 = acc[ai][bj][m][0] * r0, v1 = acc[ai][bj][m][1] * r1;
                    u32x4 w; w.x = cvt_pk_bf16(v0[0], v0[1]); w.y = cvt_pk_bf16(v0[2], v0[3]); w.z = cvt_pk_bf16(v1[0], v1[1]); w.w = cvt_pk_bf16(v1[2], v1[3]);
                    *(u32x4*)(base + (off + hd * S)) = w; }
            asm volatile("" ::: "memory");
        }
    }
};

struct EpiPart {
    static constexpr bool PERM = true;
    bf16_t* P0; bf16_t* P1;
    __device__ __forceinline__ void operator()(const f32x4 (&acc)[2][2][4][2], const Unit& u, int wr, int wc, int fr_, int fq_) const {
        int lane_e = (int)threadIdx.x & 63; asm volatile("" : "+v"(lane_e)); const int fr = lane_e & 15, fq = lane_e >> 4;
        const int col0 = u.pn * BM + wc * 32 + 8 * fq; bf16_t* P = u.ks ? P1 : P0;
        EPI_ROWS_BEGIN
            bf16_t* rowp = P + (size_t)row * D + col0;
#pragma unroll
            for (int bj = 0; bj < 2; ++bj) { const f32x4 v0 = acc[ai][bj][m][0], v1 = acc[ai][bj][m][1];
                u32x4 w; w.x = cvt_pk_bf16(v0[0], v0[1]); w.y = cvt_pk_bf16(v0[2], v0[3]); w.z = cvt_pk_bf16(v1[0], v1[1]); w.w = cvt_pk_bf16(v1[2], v1[3]);
                *(u32x4*)(rowp + bj * HALF) = w; }
        EPI_ROWS_END
    }
};

struct EpiFFI {
    static constexpr bool PERM = true;
    bf16_t* H;
    __device__ __forceinline__ void operator()(const f32x4 (&acc)[2][2][4][2], const Unit& u, int wr, int wc, int fr_, int fq_) const {
        int lane_e = (int)threadIdx.x & 63; asm volatile("" : "+v"(lane_e)); const int fr = lane_e & 15, fq = lane_e >> 4;
        const int col0 = u.pn * HALF + wc * 32 + 8 * fq;
        EPI_ROWS_BEGIN
            float o[8];
#pragma unroll
            for (int i = 0; i < 4; ++i) { o[i] = silu_f(acc[ai][0][m][0][i]) * acc[ai][1][m][0][i]; o[4 + i] = silu_f(acc[ai][0][m][1][i]) * acc[ai][1][m][1][i]; }
            u32x4 w; w.x = cvt_pk_bf16(o[0], o[1]); w.y = cvt_pk_bf16(o[2], o[3]); w.z = cvt_pk_bf16(o[4], o[5]); w.w = cvt_pk_bf16(o[6], o[7]);
            *(u32x4*)(H + (size_t)row * DFF + col0) = w;
        EPI_ROWS_END
    }
};
}

struct Args { const float* in[26]; float* out; unsigned char* ws; int ph_lo, ph_hi; };
enum { I_XP = 0, I_XS, I_CKV, I_CKR, I_SF, I_SB, I_C, I_CCTX, I_WADA, I_BADA, I_NATT, I_WIN, I_QN, I_WUQ, I_KVN, I_WUKV, I_WGF, I_BGF, I_WGB, I_BGB, I_GLAN, I_WOUT, I_NFFN, I_WFFI, I_WFFO, I_FN };

__device__ __forceinline__ const float* xrow_ptr(const Args& a, int r) { return r < MP ? a.in[I_XP] + (size_t)r * D : a.in[I_XS] + (size_t)(r - MP) * D; }
__device__ __forceinline__ int cond_of_row(int r) { return r < MP ? 0 : 1 + ((r - MP) >> 11); }

__device__ __forceinline__ void p0_tr(const float* W, int K, int N, bf16_t* WT, bf16_t* WT2, const float* kscale, int kb, int nb, int drow, LAS float* scr, int lane) {
    const int k0 = 64 * kb, n0 = 32 * nb;
#pragma unroll 8
    for (int i = 0; i < 32; ++i) { const int kk = 2 * i + (lane >> 5); scr[kk * 33 + (lane & 31)] = W[(size_t)(k0 + kk) * N + n0 + (lane & 31)]; }
    LDS_WAIT();
    const int c = lane & 7;
    float sc[8];
#pragma unroll
    for (int i = 0; i < 8; ++i) sc[i] = kscale ? kscale[k0 + 8 * c + i] : 1.f;
#pragma unroll
    for (int j = 0; j < 4; ++j) { const int n = (lane >> 3) + 8 * j; const LAS float* s = scr + (8 * c) * 33 + n;
        float v[8];
#pragma unroll
        for (int i = 0; i < 8; ++i) v[i] = s[i * 33];
        if (WT2) { u32x4 o; o.x = cvt_pk_bf16(v[0], v[1]); o.y = cvt_pk_bf16(v[2], v[3]); o.z = cvt_pk_bf16(v[4], v[5]); o.w = cvt_pk_bf16(v[6], v[7]);
            *(u32x4*)(WT2 + (size_t)(drow + n0 + n) * K + k0 + 8 * c) = o; }
        u32x4 o; o.x = cvt_pk_bf16(v[0] * sc[0], v[1] * sc[1]); o.y = cvt_pk_bf16(v[2] * sc[2], v[3] * sc[3]); o.z = cvt_pk_bf16(v[4] * sc[4], v[5] * sc[5]); o.w = cvt_pk_bf16(v[6] * sc[6], v[7] * sc[7]);
        *(u32x4*)(WT + (size_t)(drow + n0 + n) * K + k0 + 8 * c) = o; }
    LDS_WAIT();
}

__device__ __forceinline__ void phase0(const Args& a, int wv, LAS unsigned char* lds, int vcu, int G) {
    const int tid = otid(wv), lane = tid & 63, wave = __builtin_amdgcn_readfirstlane(tid >> 6);
    unsigned char* ws = a.ws;
#ifndef P0MASK
#define P0MASK 7
#endif
    if (P0MASK & 2) {
        LAS float* scr = (LAS float*)(lds + wave * 16384);
        LAS float* scnd = (LAS float*)(lds + 131072);
        for (int i = tid; i < 3072; i += 512) { const int ci = i >> 10, k = i & 1023; scnd[i] = silu_f(ci == 0 ? a.in[I_CCTX][k] : a.in[I_C][(ci - 1) * D + k]); }
        __syncthreads();
        const int gw = vcu * 8 + wave, NGW = G * 8;
        constexpr int T_IN = 16 * 70, T_UQ = 6 * 24, T_UKV = 4 * 32, T_OUT = 16 * 32, T_FFI = 16 * 176, T_FFO = 44 * 32, T_ZERO = 64, T_ADA = 768;
        constexpr int NIT = T_ADA + T_IN + T_UQ + T_UKV + T_OUT + T_FFI + T_FFO + T_ZERO;
        constexpr int NTR = NIT - T_ADA;
        const int nslot = wave < 3 ? 2 : 5;
        for (int sl = 0; sl < nslot; ++sl) {
            int r;
            if (wave < 3) { if (sl == 0) { r = wave * G + vcu; if (r >= T_ADA) continue; } else { const int t = vcu + G * wave; if (t >= NTR) continue; r = T_ADA + t; } }
            else { const int j = 3 + (wave - 3) + 5 * sl; const int t = vcu + G * j; if (t >= NTR) continue; r = T_ADA + t; }
            if (r < T_ADA) {
                const int nbq = r >> 2, kq = r & 3; const int n0 = 32 * nbq; const float* W = a.in[I_WADA];
                const int n = lane & 31, hf = lane >> 5; float s0 = 0.f, s1 = 0.f, s2 = 0.f;
                for (int kb = 4 * kq; kb < 4 * kq + 4; ++kb) { const int k0 = 64 * kb;
#pragma unroll 8
                    for (int i = 0; i < 32; ++i) { const int kk = 2 * i + (lane >> 5); scr[kk * 33 + (lane & 31)] = W[(size_t)(k0 + kk) * 6144 + n0 + (lane & 31)]; }
                    LDS_WAIT();
#pragma unroll 8
                    for (int j = 0; j < 32; ++j) { const int kk = hf * 32 + j; const float w = scr[kk * 33 + n];
                        s0 += w * scnd[k0 + kk]; s1 += w * scnd[1024 + k0 + kk]; s2 += w * scnd[2048 + k0 + kk]; }
                    LDS_WAIT(); }
                s0 += __shfl_xor(s0, 32); s1 += __shfl_xor(s1, 32); s2 += __shfl_xor(s2, 32);
                float* MOD = (float*)(ws + WS_MOD) + (size_t)kq * 18432;
                if (hf == 0) { MOD[n0 + n] = s0; MOD[6144 + n0 + n] = s1; MOD[12288 + n0 + n] = s2; }
                continue; } r -= T_ADA;
            if (r < T_FFI) { const int kb = r / 176, nb = r % 176; const int n0 = nb * 32; const int drow = n0 < DFF ? (n0 / 128) * 256 + (n0 % 128) : ((n0 - DFF) / 128) * 256 + 128 + ((n0 - DFF) % 128);
                p0_tr(a.in[I_WFFI], 1024, 5632, (bf16_t*)(ws + WS_WFFI), nullptr, nullptr, kb, nb, drow - n0, scr, lane); continue; } r -= T_FFI;
            if (r < T_FFO) { p0_tr(a.in[I_WFFO], DFF, 1024, (bf16_t*)(ws + WS_WFFO), nullptr, nullptr, r / 32, r % 32, 0, scr, lane); continue; } r -= T_FFO;
            if (r < T_IN) { p0_tr(a.in[I_WIN], 1024, 2240, (bf16_t*)(ws + WS_WIN), nullptr, nullptr, r / 70, r % 70, 0, scr, lane); continue; } r -= T_IN;
            if (r < T_OUT) { p0_tr(a.in[I_WOUT], 1024, 1024, (bf16_t*)(ws + WS_WOUT), nullptr, nullptr, r / 32, r % 32, 0, scr, lane); continue; } r -= T_OUT;
            if (r < T_UQ) { p0_tr(a.in[I_WUQ], 384, 768, (bf16_t*)(ws + WS_WUQ), nullptr, a.in[I_QN], r / 24, r % 24, 0, scr, lane); continue; } r -= T_UQ;
            if (r < T_UKV) { const int nb = r % 32, n0 = nb * 32, hh = n0 >> 7, j0 = n0 & 127; const bool isv = j0 >= 64; const int drow = hh * 64 + (j0 & 63);
                p0_tr(a.in[I_WUKV], 256, 1024, (bf16_t*)(ws + (isv ? WS_WVF : WS_WKF)), (bf16_t*)(ws + (isv ? WS_WVU : WS_WKU)), a.in[I_KVN], r / 32, nb, drow - n0, scr, lane); continue; } r -= T_UKV;
            { u32x4 z = {0u, 0u, 0u, 0u}; u32x4* p = (u32x4*)((bf16_t*)(ws + WS_WIN) + (size_t)(2240 + r) * 1024); p[lane] = z; p[64 + lane] = z; }
        }
    }
    if (P0MASK & 4) {
        const int gt = vcu * 512 + tid, NT = G * 512;
        for (int i = gt; i < 32768; i += NT) { const f32x4 v = ((const f32x4*)a.in[I_CKV])[i]; u32x2 w; w.x = cvt_pk_bf16(v[0], v[1]); w.y = cvt_pk_bf16(v[2], v[3]); ((u32x2*)(ws + WS_CACHEB))[i] = w; }
    }
}

__device__ __forceinline__ f32x4 mod4(const float* modp, const float* bias, int ci, int off) {
    const float* p = modp + ci * 6144 + off;
    return ((*(const f32x4*)p + *(const f32x4*)(p + 18432)) + (*(const f32x4*)(p + 36864) + *(const f32x4*)(p + 55296))) + *(const f32x4*)(bias + off);
}
__device__ __forceinline__ void phase1(const Args& a, int wv, int vcu, int G) {
    if (PROBE_FILL == 3) { float* m = (float*)(a.ws + WS_MOD); for (int i = otid(wv); i < 3 * 6144; i += 512) { unsigned h = (unsigned)i * 2654435761u; h ^= h >> 15; h *= 2246822519u; h ^= h >> 13; m[i] = ((float)(h & 0xffff) * (1.f / 65536.f) - 0.5f) * 2.f; } __syncthreads(); }
    const int tid_ = otid(wv); const int lane = tid_ & 63, wave = tid_ >> 6; const int gw = vcu * 8 + wave, NGW = G * 8;
    const float* mod = (const float*)(a.ws + WS_MOD + PROBE_MODOFF); bf16_t* H = (bf16_t*)(a.ws + WS_H);
    for (int r = gw; r < MTOK; r += NGW * PROBE_RSTRIDE) {
        const f32x4* xr = (const f32x4*)xrow_ptr(a, r) + lane; const int ci_ = cond_of_row(r);
        f32x4 v[4]; float s = 0.f;
#pragma unroll
        for (int j = 0; j < 4; ++j) { v[j] = xr[64 * j]; s += (v[j][0] * v[j][0] + v[j][1] * v[j][1]) + (v[j][2] * v[j][2] + v[j][3] * v[j][3]); }
        const float rstd = rsqrtf(wave_sum(s) * (1.f / D) + EPS);
        u32x2* o = (u32x2*)(H + (size_t)r * D) + lane;
#pragma unroll
        for (int j = 0; j < 4; ++j) { const int c = 4 * lane + 256 * j; const f32x4 w = *(const f32x4*)(a.in[I_NATT] + c), sh = mod4(mod, a.in[I_BADA], ci_, c), scv = mod4(mod, a.in[I_BADA], ci_, 1024 + c);
            const f32x4 y = v[j] * rstd * w * (scv * PROBE_MUL + 1.f) + sh * PROBE_MUL; u32x2 p; p.x = cvt_pk_bf16(y[0], y[1]); p.y = cvt_pk_bf16(y[2], y[3]); if (PROBE_NOSTORE) { if ((p.x ^ p.y) == 0x12345u) o[64 * j] = p; } else o[64 * j] = p; }
    }
}
__device__ __forceinline__ void phase6(const Args& a, int wv, int vcu, int G) {
    const int tid_ = otid(wv); const int lane = tid_ & 63, wave = tid_ >> 6; const int gw = vcu * 8 + wave, NGW = G * 8;
    const float* mod = (const float*)(a.ws + WS_MOD); bf16_t* H = (bf16_t*)(a.ws + WS_H); float* X1 = (float*)(a.ws + WS_X1);
    const bf16_t* P0 = (const bf16_t*)(a.ws + WS_P0); const bf16_t* P1 = (const bf16_t*)(a.ws + WS_P1A);
    for (int r = gw; r < MTOK; r += NGW) {
        const f32x4* xr = (const f32x4*)xrow_ptr(a, r) + lane; const int ci_ = cond_of_row(r);
        const u32x2* p0 = (const u32x2*)(P0 + (size_t)r * D) + lane; const u32x2* p1 = (const u32x2*)(P1 + (size_t)r * D) + lane;
        f32x4 v[4]; float s = 0.f;
#pragma unroll
        for (int j = 0; j < 4; ++j) { const int c = 4 * lane + 256 * j; const f32x4 gt = mod4(mod, a.in[I_BADA], ci_, 2048 + c);
            { const u32x2 qa = p0[64 * j], qb = p1[64 * j]; const f32x4 ps = {bflo(qa.x) + bflo(qb.x), bfhi(qa.x) + bfhi(qb.x), bflo(qa.y) + bflo(qb.y), bfhi(qa.y) + bfhi(qb.y)}; v[j] = xr[64 * j] + gt * ps; } s += (v[j][0] * v[j][0] + v[j][1] * v[j][1]) + (v[j][2] * v[j][2] + v[j][3] * v[j][3]); }
        const float rstd = rsqrtf(wave_sum(s) * (1.f / D) + EPS);
        u32x2* x1 = (u32x2*)((bf16_t*)X1 + (size_t)r * D) + lane; u32x2* o = (u32x2*)(H + (size_t)r * D) + lane;
#pragma unroll
        for (int j = 0; j < 4; ++j) { const int c = 4 * lane + 256 * j; { u32x2 xw; xw.x = cvt_pk_bf16(v[j][0], v[j][1]); xw.y = cvt_pk_bf16(v[j][2], v[j][3]); x1[64 * j] = xw; }
            const f32x4 w = *(const f32x4*)(a.in[I_NFFN] + c), sh = mod4(mod, a.in[I_BADA], ci_, 3072 + c), scv = mod4(mod, a.in[I_BADA], ci_, 4096 + c);
            const f32x4 y = v[j] * rstd * w * (scv + 1.f) + sh; u32x2 p; p.x = cvt_pk_bf16(y[0], y[1]); p.y = cvt_pk_bf16(y[2], y[3]); o[64 * j] = p; }
    }
}
__device__ __forceinline__ void phase9(const Args& a, int wv, int vcu, int G) {
    const int tid_ = otid(wv); const int lane = tid_ & 63, wave = tid_ >> 6; const int gw = vcu * 8 + wave, NGW = G * 8;
    const float* mod = (const float*)(a.ws + WS_MOD); const float* X1 = (const float*)(a.ws + WS_X1);
    const bf16_t* P0 = (const bf16_t*)(a.ws + WS_P0); const bf16_t* P1 = (const bf16_t*)(a.ws + WS_P1B);
    for (int r = gw; r < MTOK; r += NGW) {
        const u32x2* xr = (const u32x2*)((const bf16_t*)X1 + (size_t)r * D) + lane; const int ci_ = cond_of_row(r);
        const u32x2* p0 = (const u32x2*)(P0 + (size_t)r * D) + lane; const u32x2* p1 = (const u32x2*)(P1 + (size_t)r * D) + lane;
        f32x4 v[4]; float s = 0.f;
#pragma unroll
        for (int j = 0; j < 4; ++j) { const int c = 4 * lane + 256 * j; const f32x4 gt = mod4(mod, a.in[I_BADA], ci_, 5120 + c);
            { const u32x2 qa = p0[64 * j], qb = p1[64 * j]; const f32x4 ps = {bflo(qa.x) + bflo(qb.x), bfhi(qa.x) + bfhi(qb.x), bflo(qa.y) + bflo(qb.y), bfhi(qa.y) + bfhi(qb.y)}; const u32x2 xq = xr[64 * j]; const f32x4 xv = {bflo(xq.x), bfhi(xq.x), bflo(xq.y), bfhi(xq.y)}; v[j] = xv + gt * ps; } s += (v[j][0] * v[j][0] + v[j][1] * v[j][1]) + (v[j][2] * v[j][2] + v[j][3] * v[j][3]); }
        const float rstd = rsqrtf(wave_sum(s) * (1.f / D) + EPS);
        f32x4* y = (f32x4*)(a.out + O_Y + (size_t)r * D) + lane;
#pragma unroll
        for (int j = 0; j < 4; ++j) { const int c = 4 * lane + 256 * j; const f32x4 w = *(const f32x4*)(a.in[I_FN] + c); y[64 * j] = v[j] * rstd * w; }
    }
}

__device__ __forceinline__ void p3_row_extras(const Args& a, int wv, int gw, int NGW) {
    const int lane = otid(wv) & 63;
    const bf16_t* Z = (const bf16_t*)(a.ws + WS_Z); const float* rsskv = (const float*)(a.ws + WS_RSSKV);
    bf16_t* Kp = (bf16_t*)(a.ws + WS_KP); bf16_t* Ks = (bf16_t*)(a.ws + WS_KS);
    const float inv[8] = {1.f, 0.316227766f, 0.1f, 0.0316227766f, 0.01f, 0.00316227766f, 0.001f, 0.000316227766f};
    for (int r = gw; r < MTOK + 512; r += NGW) {
        if (r < MTOK) {
            const bf16_t* zr = Z + (size_t)r * ZP;
            if (r < MP) {
                const float rs = rsqrtf(pg8::rss_kv(rsskv, r) * (1.f / 256.f) + EPS);
                const u32x2 w = *(const u32x2*)(zr + C_KVLAT + 4 * lane); const f32x4 g = *(const f32x4*)(a.in[I_KVN] + 4 * lane);
                f32x4 o; o[0] = bflo(w.x) * rs * g[0]; o[1] = bfhi(w.x) * rs * g[1]; o[2] = bflo(w.y) * rs * g[2]; o[3] = bfhi(w.y) * rs * g[3];
                *(f32x4*)(a.out + O_KV + (size_t)r * 256 + 4 * lane) = o;
            }
            const int i = lane & 31;
            float v = bf2f(zr[C_KROPE + i]);
            if (r < MP && lane < 32) a.out[O_KR + (size_t)r * 32 + i] = v;
            const float pv = __shfl_xor(v, 8);
            int b, s; bf16_t* kb;
            if (r >= MP) { const int t = (r - MP) & 2047; const float pos = (float)((i < 16) ? (t >> 6) : (t & 63));
                const float rev = pos * inv[i & 7] * 0.15915494309189535f; const float rf = rev - floorf(rev);
                const float cs = __builtin_amdgcn_cosf(rf), sn = __builtin_amdgcn_sinf(rf); v = v * cs + ((i & 8) ? pv : -pv) * sn;
                b = (r - MP) >> 11; s = 256 + t; kb = Ks + ((size_t)(b * 8) * SKS + s) * 96 + 64 + i;
                const bf16_t o = f2bf(v);
                if (lane < 32) { for (int h = 0; h < 8; ++h) kb[(size_t)h * SKS * 96] = o; }
            } else { b = r >> 8; s = r & 255; kb = Kp + ((size_t)(b * 8) * 256 + s) * 96 + 64 + i; const bf16_t o = f2bf(v);
                if (lane < 32) { for (int h = 0; h < 8; ++h) kb[(size_t)h * 256 * 96] = o; } }
        } else {
            const int rr = r - MTOK, b = rr >> 8, s = rr & 255, i = lane & 31;
            const bf16_t o = f2bf(a.in[I_CKR][(size_t)rr * 32 + i]); bf16_t* kb = Ks + ((size_t)(b * 8) * SKS + s) * 96 + 64 + i;
            if (lane < 32) { for (int h = 0; h < 8; ++h) kb[(size_t)h * SKS * 96] = o; }
        }
    }
}

constexpr int GL_LOW = 0, GL_WG = 8192, GL_BG = 16384, GL_SEG = 16896, GL_RED = 20992, GL_VT = 22528, GL_QF = 40960, GL_KF = GL_QF + 9216, GL_QB = GL_KF + 9216, GL_KB = GL_QB + 9216;
constexpr int GROW = 144;

__device__ __forceinline__ void gla_gates(const Args& a, int wv, LAS unsigned char* lds, int r0, int h, float (&cumF)[8], float (&cumB)[8], float& totF, float& totB) {
    const int tid = otid(wv), d = tid & 63, tg = tid >> 6;
    const bf16_t* Z = (const bf16_t*)(a.ws + WS_Z);
    LAS float* low = (LAS float*)(lds + GL_LOW); LAS float* wg = (LAS float*)(lds + GL_WG); LAS float* bg = (LAS float*)(lds + GL_BG); LAS float* seg = (LAS float*)(lds + GL_SEG);
    { const int t = tid >> 3, r4 = (tid & 7) * 4; const u32x2 w = *(const u32x2*)(Z + (size_t)(r0 + t) * ZP + C_GFL + r4);
      low[t * 32 + r4] = bflo(w.x); low[t * 32 + r4 + 1] = bfhi(w.x); low[t * 32 + r4 + 2] = bflo(w.y); low[t * 32 + r4 + 3] = bfhi(w.y); }
    { const int dir = tid >> 8, r = (tid >> 4) & 15, d4 = (tid & 15) * 4; const f32x4 w = *(const f32x4*)(a.in[dir ? I_WGB : I_WGF] + r * 256 + h * 64 + d4);
      *(LAS f32x4*)(wg + (dir * 16 + r) * 64 + d4) = w; }
    if (tid < 128) { const int dir = tid >> 6; bg[tid] = a.in[dir ? I_BGB : I_BGF][h * 64 + (tid & 63)]; }
    __syncthreads();
    float wf[16], wb[16];
#pragma unroll
    for (int r = 0; r < 16; ++r) { wf[r] = wg[r * 64 + d]; wb[r] = wg[(16 + r) * 64 + d]; }
    const float bf_ = bg[d], bb_ = bg[64 + d];
    float gf[8], gb[8];
#pragma unroll
    for (int i = 0; i < 8; ++i) { const int t = tg * 8 + i; float xf = bf_, xb = bb_;
#pragma unroll
        for (int r = 0; r < 16; ++r) { xf += low[t * 32 + r] * wf[r]; xb += low[t * 32 + 16 + r] * wb[r]; }
        gf[i] = logsigmoid_f(xf) * (1.f / 16.f); gb[i] = logsigmoid_f(xb) * (1.f / 16.f); }
#pragma unroll
    for (int i = 1; i < 8; ++i) gf[i] += gf[i - 1];
#pragma unroll
    for (int i = 6; i >= 0; --i) gb[i] += gb[i + 1];
    seg[tg * 64 + d] = gf[7]; seg[512 + tg * 64 + d] = gb[0];
    __syncthreads();
    float offF = 0.f, offB = 0.f; totF = 0.f; totB = 0.f;
#pragma unroll
    for (int g = 0; g < 8; ++g) { const float sf = seg[g * 64 + d], sb = seg[512 + g * 64 + d]; totF += sf; totB += sb; if (g < tg) offF += sf; if (g > tg) offB += sb; }
#pragma unroll
    for (int i = 0; i < 8; ++i) { cumF[i] = gf[i] + offF; cumB[i] = gb[i] + offB; }
}
__device__ __forceinline__ void gla_load_vT(const Args& a, int wv, LAS unsigned char* lds, int r0, int h) {
    const int tid = otid(wv), e = tid & 127, tq = tid >> 7;
    const bf16_t* Z = (const bf16_t*)(a.ws + WS_Z) + (size_t)r0 * ZP + C_GV + h * 128 + e;
    unsigned w[8];
#pragma unroll
    for (int i = 0; i < 8; ++i) { const unsigned lo = Z[(size_t)(tq * 16 + 2 * i) * ZP], hi = Z[(size_t)(tq * 16 + 2 * i + 1) * ZP]; w[i] = lo | (hi << 16); }
    LAS u32x4* p = (LAS u32x4*)(lds + GL_VT + e * GROW + tq * 32);
    p[0] = (u32x4){w[0], w[1], w[2], w[3]}; p[1] = (u32x4){w[4], w[5], w[6], w[7]};
}

__device__ __forceinline__ void gla_stepA(const Args& a, int wv, LAS unsigned char* lds, int u) {
    const int tid = otid(wv), lane = tid & 63, wave = __builtin_amdgcn_readfirstlane(tid >> 6), d = tid & 63, tg = tid >> 6, fr = lane & 15, fq = lane >> 4;
    const int cgi = u >> 2, h = u & 3, r0 = cgi * 64;
    const bf16_t* Z = (const bf16_t*)(a.ws + WS_Z);
    float cumF[8], cumB[8], totF, totB;
    gla_gates(a, wv, lds, r0, h, cumF, cumB, totF, totB);
    unsigned kf[4], kb[4];
#pragma unroll
    for (int i = 0; i < 4; ++i) { const float k0 = bf2f(Z[(size_t)(r0 + tg * 8 + 2 * i) * ZP + C_GK + h * 64 + d]), k1 = bf2f(Z[(size_t)(r0 + tg * 8 + 2 * i + 1) * ZP + C_GK + h * 64 + d]);
        kf[i] = cvt_pk_bf16(k0 * __expf(totF - cumF[2 * i]), k1 * __expf(totF - cumF[2 * i + 1]));
        kb[i] = cvt_pk_bf16(k0 * __expf(totB - cumB[2 * i]), k1 * __expf(totB - cumB[2 * i + 1])); }
    *(LAS u32x4*)(lds + GL_QF + d * GROW + tg * 16) = (u32x4){kf[0], kf[1], kf[2], kf[3]};
    *(LAS u32x4*)(lds + GL_KF + d * GROW + tg * 16) = (u32x4){kb[0], kb[1], kb[2], kb[3]};
    gla_load_vT(a, wv, lds, r0, h);
    if (tg == 0) { float* dec = (float*)(a.ws + WS_DEC) + (size_t)u * 128; dec[d] = __expf(totF); dec[64 + d] = __expf(totB); }
    __syncthreads();
    const int dir = wave >> 2, eb0 = 2 * (wave & 3);
    const LAS unsigned char* kd = lds + (dir ? GL_KF : GL_QF);
    float* CT = (float*)(a.ws + WS_CT) + ((size_t)u * 2 + dir) * 8192;
#pragma unroll
    for (int eb = 0; eb < 2; ++eb) {
        bf16x8 vf[2];
#pragma unroll
        for (int ks = 0; ks < 2; ++ks) vf[ks] = *(const LAS bf16x8*)(lds + GL_VT + (16 * (eb0 + eb) + fr) * GROW + (32 * ks + 8 * fq) * 2);
#pragma unroll
        for (int db = 0; db < 4; ++db) { f32x4 c = {0.f, 0.f, 0.f, 0.f};
#pragma unroll
            for (int ks = 0; ks < 2; ++ks) { const bf16x8 kfr = *(const LAS bf16x8*)(kd + (16 * db + fr) * GROW + (32 * ks + 8 * fq) * 2); c = __builtin_amdgcn_mfma_f32_16x16x32_bf16(vf[ks], kfr, c, 0, 0, 0); }
#pragma unroll
            for (int j = 0; j < 4; ++j) CT[(16 * (eb0 + eb) + 4 * fq + j) * 64 + 16 * db + fr] = c[j]; }
    }
    __syncthreads();
}

__device__ __forceinline__ void gla_scan(const Args& a, int wv, int vcu, int G) {
    const int gt = vcu * 512 + otid(wv), NT = G * 512;
    float* CTb = (float*)(a.ws + WS_CT); const float* DEC = (const float*)(a.ws + WS_DEC);
    for (int it = gt; it < 32768 + 262144; it += NT) {
        int seq, N, cg0, x;
        if (it < 32768) { seq = 16 + (it >> 14); x = it & 16383; N = 32; cg0 = 64 + 32 * (seq - 16); } else { const int j = it - 32768; seq = j >> 14; x = j & 16383; N = 4; cg0 = 4 * seq; }
        const int h = x >> 12, dir = (x >> 11) & 1, e = (x >> 4) & 127, d4 = (x & 15) * 4;
        f32x4 st = {0.f, 0.f, 0.f, 0.f};
        if (seq >= 16) { const float* s0 = a.in[dir ? I_SB : I_SF] + ((size_t)((seq - 16) * 4 + h) * 64) * 128 + e;
#pragma unroll
            for (int i = 0; i < 4; ++i) st[i] = s0[(size_t)(d4 + i) * 128]; }
        if (N == 32) {
            for (int n0 = 0; n0 < 32; n0 += 8) {
                f32x4 c[8], dc[8];
#pragma unroll
                for (int i = 0; i < 8; ++i) { const int n = dir ? (31 - n0 - i) : (n0 + i); const int u = (cg0 + n) * 4 + h;
                    c[i] = *(const f32x4*)(CTb + ((size_t)u * 2 + dir) * 8192 + e * 64 + d4); dc[i] = *(const f32x4*)(DEC + (size_t)u * 128 + dir * 64 + d4); }
#pragma unroll
                for (int i = 0; i < 8; ++i) { const int n = dir ? (31 - n0 - i) : (n0 + i); const int u = (cg0 + n) * 4 + h;
                    *(f32x4*)(CTb + ((size_t)u * 2 + dir) * 8192 + e * 64 + d4) = st; st = dc[i] * st + c[i]; }
            }
        } else {
            f32x4 c[4], dc[4];
#pragma unroll
            for (int i = 0; i < 4; ++i) { const int n = dir ? (3 - i) : i; const int u = (cg0 + n) * 4 + h;
                c[i] = *(const f32x4*)(CTb + ((size_t)u * 2 + dir) * 8192 + e * 64 + d4); dc[i] = *(const f32x4*)(DEC + (size_t)u * 128 + dir * 64 + d4); }
#pragma unroll
            for (int i = 0; i < 4; ++i) { const int n = dir ? (3 - i) : i; const int u = (cg0 + n) * 4 + h;
                *(f32x4*)(CTb + ((size_t)u * 2 + dir) * 8192 + e * 64 + d4) = st; st = dc[i] * st + c[i]; }
        }
        if (seq < 16) { float* o = a.out + (dir ? O_SB : O_SF) + ((size_t)(seq * 4 + h) * 64) * 128 + e;
#pragma unroll
            for (int i = 0; i < 4; ++i) o[(size_t)(d4 + i) * 128] = st[i]; }
    }
}

__device__ __forceinline__ void gla_stepC(const Args& a, int wv, LAS unsigned char* lds, int u) {
    const int tid = otid(wv), lane = tid & 63, wave = __builtin_amdgcn_readfirstlane(tid >> 6), d = tid & 63, tg = tid >> 6, fr = lane & 15, fq = lane >> 4;
    const int cgi = u >> 2, h = u & 3, r0 = cgi * 64;
    const bf16_t* Z = (const bf16_t*)(a.ws + WS_Z);
    float cumF[8], cumB[8], totF, totB;
    gla_gates(a, wv, lds, r0, h, cumF, cumB, totF, totB);
#pragma unroll
    for (int i = 0; i < 8; ++i) { const int t = tg * 8 + i; const float q = bf2f(Z[(size_t)(r0 + t) * ZP + C_GQ + h * 64 + d]) * 0.125f, k = bf2f(Z[(size_t)(r0 + t) * ZP + C_GK + h * 64 + d]);
        *(LAS bf16_t*)(lds + GL_QF + t * GROW + d * 2) = f2bf(q * __expf(cumF[i]));
        *(LAS bf16_t*)(lds + GL_KF + t * GROW + d * 2) = f2bf(k * __expf(-cumF[i]));
        *(LAS bf16_t*)(lds + GL_QB + t * GROW + d * 2) = f2bf(q * __expf(cumB[i]));
        *(LAS bf16_t*)(lds + GL_KB + t * GROW + d * 2) = f2bf(k * __expf(-cumB[i])); }
    gla_load_vT(a, wv, lds, r0, h);
    __syncthreads();
    const int ch = wave & 1, eq = wave >> 1;
    f32x4 oT[2][2];
#pragma unroll
    for (int i = 0; i < 2; ++i)
#pragma unroll
        for (int j = 0; j < 2; ++j) oT[i][j] = (f32x4){0.f, 0.f, 0.f, 0.f};
#pragma unroll
    for (int dir = 0; dir < 2; ++dir) {
        const LAS unsigned char* qe = lds + (dir ? GL_QB : GL_QF); const LAS unsigned char* ke = lds + (dir ? GL_KB : GL_KF);
        const float* ST = (const float*)(a.ws + WS_CT) + ((size_t)u * 2 + dir) * 8192;
        bf16x8 sf[2][2];
#pragma unroll
        for (int eb = 0; eb < 2; ++eb)
#pragma unroll
            for (int ks = 0; ks < 2; ++ks) { const float* p = ST + (16 * (2 * eq + eb) + fr) * 64 + 32 * ks + 8 * fq; const f32x4 x0 = *(const f32x4*)p, x1 = *(const f32x4*)(p + 4);
                u32x4 w; w.x = cvt_pk_bf16(x0[0], x0[1]); w.y = cvt_pk_bf16(x0[2], x0[3]); w.z = cvt_pk_bf16(x1[0], x1[1]); w.w = cvt_pk_bf16(x1[2], x1[3]); sf[eb][ks] = __builtin_bit_cast(bf16x8, w); }
#pragma unroll
        for (int cb = 0; cb < 2; ++cb) {
            const int cbg = 2 * ch + cb;
            bf16x8 qf[2];
#pragma unroll
            for (int ks = 0; ks < 2; ++ks) qf[ks] = *(const LAS bf16x8*)(qe + (16 * cbg + fr) * GROW + (32 * ks + 8 * fq) * 2);
            f32x4 att[4];
#pragma unroll
            for (int sb = 0; sb < 4; ++sb) {
                f32x4 acc = {0.f, 0.f, 0.f, 0.f};
                const bool need = dir == 0 ? (sb <= cbg) : (sb >= cbg);
                if (need) {
#pragma unroll
                    for (int ks = 0; ks < 2; ++ks) { const bf16x8 kfr = *(const LAS bf16x8*)(ke + (16 * sb + fr) * GROW + (32 * ks + 8 * fq) * 2); acc = __builtin_amdgcn_mfma_f32_16x16x32_bf16(kfr, qf[ks], acc, 0, 0, 0); }
                    if (sb == cbg) {
#pragma unroll
                        for (int j = 0; j < 4; ++j) { const int sl = 4 * fq + j; const bool keep = dir == 0 ? (sl <= fr) : (sl >= fr); acc[j] = keep ? acc[j] : 0.f; } }
                }
                att[sb] = acc;
            }
#pragma unroll
            for (int kp = 0; kp < 2; ++kp) {
                u32x4 w; w.x = cvt_pk_bf16(att[2 * kp][0], att[2 * kp][1]); w.y = cvt_pk_bf16(att[2 * kp][2], att[2 * kp][3]); w.z = cvt_pk_bf16(att[2 * kp + 1][0], att[2 * kp + 1][1]); w.w = cvt_pk_bf16(att[2 * kp + 1][2], att[2 * kp + 1][3]);
                const bf16x8 pb = __builtin_bit_cast(bf16x8, w);
#pragma unroll
                for (int eb = 0; eb < 2; ++eb) { const LAS unsigned char* vp = lds + GL_VT + (16 * (2 * eq + eb) + fr) * GROW + (32 * kp + 4 * fq) * 2;
                    const u32x2 v0 = *(const LAS u32x2*)vp, v1 = *(const LAS u32x2*)(vp + 32); const u32x4 vv = {v0.x, v0.y, v1.x, v1.y};
                    oT[eb][cb] = __builtin_amdgcn_mfma_f32_16x16x32_bf16(__builtin_bit_cast(bf16x8, vv), pb, oT[eb][cb], 0, 0, 0); }
            }
#pragma unroll
            for (int ks = 0; ks < 2; ++ks)
#pragma unroll
                for (int eb = 0; eb < 2; ++eb) oT[eb][cb] = __builtin_amdgcn_mfma_f32_16x16x32_bf16(sf[eb][ks], qf[ks], oT[eb][cb], 0, 0, 0);
        }
    }
    LAS float* red = (LAS float*)(lds + GL_RED);
#pragma unroll
    for (int cb = 0; cb < 2; ++cb) { float s = 0.f;
#pragma unroll
        for (int eb = 0; eb < 2; ++eb)
#pragma unroll
            for (int j = 0; j < 4; ++j) s += oT[eb][cb][j] * oT[eb][cb][j];
        s += __shfl_xor(s, 16); s += __shfl_xor(s, 32);
        if (fq == 0) red[eq * 64 + 16 * (2 * ch + cb) + fr] = s; }
    __syncthreads();
    bf16_t* MIX = (bf16_t*)(a.ws + WS_MIX);
#pragma unroll
    for (int cb = 0; cb < 2; ++cb) { const int c = 16 * (2 * ch + cb) + fr; const float tot = red[c] + red[64 + c] + red[128 + c] + red[192 + c]; const float rstd = rsqrtf(tot * (1.f / 128.f) + EPS);
#pragma unroll
        for (int eb = 0; eb < 2; ++eb) { const int e = 16 * (2 * eq + eb) + 4 * fq; const f32x4 gn = *(const f32x4*)(a.in[I_GLAN] + e);
            const u32x2 gw = *(const u32x2*)(Z + (size_t)(r0 + c) * ZP + C_GOUT + h * 128 + e);
            const float g0 = bflo(gw.x), g1 = bfhi(gw.x), g2 = bflo(gw.y), g3 = bfhi(gw.y);
            const f32x4 o = oT[eb][cb] * rstd * gn; u32x2 w; w.x = cvt_pk_bf16(o[0] * silu_f(g0), o[1] * silu_f(g1)); w.y = cvt_pk_bf16(o[2] * silu_f(g2), o[3] * silu_f(g3));
            *(u32x2*)(MIX + (size_t)(r0 + c) * D + 512 + h * 128 + e) = w; } }
    __syncthreads();
}

constexpr int AT_KROW = 208, AT_VROW = 144, AT_KB = 64 * AT_KROW  , AT_STAGE = AT_KB + 64 * AT_VROW  ;
__device__ __forceinline__ void attn_unit(const Args& a, int wv, LAS unsigned char* lds, int idx) {
    const int tid = otid(wv), lane = tid & 63, wave = __builtin_amdgcn_readfirstlane(tid >> 6), fr = lane & 15, fq = lane >> 4;
    int row0, S, nt; const bf16_t* Kb; const bf16_t* Vb; int h;
    if (idx < 256) { const int b = idx >> 7, qb = idx & 15; h = (idx >> 4) & 7; row0 = MP + b * 2048 + qb * 128; S = SKS; nt = 36;
        Kb = (const bf16_t*)(a.ws + WS_KS) + (size_t)(b * 8 + h) * SKS * 96; Vb = (const bf16_t*)(a.ws + WS_VTS) + (size_t)(b * 8 + h) * 64 * SKS; }
    else { const int j = idx - 256; const int b = j >> 4, qb = j & 1; h = (j >> 1) & 7; row0 = b * 256 + qb * 128; S = 256; nt = 4;
        Kb = (const bf16_t*)(a.ws + WS_KP) + (size_t)(b * 8 + h) * 256 * 96; Vb = (const bf16_t*)(a.ws + WS_VTP) + (size_t)(b * 8 + h) * 64 * 256; }
    const char* src[3]; unsigned step[3]; unsigned dst[3]; bool valid[3];
#pragma unroll
    for (int j = 0; j < 3; ++j) { const int ins = wave + 8 * j; valid[j] = ins < 22;
        if (ins < 13) { const int ck = ins * 64 + lane, r = ck / 13, cc = ck % 13; src[j] = (const char*)Kb + (size_t)r * 192 + (cc < 12 ? cc : 11) * 16; step[j] = 64 * 192; dst[j] = ins * 1024; }
        else { const int cv = (ins - 13) * 64 + lane, r = cv / 9, cc = cv % 9; src[j] = (const char*)Vb + (size_t)r * S * 2 + (cc < 8 ? cc : 7) * 16; step[j] = 128; dst[j] = AT_KB + (ins - 13) * 1024; } }
#define AT_ISSUE(t, buf) do { _Pragma("unroll") for (int j = 0; j < 3; ++j) if (valid[j]) \
        __builtin_amdgcn_global_load_lds((const unsigned*)(src[j] + (size_t)(t) * step[j]), (LAS unsigned*)(lds + (buf) * AT_STAGE + dst[j]), 16, 0, 0); } while (0)
    AT_ISSUE(0, 0);
    const bf16_t* Q = (const bf16_t*)(a.ws + WS_Q) + (size_t)(row0 + wave * 16 + fr) * 768 + h * 96 + 8 * fq;
    bf16x8 qf[3];
#pragma unroll
    for (int ks = 0; ks < 3; ++ks) qf[ks] = *(const bf16x8*)(Q + 32 * ks);
    float mrun = -1e30f, lsum = 0.f;
    f32x4 o[4];
#pragma unroll
    for (int i = 0; i < 4; ++i) o[i] = (f32x4){0.f, 0.f, 0.f, 0.f};
    for (int t = 0; t < nt; ++t) {
        VM_WAIT(); __syncthreads();
        if (t + 1 < nt) AT_ISSUE(t + 1, (t + 1) & 1);
        const LAS unsigned char* kt = lds + (t & 1) * AT_STAGE; const LAS unsigned char* vt = kt + AT_KB;
        f32x4 s[4];
#pragma unroll
        for (int kb = 0; kb < 4; ++kb) { s[kb] = (f32x4){0.f, 0.f, 0.f, 0.f};
#pragma unroll
            for (int ks = 0; ks < 3; ++ks) { const bf16x8 kf = *(const LAS bf16x8*)(kt + (16 * kb + fr) * AT_KROW + (32 * ks + 8 * fq) * 2); s[kb] = __builtin_amdgcn_mfma_f32_16x16x32_bf16(kf, qf[ks], s[kb], 0, 0, 0); } }
        float mx = fmaxf(fmaxf(fmaxf(s[0][0], s[0][1]), fmaxf(s[0][2], s[0][3])), fmaxf(fmaxf(s[1][0], s[1][1]), fmaxf(s[1][2], s[1][3])));
        mx = fmaxf(mx, fmaxf(fmaxf(fmaxf(s[2][0], s[2][1]), fmaxf(s[2][2], s[2][3])), fmaxf(fmaxf(s[3][0], s[3][1]), fmaxf(s[3][2], s[3][3]))));
        { const float m1 = __shfl_xor(mx, 16), m2 = __shfl_xor(mx, 32), m3 = __shfl_xor(mx, 48); mx = fmaxf(fmaxf(mx, m1), fmaxf(m2, m3)); }
        const float mnew = fmaxf(mrun, mx);
        f32x4 psv = {0.f, 0.f, 0.f, 0.f};
#pragma unroll
        for (int kb = 0; kb < 4; ++kb) { s[kb] = s[kb] - mnew;
#pragma unroll
            for (int j = 0; j < 4; ++j) s[kb][j] = __builtin_amdgcn_exp2f(s[kb][j]);
            psv += s[kb]; }
        const float ps = (psv[0] + psv[1]) + (psv[2] + psv[3]);
        if (__builtin_amdgcn_ballot_w64(mnew != mrun) != 0ull) {
            const float alpha = __builtin_amdgcn_exp2f(mrun - mnew); mrun = mnew; lsum *= alpha;
#pragma unroll
            for (int i = 0; i < 4; ++i) o[i] = o[i] * alpha;
        }
        lsum += ps;
#pragma unroll
        for (int kp = 0; kp < 2; ++kp) {
            u32x4 w; w.x = cvt_pk_bf16(s[2 * kp][0], s[2 * kp][1]); w.y = cvt_pk_bf16(s[2 * kp][2], s[2 * kp][3]); w.z = cvt_pk_bf16(s[2 * kp + 1][0], s[2 * kp + 1][1]); w.w = cvt_pk_bf16(s[2 * kp + 1][2], s[2 * kp + 1][3]);
            const bf16x8 pb = __builtin_bit_cast(bf16x8, w);
#pragma unroll
            for (int mb = 0; mb < 4; ++mb) { const LAS unsigned char* vp = vt + (16 * mb + fr) * AT_VROW + (32 * kp + 4 * fq) * 2;
                const u32x2 v0 = *(const LAS u32x2*)vp, v1 = *(const LAS u32x2*)(vp + 32); const u32x4 vv = {v0.x, v0.y, v1.x, v1.y};
                o[mb] = __builtin_amdgcn_mfma_f32_16x16x32_bf16(__builtin_bit_cast(bf16x8, vv), pb, o[mb], 0, 0, 0); }
        }
    }
    lsum += __shfl_xor(lsum, 16); lsum += __shfl_xor(lsum, 32);
    const float il = fast_rcp(lsum);
    bf16_t* MIX = (bf16_t*)(a.ws + WS_MIX) + (size_t)(row0 + wave * 16 + fr) * D + h * 64 + 4 * fq;
#pragma unroll
    for (int mb = 0; mb < 4; ++mb) { u32x2 w; w.x = cvt_pk_bf16(o[mb][0] * il, o[mb][1] * il); w.y = cvt_pk_bf16(o[mb][2] * il, o[mb][3] * il); *(u32x2*)(MIX + 16 * mb) = w; }
    __syncthreads();
#undef AT_ISSUE
}

__device__ unsigned g_bar[64 * 52];
#define GB(i) (g_bar + 64 * (i))
__device__ __forceinline__ unsigned gb_ld(unsigned* p) { return __hip_atomic_load(p, __ATOMIC_RELAXED, __HIP_MEMORY_SCOPE_AGENT); }
__device__ __forceinline__ unsigned gb_add(unsigned* p, unsigned v) { return __hip_atomic_fetch_add(p, v, __ATOMIC_RELAXED, __HIP_MEMORY_SCOPE_AGENT); }
__device__ __forceinline__ unsigned xcc_id() { return (unsigned)__builtin_amdgcn_s_getreg((3 << 11) | 20) & 0xFu; }
__device__ __forceinline__ void my_grid_barrier(unsigned nth, unsigned G, int tid, LAS unsigned* st) {
    asm volatile("s_waitcnt vmcnt(0) lgkmcnt(0)" ::: "memory");
    __syncthreads();
    if (tid == 0) {
        if (nth == 1u) {
            const unsigned x = xcc_id(); unsigned sum, cnt, mine;
            for (;;) { sum = 0u; cnt = 0u; mine = 0u;
#pragma unroll
                for (unsigned j = 0; j < 16; ++j) { const unsigned c = gb_ld(GB(4 + j)); sum += c; cnt += (c > 0u) ? 1u : 0u; mine = (j == x) ? c : mine; }
                if (sum >= G) break; __builtin_amdgcn_s_sleep(1); }
            st[0] = mine; st[1] = cnt; st[2] = x;
        }
        const unsigned nloc = st[0], nx = st[1], x = st[2];
        const unsigned old = gb_add(GB(20 + x), 1u);
        if (old + 1u == nth * nloc) {
            __builtin_amdgcn_fence(__ATOMIC_RELEASE, "agent");
            asm volatile("s_waitcnt vmcnt(0)" ::: "memory");
            const unsigned og = gb_add(GB(1), 1u);
            if (og + 1u == nth * nx) gb_add(GB(2), 1u);
            else while (gb_ld(GB(2)) < nth) __builtin_amdgcn_s_sleep(1);
            __builtin_amdgcn_fence(__ATOMIC_ACQUIRE, "agent");
            gb_add(GB(36 + x), 1u);
            asm volatile("s_waitcnt vmcnt(0)" ::: "memory");
        } else {
            while (gb_ld(GB(36 + x)) < nth) __builtin_amdgcn_s_sleep(1);
            __builtin_amdgcn_fence(__ATOMIC_ACQUIRE, "agent");
            asm volatile("s_waitcnt vmcnt(0)" ::: "memory");
        }
    }
    __syncthreads();
}
__device__ __forceinline__ void my_grid_barrier_finish(unsigned G, int tid) {
    if (tid == 0) {
        const unsigned old = gb_add(GB(0), 1u);
        if (old == G - 1u) { for (int i = 0; i < 52; ++i) __hip_atomic_store(GB(i), 0u, __ATOMIC_RELAXED, __HIP_MEMORY_SCOPE_AGENT); }
    }
}
constexpr int NPHASE = 11;
__global__ void __launch_bounds__(512, 2) mk_fwd(Args a) {
    const int wv = __builtin_amdgcn_readfirstlane((int)threadIdx.x >> 6);
    extern __shared__ __attribute__((aligned(16))) unsigned char lds_raw[];
    LAS unsigned char* lds = (LAS unsigned char*)lds_raw;
    const int G = gridDim.x, bx = blockIdx.x;
    const int vcu = (G % 8 == 0) ? (bx % 8) * (G / 8) + bx / 8 : bx;
    unsigned char* ws = a.ws;
    const int lo = a.ph_lo, hi = a.ph_hi;
#ifndef PHMASK
#define PHMASK 0x7ff
#endif
#define IN(k) (((PHMASK >> (k)) & 1) && lo <= (k) && (k) < hi)
#define SEAM(k) do { if (IN(k) && IN((k) + 1)) { ++nbar; my_grid_barrier(nbar, (unsigned)G, otid(wv), (LAS unsigned*)(lds + LDS_BYTES - 64)); } } while (0)
#ifndef PROBE_FILL
#define PROBE_FILL 0
#endif
    if (PROBE_FILL && lo == 0) { f32x4* p = (f32x4*)a.ws; const size_t n = (size_t)(PROBE_FILL_MIB) << 16; const float fv = PROBE_FILL_VAL;
        for (size_t i = (size_t)bx * 512 + threadIdx.x; i < n; i += (size_t)G * 512) { unsigned h = (unsigned)i * 2654435761u; h ^= h >> 15; h *= 2246822519u; h ^= h >> 13; const float r0 = (float)(h & 0xffff) * (1.f / 65536.f) - 0.5f + fv * 0.f; p[i] = (f32x4){r0, r0 * 1.7f, r0 * -0.3f, r0 + 0.1f}; } }
    if (PROBE_FILL == 2 && lo == 0 && bx == 0) { static const int szs[26] = {4194304, 4194304, 131072, 16384, 65536, 65536, 2048, 1024, 6291456, 6144, 1024, 2293760, 384, 294912, 256, 262144, 4096, 256, 4096, 256, 128, 1048576, 1024, 5767168, 2883584, 1024};
        float sm = 0.f; for (int i = 0; i < 26; ++i) { const int n = szs[i]; const int st = n > 1024 ? n - 1024 : 0; for (int j = st + (int)threadIdx.x; j < n; j += 512) sm += a.in[i][j]; for (int j = threadIdx.x; j < (n < 1024 ? n : 1024); j += 512) sm += a.in[i][j]; }
        ((float*)(a.ws))[threadIdx.x] = sm; }
    if (PROBE_FILL == 5 && lo == 0) { volatile float* p = (volatile float*)a.ws; const float big = p[0] * 0.f + 1e38f, tiny = p[1] * 0.f + 1e-38f, zero = p[2] * 0.f, neg = p[3] * 0.f - 1.f;
        float r = 0.f;
#if PROBE_EXC & 1
        r += big * big;
#endif
#if PROBE_EXC & 2
        r += tiny * tiny;
#endif
#if PROBE_EXC & 4
        r += 1.f / zero;
#endif
#if PROBE_EXC & 8
        r += __builtin_sqrtf(neg);
#endif
        p[4 + bx] = r; }
    unsigned nbar = 0;
    if (otid(wv) == 0) gb_add(GB(4 + xcc_id()), 1u);
    if (IN(0)) { for (int rep = 0; rep < PROBE_P0_REP; ++rep) { phase0(a, wv, lds, vcu, G); __syncthreads(); } } SEAM(0);
    if (IN(1)) { for (int rep = 0; rep < PROBE_ROW_REP; ++rep) phase1(a, wv, vcu, G); } SEAM(1);
    if (PROBE_HANG && lo == 1) { volatile unsigned* q = (volatile unsigned*)(a.ws + 8); while (*q != 0x12345678u) __builtin_amdgcn_s_sleep(20); }
    if (IN(2)) {
        pg8::Gemm g{(const bf16_t*)(ws + WS_H), (const bf16_t*)(ws + WS_WIN), D, D, D, wv}; pg8::Order S; S.init(MTOK, 2048, 1, G, bx);
        pg8::EpiZ E{(bf16_t*)(ws + WS_Z), (float*)(ws + WS_RSSQ), (float*)(ws + WS_RSSKV), 0};
        pg8::gemm_phase<pg8::EpiZ, pg8::Order>(lds, g, S, E);
    } SEAM(2);
    if (IN(3)) {
#ifndef P3MASK
#define P3MASK 0x3f
#endif
#if (P3MASK >> 0) & 1
        { pg8::Gemm g{(const bf16_t*)(ws + WS_Z) + C_QLAT, (const bf16_t*)(ws + WS_WUQ), ZP, 384, 384, wv}; pg8::Order S; S.init(MTOK, 768, 1, G, bx);
          pg8::EpiQ E{(bf16_t*)(ws + WS_Q), (const float*)(ws + WS_RSSQ)}; pg8::gemm_phase<pg8::EpiQ, pg8::Order>(lds, g, S, E); }
#endif
#if (P3MASK >> 1) & 1
        { pg8::Gemm g{(const bf16_t*)(ws + WS_Z) + C_KVLAT, (const bf16_t*)(ws + WS_WKF), ZP, 256, 256, wv}; pg8::Order S; S.init(MTOK, 512, 1, G, (bx + G - 96) % G);
          pg8::EpiK E{(bf16_t*)(ws + WS_KP), (bf16_t*)(ws + WS_KS), (const float*)(ws + WS_RSSKV), 0}; pg8::gemm_phase<pg8::EpiK, pg8::Order>(lds, g, S, E); }
#endif
#if (P3MASK >> 2) & 1
        { pg8::Gemm g{(const bf16_t*)(ws + WS_WVF), (const bf16_t*)(ws + WS_Z) + C_KVLAT, 256, ZP, 256, wv}; pg8::Order S; S.init(512, MTOK, 1, G, (bx + G - 160) % G);
          pg8::EpiVt E{(bf16_t*)(ws + WS_VTP), (bf16_t*)(ws + WS_VTS), (const float*)(ws + WS_RSSKV), 0}; pg8::gemm_phase<pg8::EpiVt, pg8::Order>(lds, g, S, E); }
#endif
#if (P3MASK >> 3) & 1
        { pg8::Gemm g{(const bf16_t*)(ws + WS_CACHEB), (const bf16_t*)(ws + WS_WKU), 256, 256, 256, wv}; pg8::Order S; S.init(512, 512, 1, G, (bx + G - 224) % G);
          pg8::EpiK E{(bf16_t*)(ws + WS_KP), (bf16_t*)(ws + WS_KS), (const float*)(ws + WS_RSSKV), 1}; pg8::gemm_phase<pg8::EpiK, pg8::Order>(lds, g, S, E); }
#endif
#if (P3MASK >> 4) & 1
        { pg8::Gemm g{(const bf16_t*)(ws + WS_WVU), (const bf16_t*)(ws + WS_CACHEB), 256, 256, 256, wv}; pg8::Order S; S.init(512, 512, 1, G, (bx + G - 228) % G);
          pg8::EpiVt E{(bf16_t*)(ws + WS_VTP), (bf16_t*)(ws + WS_VTS), (const float*)(ws + WS_RSSKV), 1}; pg8::gemm_phase<pg8::EpiVt, pg8::Order>(lds, g, S, E); }
#endif
        __syncthreads();
        { const int c2 = (bx + G - 232) % G;
          for (int u = c2; u < 512; u += G) gla_stepA(a, wv, lds, u);
          p3_row_extras(a, wv, c2 * 8 + (otid(wv) >> 6), G * 8); }
    } SEAM(3);
    if (IN(4)) {
        if (bx >= 224) {
        { pg8::Gemm g{(const bf16_t*)(ws + WS_H), (const bf16_t*)(ws + WS_WIN) + (size_t)2048 * D, D, D, D, wv}; pg8::Order S; S.init(MTOK, 256, 1, G, bx - 224);
          pg8::EpiZ E{(bf16_t*)(ws + WS_Z), (float*)(ws + WS_RSSQ), (float*)(ws + WS_RSSKV), 8}; pg8::gemm_phase<pg8::EpiZ, pg8::Order>(lds, g, S, E); }
        } else gla_scan(a, wv, bx, 224);
    } SEAM(4);
    if (IN(5)) {
        for (int rep = 0; rep < PROBE_ATT_REP; ++rep) for (int u = vcu; u < 512; u += G) attn_unit(a, wv, lds, u);
        for (int rep = 0; rep < PROBE_GLAC_REP; ++rep) for (int u = vcu; u < 512; u += G) gla_stepC(a, wv, lds, u);
    } SEAM(5);
    if (IN(6)) {
        pg8::Gemm g{(const bf16_t*)(ws + WS_MIX), (const bf16_t*)(ws + WS_WOUT), D, D, PROBE_K6, wv}; pg8::Order S; S.init(MTOK, D, 1024 / PROBE_K6, G, bx);
        pg8::EpiPart E{(bf16_t*)(ws + WS_P0), (bf16_t*)(ws + WS_P1A)}; pg8::gemm_phase<pg8::EpiPart, pg8::Order>(lds, g, S, E);
    } SEAM(6);
    if (IN(7)) { for (int rep = 0; rep < PROBE_ROW_REP; ++rep) phase6(a, wv, vcu, G); } SEAM(7);
    if (IN(8)) {
        pg8::Gemm g{(const bf16_t*)(ws + WS_H), (const bf16_t*)(ws + WS_WFFI), D, D, D, wv}; pg8::Order S; S.init(MTOK, 2 * DFF, 1, G, bx);
        pg8::EpiFFI E{(bf16_t*)(ws + WS_HFF)}; for (int rep = 0; rep < PROBE_FFI_REP; ++rep) pg8::gemm_phase<pg8::EpiFFI, pg8::Order>(lds, g, S, E);
    } SEAM(8);
    if (IN(9)) {
        pg8::Gemm g{(const bf16_t*)(ws + WS_HFF), (const bf16_t*)(ws + WS_WFFO), DFF, DFF, DFF / 2, wv}; pg8::Order S; S.init(MTOK, D, 2, G, bx);
        pg8::EpiPart E{(bf16_t*)(ws + WS_P0), (bf16_t*)(ws + WS_P1B)}; pg8::gemm_phase<pg8::EpiPart, pg8::Order>(lds, g, S, E);
    } SEAM(9);
    if (IN(10)) { for (int rep = 0; rep < PROBE_ROW_REP; ++rep) phase9(a, wv, vcu, G); }
    if (PROBE_DUMP) {
        if (PROBE_DUMP != 5 && PROBE_DUMP != 7) { ++nbar; } if (PROBE_DUMP != 5 && PROBE_DUMP != 7) my_grid_barrier(nbar, (unsigned)G, otid(wv), (LAS unsigned*)(lds + LDS_BYTES - 64));
        const bf16_t* src = (const bf16_t*)(ws + (PROBE_DUMP == 1 ? WS_Z : PROBE_DUMP == 2 ? WS_MIX : WS_H)); const int pitch = PROBE_DUMP == 1 ? ZP : D;
        for (size_t i = (size_t)bx * 512 + otid(wv); i < (size_t)MTOK * D; i += (size_t)G * 512) { const int r = (int)(i >> 10), c = (int)(i & 1023); a.out[i] = PROBE_DUMP == 7 ? 1.0f : PROBE_DUMP == 6 ? (r < 2304 ? bf2f(((const bf16_t*)(ws + WS_WIN))[(size_t)r * 1024 + c]) : 0.f) : PROBE_DUMP >= 4 ? xrow_ptr(a, r)[c] * 2.f : bf2f(src[(size_t)r * pitch + c]); }
        for (size_t i = O_KV + (size_t)bx * 512 + otid(wv); i < 10616832; i += (size_t)G * 512) a.out[i] = 0.f;
    }
    for (int xb = 0; xb < PROBE_XBAR; ++xb) { ++nbar; my_grid_barrier(nbar, (unsigned)G, otid(wv), (LAS unsigned*)(lds + LDS_BYTES - 64)); }
    if (nbar) my_grid_barrier_finish((unsigned)G, otid(wv));
#undef IN
#undef SEAM
}

extern "C" void kernel_launch(void* const* d_in, const int* in_sizes, int n_in, void* d_out, int out_size, void* d_ws, size_t ws_size, hipStream_t stream) {
    static int grid = 0;
    if (grid == 0) {
        int dev = 0, cus = 0;
        static const int exp_sizes[26] = {4194304, 4194304, 131072, 16384, 65536, 65536, 2048, 1024, 6291456, 6144, 1024, 2293760, 384, 294912, 256, 262144, 4096, 256, 4096, 256, 128, 1048576, 1024, 5767168, 2883584, 1024};
        bool okk = (n_in == 26); for (int i = 0; okk && i < 26; ++i) okk = (in_sizes[i] == exp_sizes[i]);
        if (!okk || out_size != 10616832) { fprintf(stderr, "kernel_launch: unexpected input sizes\n"); grid = -1; return; }
        if (n_in != 26 || ws_size < 198 * MiB) { fprintf(stderr, "kernel_launch: unexpected n_in %d / ws %zu\n", n_in, ws_size); grid = -1; return; }
        hipGetDevice(&dev); hipDeviceGetAttribute(&cus, hipDeviceAttributeMultiprocessorCount, dev);
        if (hipFuncSetAttribute((const void*)mk_fwd, hipFuncAttributeMaxDynamicSharedMemorySize, LDS_BYTES) != hipSuccess) { fprintf(stderr, "kernel_launch: hipFuncSetAttribute failed\n"); grid = -1; return; }
        int per_cu = 0;
        if (hipOccupancyMaxActiveBlocksPerMultiprocessor(&per_cu, (const void*)mk_fwd, 512, LDS_BYTES) != hipSuccess || per_cu < 1) { fprintf(stderr, "kernel_launch: occupancy query says %d\n", per_cu); per_cu = 1; }
        (void)hipGetLastError();
        if (cus < 256) { fprintf(stderr, "kernel_launch: needs 256 CUs, got %d\n", cus); grid = -1; return; }
        grid = 256;
    }
    if (grid < 0) return;
    Args a{};
    for (int i = 0; i < 26; ++i) a.in[i] = (const float*)d_in[i];
    a.out = (float*)d_out; a.ws = (unsigned char*)d_ws;
#if MK_PER_PHASE_LAUNCH
    for (int p = 0; p < NPHASE; ++p) { if (PROBE_ONLY_LAUNCH >= 0 && p != PROBE_ONLY_LAUNCH) continue; a.ph_lo = p; a.ph_hi = p + 1; hipLaunchKernelGGL(mk_fwd, dim3(grid), dim3(512), LDS_BYTES, stream, a); }
#else
    a.ph_lo = 0; a.ph_hi = NPHASE;
#if MK_COOP
    void* args[] = {&a};
    hipError_t e = hipLaunchCooperativeKernel((const void*)mk_fwd, dim3(grid), dim3(512), args, LDS_BYTES, stream);
    if (e != hipSuccess) fprintf(stderr, "cooperative launch failed: %s (grid %d)\n", hipGetErrorString(e), grid);
#else
    hipLaunchKernelGGL(mk_fwd, dim3(grid), dim3(512), LDS_BYTES, stream, a);
#endif
#endif
}
```

```cpp
#include <hip/hip_runtime.h>
#include <hip/hip_cooperative_groups.h>
#include <cstdio>
#include <cstdint>
namespace cg = cooperative_groups;

#define PROBE_FILL 0
#define PROBE_EXC 0
#define PROBE_BLO 0
#define PROBE_BHI 256
#define PROBE_RSTRIDE 1
#define PROBE_REP 1
#define PROBE_XLO 0
#define PROBE_XHI 8
#define PROBE_HANG 0
#define PROBE_ATT_REP 1
#define PROBE_GLAC_REP 1
#define PROBE_FFI_REP 1
#define PROBE_XBAR 0
#define PROBE_P0_REP 1
#define PROBE_ROW_REP 1
#define PROBE_P3_REP 1
#define PROBE_DUMP 0
#define PROBE_STATS 0
#define PROBE_K6 512
#define PROBE_ONLY_LAUNCH -1
#define PROBE_NOSTORE 0
#define PROBE_FILL_MIB 256
#define PROBE_FILL_VAL 1.2345f
#ifndef PROBE_MUL
#define PROBE_MUL 1.f
#endif
#ifndef PROBE_MODOFF
#define PROBE_MODOFF 0u
#endif
#ifndef MK_COOP
#define MK_COOP 0
#endif
#ifndef MK_PER_PHASE_LAUNCH
#define MK_PER_PHASE_LAUNCH 0
#endif

#define LAS __attribute__((address_space(3)))
typedef unsigned short bf16_t;
typedef short bf16x8 __attribute__((ext_vector_type(8)));
typedef float f32x4 __attribute__((ext_vector_type(4)));
typedef float f32x2 __attribute__((ext_vector_type(2)));
typedef unsigned u32x4 __attribute__((ext_vector_type(4)));
typedef unsigned u32x2 __attribute__((ext_vector_type(2)));

constexpr int D = 1024, MTOK = 8192, MP = 4096;
constexpr int ZP = 2304;
constexpr int C_QLAT = 0, C_KVLAT = 384, C_KROPE = 640, C_GQ = 672, C_GK = 928, C_GV = 1184, C_GFL = 1696, C_GOUT = 1728;
constexpr int DFF = 2816;
constexpr float EPS = 1e-6f;
constexpr float QSCALE = 0.10206207261596577f * 1.4426950408889634f;
constexpr int SKS = 2304;

constexpr size_t MiB = 1u << 20;
constexpr size_t WS_WIN = 1 * MiB;
constexpr size_t WS_WUQ = 6 * MiB;
constexpr size_t WS_WKF = 7 * MiB, WS_WVF = 7 * MiB + 256 * 1024;
constexpr size_t WS_WKU = 7 * MiB + 512 * 1024, WS_WVU = 7 * MiB + 768 * 1024;
constexpr size_t WS_WOUT = 8 * MiB;
constexpr size_t WS_WFFI = 10 * MiB;
constexpr size_t WS_WFFO = 21 * MiB;
constexpr size_t WS_BAR = 27 * MiB - 4096;
constexpr size_t WS_MOD = 27 * MiB;
constexpr size_t WS_RSSQ = 29 * MiB;
constexpr size_t WS_RSSKV = WS_RSSQ;
constexpr size_t WS_MODF = 27 * MiB + 320 * 1024;
constexpr size_t WS_CACHEB = 27 * MiB + 512 * 1024;
constexpr size_t WS_DEC = 28 * MiB;
constexpr size_t WS_H = 32 * MiB;
constexpr size_t WS_Z = 48 * MiB;
constexpr size_t WS_Q = 84 * MiB;
constexpr size_t WS_HFF = 48 * MiB;
constexpr size_t WS_KP = 96 * MiB;
constexpr size_t WS_KS = 102 * MiB;
constexpr size_t WS_VTP = 109 * MiB;
constexpr size_t WS_VTS = 113 * MiB;
constexpr size_t WS_CT = 118 * MiB;
constexpr size_t WS_MIX = 150 * MiB;
constexpr size_t WS_X1 = 166 * MiB;
constexpr size_t WS_P0 = 96 * MiB;
constexpr size_t WS_P1A = 48 * MiB, WS_P1B = 128 * MiB;
constexpr size_t O_Y = 0, O_KV = 8388608, O_KR = O_KV + 1048576, O_SF = O_KR + 131072, O_SB = O_SF + 524288;

constexpr int LDS_BYTES = 147456;

__device__ __forceinline__ unsigned f2bf_sw(float f) { unsigned u = __builtin_bit_cast(unsigned, f); return (u + 0x7fffu + ((u >> 16) & 1u)) >> 16; }
__device__ __forceinline__ unsigned cvt_pk_bf16(float lo, float hi) { unsigned r; asm volatile("v_cvt_pk_bf16_f32 %0, %1, %2" : "=v"(r) : "v"(lo), "v"(hi)); return r; }
__device__ __forceinline__ bf16_t f2bf(float f) { return (bf16_t)(cvt_pk_bf16(f, 0.f) & 0xffffu); }
__device__ __forceinline__ float bf2f(bf16_t b) { return __uint_as_float((unsigned)b << 16); }
__device__ __forceinline__ float bflo(unsigned w) { return __uint_as_float(w << 16); }
__device__ __forceinline__ float bfhi(unsigned w) { return __uint_as_float(w & 0xffff0000u); }
__device__ __forceinline__ float wave_sum(float v) {
#pragma unroll
    for (int o = 1; o < 64; o <<= 1) v += __shfl_xor(v, o);
    return v;
}
__device__ __forceinline__ float fast_rcp(float x) { return __builtin_amdgcn_rcpf(x); }
__device__ __forceinline__ float silu_f(float a) { return a * fast_rcp(1.f + __expf(-a)); }
__device__ __forceinline__ float logsigmoid_f(float x) { return fminf(x, 0.f) - __logf(1.f + __expf(-fabsf(x))); }
__device__ __forceinline__ int opaque_lane() { int l; asm volatile("v_mbcnt_lo_u32_b32 %0, -1, 0\n\tv_mbcnt_hi_u32_b32 %0, -1, %0" : "=v"(l)); return l; }
__device__ __forceinline__ int otid(int wv) { int t = (int)threadIdx.x; asm volatile("" : "+v"(t)); return t; }
#define LDS_WAIT() asm volatile("s_waitcnt lgkmcnt(0)" ::: "memory")
#define VM_WAIT() asm volatile("s_waitcnt vmcnt(0)" ::: "memory")

namespace pg8 {
constexpr int BM = 256, BK = 64, HALF = 128, HTB = HALF * BK * 2, STAGE_BYTES = 8 * HTB, NXCD = 8, WGM = 8;
__host__ __device__ __forceinline__ int lds_byte(int r, int c) { const int st = (r >> 4) * 2 + (c >> 5), rr = r & 15, cc = c & 31, ob = rr * 64 + cc * 2; return st * 1024 + (ob ^ (((ob >> 9) & 1) << 5)); }
__host__ __device__ __forceinline__ void stage_rc(int b, int& R, int& C) { const int st = b / 1024, sb = b % 1024, swz = sb ^ (((sb >> 9) & 1) << 5); R = (st >> 1) * 16 + swz / 64; C = (st & 1) * 32 + (swz % 64) / 2; }
__host__ __device__ __forceinline__ int perm32(int rho) { const int n = rho >> 4, i = rho & 15; return 8 * (i >> 2) + 4 * n + (i & 3); }

struct Unit { int pm, pn, ks; };
struct Gemm { const bf16_t* A; const bf16_t* Bt; int lda, ldb, K, wv; };

struct Order {
    int nM, nN, nNs, nwg, G, c;
    __device__ void init(int M, int N, int nsplit, int G_, int c_) { nM = M / BM; nN = N / BM; nNs = nN * nsplit; nwg = nM * nNs; G = G_; c = c_; }
    __device__ bool next(int i, Unit& u) const {
        const long L = (long)i * G + c; if (L >= nwg) return false;
        int wgid = (int)L; { const int q = nwg / NXCD, r = nwg % NXCD, xcd = wgid % NXCD, off = wgid / NXCD; wgid = (xcd < r ? xcd * (q + 1) : r * (q + 1) + (xcd - r) * q) + off; }
        const int nig = WGM * nNs, gid = wgid / nig, fm = gid * WGM, gsz = (nM - fm) < WGM ? (nM - fm) : WGM;
        u.pm = fm + ((wgid % nig) % gsz); const int pn2 = (wgid % nig) / gsz; u.pn = pn2 % nN; u.ks = pn2 / nN; return true;
    }
};

template <class Epi, class Sched, bool ALIGN_EPI = true, bool SP2 = true>
__device__ __forceinline__ void gemm_phase(LAS unsigned char* lds, const Gemm g, const Sched& S, const Epi& E) {
    const int tid = otid(g.wv), wid = g.wv, lane = tid & 63, wr = wid >> 2, wc = wid & 3, fr = lane & 15, fq = lane >> 4;
    const int K = g.K, nt = K / BK;
    unsigned voffA[2], voffB[2];
#pragma unroll
    for (int i = 0; i < 2; ++i) { int R, C; stage_rc(tid * 16 + i * 8192, R, C); const int Rb = Epi::PERM ? ((R & ~31) + perm32(R & 31)) : R;
        voffA[i] = (unsigned)(R * g.lda + C) * 2u; voffB[i] = (unsigned)(Rb * g.ldb + C) * 2u; }
    const size_t kstep = (size_t)(BK * 2);
    const size_t hstepA = (size_t)HALF * g.lda * 2, hstepB = (size_t)HALF * g.ldb * 2;
    const size_t tstepA = 2 * hstepA, tstepB = 2 * hstepB;
    const size_t ksplit = (size_t)K * 2;
    const unsigned ldsw = (unsigned)wid * 1024u;
    const int aoff = lds_byte(wr * 64 + fr, fq * 8), boff = lds_byte(wc * 32 + fr, fq * 8);
#define PG8_SA(b, h) (((b) * 2 + (h)) * HTB)
#define PG8_SB(b, h) ((4 + (b) * 2 + (h)) * HTB)
#define PG8_STAGE(bufoff, gbase, voff) do { _Pragma("unroll") for (int _i = 0; _i < 2; ++_i) \
        __builtin_amdgcn_global_load_lds((const unsigned*)((const char*)(gbase) + (voff)[_i]), (LAS unsigned*)(lds + (bufoff) + ldsw + _i * 8192), 16, 0, 0); } while (0)
#define PG8_LDA(dst, b, h) do { _Pragma("unroll") for (int m = 0; m < 4; ++m) _Pragma("unroll") for (int k = 0; k < 2; ++k) dst[m][k] = *(const LAS bf16x8*)(lds + PG8_SA(b, h) + aoff + m * 2048 + k * 1024); } while (0)
#define PG8_LDB(dst, b, h) do { _Pragma("unroll") for (int n = 0; n < 2; ++n) _Pragma("unroll") for (int k = 0; k < 2; ++k) dst[n][k] = *(const LAS bf16x8*)(lds + PG8_SB(b, h) + boff + n * 2048 + k * 1024); } while (0)
#define PG8_MMA(ai, bj, At, Bt) do { __builtin_amdgcn_s_setprio(1); _Pragma("unroll") for (int m = 0; m < 4; ++m) _Pragma("unroll") for (int n = 0; n < 2; ++n) _Pragma("unroll") for (int k = 0; k < 2; ++k) \
        acc[ai][bj][m][n] = __builtin_amdgcn_mfma_f32_16x16x32_bf16(Bt[n][k], At[m][k], acc[ai][bj][m][n], 0, 0, 0); __builtin_amdgcn_s_setprio(0); } while (0)
#define PG8_WAIT_V(n) asm volatile("s_waitcnt vmcnt(" #n ")" ::: "memory")
#define PG8_WAIT_L(n) asm volatile("s_waitcnt lgkmcnt(" #n ")" ::: "memory")
#define PG8_BAR __builtin_amdgcn_s_barrier()
#define PG8_SCHED __builtin_amdgcn_sched_barrier(0)
    Unit cur, nxt; int ui = 0;
    if (!S.next(0, cur)) return;
    f32x4 acc[2][2][4][2];
#pragma unroll
    for (int a = 0; a < 2; ++a)
#pragma unroll
        for (int b = 0; b < 2; ++b)
#pragma unroll
            for (int m = 0; m < 4; ++m)
#pragma unroll
                for (int n = 0; n < 2; ++n) acc[a][b][m][n] = (f32x4){0.f, 0.f, 0.f, 0.f};
    bf16x8 At[4][2], B0[2][2], B1[2][2];
    const char* cA = (const char*)g.A + (size_t)cur.pm * tstepA + (size_t)cur.ks * ksplit; const char* cB = (const char*)g.Bt + (size_t)cur.pn * tstepB + (size_t)cur.ks * ksplit;
    if constexpr (SP2) {
        PG8_STAGE(PG8_SB(0, 0), cB, voffB); PG8_STAGE(PG8_SB(0, 1), cB + hstepB, voffB); PG8_STAGE(PG8_SA(0, 0), cA, voffA); PG8_STAGE(PG8_SA(0, 1), cA + hstepA, voffA);
        if (wr == 1) PG8_BAR;
        PG8_WAIT_V(2); PG8_BAR;
        PG8_STAGE(PG8_SB(1, 0), cB + kstep, voffB); PG8_STAGE(PG8_SA(1, 0), cA + kstep, voffA); PG8_STAGE(PG8_SB(1, 1), cB + hstepB + kstep, voffB);
        PG8_WAIT_V(6); PG8_BAR;
    } else {
        PG8_STAGE(PG8_SB(0, 0), cB, voffB); PG8_STAGE(PG8_SA(0, 0), cA, voffA); PG8_STAGE(PG8_SB(0, 1), cB + hstepB, voffB); PG8_STAGE(PG8_SA(0, 1), cA + hstepA, voffA);
        if (wr == 1) PG8_BAR;
        PG8_WAIT_V(4); PG8_BAR;
        PG8_STAGE(PG8_SB(1, 0), cB + kstep, voffB); PG8_STAGE(PG8_SA(1, 0), cA + kstep, voffA); PG8_STAGE(PG8_SB(1, 1), cB + hstepB + kstep, voffB);
        PG8_WAIT_V(6); PG8_BAR;
    }
    for (;;) {
        const bool has_next = S.next(ui + 1, nxt);
        const char* nA = has_next ? (const char*)g.A + (size_t)nxt.pm * tstepA + (size_t)nxt.ks * ksplit : cA; const char* nB = has_next ? (const char*)g.Bt + (size_t)nxt.pn * tstepB + (size_t)nxt.ks * ksplit : cB;
#pragma nounroll
        for (int t = 0; t < nt; t += 2) {
            const bool last = (t == nt - 2);
            const char* a1 = cA + (size_t)(t + 1) * kstep;
            const char* a2 = last ? nA : cA + (size_t)(t + 2) * kstep; const char* b2 = last ? nB : cB + (size_t)(t + 2) * kstep;
            const char* a3 = a2 + kstep; const char* b3 = b2 + kstep;
            if constexpr (SP2) {
            PG8_LDB(B0, 0, 0); PG8_LDB(B1, 0, 1); PG8_SCHED; PG8_LDA(At, 0, 0); PG8_STAGE(PG8_SA(1, 1), a1 + hstepA, voffA);
            PG8_WAIT_V(8); PG8_WAIT_L(0); PG8_BAR; PG8_MMA(0, 0, At, B0); PG8_MMA(0, 1, At, B1); PG8_BAR; PG8_SCHED;
            PG8_LDA(At, 0, 1); PG8_STAGE(PG8_SB(0, 0), b2, voffB); PG8_STAGE(PG8_SB(0, 1), b2 + hstepB, voffB); PG8_STAGE(PG8_SA(0, 0), a2, voffA);
            PG8_WAIT_V(8); PG8_WAIT_L(0); PG8_BAR; PG8_MMA(1, 0, At, B0); PG8_MMA(1, 1, At, B1); PG8_BAR; PG8_SCHED;
            PG8_LDB(B0, 1, 0); PG8_LDB(B1, 1, 1); PG8_SCHED; PG8_LDA(At, 1, 0); PG8_STAGE(PG8_SA(0, 1), a2 + hstepA, voffA);
            PG8_WAIT_V(8); PG8_WAIT_L(0); PG8_BAR; PG8_MMA(0, 0, At, B0); PG8_MMA(0, 1, At, B1); PG8_BAR; PG8_SCHED;
            PG8_LDA(At, 1, 1); PG8_STAGE(PG8_SB(1, 0), b3, voffB); PG8_STAGE(PG8_SB(1, 1), b3 + hstepB, voffB); PG8_STAGE(PG8_SA(1, 0), a3, voffA);
            PG8_WAIT_V(8); PG8_WAIT_L(0); PG8_BAR; PG8_MMA(1, 0, At, B0); PG8_MMA(1, 1, At, B1); PG8_BAR; PG8_SCHED;
            } else {
            PG8_LDB(B0, 0, 0); PG8_SCHED; PG8_LDA(At, 0, 0); PG8_STAGE(PG8_SA(1, 1), a1 + hstepA, voffA);
            PG8_WAIT_L(8); PG8_BAR; PG8_WAIT_L(0); PG8_MMA(0, 0, At, B0); PG8_BAR; PG8_SCHED;
            PG8_LDB(B1, 0, 1); PG8_STAGE(PG8_SB(0, 0), b2, voffB);
            PG8_BAR; PG8_WAIT_L(0); PG8_MMA(0, 1, At, B1); PG8_BAR;
            PG8_LDA(At, 0, 1); PG8_STAGE(PG8_SA(0, 0), a2, voffA);
            PG8_BAR; PG8_WAIT_L(0); PG8_MMA(1, 0, At, B0); PG8_BAR; PG8_SCHED;
            PG8_STAGE(PG8_SB(0, 1), b2 + hstepB, voffB);
            PG8_WAIT_V(6); PG8_BAR; PG8_MMA(1, 1, At, B1); PG8_BAR;
            PG8_LDB(B0, 1, 0); PG8_SCHED; PG8_LDA(At, 1, 0); PG8_STAGE(PG8_SA(0, 1), a2 + hstepA, voffA);
            PG8_WAIT_L(8); PG8_BAR; PG8_WAIT_L(0); PG8_MMA(0, 0, At, B0); PG8_BAR; PG8_SCHED;
            PG8_LDB(B1, 1, 1); PG8_STAGE(PG8_SB(1, 0), b3, voffB);
            PG8_BAR; PG8_WAIT_L(0); PG8_MMA(0, 1, At, B1); PG8_BAR;
            PG8_LDA(At, 1, 1); PG8_STAGE(PG8_SA(1, 0), a3, voffA);
            PG8_BAR; PG8_WAIT_L(0); PG8_MMA(1, 0, At, B0); PG8_BAR; PG8_SCHED;
            PG8_STAGE(PG8_SB(1, 1), b3 + hstepB, voffB);
            PG8_WAIT_V(6); PG8_BAR; PG8_MMA(1, 1, At, B1); PG8_BAR;
            }
        }
        if constexpr (ALIGN_EPI) { if (wr == 0) PG8_BAR; }
        E(acc, cur, wr, wc, fr, fq);
        if (!has_next) break;
#pragma unroll
        for (int a = 0; a < 2; ++a)
#pragma unroll
            for (int b = 0; b < 2; ++b)
#pragma unroll
                for (int m = 0; m < 4; ++m)
#pragma unroll
                    for (int n = 0; n < 2; ++n) acc[a][b][m][n] = (f32x4){0.f, 0.f, 0.f, 0.f};
        cur = nxt; cA = nA; cB = nB; ++ui;
        if constexpr (ALIGN_EPI) { if (wr == 1) PG8_BAR; }
    }
    PG8_WAIT_V(0);
    if constexpr (!ALIGN_EPI) { if (wr == 0) PG8_BAR; }
    PG8_BAR;
#undef PG8_SA
#undef PG8_SB
#undef PG8_STAGE
#undef PG8_LDA
#undef PG8_LDB
#undef PG8_MMA
#undef PG8_WAIT_V
#undef PG8_WAIT_L
#undef PG8_BAR
#undef PG8_SCHED
}

__device__ __forceinline__ float rss_q(const float* rss, int row) { float s = 0.f;
#pragma unroll
    for (int p = 0; p < 12; ++p) s += rss[(size_t)p * MTOK + row]; return s; }
__device__ __forceinline__ float rss_kv(const float* rss, int row) { float s = 0.f;
#pragma unroll
    for (int p = 12; p < 20; ++p) s += rss[(size_t)p * MTOK + row]; return s; }
#define EPI_ROWS_BEGIN _Pragma("unroll") for (int ai = 0; ai < 2; ++ai) _Pragma("unroll") for (int m = 0; m < 4; ++m) { const int row = u.pm * BM + wr * 64 + fr + ai * HALF + m * 16;
#define EPI_ROWS_END asm volatile("" ::: "memory"); }

struct EpiZ {
    static constexpr bool PERM = true;
    bf16_t* Z; float* rssq; float* rsskv; int pn_off;
    __device__ __forceinline__ void operator()(const f32x4 (&acc)[2][2][4][2], const Unit& u, int wr, int wc, int fr_, int fq_) const {
        int lane_e = (int)threadIdx.x & 63; asm volatile("" : "+v"(lane_e)); const int fr = lane_e & 15, fq = lane_e >> 4;
        const int col0 = (u.pn + pn_off) * BM + wc * 32 + 8 * fq;
        EPI_ROWS_BEGIN
            bf16_t* rowp = Z + (size_t)row * ZP + col0;
#pragma unroll
            for (int bj = 0; bj < 2; ++bj) { const f32x4 v0 = acc[ai][bj][m][0], v1 = acc[ai][bj][m][1];
                u32x4 w; w.x = cvt_pk_bf16(v0[0], v0[1]); w.y = cvt_pk_bf16(v0[2], v0[3]); w.z = cvt_pk_bf16(v1[0], v1[1]); w.w = cvt_pk_bf16(v1[2], v1[3]);
                *(u32x4*)(rowp + bj * HALF) = w;
                const int hc = 2 * (u.pn + pn_off) + bj;
                if (hc < 5) { float s = (v0[0] * v0[0] + v0[1] * v0[1]) + (v0[2] * v0[2] + v0[3] * v0[3]) + (v1[0] * v1[0] + v1[1] * v1[1]) + (v1[2] * v1[2] + v1[3] * v1[3]);
                    s += __shfl_xor(s, 16); s += __shfl_xor(s, 32);
                    if (fq == 0) rssq[(size_t)(hc * 4 + wc) * MTOK + row] = s; } }
        EPI_ROWS_END
    }
};

struct EpiQ {
    static constexpr bool PERM = true;
    bf16_t* Q; const float* rssq;
    __device__ __forceinline__ void operator()(const f32x4 (&acc)[2][2][4][2], const Unit& u, int wr, int wc, int fr_, int fq_) const {
        int lane_e = (int)threadIdx.x & 63; asm volatile("" : "+v"(lane_e)); const int fr = lane_e & 15, fq = lane_e >> 4;
        const int col0 = u.pn * BM + wc * 32 + 8 * fq;
        const float inv[8] = {1.f, 0.316227766f, 0.1f, 0.0316227766f, 0.01f, 0.00316227766f, 0.001f, 0.000316227766f};
        EPI_ROWS_BEGIN
            const float rs = rsqrtf(rss_q(rssq, row) * (1.f / 384.f) + EPS) * QSCALE;
            const int t = (row - MP) & 2047;
#pragma unroll
            for (int bj = 0; bj < 2; ++bj) { const int c = col0 + bj * HALF; const int j0 = c % 96;
                const bool rp = (row >= MP && j0 >= 64);
                const float pos = (float)((j0 < 80) ? (t >> 6) : (t & 63)) * 0.15915494309189535f;
                const float sg = (j0 & 8) ? 1.f : -1.f;
#pragma unroll
                for (int n = 0; n < 2; ++n) {
                    f32x4 v = acc[ai][bj][m][n] * rs;
#pragma unroll
                    for (int i = 0; i < 4; ++i) { const float p = __shfl_xor(v[i], 16);
                        const float rev = pos * inv[4 * n + i]; const float rf = rev - floorf(rev);
                        const float cs = __builtin_amdgcn_cosf(rf), sn = __builtin_amdgcn_sinf(rf); v[i] = rp ? v[i] * cs + sg * p * sn : v[i]; }
                    u32x2 w; w.x = cvt_pk_bf16(v[0], v[1]); w.y = cvt_pk_bf16(v[2], v[3]);
                    *(u32x2*)(Q + (size_t)row * 768 + c + 4 * n) = w; } }
        EPI_ROWS_END
    }
};

struct EpiK {
    static constexpr bool PERM = true;
    bf16_t* Kp; bf16_t* Ks; const float* rsskv; int ctx;
    __device__ __forceinline__ void operator()(const f32x4 (&acc)[2][2][4][2], const Unit& u, int wr, int wc, int fr_, int fq_) const {
        int lane_e = (int)threadIdx.x & 63; asm volatile("" : "+v"(lane_e)); const int fr = lane_e & 15, fq = lane_e >> 4;
        EPI_ROWS_BEGIN
            float rs = 1.f; unsigned off; bool smp;
            if (ctx) { off = ((unsigned)(row >> 8) * 8u * SKS + (row & 255)) * 96u; smp = true; }
            else { rs = rsqrtf(rss_kv(rsskv, row) * (1.f / 256.f) + EPS);
                if (row < MP) { off = ((unsigned)(row >> 8) * 8u * 256u + (row & 255)) * 96u; smp = false; } else { off = ((unsigned)((row - MP) >> 11) * 8u * SKS + 256u + ((row - MP) & 2047)) * 96u; smp = true; } }
            bf16_t* base = smp ? Ks : Kp; const unsigned hs = (smp ? SKS : 256) * 96u;
#pragma unroll
            for (int bj = 0; bj < 2; ++bj) { const unsigned h = 4 * u.pn + 2 * bj + (wc >> 1); const unsigned j = (wc & 1) * 32 + 8 * fq;
                const f32x4 v0 = acc[ai][bj][m][0] * rs, v1 = acc[ai][bj][m][1] * rs;
                u32x4 w; w.x = cvt_pk_bf16(v0[0], v0[1]); w.y = cvt_pk_bf16(v0[2], v0[3]); w.z = cvt_pk_bf16(v1[0], v1[1]); w.w = cvt_pk_bf16(v1[2], v1[3]);
                *(u32x4*)(base + (off + h * hs + j)) = w; }
        EPI_ROWS_END
    }
};

struct EpiVt {
    static constexpr bool PERM = true;
    bf16_t* Vtp; bf16_t* Vts; const float* rsskv; int ctx;
    __device__ __forceinline__ void operator()(const f32x4 (&acc)[2][2][4][2], const Unit& u, int wr, int wc, int fr_, int fq_) const {
        int lane_e = (int)threadIdx.x & 63; asm volatile("" : "+v"(lane_e)); const int fr = lane_e & 15, fq = lane_e >> 4;
#pragma unroll
        for (int bj = 0; bj < 2; ++bj) {
            const int tok = u.pn * BM + bj * HALF + wc * 32 + 8 * fq;
            f32x4 r0 = {1.f, 1.f, 1.f, 1.f}, r1 = {1.f, 1.f, 1.f, 1.f}; unsigned off; bool smp; unsigned S;
            if (ctx) { off = (unsigned)(tok >> 8) * 8u * 64u * SKS + (tok & 255); smp = true; S = SKS; }
            else { f32x4 q0 = {0.f, 0.f, 0.f, 0.f}, q1 = {0.f, 0.f, 0.f, 0.f};
#pragma unroll
                for (int p = 12; p < 20; ++p) { q0 += *(const f32x4*)(rsskv + (size_t)p * MTOK + tok); q1 += *(const f32x4*)(rsskv + (size_t)p * MTOK + tok + 4); }
#pragma unroll
                for (int i = 0; i < 4; ++i) { r0[i] = rsqrtf(q0[i] * (1.f / 256.f) + EPS); r1[i] = rsqrtf(q1[i] * (1.f / 256.f) + EPS); }
                if (tok < MP) { off = (unsigned)(tok >> 8) * 8u * 64u * 256u + (tok & 255); smp = false; S = 256; } else { off = (unsigned)((tok - MP) >> 11) * 8u * 64u * SKS + 256u + ((tok - MP) & 2047); smp = true; S = SKS; } }
            bf16_t* base = smp ? Vts : Vtp;
#pragma unroll
            for (int ai = 0; ai < 2; ++ai)
#pragma unroll
                for (int m = 0; m < 4; ++m) { const unsigned hd = u.pm * BM + wr * 64 + fr + ai * HALF + m * 16;
                    const f32x4 v0 = acc[ai][bj][m][0] * r0, v1 = acc[ai][bj][m][1] * r1;
                    u32x4 w; w.x = cvt_pk_bf16(v0[0], v0[1]); w.y = cvt_pk_bf16(v0[2], v0[3]); w.z = cvt_pk_bf16(v1[0], v1[1]); w.w = cvt_pk_bf16(v1[2], v1[3]);
                    *(u32x4*)(base + (off + hd * S)) = w; }
            asm volatile("" ::: "memory");
        }
    }
};

struct EpiPart {
    static constexpr bool PERM = true;
    bf16_t* P0; bf16_t* P1;
    __device__ __forceinline__ void operator()(const f32x4 (&acc)[2][2][4][2], const Unit& u, int wr, int wc, int fr_, int fq_) const {
        int lane_e = (int)threadIdx.x & 63; asm volatile("" : "+v"(lane_e)); const int fr = lane_e & 15, fq = lane_e >> 4;
        const int col0 = u.pn * BM + wc * 32 + 8 * fq; bf16_t* P = u.ks ? P1 : P0;
        EPI_ROWS_BEGIN
            bf16_t* rowp = P + (size_t)row * D + col0;
#pragma unroll
            for (int bj = 0; bj < 2; ++bj) { const f32x4 v0 = acc[ai][bj][m][0], v1 = acc[ai][bj][m][1];
                u32x4 w; w.x = cvt_pk_bf16(v0[0], v0[1]); w.y = cvt_pk_bf16(v0[2], v0[3]); w.z = cvt_pk_bf16(v1[0], v1[1]); w.w = cvt_pk_bf16(v1[2], v1[3]);
                *(u32x4*)(rowp + bj * HALF) = w; }
        EPI_ROWS_END
    }
};

struct EpiFFI {
    static constexpr bool PERM = true;
    bf16_t* H;
    __device__ __forceinline__ void operator()(const f32x4 (&acc)[2][2][4][2], const Unit& u, int wr, int wc, int fr_, int fq_) const {
        int lane_e = (int)threadIdx.x & 63; asm volatile("" : "+v"(lane_e)); const int fr = lane_e & 15, fq = lane_e >> 4;
        const int col0 = u.pn * HALF + wc * 32 + 8 * fq;
        EPI_ROWS_BEGIN
            float o[8];
#pragma unroll
            for (int i = 0; i < 4; ++i) { o[i] = silu_f(acc[ai][0][m][0][i]) * acc[ai][1][m][0][i]; o[4 + i] = silu_f(acc[ai][0][m][1][i]) * acc[ai][1][m][1][i]; }
            u32x4 w; w.x = cvt_pk_bf16(o[0], o[1]); w.y = cvt_pk_bf16(o[2], o[3]); w.z = cvt_pk_bf16(o[4], o[5]); w.w = cvt_pk_bf16(o[6], o[7]);
            *(u32x4*)(H + (size_t)row * DFF + col0) = w;
        EPI_ROWS_END
    }
};
}

struct Args { const float* in[26]; float* out; unsigned char* ws; int ph_lo, ph_hi; };
enum { I_XP = 0, I_XS, I_CKV, I_CKR, I_SF, I_SB, I_C, I_CCTX, I_WADA, I_BADA, I_NATT, I_WIN, I_QN, I_WUQ, I_KVN, I_WUKV, I_WGF, I_BGF, I_WGB, I_BGB, I_GLAN, I_WOUT, I_NFFN, I_WFFI, I_WFFO, I_FN };

__device__ __forceinline__ const float* xrow_ptr(const Args& a, int r) { return r < MP ? a.in[I_XP] + (size_t)r * D : a.in[I_XS] + (size_t)(r - MP) * D; }
__device__ __forceinline__ int cond_of_row(int r) { return r < MP ? 0 : 1 + ((r - MP) >> 11); }

__device__ __forceinline__ void p0_tr(const float* W, int K, int N, bf16_t* WT, bf16_t* WT2, const float* kscale, int kb, int nb, int drow, LAS float* scr, int lane) {
    const int k0 = 64 * kb, n0 = 32 * nb;
#pragma unroll 8
    for (int i = 0; i < 32; ++i) { const int kk = 2 * i + (lane >> 5); scr[kk * 33 + (lane & 31)] = W[(size_t)(k0 + kk) * N + n0 + (lane & 31)]; }
    LDS_WAIT();
    const int c = lane & 7;
    float sc[8];
#pragma unroll
    for (int i = 0; i < 8; ++i) sc[i] = kscale ? kscale[k0 + 8 * c + i] : 1.f;
#pragma unroll
    for (int j = 0; j < 4; ++j) { const int n = (lane >> 3) + 8 * j; const LAS float* s = scr + (8 * c) * 33 + n;
        float v[8];
#pragma unroll
        for (int i = 0; i < 8; ++i) v[i] = s[i * 33];
        if (WT2) { u32x4 o; o.x = cvt_pk_bf16(v[0], v[1]); o.y = cvt_pk_bf16(v[2], v[3]); o.z = cvt_pk_bf16(v[4], v[5]); o.w = cvt_pk_bf16(v[6], v[7]);
            *(u32x4*)(WT2 + (size_t)(drow + n0 + n) * K + k0 + 8 * c) = o; }
        u32x4 o; o.x = cvt_pk_bf16(v[0] * sc[0], v[1] * sc[1]); o.y = cvt_pk_bf16(v[2] * sc[2], v[3] * sc[3]); o.z = cvt_pk_bf16(v[4] * sc[4], v[5] * sc[5]); o.w = cvt_pk_bf16(v[6] * sc[6], v[7] * sc[7]);
        *(u32x4*)(WT + (size_t)(drow + n0 + n) * K + k0 + 8 * c) = o; }
    LDS_WAIT();
}

__device__ __forceinline__ void phase0(const Args& a, int wv, LAS unsigned char* lds, int vcu, int G) {
    const int tid = otid(wv), lane = tid & 63, wave = __builtin_amdgcn_readfirstlane(tid >> 6);
    unsigned char* ws = a.ws;
#ifndef P0MASK
#define P0MASK 7
#endif
    if (P0MASK & 2) {
        LAS float* scr = (LAS float*)(lds + wave * 16384);
        LAS float* scnd = (LAS float*)(lds + 131072);
        for (int i = tid; i < 3072; i += 512) { const int ci = i >> 10, k = i & 1023; scnd[i] = silu_f(ci == 0 ? a.in[I_CCTX][k] : a.in[I_C][(ci - 1) * D + k]); }
        __syncthreads();
        const int gw = vcu * 8 + wave, NGW = G * 8;
        constexpr int T_IN = 16 * 70, T_UQ = 6 * 24, T_UKV = 4 * 32, T_OUT = 16 * 32, T_FFI = 16 * 176, T_FFO = 44 * 32, T_ZERO = 64, T_ADA = 768;
        constexpr int NIT = T_ADA + T_IN + T_UQ + T_UKV + T_OUT + T_FFI + T_FFO + T_ZERO;
        constexpr int NTR = NIT - T_ADA;
        const int nslot = wave < 3 ? 2 : 5;
        for (int sl = 0; sl < nslot; ++sl) {
            int r;
            if (wave < 3) { if (sl == 0) { r = wave * G + vcu; if (r >= T_ADA) continue; } else { const int t = vcu + G * wave; if (t >= NTR) continue; r = T_ADA + t; } }
            else { const int j = 3 + (wave - 3) + 5 * sl; const int t = vcu + G * j; if (t >= NTR) continue; r = T_ADA + t; }
            if (r < T_ADA) {
                const int nbq = r >> 2, kq = r & 3; const int n0 = 32 * nbq; const float* W = a.in[I_WADA];
                const int n = lane & 31, hf = lane >> 5; float s0 = 0.f, s1 = 0.f, s2 = 0.f;
                for (int kb = 4 * kq; kb < 4 * kq + 4; ++kb) { const int k0 = 64 * kb;
#pragma unroll 8
                    for (int i = 0; i < 32; ++i) { const int kk = 2 * i + (lane >> 5); scr[kk * 33 + (lane & 31)] = W[(size_t)(k0 + kk) * 6144 + n0 + (lane & 31)]; }
                    LDS_WAIT();
#pragma unroll 8
                    for (int j = 0; j < 32; ++j) { const int kk = hf * 32 + j; const float w = scr[kk * 33 + n];
                        s0 += w * scnd[k0 + kk]; s1 += w * scnd[1024 + k0 + kk]; s2 += w * scnd[2048 + k0 + kk]; }
                    LDS_WAIT(); }
                s0 += __shfl_xor(s0, 32); s1 += __shfl_xor(s1, 32); s2 += __shfl_xor(s2, 32);
                float* MOD = (float*)(ws + WS_MOD) + (size_t)kq * 18432;
                if (hf == 0) { MOD[n0 + n] = s0; MOD[6144 + n0 + n] = s1; MOD[12288 + n0 + n] = s2; }
                continue; } r -= T_ADA;
            if (r < T_FFI) { const int kb = r / 176, nb = r % 176; const int n0 = nb * 32; const int drow = n0 < DFF ? (n0 / 128) * 256 + (n0 % 128) : ((n0 - DFF) / 128) * 256 + 128 + ((n0 - DFF) % 128);
                p0_tr(a.in[I_WFFI], 1024, 5632, (bf16_t*)(ws + WS_WFFI), nullptr, nullptr, kb, nb, drow - n0, scr, lane); continue; } r -= T_FFI;
            if (r < T_FFO) { p0_tr(a.in[I_WFFO], DFF, 1024, (bf16_t*)(ws + WS_WFFO), nullptr, nullptr, r / 32, r % 32, 0, scr, lane); continue; } r -= T_FFO;
            if (r < T_IN) { p0_tr(a.in[I_WIN], 1024, 2240, (bf16_t*)(ws + WS_WIN), nullptr, nullptr, r / 70, r % 70, 0, scr, lane); continue; } r -= T_IN;
            if (r < T_OUT) { p0_tr(a.in[I_WOUT], 1024, 1024, (bf16_t*)(ws + WS_WOUT), nullptr, nullptr, r / 32, r % 32, 0, scr, lane); continue; } r -= T_OUT;
            if (r < T_UQ) { p0_tr(a.in[I_WUQ], 384, 768, (bf16_t*)(ws + WS_WUQ), nullptr, a.in[I_QN], r / 24, r % 24, 0, scr, lane); continue; } r -= T_UQ;
            if (r < T_UKV) { const int nb = r % 32, n0 = nb * 32, hh = n0 >> 7, j0 = n0 & 127; const bool isv = j0 >= 64; const int drow = hh * 64 + (j0 & 63);
                p0_tr(a.in[I_WUKV], 256, 1024, (bf16_t*)(ws + (isv ? WS_WVF : WS_WKF)), (bf16_t*)(ws + (isv ? WS_WVU : WS_WKU)), a.in[I_KVN], r / 32, nb, drow - n0, scr, lane); continue; } r -= T_UKV;
            { u32x4 z = {0u, 0u, 0u, 0u}; u32x4* p = (u32x4*)((bf16_t*)(ws + WS_WIN) + (size_t)(2240 + r) * 1024); p[lane] = z; p[64 + lane] = z; }
        }
    }
    if (P0MASK & 4) {
        const int gt = vcu * 512 + tid, NT = G * 512;
        for (int i = gt; i < 32768; i += NT) { const f32x4 v = ((const f32x4*)a.in[I_CKV])[i]; u32x2 w; w.x = cvt_pk_bf16(v[0], v[1]); w.y = cvt_pk_bf16(v[2], v[3]); ((u32x2*)(ws + WS_CACHEB))[i] = w; }
    }
}

__device__ __forceinline__ f32x4 mod4(const float* modp, const float* bias, int ci, int off) {
    const float* p = modp + ci * 6144 + off;
    return ((*(const f32x4*)p + *(const f32x4*)(p + 18432)) + (*(const f32x4*)(p + 36864) + *(const f32x4*)(p + 55296))) + *(const f32x4*)(bias + off);
}
__device__ __forceinline__ void phase1(const Args& a, int wv, int vcu, int G) {
    if (PROBE_FILL == 3) { float* m = (float*)(a.ws + WS_MOD); for (int i = otid(wv); i < 3 * 6144; i += 512) { unsigned h = (unsigned)i * 2654435761u; h ^= h >> 15; h *= 2246822519u; h ^= h >> 13; m[i] = ((float)(h & 0xffff) * (1.f / 65536.f) - 0.5f) * 2.f; } __syncthreads(); }
    const int tid_ = otid(wv); const int lane = tid_ & 63, wave = tid_ >> 6; const int gw = vcu * 8 + wave, NGW = G * 8;
    const float* mod = (const float*)(a.ws + WS_MOD + PROBE_MODOFF); bf16_t* H = (bf16_t*)(a.ws + WS_H);
    for (int r = gw; r < MTOK; r += NGW * PROBE_RSTRIDE) {
        const f32x4* xr = (const f32x4*)xrow_ptr(a, r) + lane; const int ci_ = cond_of_row(r);
        f32x4 v[4]; float s = 0.f;
#pragma unroll
        for (int j = 0; j < 4; ++j) { v[j] = xr[64 * j]; s += (v[j][0] * v[j][0] + v[j][1] * v[j][1]) + (v[j][2] * v[j][2] + v[j][3] * v[j][3]); }
        const float rstd = rsqrtf(wave_sum(s) * (1.f / D) + EPS);
        u32x2* o = (u32x2*)(H + (size_t)r * D) + lane;
#pragma unroll
        for (int j = 0; j < 4; ++j) { const int c = 4 * lane + 256 * j; const f32x4 w = *(const f32x4*)(a.in[I_NATT] + c), sh = mod4(mod, a.in[I_BADA], ci_, c), scv = mod4(mod, a.in[I_BADA], ci_, 1024 + c);
            const f32x4 y = v[j] * rstd * w * (scv * PROBE_MUL + 1.f) + sh * PROBE_MUL; u32x2 p; p.x = cvt_pk_bf16(y[0], y[1]); p.y = cvt_pk_bf16(y[2], y[3]); if (PROBE_NOSTORE) { if ((p.x ^ p.y) == 0x12345u) o[64 * j] = p; } else o[64 * j] = p; }
    }
}
__device__ __forceinline__ void phase6(const Args& a, int wv, int vcu, int G) {
    const int tid_ = otid(wv); const int lane = tid_ & 63, wave = tid_ >> 6; const int gw = vcu * 8 + wave, NGW = G * 8;
    const float* mod = (const float*)(a.ws + WS_MODF); bf16_t* H = (bf16_t*)(a.ws + WS_H); float* X1 = (float*)(a.ws + WS_X1);
    const bf16_t* P0 = (const bf16_t*)(a.ws + WS_P0); const bf16_t* P1 = (const bf16_t*)(a.ws + WS_P1A);
    for (int r = gw; r < MTOK; r += NGW) {
        const f32x4* xr = (const f32x4*)xrow_ptr(a, r) + lane; const int ci_ = cond_of_row(r);
        const u32x2* p0 = (const u32x2*)(P0 + (size_t)r * D) + lane; const u32x2* p1 = (const u32x2*)(P1 + (size_t)r * D) + lane;
        f32x4 v[4]; float s = 0.f;
#pragma unroll
        for (int j = 0; j < 4; ++j) { const int c = 4 * lane + 256 * j; const f32x4 gt = (*(const f32x4*)(mod + ci_ * 6144 + (2048 + c)));
            { const u32x2 qa = p0[64 * j], qb = p1[64 * j]; const f32x4 ps = {bflo(qa.x) + bflo(qb.x), bfhi(qa.x) + bfhi(qb.x), bflo(qa.y) + bflo(qb.y), bfhi(qa.y) + bfhi(qb.y)}; v[j] = xr[64 * j] + gt * ps; } s += (v[j][0] * v[j][0] + v[j][1] * v[j][1]) + (v[j][2] * v[j][2] + v[j][3] * v[j][3]); }
        const float rstd = rsqrtf(wave_sum(s) * (1.f / D) + EPS);
        u32x2* x1 = (u32x2*)((bf16_t*)X1 + (size_t)r * D) + lane; u32x2* o = (u32x2*)(H + (size_t)r * D) + lane;
#pragma unroll
        for (int j = 0; j < 4; ++j) { const int c = 4 * lane + 256 * j; { u32x2 xw; xw.x = cvt_pk_bf16(v[j][0], v[j][1]); xw.y = cvt_pk_bf16(v[j][2], v[j][3]); x1[64 * j] = xw; }
            const f32x4 w = *(const f32x4*)(a.in[I_NFFN] + c), sh = (*(const f32x4*)(mod + ci_ * 6144 + (3072 + c))), scv = (*(const f32x4*)(mod + ci_ * 6144 + (4096 + c)));
            const f32x4 y = v[j] * rstd * w * (scv + 1.f) + sh; u32x2 p; p.x = cvt_pk_bf16(y[0], y[1]); p.y = cvt_pk_bf16(y[2], y[3]); o[64 * j] = p; }
    }
}
__device__ __forceinline__ void phase9(const Args& a, int wv, int vcu, int G) {
    const int tid_ = otid(wv); const int lane = tid_ & 63, wave = tid_ >> 6; const int gw = vcu * 8 + wave, NGW = G * 8;
    const float* mod = (const float*)(a.ws + WS_MODF); const float* X1 = (const float*)(a.ws + WS_X1);
    const bf16_t* P0 = (const bf16_t*)(a.ws + WS_P0); const bf16_t* P1 = (const bf16_t*)(a.ws + WS_P1B);
    for (int r = gw; r < MTOK; r += NGW) {
        const u32x2* xr = (const u32x2*)((const bf16_t*)X1 + (size_t)r * D) + lane; const int ci_ = cond_of_row(r);
        const u32x2* p0 = (const u32x2*)(P0 + (size_t)r * D) + lane; const u32x2* p1 = (const u32x2*)(P1 + (size_t)r * D) + lane;
        f32x4 v[4]; float s = 0.f;
#pragma unroll
        for (int j = 0; j < 4; ++j) { const int c = 4 * lane + 256 * j; const f32x4 gt = (*(const f32x4*)(mod + ci_ * 6144 + (5120 + c)));
            { const u32x2 qa = p0[64 * j], qb = p1[64 * j]; const f32x4 ps = {bflo(qa.x) + bflo(qb.x), bfhi(qa.x) + bfhi(qb.x), bflo(qa.y) + bflo(qb.y), bfhi(qa.y) + bfhi(qb.y)}; const u32x2 xq = xr[64 * j]; const f32x4 xv = {bflo(xq.x), bfhi(xq.x), bflo(xq.y), bfhi(xq.y)}; v[j] = xv + gt * ps; } s += (v[j][0] * v[j][0] + v[j][1] * v[j][1]) + (v[j][2] * v[j][2] + v[j][3] * v[j][3]); }
        const float rstd = rsqrtf(wave_sum(s) * (1.f / D) + EPS);
        f32x4* y = (f32x4*)(a.out + O_Y + (size_t)r * D) + lane;
#pragma unroll
        for (int j = 0; j < 4; ++j) { const int c = 4 * lane + 256 * j; const f32x4 w = *(const f32x4*)(a.in[I_FN] + c); y[64 * j] = v[j] * rstd * w; }
    }
}

__device__ __forceinline__ void p3_row_extras(const Args& a, int wv, int gw, int NGW) {
    const int lane = otid(wv) & 63;
    const bf16_t* Z = (const bf16_t*)(a.ws + WS_Z); const float* rsskv = (const float*)(a.ws + WS_RSSKV);
    bf16_t* Kp = (bf16_t*)(a.ws + WS_KP); bf16_t* Ks = (bf16_t*)(a.ws + WS_KS);
    const float inv[8] = {1.f, 0.316227766f, 0.1f, 0.0316227766f, 0.01f, 0.00316227766f, 0.001f, 0.000316227766f};
    for (int r = gw; r < MTOK + 512; r += NGW) {
        if (r < MTOK) {
            const bf16_t* zr = Z + (size_t)r * ZP;
            if (r < MP) {
                const float rs = rsqrtf(pg8::rss_kv(rsskv, r) * (1.f / 256.f) + EPS);
                const u32x2 w = *(const u32x2*)(zr + C_KVLAT + 4 * lane); const f32x4 g = *(const f32x4*)(a.in[I_KVN] + 4 * lane);
                f32x4 o; o[0] = bflo(w.x) * rs * g[0]; o[1] = bfhi(w.x) * rs * g[1]; o[2] = bflo(w.y) * rs * g[2]; o[3] = bfhi(w.y) * rs * g[3];
                *(f32x4*)(a.out + O_KV + (size_t)r * 256 + 4 * lane) = o;
            }
            const int i = lane & 31;
            float v = bf2f(zr[C_KROPE + i]);
            if (r < MP && lane < 32) a.out[O_KR + (size_t)r * 32 + i] = v;
            const float pv = __shfl_xor(v, 8);
            int b, s; bf16_t* kb;
            if (r >= MP) { const int t = (r - MP) & 2047; const float pos = (float)((i < 16) ? (t >> 6) : (t & 63));
                const float rev = pos * inv[i & 7] * 0.15915494309189535f; const float rf = rev - floorf(rev);
                const float cs = __builtin_amdgcn_cosf(rf), sn = __builtin_amdgcn_sinf(rf); v = v * cs + ((i & 8) ? pv : -pv) * sn;
                b = (r - MP) >> 11; s = 256 + t; kb = Ks + ((size_t)(b * 8) * SKS + s) * 96 + 64 + i;
                const bf16_t o = f2bf(v);
                if (lane < 32) { for (int h = 0; h < 8; ++h) kb[(size_t)h * SKS * 96] = o; }
            } else { b = r >> 8; s = r & 255; kb = Kp + ((size_t)(b * 8) * 256 + s) * 96 + 64 + i; const bf16_t o = f2bf(v);
                if (lane < 32) { for (int h = 0; h < 8; ++h) kb[(size_t)h * 256 * 96] = o; } }
        } else {
            const int rr = r - MTOK, b = rr >> 8, s = rr & 255, i = lane & 31;
            const bf16_t o = f2bf(a.in[I_CKR][(size_t)rr * 32 + i]); bf16_t* kb = Ks + ((size_t)(b * 8) * SKS + s) * 96 + 64 + i;
            if (lane < 32) { for (int h = 0; h < 8; ++h) kb[(size_t)h * SKS * 96] = o; }
        }
    }
}

constexpr int GL_LOW = 0, GL_WG = 8192, GL_BG = 16384, GL_SEG = 16896, GL_RED = 20992, GL_VT = 22528, GL_QF = 40960, GL_KF = GL_QF + 9216, GL_QB = GL_KF + 9216, GL_KB = GL_QB + 9216;
constexpr int GROW = 144;

__device__ __forceinline__ void gla_gates(const Args& a, int wv, LAS unsigned char* lds, int r0, int h, float (&cumF)[8], float (&cumB)[8], float& totF, float& totB) {
    const int tid = otid(wv), d = tid & 63, tg = tid >> 6;
    const bf16_t* Z = (const bf16_t*)(a.ws + WS_Z);
    LAS float* low = (LAS float*)(lds + GL_LOW); LAS float* wg = (LAS float*)(lds + GL_WG); LAS float* bg = (LAS float*)(lds + GL_BG); LAS float* seg = (LAS float*)(lds + GL_SEG);
    { const int t = tid >> 3, r4 = (tid & 7) * 4; const u32x2 w = *(const u32x2*)(Z + (size_t)(r0 + t) * ZP + C_GFL + r4);
      low[t * 32 + r4] = bflo(w.x); low[t * 32 + r4 + 1] = bfhi(w.x); low[t * 32 + r4 + 2] = bflo(w.y); low[t * 32 + r4 + 3] = bfhi(w.y); }
    { const int dir = tid >> 8, r = (tid >> 4) & 15, d4 = (tid & 15) * 4; const f32x4 w = *(const f32x4*)(a.in[dir ? I_WGB : I_WGF] + r * 256 + h * 64 + d4);
      *(LAS f32x4*)(wg + (dir * 16 + r) * 64 + d4) = w; }
    if (tid < 128) { const int dir = tid >> 6; bg[tid] = a.in[dir ? I_BGB : I_BGF][h * 64 + (tid & 63)]; }
    __syncthreads();
    float wf[16], wb[16];
#pragma unroll
    for (int r = 0; r < 16; ++r) { wf[r] = wg[r * 64 + d]; wb[r] = wg[(16 + r) * 64 + d]; }
    const float bf_ = bg[d], bb_ = bg[64 + d];
    float gf[8], gb[8];
#pragma unroll
    for (int i = 0; i < 8; ++i) { const int t = tg * 8 + i; float xf = bf_, xb = bb_;
#pragma unroll
        for (int r = 0; r < 16; ++r) { xf += low[t * 32 + r] * wf[r]; xb += low[t * 32 + 16 + r] * wb[r]; }
        gf[i] = logsigmoid_f(xf) * (1.f / 16.f); gb[i] = logsigmoid_f(xb) * (1.f / 16.f); }
#pragma unroll
    for (int i = 1; i < 8; ++i) gf[i] += gf[i - 1];
#pragma unroll
    for (int i = 6; i >= 0; --i) gb[i] += gb[i + 1];
    seg[tg * 64 + d] = gf[7]; seg[512 + tg * 64 + d] = gb[0];
    __syncthreads();
    float offF = 0.f, offB = 0.f; totF = 0.f; totB = 0.f;
#pragma unroll
    for (int g = 0; g < 8; ++g) { const float sf = seg[g * 64 + d], sb = seg[512 + g * 64 + d]; totF += sf; totB += sb; if (g < tg) offF += sf; if (g > tg) offB += sb; }
#pragma unroll
    for (int i = 0; i < 8; ++i) { cumF[i] = gf[i] + offF; cumB[i] = gb[i] + offB; }
}
__device__ __forceinline__ void gla_load_vT(const Args& a, int wv, LAS unsigned char* lds, int r0, int h) {
    const int tid = otid(wv), e = tid & 127, tq = tid >> 7;
    const bf16_t* Z = (const bf16_t*)(a.ws + WS_Z) + (size_t)r0 * ZP + C_GV + h * 128 + e;
    unsigned w[8];
#pragma unroll
    for (int i = 0; i < 8; ++i) { const unsigned lo = Z[(size_t)(tq * 16 + 2 * i) * ZP], hi = Z[(size_t)(tq * 16 + 2 * i + 1) * ZP]; w[i] = lo | (hi << 16); }
    LAS u32x4* p = (LAS u32x4*)(lds + GL_VT + e * GROW + tq * 32);
    p[0] = (u32x4){w[0], w[1], w[2], w[3]}; p[1] = (u32x4){w[4], w[5], w[6], w[7]};
}

__device__ __forceinline__ void gla_stepA(const Args& a, int wv, LAS unsigned char* lds, int u) {
    const int tid = otid(wv), lane = tid & 63, wave = __builtin_amdgcn_readfirstlane(tid >> 6), d = tid & 63, tg = tid >> 6, fr = lane & 15, fq = lane >> 4;
    const int cgi = u >> 2, h = u & 3, r0 = cgi * 64;
    const bf16_t* Z = (const bf16_t*)(a.ws + WS_Z);
    float cumF[8], cumB[8], totF, totB;
    gla_gates(a, wv, lds, r0, h, cumF, cumB, totF, totB);
    unsigned kf[4], kb[4];
#pragma unroll
    for (int i = 0; i < 4; ++i) { const float k0 = bf2f(Z[(size_t)(r0 + tg * 8 + 2 * i) * ZP + C_GK + h * 64 + d]), k1 = bf2f(Z[(size_t)(r0 + tg * 8 + 2 * i + 1) * ZP + C_GK + h * 64 + d]);
        kf[i] = cvt_pk_bf16(k0 * __expf(totF - cumF[2 * i]), k1 * __expf(totF - cumF[2 * i + 1]));
        kb[i] = cvt_pk_bf16(k0 * __expf(totB - cumB[2 * i]), k1 * __expf(totB - cumB[2 * i + 1])); }
    *(LAS u32x4*)(lds + GL_QF + d * GROW + tg * 16) = (u32x4){kf[0], kf[1], kf[2], kf[3]};
    *(LAS u32x4*)(lds + GL_KF + d * GROW + tg * 16) = (u32x4){kb[0], kb[1], kb[2], kb[3]};
    gla_load_vT(a, wv, lds, r0, h);
    if (tg == 0) { float* dec = (float*)(a.ws + WS_DEC) + (size_t)u * 128; dec[d] = __expf(totF); dec[64 + d] = __expf(totB); }
    __syncthreads();
    const int dir = wave >> 2, eb0 = 2 * (wave & 3);
    const LAS unsigned char* kd = lds + (dir ? GL_KF : GL_QF);
    float* CT = (float*)(a.ws + WS_CT) + ((size_t)u * 2 + dir) * 8192;
#pragma unroll
    for (int eb = 0; eb < 2; ++eb) {
        bf16x8 vf[2];
#pragma unroll
        for (int ks = 0; ks < 2; ++ks) vf[ks] = *(const LAS bf16x8*)(lds + GL_VT + (16 * (eb0 + eb) + fr) * GROW + (32 * ks + 8 * fq) * 2);
#pragma unroll
        for (int db = 0; db < 4; ++db) { f32x4 c = {0.f, 0.f, 0.f, 0.f};
#pragma unroll
            for (int ks = 0; ks < 2; ++ks) { const bf16x8 kfr = *(const LAS bf16x8*)(kd + (16 * db + fr) * GROW + (32 * ks + 8 * fq) * 2); c = __builtin_amdgcn_mfma_f32_16x16x32_bf16(vf[ks], kfr, c, 0, 0, 0); }
#pragma unroll
            for (int j = 0; j < 4; ++j) CT[(16 * (eb0 + eb) + 4 * fq + j) * 64 + 16 * db + fr] = c[j]; }
    }
    __syncthreads();
}

__device__ __forceinline__ void gla_scan(const Args& a, int wv, int vcu, int G) {
    const int gt = vcu * 512 + otid(wv), NT = G * 512;
    float* CTb = (float*)(a.ws + WS_CT); const float* DEC = (const float*)(a.ws + WS_DEC);
    for (int it = gt; it < 32768 + 262144; it += NT) {
        int seq, N, cg0, x;
        if (it < 32768) { seq = 16 + (it >> 14); x = it & 16383; N = 32; cg0 = 64 + 32 * (seq - 16); } else { const int j = it - 32768; seq = j >> 14; x = j & 16383; N = 4; cg0 = 4 * seq; }
        const int h = x >> 12, dir = (x >> 11) & 1, e = (x >> 4) & 127, d4 = (x & 15) * 4;
        f32x4 st = {0.f, 0.f, 0.f, 0.f};
        if (seq >= 16) { const float* s0 = a.in[dir ? I_SB : I_SF] + ((size_t)((seq - 16) * 4 + h) * 64) * 128 + e;
#pragma unroll
            for (int i = 0; i < 4; ++i) st[i] = s0[(size_t)(d4 + i) * 128]; }
        if (N == 32) {
            for (int n0 = 0; n0 < 32; n0 += 8) {
                f32x4 c[8], dc[8];
#pragma unroll
                for (int i = 0; i < 8; ++i) { const int n = dir ? (31 - n0 - i) : (n0 + i); const int u = (cg0 + n) * 4 + h;
                    c[i] = *(const f32x4*)(CTb + ((size_t)u * 2 + dir) * 8192 + e * 64 + d4); dc[i] = *(const f32x4*)(DEC + (size_t)u * 128 + dir * 64 + d4); }
#pragma unroll
                for (int i = 0; i < 8; ++i) { const int n = dir ? (31 - n0 - i) : (n0 + i); const int u = (cg0 + n) * 4 + h;
                    *(f32x4*)(CTb + ((size_t)u * 2 + dir) * 8192 + e * 64 + d4) = st; st = dc[i] * st + c[i]; }
            }
        } else {
            f32x4 c[4], dc[4];
#pragma unroll
            for (int i = 0; i < 4; ++i) { const int n = dir ? (3 - i) : i; const int u = (cg0 + n) * 4 + h;
                c[i] = *(const f32x4*)(CTb + ((size_t)u * 2 + dir) * 8192 + e * 64 + d4); dc[i] = *(const f32x4*)(DEC + (size_t)u * 128 + dir * 64 + d4); }
#pragma unroll
            for (int i = 0; i < 4; ++i) { const int n = dir ? (3 - i) : i; const int u = (cg0 + n) * 4 + h;
                *(f32x4*)(CTb + ((size_t)u * 2 + dir) * 8192 + e * 64 + d4) = st; st = dc[i] * st + c[i]; }
        }
        if (seq < 16) { float* o = a.out + (dir ? O_SB : O_SF) + ((size_t)(seq * 4 + h) * 64) * 128 + e;
#pragma unroll
            for (int i = 0; i < 4; ++i) o[(size_t)(d4 + i) * 128] = st[i]; }
    }
}

__device__ __forceinline__ void gla_stepC(const Args& a, int wv, LAS unsigned char* lds, int u) {
    const int tid = otid(wv), lane = tid & 63, wave = __builtin_amdgcn_readfirstlane(tid >> 6), d = tid & 63, tg = tid >> 6, fr = lane & 15, fq = lane >> 4;
    const int cgi = u >> 2, h = u & 3, r0 = cgi * 64;
    const bf16_t* Z = (const bf16_t*)(a.ws + WS_Z);
    float cumF[8], cumB[8], totF, totB;
    gla_gates(a, wv, lds, r0, h, cumF, cumB, totF, totB);
#pragma unroll
    for (int i = 0; i < 8; ++i) { const int t = tg * 8 + i; const float q = bf2f(Z[(size_t)(r0 + t) * ZP + C_GQ + h * 64 + d]) * 0.125f, k = bf2f(Z[(size_t)(r0 + t) * ZP + C_GK + h * 64 + d]);
        *(LAS bf16_t*)(lds + GL_QF + t * GROW + d * 2) = f2bf(q * __expf(cumF[i]));
        *(LAS bf16_t*)(lds + GL_KF + t * GROW + d * 2) = f2bf(k * __expf(-cumF[i]));
        *(LAS bf16_t*)(lds + GL_QB + t * GROW + d * 2) = f2bf(q * __expf(cumB[i]));
        *(LAS bf16_t*)(lds + GL_KB + t * GROW + d * 2) = f2bf(k * __expf(-cumB[i])); }
    gla_load_vT(a, wv, lds, r0, h);
    __syncthreads();
    const int ch = wave & 1, eq = wave >> 1;
    f32x4 oT[2][2];
#pragma unroll
    for (int i = 0; i < 2; ++i)
#pragma unroll
        for (int j = 0; j < 2; ++j) oT[i][j] = (f32x4){0.f, 0.f, 0.f, 0.f};
#pragma unroll
    for (int dir = 0; dir < 2; ++dir) {
        const LAS unsigned char* qe = lds + (dir ? GL_QB : GL_QF); const LAS unsigned char* ke = lds + (dir ? GL_KB : GL_KF);
        const float* ST = (const float*)(a.ws + WS_CT) + ((size_t)u * 2 + dir) * 8192;
        bf16x8 sf[2][2];
#pragma unroll
        for (int eb = 0; eb < 2; ++eb)
#pragma unroll
            for (int ks = 0; ks < 2; ++ks) { const float* p = ST + (16 * (2 * eq + eb) + fr) * 64 + 32 * ks + 8 * fq; const f32x4 x0 = *(const f32x4*)p, x1 = *(const f32x4*)(p + 4);
                u32x4 w; w.x = cvt_pk_bf16(x0[0], x0[1]); w.y = cvt_pk_bf16(x0[2], x0[3]); w.z = cvt_pk_bf16(x1[0], x1[1]); w.w = cvt_pk_bf16(x1[2], x1[3]); sf[eb][ks] = __builtin_bit_cast(bf16x8, w); }
#pragma unroll
        for (int cb = 0; cb < 2; ++cb) {
            const int cbg = 2 * ch + cb;
            bf16x8 qf[2];
#pragma unroll
            for (int ks = 0; ks < 2; ++ks) qf[ks] = *(const LAS bf16x8*)(qe + (16 * cbg + fr) * GROW + (32 * ks + 8 * fq) * 2);
            f32x4 att[4];
#pragma unroll
            for (int sb = 0; sb < 4; ++sb) {
                f32x4 acc = {0.f, 0.f, 0.f, 0.f};
                const bool need = dir == 0 ? (sb <= cbg) : (sb >= cbg);
                if (need) {
#pragma unroll
                    for (int ks = 0; ks < 2; ++ks) { const bf16x8 kfr = *(const LAS bf16x8*)(ke + (16 * sb + fr) * GROW + (32 * ks + 8 * fq) * 2); acc = __builtin_amdgcn_mfma_f32_16x16x32_bf16(kfr, qf[ks], acc, 0, 0, 0); }
                    if (sb == cbg) {
#pragma unroll
                        for (int j = 0; j < 4; ++j) { const int sl = 4 * fq + j; const bool keep = dir == 0 ? (sl <= fr) : (sl >= fr); acc[j] = keep ? acc[j] : 0.f; } }
                }
                att[sb] = acc;
            }
#pragma unroll
            for (int kp = 0; kp < 2; ++kp) {
                u32x4 w; w.x = cvt_pk_bf16(att[2 * kp][0], att[2 * kp][1]); w.y = cvt_pk_bf16(att[2 * kp][2], att[2 * kp][3]); w.z = cvt_pk_bf16(att[2 * kp + 1][0], att[2 * kp + 1][1]); w.w = cvt_pk_bf16(att[2 * kp + 1][2], att[2 * kp + 1][3]);
                const bf16x8 pb = __builtin_bit_cast(bf16x8, w);
#pragma unroll
                for (int eb = 0; eb < 2; ++eb) { const LAS unsigned char* vp = lds + GL_VT + (16 * (2 * eq + eb) + fr) * GROW + (32 * kp + 4 * fq) * 2;
                    const u32x2 v0 = *(const LAS u32x2*)vp, v1 = *(const LAS u32x2*)(vp + 32); const u32x4 vv = {v0.x, v0.y, v1.x, v1.y};
                    oT[eb][cb] = __builtin_amdgcn_mfma_f32_16x16x32_bf16(__builtin_bit_cast(bf16x8, vv), pb, oT[eb][cb], 0, 0, 0); }
            }
#pragma unroll
            for (int ks = 0; ks < 2; ++ks)
#pragma unroll
                for (int eb = 0; eb < 2; ++eb) oT[eb][cb] = __builtin_amdgcn_mfma_f32_16x16x32_bf16(sf[eb][ks], qf[ks], oT[eb][cb], 0, 0, 0);
        }
    }
    LAS float* red = (LAS float*)(lds + GL_RED);
#pragma unroll
    for (int cb = 0; cb < 2; ++cb) { float s = 0.f;
#pragma unroll
        for (int eb = 0; eb < 2; ++eb)
#pragma unroll
            for (int j = 0; j < 4; ++j) s += oT[eb][cb][j] * oT[eb][cb][j];
        s += __shfl_xor(s, 16); s += __shfl_xor(s, 32);
        if (fq == 0) red[eq * 64 + 16 * (2 * ch + cb) + fr] = s; }
    __syncthreads();
    bf16_t* MIX = (bf16_t*)(a.ws + WS_MIX);
#pragma unroll
    for (int cb = 0; cb < 2; ++cb) { const int c = 16 * (2 * ch + cb) + fr; const float tot = red[c] + red[64 + c] + red[128 + c] + red[192 + c]; const float rstd = rsqrtf(tot * (1.f / 128.f) + EPS);
#pragma unroll
        for (int eb = 0; eb < 2; ++eb) { const int e = 16 * (2 * eq + eb) + 4 * fq; const f32x4 gn = *(const f32x4*)(a.in[I_GLAN] + e);
            const u32x2 gw = *(const u32x2*)(Z + (size_t)(r0 + c) * ZP + C_GOUT + h * 128 + e);
            const float g0 = bflo(gw.x), g1 = bfhi(gw.x), g2 = bflo(gw.y), g3 = bfhi(gw.y);
            const f32x4 o = oT[eb][cb] * rstd * gn; u32x2 w; w.x = cvt_pk_bf16(o[0] * silu_f(g0), o[1] * silu_f(g1)); w.y = cvt_pk_bf16(o[2] * silu_f(g2), o[3] * silu_f(g3));
            *(u32x2*)(MIX + (size_t)(r0 + c) * D + 512 + h * 128 + e) = w; } }
    __syncthreads();
}

constexpr int AT_KROW = 208, AT_VROW = 144, AT_KB = 64 * AT_KROW  , AT_STAGE = AT_KB + 64 * AT_VROW  ;
__device__ __forceinline__ void attn_unit(const Args& a, int wv, LAS unsigned char* lds, int idx) {
    const int tid = otid(wv), lane = tid & 63, wave = __builtin_amdgcn_readfirstlane(tid >> 6), fr = lane & 15, fq = lane >> 4;
    int row0, S, nt; const bf16_t* Kb; const bf16_t* Vb; int h;
    if (idx < 256) { const int b = idx >> 7, qb = idx & 15; h = (idx >> 4) & 7; row0 = MP + b * 2048 + qb * 128; S = SKS; nt = 36;
        Kb = (const bf16_t*)(a.ws + WS_KS) + (size_t)(b * 8 + h) * SKS * 96; Vb = (const bf16_t*)(a.ws + WS_VTS) + (size_t)(b * 8 + h) * 64 * SKS; }
    else { const int j = idx - 256; const int b = j >> 4, qb = j & 1; h = (j >> 1) & 7; row0 = b * 256 + qb * 128; S = 256; nt = 4;
        Kb = (const bf16_t*)(a.ws + WS_KP) + (size_t)(b * 8 + h) * 256 * 96; Vb = (const bf16_t*)(a.ws + WS_VTP) + (size_t)(b * 8 + h) * 64 * 256; }
    const char* src[3]; unsigned step[3]; unsigned dst[3]; bool valid[3];
#pragma unroll
    for (int j = 0; j < 3; ++j) { const int ins = wave + 8 * j; valid[j] = ins < 22;
        if (ins < 13) { const int ck = ins * 64 + lane, r = ck / 13, cc = ck % 13; src[j] = (const char*)Kb + (size_t)r * 192 + (cc < 12 ? cc : 11) * 16; step[j] = 64 * 192; dst[j] = ins * 1024; }
        else { const int cv = (ins - 13) * 64 + lane, r = cv / 9, cc = cv % 9; src[j] = (const char*)Vb + (size_t)r * S * 2 + (cc < 8 ? cc : 7) * 16; step[j] = 128; dst[j] = AT_KB + (ins - 13) * 1024; } }
#define AT_ISSUE(t, buf) do { _Pragma("unroll") for (int j = 0; j < 3; ++j) if (valid[j]) \
        __builtin_amdgcn_global_load_lds((const unsigned*)(src[j] + (size_t)(t) * step[j]), (LAS unsigned*)(lds + (buf) * AT_STAGE + dst[j]), 16, 0, 0); } while (0)
    AT_ISSUE(0, 0);
    const bf16_t* Q = (const bf16_t*)(a.ws + WS_Q) + (size_t)(row0 + wave * 16 + fr) * 768 + h * 96 + 8 * fq;
    bf16x8 qf[3];
#pragma unroll
    for (int ks = 0; ks < 3; ++ks) qf[ks] = *(const bf16x8*)(Q + 32 * ks);
    float mrun = -1e30f, lsum = 0.f;
    f32x4 o[4];
#pragma unroll
    for (int i = 0; i < 4; ++i) o[i] = (f32x4){0.f, 0.f, 0.f, 0.f};
    for (int t = 0; t < nt; ++t) {
        VM_WAIT(); __syncthreads();
        if (t + 1 < nt) AT_ISSUE(t + 1, (t + 1) & 1);
        const LAS unsigned char* kt = lds + (t & 1) * AT_STAGE; const LAS unsigned char* vt = kt + AT_KB;
        f32x4 s[4];
#pragma unroll
        for (int kb = 0; kb < 4; ++kb) { s[kb] = (f32x4){0.f, 0.f, 0.f, 0.f};
#pragma unroll
            for (int ks = 0; ks < 3; ++ks) { const bf16x8 kf = *(const LAS bf16x8*)(kt + (16 * kb + fr) * AT_KROW + (32 * ks + 8 * fq) * 2); s[kb] = __builtin_amdgcn_mfma_f32_16x16x32_bf16(kf, qf[ks], s[kb], 0, 0, 0); } }
        float mx = fmaxf(fmaxf(fmaxf(s[0][0], s[0][1]), fmaxf(s[0][2], s[0][3])), fmaxf(fmaxf(s[1][0], s[1][1]), fmaxf(s[1][2], s[1][3])));
        mx = fmaxf(mx, fmaxf(fmaxf(fmaxf(s[2][0], s[2][1]), fmaxf(s[2][2], s[2][3])), fmaxf(fmaxf(s[3][0], s[3][1]), fmaxf(s[3][2], s[3][3]))));
        { const float m1 = __shfl_xor(mx, 16), m2 = __shfl_xor(mx, 32), m3 = __shfl_xor(mx, 48); mx = fmaxf(fmaxf(mx, m1), fmaxf(m2, m3)); }
        const float mnew = fmaxf(mrun, mx);
        f32x4 psv = {0.f, 0.f, 0.f, 0.f};
#pragma unroll
        for (int kb = 0; kb < 4; ++kb) { s[kb] = s[kb] - mnew;
#pragma unroll
            for (int j = 0; j < 4; ++j) s[kb][j] = __builtin_amdgcn_exp2f(s[kb][j]);
            psv += s[kb]; }
        const float ps = (psv[0] + psv[1]) + (psv[2] + psv[3]);
        if (__builtin_amdgcn_ballot_w64(mnew != mrun) != 0ull) {
            const float alpha = __builtin_amdgcn_exp2f(mrun - mnew); mrun = mnew; lsum *= alpha;
#pragma unroll
            for (int i = 0; i < 4; ++i) o[i] = o[i] * alpha;
        }
        lsum += ps;
#pragma unroll
        for (int kp = 0; kp < 2; ++kp) {
            u32x4 w; w.x = cvt_pk_bf16(s[2 * kp][0], s[2 * kp][1]); w.y = cvt_pk_bf16(s[2 * kp][2], s[2 * kp][3]); w.z = cvt_pk_bf16(s[2 * kp + 1][0], s[2 * kp + 1][1]); w.w = cvt_pk_bf16(s[2 * kp + 1][2], s[2 * kp + 1][3]);
            const bf16x8 pb = __builtin_bit_cast(bf16x8, w);
#pragma unroll
            for (int mb = 0; mb < 4; ++mb) { const LAS unsigned char* vp = vt + (16 * mb + fr) * AT_VROW + (32 * kp + 4 * fq) * 2;
                const u32x2 v0 = *(const LAS u32x2*)vp, v1 = *(const LAS u32x2*)(vp + 32); const u32x4 vv = {v0.x, v0.y, v1.x, v1.y};
                o[mb] = __builtin_amdgcn_mfma_f32_16x16x32_bf16(__builtin_bit_cast(bf16x8, vv), pb, o[mb], 0, 0, 0); }
        }
    }
    lsum += __shfl_xor(lsum, 16); lsum += __shfl_xor(lsum, 32);
    const float il = fast_rcp(lsum);
    bf16_t* MIX = (bf16_t*)(a.ws + WS_MIX) + (size_t)(row0 + wave * 16 + fr) * D + h * 64 + 4 * fq;
#pragma unroll
    for (int mb = 0; mb < 4; ++mb) { u32x2 w; w.x = cvt_pk_bf16(o[mb][0] * il, o[mb][1] * il); w.y = cvt_pk_bf16(o[mb][2] * il, o[mb][3] * il); *(u32x2*)(MIX + 16 * mb) = w; }
    __syncthreads();
#undef AT_ISSUE
}

__device__ unsigned g_bar[64 * 52];
#define GB(i) (g_bar + 64 * (i))
__device__ __forceinline__ unsigned gb_ld(unsigned* p) { return __hip_atomic_load(p, __ATOMIC_RELAXED, __HIP_MEMORY_SCOPE_AGENT); }
__device__ __forceinline__ unsigned gb_add(unsigned* p, unsigned v) { return __hip_atomic_fetch_add(p, v, __ATOMIC_RELAXED, __HIP_MEMORY_SCOPE_AGENT); }
__device__ __forceinline__ unsigned xcc_id() { return (unsigned)__builtin_amdgcn_s_getreg((3 << 11) | 20) & 0xFu; }
__device__ __forceinline__ void my_grid_barrier(unsigned nth, unsigned G, int tid, LAS unsigned* st) {
    asm volatile("s_waitcnt vmcnt(0) lgkmcnt(0)" ::: "memory");
    __syncthreads();
    if (tid == 0) {
        if (nth == 1u) {
            const unsigned x = xcc_id(); unsigned sum, cnt, mine;
            for (;;) { sum = 0u; cnt = 0u; mine = 0u;
#pragma unroll
                for (unsigned j = 0; j < 16; ++j) { const unsigned c = gb_ld(GB(4 + j)); sum += c; cnt += (c > 0u) ? 1u : 0u; mine = (j == x) ? c : mine; }
                if (sum >= G) break; __builtin_amdgcn_s_sleep(1); }
            st[0] = mine; st[1] = cnt; st[2] = x;
        }
        const unsigned nloc = st[0], nx = st[1], x = st[2];
        const unsigned old = gb_add(GB(20 + x), 1u);
        if (old + 1u == nth * nloc) {
            __builtin_amdgcn_fence(__ATOMIC_RELEASE, "agent");
            asm volatile("s_waitcnt vmcnt(0)" ::: "memory");
            const unsigned og = gb_add(GB(1), 1u);
            if (og + 1u == nth * nx) gb_add(GB(2), 1u);
            else while (gb_ld(GB(2)) < nth) __builtin_amdgcn_s_sleep(1);
            __builtin_amdgcn_fence(__ATOMIC_ACQUIRE, "agent");
            gb_add(GB(36 + x), 1u);
            asm volatile("s_waitcnt vmcnt(0)" ::: "memory");
        } else {
            while (gb_ld(GB(36 + x)) < nth) __builtin_amdgcn_s_sleep(1);
            __builtin_amdgcn_fence(__ATOMIC_ACQUIRE, "agent");
            asm volatile("s_waitcnt vmcnt(0)" ::: "memory");
        }
    }
    __syncthreads();
}
__device__ __forceinline__ void my_grid_barrier_finish(unsigned G, int tid) {
    if (tid == 0) {
        const unsigned old = gb_add(GB(0), 1u);
        if (old == G - 1u) { for (int i = 0; i < 52; ++i) __hip_atomic_store(GB(i), 0u, __ATOMIC_RELAXED, __HIP_MEMORY_SCOPE_AGENT); }
    }
}
constexpr int NPHASE = 11;
__global__ void __launch_bounds__(512, 2) mk_fwd(Args a) {
    const int wv = __builtin_amdgcn_readfirstlane((int)threadIdx.x >> 6);
    extern __shared__ __attribute__((aligned(16))) unsigned char lds_raw[];
    LAS unsigned char* lds = (LAS unsigned char*)lds_raw;
    const int G = gridDim.x, bx = blockIdx.x;
    const int vcu = (G % 8 == 0) ? (bx % 8) * (G / 8) + bx / 8 : bx;
    unsigned char* ws = a.ws;
    const int lo = a.ph_lo, hi = a.ph_hi;
#ifndef PHMASK
#define PHMASK 0x7ff
#endif
#define IN(k) (((PHMASK >> (k)) & 1) && lo <= (k) && (k) < hi)
#define SEAM(k) do { if (IN(k) && IN((k) + 1)) { ++nbar; my_grid_barrier(nbar, (unsigned)G, otid(wv), (LAS unsigned*)(lds + LDS_BYTES - 64)); } } while (0)
#ifndef PROBE_FILL
#define PROBE_FILL 0
#endif
    if (PROBE_FILL && lo == 0) { f32x4* p = (f32x4*)a.ws; const size_t n = (size_t)(PROBE_FILL_MIB) << 16; const float fv = PROBE_FILL_VAL;
        for (size_t i = (size_t)bx * 512 + threadIdx.x; i < n; i += (size_t)G * 512) { unsigned h = (unsigned)i * 2654435761u; h ^= h >> 15; h *= 2246822519u; h ^= h >> 13; const float r0 = (float)(h & 0xffff) * (1.f / 65536.f) - 0.5f + fv * 0.f; p[i] = (f32x4){r0, r0 * 1.7f, r0 * -0.3f, r0 + 0.1f}; } }
    if (PROBE_FILL == 2 && lo == 0 && bx == 0) { static const int szs[26] = {4194304, 4194304, 131072, 16384, 65536, 65536, 2048, 1024, 6291456, 6144, 1024, 2293760, 384, 294912, 256, 262144, 4096, 256, 4096, 256, 128, 1048576, 1024, 5767168, 2883584, 1024};
        float sm = 0.f; for (int i = 0; i < 26; ++i) { const int n = szs[i]; const int st = n > 1024 ? n - 1024 : 0; for (int j = st + (int)threadIdx.x; j < n; j += 512) sm += a.in[i][j]; for (int j = threadIdx.x; j < (n < 1024 ? n : 1024); j += 512) sm += a.in[i][j]; }
        ((float*)(a.ws))[threadIdx.x] = sm; }
    if (PROBE_FILL == 5 && lo == 0) { volatile float* p = (volatile float*)a.ws; const float big = p[0] * 0.f + 1e38f, tiny = p[1] * 0.f + 1e-38f, zero = p[2] * 0.f, neg = p[3] * 0.f - 1.f;
        float r = 0.f;
#if PROBE_EXC & 1
        r += big * big;
#endif
#if PROBE_EXC & 2
        r += tiny * tiny;
#endif
#if PROBE_EXC & 4
        r += 1.f / zero;
#endif
#if PROBE_EXC & 8
        r += __builtin_sqrtf(neg);
#endif
        p[4 + bx] = r; }
    unsigned nbar = 0;
    if (otid(wv) == 0) gb_add(GB(4 + xcc_id()), 1u);
    if (IN(0)) { for (int rep = 0; rep < PROBE_P0_REP; ++rep) { phase0(a, wv, lds, vcu, G); __syncthreads(); } } SEAM(0);
    if (IN(1)) { for (int rep = 0; rep < PROBE_ROW_REP; ++rep) phase1(a, wv, vcu, G); } SEAM(1);
    if (PROBE_HANG && lo == 1) { volatile unsigned* q = (volatile unsigned*)(a.ws + 8); while (*q != 0x12345678u) __builtin_amdgcn_s_sleep(20); }
    if (IN(2)) {
        pg8::Gemm g{(const bf16_t*)(ws + WS_H), (const bf16_t*)(ws + WS_WIN), D, D, D, wv}; pg8::Order S; S.init(MTOK, 2048, 1, G, bx);
        pg8::EpiZ E{(bf16_t*)(ws + WS_Z), (float*)(ws + WS_RSSQ), (float*)(ws + WS_RSSKV), 0};
        pg8::gemm_phase<pg8::EpiZ, pg8::Order>(lds, g, S, E);
    } SEAM(2);
    if (IN(3)) {
#ifndef P3MASK
#define P3MASK 0x3f
#endif
#if (P3MASK >> 0) & 1
        { pg8::Gemm g{(const bf16_t*)(ws + WS_Z) + C_QLAT, (const bf16_t*)(ws + WS_WUQ), ZP, 384, 384, wv}; pg8::Order S; S.init(MTOK, 768, 1, G, bx);
          pg8::EpiQ E{(bf16_t*)(ws + WS_Q), (const float*)(ws + WS_RSSQ)}; pg8::gemm_phase<pg8::EpiQ, pg8::Order>(lds, g, S, E); }
#endif
#if (P3MASK >> 1) & 1
        { pg8::Gemm g{(const bf16_t*)(ws + WS_Z) + C_KVLAT, (const bf16_t*)(ws + WS_WKF), ZP, 256, 256, wv}; pg8::Order S; S.init(MTOK, 512, 1, G, (bx + G - 96) % G);
          pg8::EpiK E{(bf16_t*)(ws + WS_KP), (bf16_t*)(ws + WS_KS), (const float*)(ws + WS_RSSKV), 0}; pg8::gemm_phase<pg8::EpiK, pg8::Order>(lds, g, S, E); }
#endif
#if (P3MASK >> 2) & 1
        { pg8::Gemm g{(const bf16_t*)(ws + WS_WVF), (const bf16_t*)(ws + WS_Z) + C_KVLAT, 256, ZP, 256, wv}; pg8::Order S; S.init(512, MTOK, 1, G, (bx + G - 160) % G);
          pg8::EpiVt E{(bf16_t*)(ws + WS_VTP), (bf16_t*)(ws + WS_VTS), (const float*)(ws + WS_RSSKV), 0}; pg8::gemm_phase<pg8::EpiVt, pg8::Order>(lds, g, S, E); }
#endif
#if (P3MASK >> 3) & 1
        { pg8::Gemm g{(const bf16_t*)(ws + WS_CACHEB), (const bf16_t*)(ws + WS_WKU), 256, 256, 256, wv}; pg8::Order S; S.init(512, 512, 1, G, (bx + G - 224) % G);
          pg8::EpiK E{(bf16_t*)(ws + WS_KP), (bf16_t*)(ws + WS_KS), (const float*)(ws + WS_RSSKV), 1}; pg8::gemm_phase<pg8::EpiK, pg8::Order>(lds, g, S, E); }
#endif
#if (P3MASK >> 4) & 1
        { pg8::Gemm g{(const bf16_t*)(ws + WS_WVU), (const bf16_t*)(ws + WS_CACHEB), 256, 256, 256, wv}; pg8::Order S; S.init(512, 512, 1, G, (bx + G - 228) % G);
          pg8::EpiVt E{(bf16_t*)(ws + WS_VTP), (bf16_t*)(ws + WS_VTS), (const float*)(ws + WS_RSSKV), 1}; pg8::gemm_phase<pg8::EpiVt, pg8::Order>(lds, g, S, E); }
#endif
        __syncthreads();
        if (bx == G - 1) { const float* mp = (const float*)(ws + WS_MOD); float* mf = (float*)(ws + WS_MODF);
            for (int i = otid(wv); i < 18432; i += 512) mf[i] = ((mp[i] + mp[18432 + i]) + (mp[36864 + i] + mp[55296 + i])) + a.in[I_BADA][i % 6144]; }
        { const int c2 = (bx + G - 232) % G;
          for (int u = c2; u < 512; u += G) gla_stepA(a, wv, lds, u);
          p3_row_extras(a, wv, c2 * 8 + (otid(wv) >> 6), G * 8); }
    } SEAM(3);
    if (IN(4)) {
        if (bx >= 224) {
        { pg8::Gemm g{(const bf16_t*)(ws + WS_H), (const bf16_t*)(ws + WS_WIN) + (size_t)2048 * D, D, D, D, wv}; pg8::Order S; S.init(MTOK, 256, 1, G, bx - 224);
          pg8::EpiZ E{(bf16_t*)(ws + WS_Z), (float*)(ws + WS_RSSQ), (float*)(ws + WS_RSSKV), 8}; pg8::gemm_phase<pg8::EpiZ, pg8::Order>(lds, g, S, E); }
        } else gla_scan(a, wv, bx, 224);
    } SEAM(4);
    if (IN(5)) {
        for (int rep = 0; rep < PROBE_ATT_REP; ++rep) for (int u = vcu; u < 512; u += G) attn_unit(a, wv, lds, u);
        for (int rep = 0; rep < PROBE_GLAC_REP; ++rep) for (int u = vcu; u < 512; u += G) gla_stepC(a, wv, lds, u);
    } SEAM(5);
    if (IN(6)) {
        pg8::Gemm g{(const bf16_t*)(ws + WS_MIX), (const bf16_t*)(ws + WS_WOUT), D, D, PROBE_K6, wv}; pg8::Order S; S.init(MTOK, D, 1024 / PROBE_K6, G, bx);
        pg8::EpiPart E{(bf16_t*)(ws + WS_P0), (bf16_t*)(ws + WS_P1A)}; pg8::gemm_phase<pg8::EpiPart, pg8::Order>(lds, g, S, E);
    } SEAM(6);
    if (IN(7)) { for (int rep = 0; rep < PROBE_ROW_REP; ++rep) phase6(a, wv, vcu, G); } SEAM(7);
    if (IN(8)) {
        pg8::Gemm g{(const bf16_t*)(ws + WS_H), (const bf16_t*)(ws + WS_WFFI), D, D, D, wv}; pg8::Order S; S.init(MTOK, 2 * DFF, 1, G, bx);
        pg8::EpiFFI E{(bf16_t*)(ws + WS_HFF)}; for (int rep = 0; rep < PROBE_FFI_REP; ++rep) pg8::gemm_phase<pg8::EpiFFI, pg8::Order>(lds, g, S, E);
    } SEAM(8);
    if (IN(9)) {
        pg8::Gemm g{(const bf16_t*)(ws + WS_HFF), (const bf16_t*)(ws + WS_WFFO), DFF, DFF, DFF / 2, wv}; pg8::Order S; S.init(MTOK, D, 2, G, bx);
        pg8::EpiPart E{(bf16_t*)(ws + WS_P0), (bf16_t*)(ws + WS_P1B)}; pg8::gemm_phase<pg8::EpiPart, pg8::Order>(lds, g, S, E);
    } SEAM(9);
    if (IN(10)) { for (int rep = 0; rep < PROBE_ROW_REP; ++rep) phase9(a, wv, vcu, G); }
    if (PROBE_DUMP) {
        if (PROBE_DUMP != 5 && PROBE_DUMP != 7) { ++nbar; } if (PROBE_DUMP != 5 && PROBE_DUMP != 7) my_grid_barrier(nbar, (unsigned)G, otid(wv), (LAS unsigned*)(lds + LDS_BYTES - 64));
        const bf16_t* src = (const bf16_t*)(ws + (PROBE_DUMP == 1 ? WS_Z : PROBE_DUMP == 2 ? WS_MIX : WS_H)); const int pitch = PROBE_DUMP == 1 ? ZP : D;
        for (size_t i = (size_t)bx * 512 + otid(wv); i < (size_t)MTOK * D; i += (size_t)G * 512) { const int r = (int)(i >> 10), c = (int)(i & 1023); a.out[i] = PROBE_DUMP == 7 ? 1.0f : PROBE_DUMP == 6 ? (r < 2304 ? bf2f(((const bf16_t*)(ws + WS_WIN))[(size_t)r * 1024 + c]) : 0.f) : PROBE_DUMP >= 4 ? xrow_ptr(a, r)[c] * 2.f : bf2f(src[(size_t)r * pitch + c]); }
        for (size_t i = O_KV + (size_t)bx * 512 + otid(wv); i < 10616832; i += (size_t)G * 512) a.out[i] = 0.f;
    }
    for (int xb = 0; xb < PROBE_XBAR; ++xb) { ++nbar; my_grid_barrier(nbar, (unsigned)G, otid(wv), (LAS unsigned*)(lds + LDS_BYTES - 64)); }
    if (nbar) my_grid_barrier_finish((unsigned)G, otid(wv));
#undef IN
#undef SEAM
}

extern "C" void kernel_launch(void* const* d_in, const int* in_sizes, int n_in, void* d_out, int out_size, void* d_ws, size_t ws_size, hipStream_t stream) {
    static int grid = 0;
    if (grid == 0) {
        int dev = 0, cus = 0;
        static const int exp_sizes[26] = {4194304, 4194304, 131072, 16384, 65536, 65536, 2048, 1024, 6291456, 6144, 1024, 2293760, 384, 294912, 256, 262144, 4096, 256, 4096, 256, 128, 1048576, 1024, 5767168, 2883584, 1024};
        bool okk = (n_in == 26); for (int i = 0; okk && i < 26; ++i) okk = (in_sizes[i] == exp_sizes[i]);
        if (!okk || out_size != 10616832) { fprintf(stderr, "kernel_launch: unexpected input sizes\n"); grid = -1; return; }
        if (n_in != 26 || ws_size < 198 * MiB) { fprintf(stderr, "kernel_launch: unexpected n_in %d / ws %zu\n", n_in, ws_size); grid = -1; return; }
        hipGetDevice(&dev); hipDeviceGetAttribute(&cus, hipDeviceAttributeMultiprocessorCount, dev);
        if (hipFuncSetAttribute((const void*)mk_fwd, hipFuncAttributeMaxDynamicSharedMemorySize, LDS_BYTES) != hipSuccess) { fprintf(stderr, "kernel_launch: hipFuncSetAttribute failed\n"); grid = -1; return; }
        int per_cu = 0;
        if (hipOccupancyMaxActiveBlocksPerMultiprocessor(&per_cu, (const void*)mk_fwd, 512, LDS_BYTES) != hipSuccess || per_cu < 1) { fprintf(stderr, "kernel_launch: occupancy query says %d\n", per_cu); per_cu = 1; }
        (void)hipGetLastError();
        if (cus < 256) { fprintf(stderr, "kernel_launch: needs 256 CUs, got %d\n", cus); grid = -1; return; }
        grid = 256;
    }
    if (grid < 0) return;
    Args a{};
    for (int i = 0; i < 26; ++i) a.in[i] = (const float*)d_in[i];
    a.out = (float*)d_out; a.ws = (unsigned char*)d_ws;
#if MK_PER_PHASE_LAUNCH
    for (int p = 0; p < NPHASE; ++p) { if (PROBE_ONLY_LAUNCH >= 0 && p != PROBE_ONLY_LAUNCH) continue; a.ph_lo = p; a.ph_hi = p + 1; hipLaunchKernelGGL(mk_fwd, dim3(grid), dim3(512), LDS_BYTES, stream, a); }
#else
    a.ph_lo = 0; a.ph_hi = NPHASE;
#if MK_COOP
    void* args[] = {&a};
    hipError_t e = hipLaunchCooperativeKernel((const void*)mk_fwd, dim3(grid), dim3(512), args, LDS_BYTES, stream);
    if (e != hipSuccess) fprintf(stderr, "cooperative launch failed: %s (grid %d)\n", hipGetErrorString(e), grid);
#else
    hipLaunchKernelGGL(mk_fwd, dim3(grid), dim3(512), LDS_BYTES, stream, a);
#endif
#endif
}
```

```cpp
#include <hip/hip_runtime.h>
#include <hip/hip_cooperative_groups.h>
#include <cstdio>
#include <cstdint>
namespace cg = cooperative_groups;

#define PROBE_FILL 0
#define PROBE_EXC 0
#define PROBE_BLO 0
#define PROBE_BHI 256
#define PROBE_RSTRIDE 1
#define PROBE_REP 1
#define PROBE_XLO 0
#define PROBE_XHI 8
#define PROBE_HANG 0
#define PROBE_ATT_REP 1
#define PROBE_GLAC_REP 1
#define PROBE_FFI_REP 1
#define PROBE_XBAR 0
#define PROBE_P0_REP 1
#define PROBE_ROW_REP 1
#define PROBE_P3_REP 1
#define PROBE_DUMP 0
#define PROBE_STATS 0
#define PROBE_K6 512
#define PROBE_ONLY_LAUNCH -1
#define PROBE_NOSTORE 0
#define PROBE_FILL_MIB 256
#define PROBE_FILL_VAL 1.2345f
#ifndef PROBE_MUL
#define PROBE_MUL 1.f
#endif
#ifndef PROBE_MODOFF
#define PROBE_MODOFF 0u
#endif
#ifndef MK_COOP
#define MK_COOP 0
#endif
#ifndef MK_PER_PHASE_LAUNCH
#define MK_PER_PHASE_LAUNCH 0
#endif

#define LAS __attribute__((address_space(3)))
typedef unsigned short bf16_t;
typedef short bf16x8 __attribute__((ext_vector_type(8)));
typedef float f32x4 __attribute__((ext_vector_type(4)));
typedef float f32x2 __attribute__((ext_vector_type(2)));
typedef unsigned u32x4 __attribute__((ext_vector_type(4)));
typedef unsigned u32x2 __attribute__((ext_vector_type(2)));

constexpr int D = 1024, MTOK = 8192, MP = 4096;
constexpr int ZP = 2304;
constexpr int C_QLAT = 0, C_KVLAT = 384, C_KROPE = 640, C_GQ = 672, C_GK = 928, C_GV = 1184, C_GFL = 1696, C_GOUT = 1728;
constexpr int DFF = 2816;
constexpr float EPS = 1e-6f;
constexpr float QSCALE = 0.10206207261596577f * 1.4426950408889634f;
constexpr int SKS = 2304;

constexpr size_t MiB = 1u << 20;
constexpr size_t WS_WIN = 1 * MiB;
constexpr size_t WS_WUQ = 6 * MiB;
constexpr size_t WS_WKF = 7 * MiB, WS_WVF = 7 * MiB + 256 * 1024;
constexpr size_t WS_WKU = 7 * MiB + 512 * 1024, WS_WVU = 7 * MiB + 768 * 1024;
constexpr size_t WS_WOUT = 8 * MiB;
constexpr size_t WS_WFFI = 10 * MiB;
constexpr size_t WS_WFFO = 21 * MiB;
constexpr size_t WS_BAR = 27 * MiB - 4096;
constexpr size_t WS_MOD = 27 * MiB;
constexpr size_t WS_RSSQ = 29 * MiB;
constexpr size_t WS_RSSKV = WS_RSSQ;
constexpr size_t WS_MODF = 27 * MiB + 320 * 1024;
constexpr size_t WS_CACHEB = 27 * MiB + 512 * 1024;
constexpr size_t WS_DEC = 28 * MiB;
constexpr size_t WS_H = 32 * MiB;
constexpr size_t WS_Z = 48 * MiB;
constexpr size_t WS_Q = 84 * MiB;
constexpr size_t WS_HFF = 48 * MiB;
constexpr size_t WS_KP = 96 * MiB;
constexpr size_t WS_KS = 102 * MiB;
constexpr size_t WS_VTP = 109 * MiB;
constexpr size_t WS_VTS = 113 * MiB;
constexpr size_t WS_CT = 118 * MiB;
constexpr size_t WS_MIX = 150 * MiB;
constexpr size_t WS_X1 = 166 * MiB;
constexpr size_t WS_P0 = 96 * MiB;
constexpr size_t WS_P1A = 48 * MiB, WS_P1B = 128 * MiB;
constexpr size_t O_Y = 0, O_KV = 8388608, O_KR = O_KV + 1048576, O_SF = O_KR + 131072, O_SB = O_SF + 524288;

constexpr int LDS_BYTES = 147456;

__device__ __forceinline__ unsigned f2bf_sw(float f) { unsigned u = __builtin_bit_cast(unsigned, f); return (u + 0x7fffu + ((u >> 16) & 1u)) >> 16; }
__device__ __forceinline__ unsigned cvt_pk_bf16(float lo, float hi) { unsigned r; asm volatile("v_cvt_pk_bf16_f32 %0, %1, %2" : "=v"(r) : "v"(lo), "v"(hi)); return r; }
__device__ __forceinline__ bf16_t f2bf(float f) { return (bf16_t)(cvt_pk_bf16(f, 0.f) & 0xffffu); }
__device__ __forceinline__ float bf2f(bf16_t b) { return __uint_as_float((unsigned)b << 16); }
__device__ __forceinline__ float bflo(unsigned w) { return __uint_as_float(w << 16); }
__device__ __forceinline__ float bfhi(unsigned w) { return __uint_as_float(w & 0xffff0000u); }
__device__ __forceinline__ float wave_sum(float v) {
#pragma unroll
    for (int o = 1; o < 64; o <<= 1) v += __shfl_xor(v, o);
    return v;
}
__device__ __forceinline__ float fast_rcp(float x) { return __builtin_amdgcn_rcpf(x); }
__device__ __forceinline__ float silu_f(float a) { return a * fast_rcp(1.f + __expf(-a)); }
__device__ __forceinline__ float logsigmoid_f(float x) { return fminf(x, 0.f) - __logf(1.f + __expf(-fabsf(x))); }
__device__ __forceinline__ int opaque_lane() { int l; asm volatile("v_mbcnt_lo_u32_b32 %0, -1, 0\n\tv_mbcnt_hi_u32_b32 %0, -1, %0" : "=v"(l)); return l; }
__device__ __forceinline__ int otid(int wv) { int t = (int)threadIdx.x; asm volatile("" : "+v"(t)); return t; }
#define LDS_WAIT() asm volatile("s_waitcnt lgkmcnt(0)" ::: "memory")
#define VM_WAIT() asm volatile("s_waitcnt vmcnt(0)" ::: "memory")

namespace pg8 {
constexpr int BM = 256, BK = 64, HALF = 128, HTB = HALF * BK * 2, STAGE_BYTES = 8 * HTB, NXCD = 8, WGM = 8;
__host__ __device__ __forceinline__ int lds_byte(int r, int c) { const int st = (r >> 4) * 2 + (c >> 5), rr = r & 15, cc = c & 31, ob = rr * 64 + cc * 2; return st * 1024 + (ob ^ (((ob >> 9) & 1) << 5)); }
__host__ __device__ __forceinline__ void stage_rc(int b, int& R, int& C) { const int st = b / 1024, sb = b % 1024, swz = sb ^ (((sb >> 9) & 1) << 5); R = (st >> 1) * 16 + swz / 64; C = (st & 1) * 32 + (swz % 64) / 2; }
__host__ __device__ __forceinline__ int perm32(int rho) { const int n = rho >> 4, i = rho & 15; return 8 * (i >> 2) + 4 * n + (i & 3); }

struct Unit { int pm, pn, ks; };
struct Gemm { const bf16_t* A; const bf16_t* Bt; int lda, ldb, K, wv; };

struct Order {
    int nM, nN, nNs, nwg, G, c;
    __device__ void init(int M, int N, int nsplit, int G_, int c_) { nM = M / BM; nN = N / BM; nNs = nN * nsplit; nwg = nM * nNs; G = G_; c = c_; }
    __device__ bool next(int i, Unit& u) const {
        const long L = (long)i * G + c; if (L >= nwg) return false;
        int wgid = (int)L; { const int q = nwg / NXCD, r = nwg % NXCD, xcd = wgid % NXCD, off = wgid / NXCD; wgid = (xcd < r ? xcd * (q + 1) : r * (q + 1) + (xcd - r) * q) + off; }
        const int nig = WGM * nNs, gid = wgid / nig, fm = gid * WGM, gsz = (nM - fm) < WGM ? (nM - fm) : WGM;
        u.pm = fm + ((wgid % nig) % gsz); const int pn2 = (wgid % nig) / gsz; u.pn = pn2 % nN; u.ks = pn2 / nN; return true;
    }
};

template <class Epi, class Sched, bool ALIGN_EPI = true, bool SP2 = true>
__device__ __forceinline__ void gemm_phase(LAS unsigned char* lds, const Gemm g, const Sched& S, const Epi& E) {
    const int tid = otid(g.wv), wid = g.wv, lane = tid & 63, wr = wid >> 2, wc = wid & 3, fr = lane & 15, fq = lane >> 4;
    const int K = g.K, nt = K / BK;
    unsigned voffA[2], voffB[2];
#pragma unroll
    for (int i = 0; i < 2; ++i) { int R, C; stage_rc(tid * 16 + i * 8192, R, C); const int Rb = Epi::PERM ? ((R & ~31) + perm32(R & 31)) : R;
        voffA[i] = (unsigned)(R * g.lda + C) * 2u; voffB[i] = (unsigned)(Rb * g.ldb + C) * 2u; }
    const size_t kstep = (size_t)(BK * 2);
    const size_t hstepA = (size_t)HALF * g.lda * 2, hstepB = (size_t)HALF * g.ldb * 2;
    const size_t tstepA = 2 * hstepA, tstepB = 2 * hstepB;
    const size_t ksplit = (size_t)K * 2;
    const unsigned ldsw = (unsigned)wid * 1024u;
    const int aoff = lds_byte(wr * 64 + fr, fq * 8), boff = lds_byte(wc * 32 + fr, fq * 8);
#define PG8_SA(b, h) (((b) * 2 + (h)) * HTB)
#define PG8_SB(b, h) ((4 + (b) * 2 + (h)) * HTB)
#define PG8_STAGE(bufoff, gbase, voff) do { _Pragma("unroll") for (int _i = 0; _i < 2; ++_i) \
        __builtin_amdgcn_global_load_lds((const unsigned*)((const char*)(gbase) + (voff)[_i]), (LAS unsigned*)(lds + (bufoff) + ldsw + _i * 8192), 16, 0, 0); } while (0)
#define PG8_LDA(dst, b, h) do { _Pragma("unroll") for (int m = 0; m < 4; ++m) _Pragma("unroll") for (int k = 0; k < 2; ++k) dst[m][k] = *(const LAS bf16x8*)(lds + PG8_SA(b, h) + aoff + m * 2048 + k * 1024); } while (0)
#define PG8_LDB(dst, b, h) do { _Pragma("unroll") for (int n = 0; n < 2; ++n) _Pragma("unroll") for (int k = 0; k < 2; ++k) dst[n][k] = *(const LAS bf16x8*)(lds + PG8_SB(b, h) + boff + n * 2048 + k * 1024); } while (0)
#define PG8_MMA(ai, bj, At, Bt) do { __builtin_amdgcn_s_setprio(1); _Pragma("unroll") for (int m = 0; m < 4; ++m) _Pragma("unroll") for (int n = 0; n < 2; ++n) _Pragma("unroll") for (int k = 0; k < 2; ++k) \
        acc[ai][bj][m][n] = __builtin_amdgcn_mfma_f32_16x16x32_bf16(Bt[n][k], At[m][k], acc[ai][bj][m][n], 0, 0, 0); __builtin_amdgcn_s_setprio(0); } while (0)
#define PG8_WAIT_V(n) asm volatile("s_waitcnt vmcnt(" #n ")" ::: "memory")
#define PG8_WAIT_L(n) asm volatile("s_waitcnt lgkmcnt(" #n ")" ::: "memory")
#define PG8_BAR __builtin_amdgcn_s_barrier()
#define PG8_SCHED __builtin_amdgcn_sched_barrier(0)
    Unit cur, nxt; int ui = 0;
    if (!S.next(0, cur)) return;
    f32x4 acc[2][2][4][2];
#pragma unroll
    for (int a = 0; a < 2; ++a)
#pragma unroll
        for (int b = 0; b < 2; ++b)
#pragma unroll
            for (int m = 0; m < 4; ++m)
#pragma unroll
                for (int n = 0; n < 2; ++n) acc[a][b][m][n] = (f32x4){0.f, 0.f, 0.f, 0.f};
    bf16x8 At[4][2], B0[2][2], B1[2][2];
    const char* cA = (const char*)g.A + (size_t)cur.pm * tstepA + (size_t)cur.ks * ksplit; const char* cB = (const char*)g.Bt + (size_t)cur.pn * tstepB + (size_t)cur.ks * ksplit;
    if constexpr (SP2) {
        PG8_STAGE(PG8_SB(0, 0), cB, voffB); PG8_STAGE(PG8_SB(0, 1), cB + hstepB, voffB); PG8_STAGE(PG8_SA(0, 0), cA, voffA); PG8_STAGE(PG8_SA(0, 1), cA + hstepA, voffA);
        if (wr == 1) PG8_BAR;
        PG8_WAIT_V(2); PG8_BAR;
        PG8_STAGE(PG8_SB(1, 0), cB + kstep, voffB); PG8_STAGE(PG8_SA(1, 0), cA + kstep, voffA); PG8_STAGE(PG8_SB(1, 1), cB + hstepB + kstep, voffB);
        PG8_WAIT_V(6); PG8_BAR;
    } else {
        PG8_STAGE(PG8_SB(0, 0), cB, voffB); PG8_STAGE(PG8_SA(0, 0), cA, voffA); PG8_STAGE(PG8_SB(0, 1), cB + hstepB, voffB); PG8_STAGE(PG8_SA(0, 1), cA + hstepA, voffA);
        if (wr == 1) PG8_BAR;
        PG8_WAIT_V(4); PG8_BAR;
        PG8_STAGE(PG8_SB(1, 0), cB + kstep, voffB); PG8_STAGE(PG8_SA(1, 0), cA + kstep, voffA); PG8_STAGE(PG8_SB(1, 1), cB + hstepB + kstep, voffB);
        PG8_WAIT_V(6); PG8_BAR;
    }
    for (;;) {
        const bool has_next = S.next(ui + 1, nxt);
        const char* nA = has_next ? (const char*)g.A + (size_t)nxt.pm * tstepA + (size_t)nxt.ks * ksplit : cA; const char* nB = has_next ? (const char*)g.Bt + (size_t)nxt.pn * tstepB + (size_t)nxt.ks * ksplit : cB;
#pragma nounroll
        for (int t = 0; t < nt; t += 2) {
            const bool last = (t == nt - 2);
            const char* a1 = cA + (size_t)(t + 1) * kstep;
            const char* a2 = last ? nA : cA + (size_t)(t + 2) * kstep; const char* b2 = last ? nB : cB + (size_t)(t + 2) * kstep;
            const char* a3 = a2 + kstep; const char* b3 = b2 + kstep;
            if constexpr (SP2) {
            PG8_LDB(B0, 0, 0); PG8_LDB(B1, 0, 1); PG8_SCHED; PG8_LDA(At, 0, 0); PG8_STAGE(PG8_SA(1, 1), a1 + hstepA, voffA);
            PG8_WAIT_V(8); PG8_WAIT_L(0); PG8_BAR; PG8_MMA(0, 0, At, B0); PG8_MMA(0, 1, At, B1); PG8_BAR; PG8_SCHED;
            PG8_LDA(At, 0, 1); PG8_STAGE(PG8_SB(0, 0), b2, voffB); PG8_STAGE(PG8_SB(0, 1), b2 + hstepB, voffB); PG8_STAGE(PG8_SA(0, 0), a2, voffA);
            PG8_WAIT_V(8); PG8_WAIT_L(0); PG8_BAR; PG8_MMA(1, 0, At, B0); PG8_MMA(1, 1, At, B1); PG8_BAR; PG8_SCHED;
            PG8_LDB(B0, 1, 0); PG8_LDB(B1, 1, 1); PG8_SCHED; PG8_LDA(At, 1, 0); PG8_STAGE(PG8_SA(0, 1), a2 + hstepA, voffA);
            PG8_WAIT_V(8); PG8_WAIT_L(0); PG8_BAR; PG8_MMA(0, 0, At, B0); PG8_MMA(0, 1, At, B1); PG8_BAR; PG8_SCHED;
            PG8_LDA(At, 1, 1); PG8_STAGE(PG8_SB(1, 0), b3, voffB); PG8_STAGE(PG8_SB(1, 1), b3 + hstepB, voffB); PG8_STAGE(PG8_SA(1, 0), a3, voffA);
            PG8_WAIT_V(8); PG8_WAIT_L(0); PG8_BAR; PG8_MMA(1, 0, At, B0); PG8_MMA(1, 1, At, B1); PG8_BAR; PG8_SCHED;
            } else {
            PG8_LDB(B0, 0, 0); PG8_SCHED; PG8_LDA(At, 0, 0); PG8_STAGE(PG8_SA(1, 1), a1 + hstepA, voffA);
            PG8_WAIT_L(8); PG8_BAR; PG8_WAIT_L(0); PG8_MMA(0, 0, At, B0); PG8_BAR; PG8_SCHED;
            PG8_LDB(B1, 0, 1); PG8_STAGE(PG8_SB(0, 0), b2, voffB);
            PG8_BAR; PG8_WAIT_L(0); PG8_MMA(0, 1, At, B1); PG8_BAR;
            PG8_LDA(At, 0, 1); PG8_STAGE(PG8_SA(0, 0), a2, voffA);
            PG8_BAR; PG8_WAIT_L(0); PG8_MMA(1, 0, At, B0); PG8_BAR; PG8_SCHED;
            PG8_STAGE(PG8_SB(0, 1), b2 + hstepB, voffB);
            PG8_WAIT_V(6); PG8_BAR; PG8_MMA(1, 1, At, B1); PG8_BAR;
            PG8_LDB(B0, 1, 0); PG8_SCHED; PG8_LDA(At, 1, 0); PG8_STAGE(PG8_SA(0, 1), a2 + hstepA, voffA);
            PG8_WAIT_L(8); PG8_BAR; PG8_WAIT_L(0); PG8_MMA(0, 0, At, B0); PG8_BAR; PG8_SCHED;
            PG8_LDB(B1, 1, 1); PG8_STAGE(PG8_SB(1, 0), b3, voffB);
            PG8_BAR; PG8_WAIT_L(0); PG8_MMA(0, 1, At, B1); PG8_BAR;
            PG8_LDA(At, 1, 1); PG8_STAGE(PG8_SA(1, 0), a3, voffA);
            PG8_BAR; PG8_WAIT_L(0); PG8_MMA(1, 0, At, B0); PG8_BAR; PG8_SCHED;
            PG8_STAGE(PG8_SB(1, 1), b3 + hstepB, voffB);
            PG8_WAIT_V(6); PG8_BAR; PG8_MMA(1, 1, At, B1); PG8_BAR;
            }
        }
        if constexpr (ALIGN_EPI) { if (wr == 0) PG8_BAR; }
        E(acc, cur, wr, wc, fr, fq);
        if (!has_next) break;
#pragma unroll
        for (int a = 0; a < 2; ++a)
#pragma unroll
            for (int b = 0; b < 2; ++b)
#pragma unroll
                for (int m = 0; m < 4; ++m)
#pragma unroll
                    for (int n = 0; n < 2; ++n) acc[a][b][m][n] = (f32x4){0.f, 0.f, 0.f, 0.f};
        cur = nxt; cA = nA; cB = nB; ++ui;
        if constexpr (ALIGN_EPI) { if (wr == 1) PG8_BAR; }
    }
    PG8_WAIT_V(0);
    if constexpr (!ALIGN_EPI) { if (wr == 0) PG8_BAR; }
    PG8_BAR;
#undef PG8_SA
#undef PG8_SB
#undef PG8_STAGE
#undef PG8_LDA
#undef PG8_LDB
#undef PG8_MMA
#undef PG8_WAIT_V
#undef PG8_WAIT_L
#undef PG8_BAR
#undef PG8_SCHED
}

__device__ __forceinline__ float rss_q(const float* rss, int row) { float s = 0.f;
#pragma unroll
    for (int p = 0; p < 12; ++p) s += rss[(size_t)p * MTOK + row]; return s; }
__device__ __forceinline__ float rss_kv(const float* rss, int row) { float s = 0.f;
#pragma unroll
    for (int p = 12; p < 20; ++p) s += rss[(size_t)p * MTOK + row]; return s; }
#define EPI_ROWS_BEGIN _Pragma("unroll") for (int ai = 0; ai < 2; ++ai) _Pragma("unroll") for (int m = 0; m < 4; ++m) { const int row = u.pm * BM + wr * 64 + fr + ai * HALF + m * 16;
#define EPI_ROWS_END asm volatile("" ::: "memory"); }

struct EpiZ {
    static constexpr bool PERM = true;
    bf16_t* Z; float* rssq; float* rsskv; int pn_off;
    __device__ __forceinline__ void operator()(const f32x4 (&acc)[2][2][4][2], const Unit& u, int wr, int wc, int fr_, int fq_) const {
        int lane_e = (int)threadIdx.x & 63; asm volatile("" : "+v"(lane_e)); const int fr = lane_e & 15, fq = lane_e >> 4;
        const int col0 = (u.pn + pn_off) * BM + wc * 32 + 8 * fq;
        EPI_ROWS_BEGIN
            bf16_t* rowp = Z + (size_t)row * ZP + col0;
#pragma unroll
            for (int bj = 0; bj < 2; ++bj) { const f32x4 v0 = acc[ai][bj][m][0], v1 = acc[ai][bj][m][1];
                u32x4 w; w.x = cvt_pk_bf16(v0[0], v0[1]); w.y = cvt_pk_bf16(v0[2], v0[3]); w.z = cvt_pk_bf16(v1[0], v1[1]); w.w = cvt_pk_bf16(v1[2], v1[3]);
                *(u32x4*)(rowp + bj * HALF) = w;
                const int hc = 2 * (u.pn + pn_off) + bj;
                if (hc < 5) { float s = (v0[0] * v0[0] + v0[1] * v0[1]) + (v0[2] * v0[2] + v0[3] * v0[3]) + (v1[0] * v1[0] + v1[1] * v1[1]) + (v1[2] * v1[2] + v1[3] * v1[3]);
                    s += __shfl_xor(s, 16); s += __shfl_xor(s, 32);
                    if (fq == 0) rssq[(size_t)(hc * 4 + wc) * MTOK + row] = s; } }
        EPI_ROWS_END
    }
};

struct EpiQ {
    static constexpr bool PERM = true;
    bf16_t* Q; const float* rssq;
    __device__ __forceinline__ void operator()(const f32x4 (&acc)[2][2][4][2], const Unit& u, int wr, int wc, int fr_, int fq_) const {
        int lane_e = (int)threadIdx.x & 63; asm volatile("" : "+v"(lane_e)); const int fr = lane_e & 15, fq = lane_e >> 4;
        const int col0 = u.pn * BM + wc * 32 + 8 * fq;
        const float inv[8] = {1.f, 0.316227766f, 0.1f, 0.0316227766f, 0.01f, 0.00316227766f, 0.001f, 0.000316227766f};
        EPI_ROWS_BEGIN
            const float rs = rsqrtf(rss_q(rssq, row) * (1.f / 384.f) + EPS) * QSCALE;
            const int t = (row - MP) & 2047;
#pragma unroll
            for (int bj = 0; bj < 2; ++bj) { const int c = col0 + bj * HALF; const int j0 = c % 96;
                const bool rp = (row >= MP && j0 >= 64);
                const float pos = (float)((j0 < 80) ? (t >> 6) : (t & 63)) * 0.15915494309189535f;
                const float sg = (j0 & 8) ? 1.f : -1.f;
#pragma unroll
                for (int n = 0; n < 2; ++n) {
                    f32x4 v = acc[ai][bj][m][n] * rs;
#pragma unroll
                    for (int i = 0; i < 4; ++i) { const float p = __shfl_xor(v[i], 16);
                        const float rev = pos * inv[4 * n + i]; const float rf = rev - floorf(rev);
                        const float cs = __builtin_amdgcn_cosf(rf), sn = __builtin_amdgcn_sinf(rf); v[i] = rp ? v[i] * cs + sg * p * sn : v[i]; }
                    u32x2 w; w.x = cvt_pk_bf16(v[0], v[1]); w.y = cvt_pk_bf16(v[2], v[3]);
                    *(u32x2*)(Q + (size_t)row * 768 + c + 4 * n) = w; } }
        EPI_ROWS_END
    }
};

struct EpiK {
    static constexpr bool PERM = true;
    bf16_t* Kp; bf16_t* Ks; const float* rsskv; int ctx;
    __device__ __forceinline__ void operator()(const f32x4 (&acc)[2][2][4][2], const Unit& u, int wr, int wc, int fr_, int fq_) const {
        int lane_e = (int)threadIdx.x & 63; asm volatile("" : "+v"(lane_e)); const int fr = lane_e & 15, fq = lane_e >> 4;
        EPI_ROWS_BEGIN
            float rs = 1.f; unsigned off; bool smp;
            if (ctx) { off = ((unsigned)(row >> 8) * 8u * SKS + (row & 255)) * 96u; smp = true; }
            else { rs = rsqrtf(rss_kv(rsskv, row) * (1.f / 256.f) + EPS);
                if (row < MP) { off = ((unsigned)(row >> 8) * 8u * 256u + (row & 255)) * 96u; smp = false; } else { off = ((unsigned)((row - MP) >> 11) * 8u * SKS + 256u + ((row - MP) & 2047)) * 96u; smp = true; } }
            bf16_t* base = smp ? Ks : Kp; const unsigned hs = (smp ? SKS : 256) * 96u;
#pragma unroll
            for (int bj = 0; bj < 2; ++bj) { const unsigned h = 4 * u.pn + 2 * bj + (wc >> 1); const unsigned j = (wc & 1) * 32 + 8 * fq;
                const f32x4 v0 = acc[ai][bj][m][0] * rs, v1 = acc[ai][bj][m][1] * rs;
                u32x4 w; w.x = cvt_pk_bf16(v0[0], v0[1]); w.y = cvt_pk_bf16(v0[2], v0[3]); w.z = cvt_pk_bf16(v1[0], v1[1]); w.w = cvt_pk_bf16(v1[2], v1[3]);
                *(u32x4*)(base + (off + h * hs + j)) = w; }
        EPI_ROWS_END
    }
};

struct EpiVt {
    static constexpr bool PERM = true;
    bf16_t* Vtp; bf16_t* Vts; const float* rsskv; int ctx;
    __device__ __forceinline__ void operator()(const f32x4 (&acc)[2][2][4][2], const Unit& u, int wr, int wc, int fr_, int fq_) const {
        int lane_e = (int)threadIdx.x & 63; asm volatile("" : "+v"(lane_e)); const int fr = lane_e & 15, fq = lane_e >> 4;
#pragma unroll
        for (int bj = 0; bj < 2; ++bj) {
            const int tok = u.pn * BM + bj * HALF + wc * 32 + 8 * fq;
            f32x4 r0 = {1.f, 1.f, 1.f, 1.f}, r1 = {1.f, 1.f, 1.f, 1.f}; unsigned off; bool smp; unsigned S;
            if (ctx) { off = (unsigned)(tok >> 8) * 8u * 64u * SKS + (tok & 255); smp = true; S = SKS; }
            else { f32x4 q0 = {0.f, 0.f, 0.f, 0.f}, q1 = {0.f, 0.f, 0.f, 0.f};
#pragma unroll
                for (int p = 12; p < 20; ++p) { q0 += *(const f32x4*)(rsskv + (size_t)p * MTOK + tok); q1 += *(const f32x4*)(rsskv + (size_t)p * MTOK + tok + 4); }
#pragma unroll
                for (int i = 0; i < 4; ++i) { r0[i] = rsqrtf(q0[i] * (1.f / 256.f) + EPS); r1[i] = rsqrtf(q1[i] * (1.f / 256.f) + EPS); }
                if (tok < MP) { off = (unsigned)(tok >> 8) * 8u * 64u * 256u + (tok & 255); smp = false; S = 256; } else { off = (unsigned)((tok - MP) >> 11) * 8u * 64u * SKS + 256u + ((tok - MP) & 2047); smp = true; S = SKS; } }
            bf16_t* base = smp ? Vts : Vtp;
#pragma unroll
            for (int ai = 0; ai < 2; ++ai)
#pragma unroll
                for (int m = 0; m < 4; ++m) { const unsigned hd = u.pm * BM + wr * 64 + fr + ai * HALF + m * 16;
                    const f32x4 v0 = acc[ai][bj][m][0] * r0, v1 = acc[ai][bj][m][1] * r1;
                    u32x4 w; w.x = cvt_pk_bf16(v0[0], v0[1]); w.y = cvt_pk_bf16(v0[2], v0[3]); w.z = cvt_pk_bf16(v1[0], v1[1]); w.w = cvt_pk_bf16(v1[2], v1[3]);
                    *(u32x4*)(base + (off + hd * S)) = w; }
            asm volatile("" ::: "memory");
        }
    }
};

struct EpiPart {
    static constexpr bool PERM = true;
    bf16_t* P0; bf16_t* P1;
    __device__ __forceinline__ void operator()(const f32x4 (&acc)[2][2][4][2], const Unit& u, int wr, int wc, int fr_, int fq_) const {
        int lane_e = (int)threadIdx.x & 63; asm volatile("" : "+v"(lane_e)); const int fr = lane_e & 15, fq = lane_e >> 4;
        const int col0 = u.pn * BM + wc * 32 + 8 * fq; bf16_t* P = u.ks ? P1 : P0;
        EPI_ROWS_BEGIN
            bf16_t* rowp = P + (size_t)row * D + col0;
#pragma unroll
            for (int bj = 0; bj < 2; ++bj) { const f32x4 v0 = acc[ai][bj][m][0], v1 = acc[ai][bj][m][1];
                u32x4 w; w.x = cvt_pk_bf16(v0[0], v0[1]); w.y = cvt_pk_bf16(v0[2], v0[3]); w.z = cvt_pk_bf16(v1[0], v1[1]); w.w = cvt_pk_bf16(v1[2], v1[3]);
                *(u32x4*)(rowp + bj * HALF) = w; }
        EPI_ROWS_END
    }
};

struct EpiFFI {
    static constexpr bool PERM = true;
    bf16_t* H;
    __device__ __forceinline__ void operator()(const f32x4 (&acc)[2][2][4][2], const Unit& u, int wr, int wc, int fr_, int fq_) const {
        int lane_e = (int)threadIdx.x & 63; asm volatile("" : "+v"(lane_e)); const int fr = lane_e & 15, fq = lane_e >> 4;
        const int col0 = u.pn * HALF + wc * 32 + 8 * fq;
        EPI_ROWS_BEGIN
            float o[8];
#pragma unroll
            for (int i = 0; i < 4; ++i) { o[i] = silu_f(acc[ai][0][m][0][i]) * acc[ai][1][m][0][i]; o[4 + i] = silu_f(acc[ai][0][m][1][i]) * acc[ai][1][m][1][i]; }
            u32x4 w; w.x = cvt_pk_bf16(o[0], o[1]); w.y = cvt_pk_bf16(o[2], o[3]); w.z = cvt_pk_bf16(o[4], o[5]); w.w = cvt_pk_bf16(o[6], o[7]);
            *(u32x4*)(H + (size_t)row * DFF + col0) = w;
        EPI_ROWS_END
    }
};
}

struct Args { const float* in[26]; float* out; unsigned char* ws; int ph_lo, ph_hi; };
enum { I_XP = 0, I_XS, I_CKV, I_CKR, I_SF, I_SB, I_C, I_CCTX, I_WADA, I_BADA, I_NATT, I_WIN, I_QN, I_WUQ, I_KVN, I_WUKV, I_WGF, I_BGF, I_WGB, I_BGB, I_GLAN, I_WOUT, I_NFFN, I_WFFI, I_WFFO, I_FN };

__device__ __forceinline__ const float* xrow_ptr(const Args& a, int r) { return r < MP ? a.in[I_XP] + (size_t)r * D : a.in[I_XS] + (size_t)(r - MP) * D; }
__device__ __forceinline__ int cond_of_row(int r) { return r < MP ? 0 : 1 + ((r - MP) >> 11); }

__device__ __forceinline__ void p0_tr(const float* W, int K, int N, bf16_t* WT, bf16_t* WT2, const float* kscale, int kb, int nb, int drow, LAS float* scr, int lane) {
    const int k0 = 64 * kb, n0 = 32 * nb;
#pragma unroll 8
    for (int i = 0; i < 32; ++i) { const int kk = 2 * i + (lane >> 5); scr[kk * 33 + (lane & 31)] = W[(size_t)(k0 + kk) * N + n0 + (lane & 31)]; }
    LDS_WAIT();
    const int c = lane & 7;
    float sc[8];
#pragma unroll
    for (int i = 0; i < 8; ++i) sc[i] = kscale ? kscale[k0 + 8 * c + i] : 1.f;
#pragma unroll
    for (int j = 0; j < 4; ++j) { const int n = (lane >> 3) + 8 * j; const LAS float* s = scr + (8 * c) * 33 + n;
        float v[8];
#pragma unroll
        for (int i = 0; i < 8; ++i) v[i] = s[i * 33];
        if (WT2) { u32x4 o; o.x = cvt_pk_bf16(v[0], v[1]); o.y = cvt_pk_bf16(v[2], v[3]); o.z = cvt_pk_bf16(v[4], v[5]); o.w = cvt_pk_bf16(v[6], v[7]);
            *(u32x4*)(WT2 + (size_t)(drow + n0 + n) * K + k0 + 8 * c) = o; }
        u32x4 o; o.x = cvt_pk_bf16(v[0] * sc[0], v[1] * sc[1]); o.y = cvt_pk_bf16(v[2] * sc[2], v[3] * sc[3]); o.z = cvt_pk_bf16(v[4] * sc[4], v[5] * sc[5]); o.w = cvt_pk_bf16(v[6] * sc[6], v[7] * sc[7]);
        *(u32x4*)(WT + (size_t)(drow + n0 + n) * K + k0 + 8 * c) = o; }
    LDS_WAIT();
}

__device__ __forceinline__ void phase0(const Args& a, int wv, LAS unsigned char* lds, int vcu, int G) {
    const int tid = otid(wv), lane = tid & 63, wave = __builtin_amdgcn_readfirstlane(tid >> 6);
    unsigned char* ws = a.ws;
#ifndef P0MASK
#define P0MASK 7
#endif
    if (P0MASK & 2) {
        LAS float* scr = (LAS float*)(lds + wave * 16384);
        LAS float* scnd = (LAS float*)(lds + 131072);
        for (int i = tid; i < 3072; i += 512) { const int ci = i >> 10, k = i & 1023; scnd[i] = silu_f(ci == 0 ? a.in[I_CCTX][k] : a.in[I_C][(ci - 1) * D + k]); }
        __syncthreads();
        const int gw = vcu * 8 + wave, NGW = G * 8;
        constexpr int T_IN = 16 * 70, T_UQ = 6 * 24, T_UKV = 4 * 32, T_OUT = 16 * 32, T_FFI = 16 * 176, T_FFO = 44 * 32, T_ZERO = 64, T_ADA = 768;
        constexpr int NIT = T_ADA + T_IN + T_UQ + T_UKV + T_OUT + T_FFI + T_FFO + T_ZERO;
        constexpr int NTR = NIT - T_ADA;
        const int nslot = wave < 3 ? 2 : 5;
        for (int sl = 0; sl < nslot; ++sl) {
            int r;
            if (wave < 3) { if (sl == 0) { r = wave * G + vcu; if (r >= T_ADA) continue; } else { const int t = vcu + G * wave; if (t >= NTR) continue; r = T_ADA + t; } }
            else { const int j = 3 + (wave - 3) + 5 * sl; const int t = vcu + G * j; if (t >= NTR) continue; r = T_ADA + t; }
            if (r < T_ADA) {
                const int nbq = r >> 2, kq = r & 3; const int n0 = 32 * nbq; const float* W = a.in[I_WADA];
                const int n = lane & 31, hf = lane >> 5; float s0 = 0.f, s1 = 0.f, s2 = 0.f;
                for (int kb = 4 * kq; kb < 4 * kq + 4; ++kb) { const int k0 = 64 * kb;
#pragma unroll 8
                    for (int i = 0; i < 32; ++i) { const int kk = 2 * i + (lane >> 5); scr[kk * 33 + (lane & 31)] = W[(size_t)(k0 + kk) * 6144 + n0 + (lane & 31)]; }
                    LDS_WAIT();
#pragma unroll 8
                    for (int j = 0; j < 32; ++j) { const int kk = hf * 32 + j; const float w = scr[kk * 33 + n];
                        s0 += w * scnd[k0 + kk]; s1 += w * scnd[1024 + k0 + kk]; s2 += w * scnd[2048 + k0 + kk]; }
                    LDS_WAIT(); }
                s0 += __shfl_xor(s0, 32); s1 += __shfl_xor(s1, 32); s2 += __shfl_xor(s2, 32);
                float* MOD = (float*)(ws + WS_MOD) + (size_t)kq * 18432;
                if (kq == 0) { const float bv = a.in[I_BADA][n0 + n]; s0 += bv; s1 += bv; s2 += bv; }
                if (hf == 0) { MOD[n0 + n] = s0; MOD[6144 + n0 + n] = s1; MOD[12288 + n0 + n] = s2; }
                continue; } r -= T_ADA;
            if (r < T_FFI) { const int kb = r / 176, nb = r % 176; const int n0 = nb * 32; const int drow = n0 < DFF ? (n0 / 128) * 256 + (n0 % 128) : ((n0 - DFF) / 128) * 256 + 128 + ((n0 - DFF) % 128);
                p0_tr(a.in[I_WFFI], 1024, 5632, (bf16_t*)(ws + WS_WFFI), nullptr, nullptr, kb, nb, drow - n0, scr, lane); continue; } r -= T_FFI;
            if (r < T_FFO) { p0_tr(a.in[I_WFFO], DFF, 1024, (bf16_t*)(ws + WS_WFFO), nullptr, nullptr, r / 32, r % 32, 0, scr, lane); continue; } r -= T_FFO;
            if (r < T_IN) { p0_tr(a.in[I_WIN], 1024, 2240, (bf16_t*)(ws + WS_WIN), nullptr, nullptr, r / 70, r % 70, 0, scr, lane); continue; } r -= T_IN;
            if (r < T_OUT) { p0_tr(a.in[I_WOUT], 1024, 1024, (bf16_t*)(ws + WS_WOUT), nullptr, nullptr, r / 32, r % 32, 0, scr, lane); continue; } r -= T_OUT;
            if (r < T_UQ) { p0_tr(a.in[I_WUQ], 384, 768, (bf16_t*)(ws + WS_WUQ), nullptr, a.in[I_QN], r / 24, r % 24, 0, scr, lane); continue; } r -= T_UQ;
            if (r < T_UKV) { const int nb = r % 32, n0 = nb * 32, hh = n0 >> 7, j0 = n0 & 127; const bool isv = j0 >= 64; const int drow = hh * 64 + (j0 & 63);
                p0_tr(a.in[I_WUKV], 256, 1024, (bf16_t*)(ws + (isv ? WS_WVF : WS_WKF)), (bf16_t*)(ws + (isv ? WS_WVU : WS_WKU)), a.in[I_KVN], r / 32, nb, drow - n0, scr, lane); continue; } r -= T_UKV;
            { u32x4 z = {0u, 0u, 0u, 0u}; u32x4* p = (u32x4*)((bf16_t*)(ws + WS_WIN) + (size_t)(2240 + r) * 1024); p[lane] = z; p[64 + lane] = z; }
        }
    }
    if (P0MASK & 4) {
        const int gt = vcu * 512 + tid, NT = G * 512;
        for (int i = gt; i < 32768; i += NT) { const f32x4 v = ((const f32x4*)a.in[I_CKV])[i]; u32x2 w; w.x = cvt_pk_bf16(v[0], v[1]); w.y = cvt_pk_bf16(v[2], v[3]); ((u32x2*)(ws + WS_CACHEB))[i] = w; }
    }
}

__device__ __forceinline__ f32x4 mod4(const float* modp, const float* bias, int ci, int off) {
    const float* p = modp + ci * 6144 + off;
    return (*(const f32x4*)p + *(const f32x4*)(p + 18432)) + (*(const f32x4*)(p + 36864) + *(const f32x4*)(p + 55296));
}
__device__ __forceinline__ void phase1(const Args& a, int wv, int vcu, int G) {
    if (PROBE_FILL == 3) { float* m = (float*)(a.ws + WS_MOD); for (int i = otid(wv); i < 3 * 6144; i += 512) { unsigned h = (unsigned)i * 2654435761u; h ^= h >> 15; h *= 2246822519u; h ^= h >> 13; m[i] = ((float)(h & 0xffff) * (1.f / 65536.f) - 0.5f) * 2.f; } __syncthreads(); }
    const int tid_ = otid(wv); const int lane = tid_ & 63, wave = tid_ >> 6; const int gw = vcu * 8 + wave, NGW = G * 8;
    const float* mod = (const float*)(a.ws + WS_MOD + PROBE_MODOFF); bf16_t* H = (bf16_t*)(a.ws + WS_H);
    for (int r = gw; r < MTOK; r += NGW * PROBE_RSTRIDE) {
        const f32x4* xr = (const f32x4*)xrow_ptr(a, r) + lane; const int ci_ = cond_of_row(r);
        f32x4 v[4]; float s = 0.f;
#pragma unroll
        for (int j = 0; j < 4; ++j) { v[j] = xr[64 * j]; s += (v[j][0] * v[j][0] + v[j][1] * v[j][1]) + (v[j][2] * v[j][2] + v[j][3] * v[j][3]); }
        const float rstd = rsqrtf(wave_sum(s) * (1.f / D) + EPS);
        u32x2* o = (u32x2*)(H + (size_t)r * D) + lane;
#pragma unroll
        for (int j = 0; j < 4; ++j) { const int c = 4 * lane + 256 * j; const f32x4 w = *(const f32x4*)(a.in[I_NATT] + c), sh = mod4(mod, a.in[I_BADA], ci_, c), scv = mod4(mod, a.in[I_BADA], ci_, 1024 + c);
            const f32x4 y = v[j] * rstd * w * (scv * PROBE_MUL + 1.f) + sh * PROBE_MUL; u32x2 p; p.x = cvt_pk_bf16(y[0], y[1]); p.y = cvt_pk_bf16(y[2], y[3]); if (PROBE_NOSTORE) { if ((p.x ^ p.y) == 0x12345u) o[64 * j] = p; } else o[64 * j] = p; }
    }
}
__device__ __forceinline__ void phase6(const Args& a, int wv, int vcu, int G) {
    const int tid_ = otid(wv); const int lane = tid_ & 63, wave = tid_ >> 6; const int gw = vcu * 8 + wave, NGW = G * 8;
    const float* mod = (const float*)(a.ws + WS_MODF); bf16_t* H = (bf16_t*)(a.ws + WS_H); float* X1 = (float*)(a.ws + WS_X1);
    const bf16_t* P0 = (const bf16_t*)(a.ws + WS_P0); const bf16_t* P1 = (const bf16_t*)(a.ws + WS_P1A);
    for (int r = gw; r < MTOK; r += NGW) {
        const f32x4* xr = (const f32x4*)xrow_ptr(a, r) + lane; const int ci_ = cond_of_row(r);
        const u32x2* p0 = (const u32x2*)(P0 + (size_t)r * D) + lane; const u32x2* p1 = (const u32x2*)(P1 + (size_t)r * D) + lane;
        f32x4 v[4]; float s = 0.f;
#pragma unroll
        for (int j = 0; j < 4; ++j) { const int c = 4 * lane + 256 * j; const f32x4 gt = (*(const f32x4*)(mod + ci_ * 6144 + (2048 + c)));
            { const u32x2 qa = p0[64 * j], qb = p1[64 * j]; const f32x4 ps = {bflo(qa.x) + bflo(qb.x), bfhi(qa.x) + bfhi(qb.x), bflo(qa.y) + bflo(qb.y), bfhi(qa.y) + bfhi(qb.y)}; v[j] = xr[64 * j] + gt * ps; } s += (v[j][0] * v[j][0] + v[j][1] * v[j][1]) + (v[j][2] * v[j][2] + v[j][3] * v[j][3]); }
        const float rstd = rsqrtf(wave_sum(s) * (1.f / D) + EPS);
        u32x2* x1 = (u32x2*)((bf16_t*)X1 + (size_t)r * D) + lane; u32x2* o = (u32x2*)(H + (size_t)r * D) + lane;
#pragma unroll
        for (int j = 0; j < 4; ++j) { const int c = 4 * lane + 256 * j; { u32x2 xw; xw.x = cvt_pk_bf16(v[j][0], v[j][1]); xw.y = cvt_pk_bf16(v[j][2], v[j][3]); x1[64 * j] = xw; }
            const f32x4 w = *(const f32x4*)(a.in[I_NFFN] + c), sh = (*(const f32x4*)(mod + ci_ * 6144 + (3072 + c))), scv = (*(const f32x4*)(mod + ci_ * 6144 + (4096 + c)));
            const f32x4 y = v[j] * rstd * w * (scv + 1.f) + sh; u32x2 p; p.x = cvt_pk_bf16(y[0], y[1]); p.y = cvt_pk_bf16(y[2], y[3]); o[64 * j] = p; }
    }
}
__device__ __forceinline__ void phase9(const Args& a, int wv, int vcu, int G) {
    const int tid_ = otid(wv); const int lane = tid_ & 63, wave = tid_ >> 6; const int gw = vcu * 8 + wave, NGW = G * 8;
    const float* mod = (const float*)(a.ws + WS_MODF); const float* X1 = (const float*)(a.ws + WS_X1);
    const bf16_t* P0 = (const bf16_t*)(a.ws + WS_P0); const bf16_t* P1 = (const bf16_t*)(a.ws + WS_P1B);
    for (int r = gw; r < MTOK; r += NGW) {
        const u32x2* xr = (const u32x2*)((const bf16_t*)X1 + (size_t)r * D) + lane; const int ci_ = cond_of_row(r);
        const u32x2* p0 = (const u32x2*)(P0 + (size_t)r * D) + lane; const u32x2* p1 = (const u32x2*)(P1 + (size_t)r * D) + lane;
        f32x4 v[4]; float s = 0.f;
#pragma unroll
        for (int j = 0; j < 4; ++j) { const int c = 4 * lane + 256 * j; const f32x4 gt = (*(const f32x4*)(mod + ci_ * 6144 + (5120 + c)));
            { const u32x2 qa = p0[64 * j], qb = p1[64 * j]; const f32x4 ps = {bflo(qa.x) + bflo(qb.x), bfhi(qa.x) + bfhi(qb.x), bflo(qa.y) + bflo(qb.y), bfhi(qa.y) + bfhi(qb.y)}; const u32x2 xq = xr[64 * j]; const f32x4 xv = {bflo(xq.x), bfhi(xq.x), bflo(xq.y), bfhi(xq.y)}; v[j] = xv + gt * ps; } s += (v[j][0] * v[j][0] + v[j][1] * v[j][1]) + (v[j][2] * v[j][2] + v[j][3] * v[j][3]); }
        const float rstd = rsqrtf(wave_sum(s) * (1.f / D) + EPS);
        f32x4* y = (f32x4*)(a.out + O_Y + (size_t)r * D) + lane;
#pragma unroll
        for (int j = 0; j < 4; ++j) { const int c = 4 * lane + 256 * j; const f32x4 w = *(const f32x4*)(a.in[I_FN] + c); y[64 * j] = v[j] * rstd * w; }
    }
}

__device__ __forceinline__ void p3_row_extras(const Args& a, int wv, int gw, int NGW) {
    const int lane = otid(wv) & 63;
    const bf16_t* Z = (const bf16_t*)(a.ws + WS_Z); const float* rsskv = (const float*)(a.ws + WS_RSSKV);
    bf16_t* Kp = (bf16_t*)(a.ws + WS_KP); bf16_t* Ks = (bf16_t*)(a.ws + WS_KS);
    const float inv[8] = {1.f, 0.316227766f, 0.1f, 0.0316227766f, 0.01f, 0.00316227766f, 0.001f, 0.000316227766f};
    for (int r = gw; r < MTOK + 512; r += NGW) {
        if (r < MTOK) {
            const bf16_t* zr = Z + (size_t)r * ZP;
            if (r < MP) {
                const float rs = rsqrtf(pg8::rss_kv(rsskv, r) * (1.f / 256.f) + EPS);
                const u32x2 w = *(const u32x2*)(zr + C_KVLAT + 4 * lane); const f32x4 g = *(const f32x4*)(a.in[I_KVN] + 4 * lane);
                f32x4 o; o[0] = bflo(w.x) * rs * g[0]; o[1] = bfhi(w.x) * rs * g[1]; o[2] = bflo(w.y) * rs * g[2]; o[3] = bfhi(w.y) * rs * g[3];
                *(f32x4*)(a.out + O_KV + (size_t)r * 256 + 4 * lane) = o;
            }
            const int i = lane & 31;
            float v = bf2f(zr[C_KROPE + i]);
            if (r < MP && lane < 32) a.out[O_KR + (size_t)r * 32 + i] = v;
            const float pv = __shfl_xor(v, 8);
            int b, s; bf16_t* kb;
            if (r >= MP) { const int t = (r - MP) & 2047; const float pos = (float)((i < 16) ? (t >> 6) : (t & 63));
                const float rev = pos * inv[i & 7] * 0.15915494309189535f; const float rf = rev - floorf(rev);
                const float cs = __builtin_amdgcn_cosf(rf), sn = __builtin_amdgcn_sinf(rf); v = v * cs + ((i & 8) ? pv : -pv) * sn;
                b = (r - MP) >> 11; s = 256 + t; kb = Ks + ((size_t)(b * 8) * SKS + s) * 96 + 64 + i;
                const bf16_t o = f2bf(v);
                if (lane < 32) { for (int h = 0; h < 8; ++h) kb[(size_t)h * SKS * 96] = o; }
            } else { b = r >> 8; s = r & 255; kb = Kp + ((size_t)(b * 8) * 256 + s) * 96 + 64 + i; const bf16_t o = f2bf(v);
                if (lane < 32) { for (int h = 0; h < 8; ++h) kb[(size_t)h * 256 * 96] = o; } }
        } else {
            const int rr = r - MTOK, b = rr >> 8, s = rr & 255, i = lane & 31;
            const bf16_t o = f2bf(a.in[I_CKR][(size_t)rr * 32 + i]); bf16_t* kb = Ks + ((size_t)(b * 8) * SKS + s) * 96 + 64 + i;
            if (lane < 32) { for (int h = 0; h < 8; ++h) kb[(size_t)h * SKS * 96] = o; }
        }
    }
}

constexpr int GL_LOW = 0, GL_WG = 8192, GL_BG = 16384, GL_SEG = 16896, GL_RED = 20992, GL_VT = 22528, GL_QF = 40960, GL_KF = GL_QF + 9216, GL_QB = GL_KF + 9216, GL_KB = GL_QB + 9216;
constexpr int GROW = 144;

__device__ __forceinline__ void gla_gates(const Args& a, int wv, LAS unsigned char* lds, int r0, int h, float (&cumF)[8], float (&cumB)[8], float& totF, float& totB) {
    const int tid = otid(wv), d = tid & 63, tg = tid >> 6;
    const bf16_t* Z = (const bf16_t*)(a.ws + WS_Z);
    LAS float* low = (LAS float*)(lds + GL_LOW); LAS float* wg = (LAS float*)(lds + GL_WG); LAS float* bg = (LAS float*)(lds + GL_BG); LAS float* seg = (LAS float*)(lds + GL_SEG);
    { const int t = tid >> 3, r4 = (tid & 7) * 4; const u32x2 w = *(const u32x2*)(Z + (size_t)(r0 + t) * ZP + C_GFL + r4);
      low[t * 32 + r4] = bflo(w.x); low[t * 32 + r4 + 1] = bfhi(w.x); low[t * 32 + r4 + 2] = bflo(w.y); low[t * 32 + r4 + 3] = bfhi(w.y); }
    { const int dir = tid >> 8, r = (tid >> 4) & 15, d4 = (tid & 15) * 4; const f32x4 w = *(const f32x4*)(a.in[dir ? I_WGB : I_WGF] + r * 256 + h * 64 + d4);
      *(LAS f32x4*)(wg + (dir * 16 + r) * 64 + d4) = w; }
    if (tid < 128) { const int dir = tid >> 6; bg[tid] = a.in[dir ? I_BGB : I_BGF][h * 64 + (tid & 63)]; }
    __syncthreads();
    float wf[16], wb[16];
#pragma unroll
    for (int r = 0; r < 16; ++r) { wf[r] = wg[r * 64 + d]; wb[r] = wg[(16 + r) * 64 + d]; }
    const float bf_ = bg[d], bb_ = bg[64 + d];
    float gf[8], gb[8];
#pragma unroll
    for (int i = 0; i < 8; ++i) { const int t = tg * 8 + i; float xf = bf_, xb = bb_;
#pragma unroll
        for (int r = 0; r < 16; ++r) { xf += low[t * 32 + r] * wf[r]; xb += low[t * 32 + 16 + r] * wb[r]; }
        gf[i] = logsigmoid_f(xf) * (1.f / 16.f); gb[i] = logsigmoid_f(xb) * (1.f / 16.f); }
#pragma unroll
    for (int i = 1; i < 8; ++i) gf[i] += gf[i - 1];
#pragma unroll
    for (int i = 6; i >= 0; --i) gb[i] += gb[i + 1];
    seg[tg * 64 + d] = gf[7]; seg[512 + tg * 64 + d] = gb[0];
    __syncthreads();
    float offF = 0.f, offB = 0.f; totF = 0.f; totB = 0.f;
#pragma unroll
    for (int g = 0; g < 8; ++g) { const float sf = seg[g * 64 + d], sb = seg[512 + g * 64 + d]; totF += sf; totB += sb; if (g < tg) offF += sf; if (g > tg) offB += sb; }
#pragma unroll
    for (int i = 0; i < 8; ++i) { cumF[i] = gf[i] + offF; cumB[i] = gb[i] + offB; }
}
__device__ __forceinline__ void gla_load_vT(const Args& a, int wv, LAS unsigned char* lds, int r0, int h) {
    const int tid = otid(wv), e = tid & 127, tq = tid >> 7;
    const bf16_t* Z = (const bf16_t*)(a.ws + WS_Z) + (size_t)r0 * ZP + C_GV + h * 128 + e;
    unsigned w[8];
#pragma unroll
    for (int i = 0; i < 8; ++i) { const unsigned lo = Z[(size_t)(tq * 16 + 2 * i) * ZP], hi = Z[(size_t)(tq * 16 + 2 * i + 1) * ZP]; w[i] = lo | (hi << 16); }
    LAS u32x4* p = (LAS u32x4*)(lds + GL_VT + e * GROW + tq * 32);
    p[0] = (u32x4){w[0], w[1], w[2], w[3]}; p[1] = (u32x4){w[4], w[5], w[6], w[7]};
}

__device__ __forceinline__ void gla_stepA(const Args& a, int wv, LAS unsigned char* lds, int u) {
    const int tid = otid(wv), lane = tid & 63, wave = __builtin_amdgcn_readfirstlane(tid >> 6), d = tid & 63, tg = tid >> 6, fr = lane & 15, fq = lane >> 4;
    const int cgi = u >> 2, h = u & 3, r0 = cgi * 64;
    const bf16_t* Z = (const bf16_t*)(a.ws + WS_Z);
    float cumF[8], cumB[8], totF, totB;
    gla_gates(a, wv, lds, r0, h, cumF, cumB, totF, totB);
    unsigned kf[4], kb[4];
#pragma unroll
    for (int i = 0; i < 4; ++i) { const float k0 = bf2f(Z[(size_t)(r0 + tg * 8 + 2 * i) * ZP + C_GK + h * 64 + d]), k1 = bf2f(Z[(size_t)(r0 + tg * 8 + 2 * i + 1) * ZP + C_GK + h * 64 + d]);
        kf[i] = cvt_pk_bf16(k0 * __expf(totF - cumF[2 * i]), k1 * __expf(totF - cumF[2 * i + 1]));
        kb[i] = cvt_pk_bf16(k0 * __expf(totB - cumB[2 * i]), k1 * __expf(totB - cumB[2 * i + 1])); }
    *(LAS u32x4*)(lds + GL_QF + d * GROW + tg * 16) = (u32x4){kf[0], kf[1], kf[2], kf[3]};
    *(LAS u32x4*)(lds + GL_KF + d * GROW + tg * 16) = (u32x4){kb[0], kb[1], kb[2], kb[3]};
    gla_load_vT(a, wv, lds, r0, h);
    if (tg == 0) { float* dec = (float*)(a.ws + WS_DEC) + (size_t)u * 128; dec[d] = __expf(totF); dec[64 + d] = __expf(totB); }
    __syncthreads();
    const int dir = wave >> 2, eb0 = 2 * (wave & 3);
    const LAS unsigned char* kd = lds + (dir ? GL_KF : GL_QF);
    float* CT = (float*)(a.ws + WS_CT) + ((size_t)u * 2 + dir) * 8192;
#pragma unroll
    for (int eb = 0; eb < 2; ++eb) {
        bf16x8 vf[2];
#pragma unroll
        for (int ks = 0; ks < 2; ++ks) vf[ks] = *(const LAS bf16x8*)(lds + GL_VT + (16 * (eb0 + eb) + fr) * GROW + (32 * ks + 8 * fq) * 2);
#pragma unroll
        for (int db = 0; db < 4; ++db) { f32x4 c = {0.f, 0.f, 0.f, 0.f};
#pragma unroll
            for (int ks = 0; ks < 2; ++ks) { const bf16x8 kfr = *(const LAS bf16x8*)(kd + (16 * db + fr) * GROW + (32 * ks + 8 * fq) * 2); c = __builtin_amdgcn_mfma_f32_16x16x32_bf16(vf[ks], kfr, c, 0, 0, 0); }
#pragma unroll
            for (int j = 0; j < 4; ++j) CT[(16 * (eb0 + eb) + 4 * fq + j) * 64 + 16 * db + fr] = c[j]; }
    }
    __syncthreads();
}

__device__ __forceinline__ void gla_scan(const Args& a, int wv, int vcu, int G) {
    const int gt = vcu * 512 + otid(wv), NT = G * 512;
    float* CTb = (float*)(a.ws + WS_CT); const float* DEC = (const float*)(a.ws + WS_DEC);
    for (int it = gt; it < 32768 + 262144; it += NT) {
        int seq, N, cg0, x;
        if (it < 32768) { seq = 16 + (it >> 14); x = it & 16383; N = 32; cg0 = 64 + 32 * (seq - 16); } else { const int j = it - 32768; seq = j >> 14; x = j & 16383; N = 4; cg0 = 4 * seq; }
        const int h = x >> 12, dir = (x >> 11) & 1, e = (x >> 4) & 127, d4 = (x & 15) * 4;
        f32x4 st = {0.f, 0.f, 0.f, 0.f};
        if (seq >= 16) { const float* s0 = a.in[dir ? I_SB : I_SF] + ((size_t)((seq - 16) * 4 + h) * 64) * 128 + e;
#pragma unroll
            for (int i = 0; i < 4; ++i) st[i] = s0[(size_t)(d4 + i) * 128]; }
        if (N == 32) {
            for (int n0 = 0; n0 < 32; n0 += 8) {
                f32x4 c[8], dc[8];
#pragma unroll
                for (int i = 0; i < 8; ++i) { const int n = dir ? (31 - n0 - i) : (n0 + i); const int u = (cg0 + n) * 4 + h;
                    c[i] = *(const f32x4*)(CTb + ((size_t)u * 2 + dir) * 8192 + e * 64 + d4); dc[i] = *(const f32x4*)(DEC + (size_t)u * 128 + dir * 64 + d4); }
#pragma unroll
                for (int i = 0; i < 8; ++i) { const int n = dir ? (31 - n0 - i) : (n0 + i); const int u = (cg0 + n) * 4 + h;
                    *(f32x4*)(CTb + ((size_t)u * 2 + dir) * 8192 + e * 64 + d4) = st; st = dc[i] * st + c[i]; }
            }
        } else {
            f32x4 c[4], dc[4];
#pragma unroll
            for (int i = 0; i < 4; ++i) { const int n = dir ? (3 - i) : i; const int u = (cg0 + n) * 4 + h;
                c[i] = *(const f32x4*)(CTb + ((size_t)u * 2 + dir) * 8192 + e * 64 + d4); dc[i] = *(const f32x4*)(DEC + (size_t)u * 128 + dir * 64 + d4); }
#pragma unroll
            for (int i = 0; i < 4; ++i) { const int n = dir ? (3 - i) : i; const int u = (cg0 + n) * 4 + h;
                *(f32x4*)(CTb + ((size_t)u * 2 + dir) * 8192 + e * 64 + d4) = st; st = dc[i] * st + c[i]; }
        }
        if (seq < 16) { float* o = a.out + (dir ? O_SB : O_SF) + ((size_t)(seq * 4 + h) * 64) * 128 + e;
#pragma unroll
            for (int i = 0; i < 4; ++i) o[(size_t)(d4 + i) * 128] = st[i]; }
    }
}

__device__ __forceinline__ void gla_stepC(const Args& a, int wv, LAS unsigned char* lds, int u) {
    const int tid = otid(wv), lane = tid & 63, wave = __builtin_amdgcn_readfirstlane(tid >> 6), d = tid & 63, tg = tid >> 6, fr = lane & 15, fq = lane >> 4;
    const int cgi = u >> 2, h = u & 3, r0 = cgi * 64;
    const bf16_t* Z = (const bf16_t*)(a.ws + WS_Z);
    float cumF[8], cumB[8], totF, totB;
    gla_gates(a, wv, lds, r0, h, cumF, cumB, totF, totB);
#pragma unroll
    for (int i = 0; i < 8; ++i) { const int t = tg * 8 + i; const float q = bf2f(Z[(size_t)(r0 + t) * ZP + C_GQ + h * 64 + d]) * 0.125f, k = bf2f(Z[(size_t)(r0 + t) * ZP + C_GK + h * 64 + d]);
        *(LAS bf16_t*)(lds + GL_QF + t * GROW + d * 2) = f2bf(q * __expf(cumF[i]));
        *(LAS bf16_t*)(lds + GL_KF + t * GROW + d * 2) = f2bf(k * __expf(-cumF[i]));
        *(LAS bf16_t*)(lds + GL_QB + t * GROW + d * 2) = f2bf(q * __expf(cumB[i]));
        *(LAS bf16_t*)(lds + GL_KB + t * GROW + d * 2) = f2bf(k * __expf(-cumB[i])); }
    gla_load_vT(a, wv, lds, r0, h);
    __syncthreads();
    const int ch = wave & 1, eq = wave >> 1;
    f32x4 oT[2][2];
#pragma unroll
    for (int i = 0; i < 2; ++i)
#pragma unroll
        for (int j = 0; j < 2; ++j) oT[i][j] = (f32x4){0.f, 0.f, 0.f, 0.f};
#pragma unroll
    for (int dir = 0; dir < 2; ++dir) {
        const LAS unsigned char* qe = lds + (dir ? GL_QB : GL_QF); const LAS unsigned char* ke = lds + (dir ? GL_KB : GL_KF);
        const float* ST = (const float*)(a.ws + WS_CT) + ((size_t)u * 2 + dir) * 8192;
        bf16x8 sf[2][2];
#pragma unroll
        for (int eb = 0; eb < 2; ++eb)
#pragma unroll
            for (int ks = 0; ks < 2; ++ks) { const float* p = ST + (16 * (2 * eq + eb) + fr) * 64 + 32 * ks + 8 * fq; const f32x4 x0 = *(const f32x4*)p, x1 = *(const f32x4*)(p + 4);
                u32x4 w; w.x = cvt_pk_bf16(x0[0], x0[1]); w.y = cvt_pk_bf16(x0[2], x0[3]); w.z = cvt_pk_bf16(x1[0], x1[1]); w.w = cvt_pk_bf16(x1[2], x1[3]); sf[eb][ks] = __builtin_bit_cast(bf16x8, w); }
#pragma unroll
        for (int cb = 0; cb < 2; ++cb) {
            const int cbg = 2 * ch + cb;
            bf16x8 qf[2];
#pragma unroll
            for (int ks = 0; ks < 2; ++ks) qf[ks] = *(const LAS bf16x8*)(qe + (16 * cbg + fr) * GROW + (32 * ks + 8 * fq) * 2);
            f32x4 att[4];
#pragma unroll
            for (int sb = 0; sb < 4; ++sb) {
                f32x4 acc = {0.f, 0.f, 0.f, 0.f};
                const bool need = dir == 0 ? (sb <= cbg) : (sb >= cbg);
                if (need) {
#pragma unroll
                    for (int ks = 0; ks < 2; ++ks) { const bf16x8 kfr = *(const LAS bf16x8*)(ke + (16 * sb + fr) * GROW + (32 * ks + 8 * fq) * 2); acc = __builtin_amdgcn_mfma_f32_16x16x32_bf16(kfr, qf[ks], acc, 0, 0, 0); }
                    if (sb == cbg) {
#pragma unroll
                        for (int j = 0; j < 4; ++j) { const int sl = 4 * fq + j; const bool keep = dir == 0 ? (sl <= fr) : (sl >= fr); acc[j] = keep ? acc[j] : 0.f; } }
                }
                att[sb] = acc;
            }
#pragma unroll
            for (int kp = 0; kp < 2; ++kp) {
                u32x4 w; w.x = cvt_pk_bf16(att[2 * kp][0], att[2 * kp][1]); w.y = cvt_pk_bf16(att[2 * kp][2], att[2 * kp][3]); w.z = cvt_pk_bf16(att[2 * kp + 1][0], att[2 * kp + 1][1]); w.w = cvt_pk_bf16(att[2 * kp + 1][2], att[2 * kp + 1][3]);
                const bf16x8 pb = __builtin_bit_cast(bf16x8, w);
#pragma unroll
                for (int eb = 0; eb < 2; ++eb) { const LAS unsigned char* vp = lds + GL_VT + (16 * (2 * eq + eb) + fr) * GROW + (32 * kp + 4 * fq) * 2;
                    const u32x2 v0 = *(const LAS u32x2*)vp, v1 = *(const LAS u32x2*)(vp + 32); const u32x4 vv = {v0.x, v0.y, v1.x, v1.y};
                    oT[eb][cb] = __builtin_amdgcn_mfma_f32_16x16x32_bf16(__builtin_bit_cast(bf16x8, vv), pb, oT[eb][cb], 0, 0, 0); }
            }
#pragma unroll
            for (int ks = 0; ks < 2; ++ks)
#pragma unroll
                for (int eb = 0; eb < 2; ++eb) oT[eb][cb] = __builtin_amdgcn_mfma_f32_16x16x32_bf16(sf[eb][ks], qf[ks], oT[eb][cb], 0, 0, 0);
        }
    }
    LAS float* red = (LAS float*)(lds + GL_RED);
#pragma unroll
    for (int cb = 0; cb < 2; ++cb) { float s = 0.f;
#pragma unroll
        for (int eb = 0; eb < 2; ++eb)
#pragma unroll
            for (int j = 0; j < 4; ++j) s += oT[eb][cb][j] * oT[eb][cb][j];
        s += __shfl_xor(s, 16); s += __shfl_xor(s, 32);
        if (fq == 0) red[eq * 64 + 16 * (2 * ch + cb) + fr] = s; }
    __syncthreads();
    bf16_t* MIX = (bf16_t*)(a.ws + WS_MIX);
#pragma unroll
    for (int cb = 0; cb < 2; ++cb) { const int c = 16 * (2 * ch + cb) + fr; const float tot = red[c] + red[64 + c] + red[128 + c] + red[192 + c]; const float rstd = rsqrtf(tot * (1.f / 128.f) + EPS);
#pragma unroll
        for (int eb = 0; eb < 2; ++eb) { const int e = 16 * (2 * eq + eb) + 4 * fq; const f32x4 gn = *(const f32x4*)(a.in[I_GLAN] + e);
            const u32x2 gw = *(const u32x2*)(Z + (size_t)(r0 + c) * ZP + C_GOUT + h * 128 + e);
            const float g0 = bflo(gw.x), g1 = bfhi(gw.x), g2 = bflo(gw.y), g3 = bfhi(gw.y);
            const f32x4 o = oT[eb][cb] * rstd * gn; u32x2 w; w.x = cvt_pk_bf16(o[0] * silu_f(g0), o[1] * silu_f(g1)); w.y = cvt_pk_bf16(o[2] * silu_f(g2), o[3] * silu_f(g3));
            *(u32x2*)(MIX + (size_t)(r0 + c) * D + 512 + h * 128 + e) = w; } }
    __syncthreads();
}

constexpr int AT_KROW = 208, AT_VROW = 144, AT_KB = 64 * AT_KROW  , AT_STAGE = AT_KB + 64 * AT_VROW  ;
__device__ __forceinline__ void attn_unit(const Args& a, int wv, LAS unsigned char* lds, int idx) {
    const int tid = otid(wv), lane = tid & 63, wave = __builtin_amdgcn_readfirstlane(tid >> 6), fr = lane & 15, fq = lane >> 4;
    int row0, S, nt; const bf16_t* Kb; const bf16_t* Vb; int h;
    if (idx < 256) { const int b = idx >> 7, qb = idx & 15; h = (idx >> 4) & 7; row0 = MP + b * 2048 + qb * 128; S = SKS; nt = 36;
        Kb = (const bf16_t*)(a.ws + WS_KS) + (size_t)(b * 8 + h) * SKS * 96; Vb = (const bf16_t*)(a.ws + WS_VTS) + (size_t)(b * 8 + h) * 64 * SKS; }
    else { const int j = idx - 256; const int b = j >> 4, qb = j & 1; h = (j >> 1) & 7; row0 = b * 256 + qb * 128; S = 256; nt = 4;
        Kb = (const bf16_t*)(a.ws + WS_KP) + (size_t)(b * 8 + h) * 256 * 96; Vb = (const bf16_t*)(a.ws + WS_VTP) + (size_t)(b * 8 + h) * 64 * 256; }
    const char* src[3]; unsigned step[3]; unsigned dst[3]; bool valid[3];
#pragma unroll
    for (int j = 0; j < 3; ++j) { const int ins = wave + 8 * j; valid[j] = ins < 22;
        if (ins < 13) { const int ck = ins * 64 + lane, r = ck / 13, cc = ck % 13; src[j] = (const char*)Kb + (size_t)r * 192 + (cc < 12 ? cc : 11) * 16; step[j] = 64 * 192; dst[j] = ins * 1024; }
        else { const int cv = (ins - 13) * 64 + lane, r = cv / 9, cc = cv % 9; src[j] = (const char*)Vb + (size_t)r * S * 2 + (cc < 8 ? cc : 7) * 16; step[j] = 128; dst[j] = AT_KB + (ins - 13) * 1024; } }
#define AT_ISSUE(t, buf) do { _Pragma("unroll") for (int j = 0; j < 3; ++j) if (valid[j]) \
        __builtin_amdgcn_global_load_lds((const unsigned*)(src[j] + (size_t)(t) * step[j]), (LAS unsigned*)(lds + (buf) * AT_STAGE + dst[j]), 16, 0, 0); } while (0)
    AT_ISSUE(0, 0);
    const bf16_t* Q = (const bf16_t*)(a.ws + WS_Q) + (size_t)(row0 + wave * 16 + fr) * 768 + h * 96 + 8 * fq;
    bf16x8 qf[3];
#pragma unroll
    for (int ks = 0; ks < 3; ++ks) qf[ks] = *(const bf16x8*)(Q + 32 * ks);
    float mrun = -1e30f, lsum = 0.f;
    f32x4 o[4];
#pragma unroll
    for (int i = 0; i < 4; ++i) o[i] = (f32x4){0.f, 0.f, 0.f, 0.f};
    for (int t = 0; t < nt; ++t) {
        VM_WAIT(); __syncthreads();
        if (t + 1 < nt) AT_ISSUE(t + 1, (t + 1) & 1);
        const LAS unsigned char* kt = lds + (t & 1) * AT_STAGE; const LAS unsigned char* vt = kt + AT_KB;
        f32x4 s[4];
#pragma unroll
        for (int kb = 0; kb < 4; ++kb) { s[kb] = (f32x4){0.f, 0.f, 0.f, 0.f};
#pragma unroll
            for (int ks = 0; ks < 3; ++ks) { const bf16x8 kf = *(const LAS bf16x8*)(kt + (16 * kb + fr) * AT_KROW + (32 * ks + 8 * fq) * 2); s[kb] = __builtin_amdgcn_mfma_f32_16x16x32_bf16(kf, qf[ks], s[kb], 0, 0, 0); } }
        float mx = fmaxf(fmaxf(fmaxf(s[0][0], s[0][1]), fmaxf(s[0][2], s[0][3])), fmaxf(fmaxf(s[1][0], s[1][1]), fmaxf(s[1][2], s[1][3])));
        mx = fmaxf(mx, fmaxf(fmaxf(fmaxf(s[2][0], s[2][1]), fmaxf(s[2][2], s[2][3])), fmaxf(fmaxf(s[3][0], s[3][1]), fmaxf(s[3][2], s[3][3]))));
        { const float m1 = __shfl_xor(mx, 16), m2 = __shfl_xor(mx, 32), m3 = __shfl_xor(mx, 48); mx = fmaxf(fmaxf(mx, m1), fmaxf(m2, m3)); }
        const float mnew = fmaxf(mrun, mx);
        f32x4 psv = {0.f, 0.f, 0.f, 0.f};
#pragma unroll
        for (int kb = 0; kb < 4; ++kb) { s[kb] = s[kb] - mnew;
#pragma unroll
            for (int j = 0; j < 4; ++j) s[kb][j] = __builtin_amdgcn_exp2f(s[kb][j]);
            psv += s[kb]; }
        const float ps = (psv[0] + psv[1]) + (psv[2] + psv[3]);
        if (__builtin_amdgcn_ballot_w64(mnew != mrun) != 0ull) {
            const float alpha = __builtin_amdgcn_exp2f(mrun - mnew); mrun = mnew; lsum *= alpha;
#pragma unroll
            for (int i = 0; i < 4; ++i) o[i] = o[i] * alpha;
        }
        lsum += ps;
#pragma unroll
        for (int kp = 0; kp < 2; ++kp) {
            u32x4 w; w.x = cvt_pk_bf16(s[2 * kp][0], s[2 * kp][1]); w.y = cvt_pk_bf16(s[2 * kp][2], s[2 * kp][3]); w.z = cvt_pk_bf16(s[2 * kp + 1][0], s[2 * kp + 1][1]); w.w = cvt_pk_bf16(s[2 * kp + 1][2], s[2 * kp + 1][3]);
            const bf16x8 pb = __builtin_bit_cast(bf16x8, w);
#pragma unroll
            for (int mb = 0; mb < 4; ++mb) { const LAS unsigned char* vp = vt + (16 * mb + fr) * AT_VROW + (32 * kp + 4 * fq) * 2;
                const u32x2 v0 = *(const LAS u32x2*)vp, v1 = *(const LAS u32x2*)(vp + 32); const u32x4 vv = {v0.x, v0.y, v1.x, v1.y};
                o[mb] = __builtin_amdgcn_mfma_f32_16x16x32_bf16(__builtin_bit_cast(bf16x8, vv), pb, o[mb], 0, 0, 0); }
        }
    }
    lsum += __shfl_xor(lsum, 16); lsum += __shfl_xor(lsum, 32);
    const float il = fast_rcp(lsum);
    bf16_t* MIX = (bf16_t*)(a.ws + WS_MIX) + (size_t)(row0 + wave * 16 + fr) * D + h * 64 + 4 * fq;
#pragma unroll
    for (int mb = 0; mb < 4; ++mb) { u32x2 w; w.x = cvt_pk_bf16(o[mb][0] * il, o[mb][1] * il); w.y = cvt_pk_bf16(o[mb][2] * il, o[mb][3] * il); *(u32x2*)(MIX + 16 * mb) = w; }
    __syncthreads();
#undef AT_ISSUE
}

__device__ unsigned g_bar[64 * 52];
#define GB(i) (g_bar + 64 * (i))
__device__ __forceinline__ unsigned gb_ld(unsigned* p) { return __hip_atomic_load(p, __ATOMIC_RELAXED, __HIP_MEMORY_SCOPE_AGENT); }
__device__ __forceinline__ unsigned gb_add(unsigned* p, unsigned v) { return __hip_atomic_fetch_add(p, v, __ATOMIC_RELAXED, __HIP_MEMORY_SCOPE_AGENT); }
__device__ __forceinline__ unsigned xcc_id() { return (unsigned)__builtin_amdgcn_s_getreg((3 << 11) | 20) & 0xFu; }
__device__ __forceinline__ void my_grid_barrier(unsigned nth, unsigned G, int tid, LAS unsigned* st) {
    asm volatile("s_waitcnt vmcnt(0) lgkmcnt(0)" ::: "memory");
    __syncthreads();
    if (tid == 0) {
        if (nth == 1u) {
            const unsigned x = xcc_id(); unsigned sum, cnt, mine;
            for (;;) { sum = 0u; cnt = 0u; mine = 0u;
#pragma unroll
                for (unsigned j = 0; j < 16; ++j) { const unsigned c = gb_ld(GB(4 + j)); sum += c; cnt += (c > 0u) ? 1u : 0u; mine = (j == x) ? c : mine; }
                if (sum >= G) break; __builtin_amdgcn_s_sleep(1); }
            st[0] = mine; st[1] = cnt; st[2] = x;
        }
        const unsigned nloc = st[0], nx = st[1], x = st[2];
        const unsigned old = gb_add(GB(20 + x), 1u);
        if (old + 1u == nth * nloc) {
            __builtin_amdgcn_fence(__ATOMIC_RELEASE, "agent");
            asm volatile("s_waitcnt vmcnt(0)" ::: "memory");
            const unsigned og = gb_add(GB(1), 1u);
            if (og + 1u == nth * nx) gb_add(GB(2), 1u);
            else while (gb_ld(GB(2)) < nth) __builtin_amdgcn_s_sleep(1);
            __builtin_amdgcn_fence(__ATOMIC_ACQUIRE, "agent");
            gb_add(GB(36 + x), 1u);
            asm volatile("s_waitcnt vmcnt(0)" ::: "memory");
        } else {
            while (gb_ld(GB(36 + x)) < nth) __builtin_amdgcn_s_sleep(1);
            __builtin_amdgcn_fence(__ATOMIC_ACQUIRE, "agent");
            asm volatile("s_waitcnt vmcnt(0)" ::: "memory");
        }
    }
    __syncthreads();
}
__device__ __forceinline__ void my_grid_barrier_finish(unsigned G, int tid) {
    if (tid == 0) {
        const unsigned old = gb_add(GB(0), 1u);
        if (old == G - 1u) { for (int i = 0; i < 52; ++i) __hip_atomic_store(GB(i), 0u, __ATOMIC_RELAXED, __HIP_MEMORY_SCOPE_AGENT); }
    }
}
constexpr int NPHASE = 11;
__global__ void __launch_bounds__(512, 2) mk_fwd(Args a) {
    const int wv = __builtin_amdgcn_readfirstlane((int)threadIdx.x >> 6);
    extern __shared__ __attribute__((aligned(16))) unsigned char lds_raw[];
    LAS unsigned char* lds = (LAS unsigned char*)lds_raw;
    const int G = gridDim.x, bx = blockIdx.x;
    const int vcu = (G % 8 == 0) ? (bx % 8) * (G / 8) + bx / 8 : bx;
    unsigned char* ws = a.ws;
    const int lo = a.ph_lo, hi = a.ph_hi;
#ifndef PHMASK
#define PHMASK 0x7ff
#endif
#define IN(k) (((PHMASK >> (k)) & 1) && lo <= (k) && (k) < hi)
#define SEAM(k) do { if (IN(k) && IN((k) + 1)) { ++nbar; my_grid_barrier(nbar, (unsigned)G, otid(wv), (LAS unsigned*)(lds + LDS_BYTES - 64)); } } while (0)
#ifndef PROBE_FILL
#define PROBE_FILL 0
#endif
    if (PROBE_FILL && lo == 0) { f32x4* p = (f32x4*)a.ws; const size_t n = (size_t)(PROBE_FILL_MIB) << 16; const float fv = PROBE_FILL_VAL;
        for (size_t i = (size_t)bx * 512 + threadIdx.x; i < n; i += (size_t)G * 512) { unsigned h = (unsigned)i * 2654435761u; h ^= h >> 15; h *= 2246822519u; h ^= h >> 13; const float r0 = (float)(h & 0xffff) * (1.f / 65536.f) - 0.5f + fv * 0.f; p[i] = (f32x4){r0, r0 * 1.7f, r0 * -0.3f, r0 + 0.1f}; } }
    if (PROBE_FILL == 2 && lo == 0 && bx == 0) { static const int szs[26] = {4194304, 4194304, 131072, 16384, 65536, 65536, 2048, 1024, 6291456, 6144, 1024, 2293760, 384, 294912, 256, 262144, 4096, 256, 4096, 256, 128, 1048576, 1024, 5767168, 2883584, 1024};
        float sm = 0.f; for (int i = 0; i < 26; ++i) { const int n = szs[i]; const int st = n > 1024 ? n - 1024 : 0; for (int j = st + (int)threadIdx.x; j < n; j += 512) sm += a.in[i][j]; for (int j = threadIdx.x; j < (n < 1024 ? n : 1024); j += 512) sm += a.in[i][j]; }
        ((float*)(a.ws))[threadIdx.x] = sm; }
    if (PROBE_FILL == 5 && lo == 0) { volatile float* p = (volatile float*)a.ws; const float big = p[0] * 0.f + 1e38f, tiny = p[1] * 0.f + 1e-38f, zero = p[2] * 0.f, neg = p[3] * 0.f - 1.f;
        float r = 0.f;
#if PROBE_EXC & 1
        r += big * big;
#endif
#if PROBE_EXC & 2
        r += tiny * tiny;
#endif
#if PROBE_EXC & 4
        r += 1.f / zero;
#endif
#if PROBE_EXC & 8
        r += __builtin_sqrtf(neg);
#endif
        p[4 + bx] = r; }
    unsigned nbar = 0;
    if (otid(wv) == 0) gb_add(GB(4 + xcc_id()), 1u);
    if (IN(0)) { for (int rep = 0; rep < PROBE_P0_REP; ++rep) { phase0(a, wv, lds, vcu, G); __syncthreads(); } } SEAM(0);
    if (IN(1)) { for (int rep = 0; rep < PROBE_ROW_REP; ++rep) phase1(a, wv, vcu, G); } SEAM(1);
    if (PROBE_HANG && lo == 1) { volatile unsigned* q = (volatile unsigned*)(a.ws + 8); while (*q != 0x12345678u) __builtin_amdgcn_s_sleep(20); }
    if (IN(2)) {
        pg8::Gemm g{(const bf16_t*)(ws + WS_H), (const bf16_t*)(ws + WS_WIN), D, D, D, wv}; pg8::Order S; S.init(MTOK, 2048, 1, G, bx);
        pg8::EpiZ E{(bf16_t*)(ws + WS_Z), (float*)(ws + WS_RSSQ), (float*)(ws + WS_RSSKV), 0};
        pg8::gemm_phase<pg8::EpiZ, pg8::Order>(lds, g, S, E);
    } SEAM(2);
    if (IN(3)) {
#ifndef P3MASK
#define P3MASK 0x3f
#endif
#if (P3MASK >> 0) & 1
        { pg8::Gemm g{(const bf16_t*)(ws + WS_Z) + C_QLAT, (const bf16_t*)(ws + WS_WUQ), ZP, 384, 384, wv}; pg8::Order S; S.init(MTOK, 768, 1, G, bx);
          pg8::EpiQ E{(bf16_t*)(ws + WS_Q), (const float*)(ws + WS_RSSQ)}; pg8::gemm_phase<pg8::EpiQ, pg8::Order>(lds, g, S, E); }
#endif
#if (P3MASK >> 1) & 1
        { pg8::Gemm g{(const bf16_t*)(ws + WS_Z) + C_KVLAT, (const bf16_t*)(ws + WS_WKF), ZP, 256, 256, wv}; pg8::Order S; S.init(MTOK, 512, 1, G, (bx + G - 96) % G);
          pg8::EpiK E{(bf16_t*)(ws + WS_KP), (bf16_t*)(ws + WS_KS), (const float*)(ws + WS_RSSKV), 0}; pg8::gemm_phase<pg8::EpiK, pg8::Order>(lds, g, S, E); }
#endif
#if (P3MASK >> 2) & 1
        { pg8::Gemm g{(const bf16_t*)(ws + WS_WVF), (const bf16_t*)(ws + WS_Z) + C_KVLAT, 256, ZP, 256, wv}; pg8::Order S; S.init(512, MTOK, 1, G, (bx + G - 160) % G);
          pg8::EpiVt E{(bf16_t*)(ws + WS_VTP), (bf16_t*)(ws + WS_VTS), (const float*)(ws + WS_RSSKV), 0}; pg8::gemm_phase<pg8::EpiVt, pg8::Order>(lds, g, S, E); }
#endif
#if (P3MASK >> 3) & 1
        { pg8::Gemm g{(const bf16_t*)(ws + WS_CACHEB), (const bf16_t*)(ws + WS_WKU), 256, 256, 256, wv}; pg8::Order S; S.init(512, 512, 1, G, (bx + G - 224) % G);
          pg8::EpiK E{(bf16_t*)(ws + WS_KP), (bf16_t*)(ws + WS_KS), (const float*)(ws + WS_RSSKV), 1}; pg8::gemm_phase<pg8::EpiK, pg8::Order>(lds, g, S, E); }
#endif
#if (P3MASK >> 4) & 1
        { pg8::Gemm g{(const bf16_t*)(ws + WS_WVU), (const bf16_t*)(ws + WS_CACHEB), 256, 256, 256, wv}; pg8::Order S; S.init(512, 512, 1, G, (bx + G - 228) % G);
          pg8::EpiVt E{(bf16_t*)(ws + WS_VTP), (bf16_t*)(ws + WS_VTS), (const float*)(ws + WS_RSSKV), 1}; pg8::gemm_phase<pg8::EpiVt, pg8::Order>(lds, g, S, E); }
#endif
        __syncthreads();
        if (bx == G - 1) { const float* mp = (const float*)(ws + WS_MOD); float* mf = (float*)(ws + WS_MODF);
            for (int i = otid(wv); i < 18432; i += 512) mf[i] = (mp[i] + mp[18432 + i]) + (mp[36864 + i] + mp[55296 + i]); }
        { const int c2 = (bx + G - 232) % G;
          for (int u = c2; u < 512; u += G) gla_stepA(a, wv, lds, u);
          p3_row_extras(a, wv, c2 * 8 + (otid(wv) >> 6), G * 8); }
    } SEAM(3);
    if (IN(4)) {
        if (bx >= 224) {
        { pg8::Gemm g{(const bf16_t*)(ws + WS_H), (const bf16_t*)(ws + WS_WIN) + (size_t)2048 * D, D, D, D, wv}; pg8::Order S; S.init(MTOK, 256, 1, G, bx - 224);
          pg8::EpiZ E{(bf16_t*)(ws + WS_Z), (float*)(ws + WS_RSSQ), (float*)(ws + WS_RSSKV), 8}; pg8::gemm_phase<pg8::EpiZ, pg8::Order>(lds, g, S, E); }
        } else gla_scan(a, wv, bx, 224);
    } SEAM(4);
    if (IN(5)) {
        for (int rep = 0; rep < PROBE_ATT_REP; ++rep) for (int u = vcu; u < 512; u += G) attn_unit(a, wv, lds, u);
        for (int rep = 0; rep < PROBE_GLAC_REP; ++rep) for (int u = vcu; u < 512; u += G) gla_stepC(a, wv, lds, u);
    } SEAM(5);
    if (IN(6)) {
        pg8::Gemm g{(const bf16_t*)(ws + WS_MIX), (const bf16_t*)(ws + WS_WOUT), D, D, PROBE_K6, wv}; pg8::Order S; S.init(MTOK, D, 1024 / PROBE_K6, G, bx);
        pg8::EpiPart E{(bf16_t*)(ws + WS_P0), (bf16_t*)(ws + WS_P1A)}; pg8::gemm_phase<pg8::EpiPart, pg8::Order>(lds, g, S, E);
    } SEAM(6);
    if (IN(7)) { for (int rep = 0; rep < PROBE_ROW_REP; ++rep) phase6(a, wv, vcu, G); } SEAM(7);
    if (IN(8)) {
        pg8::Gemm g{(const bf16_t*)(ws + WS_H), (const bf16_t*)(ws + WS_WFFI), D, D, D, wv}; pg8::Order S; S.init(MTOK, 2 * DFF, 1, G, bx);
        pg8::EpiFFI E{(bf16_t*)(ws + WS_HFF)}; for (int rep = 0; rep < PROBE_FFI_REP; ++rep) pg8::gemm_phase<pg8::EpiFFI, pg8::Order>(lds, g, S, E);
    } SEAM(8);
    if (IN(9)) {
        pg8::Gemm g{(const bf16_t*)(ws + WS_HFF), (const bf16_t*)(ws + WS_WFFO), DFF, DFF, DFF / 2, wv}; pg8::Order S; S.init(MTOK, D, 2, G, bx);
        pg8::EpiPart E{(bf16_t*)(ws + WS_P0), (bf16_t*)(ws + WS_P1B)}; pg8::gemm_phase<pg8::EpiPart, pg8::Order>(lds, g, S, E);
    } SEAM(9);
    if (IN(10)) { for (int rep = 0; rep < PROBE_ROW_REP; ++rep) phase9(a, wv, vcu, G); }
    if (PROBE_DUMP) {
        if (PROBE_DUMP != 5 && PROBE_DUMP != 7) { ++nbar; } if (PROBE_DUMP != 5 && PROBE_DUMP != 7) my_grid_barrier(nbar, (unsigned)G, otid(wv), (LAS unsigned*)(lds + LDS_BYTES - 64));
        const bf16_t* src = (const bf16_t*)(ws + (PROBE_DUMP == 1 ? WS_Z : PROBE_DUMP == 2 ? WS_MIX : WS_H)); const int pitch = PROBE_DUMP == 1 ? ZP : D;
        for (size_t i = (size_t)bx * 512 + otid(wv); i < (size_t)MTOK * D; i += (size_t)G * 512) { const int r = (int)(i >> 10), c = (int)(i & 1023); a.out[i] = PROBE_DUMP == 7 ? 1.0f : PROBE_DUMP == 6 ? (r < 2304 ? bf2f(((const bf16_t*)(ws + WS_WIN))[(size_t)r * 1024 + c]) : 0.f) : PROBE_DUMP >= 4 ? xrow_ptr(a, r)[c] * 2.f : bf2f(src[(size_t)r * pitch + c]); }
        for (size_t i = O_KV + (size_t)bx * 512 + otid(wv); i < 10616832; i += (size_t)G * 512) a.out[i] = 0.f;
    }
    for (int xb = 0; xb < PROBE_XBAR; ++xb) { ++nbar; my_grid_barrier(nbar, (unsigned)G, otid(wv), (LAS unsigned*)(lds + LDS_BYTES - 64)); }
    if (nbar) my_grid_barrier_finish((unsigned)G, otid(wv));
#undef IN
#undef SEAM
}

extern "C" void kernel_launch(void* const* d_in, const int* in_sizes, int n_in, void* d_out, int out_size, void* d_ws, size_t ws_size, hipStream_t stream) {
    static int grid = 0;
    if (grid == 0) {
        int dev = 0, cus = 0;
        static const int exp_sizes[26] = {4194304, 4194304, 131072, 16384, 65536, 65536, 2048, 1024, 6291456, 6144, 1024, 2293760, 384, 294912, 256, 262144, 4096, 256, 4096, 256, 128, 1048576, 1024, 5767168, 2883584, 1024};
        bool okk = (n_in == 26); for (int i = 0; okk && i < 26; ++i) okk = (in_sizes[i] == exp_sizes[i]);
        if (!okk || out_size != 10616832) { fprintf(stderr, "kernel_launch: unexpected input sizes\n"); grid = -1; return; }
        if (n_in != 26 || ws_size < 198 * MiB) { fprintf(stderr, "kernel_launch: unexpected n_in %d / ws %zu\n", n_in, ws_size); grid = -1; return; }
        hipGetDevice(&dev); hipDeviceGetAttribute(&cus, hipDeviceAttributeMultiprocessorCount, dev);
        if (hipFuncSetAttribute((const void*)mk_fwd, hipFuncAttributeMaxDynamicSharedMemorySize, LDS_BYTES) != hipSuccess) { fprintf(stderr, "kernel_launch: hipFuncSetAttribute failed\n"); grid = -1; return; }
        int per_cu = 0;
        if (hipOccupancyMaxActiveBlocksPerMultiprocessor(&per_cu, (const void*)mk_fwd, 512, LDS_BYTES) != hipSuccess || per_cu < 1) { fprintf(stderr, "kernel_launch: occupancy query says %d\n", per_cu); per_cu = 1; }
        (void)hipGetLastError();
        if (cus < 256) { fprintf(stderr, "kernel_launch: needs 256 CUs, got %d\n", cus); grid = -1; return; }
        grid = 256;
    }
    if (grid < 0) return;
    Args a{};
    for (int i = 0; i < 26; ++i) a.in[i] = (const float*)d_in[i];
    a.out = (float*)d_out; a.ws = (unsigned char*)d_ws;
#if MK_PER_PHASE_LAUNCH
    for (int p = 0; p < NPHASE; ++p) { if (PROBE_ONLY_LAUNCH >= 0 && p != PROBE_ONLY_LAUNCH) continue; a.ph_lo = p; a.ph_hi = p + 1; hipLaunchKernelGGL(mk_fwd, dim3(grid), dim3(512), LDS_BYTES, stream, a); }
#else
    a.ph_lo = 0; a.ph_hi = NPHASE;
#if MK_COOP
    void* args[] = {&a};
    hipError_t e = hipLaunchCooperativeKernel((const void*)mk_fwd, dim3(grid), dim3(512), args, LDS_BYTES, stream);
    if (e != hipSuccess) fprintf(stderr, "cooperative launch failed: %s (grid %d)\n", hipGetErrorString(e), grid);
#else
    hipLaunchKernelGGL(mk_fwd, dim3(grid), dim3(512), LDS_BYTES, stream, a);
#endif
#endif
}
```
